# Optimizing an MI355X kernel written in HIP

```python
import jax, jax.numpy as jnp
from jax import lax
import numpy as np

D_MODEL = 1024
BATCH = 1
SEQ = 16384
DEPTH = 2

GRID_W = 64
CTX_LEN = 256
RET_HEADS = 4
RET_DK = 128
RET_DV = 128
RET_CHUNK = 128
WIN_HEADS = 8
WIN_KV_HEADS = 2
WIN_HEAD_DIM = 64
WINDOW = 128
WIN_BLOCK = 128
NA_HEADS = 8
NA_HEAD_DIM = 64
NA_ROWS_MAX = 8
NA_COLS = 16
N_EXPERTS = 16
EXPERT_HIDDEN = 1024
CAPACITY_FACTOR = 2
N_BRANCHES = 3
N_MOD = 6
ROPE_BASE = 10000.0
EPS = 1e-6
NEG_INF = -1e30
RET_QK = RET_HEADS * RET_DK
RET_V = RET_HEADS * RET_DV
WIN_Q = WIN_HEADS * WIN_HEAD_DIM
WIN_KV = WIN_KV_HEADS * WIN_HEAD_DIM
NA_W = NA_HEADS * NA_HEAD_DIM
IN_SPLITS = (('q_r', RET_QK), ('k_r', RET_QK), ('v_r', RET_V), ('g_r', RET_V),
             ('q_w', WIN_Q), ('k_w', WIN_KV), ('v_w', WIN_KV),
             ('q_n', NA_W), ('k_n', NA_W), ('v_n', NA_W),
             ('gates', N_BRANCHES * D_MODEL))
IN_COLS = 2 * RET_QK + 2 * RET_V + WIN_Q + 2 * WIN_KV + 3 * NA_W + N_BRANCHES * D_MODEL
KV_NAMES = ('k_r', 'v_r', 'k_w', 'v_w', 'k_n', 'v_n')

kernel_name = 'hybrid_retention_window_natten_ecmoe'


def rms_norm(x, g):
    xf = x.astype(jnp.float32)
    y = xf * lax.rsqrt(jnp.mean(xf * xf, axis=-1, keepdims=True) + EPS)
    return (y * g.astype(jnp.float32)).astype(x.dtype)


def modulate(h, shift, scale):
    return h * (1 + scale[:, None, :]) + shift[:, None, :]


def column_layout():
    layout, off = {}, 0
    for name, size in IN_SPLITS:
        layout[name] = (off, size)
        off += size
    return layout


def split_columns(p):
    return {n: p[..., o:o + s] for n, (o, s) in column_layout().items()}


def heads(t, n_heads):
    return t.reshape(t.shape[0], t.shape[1], n_heads, -1)


def axial_rope(x):
    n, d = x.shape[1], x.shape[-1]
    nf = d // 4
    t = jnp.arange(n)
    row = (t // GRID_W).astype(jnp.float32)
    col = (t % GRID_W).astype(jnp.float32)
    inv = ROPE_BASE ** (-jnp.arange(nf, dtype=jnp.float32) / nf)
    ang = jnp.concatenate([row[:, None] * inv, col[:, None] * inv], axis=-1)
    cos = jnp.cos(ang)[None, :, None, :]
    sin = jnp.sin(ang)[None, :, None, :]
    xf = x.astype(jnp.float32)
    x1, x2 = xf[..., :d // 2], xf[..., d // 2:]
    return jnp.concatenate([x1 * cos - x2 * sin, x1 * sin + x2 * cos], axis=-1).astype(x.dtype)


def retention_final_state(k, v, log_gamma):
    n = k.shape[2]
    w = jnp.exp((n - 1 - jnp.arange(n, dtype=jnp.float32))[None, :] * log_gamma[:, None])
    return jnp.einsum('bhnd,bhne->bhde', k * w[None, :, :, None], v)


def retention_chunkwise(q, k, v, log_gamma, state0, include_diag):
    b, h, n, dk = q.shape
    dv = v.shape[-1]
    ch = RET_CHUNK
    nc = n // ch
    qc = q.reshape(b, h, nc, ch, dk)
    kc = k.reshape(b, h, nc, ch, dk)
    vc = v.reshape(b, h, nc, ch, dv)
    i = jnp.arange(ch, dtype=jnp.float32)
    diff = i[:, None] - i[None, :]
    lg = log_gamma[:, None, None]
    dmat = jnp.where(diff >= (0.0 if include_diag else 1.0), jnp.exp(jnp.maximum(diff, 0.0) * lg), 0.0)
    inner = jnp.einsum('bhnid,bhnjd->bhnij', qc, kc) * dmat[None, :, None]
    inner = jnp.einsum('bhnij,bhnje->bhnie', inner, vc)
    zeta = jnp.exp((ch - 1 - i)[None, :] * log_gamma[:, None])
    s = jnp.einsum('bhnjd,bhnje->nbhde', kc * zeta[None, :, None, :, None], vc)
    chunk_decay = jnp.exp(ch * log_gamma)[None, :, None, None]

    def step(r, s_n):
        return chunk_decay * r + s_n, r

    _, r_prev = lax.scan(step, state0, s)
    xi = jnp.exp((i + 1)[None, :] * log_gamma[:, None])
    cross = jnp.einsum('bhnid,nbhde->bhnie', qc, r_prev) * xi[None, :, None, :, None]
    return (inner + cross).reshape(b, h, n, dv)


def bidirectional_retention(q, k, v, lg_f, lg_b, state_f, state_b):
    flip = lambda t: jnp.flip(t, axis=2)
    fwd = retention_chunkwise(q, k, v, lg_f, state_f, True)
    bwd = retention_chunkwise(flip(q), flip(k), flip(v), lg_b, state_b, False)
    return fwd + flip(bwd)


def retention_readout(y, g, gn_gain):
    mu = jnp.mean(y, axis=-1, keepdims=True)
    var = jnp.mean(jnp.square(y - mu), axis=-1, keepdims=True)
    y = (y - mu) * lax.rsqrt(var + EPS)
    y = jnp.swapaxes(y, 1, 2).reshape(y.shape[0], y.shape[2], -1) * gn_gain.astype(jnp.float32)
    return (y * jax.nn.silu(g.astype(jnp.float32))).astype(g.dtype)


def retention_mixer(px, pc, decay_logit, gn_gain, need_ctx):
    lg_f = jax.nn.log_sigmoid(decay_logit[0].astype(jnp.float32))
    lg_b = jax.nn.log_sigmoid(decay_logit[1].astype(jnp.float32))
    to_bhnd = lambda t: jnp.swapaxes(t, 1, 2).astype(jnp.float32)
    k_scale = RET_DK ** -0.5
    qx = to_bhnd(axial_rope(heads(px['q_r'], RET_HEADS)))
    kx = to_bhnd(axial_rope(heads(px['k_r'], RET_HEADS))) * k_scale
    vx = to_bhnd(heads(px['v_r'], RET_HEADS))
    kc = to_bhnd(heads(pc['k_r'], RET_HEADS)) * k_scale
    vc = to_bhnd(heads(pc['v_r'], RET_HEADS))
    flip = lambda t: jnp.flip(t, axis=2)
    state_f = retention_final_state(kc, vc, lg_f)
    state_b = retention_final_state(flip(kc), flip(vc), lg_b)
    yx = retention_readout(bidirectional_retention(qx, kx, vx, lg_f, lg_b, state_f, state_b), px['g_r'], gn_gain)
    yc = None
    if need_ctx:
        qc = to_bhnd(heads(pc['q_r'], RET_HEADS))
        zero = jnp.zeros(state_f.shape, jnp.float32)
        yc = retention_readout(bidirectional_retention(qc, kc, vc, lg_f, lg_b, zero, zero), pc['g_r'], gn_gain)
    return yx, yc


def context_self_attention(q, k, v, sink):
    b, l, hq, d = q.shape
    hkv = k.shape[2]
    g = hq // hkv
    qg = q.reshape(b, l, hkv, g, d)
    s = jnp.einsum('bqhgd,bkhd->bhgqk', qg, k).astype(jnp.float32) * d ** -0.5
    if sink is not None:
        s_sink = jnp.broadcast_to(sink.astype(jnp.float32).reshape(1, hkv, g, 1, 1), s.shape[:-1] + (1,))
        s = jnp.concatenate([s, s_sink], axis=-1)
    p = jax.nn.softmax(s, axis=-1)[..., :l].astype(v.dtype)
    return jnp.einsum('bhgqk,bkhd->bqhgd', p, v).reshape(b, l, hq * d)


def banded_window_attention(q, k, v, kc, vc, sink):
    b, n, hq, d = q.shape
    hkv = k.shape[2]
    g = hq // hkv
    l = kc.shape[1]
    nb = n // WIN_BLOCK
    pad = ((0, 0), (WIN_BLOCK, WIN_BLOCK), (0, 0), (0, 0))

    def band(t):
        tb = jnp.pad(t, pad).reshape(b, nb + 2, WIN_BLOCK, hkv, d)
        return jnp.concatenate([tb[:, :-2], tb[:, 1:-1], tb[:, 2:]], axis=2)

    kb, vb = band(k), band(v)
    qb = q.reshape(b, nb, WIN_BLOCK, hkv, g, d)
    scale = d ** -0.5
    s_loc = jnp.einsum('bnqhgd,bnkhd->bnhgqk', qb, kb).astype(jnp.float32) * scale
    s_ctx = jnp.einsum('bnqhgd,blhd->bnhgql', qb, kc).astype(jnp.float32) * scale
    qpos = jnp.arange(WIN_BLOCK)[:, None]
    kpos = jnp.arange(3 * WIN_BLOCK)[None, :] - WIN_BLOCK
    kabs = jnp.arange(nb)[:, None, None] * WIN_BLOCK + kpos[None]
    valid = (jnp.abs(kpos - qpos) <= WINDOW)[None] & (kabs >= 0) & (kabs < n)
    s_loc = jnp.where(valid[None, :, None, None], s_loc, NEG_INF)
    s_sink = jnp.broadcast_to(sink.astype(jnp.float32).reshape(1, 1, hkv, g, 1, 1), s_ctx.shape[:-1] + (1,))
    p = jax.nn.softmax(jnp.concatenate([s_loc, s_ctx, s_sink], axis=-1), axis=-1)
    kl = 3 * WIN_BLOCK
    p_loc = p[..., :kl].astype(v.dtype)
    p_ctx = p[..., kl:kl + l].astype(v.dtype)
    out = jnp.einsum('bnhgqk,bnkhd->bnqhgd', p_loc, vb) + jnp.einsum('bnhgql,blhd->bnqhgd', p_ctx, vc)
    return out.reshape(b, n, hq * d)


def window_mixer(px, pc, sink, need_ctx):
    q = axial_rope(heads(px['q_w'], WIN_HEADS))
    k = axial_rope(heads(px['k_w'], WIN_KV_HEADS))
    v = heads(px['v_w'], WIN_KV_HEADS)
    kc = heads(pc['k_w'], WIN_KV_HEADS)
    vc = heads(pc['v_w'], WIN_KV_HEADS)
    yx = banded_window_attention(q, k, v, kc, vc, sink)
    yc = context_self_attention(heads(pc['q_w'], WIN_HEADS), kc, vc, sink) if need_ctx else None
    return yx, yc


def neighbourhood_attention(q, k, v, kc, vc, rpb):
    b, n, h, d = q.shape
    rows = n // GRID_W
    kr = min(NA_ROWS_MAX, rows)
    r = jnp.arange(rows)
    row_idx = jnp.clip(r - kr // 2, 0, rows - kr)[:, None] + jnp.arange(kr)[None, :]
    cq = jnp.arange(GRID_W)
    col_start = jnp.clip(cq - NA_COLS // 2, 0, GRID_W - NA_COLS)
    col_valid = (cq[None, :] >= col_start[:, None]) & (cq[None, :] < col_start[:, None] + NA_COLS)
    ri = row_idx - r[:, None] + NA_ROWS_MAX - 1
    ci = jnp.clip(cq[None, :] - cq[:, None], -(NA_COLS - 1), NA_COLS - 1) + NA_COLS - 1
    bias = rpb.astype(jnp.float32)[:, ri[:, None, :, None], ci[None, :, None, :]]
    qg = q.reshape(b, rows, GRID_W, h, d)
    k_rows = k.reshape(b, rows, GRID_W, h, d)[:, row_idx]
    v_rows = v.reshape(b, rows, GRID_W, h, d)[:, row_idx]
    scale = d ** -0.5
    s_loc = jnp.einsum('brchd,brkwhd->bhrckw', qg, k_rows).astype(jnp.float32) * scale + bias[None]
    s_loc = jnp.where(col_valid[:, None, :], s_loc, NEG_INF).reshape(b, h, rows, GRID_W, kr * GRID_W)
    s_ctx = jnp.einsum('brchd,blhd->bhrcl', qg, kc).astype(jnp.float32) * scale
    p = jax.nn.softmax(jnp.concatenate([s_loc, s_ctx], axis=-1), axis=-1)
    nl = kr * GRID_W
    p_loc = p[..., :nl].reshape(b, h, rows, GRID_W, kr, GRID_W).astype(v.dtype)
    p_ctx = p[..., nl:].astype(v.dtype)
    out = jnp.einsum('bhrckw,brkwhd->brchd', p_loc, v_rows) + jnp.einsum('bhrcl,blhd->brchd', p_ctx, vc)
    return out.reshape(b, n, h * d)


def na_mixer(px, pc, rpb, need_ctx):
    q = heads(px['q_n'], NA_HEADS)
    k = heads(px['k_n'], NA_HEADS)
    v = heads(px['v_n'], NA_HEADS)
    kc = heads(pc['k_n'], NA_HEADS)
    vc = heads(pc['v_n'], NA_HEADS)
    yx = neighbourhood_attention(q, k, v, kc, vc, rpb)
    yc = context_self_attention(heads(pc['q_n'], NA_HEADS), kc, vc, None) if need_ctx else None
    return yx, yc


def gated_merge(gates, ya, yb, yc, w_ret, w_win, w_na, w_out):
    ga, gb, gc = jnp.split(jax.nn.sigmoid(gates), N_BRANCHES, axis=-1)
    return (ga * (ya @ w_ret) + gb * (yb @ w_win) + gc * (yc @ w_na)) @ w_out


def hybrid_mixer(hx, hc, w_in, decay_logit, gn_gain, w_ret, sink, w_win, rpb, w_na, w_out, need_ctx):
    px = split_columns(hx @ w_in)
    if need_ctx:
        pc = split_columns(hc @ w_in)
    else:
        lay = column_layout()
        pc = {nm: hc @ w_in[:, lay[nm][0]:lay[nm][0] + lay[nm][1]] for nm in KV_NAMES}
    ya, yca = retention_mixer(px, pc, decay_logit, gn_gain, need_ctx)
    yb, ycb = window_mixer(px, pc, sink, need_ctx)
    yc, ycc = na_mixer(px, pc, rpb, need_ctx)
    mx = gated_merge(px['gates'], ya, yb, yc, w_ret, w_win, w_na, w_out)
    mc = gated_merge(pc['gates'], yca, ycb, ycc, w_ret, w_win, w_na, w_out) if need_ctx else None
    return mx, mc


def expert_choice_ffn(h, w_router, w_gate, w_up, w_down):
    b, n, d = h.shape
    cap = CAPACITY_FACTOR * n // N_EXPERTS
    aff = jax.nn.softmax((h @ w_router).astype(jnp.float32), axis=-1)
    gate, idx = lax.top_k(jnp.swapaxes(aff, 1, 2), cap)
    bidx = jnp.arange(b)[:, None, None]
    xe = h[bidx, idx]
    hid = jax.nn.silu(jnp.einsum('becd,edf->becf', xe, w_gate)) * jnp.einsum('becd,edf->becf', xe, w_up)
    ye = jnp.einsum('becf,efd->becd', hid, w_down) * gate[..., None].astype(h.dtype)
    return jnp.zeros_like(h).at[bidx, idx].add(ye)


def setup_inputs(seed: int = 0) -> dict:
    key = jax.random.key(seed)
    ks = jax.random.split(key, 24)
    f32 = jnp.float32
    d = D_MODEL
    nrm = lambda k, shape, s: jax.random.normal(k, shape, f32) * s
    gamma0 = 1.0 - 2.0 ** (-5.0 - np.arange(RET_HEADS))
    logit0 = jnp.asarray(np.log(gamma0 / (1.0 - gamma0)).astype(np.float32))
    return {
        'x': nrm(ks[0], (BATCH, SEQ, d), 1.0),
        'c': nrm(ks[1], (BATCH, d), 1.0),
        'ctx': nrm(ks[2], (BATCH, CTX_LEN, d), 1.0),
        'c_ctx': nrm(ks[3], (d,), 1.0),
        'w_mod': nrm(ks[4], (DEPTH, d, N_MOD * d), 0.5 * d ** -0.5),
        'b_mod': nrm(ks[5], (DEPTH, N_MOD * d), 0.02),
        'g_mix': 1.0 + nrm(ks[6], (DEPTH, d), 0.02),
        'g_ffn': 1.0 + nrm(ks[7], (DEPTH, d), 0.02),
        'w_in': nrm(ks[8], (DEPTH, d, IN_COLS), d ** -0.5),
        'ret_decay_logit': logit0[None, None, :] + nrm(ks[9], (DEPTH, 2, RET_HEADS), 0.1),
        'ret_gn': 1.0 + nrm(ks[10], (DEPTH, RET_V), 0.02),
        'w_ret': nrm(ks[11], (DEPTH, RET_V, d), RET_V ** -0.5),
        'win_sink': nrm(ks[12], (DEPTH, WIN_HEADS), 1.0),
        'w_win': nrm(ks[13], (DEPTH, WIN_Q, d), WIN_Q ** -0.5),
        'na_rpb': nrm(ks[14], (DEPTH, NA_HEADS, 2 * NA_ROWS_MAX - 1, 2 * NA_COLS - 1), 0.1),
        'w_na': nrm(ks[15], (DEPTH, NA_W, d), NA_W ** -0.5),
        'w_out': nrm(ks[16], (DEPTH, d, d), d ** -0.5),
        'w_router': nrm(ks[17], (DEPTH, d, N_EXPERTS), d ** -0.5),
        'w_exp_gate': nrm(ks[18], (DEPTH, N_EXPERTS, d, EXPERT_HIDDEN), d ** -0.5),
        'w_exp_up': nrm(ks[19], (DEPTH, N_EXPERTS, d, EXPERT_HIDDEN), d ** -0.5),
        'w_exp_down': nrm(ks[20], (DEPTH, N_EXPERTS, EXPERT_HIDDEN, d), EXPERT_HIDDEN ** -0.5),
        'g_final': 1.0 + nrm(ks[21], (d,), 0.02),
    }


def reference(x, c, ctx, c_ctx, w_mod, b_mod, g_mix, g_ffn, w_in, ret_decay_logit, ret_gn, w_ret,
              win_sink, w_win, na_rpb, w_na, w_out, w_router, w_exp_gate, w_exp_up, w_exp_down, g_final):
    d = x.shape[-1]
    sc = jax.nn.silu(c)
    scc = jax.nn.silu(c_ctx)[None]
    for layer in range(DEPTH):
        need_ctx = layer < DEPTH - 1
        mod_x = (sc @ w_mod[layer] + b_mod[layer]).reshape(-1, N_MOD, d)
        n_mod_c = N_MOD if need_ctx else 2
        mod_c = (scc @ w_mod[layer][:, :n_mod_c * d] + b_mod[layer][:n_mod_c * d]).reshape(1, n_mod_c, d)
        hx = modulate(rms_norm(x, g_mix[layer]), mod_x[:, 0], mod_x[:, 1])
        hc = modulate(rms_norm(ctx, g_mix[layer]), mod_c[:, 0], mod_c[:, 1])
        mx, mc = hybrid_mixer(hx, hc, w_in[layer], ret_decay_logit[layer], ret_gn[layer], w_ret[layer],
                              win_sink[layer], w_win[layer], na_rpb[layer], w_na[layer], w_out[layer], need_ctx)
        x = x + mod_x[:, 2, None] * mx
        hx = modulate(rms_norm(x, g_ffn[layer]), mod_x[:, 3], mod_x[:, 4])
        x = x + mod_x[:, 5, None] * expert_choice_ffn(hx, w_router[layer], w_exp_gate[layer],
                                                      w_exp_up[layer], w_exp_down[layer])
        if need_ctx:
            ctx = ctx + mod_c[:, 2, None] * mc
            hc = modulate(rms_norm(ctx, g_ffn[layer]), mod_c[:, 3], mod_c[:, 4])
            ctx = ctx + mod_c[:, 5, None] * expert_choice_ffn(hc, w_router[layer], w_exp_gate[layer],
                                                              w_exp_up[layer], w_exp_down[layer])
    return rms_norm(x, g_final)
```

```cpp
#include <hip/hip_runtime.h>
#include <hip/hip_bf16.h>
#include <hip/hip_cooperative_groups.h>
#include <cstdio>
#include <cstdint>
namespace cg = cooperative_groups;

#ifndef MK_MULTI
#define MK_MULTI 1
#endif

#define DI __device__ __forceinline__
typedef unsigned short u16;
typedef __attribute__((ext_vector_type(8))) short bf16x8;
typedef __attribute__((ext_vector_type(4))) float f32x4;
typedef __attribute__((ext_vector_type(4))) unsigned int u32x4;

constexpr int NLAT = 16384, NCTX = 256, NROWS = NLAT + NCTX, DM = 1024, INC = 7424;
constexpr int C_QR = 0, C_KR = 512, C_VR = 1024, C_GR = 1536, C_QW = 2048, C_KW = 2560, C_VW = 2688, C_QN = 2816, C_KN = 3328, C_VN = 3840, C_GATE = 4352;
constexpr int NCHUNK = NROWS / 128;
constexpr int NEXP = 16, EH = 1024, CAP_LAT = 2048, CAP_CTX = 32;
constexpr int NTHREADS = 256;
constexpr int LDS_BYTES = 72 * 1024;
constexpr int NPHASE = 24;

struct Params {
    const float *x, *c, *ctx, *c_ctx, *w_mod, *b_mod, *g_mix, *g_ffn, *w_in, *decay, *ret_gn, *w_ret, *sink, *w_win, *rpb, *w_na, *w_out,
        *w_router, *w_eg, *w_eu, *w_ed, *g_final;
    float* out;
    float* ctxres;
    float* mod;
    float2* rope128;
    float2* rope64;
    u16 *wt_in, *wt_ret, *wt_win, *wt_na, *wt_out, *wt_gu, *wt_dn;
    u16* hx;
    u16* px;
    u16 *ya, *yb, *yc;
    float* S;
    u16* R;
    float* aff;
    int* sel_idx;
    float* sel_gate;
    u16* hid;
    u16* hidc;
};

DI int TIDX() { int t = threadIdx.x; asm volatile("" : "+v"(t)); return t; }
DI int BIDX() { int t = blockIdx.x; asm volatile("" : "+s"(t)); return t; }
DI u16 f2bf(float x) { unsigned u = __float_as_uint(x); u += 0x7fffu + ((u >> 16) & 1u); return (u16)(u >> 16); }
DI float bf2f(u16 h) { return __uint_as_float(((unsigned)h) << 16); }
DI float bflo(unsigned w) { return __uint_as_float(w << 16); }
DI float bfhi(unsigned w) { return __uint_as_float(w & 0xffff0000u); }
DI unsigned pack2(float a, float b) { return (unsigned)f2bf(a) | ((unsigned)f2bf(b) << 16); }
DI float sigmoidf_(float x) { return 1.f / (1.f + __expf(-x)); }
DI float siluf_(float x) { return x / (1.f + __expf(-x)); }
DI float wave_sum(float v) { for (int o = 32; o > 0; o >>= 1) v += __shfl_xor(v, o); return v; }
#define MFMA16(a, b, c) __builtin_amdgcn_mfma_f32_16x16x32_bf16((a), (b), (c), 0, 0, 0)

template <int MR>
DI void zero_acc(f32x4 (&acc)[MR][4]) {
#pragma unroll
    for (int m = 0; m < MR; ++m)
#pragma unroll
        for (int n = 0; n < 4; ++n) acc[m][n] = f32x4{0.f, 0.f, 0.f, 0.f};
}

template <int KT>
DI void gemm_core(f32x4 (&acc)[4][4], const u16* a0, const u16* a1, const u16* b0, const u16* b1, char* smem) {
    const int tid = TIDX(), lane = tid & 63, wid = tid >> 6, wr = wid >> 1, wc = wid & 1, fr = lane & 15, fq = lane >> 4;
    auto stage = [&](int kt, int buf) {
        char* base = smem + buf * 16384;
        __builtin_amdgcn_global_load_lds((const unsigned*)(a0 + kt * 32), (unsigned*)(base + tid * 16), 16, 0, 0);
        __builtin_amdgcn_global_load_lds((const unsigned*)(a1 + kt * 32), (unsigned*)(base + 4096 + tid * 16), 16, 0, 0);
        __builtin_amdgcn_global_load_lds((const unsigned*)(b0 + kt * 32), (unsigned*)(base + 8192 + tid * 16), 16, 0, 0);
        __builtin_amdgcn_global_load_lds((const unsigned*)(b1 + kt * 32), (unsigned*)(base + 12288 + tid * 16), 16, 0, 0);
    };
    __syncthreads();
    stage(0, 0);
    for (int kt = 0; kt < KT; ++kt) {
        asm volatile("s_waitcnt vmcnt(0)" ::: "memory");
        __syncthreads();
        if (kt + 1 < KT) stage(kt + 1, (kt + 1) & 1);
        const char* SA = smem + (kt & 1) * 16384;
        const char* SB = SA + 8192;
        bf16x8 At[4], Bt[4];
#pragma unroll
        for (int m = 0; m < 4; ++m) At[m] = *(const bf16x8*)(SA + (wr * 64 + m * 16 + fr) * 64 + fq * 16);
#pragma unroll
        for (int n = 0; n < 4; ++n) Bt[n] = *(const bf16x8*)(SB + (wc * 64 + n * 16 + fr) * 64 + fq * 16);
#pragma unroll
        for (int m = 0; m < 4; ++m)
#pragma unroll
            for (int n = 0; n < 4; ++n) acc[m][n] = MFMA16(At[m], Bt[n], acc[m][n]);
    }
}

template <int MR>
DI void mma_lds64(f32x4 (&acc)[MR][4], const u16* As, int lda, const u16* Bs, int ldb) {
    const int tid = TIDX(), lane = tid & 63, wid = tid >> 6, wr = wid >> 1, wc = wid & 1, fr = lane & 15, fq = lane >> 4;
#pragma unroll
    for (int kk = 0; kk < 2; ++kk) {
        bf16x8 At[MR], Bt[4];
#pragma unroll
        for (int m = 0; m < MR; ++m) At[m] = *(const bf16x8*)(As + (wr * (MR * 16) + m * 16 + fr) * lda + kk * 32 + fq * 8);
#pragma unroll
        for (int n = 0; n < 4; ++n) Bt[n] = *(const bf16x8*)(Bs + (wc * 64 + n * 16 + fr) * ldb + kk * 32 + fq * 8);
#pragma unroll
        for (int m = 0; m < MR; ++m)
#pragma unroll
            for (int n = 0; n < 4; ++n) acc[m][n] = MFMA16(At[m], Bt[n], acc[m][n]);
    }
}
template <int ROWS>
DI void stage_n64(u16* dst, int ld, const u16* src, long sstride) {
    const int tid = TIDX();
#pragma unroll
    for (int i = 0; i < ROWS / 32; ++i) {
        int idx = i * 256 + tid, row = idx >> 3, ch = idx & 7;
        u32x4 v = *(const u32x4*)(src + (long)row * sstride + ch * 8);
        *(u32x4*)(dst + row * ld + ch * 8) = v;
    }
}
template <bool SCALE, int NF>
DI void stage_t64(u16* dst, int ld, const u16* src, long sstride, float scale_tok_lane  ) {
    const int tid = TIDX();
#pragma unroll
    for (int i = 0; i < NF / 32; ++i) {
        int idx = i * 256 + tid, jj = idx & 63, ch = idx >> 6;
        u32x4 v = *(const u32x4*)(src + (long)jj * sstride + ch * 8);
#pragma unroll
        for (int e = 0; e < 4; ++e) {
            float lo = bflo(v[e]), hi = bfhi(v[e]);
            if (SCALE) { lo *= scale_tok_lane; hi *= scale_tok_lane; }
            dst[(ch * 8 + 2 * e) * ld + jj] = SCALE ? f2bf(lo) : (u16)(v[e] & 0xffffu);
            dst[(ch * 8 + 2 * e + 1) * ld + jj] = SCALE ? f2bf(hi) : (u16)(v[e] >> 16);
        }
    }
}

DI void convert_tile(const Params& p, int layer, int tile, char* smem);

DI void ph0_gemv_item(const Params& p, int item, char* smem) {
    const int tid = TIDX();
    const int l = item / 96, cg_ = item % 96;
    float* sl = (float*)smem;
    float* red = (float*)(smem + 8192);
    __syncthreads();
    for (int k = tid; k < 1024; k += 256) { sl[k] = siluf_(p.c[k]); sl[1024 + k] = siluf_(p.c_ctx[k]); }
    __syncthreads();
    const int c4 = tid & 15, kp = tid >> 4;
    const int col = cg_ * 64 + c4 * 4;
    const float* w = p.w_mod + (long)l * 1024 * 6144 + col;
    float a0[4] = {0, 0, 0, 0}, a1[4] = {0, 0, 0, 0};
#pragma unroll 8
    for (int kk = 0; kk < 64; ++kk) {
        int k = kp * 64 + kk;
        float4 wv = *(const float4*)(w + (long)k * 6144);
        float s0 = sl[k], s1 = sl[1024 + k];
        a0[0] += s0 * wv.x; a0[1] += s0 * wv.y; a0[2] += s0 * wv.z; a0[3] += s0 * wv.w;
        a1[0] += s1 * wv.x; a1[1] += s1 * wv.y; a1[2] += s1 * wv.z; a1[3] += s1 * wv.w;
    }
#pragma unroll
    for (int j = 0; j < 4; ++j) { red[(kp * 2 + 0) * 64 + c4 * 4 + j] = a0[j]; red[(kp * 2 + 1) * 64 + c4 * 4 + j] = a1[j]; }
    __syncthreads();
    if (tid < 128) {
        int src = tid >> 6, cr = tid & 63;
        float s = 0.f;
        for (int q = 0; q < 16; ++q) s += red[(q * 2 + src) * 64 + cr];
        int n = cg_ * 64 + cr;
        p.mod[(l * 2 + src) * 6144 + n] = s + p.b_mod[l * 6144 + n];
    }
}
DI void sincos_d(double a, float& c, float& s) {
    const double TWO_PI = 6.283185307179586476925286766559;
    double k = rint(a / TWO_PI);
    double r = a - k * TWO_PI;
    double r2 = r * r;
    double ts = r, tc = 1.0, ss = r, cc = 1.0;
    for (int i = 1; i <= 14; ++i) {
        tc = -tc * r2 / (double)((2 * i - 1) * (2 * i));
        ts = -ts * r2 / (double)((2 * i) * (2 * i + 1));
        cc += tc; ss += ts;
    }
    c = (float)cc; s = (float)ss;
}
DI void ph0_rope_item(const Params& p, int item) {
    int idx = item * 256 + TIDX();
    const double LN_BASE = 9.210340371976184;
    if (idx < 8192) {
        int pos = idx >> 5, f = idx & 31;
        float inv = (float)exp(-(double)f / 32.0 * LN_BASE);
        float ang = (float)pos * inv;
        float c, s; sincos_d((double)ang, c, s);
        p.rope128[idx] = make_float2(c, s);
    } else {
        int i2 = idx - 8192;
        int pos = i2 >> 4, f = i2 & 15;
        float inv = (float)exp(-(double)f / 16.0 * LN_BASE);
        float ang = (float)pos * inv;
        float c, s; sincos_d((double)ang, c, s);
        p.rope64[i2] = make_float2(c, s);
    }
}

constexpr int CONV_TILES = 1856 + 384 + 256 + 12288;
DI void convert_tile(const Params& p, int layer, int tile, char* smem) {
    const int tid = TIDX();
    const float* src; u16* dst; int K, N, mode = 0;
    if (tile < 1856) { src = p.w_in + (long)layer * 1024 * INC; dst = p.wt_in; K = 1024; N = INC; mode = 1; }
    else if (tile < 1856 + 384) {
        int t = tile - 1856, which = t / 128; tile = t % 128; K = 512; N = 1024;
        src = (which == 0 ? p.w_ret : which == 1 ? p.w_win : p.w_na) + (long)layer * 512 * 1024;
        dst = (which == 0 ? p.wt_ret : which == 1 ? p.wt_win : p.wt_na);
    } else if (tile < 1856 + 384 + 256) { tile -= 1856 + 384; src = p.w_out + (long)layer * 1024 * 1024; dst = p.wt_out; K = 1024; N = 1024; }
    else {
        int t = tile - (1856 + 384 + 256), which = t / 4096, e = (t % 4096) / 256; tile = t % 256; K = 1024; N = 1024;
        long eo = ((long)layer * NEXP + e) * 1024 * 1024;
        if (which == 0) { src = p.w_eg + eo; dst = p.wt_gu + (long)e * 2048 * 1024; mode = 2; }
        else if (which == 1) { src = p.w_eu + eo; dst = p.wt_gu + (long)e * 2048 * 1024; mode = 3; }
        else { src = p.w_ed + eo; dst = p.wt_dn + (long)e * 1024 * 1024; }
    }
    const int ntn = N / 64;
    const int k0 = (tile / ntn) * 64, n0 = (tile % ntn) * 64;
    float* T = (float*)smem;
    __syncthreads();
#pragma unroll
    for (int i = 0; i < 4; ++i) {
        int kk = (tid >> 4) + 16 * i, n4 = tid & 15;
        float4 v = *(const float4*)(src + (long)(k0 + kk) * N + n0 + n4 * 4);
        T[kk * 65 + n4 * 4 + 0] = v.x; T[kk * 65 + n4 * 4 + 1] = v.y; T[kk * 65 + n4 * 4 + 2] = v.z; T[kk * 65 + n4 * 4 + 3] = v.w;
    }
    __syncthreads();
#pragma unroll
    for (int i = 0; i < 2; ++i) {
        int nn = (tid >> 3) + 32 * i, k8 = tid & 7;
        u32x4 o;
#pragma unroll
        for (int e = 0; e < 4; ++e) o[e] = pack2(T[(k8 * 8 + 2 * e) * 65 + nn], T[(k8 * 8 + 2 * e + 1) * 65 + nn]);
        int n = n0 + nn, drow = n;
        if (mode == 1) {
            if (n < 1024) { int o_ = n & 127, s_ = (o_ < 32) ? o_ : (o_ < 64) ? o_ + 32 : (o_ < 96) ? o_ - 32 : o_; drow = (n & ~127) + s_; }
        } else if (mode == 2) drow = (n >> 5) * 64 + (n & 31);
        else if (mode == 3) drow = (n >> 5) * 64 + 32 + (n & 31);
        *(u32x4*)(dst + (long)drow * K + k0 + k8 * 8) = o;
    }
}

DI const float* resid_row(const Params& p, int layer, int row) {
    if (row < NLAT) return (layer == 0 ? p.x : p.out) + (long)row * DM;
    return (layer == 0 ? p.ctx : p.ctxres) + (long)(row - NLAT) * DM;
}
DI const float* cur_row(const Params& p, int row) { return row < NLAT ? p.out + (long)row * DM : p.ctxres + (long)(row - NLAT) * DM; }
DI void norm_row(const Params& p, int layer, int row, const float* xr, const float* g, int shift_idx, int scale_idx, u16* dst_row, float* keep  ) {
    const int lane = TIDX() & 63;
    const float* md = p.mod + (layer * 2 + (row < NLAT ? 0 : 1)) * 6144;
    float4 v[4]; float ss = 0.f;
#pragma unroll
    for (int i = 0; i < 4; ++i) { v[i] = *(const float4*)(xr + i * 256 + lane * 4); ss += v[i].x * v[i].x + v[i].y * v[i].y + v[i].z * v[i].z + v[i].w * v[i].w; }
    ss = wave_sum(ss);
    float rstd = rsqrtf(ss * (1.f / DM) + 1e-6f);
#pragma unroll
    for (int i = 0; i < 4; ++i) {
        int c0 = i * 256 + lane * 4;
        float4 gg = *(const float4*)(g + c0), sh = *(const float4*)(md + shift_idx * 1024 + c0), sc = *(const float4*)(md + scale_idx * 1024 + c0);
        float o0 = v[i].x * rstd * gg.x * (1.f + sc.x) + sh.x, o1 = v[i].y * rstd * gg.y * (1.f + sc.y) + sh.y;
        float o2 = v[i].z * rstd * gg.z * (1.f + sc.z) + sh.z, o3 = v[i].w * rstd * gg.w * (1.f + sc.w) + sh.w;
        uint2 pk; pk.x = pack2(o0, o1); pk.y = pack2(o2, o3);
        *(uint2*)(dst_row + c0) = pk;
        if (keep) *(float4*)(keep + c0) = make_float4(o0, o1, o2, o3);
    }
}

DI void phB_tile(const Params& p, int mt, int nt, char* smem) {
    const int tid = TIDX(), lane = tid & 63, wid = tid >> 6, wr = wid >> 1, wc = wid & 1, fr = lane & 15, fq = lane >> 4;
    f32x4 acc[4][4]; zero_acc<4>(acc);
    const int r0 = tid >> 2, ko = (tid & 3) * 8;
    const u16* a0 = p.hx + (long)(mt * 128 + r0) * DM + ko;
    const u16* b0 = p.wt_in + (long)(nt * 128 + r0) * DM + ko;
    gemm_core<32>(acc, a0, a0 + 64 * DM, b0, b0 + 64 * DM, smem);
    const bool lat = mt < 128;
    const int type = (nt < 8) ? 1 : (nt >= 16 && nt < 21) ? 2 : 0;
    if (type != 0 && lat) {
#pragma unroll
        for (int m = 0; m < 4; ++m)
#pragma unroll
            for (int j = 0; j < 4; ++j) {
                int t = mt * 128 + wr * 64 + m * 16 + fq * 4 + j;
                int pr = t >> 6, pc = t & 63;
#pragma unroll
                for (int n = 0; n < 2; ++n) {
                    float2 cs;
                    if (type == 1) { int pos = (wc == 0) ? pr : pc; cs = p.rope128[pos * 32 + n * 16 + fr]; }
                    else { int pos = (n == 0) ? pr : pc; cs = p.rope64[pos * 16 + fr]; }
                    float x1 = acc[m][n][j], x2 = acc[m][n + 2][j];
                    acc[m][n][j] = x1 * cs.x - x2 * cs.y;
                    acc[m][n + 2][j] = x1 * cs.y + x2 * cs.x;
                }
            }
    }
    const float mul = (nt >= 4 && nt < 8) ? 0.08838834764831845f : 1.f;
#pragma unroll
    for (int m = 0; m < 4; ++m)
#pragma unroll
        for (int n = 0; n < 4; ++n)
#pragma unroll
            for (int j = 0; j < 4; ++j) {
                int row = mt * 128 + wr * 64 + m * 16 + fq * 4 + j, col = nt * 128 + wc * 64 + n * 16 + fr;
                p.px[(long)row * INC + col] = f2bf(acc[m][n][j] * mul);
            }
}

struct AttnW {
    float q[64];
    float acc[64];
    float m, l;
};
DI void attn_load_q(AttnW& w, const u16* qrow) {
#pragma unroll
    for (int c = 0; c < 8; ++c) {
        u32x4 v = *(const u32x4*)(qrow + c * 8);
#pragma unroll
        for (int e = 0; e < 4; ++e) { w.q[c * 8 + 2 * e] = bflo(v[e]) * 0.125f; w.q[c * 8 + 2 * e + 1] = bfhi(v[e]) * 0.125f; }
    }
#pragma unroll
    for (int e = 0; e < 64; ++e) w.acc[e] = 0.f;
}
DI void attn_stage(u16* Ks, u16* Vs, const u16* px, int rowstart, int colK, int colV) {
    const int lane = TIDX() & 63;
#pragma unroll
    for (int i = 0; i < 8; ++i) {
        int idx = i * 64 + lane, key = idx >> 3, ch = idx & 7;
        const u16* src = px + (long)(rowstart + key) * INC;
        *(u32x4*)(Ks + key * 64 + ch * 8) = *(const u32x4*)(src + colK + ch * 8);
        *(u32x4*)(Vs + key * 64 + ch * 8) = *(const u32x4*)(src + colV + ch * 8);
    }
}
template <class F>
DI void attn_tile(AttnW& w, const u16* Ks, const u16* Vs, F&& f) {
    for (int j = 0; j < 64; ++j) {
        float s = 0.f;
        const u32x4* kr = (const u32x4*)(Ks + j * 64);
#pragma unroll
        for (int c = 0; c < 8; ++c) {
            u32x4 kk = kr[c];
#pragma unroll
            for (int e = 0; e < 4; ++e) { s += w.q[c * 8 + 2 * e] * bflo(kk[e]); s += w.q[c * 8 + 2 * e + 1] * bfhi(kk[e]); }
        }
        float bias = 0.f;
        bool valid = f(j, bias);
        s += bias;
        float mn = valid ? fmaxf(w.m, s) : w.m;
        float alpha = __expf(w.m - mn);
        float pj = valid ? __expf(s - mn) : 0.f;
        w.l = w.l * alpha + pj; w.m = mn;
        const u32x4* vr = (const u32x4*)(Vs + j * 64);
#pragma unroll
        for (int c = 0; c < 8; ++c) {
            u32x4 vv = vr[c];
#pragma unroll
            for (int e = 0; e < 4; ++e) {
                w.acc[c * 8 + 2 * e] = w.acc[c * 8 + 2 * e] * alpha + pj * bflo(vv[e]);
                w.acc[c * 8 + 2 * e + 1] = w.acc[c * 8 + 2 * e + 1] * alpha + pj * bfhi(vv[e]);
            }
        }
    }
}
DI void attn_store(const AttnW& w, u16* orow) {
    float inv = 1.f / w.l;
#pragma unroll
    for (int c = 0; c < 8; ++c) {
        u32x4 o;
#pragma unroll
        for (int e = 0; e < 4; ++e) o[e] = pack2(w.acc[c * 8 + 2 * e] * inv, w.acc[c * 8 + 2 * e + 1] * inv);
        *(u32x4*)(orow + c * 8) = o;
    }
}
DI void attn_wave_item(const Params& p, int layer, int kind, int blk, int h, char* smem) {
    const int lane = TIDX() & 63, wid = TIDX() >> 6;
    u16* Ks = (u16*)(smem + wid * 18432);
    u16* Vs = Ks + 4096;
    float* rpbs = (float*)(smem + wid * 18432 + 16384);
    AttnW w;
    const bool isna = (kind == 1 || kind == 3);
    const int t = ((kind >= 2) ? NLAT : 0) + blk * 64 + lane;
    const int colQ = isna ? C_QN + h * 64 : C_QW + h * 64;
    const int kvh = isna ? h : (h >> 2);
    const int colK = isna ? C_KN + kvh * 64 : C_KW + kvh * 64;
    const int colV = isna ? C_VN + kvh * 64 : C_VW + kvh * 64;
    attn_load_q(w, p.px + (long)t * INC + colQ);
    if (isna) { w.m = -1e30f; w.l = 0.f; } else { w.m = p.sink[layer * 8 + h]; w.l = 1.f; }
    if (kind == 0) {
        for (int i = 0; i < 5; ++i) {
            int start = blk * 64 - 128 + i * 64;
            if (start < 0 || start >= NLAT) continue;
            attn_stage(Ks, Vs, p.px, start, colK, colV);
            attn_tile(w, Ks, Vs, [&](int j, float& b) { int d = start + j - t; return d >= -128 && d <= 128; });
        }
    } else if (kind == 1) {
        const float* rp = p.rpb + ((long)layer * 8 + h) * 465;
        for (int i = lane; i < 465; i += 64) rpbs[i] = rp[i];
        const int r = blk, cq = lane;
        int sr = r - 4; sr = sr < 0 ? 0 : (sr > 248 ? 248 : sr);
        int cs = cq - 8; cs = cs < 0 ? 0 : (cs > 48 ? 48 : cs);
        for (int i = 0; i < 8; ++i) {
            int krow = sr + i;
            attn_stage(Ks, Vs, p.px, krow * 64, colK, colV);
            const float* rrow = rpbs + (krow - r + 7) * 31;
            attn_tile(w, Ks, Vs, [&](int j, float& b) {
                bool v = (j >= cs) && (j < cs + 16);
                int ci = j - cq + 15; ci = ci < 0 ? 0 : (ci > 30 ? 30 : ci);
                b = v ? rrow[ci] : 0.f;
                return v;
            });
        }
    }
    for (int i = 0; i < 4; ++i) {
        attn_stage(Ks, Vs, p.px, NLAT + i * 64, colK, colV);
        attn_tile(w, Ks, Vs, [&](int j, float& b) { return true; });
    }
    u16* y = isna ? p.yc : p.yb;
    attn_store(w, y + (long)t * 512 + h * 64);
}

DI void ret_gammas(const Params& p, int layer, int h, float& lgf2, float& lgb2) {
    float xf = p.decay[layer * 8 + h], xb = p.decay[layer * 8 + 4 + h];
    lgf2 = -log1pf(expf(-xf)) * 1.4426950408889634f;
    lgb2 = -log1pf(expf(-xb)) * 1.4426950408889634f;
}
DI void phC_state_item(const Params& p, int layer, int c, int h, int eh, char* smem) {
    const int tid = TIDX(), lane = tid & 63, wid = tid >> 6, wr = wid >> 1, wc = wid & 1, fr = lane & 15, fq = lane >> 4;
    u16* Av = (u16*)smem;
    u16* Bf = Av + 64 * 72;
    u16* Bb = Bf + 128 * 72;
    float lgf2, lgb2; ret_gammas(p, layer, h, lgf2, lgb2);
    f32x4 accF[2][4], accB[2][4]; zero_acc<2>(accF); zero_acc<2>(accB);
    const u16* base = p.px + (long)c * 128 * INC;
#pragma unroll 1
    for (int jh = 0; jh < 2; ++jh) {
        const int j = jh * 64 + (tid & 63);
        const float zf = exp2f((float)(127 - j) * lgf2), zb = exp2f((float)j * lgb2);
        __syncthreads();
        stage_t64<false, 64>(Av, 72, base + (long)jh * 64 * INC + C_VR + h * 128 + eh * 64, INC, 1.f);
        stage_t64<true, 128>(Bf, 72, base + (long)jh * 64 * INC + C_KR + h * 128, INC, zf);
        stage_t64<true, 128>(Bb, 72, base + (long)jh * 64 * INC + C_KR + h * 128, INC, zb);
        __syncthreads();
        mma_lds64<2>(accF, Av, 72, Bf, 72);
        mma_lds64<2>(accB, Av, 72, Bb, 72);
    }
    float* Sf = p.S + ((long)(c * 4 + h) * 2 + 0) * 16384;
    float* Sb = Sf + 16384;
#pragma unroll
    for (int m = 0; m < 2; ++m)
#pragma unroll
        for (int n = 0; n < 4; ++n)
#pragma unroll
            for (int j = 0; j < 4; ++j) {
                int e = eh * 64 + wr * 32 + m * 16 + fq * 4 + j, d = wc * 64 + n * 16 + fr;
                Sf[e * 128 + d] = accF[m][n][j];
                Sb[e * 128 + d] = accB[m][n][j];
            }
}

DI void phD_item(const Params& p, int layer, int item) {
    const int h = item >> 7, dir = (item >> 6) & 1, pos = (item & 63) * 256 + TIDX();
    float lgf2, lgb2; ret_gammas(p, layer, h, lgf2, lgb2);
    const float decay = exp2f(128.f * (dir == 0 ? lgf2 : lgb2));
    float r = 0.f;
    const long hs = (long)(h * 2 + dir) * 16384 + pos;
    auto chunk_at = [&](int i) -> int {
        if (dir == 0) return i < 2 ? 128 + i : i - 2;
        return i < 2 ? 129 - i : 129 - i;
    };
    for (int i0 = 0; i0 < NCHUNK; i0 += 13) {
        float s[13];
#pragma unroll
        for (int u = 0; u < 13; ++u) s[u] = p.S[(long)chunk_at(i0 + u) * 8 * 16384 + hs];
#pragma unroll
        for (int u = 0; u < 13; ++u) {
            p.R[(long)chunk_at(i0 + u) * 8 * 16384 + hs] = f2bf(r);
            r = decay * r + s[u];
        }
    }
}

DI void phE_item(const Params& p, int layer, int c, int h, int ih, char* smem) {
    const int tid = TIDX(), lane = tid & 63, wid = tid >> 6, wr = wid >> 1, wc = wid & 1, fr = lane & 15, fq = lane >> 4;
    u16* R0 = (u16*)smem;
    u16* R1 = R0 + 64 * 72;
    u16* R2 = R1 + 128 * 72;
    u16* P = (u16*)smem;
    float* red = (float*)(smem + (64 + 128 + 128) * 72 * 2);
    float lgf2, lgb2; ret_gammas(p, layer, h, lgf2, lgb2);
    const u16* base = p.px + (long)c * 128 * INC;
    const u16* qbase = base + (long)ih * 64 * INC + C_QR + h * 128;
    const u16* Rf = p.R + ((long)(c * 4 + h) * 2 + 0) * 16384;
    const u16* Rb = Rf + 16384;
    f32x4 Y[2][4], T[2][4];
    zero_acc<2>(Y); zero_acc<2>(T);
#pragma unroll 1
    for (int dh = 0; dh < 2; ++dh) {
        __syncthreads();
        stage_n64<64>(R0, 72, qbase + dh * 64, INC);
        stage_n64<128>(R1, 72, Rf + dh * 64, 128);
        stage_n64<128>(R2, 72, Rb + dh * 64, 128);
        __syncthreads();
        mma_lds64<2>(Y, R0, 72, R1, 72);
        mma_lds64<2>(T, R0, 72, R2, 72);
    }
#pragma unroll
    for (int m = 0; m < 2; ++m)
#pragma unroll
        for (int j = 0; j < 4; ++j) {
            int i = ih * 64 + wr * 32 + m * 16 + fq * 4 + j;
            float xf = exp2f((float)(i + 1) * lgf2), xb = exp2f((float)(128 - i) * lgb2);
#pragma unroll
            for (int n = 0; n < 4; ++n) Y[m][n][j] = xf * Y[m][n][j] + xb * T[m][n][j];
        }
    zero_acc<2>(T);
#pragma unroll 1
    for (int dh = 0; dh < 2; ++dh) {
        __syncthreads();
        stage_n64<64>(R0, 72, qbase + dh * 64, INC);
        stage_n64<128>(R1, 72, base + C_KR + h * 128 + dh * 64, INC);
        __syncthreads();
        mma_lds64<2>(T, R0, 72, R1, 72);
    }
    __syncthreads();
#pragma unroll
    for (int m = 0; m < 2; ++m)
#pragma unroll
        for (int n = 0; n < 4; ++n)
#pragma unroll
            for (int j = 0; j < 4; ++j) {
                int il = wr * 32 + m * 16 + fq * 4 + j, i = ih * 64 + il, jj = wc * 64 + n * 16 + fr;
                float dm = (i >= jj) ? exp2f((float)(i - jj) * lgf2) : exp2f((float)(jj - i) * lgb2);
                P[il * 136 + jj] = f2bf(T[m][n][j] * dm);
            }
#pragma unroll 1
    for (int jh = 0; jh < 2; ++jh) {
        __syncthreads();
        stage_t64<false, 128>(R2, 72, base + (long)jh * 64 * INC + C_VR + h * 128, INC, 1.f);
        __syncthreads();
        mma_lds64<2>(Y, P + jh * 64, 136, R2, 72);
    }
    float mu[2][4], rs[2][4];
#pragma unroll
    for (int m = 0; m < 2; ++m)
#pragma unroll
        for (int j = 0; j < 4; ++j) {
            float s = Y[m][0][j] + Y[m][1][j] + Y[m][2][j] + Y[m][3][j];
            s += __shfl_xor(s, 1); s += __shfl_xor(s, 2); s += __shfl_xor(s, 4); s += __shfl_xor(s, 8);
            if (fr == 0) red[(wr * 32 + m * 16 + fq * 4 + j) * 2 + wc] = s;
        }
    __syncthreads();
#pragma unroll
    for (int m = 0; m < 2; ++m)
#pragma unroll
        for (int j = 0; j < 4; ++j) { int il = wr * 32 + m * 16 + fq * 4 + j; mu[m][j] = (red[il * 2] + red[il * 2 + 1]) * (1.f / 128.f); }
    __syncthreads();
#pragma unroll
    for (int m = 0; m < 2; ++m)
#pragma unroll
        for (int j = 0; j < 4; ++j) {
            float s = 0.f;
#pragma unroll
            for (int n = 0; n < 4; ++n) { float d = Y[m][n][j] - mu[m][j]; s += d * d; }
            s += __shfl_xor(s, 1); s += __shfl_xor(s, 2); s += __shfl_xor(s, 4); s += __shfl_xor(s, 8);
            if (fr == 0) red[(wr * 32 + m * 16 + fq * 4 + j) * 2 + wc] = s;
        }
    __syncthreads();
#pragma unroll
    for (int m = 0; m < 2; ++m)
#pragma unroll
        for (int j = 0; j < 4; ++j) { int il = wr * 32 + m * 16 + fq * 4 + j; rs[m][j] = rsqrtf((red[il * 2] + red[il * 2 + 1]) * (1.f / 128.f) + 1e-6f); }
    const float* gn = p.ret_gn + layer * 512 + h * 128;
#pragma unroll
    for (int m = 0; m < 2; ++m)
#pragma unroll
        for (int n = 0; n < 4; ++n)
#pragma unroll
            for (int j = 0; j < 4; ++j) {
                int i = ih * 64 + wr * 32 + m * 16 + fq * 4 + j, e = wc * 64 + n * 16 + fr;
                long row = (long)c * 128 + i;
                float g = bf2f(p.px[row * INC + C_GR + h * 128 + e]);
                float o = (Y[m][n][j] - mu[m][j]) * rs[m][j] * gn[e] * siluf_(g);
                p.ya[row * 512 + h * 128 + e] = f2bf(o);
            }
    __syncthreads();
}

DI void phF_tile(const Params& p, int mt, int nt, char* smem) {
    const int tid = TIDX(), lane = tid & 63, wid = tid >> 6, wr = wid >> 1, wc = wid & 1, fr = lane & 15, fq = lane >> 4;
    f32x4 msum[4][4]; zero_acc<4>(msum);
    const int r0 = tid >> 2, ko = (tid & 3) * 8;
#pragma unroll 1
    for (int b = 0; b < 3; ++b) {
        const u16* y = (b == 0 ? p.ya : b == 1 ? p.yb : p.yc);
        const u16* w = (b == 0 ? p.wt_ret : b == 1 ? p.wt_win : p.wt_na);
        f32x4 acc[4][4]; zero_acc<4>(acc);
        const u16* a0 = y + (long)(mt * 128 + r0) * 512 + ko;
        const u16* b0 = w + (long)(nt * 128 + r0) * 512 + ko;
        gemm_core<16>(acc, a0, a0 + 64 * 512, b0, b0 + 64 * 512, smem);
#pragma unroll
        for (int m = 0; m < 4; ++m)
#pragma unroll
            for (int n = 0; n < 4; ++n)
#pragma unroll
                for (int j = 0; j < 4; ++j) {
                    int row = mt * 128 + wr * 64 + m * 16 + fq * 4 + j, col = nt * 128 + wc * 64 + n * 16 + fr;
                    float g = bf2f(p.px[(long)row * INC + C_GATE + b * 1024 + col]);
                    msum[m][n][j] += acc[m][n][j] * sigmoidf_(g);
                }
    }
#pragma unroll
    for (int m = 0; m < 4; ++m)
#pragma unroll
        for (int n = 0; n < 4; ++n)
#pragma unroll
            for (int j = 0; j < 4; ++j) {
                int row = mt * 128 + wr * 64 + m * 16 + fq * 4 + j, col = nt * 128 + wc * 64 + n * 16 + fr;
                p.hx[(long)row * DM + col] = f2bf(msum[m][n][j]);
            }
}
DI void phG_tile(const Params& p, int layer, int mt, int nt, char* smem) {
    const int tid = TIDX(), lane = tid & 63, wid = tid >> 6, wr = wid >> 1, wc = wid & 1, fr = lane & 15, fq = lane >> 4;
    f32x4 acc[4][4]; zero_acc<4>(acc);
    const int r0 = tid >> 2, ko = (tid & 3) * 8;
    const u16* a0 = p.hx + (long)(mt * 128 + r0) * DM + ko;
    const u16* b0 = p.wt_out + (long)(nt * 128 + r0) * DM + ko;
    gemm_core<32>(acc, a0, a0 + 64 * DM, b0, b0 + 64 * DM, smem);
    const bool lat = mt < 128;
    const float* md = p.mod + (layer * 2 + (lat ? 0 : 1)) * 6144 + 2 * 1024;
#pragma unroll
    for (int m = 0; m < 4; ++m)
#pragma unroll
        for (int n = 0; n < 4; ++n)
#pragma unroll
            for (int j = 0; j < 4; ++j) {
                int row = mt * 128 + wr * 64 + m * 16 + fq * 4 + j, col = nt * 128 + wc * 64 + n * 16 + fr;
                const float* xin = resid_row(p, layer, row);
                float* xo = lat ? p.out + (long)row * DM : p.ctxres + (long)(row - NLAT) * DM;
                xo[col] = xin[col] + md[col] * acc[m][n][j];
            }
}

DI void phH_item(const Params& p, int layer, int item, char* smem) {
    const int lane = TIDX() & 63, wid = TIDX() >> 6;
    float* hrow = (float*)smem + wid * 2048;
    const int row0 = item * 8 + wid * 2;
    norm_row(p, layer, row0, cur_row(p, row0), p.g_ffn + layer * DM, 3, 4, p.hx + (long)row0 * DM, hrow);
    norm_row(p, layer, row0 + 1, cur_row(p, row0 + 1), p.g_ffn + layer * DM, 3, 4, p.hx + (long)(row0 + 1) * DM, hrow + 1024);
    const int e = lane & 15, kp = lane >> 4;
    const float* wr_ = p.w_router + (long)layer * 1024 * 16 + e;
    float l0 = 0.f, l1 = 0.f;
#pragma unroll 8
    for (int k = kp * 256; k < kp * 256 + 256; ++k) {
        float w = wr_[k * 16];
        l0 += hrow[k] * w; l1 += hrow[1024 + k] * w;
    }
    l0 += __shfl_xor(l0, 16); l0 += __shfl_xor(l0, 32);
    l1 += __shfl_xor(l1, 16); l1 += __shfl_xor(l1, 32);
#pragma unroll
    for (int r = 0; r < 2; ++r) {
        float lg = r == 0 ? l0 : l1;
        float mx = lg;
        mx = fmaxf(mx, __shfl_xor(mx, 1)); mx = fmaxf(mx, __shfl_xor(mx, 2)); mx = fmaxf(mx, __shfl_xor(mx, 4)); mx = fmaxf(mx, __shfl_xor(mx, 8));
        float ex = expf(lg - mx);
        float sm = ex;
        sm += __shfl_xor(sm, 1); sm += __shfl_xor(sm, 2); sm += __shfl_xor(sm, 4); sm += __shfl_xor(sm, 8);
        float a = ex / sm;
        int row = row0 + r;
        if (lane < 16) {
            if (row < NLAT) p.aff[(long)e * NLAT + row] = a;
            else p.aff[(long)(16 + e) * NLAT + (row - NLAT)] = a;
        }
    }
    __syncthreads();
}

DI int block_excl_scan(int v, int* sh  , int& total) {
    const int lane = TIDX() & 63, wid = TIDX() >> 6;
    int inc = v;
    for (int o = 1; o < 64; o <<= 1) { int t = __shfl_up(inc, o); if (lane >= o) inc += t; }
    __syncthreads();
    if (lane == 63) sh[wid] = inc;
    __syncthreads();
    int base = 0;
    for (int w = 0; w < wid; ++w) base += sh[w];
    total = sh[0] + sh[1] + sh[2] + sh[3];
    return base + inc - v;
}
DI void phI_item(const Params& p, int job, char* smem) {
    const int tid = TIDX();
    const int n = job < 16 ? NLAT : NCTX, cap = job < 16 ? CAP_LAT : CAP_CTX, rowbase = job < 16 ? 0 : NLAT;
    unsigned* keys = (unsigned*)smem;
    int* hist = (int*)(smem + 66560);
    int* sh = hist + 256;
    const float* a = p.aff + (long)job * NLAT;
    __syncthreads();
    for (int i = tid; i < n; i += 256) keys[i + (i >> 6)] = __float_as_uint(a[i]);
    unsigned prefix = 0, mask = 0; int remaining = cap;
    for (int pass = 0; pass < 4; ++pass) {
        const int shift = 24 - 8 * pass;
        hist[tid] = 0;
        __syncthreads();
        for (int i = tid; i < n; i += 256) {
            unsigned k = keys[i + (i >> 6)];
            if ((k & mask) == prefix) atomicAdd(&hist[(k >> shift) & 255], 1);
        }
        __syncthreads();
        if (tid == 0) {
            int cum = 0, b = 255;
            for (; b > 0; --b) { if (cum + hist[b] >= remaining) break; cum += hist[b]; }
            sh[8] = b; sh[9] = remaining - cum;
        }
        __syncthreads();
        prefix |= ((unsigned)sh[8]) << shift; mask |= 255u << shift; remaining = sh[9];
        __syncthreads();
    }
    const unsigned T = prefix;
    const int per = n / 256;
    int ceq = 0;
    for (int i = 0; i < per; ++i) { int idx = tid * per + i; ceq += (keys[idx + (idx >> 6)] == T); }
    int tot;
    int eqb = block_excl_scan(ceq, sh, tot);
    int csel = 0, er = eqb;
    for (int i = 0; i < per; ++i) {
        int idx = tid * per + i; unsigned k = keys[idx + (idx >> 6)];
        if (k > T) ++csel; else if (k == T) { if (er < remaining) ++csel; ++er; }
    }
    int slot = block_excl_scan(csel, sh, tot);
    er = eqb;
    for (int i = 0; i < per; ++i) {
        int idx = tid * per + i; unsigned k = keys[idx + (idx >> 6)];
        bool s = false;
        if (k > T) s = true; else if (k == T) { s = er < remaining; ++er; }
        if (s) { p.sel_idx[job * 2048 + slot] = rowbase + idx; p.sel_gate[job * 2048 + slot] = __uint_as_float(k); ++slot; }
    }
    __syncthreads();
}

DI void phJ_tile(const Params& p, int job, int mt, int nt, char* smem) {
    const int tid = TIDX(), lane = tid & 63, wid = tid >> 6, wr = wid >> 1, wc = wid & 1, fr = lane & 15, fq = lane >> 4;
    const int cap = job < 16 ? CAP_LAT : CAP_CTX, e = job & 15;
    f32x4 acc[4][4]; zero_acc<4>(acc);
    const int r0 = tid >> 2, ko = (tid & 3) * 8;
    int s0 = mt * 128 + r0, s1 = s0 + 64;
    s0 = s0 < cap ? s0 : cap - 1; s1 = s1 < cap ? s1 : cap - 1;
    const u16* a0 = p.hx + (long)p.sel_idx[job * 2048 + s0] * DM + ko;
    const u16* a1 = p.hx + (long)p.sel_idx[job * 2048 + s1] * DM + ko;
    const u16* b0 = p.wt_gu + ((long)e * 2048 + nt * 128 + r0) * DM + ko;
    gemm_core<32>(acc, a0, a1, b0, b0 + 64 * DM, smem);
    u16* hb = job < 16 ? p.hid + (long)job * 2048 * EH : p.hidc + (long)(job - 16) * 32 * EH;
#pragma unroll
    for (int m = 0; m < 4; ++m)
#pragma unroll
        for (int n = 0; n < 2; ++n)
#pragma unroll
            for (int j = 0; j < 4; ++j) {
                int slot = mt * 128 + wr * 64 + m * 16 + fq * 4 + j;
                int f = nt * 64 + wc * 32 + n * 16 + fr;
                if (slot < cap) hb[(long)slot * EH + f] = f2bf(siluf_(acc[m][n][j]) * acc[m][n + 2][j]);
            }
}
DI void phK_tile(const Params& p, int layer, int job, int mt, int nt, char* smem) {
    const int tid = TIDX(), lane = tid & 63, wid = tid >> 6, wr = wid >> 1, wc = wid & 1, fr = lane & 15, fq = lane >> 4;
    const int cap = job < 16 ? CAP_LAT : CAP_CTX, e = job & 15;
    f32x4 acc[4][4]; zero_acc<4>(acc);
    const int r0 = tid >> 2, ko = (tid & 3) * 8;
    int s0 = mt * 128 + r0, s1 = s0 + 64;
    s0 = s0 < cap ? s0 : cap - 1; s1 = s1 < cap ? s1 : cap - 1;
    const u16* hb = job < 16 ? p.hid + (long)job * 2048 * EH : p.hidc + (long)(job - 16) * 32 * EH;
    const u16* a0 = hb + (long)s0 * EH + ko;
    const u16* a1 = hb + (long)s1 * EH + ko;
    const u16* b0 = p.wt_dn + ((long)e * 1024 + nt * 128 + r0) * EH + ko;
    gemm_core<32>(acc, a0, a1, b0, b0 + 64 * EH, smem);
    const float* md = p.mod + (layer * 2 + (job < 16 ? 0 : 1)) * 6144 + 5 * 1024;
#pragma unroll
    for (int m = 0; m < 4; ++m)
#pragma unroll
        for (int j = 0; j < 4; ++j) {
            int slot = mt * 128 + wr * 64 + m * 16 + fq * 4 + j;
            if (slot < cap) {
                int row = p.sel_idx[job * 2048 + slot];
                float g = p.sel_gate[job * 2048 + slot];
                float* xo = row < NLAT ? p.out + (long)row * DM : p.ctxres + (long)(row - NLAT) * DM;
#pragma unroll
                for (int n = 0; n < 4; ++n) {
                    int col = nt * 128 + wc * 64 + n * 16 + fr;
                    unsafeAtomicAdd(xo + col, acc[m][n][j] * g * md[col]);
                }
            }
        }
}

DI void run_phase(const Params& p, int ph, char* smem) {
    const int bid = BIDX(), nb = gridDim.x, tid = TIDX(), wid = tid >> 6;
#ifndef ONLY_SUB
    if (ph == 0) {
        const int total = 192 + 48 + CONV_TILES;
        for (int it = bid; it < total; it += nb) {
            if (it < 192) ph0_gemv_item(p, it, smem);
            else if (it < 240) ph0_rope_item(p, it - 192);
            else convert_tile(p, 0, it - 240, smem);
        }
        return;
    }
    if (ph == NPHASE - 1) {
        for (int it = bid; it < NLAT / 4; it += nb) {
            int row = it * 4 + wid, lane = tid & 63;
            float* xr = p.out + (long)row * DM;
            float4 v[4]; float ss = 0.f;
#pragma unroll
            for (int i = 0; i < 4; ++i) { v[i] = *(const float4*)(xr + i * 256 + lane * 4); ss += v[i].x * v[i].x + v[i].y * v[i].y + v[i].z * v[i].z + v[i].w * v[i].w; }
            ss = wave_sum(ss);
            float rstd = rsqrtf(ss * (1.f / DM) + 1e-6f);
#pragma unroll
            for (int i = 0; i < 4; ++i) {
                float4 g = *(const float4*)(p.g_final + i * 256 + lane * 4);
                *(float4*)(xr + i * 256 + lane * 4) = make_float4(v[i].x * rstd * g.x, v[i].y * rstd * g.y, v[i].z * rstd * g.z, v[i].w * rstd * g.w);
            }
        }
        return;
    }
    const int layer = (ph - 1) / 11, sub = (ph - 1) % 11;
#else
    const int layer = (ph - 1) / 11, sub = ONLY_SUB;
#endif
    const bool need_ctx = layer == 0;
    switch (sub) {
    case 0: {
        const int nrow_items = NROWS / 4;
        const int total = nrow_items + (layer == 1 ? CONV_TILES : 0);
        for (int it = bid; it < total; it += nb) {
            if (it < nrow_items) { int row = it * 4 + wid; norm_row(p, layer, row, resid_row(p, layer, row), p.g_mix + layer * DM, 0, 1, p.hx + (long)row * DM, nullptr); }
            else convert_tile(p, layer, it - nrow_items, smem);
        }
    } break;
    case 1: {
        const int total = 130 * 58;
        for (int it = bid; it < total; it += nb) {
            int g = it / (8 * 58), local = it - g * 8 * 58;
            int gsz = (130 - g * 8) < 8 ? (130 - g * 8) : 8;
            int nt = local / gsz, mt = g * 8 + local % gsz;
            phB_tile(p, mt, nt, smem);
        }
    } break;
    case 2: {
        const int n_state = NCHUNK * 8, n_win = 512, n_na = 512, n_cx = need_ctx ? 16 : 0;
        const int total = n_state + n_win + n_na + n_cx;
        for (int it = bid; it < total; it += nb) {
            if (it < n_win) attn_wave_item(p, layer, 0, it >> 1, (it & 1) * 4 + wid, smem);
            else if (it < n_win + n_na) { int i2 = it - n_win; attn_wave_item(p, layer, 1, i2 >> 1, (i2 & 1) * 4 + wid, smem); }
            else if (it < n_win + n_na + n_state) { int i2 = it - n_win - n_na; phC_state_item(p, layer, i2 >> 3, (i2 >> 1) & 3, i2 & 1, smem); }
            else { int i2 = it - n_win - n_na - n_state; int kind = 2 + (i2 >> 3); i2 &= 7; attn_wave_item(p, layer, kind, i2 >> 1, (i2 & 1) * 4 + wid, smem); }
        }
    } break;
    case 3: {
        for (int it = bid; it < 512; it += nb) phD_item(p, layer, it);
    } break;
    case 4: {
        const int nch = need_ctx ? NCHUNK : 128;
        for (int it = bid; it < nch * 8; it += nb) phE_item(p, layer, it >> 3, (it >> 1) & 3, it & 1, smem);
    } break;
    case 5: {
        const int nmt = need_ctx ? 130 : 128;
        for (int it = bid; it < nmt * 8; it += nb) phF_tile(p, it >> 3, it & 7, smem);
    } break;
    case 6: {
        const int nmt = need_ctx ? 130 : 128;
        for (int it = bid; it < nmt * 8; it += nb) phG_tile(p, layer, it >> 3, it & 7, smem);
    } break;
    case 7: {
        const int nit = (need_ctx ? NROWS : NLAT) / 8;
        for (int it = bid; it < nit; it += nb) phH_item(p, layer, it, smem);
    } break;
    case 8: {
        const int njob = need_ctx ? 32 : 16;
        for (int it = bid; it < njob; it += nb) phI_item(p, it, smem);
    } break;
    case 9: {
        const int total = 4096 + (need_ctx ? 256 : 0);
        for (int it = bid; it < total; it += nb) {
            if (it < 4096) phJ_tile(p, it >> 8, (it >> 4) & 15, it & 15, smem);
            else { int i2 = it - 4096; phJ_tile(p, 16 + (i2 >> 4), 0, i2 & 15, smem); }
        }
    } break;
    case 10: {
        const int total = 2048 + (need_ctx ? 128 : 0);
        for (int it = bid; it < total; it += nb) {
            if (it < 2048) phK_tile(p, layer, it >> 7, (it >> 3) & 15, it & 7, smem);
            else { int i2 = it - 2048; phK_tile(p, layer, 16 + (i2 >> 3), 0, i2 & 7, smem); }
        }
    } break;
    }
}

__global__ void __launch_bounds__(NTHREADS, 2) mega_kernel(Params p, int ph_lo, int ph_hi) {
    __shared__ __attribute__((aligned(16))) char smem[LDS_BYTES];
    cg::grid_group grid = cg::this_grid();
    for (int ph = ph_lo; ph < ph_hi; ++ph) {
        if (ph > ph_lo) grid.sync();
        run_phase(p, ph, smem);
    }
}

extern "C" void kernel_launch(void* const* d_in, const int* in_sizes, int n_in, void* d_out, int out_size, void* d_ws, size_t ws_size,
                              hipStream_t stream) {
    static int grid_blocks = 0;
    if (!grid_blocks) {
        int dev = 0, cus = 0, per_cu = 0;
        hipGetDevice(&dev);
        hipDeviceGetAttribute(&cus, hipDeviceAttributeMultiprocessorCount, dev);
        hipOccupancyMaxActiveBlocksPerMultiprocessor(&per_cu, mega_kernel, NTHREADS, 0);
        if (per_cu < 1) per_cu = 1;
        if (per_cu > 2) per_cu = 2;
        grid_blocks = cus * per_cu;
    }
    Params p{};
    const float** ip = (const float**)&p.x;
    for (int i = 0; i < 22; ++i) ip[i] = (const float*)d_in[i];
    p.out = (float*)d_out;
    char* w = (char*)d_ws;
    size_t off = 0;
    auto take = [&](size_t bytes) { char* r = w + off; off += (bytes + 255) & ~(size_t)255; return r; };
    p.ctxres = (float*)take((size_t)NCTX * DM * 4);
    p.mod = (float*)take(2 * 2 * 6144 * 4);
    p.rope128 = (float2*)take(256 * 32 * 8);
    p.rope64 = (float2*)take(256 * 16 * 8);
    p.wt_in = (u16*)take((size_t)INC * DM * 2);
    p.wt_ret = (u16*)take((size_t)1024 * 512 * 2);
    p.wt_win = (u16*)take((size_t)1024 * 512 * 2);
    p.wt_na = (u16*)take((size_t)1024 * 512 * 2);
    p.wt_out = (u16*)take((size_t)1024 * 1024 * 2);
    p.wt_gu = (u16*)take((size_t)NEXP * 2048 * 1024 * 2);
    p.wt_dn = (u16*)take((size_t)NEXP * 1024 * 1024 * 2);
    p.hx = (u16*)take((size_t)NROWS * DM * 2);
    p.px = (u16*)take((size_t)NROWS * INC * 2);
    p.hid = p.px;
    p.hidc = p.px + (size_t)NEXP * 2048 * 1024;
    p.ya = (u16*)take((size_t)NROWS * 512 * 2);
    p.yb = (u16*)take((size_t)NROWS * 512 * 2);
    p.yc = (u16*)take((size_t)NROWS * 512 * 2);
    p.S = (float*)take((size_t)NCHUNK * 8 * 16384 * 4);
    p.R = (u16*)take((size_t)NCHUNK * 8 * 16384 * 2);
    p.aff = (float*)take((size_t)32 * NLAT * 4);
    p.sel_idx = (int*)take(32 * 2048 * 4);
    p.sel_gate = (float*)take(32 * 2048 * 4);
    if (off > ws_size) { fprintf(stderr, "kernel_launch: workspace too small: need %zu have %zu\n", off, ws_size); return; }
#if MK_MULTI
    for (int ph = 0; ph < NPHASE; ++ph) {
        hipLaunchKernelGGL(mega_kernel, dim3(grid_blocks), dim3(NTHREADS), 0, stream, p, ph, ph + 1);
    }
#else
    int lo = 0, hi = NPHASE;
    void* args[] = {&p, &lo, &hi};
    hipError_t e = hipLaunchCooperativeKernel((void*)mega_kernel, dim3(grid_blocks), dim3(NTHREADS), args, 0, stream);
    if (e != hipSuccess) fprintf(stderr, "cooperative launch failed: %s (grid %d)\n", hipGetErrorString(e), grid_blocks);
#endif
}
```

```cpp
#include <hip/hip_runtime.h>
#include <hip/hip_bf16.h>
#include <hip/hip_cooperative_groups.h>
#include <cstdio>
#include <cstdint>
namespace cg = cooperative_groups;

#ifndef MK_MULTI
#define MK_MULTI 0
#endif

#define DI __device__ __forceinline__
typedef unsigned short u16;
typedef __attribute__((ext_vector_type(8))) short bf16x8;
typedef __attribute__((ext_vector_type(4))) float f32x4;
typedef __attribute__((ext_vector_type(4))) unsigned int u32x4;

constexpr int NLAT = 16384, NCTX = 256, NROWS = NLAT + NCTX, DM = 1024, INC = 7424;
constexpr int C_QR = 0, C_KR = 512, C_VR = 1024, C_GR = 1536, C_QW = 2048, C_KW = 2560, C_VW = 2688, C_QN = 2816, C_KN = 3328, C_VN = 3840, C_GATE = 4352;
constexpr int NCHUNK = NROWS / 128;
constexpr int NEXP = 16, EH = 1024, CAP_LAT = 2048, CAP_CTX = 32;
constexpr int NTHREADS = 256;
constexpr int LDS_BYTES = 72 * 1024;
constexpr int NPHASE = 24;

struct Params {
    const float *x, *c, *ctx, *c_ctx, *w_mod, *b_mod, *g_mix, *g_ffn, *w_in, *decay, *ret_gn, *w_ret, *sink, *w_win, *rpb, *w_na, *w_out,
        *w_router, *w_eg, *w_eu, *w_ed, *g_final;
    float* out;
    float* ctxres;
    float* mod;
    float2* rope128;
    float2* rope64;
    u16 *wt_in, *wt_ret, *wt_win, *wt_na, *wt_out, *wt_gu, *wt_dn;
    u16* hx;
    u16* px;
    u16 *ya, *yb, *yc;
    float* S;
    u16* R;
    float* aff;
    int* sel_idx;
    float* sel_gate;
    u16* hid;
    u16* hidc;
};

DI int TIDX() { int t = threadIdx.x; asm volatile("" : "+v"(t)); return t; }
DI int BIDX() { int t = blockIdx.x; asm volatile("" : "+s"(t)); return t; }
DI u16 f2bf(float x) { unsigned u = __float_as_uint(x); u += 0x7fffu + ((u >> 16) & 1u); return (u16)(u >> 16); }
DI float bf2f(u16 h) { return __uint_as_float(((unsigned)h) << 16); }
DI float bflo(unsigned w) { return __uint_as_float(w << 16); }
DI float bfhi(unsigned w) { return __uint_as_float(w & 0xffff0000u); }
DI unsigned pack2(float a, float b) { return (unsigned)f2bf(a) | ((unsigned)f2bf(b) << 16); }
DI float sigmoidf_(float x) { return 1.f / (1.f + __expf(-x)); }
DI float siluf_(float x) { return x / (1.f + __expf(-x)); }
DI float wave_sum(float v) { for (int o = 32; o > 0; o >>= 1) v += __shfl_xor(v, o); return v; }
#define MFMA16(a, b, c) __builtin_amdgcn_mfma_f32_16x16x32_bf16((a), (b), (c), 0, 0, 0)

template <int MR>
DI void zero_acc(f32x4 (&acc)[MR][4]) {
#pragma unroll
    for (int m = 0; m < MR; ++m)
#pragma unroll
        for (int n = 0; n < 4; ++n) acc[m][n] = f32x4{0.f, 0.f, 0.f, 0.f};
}

template <int KT>
DI void gemm_core(f32x4 (&acc)[4][4], const u16* a0, const u16* a1, const u16* b0, const u16* b1, char* smem) {
    const int tid = TIDX(), lane = tid & 63, wid = tid >> 6, wr = wid >> 1, wc = wid & 1, fr = lane & 15, fq = lane >> 4;
    auto stage = [&](int kt, int buf) {
        char* base = smem + buf * 16384;
        __builtin_amdgcn_global_load_lds((const unsigned*)(a0 + kt * 32), (unsigned*)(base + tid * 16), 16, 0, 0);
        __builtin_amdgcn_global_load_lds((const unsigned*)(a1 + kt * 32), (unsigned*)(base + 4096 + tid * 16), 16, 0, 0);
        __builtin_amdgcn_global_load_lds((const unsigned*)(b0 + kt * 32), (unsigned*)(base + 8192 + tid * 16), 16, 0, 0);
        __builtin_amdgcn_global_load_lds((const unsigned*)(b1 + kt * 32), (unsigned*)(base + 12288 + tid * 16), 16, 0, 0);
    };
    __syncthreads();
    stage(0, 0);
    for (int kt = 0; kt < KT; ++kt) {
        asm volatile("s_waitcnt vmcnt(0)" ::: "memory");
        __syncthreads();
        if (kt + 1 < KT) stage(kt + 1, (kt + 1) & 1);
        const char* SA = smem + (kt & 1) * 16384;
        const char* SB = SA + 8192;
        bf16x8 At[4], Bt[4];
#pragma unroll
        for (int m = 0; m < 4; ++m) At[m] = *(const bf16x8*)(SA + (wr * 64 + m * 16 + fr) * 64 + fq * 16);
#pragma unroll
        for (int n = 0; n < 4; ++n) Bt[n] = *(const bf16x8*)(SB + (wc * 64 + n * 16 + fr) * 64 + fq * 16);
#pragma unroll
        for (int m = 0; m < 4; ++m)
#pragma unroll
            for (int n = 0; n < 4; ++n) acc[m][n] = MFMA16(At[m], Bt[n], acc[m][n]);
    }
}

template <int MR>
DI void mma_lds64(f32x4 (&acc)[MR][4], const u16* As, int lda, const u16* Bs, int ldb) {
    const int tid = TIDX(), lane = tid & 63, wid = tid >> 6, wr = wid >> 1, wc = wid & 1, fr = lane & 15, fq = lane >> 4;
#pragma unroll
    for (int kk = 0; kk < 2; ++kk) {
        bf16x8 At[MR], Bt[4];
#pragma unroll
        for (int m = 0; m < MR; ++m) At[m] = *(const bf16x8*)(As + (wr * (MR * 16) + m * 16 + fr) * lda + kk * 32 + fq * 8);
#pragma unroll
        for (int n = 0; n < 4; ++n) Bt[n] = *(const bf16x8*)(Bs + (wc * 64 + n * 16 + fr) * ldb + kk * 32 + fq * 8);
#pragma unroll
        for (int m = 0; m < MR; ++m)
#pragma unroll
            for (int n = 0; n < 4; ++n) acc[m][n] = MFMA16(At[m], Bt[n], acc[m][n]);
    }
}
template <int ROWS>
DI void stage_n64(u16* dst, int ld, const u16* src, long sstride) {
    const int tid = TIDX();
#pragma unroll
    for (int i = 0; i < ROWS / 32; ++i) {
        int idx = i * 256 + tid, row = idx >> 3, ch = idx & 7;
        u32x4 v = *(const u32x4*)(src + (long)row * sstride + ch * 8);
        *(u32x4*)(dst + row * ld + ch * 8) = v;
    }
}
template <bool SCALE, int NF>
DI void stage_t64(u16* dst, int ld, const u16* src, long sstride, float scale_tok_lane  ) {
    const int tid = TIDX();
#pragma unroll
    for (int i = 0; i < NF / 32; ++i) {
        int idx = i * 256 + tid, jj = idx & 63, ch = idx >> 6;
        u32x4 v = *(const u32x4*)(src + (long)jj * sstride + ch * 8);
#pragma unroll
        for (int e = 0; e < 4; ++e) {
            float lo = bflo(v[e]), hi = bfhi(v[e]);
            if (SCALE) { lo *= scale_tok_lane; hi *= scale_tok_lane; }
            dst[(ch * 8 + 2 * e) * ld + jj] = SCALE ? f2bf(lo) : (u16)(v[e] & 0xffffu);
            dst[(ch * 8 + 2 * e + 1) * ld + jj] = SCALE ? f2bf(hi) : (u16)(v[e] >> 16);
        }
    }
}

DI void convert_tile(const Params& p, int layer, int tile, char* smem);

DI void ph0_gemv_item(const Params& p, int item, char* smem) {
    const int tid = TIDX();
    const int l = item / 96, cg_ = item % 96;
    float* sl = (float*)smem;
    float* red = (float*)(smem + 8192);
    __syncthreads();
    for (int k = tid; k < 1024; k += 256) { sl[k] = siluf_(p.c[k]); sl[1024 + k] = siluf_(p.c_ctx[k]); }
    __syncthreads();
    const int c4 = tid & 15, kp = tid >> 4;
    const int col = cg_ * 64 + c4 * 4;
    const float* w = p.w_mod + (long)l * 1024 * 6144 + col;
    float a0[4] = {0, 0, 0, 0}, a1[4] = {0, 0, 0, 0};
#pragma unroll 8
    for (int kk = 0; kk < 64; ++kk) {
        int k = kp * 64 + kk;
        float4 wv = *(const float4*)(w + (long)k * 6144);
        float s0 = sl[k], s1 = sl[1024 + k];
        a0[0] += s0 * wv.x; a0[1] += s0 * wv.y; a0[2] += s0 * wv.z; a0[3] += s0 * wv.w;
        a1[0] += s1 * wv.x; a1[1] += s1 * wv.y; a1[2] += s1 * wv.z; a1[3] += s1 * wv.w;
    }
#pragma unroll
    for (int j = 0; j < 4; ++j) { red[(kp * 2 + 0) * 64 + c4 * 4 + j] = a0[j]; red[(kp * 2 + 1) * 64 + c4 * 4 + j] = a1[j]; }
    __syncthreads();
    if (tid < 128) {
        int src = tid >> 6, cr = tid & 63;
        float s = 0.f;
        for (int q = 0; q < 16; ++q) s += red[(q * 2 + src) * 64 + cr];
        int n = cg_ * 64 + cr;
        p.mod[(l * 2 + src) * 6144 + n] = s + p.b_mod[l * 6144 + n];
    }
}
DI void sincos_d(double a, float& c, float& s) {
    const double TWO_PI = 6.283185307179586476925286766559;
    double k = rint(a / TWO_PI);
    double r = a - k * TWO_PI;
    double r2 = r * r;
    double ts = r, tc = 1.0, ss = r, cc = 1.0;
    for (int i = 1; i <= 14; ++i) {
        tc = -tc * r2 / (double)((2 * i - 1) * (2 * i));
        ts = -ts * r2 / (double)((2 * i) * (2 * i + 1));
        cc += tc; ss += ts;
    }
    c = (float)cc; s = (float)ss;
}
DI void ph0_rope_item(const Params& p, int item) {
    int idx = item * 256 + TIDX();
    const double LN_BASE = 9.210340371976184;
    if (idx < 8192) {
        int pos = idx >> 5, f = idx & 31;
        float inv = (float)exp(-(double)f / 32.0 * LN_BASE);
        float ang = (float)pos * inv;
        float c, s; sincos_d((double)ang, c, s);
        p.rope128[idx] = make_float2(c, s);
    } else {
        int i2 = idx - 8192;
        int pos = i2 >> 4, f = i2 & 15;
        float inv = (float)exp(-(double)f / 16.0 * LN_BASE);
        float ang = (float)pos * inv;
        float c, s; sincos_d((double)ang, c, s);
        p.rope64[i2] = make_float2(c, s);
    }
}

constexpr int CONV_TILES = 1856 + 384 + 256 + 12288;
DI void convert_tile(const Params& p, int layer, int tile, char* smem) {
    const int tid = TIDX();
    const float* src; u16* dst; int K, N, mode = 0;
    if (tile < 1856) { src = p.w_in + (long)layer * 1024 * INC; dst = p.wt_in; K = 1024; N = INC; mode = 1; }
    else if (tile < 1856 + 384) {
        int t = tile - 1856, which = t / 128; tile = t % 128; K = 512; N = 1024;
        src = (which == 0 ? p.w_ret : which == 1 ? p.w_win : p.w_na) + (long)layer * 512 * 1024;
        dst = (which == 0 ? p.wt_ret : which == 1 ? p.wt_win : p.wt_na);
    } else if (tile < 1856 + 384 + 256) { tile -= 1856 + 384; src = p.w_out + (long)layer * 1024 * 1024; dst = p.wt_out; K = 1024; N = 1024; }
    else {
        int t = tile - (1856 + 384 + 256), which = t / 4096, e = (t % 4096) / 256; tile = t % 256; K = 1024; N = 1024;
        long eo = ((long)layer * NEXP + e) * 1024 * 1024;
        if (which == 0) { src = p.w_eg + eo; dst = p.wt_gu + (long)e * 2048 * 1024; mode = 2; }
        else if (which == 1) { src = p.w_eu + eo; dst = p.wt_gu + (long)e * 2048 * 1024; mode = 3; }
        else { src = p.w_ed + eo; dst = p.wt_dn + (long)e * 1024 * 1024; }
    }
    const int ntn = N / 64;
    const int k0 = (tile / ntn) * 64, n0 = (tile % ntn) * 64;
    float* T = (float*)smem;
    __syncthreads();
#pragma unroll
    for (int i = 0; i < 4; ++i) {
        int kk = (tid >> 4) + 16 * i, n4 = tid & 15;
        float4 v = *(const float4*)(src + (long)(k0 + kk) * N + n0 + n4 * 4);
        T[kk * 65 + n4 * 4 + 0] = v.x; T[kk * 65 + n4 * 4 + 1] = v.y; T[kk * 65 + n4 * 4 + 2] = v.z; T[kk * 65 + n4 * 4 + 3] = v.w;
    }
    __syncthreads();
#pragma unroll
    for (int i = 0; i < 2; ++i) {
        int nn = (tid >> 3) + 32 * i, k8 = tid & 7;
        u32x4 o;
#pragma unroll
        for (int e = 0; e < 4; ++e) o[e] = pack2(T[(k8 * 8 + 2 * e) * 65 + nn], T[(k8 * 8 + 2 * e + 1) * 65 + nn]);
        int n = n0 + nn, drow = n;
        if (mode == 1) {
            if (n < 1024) { int o_ = n & 127, s_ = (o_ < 32) ? o_ : (o_ < 64) ? o_ + 32 : (o_ < 96) ? o_ - 32 : o_; drow = (n & ~127) + s_; }
        } else if (mode == 2) drow = (n >> 5) * 64 + (n & 31);
        else if (mode == 3) drow = (n >> 5) * 64 + 32 + (n & 31);
        *(u32x4*)(dst + (long)drow * K + k0 + k8 * 8) = o;
    }
}

DI const float* resid_row(const Params& p, int layer, int row) {
    if (row < NLAT) return (layer == 0 ? p.x : p.out) + (long)row * DM;
    return (layer == 0 ? p.ctx : p.ctxres) + (long)(row - NLAT) * DM;
}
DI const float* cur_row(const Params& p, int row) { return row < NLAT ? p.out + (long)row * DM : p.ctxres + (long)(row - NLAT) * DM; }
DI void norm_row(const Params& p, int layer, int row, const float* xr, const float* g, int shift_idx, int scale_idx, u16* dst_row, float* keep  ) {
    const int lane = TIDX() & 63;
    const float* md = p.mod + (layer * 2 + (row < NLAT ? 0 : 1)) * 6144;
    float4 v[4]; float ss = 0.f;
#pragma unroll
    for (int i = 0; i < 4; ++i) { v[i] = *(const float4*)(xr + i * 256 + lane * 4); ss += v[i].x * v[i].x + v[i].y * v[i].y + v[i].z * v[i].z + v[i].w * v[i].w; }
    ss = wave_sum(ss);
    float rstd = rsqrtf(ss * (1.f / DM) + 1e-6f);
#pragma unroll
    for (int i = 0; i < 4; ++i) {
        int c0 = i * 256 + lane * 4;
        float4 gg = *(const float4*)(g + c0), sh = *(const float4*)(md + shift_idx * 1024 + c0), sc = *(const float4*)(md + scale_idx * 1024 + c0);
        float o0 = v[i].x * rstd * gg.x * (1.f + sc.x) + sh.x, o1 = v[i].y * rstd * gg.y * (1.f + sc.y) + sh.y;
        float o2 = v[i].z * rstd * gg.z * (1.f + sc.z) + sh.z, o3 = v[i].w * rstd * gg.w * (1.f + sc.w) + sh.w;
        uint2 pk; pk.x = pack2(o0, o1); pk.y = pack2(o2, o3);
        *(uint2*)(dst_row + c0) = pk;
        if (keep) *(float4*)(keep + c0) = make_float4(o0, o1, o2, o3);
    }
}

DI void phB_tile(const Params& p, int mt, int nt, char* smem) {
    const int tid = TIDX(), lane = tid & 63, wid = tid >> 6, wr = wid >> 1, wc = wid & 1, fr = lane & 15, fq = lane >> 4;
    f32x4 acc[4][4]; zero_acc<4>(acc);
    const int r0 = tid >> 2, ko = (tid & 3) * 8;
    const u16* a0 = p.hx + (long)(mt * 128 + r0) * DM + ko;
    const u16* b0 = p.wt_in + (long)(nt * 128 + r0) * DM + ko;
    gemm_core<32>(acc, a0, a0 + 64 * DM, b0, b0 + 64 * DM, smem);
    const bool lat = mt < 128;
    const int type = (nt < 8) ? 1 : (nt >= 16 && nt < 21) ? 2 : 0;
    if (type != 0 && lat) {
#pragma unroll
        for (int m = 0; m < 4; ++m)
#pragma unroll
            for (int j = 0; j < 4; ++j) {
                int t = mt * 128 + wr * 64 + m * 16 + fq * 4 + j;
                int pr = t >> 6, pc = t & 63;
#pragma unroll
                for (int n = 0; n < 2; ++n) {
                    float2 cs;
                    if (type == 1) { int pos = (wc == 0) ? pr : pc; cs = p.rope128[pos * 32 + n * 16 + fr]; }
                    else { int pos = (n == 0) ? pr : pc; cs = p.rope64[pos * 16 + fr]; }
                    float x1 = acc[m][n][j], x2 = acc[m][n + 2][j];
                    acc[m][n][j] = x1 * cs.x - x2 * cs.y;
                    acc[m][n + 2][j] = x1 * cs.y + x2 * cs.x;
                }
            }
    }
    const float mul = (nt >= 4 && nt < 8) ? 0.08838834764831845f : 1.f;
#pragma unroll
    for (int m = 0; m < 4; ++m)
#pragma unroll
        for (int n = 0; n < 4; ++n)
#pragma unroll
            for (int j = 0; j < 4; ++j) {
                int row = mt * 128 + wr * 64 + m * 16 + fq * 4 + j, col = nt * 128 + wc * 64 + n * 16 + fr;
                p.px[(long)row * INC + col] = f2bf(acc[m][n][j] * mul);
            }
}

struct AttnW {
    float q[64];
    float acc[64];
    float m, l;
};
DI void attn_load_q(AttnW& w, const u16* qrow) {
#pragma unroll
    for (int c = 0; c < 8; ++c) {
        u32x4 v = *(const u32x4*)(qrow + c * 8);
#pragma unroll
        for (int e = 0; e < 4; ++e) { w.q[c * 8 + 2 * e] = bflo(v[e]) * 0.125f; w.q[c * 8 + 2 * e + 1] = bfhi(v[e]) * 0.125f; }
    }
#pragma unroll
    for (int e = 0; e < 64; ++e) w.acc[e] = 0.f;
}
DI void attn_stage(u16* Ks, u16* Vs, const u16* px, int rowstart, int colK, int colV) {
    const int lane = TIDX() & 63;
#pragma unroll
    for (int i = 0; i < 8; ++i) {
        int idx = i * 64 + lane, key = idx >> 3, ch = idx & 7;
        const u16* src = px + (long)(rowstart + key) * INC;
        *(u32x4*)(Ks + key * 64 + ch * 8) = *(const u32x4*)(src + colK + ch * 8);
        *(u32x4*)(Vs + key * 64 + ch * 8) = *(const u32x4*)(src + colV + ch * 8);
    }
}
template <class F>
DI void attn_tile(AttnW& w, const u16* Ks, const u16* Vs, F&& f) {
    for (int j = 0; j < 64; ++j) {
        float s = 0.f;
        const u32x4* kr = (const u32x4*)(Ks + j * 64);
#pragma unroll
        for (int c = 0; c < 8; ++c) {
            u32x4 kk = kr[c];
#pragma unroll
            for (int e = 0; e < 4; ++e) { s += w.q[c * 8 + 2 * e] * bflo(kk[e]); s += w.q[c * 8 + 2 * e + 1] * bfhi(kk[e]); }
        }
        float bias = 0.f;
        bool valid = f(j, bias);
        s += bias;
        float mn = valid ? fmaxf(w.m, s) : w.m;
        float alpha = __expf(w.m - mn);
        float pj = valid ? __expf(s - mn) : 0.f;
        w.l = w.l * alpha + pj; w.m = mn;
        const u32x4* vr = (const u32x4*)(Vs + j * 64);
#pragma unroll
        for (int c = 0; c < 8; ++c) {
            u32x4 vv = vr[c];
#pragma unroll
            for (int e = 0; e < 4; ++e) {
                w.acc[c * 8 + 2 * e] = w.acc[c * 8 + 2 * e] * alpha + pj * bflo(vv[e]);
                w.acc[c * 8 + 2 * e + 1] = w.acc[c * 8 + 2 * e + 1] * alpha + pj * bfhi(vv[e]);
            }
        }
    }
}
DI void attn_store(const AttnW& w, u16* orow) {
    float inv = 1.f / w.l;
#pragma unroll
    for (int c = 0; c < 8; ++c) {
        u32x4 o;
#pragma unroll
        for (int e = 0; e < 4; ++e) o[e] = pack2(w.acc[c * 8 + 2 * e] * inv, w.acc[c * 8 + 2 * e + 1] * inv);
        *(u32x4*)(orow + c * 8) = o;
    }
}
DI void attn_wave_item(const Params& p, int layer, int kind, int blk, int h, char* smem) {
    const int lane = TIDX() & 63, wid = TIDX() >> 6;
    u16* Ks = (u16*)(smem + wid * 18432);
    u16* Vs = Ks + 4096;
    float* rpbs = (float*)(smem + wid * 18432 + 16384);
    AttnW w;
    const bool isna = (kind == 1 || kind == 3);
    const int t = ((kind >= 2) ? NLAT : 0) + blk * 64 + lane;
    const int colQ = isna ? C_QN + h * 64 : C_QW + h * 64;
    const int kvh = isna ? h : (h >> 2);
    const int colK = isna ? C_KN + kvh * 64 : C_KW + kvh * 64;
    const int colV = isna ? C_VN + kvh * 64 : C_VW + kvh * 64;
    attn_load_q(w, p.px + (long)t * INC + colQ);
    if (isna) { w.m = -1e30f; w.l = 0.f; } else { w.m = p.sink[layer * 8 + h]; w.l = 1.f; }
    if (kind == 0) {
        for (int i = 0; i < 5; ++i) {
            int start = blk * 64 - 128 + i * 64;
            if (start < 0 || start >= NLAT) continue;
            attn_stage(Ks, Vs, p.px, start, colK, colV);
            attn_tile(w, Ks, Vs, [&](int j, float& b) { int d = start + j - t; return d >= -128 && d <= 128; });
        }
    } else if (kind == 1) {
        const float* rp = p.rpb + ((long)layer * 8 + h) * 465;
        for (int i = lane; i < 465; i += 64) rpbs[i] = rp[i];
        const int r = blk, cq = lane;
        int sr = r - 4; sr = sr < 0 ? 0 : (sr > 248 ? 248 : sr);
        int cs = cq - 8; cs = cs < 0 ? 0 : (cs > 48 ? 48 : cs);
        for (int i = 0; i < 8; ++i) {
            int krow = sr + i;
            attn_stage(Ks, Vs, p.px, krow * 64, colK, colV);
            const float* rrow = rpbs + (krow - r + 7) * 31;
            attn_tile(w, Ks, Vs, [&](int j, float& b) {
                bool v = (j >= cs) && (j < cs + 16);
                int ci = j - cq + 15; ci = ci < 0 ? 0 : (ci > 30 ? 30 : ci);
                b = v ? rrow[ci] : 0.f;
                return v;
            });
        }
    }
    for (int i = 0; i < 4; ++i) {
        attn_stage(Ks, Vs, p.px, NLAT + i * 64, colK, colV);
        attn_tile(w, Ks, Vs, [&](int j, float& b) { return true; });
    }
    u16* y = isna ? p.yc : p.yb;
    attn_store(w, y + (long)t * 512 + h * 64);
}

DI void ret_gammas(const Params& p, int layer, int h, float& lgf2, float& lgb2) {
    float xf = p.decay[layer * 8 + h], xb = p.decay[layer * 8 + 4 + h];
    lgf2 = -log1pf(expf(-xf)) * 1.4426950408889634f;
    lgb2 = -log1pf(expf(-xb)) * 1.4426950408889634f;
}
DI void phC_state_item(const Params& p, int layer, int c, int h, int eh, char* smem) {
    const int tid = TIDX(), lane = tid & 63, wid = tid >> 6, wr = wid >> 1, wc = wid & 1, fr = lane & 15, fq = lane >> 4;
    u16* Av = (u16*)smem;
    u16* Bf = Av + 64 * 72;
    u16* Bb = Bf + 128 * 72;
    float lgf2, lgb2; ret_gammas(p, layer, h, lgf2, lgb2);
    f32x4 accF[2][4], accB[2][4]; zero_acc<2>(accF); zero_acc<2>(accB);
    const u16* base = p.px + (long)c * 128 * INC;
#pragma unroll 1
    for (int jh = 0; jh < 2; ++jh) {
        const int j = jh * 64 + (tid & 63);
        const float zf = exp2f((float)(127 - j) * lgf2), zb = exp2f((float)j * lgb2);
        __syncthreads();
        stage_t64<false, 64>(Av, 72, base + (long)jh * 64 * INC + C_VR + h * 128 + eh * 64, INC, 1.f);
        stage_t64<true, 128>(Bf, 72, base + (long)jh * 64 * INC + C_KR + h * 128, INC, zf);
        stage_t64<true, 128>(Bb, 72, base + (long)jh * 64 * INC + C_KR + h * 128, INC, zb);
        __syncthreads();
        mma_lds64<2>(accF, Av, 72, Bf, 72);
        mma_lds64<2>(accB, Av, 72, Bb, 72);
    }
    float* Sf = p.S + ((long)(c * 4 + h) * 2 + 0) * 16384;
    float* Sb = Sf + 16384;
#pragma unroll
    for (int m = 0; m < 2; ++m)
#pragma unroll
        for (int n = 0; n < 4; ++n)
#pragma unroll
            for (int j = 0; j < 4; ++j) {
                int e = eh * 64 + wr * 32 + m * 16 + fq * 4 + j, d = wc * 64 + n * 16 + fr;
                Sf[e * 128 + d] = accF[m][n][j];
                Sb[e * 128 + d] = accB[m][n][j];
            }
}

DI void phD_item(const Params& p, int layer, int item) {
    const int h = item >> 7, dir = (item >> 6) & 1, pos = (item & 63) * 256 + TIDX();
    float lgf2, lgb2; ret_gammas(p, layer, h, lgf2, lgb2);
    const float decay = exp2f(128.f * (dir == 0 ? lgf2 : lgb2));
    float r = 0.f;
    const long hs = (long)(h * 2 + dir) * 16384 + pos;
    auto chunk_at = [&](int i) -> int {
        if (dir == 0) return i < 2 ? 128 + i : i - 2;
        return i < 2 ? 129 - i : 129 - i;
    };
    for (int i0 = 0; i0 < NCHUNK; i0 += 13) {
        float s[13];
#pragma unroll
        for (int u = 0; u < 13; ++u) s[u] = p.S[(long)chunk_at(i0 + u) * 8 * 16384 + hs];
#pragma unroll
        for (int u = 0; u < 13; ++u) {
            p.R[(long)chunk_at(i0 + u) * 8 * 16384 + hs] = f2bf(r);
            r = decay * r + s[u];
        }
    }
}

DI void phE_item(const Params& p, int layer, int c, int h, int ih, char* smem) {
    const int tid = TIDX(), lane = tid & 63, wid = tid >> 6, wr = wid >> 1, wc = wid & 1, fr = lane & 15, fq = lane >> 4;
    u16* R0 = (u16*)smem;
    u16* R1 = R0 + 64 * 72;
    u16* R2 = R1 + 128 * 72;
    u16* P = (u16*)smem;
    float* red = (float*)(smem + (64 + 128 + 128) * 72 * 2);
    float lgf2, lgb2; ret_gammas(p, layer, h, lgf2, lgb2);
    const u16* base = p.px + (long)c * 128 * INC;
    const u16* qbase = base + (long)ih * 64 * INC + C_QR + h * 128;
    const u16* Rf = p.R + ((long)(c * 4 + h) * 2 + 0) * 16384;
    const u16* Rb = Rf + 16384;
    f32x4 Y[2][4], T[2][4];
    zero_acc<2>(Y); zero_acc<2>(T);
#pragma unroll 1
    for (int dh = 0; dh < 2; ++dh) {
        __syncthreads();
        stage_n64<64>(R0, 72, qbase + dh * 64, INC);
        stage_n64<128>(R1, 72, Rf + dh * 64, 128);
        stage_n64<128>(R2, 72, Rb + dh * 64, 128);
        __syncthreads();
        mma_lds64<2>(Y, R0, 72, R1, 72);
        mma_lds64<2>(T, R0, 72, R2, 72);
    }
#pragma unroll
    for (int m = 0; m < 2; ++m)
#pragma unroll
        for (int j = 0; j < 4; ++j) {
            int i = ih * 64 + wr * 32 + m * 16 + fq * 4 + j;
            float xf = exp2f((float)(i + 1) * lgf2), xb = exp2f((float)(128 - i) * lgb2);
#pragma unroll
            for (int n = 0; n < 4; ++n) Y[m][n][j] = xf * Y[m][n][j] + xb * T[m][n][j];
        }
    zero_acc<2>(T);
#pragma unroll 1
    for (int dh = 0; dh < 2; ++dh) {
        __syncthreads();
        stage_n64<64>(R0, 72, qbase + dh * 64, INC);
        stage_n64<128>(R1, 72, base + C_KR + h * 128 + dh * 64, INC);
        __syncthreads();
        mma_lds64<2>(T, R0, 72, R1, 72);
    }
    __syncthreads();
#pragma unroll
    for (int m = 0; m < 2; ++m)
#pragma unroll
        for (int n = 0; n < 4; ++n)
#pragma unroll
            for (int j = 0; j < 4; ++j) {
                int il = wr * 32 + m * 16 + fq * 4 + j, i = ih * 64 + il, jj = wc * 64 + n * 16 + fr;
                float dm = (i >= jj) ? exp2f((float)(i - jj) * lgf2) : exp2f((float)(jj - i) * lgb2);
                P[il * 136 + jj] = f2bf(T[m][n][j] * dm);
            }
#pragma unroll 1
    for (int jh = 0; jh < 2; ++jh) {
        __syncthreads();
        stage_t64<false, 128>(R2, 72, base + (long)jh * 64 * INC + C_VR + h * 128, INC, 1.f);
        __syncthreads();
        mma_lds64<2>(Y, P + jh * 64, 136, R2, 72);
    }
    float mu[2][4], rs[2][4];
#pragma unroll
    for (int m = 0; m < 2; ++m)
#pragma unroll
        for (int j = 0; j < 4; ++j) {
            float s = Y[m][0][j] + Y[m][1][j] + Y[m][2][j] + Y[m][3][j];
            s += __shfl_xor(s, 1); s += __shfl_xor(s, 2); s += __shfl_xor(s, 4); s += __shfl_xor(s, 8);
            if (fr == 0) red[(wr * 32 + m * 16 + fq * 4 + j) * 2 + wc] = s;
        }
    __syncthreads();
#pragma unroll
    for (int m = 0; m < 2; ++m)
#pragma unroll
        for (int j = 0; j < 4; ++j) { int il = wr * 32 + m * 16 + fq * 4 + j; mu[m][j] = (red[il * 2] + red[il * 2 + 1]) * (1.f / 128.f); }
    __syncthreads();
#pragma unroll
    for (int m = 0; m < 2; ++m)
#pragma unroll
        for (int j = 0; j < 4; ++j) {
            float s = 0.f;
#pragma unroll
            for (int n = 0; n < 4; ++n) { float d = Y[m][n][j] - mu[m][j]; s += d * d; }
            s += __shfl_xor(s, 1); s += __shfl_xor(s, 2); s += __shfl_xor(s, 4); s += __shfl_xor(s, 8);
            if (fr == 0) red[(wr * 32 + m * 16 + fq * 4 + j) * 2 + wc] = s;
        }
    __syncthreads();
#pragma unroll
    for (int m = 0; m < 2; ++m)
#pragma unroll
        for (int j = 0; j < 4; ++j) { int il = wr * 32 + m * 16 + fq * 4 + j; rs[m][j] = rsqrtf((red[il * 2] + red[il * 2 + 1]) * (1.f / 128.f) + 1e-6f); }
    const float* gn = p.ret_gn + layer * 512 + h * 128;
#pragma unroll
    for (int m = 0; m < 2; ++m)
#pragma unroll
        for (int n = 0; n < 4; ++n)
#pragma unroll
            for (int j = 0; j < 4; ++j) {
                int i = ih * 64 + wr * 32 + m * 16 + fq * 4 + j, e = wc * 64 + n * 16 + fr;
                long row = (long)c * 128 + i;
                float g = bf2f(p.px[row * INC + C_GR + h * 128 + e]);
                float o = (Y[m][n][j] - mu[m][j]) * rs[m][j] * gn[e] * siluf_(g);
                p.ya[row * 512 + h * 128 + e] = f2bf(o);
            }
    __syncthreads();
}

DI void phF_tile(const Params& p, int mt, int nt, char* smem) {
    const int tid = TIDX(), lane = tid & 63, wid = tid >> 6, wr = wid >> 1, wc = wid & 1, fr = lane & 15, fq = lane >> 4;
    f32x4 msum[4][4]; zero_acc<4>(msum);
    const int r0 = tid >> 2, ko = (tid & 3) * 8;
#pragma unroll 1
    for (int b = 0; b < 3; ++b) {
        const u16* y = (b == 0 ? p.ya : b == 1 ? p.yb : p.yc);
        const u16* w = (b == 0 ? p.wt_ret : b == 1 ? p.wt_win : p.wt_na);
        f32x4 acc[4][4]; zero_acc<4>(acc);
        const u16* a0 = y + (long)(mt * 128 + r0) * 512 + ko;
        const u16* b0 = w + (long)(nt * 128 + r0) * 512 + ko;
        gemm_core<16>(acc, a0, a0 + 64 * 512, b0, b0 + 64 * 512, smem);
#pragma unroll
        for (int m = 0; m < 4; ++m)
#pragma unroll
            for (int n = 0; n < 4; ++n)
#pragma unroll
                for (int j = 0; j < 4; ++j) {
                    int row = mt * 128 + wr * 64 + m * 16 + fq * 4 + j, col = nt * 128 + wc * 64 + n * 16 + fr;
                    float g = bf2f(p.px[(long)row * INC + C_GATE + b * 1024 + col]);
                    msum[m][n][j] += acc[m][n][j] * sigmoidf_(g);
                }
    }
#pragma unroll
    for (int m = 0; m < 4; ++m)
#pragma unroll
        for (int n = 0; n < 4; ++n)
#pragma unroll
            for (int j = 0; j < 4; ++j) {
                int row = mt * 128 + wr * 64 + m * 16 + fq * 4 + j, col = nt * 128 + wc * 64 + n * 16 + fr;
                p.hx[(long)row * DM + col] = f2bf(msum[m][n][j]);
            }
}
DI void phG_tile(const Params& p, int layer, int mt, int nt, char* smem) {
    const int tid = TIDX(), lane = tid & 63, wid = tid >> 6, wr = wid >> 1, wc = wid & 1, fr = lane & 15, fq = lane >> 4;
    f32x4 acc[4][4]; zero_acc<4>(acc);
    const int r0 = tid >> 2, ko = (tid & 3) * 8;
    const u16* a0 = p.hx + (long)(mt * 128 + r0) * DM + ko;
    const u16* b0 = p.wt_out + (long)(nt * 128 + r0) * DM + ko;
    gemm_core<32>(acc, a0, a0 + 64 * DM, b0, b0 + 64 * DM, smem);
    const bool lat = mt < 128;
    const float* md = p.mod + (layer * 2 + (lat ? 0 : 1)) * 6144 + 2 * 1024;
#pragma unroll
    for (int m = 0; m < 4; ++m)
#pragma unroll
        for (int n = 0; n < 4; ++n)
#pragma unroll
            for (int j = 0; j < 4; ++j) {
                int row = mt * 128 + wr * 64 + m * 16 + fq * 4 + j, col = nt * 128 + wc * 64 + n * 16 + fr;
                const float* xin = resid_row(p, layer, row);
                float* xo = lat ? p.out + (long)row * DM : p.ctxres + (long)(row - NLAT) * DM;
                xo[col] = xin[col] + md[col] * acc[m][n][j];
            }
}

DI void phH_item(const Params& p, int layer, int item, char* smem) {
    const int lane = TIDX() & 63, wid = TIDX() >> 6;
    float* hrow = (float*)smem + wid * 2048;
    const int row0 = item * 8 + wid * 2;
    norm_row(p, layer, row0, cur_row(p, row0), p.g_ffn + layer * DM, 3, 4, p.hx + (long)row0 * DM, hrow);
    norm_row(p, layer, row0 + 1, cur_row(p, row0 + 1), p.g_ffn + layer * DM, 3, 4, p.hx + (long)(row0 + 1) * DM, hrow + 1024);
    const int e = lane & 15, kp = lane >> 4;
    const float* wr_ = p.w_router + (long)layer * 1024 * 16 + e;
    float l0 = 0.f, l1 = 0.f;
#pragma unroll 8
    for (int k = kp * 256; k < kp * 256 + 256; ++k) {
        float w = wr_[k * 16];
        l0 += hrow[k] * w; l1 += hrow[1024 + k] * w;
    }
    l0 += __shfl_xor(l0, 16); l0 += __shfl_xor(l0, 32);
    l1 += __shfl_xor(l1, 16); l1 += __shfl_xor(l1, 32);
#pragma unroll
    for (int r = 0; r < 2; ++r) {
        float lg = r == 0 ? l0 : l1;
        float mx = lg;
        mx = fmaxf(mx, __shfl_xor(mx, 1)); mx = fmaxf(mx, __shfl_xor(mx, 2)); mx = fmaxf(mx, __shfl_xor(mx, 4)); mx = fmaxf(mx, __shfl_xor(mx, 8));
        float ex = expf(lg - mx);
        float sm = ex;
        sm += __shfl_xor(sm, 1); sm += __shfl_xor(sm, 2); sm += __shfl_xor(sm, 4); sm += __shfl_xor(sm, 8);
        float a = ex / sm;
        int row = row0 + r;
        if (lane < 16) {
            if (row < NLAT) p.aff[(long)e * NLAT + row] = a;
            else p.aff[(long)(16 + e) * NLAT + (row - NLAT)] = a;
        }
    }
    __syncthreads();
}

DI int block_excl_scan(int v, int* sh  , int& total) {
    const int lane = TIDX() & 63, wid = TIDX() >> 6;
    int inc = v;
    for (int o = 1; o < 64; o <<= 1) { int t = __shfl_up(inc, o); if (lane >= o) inc += t; }
    __syncthreads();
    if (lane == 63) sh[wid] = inc;
    __syncthreads();
    int base = 0;
    for (int w = 0; w < wid; ++w) base += sh[w];
    total = sh[0] + sh[1] + sh[2] + sh[3];
    return base + inc - v;
}
DI void phI_item(const Params& p, int job, char* smem) {
    const int tid = TIDX();
    const int n = job < 16 ? NLAT : NCTX, cap = job < 16 ? CAP_LAT : CAP_CTX, rowbase = job < 16 ? 0 : NLAT;
    unsigned* keys = (unsigned*)smem;
    int* hist = (int*)(smem + 66560);
    int* sh = hist + 256;
    const float* a = p.aff + (long)job * NLAT;
    __syncthreads();
    for (int i = tid; i < n; i += 256) keys[i + (i >> 6)] = __float_as_uint(a[i]);
    unsigned prefix = 0, mask = 0; int remaining = cap;
    for (int pass = 0; pass < 4; ++pass) {
        const int shift = 24 - 8 * pass;
        hist[tid] = 0;
        __syncthreads();
        for (int i = tid; i < n; i += 256) {
            unsigned k = keys[i + (i >> 6)];
            if ((k & mask) == prefix) atomicAdd(&hist[(k >> shift) & 255], 1);
        }
        __syncthreads();
        if (tid == 0) {
            int cum = 0, b = 255;
            for (; b > 0; --b) { if (cum + hist[b] >= remaining) break; cum += hist[b]; }
            sh[8] = b; sh[9] = remaining - cum;
        }
        __syncthreads();
        prefix |= ((unsigned)sh[8]) << shift; mask |= 255u << shift; remaining = sh[9];
        __syncthreads();
    }
    const unsigned T = prefix;
    const int per = n / 256;
    int ceq = 0;
    for (int i = 0; i < per; ++i) { int idx = tid * per + i; ceq += (keys[idx + (idx >> 6)] == T); }
    int tot;
    int eqb = block_excl_scan(ceq, sh, tot);
    int csel = 0, er = eqb;
    for (int i = 0; i < per; ++i) {
        int idx = tid * per + i; unsigned k = keys[idx + (idx >> 6)];
        if (k > T) ++csel; else if (k == T) { if (er < remaining) ++csel; ++er; }
    }
    int slot = block_excl_scan(csel, sh, tot);
    er = eqb;
    for (int i = 0; i < per; ++i) {
        int idx = tid * per + i; unsigned k = keys[idx + (idx >> 6)];
        bool s = false;
        if (k > T) s = true; else if (k == T) { s = er < remaining; ++er; }
        if (s) { p.sel_idx[job * 2048 + slot] = rowbase + idx; p.sel_gate[job * 2048 + slot] = __uint_as_float(k); ++slot; }
    }
    __syncthreads();
}

DI void phJ_tile(const Params& p, int job, int mt, int nt, char* smem) {
    const int tid = TIDX(), lane = tid & 63, wid = tid >> 6, wr = wid >> 1, wc = wid & 1, fr = lane & 15, fq = lane >> 4;
    const int cap = job < 16 ? CAP_LAT : CAP_CTX, e = job & 15;
    f32x4 acc[4][4]; zero_acc<4>(acc);
    const int r0 = tid >> 2, ko = (tid & 3) * 8;
    int s0 = mt * 128 + r0, s1 = s0 + 64;
    s0 = s0 < cap ? s0 : cap - 1; s1 = s1 < cap ? s1 : cap - 1;
    const u16* a0 = p.hx + (long)p.sel_idx[job * 2048 + s0] * DM + ko;
    const u16* a1 = p.hx + (long)p.sel_idx[job * 2048 + s1] * DM + ko;
    const u16* b0 = p.wt_gu + ((long)e * 2048 + nt * 128 + r0) * DM + ko;
    gemm_core<32>(acc, a0, a1, b0, b0 + 64 * DM, smem);
    u16* hb = job < 16 ? p.hid + (long)job * 2048 * EH : p.hidc + (long)(job - 16) * 32 * EH;
#pragma unroll
    for (int m = 0; m < 4; ++m)
#pragma unroll
        for (int n = 0; n < 2; ++n)
#pragma unroll
            for (int j = 0; j < 4; ++j) {
                int slot = mt * 128 + wr * 64 + m * 16 + fq * 4 + j;
                int f = nt * 64 + wc * 32 + n * 16 + fr;
                if (slot < cap) hb[(long)slot * EH + f] = f2bf(siluf_(acc[m][n][j]) * acc[m][n + 2][j]);
            }
}
DI void phK_tile(const Params& p, int layer, int job, int mt, int nt, char* smem) {
    const int tid = TIDX(), lane = tid & 63, wid = tid >> 6, wr = wid >> 1, wc = wid & 1, fr = lane & 15, fq = lane >> 4;
    const int cap = job < 16 ? CAP_LAT : CAP_CTX, e = job & 15;
    f32x4 acc[4][4]; zero_acc<4>(acc);
    const int r0 = tid >> 2, ko = (tid & 3) * 8;
    int s0 = mt * 128 + r0, s1 = s0 + 64;
    s0 = s0 < cap ? s0 : cap - 1; s1 = s1 < cap ? s1 : cap - 1;
    const u16* hb = job < 16 ? p.hid + (long)job * 2048 * EH : p.hidc + (long)(job - 16) * 32 * EH;
    const u16* a0 = hb + (long)s0 * EH + ko;
    const u16* a1 = hb + (long)s1 * EH + ko;
    const u16* b0 = p.wt_dn + ((long)e * 1024 + nt * 128 + r0) * EH + ko;
    gemm_core<32>(acc, a0, a1, b0, b0 + 64 * EH, smem);
    const float* md = p.mod + (layer * 2 + (job < 16 ? 0 : 1)) * 6144 + 5 * 1024;
#pragma unroll
    for (int m = 0; m < 4; ++m)
#pragma unroll
        for (int j = 0; j < 4; ++j) {
            int slot = mt * 128 + wr * 64 + m * 16 + fq * 4 + j;
            if (slot < cap) {
                int row = p.sel_idx[job * 2048 + slot];
                float g = p.sel_gate[job * 2048 + slot];
                float* xo = row < NLAT ? p.out + (long)row * DM : p.ctxres + (long)(row - NLAT) * DM;
#pragma unroll
                for (int n = 0; n < 4; ++n) {
                    int col = nt * 128 + wc * 64 + n * 16 + fr;
                    unsafeAtomicAdd(xo + col, acc[m][n][j] * g * md[col]);
                }
            }
        }
}

DI void run_phase(const Params& p, int ph, char* smem) {
    const int bid = BIDX(), nb = gridDim.x, tid = TIDX(), wid = tid >> 6;
#ifndef ONLY_SUB
    if (ph == 0) {
        const int total = 192 + 48 + CONV_TILES;
        for (int it = bid; it < total; it += nb) {
            if (it < 192) ph0_gemv_item(p, it, smem);
            else if (it < 240) ph0_rope_item(p, it - 192);
            else convert_tile(p, 0, it - 240, smem);
        }
        return;
    }
    if (ph == NPHASE - 1) {
        for (int it = bid; it < NLAT / 4; it += nb) {
            int row = it * 4 + wid, lane = tid & 63;
            float* xr = p.out + (long)row * DM;
            float4 v[4]; float ss = 0.f;
#pragma unroll
            for (int i = 0; i < 4; ++i) { v[i] = *(const float4*)(xr + i * 256 + lane * 4); ss += v[i].x * v[i].x + v[i].y * v[i].y + v[i].z * v[i].z + v[i].w * v[i].w; }
            ss = wave_sum(ss);
            float rstd = rsqrtf(ss * (1.f / DM) + 1e-6f);
#pragma unroll
            for (int i = 0; i < 4; ++i) {
                float4 g = *(const float4*)(p.g_final + i * 256 + lane * 4);
                *(float4*)(xr + i * 256 + lane * 4) = make_float4(v[i].x * rstd * g.x, v[i].y * rstd * g.y, v[i].z * rstd * g.z, v[i].w * rstd * g.w);
            }
        }
        return;
    }
    const int layer = (ph - 1) / 11, sub = (ph - 1) % 11;
#else
    const int layer = (ph - 1) / 11, sub = ONLY_SUB;
#endif
    const bool need_ctx = layer == 0;
    switch (sub) {
    case 0: {
        const int nrow_items = NROWS / 4;
        const int total = nrow_items + (layer == 1 ? CONV_TILES : 0);
        for (int it = bid; it < total; it += nb) {
            if (it < nrow_items) { int row = it * 4 + wid; norm_row(p, layer, row, resid_row(p, layer, row), p.g_mix + layer * DM, 0, 1, p.hx + (long)row * DM, nullptr); }
            else convert_tile(p, layer, it - nrow_items, smem);
        }
    } break;
    case 1: {
        const int total = 130 * 58;
        for (int it = bid; it < total; it += nb) {
            int g = it / (8 * 58), local = it - g * 8 * 58;
            int gsz = (130 - g * 8) < 8 ? (130 - g * 8) : 8;
            int nt = local / gsz, mt = g * 8 + local % gsz;
            phB_tile(p, mt, nt, smem);
        }
    } break;
    case 2: {
        const int n_state = NCHUNK * 8, n_win = 512, n_na = 512, n_cx = need_ctx ? 16 : 0;
        const int total = n_state + n_win + n_na + n_cx;
        for (int it = bid; it < total; it += nb) {
            if (it < n_win) attn_wave_item(p, layer, 0, it >> 1, (it & 1) * 4 + wid, smem);
            else if (it < n_win + n_na) { int i2 = it - n_win; attn_wave_item(p, layer, 1, i2 >> 1, (i2 & 1) * 4 + wid, smem); }
            else if (it < n_win + n_na + n_state) { int i2 = it - n_win - n_na; phC_state_item(p, layer, i2 >> 3, (i2 >> 1) & 3, i2 & 1, smem); }
            else { int i2 = it - n_win - n_na - n_state; int kind = 2 + (i2 >> 3); i2 &= 7; attn_wave_item(p, layer, kind, i2 >> 1, (i2 & 1) * 4 + wid, smem); }
        }
    } break;
    case 3: {
        for (int it = bid; it < 512; it += nb) phD_item(p, layer, it);
    } break;
    case 4: {
        const int nch = need_ctx ? NCHUNK : 128;
        for (int it = bid; it < nch * 8; it += nb) phE_item(p, layer, it >> 3, (it >> 1) & 3, it & 1, smem);
    } break;
    case 5: {
        const int nmt = need_ctx ? 130 : 128;
        for (int it = bid; it < nmt * 8; it += nb) phF_tile(p, it >> 3, it & 7, smem);
    } break;
    case 6: {
        const int nmt = need_ctx ? 130 : 128;
        for (int it = bid; it < nmt * 8; it += nb) phG_tile(p, layer, it >> 3, it & 7, smem);
    } break;
    case 7: {
        const int nit = (need_ctx ? NROWS : NLAT) / 8;
        for (int it = bid; it < nit; it += nb) phH_item(p, layer, it, smem);
    } break;
    case 8: {
        const int njob = need_ctx ? 32 : 16;
        for (int it = bid; it < njob; it += nb) phI_item(p, it, smem);
    } break;
    case 9: {
        const int total = 4096 + (need_ctx ? 256 : 0);
        for (int it = bid; it < total; it += nb) {
            if (it < 4096) phJ_tile(p, it >> 8, (it >> 4) & 15, it & 15, smem);
            else { int i2 = it - 4096; phJ_tile(p, 16 + (i2 >> 4), 0, i2 & 15, smem); }
        }
    } break;
    case 10: {
        const int total = 2048 + (need_ctx ? 128 : 0);
        for (int it = bid; it < total; it += nb) {
            if (it < 2048) phK_tile(p, layer, it >> 7, (it >> 3) & 15, it & 7, smem);
            else { int i2 = it - 2048; phK_tile(p, layer, 16 + (i2 >> 3), 0, i2 & 7, smem); }
        }
    } break;
    }
}

__global__ void __launch_bounds__(NTHREADS, 2) mega_kernel(Params p, int ph_lo, int ph_hi) {
    __shared__ __attribute__((aligned(16))) char smem[LDS_BYTES];
    cg::grid_group grid = cg::this_grid();
    for (int ph = ph_lo; ph < ph_hi; ++ph) {
        if (ph > ph_lo) grid.sync();
        run_phase(p, ph, smem);
    }
}

extern "C" void kernel_launch(void* const* d_in, const int* in_sizes, int n_in, void* d_out, int out_size, void* d_ws, size_t ws_size,
                              hipStream_t stream) {
    static int grid_blocks = 0;
    if (!grid_blocks) {
        int dev = 0, cus = 0, per_cu = 0;
        hipGetDevice(&dev);
        hipDeviceGetAttribute(&cus, hipDeviceAttributeMultiprocessorCount, dev);
        hipOccupancyMaxActiveBlocksPerMultiprocessor(&per_cu, mega_kernel, NTHREADS, 0);
        if (per_cu < 1) per_cu = 1;
        if (per_cu > 2) per_cu = 2;
        grid_blocks = cus * per_cu;
    }
    Params p{};
    const float** ip = (const float**)&p.x;
    for (int i = 0; i < 22; ++i) ip[i] = (const float*)d_in[i];
    p.out = (float*)d_out;
    char* w = (char*)d_ws;
    size_t off = 0;
    auto take = [&](size_t bytes) { char* r = w + off; off += (bytes + 255) & ~(size_t)255; return r; };
    p.ctxres = (float*)take((size_t)NCTX * DM * 4);
    p.mod = (float*)take(2 * 2 * 6144 * 4);
    p.rope128 = (float2*)take(256 * 32 * 8);
    p.rope64 = (float2*)take(256 * 16 * 8);
    p.wt_in = (u16*)take((size_t)INC * DM * 2);
    p.wt_ret = (u16*)take((size_t)1024 * 512 * 2);
    p.wt_win = (u16*)take((size_t)1024 * 512 * 2);
    p.wt_na = (u16*)take((size_t)1024 * 512 * 2);
    p.wt_out = (u16*)take((size_t)1024 * 1024 * 2);
    p.wt_gu = (u16*)take((size_t)NEXP * 2048 * 1024 * 2);
    p.wt_dn = (u16*)take((size_t)NEXP * 1024 * 1024 * 2);
    p.hx = (u16*)take((size_t)NROWS * DM * 2);
    p.px = (u16*)take((size_t)NROWS * INC * 2);
    p.hid = p.px;
    p.hidc = p.px + (size_t)NEXP * 2048 * 1024;
    p.ya = (u16*)take((size_t)NROWS * 512 * 2);
    p.yb = (u16*)take((size_t)NROWS * 512 * 2);
    p.yc = (u16*)take((size_t)NROWS * 512 * 2);
    p.S = (float*)take((size_t)NCHUNK * 8 * 16384 * 4);
    p.R = (u16*)take((size_t)NCHUNK * 8 * 16384 * 2);
    p.aff = (float*)take((size_t)32 * NLAT * 4);
    p.sel_idx = (int*)take(32 * 2048 * 4);
    p.sel_gate = (float*)take(32 * 2048 * 4);
    if (off > ws_size) { fprintf(stderr, "kernel_launch: workspace too small: need %zu have %zu\n", off, ws_size); return; }
#if MK_MULTI
    for (int ph = 0; ph < NPHASE; ++ph) {
        hipLaunchKernelGGL(mega_kernel, dim3(grid_blocks), dim3(NTHREADS), 0, stream, p, ph, ph + 1);
    }
#else
    int lo = 0, hi = NPHASE;
    void* args[] = {&p, &lo, &hi};
    hipError_t e = hipLaunchCooperativeKernel((void*)mega_kernel, dim3(grid_blocks), dim3(NTHREADS), args, 0, stream);
    if (e != hipSuccess) fprintf(stderr, "cooperative launch failed: %s (grid %d)\n", hipGetErrorString(e), grid_blocks);
#endif
}
```

```cpp
#include <hip/hip_runtime.h>
#include <hip/hip_bf16.h>
#include <hip/hip_cooperative_groups.h>
#include <cstdio>
#include <cstdint>
namespace cg = cooperative_groups;

#ifndef MK_MULTI
#define MK_MULTI 0
#endif

#define DI __device__ __forceinline__
typedef unsigned short u16;
typedef __attribute__((ext_vector_type(8))) short bf16x8;
typedef __attribute__((ext_vector_type(4))) float f32x4;
typedef __attribute__((ext_vector_type(4))) unsigned int u32x4;

constexpr int NLAT = 16384, NCTX = 256, NROWS = NLAT + NCTX, DM = 1024, INC = 7424;
constexpr int C_QR = 0, C_KR = 512, C_VR = 1024, C_GR = 1536, C_QW = 2048, C_KW = 2560, C_VW = 2688, C_QN = 2816, C_KN = 3328, C_VN = 3840, C_GATE = 4352;
constexpr int NCHUNK = NROWS / 128;
constexpr int NEXP = 16, EH = 1024, CAP_LAT = 2048, CAP_CTX = 32;
constexpr int NTHREADS = 256;
constexpr int LDS_BYTES = 76 * 1024;
constexpr int NPHASE = 24;

struct Params {
    const float *x, *c, *ctx, *c_ctx, *w_mod, *b_mod, *g_mix, *g_ffn, *w_in, *decay, *ret_gn, *w_ret, *sink, *w_win, *rpb, *w_na, *w_out,
        *w_router, *w_eg, *w_eu, *w_ed, *g_final;
    float* out;
    float* ctxres;
    float* mod;
    float2* rope128;
    float2* rope64;
    u16 *wt_in, *wt_ret, *wt_win, *wt_na, *wt_out, *wt_gu, *wt_dn;
    u16* hx;
    u16* px;
    u16 *ya, *yb, *yc;
    float* S;
    u16* R;
    float* aff;
    int* sel_idx;
    float* sel_gate;
    u16* hid;
    u16* hidc;
};

DI int TIDX() { int t = threadIdx.x; asm volatile("" : "+v"(t)); return t; }
DI int BIDX() { int t = blockIdx.x; asm volatile("" : "+s"(t)); return t; }
DI u16 f2bf(float x) { unsigned u = __float_as_uint(x); u += 0x7fffu + ((u >> 16) & 1u); return (u16)(u >> 16); }
DI float bf2f(u16 h) { return __uint_as_float(((unsigned)h) << 16); }
DI float bflo(unsigned w) { return __uint_as_float(w << 16); }
DI float bfhi(unsigned w) { return __uint_as_float(w & 0xffff0000u); }
typedef __bf16 bf16v2 __attribute__((ext_vector_type(2)));
typedef float f32v2 __attribute__((ext_vector_type(2)));
DI unsigned pack2(float a, float b) { f32v2 v = {a, b}; bf16v2 r = __builtin_convertvector(v, bf16v2); return __builtin_bit_cast(unsigned, r); }
DI float sigmoidf_(float x) { return 1.f / (1.f + __expf(-x)); }
DI float siluf_(float x) { return x / (1.f + __expf(-x)); }
DI float wave_sum(float v) { for (int o = 32; o > 0; o >>= 1) v += __shfl_xor(v, o); return v; }
#define MFMA16(a, b, c) __builtin_amdgcn_mfma_f32_16x16x32_bf16((a), (b), (c), 0, 0, 0)

template <int MR>
DI void zero_acc(f32x4 (&acc)[MR][4]) {
#pragma unroll
    for (int m = 0; m < MR; ++m)
#pragma unroll
        for (int n = 0; n < 4; ++n) acc[m][n] = f32x4{0.f, 0.f, 0.f, 0.f};
}

template <int KT>
DI void gemm_core(f32x4 (&acc)[4][4], const u16* a0, const u16* a1, const u16* b0, const u16* b1, char* smem) {
    const int tid = TIDX(), lane = tid & 63, wid = tid >> 6, wr = wid >> 1, wc = wid & 1, fr = lane & 15, fq = lane >> 4;
    auto stage = [&](int kt, int buf) {
        char* base = smem + buf * 16384;
        __builtin_amdgcn_global_load_lds((const unsigned*)(a0 + kt * 32), (unsigned*)(base + tid * 16), 16, 0, 0);
        __builtin_amdgcn_global_load_lds((const unsigned*)(a1 + kt * 32), (unsigned*)(base + 4096 + tid * 16), 16, 0, 0);
        __builtin_amdgcn_global_load_lds((const unsigned*)(b0 + kt * 32), (unsigned*)(base + 8192 + tid * 16), 16, 0, 0);
        __builtin_amdgcn_global_load_lds((const unsigned*)(b1 + kt * 32), (unsigned*)(base + 12288 + tid * 16), 16, 0, 0);
    };
    __syncthreads();
    stage(0, 0);
    for (int kt = 0; kt < KT; ++kt) {
        asm volatile("s_waitcnt vmcnt(0)" ::: "memory");
        __syncthreads();
        if (kt + 1 < KT) stage(kt + 1, (kt + 1) & 1);
        const char* SA = smem + (kt & 1) * 16384;
        const char* SB = SA + 8192;
        bf16x8 At[4], Bt[4];
#pragma unroll
        for (int m = 0; m < 4; ++m) At[m] = *(const bf16x8*)(SA + (wr * 64 + m * 16 + fr) * 64 + fq * 16);
#pragma unroll
        for (int n = 0; n < 4; ++n) Bt[n] = *(const bf16x8*)(SB + (wc * 64 + n * 16 + fr) * 64 + fq * 16);
#pragma unroll
        for (int m = 0; m < 4; ++m)
#pragma unroll
            for (int n = 0; n < 4; ++n) acc[m][n] = MFMA16(At[m], Bt[n], acc[m][n]);
    }
}

template <int MR>
DI void mma_lds64(f32x4 (&acc)[MR][4], const u16* As, int lda, const u16* Bs, int ldb) {
    const int tid = TIDX(), lane = tid & 63, wid = tid >> 6, wr = wid >> 1, wc = wid & 1, fr = lane & 15, fq = lane >> 4;
#pragma unroll
    for (int kk = 0; kk < 2; ++kk) {
        bf16x8 At[MR], Bt[4];
#pragma unroll
        for (int m = 0; m < MR; ++m) At[m] = *(const bf16x8*)(As + (wr * (MR * 16) + m * 16 + fr) * lda + kk * 32 + fq * 8);
#pragma unroll
        for (int n = 0; n < 4; ++n) Bt[n] = *(const bf16x8*)(Bs + (wc * 64 + n * 16 + fr) * ldb + kk * 32 + fq * 8);
#pragma unroll
        for (int m = 0; m < MR; ++m)
#pragma unroll
            for (int n = 0; n < 4; ++n) acc[m][n] = MFMA16(At[m], Bt[n], acc[m][n]);
    }
}
template <int ROWS>
DI void stage_n64(u16* dst, int ld, const u16* src, long sstride) {
    const int tid = TIDX();
#pragma unroll
    for (int i = 0; i < ROWS / 32; ++i) {
        int idx = i * 256 + tid, row = idx >> 3, ch = idx & 7;
        u32x4 v = *(const u32x4*)(src + (long)row * sstride + ch * 8);
        *(u32x4*)(dst + row * ld + ch * 8) = v;
    }
}
template <bool SCALE, int NF>
DI void stage_t64(u16* dst, int ld, const u16* src, long sstride, float scale_tok_lane  ) {
    const int tid = TIDX();
#pragma unroll
    for (int i = 0; i < NF / 32; ++i) {
        int idx = i * 256 + tid, jj = idx & 63, ch = idx >> 6;
        u32x4 v = *(const u32x4*)(src + (long)jj * sstride + ch * 8);
#pragma unroll
        for (int e = 0; e < 4; ++e) {
            float lo = bflo(v[e]), hi = bfhi(v[e]);
            if (SCALE) { lo *= scale_tok_lane; hi *= scale_tok_lane; }
            dst[(ch * 8 + 2 * e) * ld + jj] = SCALE ? f2bf(lo) : (u16)(v[e] & 0xffffu);
            dst[(ch * 8 + 2 * e + 1) * ld + jj] = SCALE ? f2bf(hi) : (u16)(v[e] >> 16);
        }
    }
}

DI void convert_tile(const Params& p, int layer, int tile, char* smem);

DI void ph0_gemv_item(const Params& p, int item, char* smem) {
    const int tid = TIDX();
    const int l = item / 96, cg_ = item % 96;
    float* sl = (float*)smem;
    float* red = (float*)(smem + 8192);
    __syncthreads();
    for (int k = tid; k < 1024; k += 256) { sl[k] = siluf_(p.c[k]); sl[1024 + k] = siluf_(p.c_ctx[k]); }
    __syncthreads();
    const int c4 = tid & 15, kp = tid >> 4;
    const int col = cg_ * 64 + c4 * 4;
    const float* w = p.w_mod + (long)l * 1024 * 6144 + col;
    float a0[4] = {0, 0, 0, 0}, a1[4] = {0, 0, 0, 0};
#pragma unroll 8
    for (int kk = 0; kk < 64; ++kk) {
        int k = kp * 64 + kk;
        float4 wv = *(const float4*)(w + (long)k * 6144);
        float s0 = sl[k], s1 = sl[1024 + k];
        a0[0] += s0 * wv.x; a0[1] += s0 * wv.y; a0[2] += s0 * wv.z; a0[3] += s0 * wv.w;
        a1[0] += s1 * wv.x; a1[1] += s1 * wv.y; a1[2] += s1 * wv.z; a1[3] += s1 * wv.w;
    }
#pragma unroll
    for (int j = 0; j < 4; ++j) { red[(kp * 2 + 0) * 64 + c4 * 4 + j] = a0[j]; red[(kp * 2 + 1) * 64 + c4 * 4 + j] = a1[j]; }
    __syncthreads();
    if (tid < 128) {
        int src = tid >> 6, cr = tid & 63;
        float s = 0.f;
        for (int q = 0; q < 16; ++q) s += red[(q * 2 + src) * 64 + cr];
        int n = cg_ * 64 + cr;
        p.mod[(l * 2 + src) * 6144 + n] = s + p.b_mod[l * 6144 + n];
    }
}
DI void sincos_d(double a, float& c, float& s) {
    const double TWO_PI = 6.283185307179586476925286766559;
    double k = rint(a / TWO_PI);
    double r = a - k * TWO_PI;
    double r2 = r * r;
    double ts = r, tc = 1.0, ss = r, cc = 1.0;
    for (int i = 1; i <= 14; ++i) {
        tc = -tc * r2 / (double)((2 * i - 1) * (2 * i));
        ts = -ts * r2 / (double)((2 * i) * (2 * i + 1));
        cc += tc; ss += ts;
    }
    c = (float)cc; s = (float)ss;
}
DI void ph0_rope_item(const Params& p, int item) {
    int idx = item * 256 + TIDX();
    const double LN_BASE = 9.210340371976184;
    if (idx < 8192) {
        int pos = idx >> 5, f = idx & 31;
        float inv = (float)exp(-(double)f / 32.0 * LN_BASE);
        float ang = (float)pos * inv;
        float c, s; sincos_d((double)ang, c, s);
        p.rope128[idx] = make_float2(c, s);
    } else {
        int i2 = idx - 8192;
        int pos = i2 >> 4, f = i2 & 15;
        float inv = (float)exp(-(double)f / 16.0 * LN_BASE);
        float ang = (float)pos * inv;
        float c, s; sincos_d((double)ang, c, s);
        p.rope64[i2] = make_float2(c, s);
    }
}

constexpr int CONV_TILES = 1856 + 384 + 256 + 12288;
DI void convert_tile(const Params& p, int layer, int tile, char* smem) {
    const int tid = TIDX();
    const float* src; u16* dst; int K, N, mode = 0;
    if (tile < 1856) { src = p.w_in + (long)layer * 1024 * INC; dst = p.wt_in; K = 1024; N = INC; mode = 1; }
    else if (tile < 1856 + 384) {
        int t = tile - 1856, which = t / 128; tile = t % 128; K = 512; N = 1024;
        src = (which == 0 ? p.w_ret : which == 1 ? p.w_win : p.w_na) + (long)layer * 512 * 1024;
        dst = (which == 0 ? p.wt_ret : which == 1 ? p.wt_win : p.wt_na);
    } else if (tile < 1856 + 384 + 256) { tile -= 1856 + 384; src = p.w_out + (long)layer * 1024 * 1024; dst = p.wt_out; K = 1024; N = 1024; }
    else {
        int t = tile - (1856 + 384 + 256), which = t / 4096, e = (t % 4096) / 256; tile = t % 256; K = 1024; N = 1024;
        long eo = ((long)layer * NEXP + e) * 1024 * 1024;
        if (which == 0) { src = p.w_eg + eo; dst = p.wt_gu + (long)e * 2048 * 1024; mode = 2; }
        else if (which == 1) { src = p.w_eu + eo; dst = p.wt_gu + (long)e * 2048 * 1024; mode = 3; }
        else { src = p.w_ed + eo; dst = p.wt_dn + (long)e * 1024 * 1024; }
    }
    const int ntn = N / 64;
    const int k0 = (tile / ntn) * 64, n0 = (tile % ntn) * 64;
    float* T = (float*)smem;
    __syncthreads();
#pragma unroll
    for (int i = 0; i < 4; ++i) {
        int kk = (tid >> 4) + 16 * i, n4 = tid & 15;
        float4 v = *(const float4*)(src + (long)(k0 + kk) * N + n0 + n4 * 4);
        T[kk * 65 + n4 * 4 + 0] = v.x; T[kk * 65 + n4 * 4 + 1] = v.y; T[kk * 65 + n4 * 4 + 2] = v.z; T[kk * 65 + n4 * 4 + 3] = v.w;
    }
    __syncthreads();
#pragma unroll
    for (int i = 0; i < 2; ++i) {
        int nn = (tid >> 3) + 32 * i, k8 = tid & 7;
        u32x4 o;
#pragma unroll
        for (int e = 0; e < 4; ++e) o[e] = pack2(T[(k8 * 8 + 2 * e) * 65 + nn], T[(k8 * 8 + 2 * e + 1) * 65 + nn]);
        int n = n0 + nn, drow = n;
        if (mode == 1) {
            if (n < 1024) { int o_ = n & 127, s_ = (o_ < 32) ? o_ : (o_ < 64) ? o_ + 32 : (o_ < 96) ? o_ - 32 : o_; drow = (n & ~127) + s_; }
        } else if (mode == 2) drow = (n >> 5) * 64 + (n & 31);
        else if (mode == 3) drow = (n >> 5) * 64 + 32 + (n & 31);
        *(u32x4*)(dst + (long)drow * K + k0 + k8 * 8) = o;
    }
}

DI const float* resid_row(const Params& p, int layer, int row) {
    if (row < NLAT) return (layer == 0 ? p.x : p.out) + (long)row * DM;
    return (layer == 0 ? p.ctx : p.ctxres) + (long)(row - NLAT) * DM;
}
DI const float* cur_row(const Params& p, int row) { return row < NLAT ? p.out + (long)row * DM : p.ctxres + (long)(row - NLAT) * DM; }
DI void norm_row(const Params& p, int layer, int row, const float* xr, const float* g, int shift_idx, int scale_idx, u16* dst_row, float* keep  ) {
    const int lane = TIDX() & 63;
    const float* md = p.mod + (layer * 2 + (row < NLAT ? 0 : 1)) * 6144;
    float4 v[4]; float ss = 0.f;
#pragma unroll
    for (int i = 0; i < 4; ++i) { v[i] = *(const float4*)(xr + i * 256 + lane * 4); ss += v[i].x * v[i].x + v[i].y * v[i].y + v[i].z * v[i].z + v[i].w * v[i].w; }
    ss = wave_sum(ss);
    float rstd = rsqrtf(ss * (1.f / DM) + 1e-6f);
#pragma unroll
    for (int i = 0; i < 4; ++i) {
        int c0 = i * 256 + lane * 4;
        float4 gg = *(const float4*)(g + c0), sh = *(const float4*)(md + shift_idx * 1024 + c0), sc = *(const float4*)(md + scale_idx * 1024 + c0);
        float o0 = v[i].x * rstd * gg.x * (1.f + sc.x) + sh.x, o1 = v[i].y * rstd * gg.y * (1.f + sc.y) + sh.y;
        float o2 = v[i].z * rstd * gg.z * (1.f + sc.z) + sh.z, o3 = v[i].w * rstd * gg.w * (1.f + sc.w) + sh.w;
        uint2 pk; pk.x = pack2(o0, o1); pk.y = pack2(o2, o3);
        *(uint2*)(dst_row + c0) = pk;
        if (keep) *(float4*)(keep + c0) = make_float4(o0, o1, o2, o3);
    }
}

DI void phB_tile(const Params& p, int mt, int nt, char* smem) {
    const int tid = TIDX(), lane = tid & 63, wid = tid >> 6, wr = wid >> 1, wc = wid & 1, fr = lane & 15, fq = lane >> 4;
    f32x4 acc[4][4]; zero_acc<4>(acc);
    const int r0 = tid >> 2, ko = (tid & 3) * 8;
    const u16* a0 = p.hx + (long)(mt * 128 + r0) * DM + ko;
    const u16* b0 = p.wt_in + (long)(nt * 128 + r0) * DM + ko;
    gemm_core<32>(acc, a0, a0 + 64 * DM, b0, b0 + 64 * DM, smem);
    const bool lat = mt < 128;
    const int type = (nt < 8) ? 1 : (nt >= 16 && nt < 21) ? 2 : 0;
    if (type != 0 && lat) {
#pragma unroll
        for (int m = 0; m < 4; ++m)
#pragma unroll
            for (int j = 0; j < 4; ++j) {
                int t = mt * 128 + wr * 64 + m * 16 + fq * 4 + j;
                int pr = t >> 6, pc = t & 63;
#pragma unroll
                for (int n = 0; n < 2; ++n) {
                    float2 cs;
                    if (type == 1) { int pos = (wc == 0) ? pr : pc; cs = p.rope128[pos * 32 + n * 16 + fr]; }
                    else { int pos = (n == 0) ? pr : pc; cs = p.rope64[pos * 16 + fr]; }
                    float x1 = acc[m][n][j], x2 = acc[m][n + 2][j];
                    acc[m][n][j] = x1 * cs.x - x2 * cs.y;
                    acc[m][n + 2][j] = x1 * cs.y + x2 * cs.x;
                }
            }
    }
    const float mul = (nt >= 4 && nt < 8) ? 0.08838834764831845f : ((nt >= 16 && nt < 20) || (nt >= 22 && nt < 26)) ? 0.125f : 1.f;
#pragma unroll
    for (int m = 0; m < 4; ++m)
#pragma unroll
        for (int n = 0; n < 4; ++n)
#pragma unroll
            for (int j = 0; j < 4; ++j) {
                int row = mt * 128 + wr * 64 + m * 16 + fq * 4 + j, col = nt * 128 + wc * 64 + n * 16 + fr;
                p.px[(long)row * INC + col] = f2bf(acc[m][n][j] * mul);
            }
}

typedef __attribute__((ext_vector_type(16))) float f32x16;
typedef short v4s __attribute__((ext_vector_type(4)));
typedef __attribute__((address_space(3))) v4s* lds_v4s_ptr;
#define MFMA32(a, b, c) __builtin_amdgcn_mfma_f32_32x32x16_bf16((a), (b), (c), 0, 0, 0)
constexpr float LOG2E = 1.4426950408889634f;

struct FA {
    bf16x8 qf[4];
    f32x16 o[2];
    float m, l;
};
DI void fa_stage(u16* Ks, u16* Vs, const u16* px, int rowstart, int colK1, int colK2, int colV) {
    const int lane = TIDX() & 63;
#pragma unroll
    for (int i = 0; i < 8; ++i) {
        int idx = i * 64 + lane, key = idx >> 3, ch = idx & 7;
        const u16* src = px + (long)(rowstart + key) * INC;
        u32x4 kv = *(const u32x4*)(src + (ch < 4 ? colK1 + ch * 8 : colK2 + (ch - 4) * 8));
        u32x4 vv = *(const u32x4*)(src + colV + ch * 8);
        *(u32x4*)(Ks + key * 72 + ch * 8) = kv;
        *(u32x4*)(Vs + key * 72 + ch * 8) = vv;
    }
}
template <int MODE>
DI void fa_tile(FA& st, const u16* Ks, const u16* Vs, int a0, const float* rrow) {
    const int lane = TIDX() & 63, c = lane & 31, hh = lane >> 5;
    const u16* kbase = Ks + c * 72 + hh * 8;
    const u16* vbase = Vs + (4 * hh + ((lane & 15) >> 2)) * 72 + 16 * ((lane >> 4) & 1) + 4 * (lane & 3);
    f32x16 s[2];
#pragma unroll
    for (int kb = 0; kb < 2; ++kb) {
#pragma unroll
        for (int r = 0; r < 16; ++r) s[kb][r] = 0.f;
#pragma unroll
        for (int ks = 0; ks < 4; ++ks) {
            bf16x8 A = *(const bf16x8*)(kbase + kb * 32 * 72 + ks * 16);
            s[kb] = MFMA32(A, st.qf[ks], s[kb]);
        }
    }
    float mx = -3.0e38f;
    const int cq = a0 + c;
    int cs = cq - 8; cs = cs < 0 ? 0 : (cs > 48 ? 48 : cs);
#pragma unroll
    for (int kb = 0; kb < 2; ++kb)
#pragma unroll
        for (int r = 0; r < 16; ++r) {
            const int j = kb * 32 + (r & 3) + 8 * (r >> 2) + 4 * hh;
            float v = s[kb][r];
            if (MODE == 1) { int d = a0 + j - c; v = (d >= -128 && d <= 128) ? v : -1e30f; }
            if (MODE == 2) { bool ok = (j >= cs) && (j < cs + 16); int ci = j - cq + 15; ci = ci < 0 ? 0 : (ci > 30 ? 30 : ci); v = ok ? v + rrow[ci] : -1e30f; }
            v *= LOG2E;
            s[kb][r] = v;
            mx = fmaxf(mx, v);
        }
    mx = fmaxf(mx, __shfl_xor(mx, 32));
    const float mn = fmaxf(st.m, mx);
    const float alpha = __builtin_amdgcn_exp2f(st.m - mn);
    float ls = 0.f;
#pragma unroll
    for (int kb = 0; kb < 2; ++kb)
#pragma unroll
        for (int r = 0; r < 16; ++r) { float pv = __builtin_amdgcn_exp2f(s[kb][r] - mn); s[kb][r] = pv; ls += pv; }
    st.l = st.l * alpha + ls; st.m = mn;
#pragma unroll
    for (int db = 0; db < 2; ++db)
#pragma unroll
        for (int r = 0; r < 16; ++r) st.o[db][r] *= alpha;
    bf16x8 pf[2][2];
#pragma unroll
    for (int kb = 0; kb < 2; ++kb)
#pragma unroll
        for (int k2 = 0; k2 < 2; ++k2) {
            u32x4 w;
#pragma unroll
            for (int e = 0; e < 4; ++e) w[e] = pack2(s[kb][8 * k2 + 2 * e], s[kb][8 * k2 + 2 * e + 1]);
            pf[kb][k2] = __builtin_bit_cast(bf16x8, w);
        }
#pragma unroll
    for (int db = 0; db < 2; ++db)
#pragma unroll
        for (int kb = 0; kb < 2; ++kb)
#pragma unroll
            for (int k2 = 0; k2 < 2; ++k2) {
                const u16* alo = vbase + (kb * 32 + 16 * k2) * 72 + db * 32;
                v4s lo = __builtin_amdgcn_ds_read_tr16_b64_v4i16((lds_v4s_ptr)alo);
                v4s hi = __builtin_amdgcn_ds_read_tr16_b64_v4i16((lds_v4s_ptr)(alo + 8 * 72));
                bf16x8 A = __builtin_shufflevector(lo, hi, 0, 1, 2, 3, 4, 5, 6, 7);
                st.o[db] = MFMA32(A, pf[kb][k2], st.o[db]);
            }
}
DI void attn_wave_item(const Params& p, int layer, int kind, int blk, int h, char* smem) {
    const int lane = TIDX() & 63, wid = TIDX() >> 6, c = lane & 31, hh = lane >> 5;
    u16* Ks = (u16*)(smem + wid * 19456);
    u16* Vs = Ks + 64 * 72;
    float* rpbs = (float*)(smem + wid * 19456 + 18432);
    const bool isna = (kind == 1 || kind == 3);
    const int q0 = ((kind >= 2) ? NLAT : 0) + blk * 32;
    const int colQ1 = isna ? C_QN + h * 64 : C_QW + h * 64, colQ2 = colQ1 + 32;
    const int kvh = isna ? h : (h >> 2);
    const int colK1 = isna ? C_KN + kvh * 64 : C_KW + kvh * 64, colK2 = colK1 + 32;
    const int colV = isna ? C_VN + kvh * 64 : C_VW + kvh * 64;
    FA st;
    {
        const u16* qrow = p.px + (long)(q0 + c) * INC;
#pragma unroll
        for (int ks = 0; ks < 4; ++ks) st.qf[ks] = *(const bf16x8*)(qrow + (ks < 2 ? colQ1 + ks * 16 : colQ2 + (ks - 2) * 16) + hh * 8);
#pragma unroll
        for (int db = 0; db < 2; ++db)
#pragma unroll
            for (int r = 0; r < 16; ++r) st.o[db][r] = 0.f;
        if (isna) { st.m = -1e30f; st.l = 0.f; } else { st.m = p.sink[layer * 8 + h] * LOG2E; st.l = hh == 0 ? 1.f : 0.f; }
    }
    if (kind == 0) {
        const int t0 = (q0 >> 6) - 2;
        for (int i = 0; i < 5; ++i) {
            int start = (t0 + i) * 64;
            if (start < 0 || start >= NLAT) continue;
            fa_stage(Ks, Vs, p.px, start, colK1, colK2, colV);
            if (i == 0 || i == 4) fa_tile<1>(st, Ks, Vs, start - q0, nullptr);
            else fa_tile<0>(st, Ks, Vs, 0, nullptr);
        }
    } else if (kind == 1) {
        const int r = blk >> 1;
        int sr = r - 4; sr = sr < 0 ? 0 : (sr > 248 ? 248 : sr);
        const float* rp = p.rpb + ((long)layer * 8 + h) * 465 + (sr - r + 7) * 31;
        for (int i = lane; i < 248; i += 64) rpbs[i] = rp[i];
        for (int i = 0; i < 8; ++i) {
            fa_stage(Ks, Vs, p.px, (sr + i) * 64, colK1, colK2, colV);
            fa_tile<2>(st, Ks, Vs, (blk & 1) * 32, rpbs + i * 31);
        }
    }
    for (int i = 0; i < 4; ++i) {
        fa_stage(Ks, Vs, p.px, NLAT + i * 64, colK1, colK2, colV);
        fa_tile<0>(st, Ks, Vs, 0, nullptr);
    }
    u16* y = isna ? p.yc : p.yb;
    {
        float lt = st.l + __shfl_xor(st.l, 32);
        float inv = 1.f / lt;
        u16* orow = y + (long)(q0 + c) * 512 + h * 64;
#pragma unroll
        for (int db = 0; db < 2; ++db)
#pragma unroll
            for (int g = 0; g < 4; ++g) {
                uint2 o;
                o.x = pack2(st.o[db][4 * g] * inv, st.o[db][4 * g + 1] * inv);
                o.y = pack2(st.o[db][4 * g + 2] * inv, st.o[db][4 * g + 3] * inv);
                *(uint2*)(orow + db * 32 + 8 * g + 4 * hh) = o;
            }
    }
}

DI void ret_gammas(const Params& p, int layer, int h, float& lgf2, float& lgb2) {
    float xf = p.decay[layer * 8 + h], xb = p.decay[layer * 8 + 4 + h];
    lgf2 = -log1pf(expf(-xf)) * 1.4426950408889634f;
    lgb2 = -log1pf(expf(-xb)) * 1.4426950408889634f;
}
DI void phC_state_item(const Params& p, int layer, int c, int h, int eh, char* smem) {
    const int tid = TIDX(), lane = tid & 63, wid = tid >> 6, wr = wid >> 1, wc = wid & 1, fr = lane & 15, fq = lane >> 4;
    u16* Av = (u16*)smem;
    u16* Bf = Av + 64 * 72;
    u16* Bb = Bf + 128 * 72;
    float lgf2, lgb2; ret_gammas(p, layer, h, lgf2, lgb2);
    f32x4 accF[2][4], accB[2][4]; zero_acc<2>(accF); zero_acc<2>(accB);
    const u16* base = p.px + (long)c * 128 * INC;
#pragma unroll 1
    for (int jh = 0; jh < 2; ++jh) {
        const int j = jh * 64 + (tid & 63);
        const float zf = exp2f((float)(127 - j) * lgf2), zb = exp2f((float)j * lgb2);
        __syncthreads();
        stage_t64<false, 64>(Av, 72, base + (long)jh * 64 * INC + C_VR + h * 128 + eh * 64, INC, 1.f);
        stage_t64<true, 128>(Bf, 72, base + (long)jh * 64 * INC + C_KR + h * 128, INC, zf);
        stage_t64<true, 128>(Bb, 72, base + (long)jh * 64 * INC + C_KR + h * 128, INC, zb);
        __syncthreads();
        mma_lds64<2>(accF, Av, 72, Bf, 72);
        mma_lds64<2>(accB, Av, 72, Bb, 72);
    }
    float* Sf = p.S + ((long)(c * 4 + h) * 2 + 0) * 16384;
    float* Sb = Sf + 16384;
#pragma unroll
    for (int m = 0; m < 2; ++m)
#pragma unroll
        for (int n = 0; n < 4; ++n)
#pragma unroll
            for (int j = 0; j < 4; ++j) {
                int e = eh * 64 + wr * 32 + m * 16 + fq * 4 + j, d = wc * 64 + n * 16 + fr;
                Sf[e * 128 + d] = accF[m][n][j];
                Sb[e * 128 + d] = accB[m][n][j];
            }
}

DI void phD_item(const Params& p, int layer, int item) {
    const int h = item >> 7, dir = (item >> 6) & 1, pos = (item & 63) * 256 + TIDX();
    float lgf2, lgb2; ret_gammas(p, layer, h, lgf2, lgb2);
    const float decay = exp2f(128.f * (dir == 0 ? lgf2 : lgb2));
    float r = 0.f;
    const long hs = (long)(h * 2 + dir) * 16384 + pos;
    auto chunk_at = [&](int i) -> int {
        if (dir == 0) return i < 2 ? 128 + i : i - 2;
        return i < 2 ? 129 - i : 129 - i;
    };
    for (int i0 = 0; i0 < NCHUNK; i0 += 13) {
        float s[13];
#pragma unroll
        for (int u = 0; u < 13; ++u) s[u] = p.S[(long)chunk_at(i0 + u) * 8 * 16384 + hs];
#pragma unroll
        for (int u = 0; u < 13; ++u) {
            p.R[(long)chunk_at(i0 + u) * 8 * 16384 + hs] = f2bf(r);
            r = decay * r + s[u];
        }
    }
}

DI void phE_item(const Params& p, int layer, int c, int h, int ih, char* smem) {
    const int tid = TIDX(), lane = tid & 63, wid = tid >> 6, wr = wid >> 1, wc = wid & 1, fr = lane & 15, fq = lane >> 4;
    u16* R0 = (u16*)smem;
    u16* R1 = R0 + 64 * 72;
    u16* R2 = R1 + 128 * 72;
    u16* P = (u16*)smem;
    float* red = (float*)(smem + (64 + 128 + 128) * 72 * 2);
    float lgf2, lgb2; ret_gammas(p, layer, h, lgf2, lgb2);
    const u16* base = p.px + (long)c * 128 * INC;
    const u16* qbase = base + (long)ih * 64 * INC + C_QR + h * 128;
    const u16* Rf = p.R + ((long)(c * 4 + h) * 2 + 0) * 16384;
    const u16* Rb = Rf + 16384;
    f32x4 Y[2][4], T[2][4];
    zero_acc<2>(Y); zero_acc<2>(T);
#pragma unroll 1
    for (int dh = 0; dh < 2; ++dh) {
        __syncthreads();
        stage_n64<64>(R0, 72, qbase + dh * 64, INC);
        stage_n64<128>(R1, 72, Rf + dh * 64, 128);
        stage_n64<128>(R2, 72, Rb + dh * 64, 128);
        __syncthreads();
        mma_lds64<2>(Y, R0, 72, R1, 72);
        mma_lds64<2>(T, R0, 72, R2, 72);
    }
#pragma unroll
    for (int m = 0; m < 2; ++m)
#pragma unroll
        for (int j = 0; j < 4; ++j) {
            int i = ih * 64 + wr * 32 + m * 16 + fq * 4 + j;
            float xf = exp2f((float)(i + 1) * lgf2), xb = exp2f((float)(128 - i) * lgb2);
#pragma unroll
            for (int n = 0; n < 4; ++n) Y[m][n][j] = xf * Y[m][n][j] + xb * T[m][n][j];
        }
    zero_acc<2>(T);
#pragma unroll 1
    for (int dh = 0; dh < 2; ++dh) {
        __syncthreads();
        stage_n64<64>(R0, 72, qbase + dh * 64, INC);
        stage_n64<128>(R1, 72, base + C_KR + h * 128 + dh * 64, INC);
        __syncthreads();
        mma_lds64<2>(T, R0, 72, R1, 72);
    }
    __syncthreads();
#pragma unroll
    for (int m = 0; m < 2; ++m)
#pragma unroll
        for (int n = 0; n < 4; ++n)
#pragma unroll
            for (int j = 0; j < 4; ++j) {
                int il = wr * 32 + m * 16 + fq * 4 + j, i = ih * 64 + il, jj = wc * 64 + n * 16 + fr;
                float dm = (i >= jj) ? exp2f((float)(i - jj) * lgf2) : exp2f((float)(jj - i) * lgb2);
                P[il * 136 + jj] = f2bf(T[m][n][j] * dm);
            }
#pragma unroll 1
    for (int jh = 0; jh < 2; ++jh) {
        __syncthreads();
        stage_t64<false, 128>(R2, 72, base + (long)jh * 64 * INC + C_VR + h * 128, INC, 1.f);
        __syncthreads();
        mma_lds64<2>(Y, P + jh * 64, 136, R2, 72);
    }
    float mu[2][4], rs[2][4];
#pragma unroll
    for (int m = 0; m < 2; ++m)
#pragma unroll
        for (int j = 0; j < 4; ++j) {
            float s = Y[m][0][j] + Y[m][1][j] + Y[m][2][j] + Y[m][3][j];
            s += __shfl_xor(s, 1); s += __shfl_xor(s, 2); s += __shfl_xor(s, 4); s += __shfl_xor(s, 8);
            if (fr == 0) red[(wr * 32 + m * 16 + fq * 4 + j) * 2 + wc] = s;
        }
    __syncthreads();
#pragma unroll
    for (int m = 0; m < 2; ++m)
#pragma unroll
        for (int j = 0; j < 4; ++j) { int il = wr * 32 + m * 16 + fq * 4 + j; mu[m][j] = (red[il * 2] + red[il * 2 + 1]) * (1.f / 128.f); }
    __syncthreads();
#pragma unroll
    for (int m = 0; m < 2; ++m)
#pragma unroll
        for (int j = 0; j < 4; ++j) {
            float s = 0.f;
#pragma unroll
            for (int n = 0; n < 4; ++n) { float d = Y[m][n][j] - mu[m][j]; s += d * d; }
            s += __shfl_xor(s, 1); s += __shfl_xor(s, 2); s += __shfl_xor(s, 4); s += __shfl_xor(s, 8);
            if (fr == 0) red[(wr * 32 + m * 16 + fq * 4 + j) * 2 + wc] = s;
        }
    __syncthreads();
#pragma unroll
    for (int m = 0; m < 2; ++m)
#pragma unroll
        for (int j = 0; j < 4; ++j) { int il = wr * 32 + m * 16 + fq * 4 + j; rs[m][j] = rsqrtf((red[il * 2] + red[il * 2 + 1]) * (1.f / 128.f) + 1e-6f); }
    const float* gn = p.ret_gn + layer * 512 + h * 128;
#pragma unroll
    for (int m = 0; m < 2; ++m)
#pragma unroll
        for (int n = 0; n < 4; ++n)
#pragma unroll
            for (int j = 0; j < 4; ++j) {
                int i = ih * 64 + wr * 32 + m * 16 + fq * 4 + j, e = wc * 64 + n * 16 + fr;
                long row = (long)c * 128 + i;
                float g = bf2f(p.px[row * INC + C_GR + h * 128 + e]);
                float o = (Y[m][n][j] - mu[m][j]) * rs[m][j] * gn[e] * siluf_(g);
                p.ya[row * 512 + h * 128 + e] = f2bf(o);
            }
    __syncthreads();
}

DI void phF_tile(const Params& p, int mt, int nt, char* smem) {
    const int tid = TIDX(), lane = tid & 63, wid = tid >> 6, wr = wid >> 1, wc = wid & 1, fr = lane & 15, fq = lane >> 4;
    f32x4 msum[4][4]; zero_acc<4>(msum);
    const int r0 = tid >> 2, ko = (tid & 3) * 8;
#pragma unroll 1
    for (int b = 0; b < 3; ++b) {
        const u16* y = (b == 0 ? p.ya : b == 1 ? p.yb : p.yc);
        const u16* w = (b == 0 ? p.wt_ret : b == 1 ? p.wt_win : p.wt_na);
        f32x4 acc[4][4]; zero_acc<4>(acc);
        const u16* a0 = y + (long)(mt * 128 + r0) * 512 + ko;
        const u16* b0 = w + (long)(nt * 128 + r0) * 512 + ko;
        gemm_core<16>(acc, a0, a0 + 64 * 512, b0, b0 + 64 * 512, smem);
#pragma unroll
        for (int m = 0; m < 4; ++m)
#pragma unroll
            for (int n = 0; n < 4; ++n)
#pragma unroll
                for (int j = 0; j < 4; ++j) {
                    int row = mt * 128 + wr * 64 + m * 16 + fq * 4 + j, col = nt * 128 + wc * 64 + n * 16 + fr;
                    float g = bf2f(p.px[(long)row * INC + C_GATE + b * 1024 + col]);
                    msum[m][n][j] += acc[m][n][j] * sigmoidf_(g);
                }
    }
#pragma unroll
    for (int m = 0; m < 4; ++m)
#pragma unroll
        for (int n = 0; n < 4; ++n)
#pragma unroll
            for (int j = 0; j < 4; ++j) {
                int row = mt * 128 + wr * 64 + m * 16 + fq * 4 + j, col = nt * 128 + wc * 64 + n * 16 + fr;
                p.hx[(long)row * DM + col] = f2bf(msum[m][n][j]);
            }
}
DI void phG_tile(const Params& p, int layer, int mt, int nt, char* smem) {
    const int tid = TIDX(), lane = tid & 63, wid = tid >> 6, wr = wid >> 1, wc = wid & 1, fr = lane & 15, fq = lane >> 4;
    f32x4 acc[4][4]; zero_acc<4>(acc);
    const int r0 = tid >> 2, ko = (tid & 3) * 8;
    const u16* a0 = p.hx + (long)(mt * 128 + r0) * DM + ko;
    const u16* b0 = p.wt_out + (long)(nt * 128 + r0) * DM + ko;
    gemm_core<32>(acc, a0, a0 + 64 * DM, b0, b0 + 64 * DM, smem);
    const bool lat = mt < 128;
    const float* md = p.mod + (layer * 2 + (lat ? 0 : 1)) * 6144 + 2 * 1024;
#pragma unroll
    for (int m = 0; m < 4; ++m)
#pragma unroll
        for (int n = 0; n < 4; ++n)
#pragma unroll
            for (int j = 0; j < 4; ++j) {
                int row = mt * 128 + wr * 64 + m * 16 + fq * 4 + j, col = nt * 128 + wc * 64 + n * 16 + fr;
                const float* xin = resid_row(p, layer, row);
                float* xo = lat ? p.out + (long)row * DM : p.ctxres + (long)(row - NLAT) * DM;
                xo[col] = xin[col] + md[col] * acc[m][n][j];
            }
}

DI void phH_item(const Params& p, int layer, int item, char* smem) {
    const int lane = TIDX() & 63, wid = TIDX() >> 6;
    float* hrow = (float*)smem + wid * 2048;
    const int row0 = item * 8 + wid * 2;
    norm_row(p, layer, row0, cur_row(p, row0), p.g_ffn + layer * DM, 3, 4, p.hx + (long)row0 * DM, hrow);
    norm_row(p, layer, row0 + 1, cur_row(p, row0 + 1), p.g_ffn + layer * DM, 3, 4, p.hx + (long)(row0 + 1) * DM, hrow + 1024);
    const int e = lane & 15, kp = lane >> 4;
    const float* wr_ = p.w_router + (long)layer * 1024 * 16 + e;
    float l0 = 0.f, l1 = 0.f;
#pragma unroll 8
    for (int k = kp * 256; k < kp * 256 + 256; ++k) {
        float w = wr_[k * 16];
        l0 += hrow[k] * w; l1 += hrow[1024 + k] * w;
    }
    l0 += __shfl_xor(l0, 16); l0 += __shfl_xor(l0, 32);
    l1 += __shfl_xor(l1, 16); l1 += __shfl_xor(l1, 32);
#pragma unroll
    for (int r = 0; r < 2; ++r) {
        float lg = r == 0 ? l0 : l1;
        float mx = lg;
        mx = fmaxf(mx, __shfl_xor(mx, 1)); mx = fmaxf(mx, __shfl_xor(mx, 2)); mx = fmaxf(mx, __shfl_xor(mx, 4)); mx = fmaxf(mx, __shfl_xor(mx, 8));
        float ex = expf(lg - mx);
        float sm = ex;
        sm += __shfl_xor(sm, 1); sm += __shfl_xor(sm, 2); sm += __shfl_xor(sm, 4); sm += __shfl_xor(sm, 8);
        float a = ex / sm;
        int row = row0 + r;
        if (lane < 16) {
            if (row < NLAT) p.aff[(long)e * NLAT + row] = a;
            else p.aff[(long)(16 + e) * NLAT + (row - NLAT)] = a;
        }
    }
    __syncthreads();
}

DI int block_excl_scan(int v, int* sh  , int& total) {
    const int lane = TIDX() & 63, wid = TIDX() >> 6;
    int inc = v;
    for (int o = 1; o < 64; o <<= 1) { int t = __shfl_up(inc, o); if (lane >= o) inc += t; }
    __syncthreads();
    if (lane == 63) sh[wid] = inc;
    __syncthreads();
    int base = 0;
    for (int w = 0; w < wid; ++w) base += sh[w];
    total = sh[0] + sh[1] + sh[2] + sh[3];
    return base + inc - v;
}
DI void phI_item(const Params& p, int job, char* smem) {
    const int tid = TIDX();
    const int n = job < 16 ? NLAT : NCTX, cap = job < 16 ? CAP_LAT : CAP_CTX, rowbase = job < 16 ? 0 : NLAT;
    unsigned* keys = (unsigned*)smem;
    int* hist = (int*)(smem + 66560);
    int* sh = hist + 256;
    const float* a = p.aff + (long)job * NLAT;
    __syncthreads();
    for (int i = tid; i < n; i += 256) keys[i + (i >> 6)] = __float_as_uint(a[i]);
    unsigned prefix = 0, mask = 0; int remaining = cap;
    for (int pass = 0; pass < 4; ++pass) {
        const int shift = 24 - 8 * pass;
        hist[tid] = 0;
        __syncthreads();
        for (int i = tid; i < n; i += 256) {
            unsigned k = keys[i + (i >> 6)];
            if ((k & mask) == prefix) atomicAdd(&hist[(k >> shift) & 255], 1);
        }
        __syncthreads();
        if (tid == 0) {
            int cum = 0, b = 255;
            for (; b > 0; --b) { if (cum + hist[b] >= remaining) break; cum += hist[b]; }
            sh[8] = b; sh[9] = remaining - cum;
        }
        __syncthreads();
        prefix |= ((unsigned)sh[8]) << shift; mask |= 255u << shift; remaining = sh[9];
        __syncthreads();
    }
    const unsigned T = prefix;
    const int per = n / 256;
    int ceq = 0;
    for (int i = 0; i < per; ++i) { int idx = tid * per + i; ceq += (keys[idx + (idx >> 6)] == T); }
    int tot;
    int eqb = block_excl_scan(ceq, sh, tot);
    int csel = 0, er = eqb;
    for (int i = 0; i < per; ++i) {
        int idx = tid * per + i; unsigned k = keys[idx + (idx >> 6)];
        if (k > T) ++csel; else if (k == T) { if (er < remaining) ++csel; ++er; }
    }
    int slot = block_excl_scan(csel, sh, tot);
    er = eqb;
    for (int i = 0; i < per; ++i) {
        int idx = tid * per + i; unsigned k = keys[idx + (idx >> 6)];
        bool s = false;
        if (k > T) s = true; else if (k == T) { s = er < remaining; ++er; }
        if (s) { p.sel_idx[job * 2048 + slot] = rowbase + idx; p.sel_gate[job * 2048 + slot] = __uint_as_float(k); ++slot; }
    }
    __syncthreads();
}

DI void phJ_tile(const Params& p, int job, int mt, int nt, char* smem) {
    const int tid = TIDX(), lane = tid & 63, wid = tid >> 6, wr = wid >> 1, wc = wid & 1, fr = lane & 15, fq = lane >> 4;
    const int cap = job < 16 ? CAP_LAT : CAP_CTX, e = job & 15;
    f32x4 acc[4][4]; zero_acc<4>(acc);
    const int r0 = tid >> 2, ko = (tid & 3) * 8;
    int s0 = mt * 128 + r0, s1 = s0 + 64;
    s0 = s0 < cap ? s0 : cap - 1; s1 = s1 < cap ? s1 : cap - 1;
    const u16* a0 = p.hx + (long)p.sel_idx[job * 2048 + s0] * DM + ko;
    const u16* a1 = p.hx + (long)p.sel_idx[job * 2048 + s1] * DM + ko;
    const u16* b0 = p.wt_gu + ((long)e * 2048 + nt * 128 + r0) * DM + ko;
    gemm_core<32>(acc, a0, a1, b0, b0 + 64 * DM, smem);
    u16* hb = job < 16 ? p.hid + (long)job * 2048 * EH : p.hidc + (long)(job - 16) * 32 * EH;
#pragma unroll
    for (int m = 0; m < 4; ++m)
#pragma unroll
        for (int n = 0; n < 2; ++n)
#pragma unroll
            for (int j = 0; j < 4; ++j) {
                int slot = mt * 128 + wr * 64 + m * 16 + fq * 4 + j;
                int f = nt * 64 + wc * 32 + n * 16 + fr;
                if (slot < cap) hb[(long)slot * EH + f] = f2bf(siluf_(acc[m][n][j]) * acc[m][n + 2][j]);
            }
}
DI void phK_tile(const Params& p, int layer, int job, int mt, int nt, char* smem) {
    const int tid = TIDX(), lane = tid & 63, wid = tid >> 6, wr = wid >> 1, wc = wid & 1, fr = lane & 15, fq = lane >> 4;
    const int cap = job < 16 ? CAP_LAT : CAP_CTX, e = job & 15;
    f32x4 acc[4][4]; zero_acc<4>(acc);
    const int r0 = tid >> 2, ko = (tid & 3) * 8;
    int s0 = mt * 128 + r0, s1 = s0 + 64;
    s0 = s0 < cap ? s0 : cap - 1; s1 = s1 < cap ? s1 : cap - 1;
    const u16* hb = job < 16 ? p.hid + (long)job * 2048 * EH : p.hidc + (long)(job - 16) * 32 * EH;
    const u16* a0 = hb + (long)s0 * EH + ko;
    const u16* a1 = hb + (long)s1 * EH + ko;
    const u16* b0 = p.wt_dn + ((long)e * 1024 + nt * 128 + r0) * EH + ko;
    gemm_core<32>(acc, a0, a1, b0, b0 + 64 * EH, smem);
    const float* md = p.mod + (layer * 2 + (job < 16 ? 0 : 1)) * 6144 + 5 * 1024;
#pragma unroll
    for (int m = 0; m < 4; ++m)
#pragma unroll
        for (int j = 0; j < 4; ++j) {
            int slot = mt * 128 + wr * 64 + m * 16 + fq * 4 + j;
            if (slot < cap) {
                int row = p.sel_idx[job * 2048 + slot];
                float g = p.sel_gate[job * 2048 + slot];
                float* xo = row < NLAT ? p.out + (long)row * DM : p.ctxres + (long)(row - NLAT) * DM;
#pragma unroll
                for (int n = 0; n < 4; ++n) {
                    int col = nt * 128 + wc * 64 + n * 16 + fr;
                    unsafeAtomicAdd(xo + col, acc[m][n][j] * g * md[col]);
                }
            }
        }
}

DI void run_phase(const Params& p, int ph, char* smem) {
    const int bid = BIDX(), nb = gridDim.x, tid = TIDX(), wid = tid >> 6;
#ifndef ONLY_SUB
    if (ph == 0) {
        const int total = 192 + 48 + CONV_TILES;
        for (int it = bid; it < total; it += nb) {
            if (it < 192) ph0_gemv_item(p, it, smem);
            else if (it < 240) ph0_rope_item(p, it - 192);
            else convert_tile(p, 0, it - 240, smem);
        }
        return;
    }
    if (ph == NPHASE - 1) {
        for (int it = bid; it < NLAT / 4; it += nb) {
            int row = it * 4 + wid, lane = tid & 63;
            float* xr = p.out + (long)row * DM;
            float4 v[4]; float ss = 0.f;
#pragma unroll
            for (int i = 0; i < 4; ++i) { v[i] = *(const float4*)(xr + i * 256 + lane * 4); ss += v[i].x * v[i].x + v[i].y * v[i].y + v[i].z * v[i].z + v[i].w * v[i].w; }
            ss = wave_sum(ss);
            float rstd = rsqrtf(ss * (1.f / DM) + 1e-6f);
#pragma unroll
            for (int i = 0; i < 4; ++i) {
                float4 g = *(const float4*)(p.g_final + i * 256 + lane * 4);
                *(float4*)(xr + i * 256 + lane * 4) = make_float4(v[i].x * rstd * g.x, v[i].y * rstd * g.y, v[i].z * rstd * g.z, v[i].w * rstd * g.w);
            }
        }
        return;
    }
    const int layer = (ph - 1) / 11, sub = (ph - 1) % 11;
#else
    const int layer = (ph - 1) / 11, sub = ONLY_SUB;
#endif
    const bool need_ctx = layer == 0;
    switch (sub) {
    case 0: {
        const int nrow_items = NROWS / 4;
        const int total = nrow_items + (layer == 1 ? CONV_TILES : 0);
        for (int it = bid; it < total; it += nb) {
            if (it < nrow_items) { int row = it * 4 + wid; norm_row(p, layer, row, resid_row(p, layer, row), p.g_mix + layer * DM, 0, 1, p.hx + (long)row * DM, nullptr); }
            else convert_tile(p, layer, it - nrow_items, smem);
        }
    } break;
    case 1: {
        const int total = 130 * 58;
        for (int it = bid; it < total; it += nb) {
            int g = it / (8 * 58), local = it - g * 8 * 58;
            int gsz = (130 - g * 8) < 8 ? (130 - g * 8) : 8;
            int nt = local / gsz, mt = g * 8 + local % gsz;
            phB_tile(p, mt, nt, smem);
        }
    } break;
    case 2: {
        const int n_state = NCHUNK * 8, n_win = 1024, n_na = 1024, n_cx = need_ctx ? 32 : 0;
        const int total = n_state + n_win + n_na + n_cx;
        for (int it = bid; it < total; it += nb) {
            if (it < n_win) attn_wave_item(p, layer, 0, it >> 1, (it & 1) * 4 + wid, smem);
            else if (it < n_win + n_na) { int i2 = it - n_win; attn_wave_item(p, layer, 1, i2 >> 1, (i2 & 1) * 4 + wid, smem); }
            else if (it < n_win + n_na + n_state) { int i2 = it - n_win - n_na; phC_state_item(p, layer, i2 >> 3, (i2 >> 1) & 3, i2 & 1, smem); }
            else { int i2 = it - n_win - n_na - n_state; int kind = 2 + (i2 >> 4); i2 &= 15; attn_wave_item(p, layer, kind, i2 >> 1, (i2 & 1) * 4 + wid, smem); }
        }
    } break;
    case 3: {
        for (int it = bid; it < 512; it += nb) phD_item(p, layer, it);
    } break;
    case 4: {
        const int nch = need_ctx ? NCHUNK : 128;
        for (int it = bid; it < nch * 8; it += nb) phE_item(p, layer, it >> 3, (it >> 1) & 3, it & 1, smem);
    } break;
    case 5: {
        const int nmt = need_ctx ? 130 : 128;
        for (int it = bid; it < nmt * 8; it += nb) phF_tile(p, it >> 3, it & 7, smem);
    } break;
    case 6: {
        const int nmt = need_ctx ? 130 : 128;
        for (int it = bid; it < nmt * 8; it += nb) phG_tile(p, layer, it >> 3, it & 7, smem);
    } break;
    case 7: {
        const int nit = (need_ctx ? NROWS : NLAT) / 8;
        for (int it = bid; it < nit; it += nb) phH_item(p, layer, it, smem);
    } break;
    case 8: {
        const int njob = need_ctx ? 32 : 16;
        for (int it = bid; it < njob; it += nb) phI_item(p, it, smem);
    } break;
    case 9: {
        const int total = 4096 + (need_ctx ? 256 : 0);
        for (int it = bid; it < total; it += nb) {
            if (it < 4096) phJ_tile(p, it >> 8, (it >> 4) & 15, it & 15, smem);
            else { int i2 = it - 4096; phJ_tile(p, 16 + (i2 >> 4), 0, i2 & 15, smem); }
        }
    } break;
    case 10: {
        const int total = 2048 + (need_ctx ? 128 : 0);
        for (int it = bid; it < total; it += nb) {
            if (it < 2048) phK_tile(p, layer, it >> 7, (it >> 3) & 15, it & 7, smem);
            else { int i2 = it - 2048; phK_tile(p, layer, 16 + (i2 >> 3), 0, i2 & 7, smem); }
        }
    } break;
    }
}

__global__ void __launch_bounds__(NTHREADS, 2) mega_kernel(Params p, int ph_lo, int ph_hi) {
    __shared__ __attribute__((aligned(16))) char smem[LDS_BYTES];
    cg::grid_group grid = cg::this_grid();
    for (int ph = ph_lo; ph < ph_hi; ++ph) {
        if (ph > ph_lo) grid.sync();
        run_phase(p, ph, smem);
#ifdef PROBE_SUB
        if (ph >= 1 && ph < NPHASE - 1 && ((ph - 1) % 11) == PROBE_SUB) { grid.sync(); run_phase(p, ph, smem); }
#endif
    }
}

extern "C" void kernel_launch(void* const* d_in, const int* in_sizes, int n_in, void* d_out, int out_size, void* d_ws, size_t ws_size,
                              hipStream_t stream) {
    static int grid_blocks = 0;
    if (!grid_blocks) {
        int dev = 0, cus = 0, per_cu = 0;
        hipGetDevice(&dev);
        hipDeviceGetAttribute(&cus, hipDeviceAttributeMultiprocessorCount, dev);
        hipOccupancyMaxActiveBlocksPerMultiprocessor(&per_cu, mega_kernel, NTHREADS, 0);
        if (per_cu < 1) per_cu = 1;
        if (per_cu > 2) per_cu = 2;
        grid_blocks = cus * per_cu;
    }
    Params p{};
    const float** ip = (const float**)&p.x;
    for (int i = 0; i < 22; ++i) ip[i] = (const float*)d_in[i];
    p.out = (float*)d_out;
    char* w = (char*)d_ws;
    size_t off = 0;
    auto take = [&](size_t bytes) { char* r = w + off; off += (bytes + 255) & ~(size_t)255; return r; };
    p.ctxres = (float*)take((size_t)NCTX * DM * 4);
    p.mod = (float*)take(2 * 2 * 6144 * 4);
    p.rope128 = (float2*)take(256 * 32 * 8);
    p.rope64 = (float2*)take(256 * 16 * 8);
    p.wt_in = (u16*)take((size_t)INC * DM * 2);
    p.wt_ret = (u16*)take((size_t)1024 * 512 * 2);
    p.wt_win = (u16*)take((size_t)1024 * 512 * 2);
    p.wt_na = (u16*)take((size_t)1024 * 512 * 2);
    p.wt_out = (u16*)take((size_t)1024 * 1024 * 2);
    p.wt_gu = (u16*)take((size_t)NEXP * 2048 * 1024 * 2);
    p.wt_dn = (u16*)take((size_t)NEXP * 1024 * 1024 * 2);
    p.hx = (u16*)take((size_t)NROWS * DM * 2);
    p.px = (u16*)take((size_t)NROWS * INC * 2);
    p.hid = p.px;
    p.hidc = p.px + (size_t)NEXP * 2048 * 1024;
    p.ya = (u16*)take((size_t)NROWS * 512 * 2);
    p.yb = (u16*)take((size_t)NROWS * 512 * 2);
    p.yc = (u16*)take((size_t)NROWS * 512 * 2);
    p.S = (float*)take((size_t)NCHUNK * 8 * 16384 * 4);
    p.R = (u16*)take((size_t)NCHUNK * 8 * 16384 * 2);
    p.aff = (float*)take((size_t)32 * NLAT * 4);
    p.sel_idx = (int*)take(32 * 2048 * 4);
    p.sel_gate = (float*)take(32 * 2048 * 4);
    if (off > ws_size) { fprintf(stderr, "kernel_launch: workspace too small: need %zu have %zu\n", off, ws_size); return; }
#if MK_MULTI
    for (int ph = 0; ph < NPHASE; ++ph) {
        hipLaunchKernelGGL(mega_kernel, dim3(grid_blocks), dim3(NTHREADS), 0, stream, p, ph, ph + 1);
    }
#else
    int lo = 0, hi = NPHASE;
    void* args[] = {&p, &lo, &hi};
    hipError_t e = hipLaunchCooperativeKernel((void*)mega_kernel, dim3(grid_blocks), dim3(NTHREADS), args, 0, stream);
    if (e != hipSuccess) fprintf(stderr, "cooperative launch failed: %s (grid %d)\n", hipGetErrorString(e), grid_blocks);
#endif
}
```

```cpp
#include <hip/hip_runtime.h>
#include <hip/hip_bf16.h>
#include <hip/hip_cooperative_groups.h>
#include <cstdio>
#include <cstdint>
namespace cg = cooperative_groups;

#ifndef MK_MULTI
#define MK_MULTI 0
#endif

#define DI __device__ __forceinline__
typedef unsigned short u16;
typedef __attribute__((ext_vector_type(8))) short bf16x8;
typedef __attribute__((ext_vector_type(4))) float f32x4;
typedef __attribute__((ext_vector_type(4))) unsigned int u32x4;

constexpr int NLAT = 16384, NCTX = 256, NROWS = NLAT + NCTX, DM = 1024, INC = 7424;
constexpr int C_QR = 0, C_KR = 512, C_VR = 1024, C_GR = 1536, C_QW = 2048, C_KW = 2560, C_VW = 2688, C_QN = 2816, C_KN = 3328, C_VN = 3840, C_GATE = 4352;
constexpr int NCHUNK = NROWS / 128;
constexpr int NEXP = 16, EH = 1024, CAP_LAT = 2048, CAP_CTX = 32;
constexpr int NTHREADS = 512;
constexpr int SUB_LDS = 76 * 1024;
constexpr int LDS_BYTES = 2 * SUB_LDS;
constexpr int NPHASE = 24;


constexpr size_t al256(size_t b) { return (b + 255) & ~(size_t)255; }
constexpr size_t WS_CTXRES = 0;
constexpr size_t WS_MOD = WS_CTXRES + al256((size_t)NCTX * DM * 4);
constexpr size_t WS_ROPE128 = WS_MOD + al256(2 * 2 * 6144 * 4);
constexpr size_t WS_ROPE64 = WS_ROPE128 + al256(256 * 32 * 8);
constexpr size_t WS_WT_IN = WS_ROPE64 + al256(256 * 16 * 8);
constexpr size_t WS_WT_RET = WS_WT_IN + al256((size_t)INC * DM * 2);
constexpr size_t WS_WT_WIN = WS_WT_RET + al256((size_t)1024 * 512 * 2);
constexpr size_t WS_WT_NA = WS_WT_WIN + al256((size_t)1024 * 512 * 2);
constexpr size_t WS_WT_OUT = WS_WT_NA + al256((size_t)1024 * 512 * 2);
constexpr size_t WS_WT_GU = WS_WT_OUT + al256((size_t)1024 * 1024 * 2);
constexpr size_t WS_WT_DN = WS_WT_GU + al256((size_t)NEXP * 2048 * 1024 * 2);
constexpr size_t WS_HX = WS_WT_DN + al256((size_t)NEXP * 1024 * 1024 * 2);
constexpr size_t WS_PX = WS_HX + al256((size_t)NROWS * DM * 2);
constexpr size_t WS_YA = WS_PX + al256((size_t)NROWS * INC * 2);
constexpr size_t WS_YB = WS_YA + al256((size_t)NROWS * 512 * 2);
constexpr size_t WS_YC = WS_YB + al256((size_t)NROWS * 512 * 2);
constexpr size_t WS_S = WS_YC + al256((size_t)NROWS * 512 * 2);
constexpr size_t WS_R = WS_S + al256((size_t)NCHUNK * 8 * 16384 * 4);
constexpr size_t WS_AFF = WS_R + al256((size_t)NCHUNK * 8 * 16384 * 2);
constexpr size_t WS_SELI = WS_AFF + al256((size_t)32 * NLAT * 4);
constexpr size_t WS_SELG = WS_SELI + al256(32 * 2048 * 4);
constexpr size_t WS_TSLOT = WS_SELG + al256(32 * 2048 * 4);
constexpr size_t WS_END = WS_TSLOT + al256((size_t)32 * NLAT * 4);
struct Params {
    const float *x, *c, *ctx, *c_ctx, *w_mod, *b_mod, *g_mix, *g_ffn, *w_in, *decay, *ret_gn, *w_ret, *sink, *w_win, *rpb, *w_na, *w_out,
        *w_router, *w_eg, *w_eu, *w_ed, *g_final;
    float* out;
    char* ws;
};
typedef const Params __attribute__((address_space(4)))* KP;
#define WSF(name, type, off) __device__ __forceinline__ type* P_##name(KP p) { return (type*)(p->ws + (off)); }
WSF(ctxres, float, WS_CTXRES)
WSF(mod, float, WS_MOD)
WSF(rope128, float2, WS_ROPE128)
WSF(rope64, float2, WS_ROPE64)
WSF(wt_in, u16, WS_WT_IN) WSF(wt_ret, u16, WS_WT_RET) WSF(wt_win, u16, WS_WT_WIN) WSF(wt_na, u16, WS_WT_NA) WSF(wt_out, u16, WS_WT_OUT)
WSF(wt_gu, u16, WS_WT_GU) WSF(wt_dn, u16, WS_WT_DN)
WSF(hx, u16, WS_HX)
WSF(px, u16, WS_PX)
WSF(ya, u16, WS_YA) WSF(yb, u16, WS_YB) WSF(yc, u16, WS_YC)
WSF(S, float, WS_S)
WSF(R, u16, WS_R)
WSF(aff, float, WS_AFF)
WSF(sel_idx, int, WS_SELI) WSF(sel_gate, float, WS_SELG)
WSF(hid, u16, WS_PX)
__device__ __forceinline__ u16* P_hidc(KP p) { return (u16*)(p->ws + WS_PX) + (size_t)NEXP * 2048 * 1024; }
__device__ __forceinline__ u16* P_ye(KP p) { return (u16*)(p->ws + WS_PX) + (size_t)NEXP * (2048 + 32) * 1024; }
__device__ __forceinline__ u16* P_yec(KP p) { return P_ye(p) + (size_t)NEXP * 2048 * 1024; }
__device__ __forceinline__ int* P_tslot(KP p) { return (int*)(p->ws + WS_TSLOT); }
__device__ __forceinline__ u16* P_z(KP p) { return (u16*)(p->ws + WS_S); }
__device__ __forceinline__ float* P_maccx(KP p) { return (float*)(p->ws + WS_S + (size_t)3 * NLAT * DM * 2); }
#undef WSF


DI int TIDX() { int t = threadIdx.x & 255; asm volatile("" : "+v"(t)); return t; }
DI int TID512() { int t = threadIdx.x; asm volatile("" : "+v"(t)); return t; }
DI int BIDX() { int t = blockIdx.x; asm volatile("" : "+s"(t)); return t; }
DI u16 f2bf(float x) { unsigned u = __float_as_uint(x); u += 0x7fffu + ((u >> 16) & 1u); return (u16)(u >> 16); }
DI float bf2f(u16 h) { return __uint_as_float(((unsigned)h) << 16); }
DI float bflo(unsigned w) { return __uint_as_float(w << 16); }
DI float bfhi(unsigned w) { return __uint_as_float(w & 0xffff0000u); }
typedef __bf16 bf16v2 __attribute__((ext_vector_type(2)));
typedef float f32v2 __attribute__((ext_vector_type(2)));
DI unsigned pack2(float a, float b) { f32v2 v = {a, b}; bf16v2 r = __builtin_convertvector(v, bf16v2); return __builtin_bit_cast(unsigned, r); }
DI float sigmoidf_(float x) { return 1.f / (1.f + __expf(-x)); }
DI float siluf_(float x) { return x / (1.f + __expf(-x)); }
DI float wave_sum(float v) { for (int o = 32; o > 0; o >>= 1) v += __shfl_xor(v, o); return v; }
#define MFMA16(a, b, c) __builtin_amdgcn_mfma_f32_16x16x32_bf16((a), (b), (c), 0, 0, 0)

template <int MR>
DI void zero_acc(f32x4 (&acc)[MR][4]) {
#pragma unroll
    for (int m = 0; m < MR; ++m)
#pragma unroll
        for (int n = 0; n < 4; ++n) acc[m][n] = f32x4{0.f, 0.f, 0.f, 0.f};
}

template <int KT>
DI void gemm_core(f32x4 (&acc)[4][4], const u16* a0, const u16* a1, const u16* b0, const u16* b1, char* smem) {
    const int tid = TIDX(), lane = tid & 63, wid = tid >> 6, wr = wid >> 1, wc = wid & 1, fr = lane & 15, fq = lane >> 4;
    auto stage = [&](int kt, int buf) {
        char* base = smem + buf * 16384;
        __builtin_amdgcn_global_load_lds((const unsigned*)(a0 + kt * 32), (unsigned*)(base + tid * 16), 16, 0, 0);
        __builtin_amdgcn_global_load_lds((const unsigned*)(a1 + kt * 32), (unsigned*)(base + 4096 + tid * 16), 16, 0, 0);
        __builtin_amdgcn_global_load_lds((const unsigned*)(b0 + kt * 32), (unsigned*)(base + 8192 + tid * 16), 16, 0, 0);
        __builtin_amdgcn_global_load_lds((const unsigned*)(b1 + kt * 32), (unsigned*)(base + 12288 + tid * 16), 16, 0, 0);
    };
    __syncthreads();
    stage(0, 0);
    for (int kt = 0; kt < KT; ++kt) {
        asm volatile("s_waitcnt vmcnt(0)" ::: "memory");
        __syncthreads();
        if (kt + 1 < KT) stage(kt + 1, (kt + 1) & 1);
        const char* SA = smem + (kt & 1) * 16384;
        const char* SB = SA + 8192;
        bf16x8 At[4], Bt[4];
#pragma unroll
        for (int m = 0; m < 4; ++m) At[m] = *(const bf16x8*)(SA + (wr * 64 + m * 16 + fr) * 64 + fq * 16);
#pragma unroll
        for (int n = 0; n < 4; ++n) Bt[n] = *(const bf16x8*)(SB + (wc * 64 + n * 16 + fr) * 64 + fq * 16);
#pragma unroll
        for (int m = 0; m < 4; ++m)
#pragma unroll
            for (int n = 0; n < 4; ++n) acc[m][n] = MFMA16(At[m], Bt[n], acc[m][n]);
    }
}

template <int MR>
DI void mma_lds64(f32x4 (&acc)[MR][4], const u16* As, int lda, const u16* Bs, int ldb) {
    const int tid = TIDX(), lane = tid & 63, wid = tid >> 6, wr = wid >> 1, wc = wid & 1, fr = lane & 15, fq = lane >> 4;
#pragma unroll
    for (int kk = 0; kk < 2; ++kk) {
        bf16x8 At[MR], Bt[4];
#pragma unroll
        for (int m = 0; m < MR; ++m) At[m] = *(const bf16x8*)(As + (wr * (MR * 16) + m * 16 + fr) * lda + kk * 32 + fq * 8);
#pragma unroll
        for (int n = 0; n < 4; ++n) Bt[n] = *(const bf16x8*)(Bs + (wc * 64 + n * 16 + fr) * ldb + kk * 32 + fq * 8);
#pragma unroll
        for (int m = 0; m < MR; ++m)
#pragma unroll
            for (int n = 0; n < 4; ++n) acc[m][n] = MFMA16(At[m], Bt[n], acc[m][n]);
    }
}
template <int ROWS>
DI void stage_n64(u16* dst, int ld, const u16* src, long sstride) {
    const int tid = TIDX();
#pragma unroll
    for (int i = 0; i < ROWS / 32; ++i) {
        int idx = i * 256 + tid, row = idx >> 3, ch = idx & 7;
        u32x4 v = *(const u32x4*)(src + (long)row * sstride + ch * 8);
        *(u32x4*)(dst + row * ld + ch * 8) = v;
    }
}
template <bool SCALE, int NF>
DI void stage_t64(u16* dst, int ld, const u16* src, long sstride, float scale_tok_lane  ) {
    const int tid = TIDX();
#pragma unroll
    for (int i = 0; i < NF / 32; ++i) {
        int idx = i * 256 + tid, jj = idx & 63, ch = idx >> 6;
        u32x4 v = *(const u32x4*)(src + (long)jj * sstride + ch * 8);
#pragma unroll
        for (int e = 0; e < 4; ++e) {
            float lo = bflo(v[e]), hi = bfhi(v[e]);
            if (SCALE) { lo *= scale_tok_lane; hi *= scale_tok_lane; }
            dst[(ch * 8 + 2 * e) * ld + jj] = SCALE ? f2bf(lo) : (u16)(v[e] & 0xffffu);
            dst[(ch * 8 + 2 * e + 1) * ld + jj] = SCALE ? f2bf(hi) : (u16)(v[e] >> 16);
        }
    }
}

DI void convert_tile(KP p, int layer, int tile, char* smem);

DI void ph0_gemv_item(KP p, int item, char* smem) {
    const int tid = TIDX();
    const int l = item / 96, cg_ = item % 96;
    float* sl = (float*)smem;
    float* red = (float*)(smem + 8192);
    __syncthreads();
    for (int k = tid; k < 1024; k += 256) { sl[k] = siluf_(p->c[k]); sl[1024 + k] = siluf_(p->c_ctx[k]); }
    __syncthreads();
    const int c4 = tid & 15, kp = tid >> 4;
    const int col = cg_ * 64 + c4 * 4;
    const float* w = p->w_mod + (long)l * 1024 * 6144 + col;
    float a0[4] = {0, 0, 0, 0}, a1[4] = {0, 0, 0, 0};
#pragma unroll 8
    for (int kk = 0; kk < 64; ++kk) {
        int k = kp * 64 + kk;
        float4 wv = *(const float4*)(w + (long)k * 6144);
        float s0 = sl[k], s1 = sl[1024 + k];
        a0[0] += s0 * wv.x; a0[1] += s0 * wv.y; a0[2] += s0 * wv.z; a0[3] += s0 * wv.w;
        a1[0] += s1 * wv.x; a1[1] += s1 * wv.y; a1[2] += s1 * wv.z; a1[3] += s1 * wv.w;
    }
#pragma unroll
    for (int j = 0; j < 4; ++j) { red[(kp * 2 + 0) * 64 + c4 * 4 + j] = a0[j]; red[(kp * 2 + 1) * 64 + c4 * 4 + j] = a1[j]; }
    __syncthreads();
    if (tid < 128) {
        int src = tid >> 6, cr = tid & 63;
        float s = 0.f;
        for (int q = 0; q < 16; ++q) s += red[(q * 2 + src) * 64 + cr];
        int n = cg_ * 64 + cr;
        P_mod(p)[(l * 2 + src) * 6144 + n] = s + p->b_mod[l * 6144 + n];
    }
}
DI void sincos_d(double a, float& c, float& s) {
    const double TWO_PI = 6.283185307179586476925286766559;
    double k = rint(a / TWO_PI);
    double r = a - k * TWO_PI;
    double r2 = r * r;
    double ts = r, tc = 1.0, ss = r, cc = 1.0;
    for (int i = 1; i <= 14; ++i) {
        tc = -tc * r2 / (double)((2 * i - 1) * (2 * i));
        ts = -ts * r2 / (double)((2 * i) * (2 * i + 1));
        cc += tc; ss += ts;
    }
    c = (float)cc; s = (float)ss;
}
DI void ph0_rope_item(KP p, int item) {
    int idx = item * 256 + TIDX();
    const double LN_BASE = 9.210340371976184;
    if (idx < 8192) {
        int pos = idx >> 5, f = idx & 31;
        float inv = (float)exp(-(double)f / 32.0 * LN_BASE);
        float ang = (float)pos * inv;
        float c, s; sincos_d((double)ang, c, s);
        P_rope128(p)[idx] = make_float2(c, s);
    } else {
        int i2 = idx - 8192;
        int pos = i2 >> 4, f = i2 & 15;
        float inv = (float)exp(-(double)f / 16.0 * LN_BASE);
        float ang = (float)pos * inv;
        float c, s; sincos_d((double)ang, c, s);
        P_rope64(p)[i2] = make_float2(c, s);
    }
}

constexpr int CONV_TILES = 1856 + 384 + 256 + 12288;
DI void convert_tile(KP p, int layer, int tile, char* smem) {
    const int tid = TIDX();
    const float* src; u16* dst; int K, N, mode = 0;
    if (tile < 1856) { src = p->w_in + (long)layer * 1024 * INC; dst = P_wt_in(p); K = 1024; N = INC; mode = 1; }
    else if (tile < 1856 + 384) {
        int t = tile - 1856, which = t / 128; tile = t % 128; K = 512; N = 1024;
        src = (which == 0 ? p->w_ret : which == 1 ? p->w_win : p->w_na) + (long)layer * 512 * 1024;
        dst = (which == 0 ? P_wt_ret(p) : which == 1 ? P_wt_win(p) : P_wt_na(p));
    } else if (tile < 1856 + 384 + 256) { tile -= 1856 + 384; src = p->w_out + (long)layer * 1024 * 1024; dst = P_wt_out(p); K = 1024; N = 1024; }
    else {
        int t = tile - (1856 + 384 + 256), which = t / 4096, e = (t % 4096) / 256; tile = t % 256; K = 1024; N = 1024;
        long eo = ((long)layer * NEXP + e) * 1024 * 1024;
        if (which == 0) { src = p->w_eg + eo; dst = P_wt_gu(p) + (long)e * 2048 * 1024; mode = 2; }
        else if (which == 1) { src = p->w_eu + eo; dst = P_wt_gu(p) + (long)e * 2048 * 1024; mode = 3; }
        else { src = p->w_ed + eo; dst = P_wt_dn(p) + (long)e * 1024 * 1024; }
    }
    const int ntn = N / 64;
    const int k0 = (tile / ntn) * 64, n0 = (tile % ntn) * 64;
    float* T = (float*)smem;
    __syncthreads();
#pragma unroll
    for (int i = 0; i < 4; ++i) {
        int kk = (tid >> 4) + 16 * i, n4 = tid & 15;
        float4 v = *(const float4*)(src + (long)(k0 + kk) * N + n0 + n4 * 4);
        T[kk * 65 + n4 * 4 + 0] = v.x; T[kk * 65 + n4 * 4 + 1] = v.y; T[kk * 65 + n4 * 4 + 2] = v.z; T[kk * 65 + n4 * 4 + 3] = v.w;
    }
    __syncthreads();
#pragma unroll
    for (int i = 0; i < 2; ++i) {
        int nn = (tid >> 3) + 32 * i, k8 = tid & 7;
        u32x4 o;
#pragma unroll
        for (int e = 0; e < 4; ++e) o[e] = pack2(T[(k8 * 8 + 2 * e) * 65 + nn], T[(k8 * 8 + 2 * e + 1) * 65 + nn]);
        int n = n0 + nn, drow = n;
        if (mode == 1) {
            if (n < 1024) { int o_ = n & 127, s_ = (o_ < 32) ? o_ : (o_ < 64) ? o_ + 32 : (o_ < 96) ? o_ - 32 : o_; drow = (n & ~127) + s_; }
        } else if (mode == 2) drow = (n >> 7) * 256 + (n & 127);
        else if (mode == 3) drow = (n >> 7) * 256 + 128 + (n & 127);
        *(u32x4*)(dst + (long)drow * K + k0 + k8 * 8) = o;
    }
}

DI const float* resid_row(KP p, int layer, int row) {
    if (row < NLAT) return (layer == 0 ? p->x : p->out) + (long)row * DM;
    return (layer == 0 ? p->ctx : P_ctxres(p)) + (long)(row - NLAT) * DM;
}
DI const float* cur_row(KP p, int row) { return row < NLAT ? p->out + (long)row * DM : P_ctxres(p) + (long)(row - NLAT) * DM; }
DI void moe_combine(KP p, int row, float4 (&v)[4]) {
    const int lane = TIDX() & 63;
    const bool lat = row < NLAT;
    const int* ts = P_tslot(p) + (lat ? 0 : 16) * (long)NLAT + (lat ? row : row - NLAT);
    const u16* yb_ = lat ? P_ye(p) : P_yec(p);
    const int cap = lat ? CAP_LAT : CAP_CTX;
#pragma unroll 4
    for (int e = 0; e < NEXP; ++e) {
        const int slot = ts[(long)e * NLAT];
        if (slot >= 0) {
            const u16* yr = yb_ + ((long)e * cap + slot) * DM + lane * 4;
#pragma unroll
            for (int i = 0; i < 4; ++i) {
                uint2 w = *(const uint2*)(yr + i * 256);
                v[i].x += bflo(w.x); v[i].y += bfhi(w.x); v[i].z += bflo(w.y); v[i].w += bfhi(w.y);
            }
        }
    }
}
DI void norm_row(KP p, int layer, int row, const float* xr, const float* g, int shift_idx, int scale_idx, u16* dst_row, float* keep  , float* wb  ) {
    const int lane = TIDX() & 63;
    const float* md = P_mod(p) + (layer * 2 + (row < NLAT ? 0 : 1)) * 6144;
    float4 v[4]; float ss = 0.f;
#pragma unroll
    for (int i = 0; i < 4; ++i) v[i] = *(const float4*)(xr + i * 256 + lane * 4);
    if (wb) {
        moe_combine(p, row, v);
#pragma unroll
        for (int i = 0; i < 4; ++i) *(float4*)(wb + i * 256 + lane * 4) = v[i];
    }
#pragma unroll
    for (int i = 0; i < 4; ++i) ss += v[i].x * v[i].x + v[i].y * v[i].y + v[i].z * v[i].z + v[i].w * v[i].w;
    ss = wave_sum(ss);
    float rstd = rsqrtf(ss * (1.f / DM) + 1e-6f);
#pragma unroll
    for (int i = 0; i < 4; ++i) {
        int c0 = i * 256 + lane * 4;
        float4 gg = *(const float4*)(g + c0), sh = *(const float4*)(md + shift_idx * 1024 + c0), sc = *(const float4*)(md + scale_idx * 1024 + c0);
        float o0 = v[i].x * rstd * gg.x * (1.f + sc.x) + sh.x, o1 = v[i].y * rstd * gg.y * (1.f + sc.y) + sh.y;
        float o2 = v[i].z * rstd * gg.z * (1.f + sc.z) + sh.z, o3 = v[i].w * rstd * gg.w * (1.f + sc.w) + sh.w;
        uint2 pk; pk.x = pack2(o0, o1); pk.y = pack2(o2, o3);
        *(uint2*)(dst_row + c0) = pk;
        if (keep) *(float4*)(keep + c0) = make_float4(o0, o1, o2, o3);
    }
}

DI void phB_tile(KP p, int mt, int nt, char* smem) {
    const int tid = TIDX(), lane = tid & 63, wid = tid >> 6, wr = wid >> 1, wc = wid & 1, fr = lane & 15, fq = lane >> 4;
    f32x4 acc[4][4]; zero_acc<4>(acc);
    const int r0 = tid >> 2, ko = (tid & 3) * 8;
    const u16* a0 = P_hx(p) + (long)(mt * 128 + r0) * DM + ko;
    const u16* b0 = P_wt_in(p) + (long)(nt * 128 + r0) * DM + ko;
    gemm_core<32>(acc, a0, a0 + 64 * DM, b0, b0 + 64 * DM, smem);
    const bool lat = mt < 128;
    const int type = (nt < 8) ? 1 : (nt >= 16 && nt < 21) ? 2 : 0;
    if (type != 0 && lat) {
#pragma unroll
        for (int m = 0; m < 4; ++m)
#pragma unroll
            for (int j = 0; j < 4; ++j) {
                int t = mt * 128 + wr * 64 + m * 16 + fq * 4 + j;
                int pr = t >> 6, pc = t & 63;
#pragma unroll
                for (int n = 0; n < 2; ++n) {
                    float2 cs;
                    if (type == 1) { int pos = (wc == 0) ? pr : pc; cs = P_rope128(p)[pos * 32 + n * 16 + fr]; }
                    else { int pos = (n == 0) ? pr : pc; cs = P_rope64(p)[pos * 16 + fr]; }
                    float x1 = acc[m][n][j], x2 = acc[m][n + 2][j];
                    acc[m][n][j] = x1 * cs.x - x2 * cs.y;
                    acc[m][n + 2][j] = x1 * cs.y + x2 * cs.x;
                }
            }
    }
    const float mul = (nt >= 4 && nt < 8) ? 0.08838834764831845f : ((nt >= 16 && nt < 20) || (nt >= 22 && nt < 26)) ? 0.125f : 1.f;
#pragma unroll
    for (int m = 0; m < 4; ++m)
#pragma unroll
        for (int n = 0; n < 4; ++n)
#pragma unroll
            for (int j = 0; j < 4; ++j) {
                int row = mt * 128 + wr * 64 + m * 16 + fq * 4 + j, col = nt * 128 + wc * 64 + n * 16 + fr;
                P_px(p)[(long)row * INC + col] = f2bf(acc[m][n][j] * mul);
            }
}

typedef __attribute__((ext_vector_type(16))) float f32x16;
typedef short v4s __attribute__((ext_vector_type(4)));
typedef __attribute__((address_space(3))) v4s* lds_v4s_ptr;
#define MFMA32(a, b, c) __builtin_amdgcn_mfma_f32_32x32x16_bf16((a), (b), (c), 0, 0, 0)
constexpr float LOG2E = 1.4426950408889634f;

struct FA {
    bf16x8 qf[4];
    f32x16 o[2];
    float m, l;
};
DI void fa_stage(u16* Ks, u16* Vs, const u16* px, int rowstart, int colK1, int colK2, int colV) {
    const int lane = TIDX() & 63;
#pragma unroll
    for (int i = 0; i < 8; ++i) {
        int idx = i * 64 + lane, key = idx >> 3, ch = idx & 7;
        const u16* src = px + (long)(rowstart + key) * INC;
        u32x4 kv = *(const u32x4*)(src + (ch < 4 ? colK1 + ch * 8 : colK2 + (ch - 4) * 8));
        u32x4 vv = *(const u32x4*)(src + colV + ch * 8);
        *(u32x4*)(Ks + key * 72 + ch * 8) = kv;
        *(u32x4*)(Vs + key * 72 + ch * 8) = vv;
    }
}
template <int MODE>
DI void fa_tile(FA& st, const u16* Ks, const u16* Vs, int a0, const float* rrow) {
    const int lane = TIDX() & 63, c = lane & 31, hh = lane >> 5;
    const u16* kbase = Ks + c * 72 + hh * 8;
    const u16* vbase = Vs + (4 * hh + ((lane & 15) >> 2)) * 72 + 16 * ((lane >> 4) & 1) + 4 * (lane & 3);
    f32x16 s[2];
#pragma unroll
    for (int kb = 0; kb < 2; ++kb) {
#pragma unroll
        for (int r = 0; r < 16; ++r) s[kb][r] = 0.f;
#pragma unroll
        for (int ks = 0; ks < 4; ++ks) {
            bf16x8 A = *(const bf16x8*)(kbase + kb * 32 * 72 + ks * 16);
            s[kb] = MFMA32(A, st.qf[ks], s[kb]);
        }
    }
    float mx = -3.0e38f;
    const int cq = a0 + c;
    int cs = cq - 8; cs = cs < 0 ? 0 : (cs > 48 ? 48 : cs);
#pragma unroll
    for (int kb = 0; kb < 2; ++kb)
#pragma unroll
        for (int r = 0; r < 16; ++r) {
            const int j = kb * 32 + (r & 3) + 8 * (r >> 2) + 4 * hh;
            float v = s[kb][r];
            if (MODE == 1) { int d = a0 + j - c; v = (d >= -128 && d <= 128) ? v : -1e30f; }
            if (MODE == 2) { bool ok = (j >= cs) && (j < cs + 16); int ci = j - cq + 15; ci = ci < 0 ? 0 : (ci > 30 ? 30 : ci); v = ok ? v + rrow[ci] : -1e30f; }
            v *= LOG2E;
            s[kb][r] = v;
            mx = fmaxf(mx, v);
        }
    mx = fmaxf(mx, __shfl_xor(mx, 32));
    const float mn = fmaxf(st.m, mx);
    const float alpha = __builtin_amdgcn_exp2f(st.m - mn);
    float ls = 0.f;
#pragma unroll
    for (int kb = 0; kb < 2; ++kb)
#pragma unroll
        for (int r = 0; r < 16; ++r) { float pv = __builtin_amdgcn_exp2f(s[kb][r] - mn); s[kb][r] = pv; ls += pv; }
    st.l = st.l * alpha + ls; st.m = mn;
#pragma unroll
    for (int db = 0; db < 2; ++db)
#pragma unroll
        for (int r = 0; r < 16; ++r) st.o[db][r] *= alpha;
    bf16x8 pf[2][2];
#pragma unroll
    for (int kb = 0; kb < 2; ++kb)
#pragma unroll
        for (int k2 = 0; k2 < 2; ++k2) {
            u32x4 w;
#pragma unroll
            for (int e = 0; e < 4; ++e) w[e] = pack2(s[kb][8 * k2 + 2 * e], s[kb][8 * k2 + 2 * e + 1]);
            pf[kb][k2] = __builtin_bit_cast(bf16x8, w);
        }
#pragma unroll
    for (int db = 0; db < 2; ++db)
#pragma unroll
        for (int kb = 0; kb < 2; ++kb)
#pragma unroll
            for (int k2 = 0; k2 < 2; ++k2) {
                const u16* alo = vbase + (kb * 32 + 16 * k2) * 72 + db * 32;
                v4s lo = __builtin_amdgcn_ds_read_tr16_b64_v4i16((lds_v4s_ptr)alo);
                v4s hi = __builtin_amdgcn_ds_read_tr16_b64_v4i16((lds_v4s_ptr)(alo + 8 * 72));
                bf16x8 A = __builtin_shufflevector(lo, hi, 0, 1, 2, 3, 4, 5, 6, 7);
                st.o[db] = MFMA32(A, pf[kb][k2], st.o[db]);
            }
}
DI void attn_wave_item(KP p, int layer, int kind, int blk, int h, char* smem) {
    const int lane = TIDX() & 63, wid = TIDX() >> 6, c = lane & 31, hh = lane >> 5;
    u16* Ks = (u16*)(smem + wid * 19456);
    u16* Vs = Ks + 64 * 72;
    float* rpbs = (float*)(smem + wid * 19456 + 18432);
    const bool isna = (kind == 1 || kind == 3);
    const int q0 = ((kind >= 2) ? NLAT : 0) + blk * 32;
    const int colQ1 = isna ? C_QN + h * 64 : C_QW + h * 64, colQ2 = colQ1 + 32;
    const int kvh = isna ? h : (h >> 2);
    const int colK1 = isna ? C_KN + kvh * 64 : C_KW + kvh * 64, colK2 = colK1 + 32;
    const int colV = isna ? C_VN + kvh * 64 : C_VW + kvh * 64;
    FA st;
    {
        const u16* qrow = P_px(p) + (long)(q0 + c) * INC;
#pragma unroll
        for (int ks = 0; ks < 4; ++ks) st.qf[ks] = *(const bf16x8*)(qrow + (ks < 2 ? colQ1 + ks * 16 : colQ2 + (ks - 2) * 16) + hh * 8);
#pragma unroll
        for (int db = 0; db < 2; ++db)
#pragma unroll
            for (int r = 0; r < 16; ++r) st.o[db][r] = 0.f;
        if (isna) { st.m = -1e30f; st.l = 0.f; } else { st.m = p->sink[layer * 8 + h] * LOG2E; st.l = hh == 0 ? 1.f : 0.f; }
    }
    if (kind == 0) {
        const int t0 = (q0 >> 6) - 2;
        for (int i = 0; i < 5; ++i) {
            int start = (t0 + i) * 64;
            if (start < 0 || start >= NLAT) continue;
            fa_stage(Ks, Vs, P_px(p), start, colK1, colK2, colV);
            if (i == 0 || i == 4) fa_tile<1>(st, Ks, Vs, start - q0, nullptr);
            else fa_tile<0>(st, Ks, Vs, 0, nullptr);
        }
    } else if (kind == 1) {
        const int r = blk >> 1;
        int sr = r - 4; sr = sr < 0 ? 0 : (sr > 248 ? 248 : sr);
        const float* rp = p->rpb + ((long)layer * 8 + h) * 465 + (sr - r + 7) * 31;
        for (int i = lane; i < 248; i += 64) rpbs[i] = rp[i];
        for (int i = 0; i < 8; ++i) {
            fa_stage(Ks, Vs, P_px(p), (sr + i) * 64, colK1, colK2, colV);
            fa_tile<2>(st, Ks, Vs, (blk & 1) * 32, rpbs + i * 31);
        }
    }
    for (int i = 0; i < 4; ++i) {
        fa_stage(Ks, Vs, P_px(p), NLAT + i * 64, colK1, colK2, colV);
        fa_tile<0>(st, Ks, Vs, 0, nullptr);
    }
    u16* y = isna ? P_yc(p) : P_yb(p);
    {
        float lt = st.l + __shfl_xor(st.l, 32);
        float inv = 1.f / lt;
        u16* orow = y + (long)(q0 + c) * 512 + h * 64;
#pragma unroll
        for (int db = 0; db < 2; ++db)
#pragma unroll
            for (int g = 0; g < 4; ++g) {
                uint2 o;
                o.x = pack2(st.o[db][4 * g] * inv, st.o[db][4 * g + 1] * inv);
                o.y = pack2(st.o[db][4 * g + 2] * inv, st.o[db][4 * g + 3] * inv);
                *(uint2*)(orow + db * 32 + 8 * g + 4 * hh) = o;
            }
    }
}

DI void ret_gammas(KP p, int layer, int h, float& lgf2, float& lgb2) {
    float xf = p->decay[layer * 8 + h], xb = p->decay[layer * 8 + 4 + h];
    lgf2 = -log1pf(expf(-xf)) * 1.4426950408889634f;
    lgb2 = -log1pf(expf(-xb)) * 1.4426950408889634f;
}
DI void phC_state_item(KP p, int layer, int c, int h, int eh, char* smem) {
    const int tid = TIDX(), lane = tid & 63, wid = tid >> 6, wr = wid >> 1, wc = wid & 1, fr = lane & 15, fq = lane >> 4;
    u16* Av = (u16*)smem;
    u16* Bf = Av + 64 * 72;
    u16* Bb = Bf + 128 * 72;
    float lgf2, lgb2; ret_gammas(p, layer, h, lgf2, lgb2);
    f32x4 accF[2][4], accB[2][4]; zero_acc<2>(accF); zero_acc<2>(accB);
    const u16* base = P_px(p) + (long)c * 128 * INC;
#pragma unroll 1
    for (int jh = 0; jh < 2; ++jh) {
        const int j = jh * 64 + (tid & 63);
        const float zf = exp2f((float)(127 - j) * lgf2), zb = exp2f((float)j * lgb2);
        __syncthreads();
        stage_t64<false, 64>(Av, 72, base + (long)jh * 64 * INC + C_VR + h * 128 + eh * 64, INC, 1.f);
        stage_t64<true, 128>(Bf, 72, base + (long)jh * 64 * INC + C_KR + h * 128, INC, zf);
        stage_t64<true, 128>(Bb, 72, base + (long)jh * 64 * INC + C_KR + h * 128, INC, zb);
        __syncthreads();
        mma_lds64<2>(accF, Av, 72, Bf, 72);
        mma_lds64<2>(accB, Av, 72, Bb, 72);
    }
    float* Sf = P_S(p) + ((long)(c * 4 + h) * 2 + 0) * 16384;
    float* Sb = Sf + 16384;
#pragma unroll
    for (int m = 0; m < 2; ++m)
#pragma unroll
        for (int n = 0; n < 4; ++n)
#pragma unroll
            for (int j = 0; j < 4; ++j) {
                int e = eh * 64 + wr * 32 + m * 16 + fq * 4 + j, d = wc * 64 + n * 16 + fr;
                Sf[e * 128 + d] = accF[m][n][j];
                Sb[e * 128 + d] = accB[m][n][j];
            }
}

DI void phD_item(KP p, int layer, int item) {
    const int h = item >> 7, dir = (item >> 6) & 1, pos = (item & 63) * 256 + TIDX();
    float lgf2, lgb2; ret_gammas(p, layer, h, lgf2, lgb2);
    const float decay = exp2f(128.f * (dir == 0 ? lgf2 : lgb2));
    float r = 0.f;
    const long hs = (long)(h * 2 + dir) * 16384 + pos;
    auto chunk_at = [&](int i) -> int {
        if (dir == 0) return i < 2 ? 128 + i : i - 2;
        return i < 2 ? 129 - i : 129 - i;
    };
    for (int i0 = 0; i0 < NCHUNK; i0 += 13) {
        float s[13];
#pragma unroll
        for (int u = 0; u < 13; ++u) s[u] = P_S(p)[(long)chunk_at(i0 + u) * 8 * 16384 + hs];
#pragma unroll
        for (int u = 0; u < 13; ++u) {
            P_R(p)[(long)chunk_at(i0 + u) * 8 * 16384 + hs] = f2bf(r);
            r = decay * r + s[u];
        }
    }
}

DI void phE_item(KP p, int layer, int c, int h, int ih, char* smem) {
    const int tid = TIDX(), lane = tid & 63, wid = tid >> 6, wr = wid >> 1, wc = wid & 1, fr = lane & 15, fq = lane >> 4;
    u16* R0 = (u16*)smem;
    u16* R1 = R0 + 64 * 72;
    u16* R2 = R1 + 128 * 72;
    u16* P = (u16*)smem;
    float* red = (float*)(smem + (64 + 128 + 128) * 72 * 2);
    float lgf2, lgb2; ret_gammas(p, layer, h, lgf2, lgb2);
    const u16* base = P_px(p) + (long)c * 128 * INC;
    const u16* qbase = base + (long)ih * 64 * INC + C_QR + h * 128;
    const u16* Rf = P_R(p) + ((long)(c * 4 + h) * 2 + 0) * 16384;
    const u16* Rb = Rf + 16384;
    f32x4 Y[2][4], T[2][4];
    zero_acc<2>(Y); zero_acc<2>(T);
#pragma unroll 1
    for (int dh = 0; dh < 2; ++dh) {
        __syncthreads();
        stage_n64<64>(R0, 72, qbase + dh * 64, INC);
        stage_n64<128>(R1, 72, Rf + dh * 64, 128);
        stage_n64<128>(R2, 72, Rb + dh * 64, 128);
        __syncthreads();
        mma_lds64<2>(Y, R0, 72, R1, 72);
        mma_lds64<2>(T, R0, 72, R2, 72);
    }
#pragma unroll
    for (int m = 0; m < 2; ++m)
#pragma unroll
        for (int j = 0; j < 4; ++j) {
            int i = ih * 64 + wr * 32 + m * 16 + fq * 4 + j;
            float xf = exp2f((float)(i + 1) * lgf2), xb = exp2f((float)(128 - i) * lgb2);
#pragma unroll
            for (int n = 0; n < 4; ++n) Y[m][n][j] = xf * Y[m][n][j] + xb * T[m][n][j];
        }
    zero_acc<2>(T);
#pragma unroll 1
    for (int dh = 0; dh < 2; ++dh) {
        __syncthreads();
        stage_n64<64>(R0, 72, qbase + dh * 64, INC);
        stage_n64<128>(R1, 72, base + C_KR + h * 128 + dh * 64, INC);
        __syncthreads();
        mma_lds64<2>(T, R0, 72, R1, 72);
    }
    __syncthreads();
#pragma unroll
    for (int m = 0; m < 2; ++m)
#pragma unroll
        for (int n = 0; n < 4; ++n)
#pragma unroll
            for (int j = 0; j < 4; ++j) {
                int il = wr * 32 + m * 16 + fq * 4 + j, i = ih * 64 + il, jj = wc * 64 + n * 16 + fr;
                float dm = (i >= jj) ? exp2f((float)(i - jj) * lgf2) : exp2f((float)(jj - i) * lgb2);
                P[il * 136 + jj] = f2bf(T[m][n][j] * dm);
            }
#pragma unroll 1
    for (int jh = 0; jh < 2; ++jh) {
        __syncthreads();
        stage_t64<false, 128>(R2, 72, base + (long)jh * 64 * INC + C_VR + h * 128, INC, 1.f);
        __syncthreads();
        mma_lds64<2>(Y, P + jh * 64, 136, R2, 72);
    }
    float mu[2][4], rs[2][4];
#pragma unroll
    for (int m = 0; m < 2; ++m)
#pragma unroll
        for (int j = 0; j < 4; ++j) {
            float s = Y[m][0][j] + Y[m][1][j] + Y[m][2][j] + Y[m][3][j];
            s += __shfl_xor(s, 1); s += __shfl_xor(s, 2); s += __shfl_xor(s, 4); s += __shfl_xor(s, 8);
            if (fr == 0) red[(wr * 32 + m * 16 + fq * 4 + j) * 2 + wc] = s;
        }
    __syncthreads();
#pragma unroll
    for (int m = 0; m < 2; ++m)
#pragma unroll
        for (int j = 0; j < 4; ++j) { int il = wr * 32 + m * 16 + fq * 4 + j; mu[m][j] = (red[il * 2] + red[il * 2 + 1]) * (1.f / 128.f); }
    __syncthreads();
#pragma unroll
    for (int m = 0; m < 2; ++m)
#pragma unroll
        for (int j = 0; j < 4; ++j) {
            float s = 0.f;
#pragma unroll
            for (int n = 0; n < 4; ++n) { float d = Y[m][n][j] - mu[m][j]; s += d * d; }
            s += __shfl_xor(s, 1); s += __shfl_xor(s, 2); s += __shfl_xor(s, 4); s += __shfl_xor(s, 8);
            if (fr == 0) red[(wr * 32 + m * 16 + fq * 4 + j) * 2 + wc] = s;
        }
    __syncthreads();
#pragma unroll
    for (int m = 0; m < 2; ++m)
#pragma unroll
        for (int j = 0; j < 4; ++j) { int il = wr * 32 + m * 16 + fq * 4 + j; rs[m][j] = rsqrtf((red[il * 2] + red[il * 2 + 1]) * (1.f / 128.f) + 1e-6f); }
    const float* gn = p->ret_gn + layer * 512 + h * 128;
#pragma unroll
    for (int m = 0; m < 2; ++m)
#pragma unroll
        for (int n = 0; n < 4; ++n)
#pragma unroll
            for (int j = 0; j < 4; ++j) {
                int i = ih * 64 + wr * 32 + m * 16 + fq * 4 + j, e = wc * 64 + n * 16 + fr;
                long row = (long)c * 128 + i;
                float g = bf2f(P_px(p)[row * INC + C_GR + h * 128 + e]);
                float o = (Y[m][n][j] - mu[m][j]) * rs[m][j] * gn[e] * siluf_(g);
                P_ya(p)[row * 512 + h * 128 + e] = f2bf(o);
            }
    __syncthreads();
}

DI void phF_tile(KP p, int mt, int nt, char* smem) {
    const int tid = TIDX(), lane = tid & 63, wid = tid >> 6, wr = wid >> 1, wc = wid & 1, fr = lane & 15, fq = lane >> 4;
    const int r0 = tid >> 2, ko = (tid & 3) * 8;
    float* macc = P_maccx(p) - (long)NLAT * DM;
#pragma unroll 1
    for (int b = 0; b < 3; ++b) {
        const u16* y = (b == 0 ? P_ya(p) : b == 1 ? P_yb(p) : P_yc(p));
        const u16* w = (b == 0 ? P_wt_ret(p) : b == 1 ? P_wt_win(p) : P_wt_na(p));
        f32x4 acc[4][4]; zero_acc<4>(acc);
        const u16* a0 = y + (long)(mt * 128 + r0) * 512 + ko;
        const u16* b0 = w + (long)(nt * 128 + r0) * 512 + ko;
        gemm_core<16>(acc, a0, a0 + 64 * 512, b0, b0 + 64 * 512, smem);
        int zero = 0; asm volatile("" : "+v"(zero));
#pragma unroll
        for (int m = 0; m < 4; ++m)
#pragma unroll
            for (int n = 0; n < 4; ++n)
#pragma unroll
                for (int j = 0; j < 4; ++j) {
                    int row = mt * 128 + wr * 64 + m * 16 + fq * 4 + j + zero, col = nt * 128 + wc * 64 + n * 16 + fr;
                    float g = bf2f(P_px(p)[(long)row * INC + C_GATE + b * 1024 + col]);
                    float v = acc[m][n][j] * sigmoidf_(g);
                    float* mp = macc + (long)row * DM + col;
                    if (b == 0) *mp = v;
                    else if (b == 1) *mp += v;
                    else P_hx(p)[(long)row * DM + col] = f2bf(*mp + v);
                }
    }
}
DI void phG_tile(KP p, int layer, int mt, int nt, char* smem) {
    const int tid = TIDX(), lane = tid & 63, wid = tid >> 6, wr = wid >> 1, wc = wid & 1, fr = lane & 15, fq = lane >> 4;
    f32x4 acc[4][4]; zero_acc<4>(acc);
    const int r0 = tid >> 2, ko = (tid & 3) * 8;
    const u16* a0 = P_hx(p) + (long)(mt * 128 + r0) * DM + ko;
    const u16* b0 = P_wt_out(p) + (long)(nt * 128 + r0) * DM + ko;
    gemm_core<32>(acc, a0, a0 + 64 * DM, b0, b0 + 64 * DM, smem);
    const bool lat = mt < 128;
    const float* md = P_mod(p) + (layer * 2 + (lat ? 0 : 1)) * 6144 + 2 * 1024;
#pragma unroll
    for (int m = 0; m < 4; ++m)
#pragma unroll
        for (int n = 0; n < 4; ++n)
#pragma unroll
            for (int j = 0; j < 4; ++j) {
                int row = mt * 128 + wr * 64 + m * 16 + fq * 4 + j, col = nt * 128 + wc * 64 + n * 16 + fr;
                const float* xin = resid_row(p, layer, row);
                float* xo = lat ? p->out + (long)row * DM : P_ctxres(p) + (long)(row - NLAT) * DM;
                xo[col] = xin[col] + md[col] * acc[m][n][j];
            }
}


#define LAS __attribute__((address_space(3)))
namespace g8 {
constexpr int BM = 256, BK = 64, HALF = 128, HTB = HALF * BK * 2, STAGE_BYTES = 8 * HTB;
DI int lds_byte(int r, int c) { const int st = (r >> 4) * 2 + (c >> 5), rr = r & 15, cc = c & 31, ob = rr * 64 + cc * 2; return st * 1024 + (ob ^ (((ob >> 9) & 1) << 5)); }
DI void stage_rc(int b, int& R, int& C) { const int st = b / 1024, sb = b % 1024, swz = sb ^ (((sb >> 9) & 1) << 5); R = (st >> 1) * 16 + swz / 64; C = (st & 1) * 32 + (swz % 64) / 2; }
DI int perm32(int rho) { const int n = rho >> 4, i = rho & 15; return 8 * (i >> 2) + 4 * n + (i & 3); }
struct Unit { int pm, pn, aux; };
typedef f32x4 Acc[2][2][4][2];

template <class P>
DI void gemm_phase(LAS unsigned char* lds, const P& prob) {
    const int tid = TID512(), wid = __builtin_amdgcn_readfirstlane(tid >> 6), lane = tid & 63, wr = wid >> 2, wc = wid & 3, fr = lane & 15, fq = lane >> 4;
    constexpr int K = P::K, nt = K / BK;
    int Rr[2], Cc[2];
    unsigned voffA[2], voffB[2];
#pragma unroll
    for (int i = 0; i < 2; ++i) { stage_rc(tid * 16 + i * 8192, Rr[i], Cc[i]); const int Rb = P::PERM ? ((Rr[i] & ~31) + perm32(Rr[i] & 31)) : Rr[i];
        voffA[i] = (unsigned)(Rr[i] * K + Cc[i]) * 2u; voffB[i] = (unsigned)(Rb * K + Cc[i]) * 2u; }
    constexpr size_t kstep = (size_t)(BK * 2);
    constexpr size_t hstep = (size_t)HALF * K * 2;
    const unsigned ldsw = (unsigned)wid * 1024u;
    const int aoff = lds_byte(wr * 64 + fr, fq * 8), boff = lds_byte(wc * 32 + fr, fq * 8);
    unsigned vaC[2][2], vaN[2][2];
#define G8_SA(b, h) (((b) * 2 + (h)) * HTB)
#define G8_SB(b, h) ((4 + (b) * 2 + (h)) * HTB)
#define G8_STAGEA(bufoff, base, VA, h, kt) do { _Pragma("unroll") for (int _i = 0; _i < 2; ++_i) \
        __builtin_amdgcn_global_load_lds((const unsigned*)((base) + (P::GATHER ? (size_t)(VA)[h][_i] : (size_t)voffA[_i] + (size_t)(h) * hstep) + (size_t)(kt) * kstep), (LAS unsigned*)(lds + (bufoff) + ldsw + _i * 8192), 16, 0, 0); } while (0)
#define G8_STAGEB(bufoff, base, h, kt) do { _Pragma("unroll") for (int _i = 0; _i < 2; ++_i) \
        __builtin_amdgcn_global_load_lds((const unsigned*)((base) + (size_t)(h) * hstep + voffB[_i] + (size_t)(kt) * kstep), (LAS unsigned*)(lds + (bufoff) + ldsw + _i * 8192), 16, 0, 0); } while (0)
#define G8_LDA(dst, b, h) do { _Pragma("unroll") for (int m = 0; m < 4; ++m) _Pragma("unroll") for (int k = 0; k < 2; ++k) dst[m][k] = *(const LAS bf16x8*)(lds + G8_SA(b, h) + aoff + m * 2048 + k * 1024); } while (0)
#define G8_LDB(dst, b, h) do { _Pragma("unroll") for (int n = 0; n < 2; ++n) _Pragma("unroll") for (int k = 0; k < 2; ++k) dst[n][k] = *(const LAS bf16x8*)(lds + G8_SB(b, h) + boff + n * 2048 + k * 1024); } while (0)
#define G8_MMA(ai, bj, At, Bt) do { __builtin_amdgcn_s_setprio(1); _Pragma("unroll") for (int m = 0; m < 4; ++m) _Pragma("unroll") for (int n = 0; n < 2; ++n) _Pragma("unroll") for (int k = 0; k < 2; ++k) \
        acc[ai][bj][m][n] = __builtin_amdgcn_mfma_f32_16x16x32_bf16(Bt[n][k], At[m][k], acc[ai][bj][m][n], 0, 0, 0); __builtin_amdgcn_s_setprio(0); } while (0)
#define G8_WAIT_V(n) asm volatile("s_waitcnt vmcnt(" #n ")" ::: "memory")
#define G8_WAIT_L(n) asm volatile("s_waitcnt lgkmcnt(" #n ")" ::: "memory")
#define G8_BAR __builtin_amdgcn_s_barrier()
#define G8_SCHED __builtin_amdgcn_sched_barrier(0)
    Unit cur, nxt; int ui = 0;
    __syncthreads();
    if (!prob.next(0, cur)) return;
    if (P::GATHER) prob.gather(cur, Rr, Cc, vaC);
    const char* cA = prob.a_base(cur); const char* cB = prob.b_base(cur);
    Acc acc;
#pragma unroll
    for (int a = 0; a < 2; ++a)
#pragma unroll
        for (int b = 0; b < 2; ++b)
#pragma unroll
            for (int m = 0; m < 4; ++m)
#pragma unroll
                for (int n = 0; n < 2; ++n) acc[a][b][m][n] = (f32x4){0.f, 0.f, 0.f, 0.f};
    bf16x8 At[4][2], B0[2][2], B1[2][2];
    G8_STAGEB(G8_SB(0, 0), cB, 0, 0); G8_STAGEA(G8_SA(0, 0), cA, vaC, 0, 0); G8_STAGEB(G8_SB(0, 1), cB, 1, 0); G8_STAGEA(G8_SA(0, 1), cA, vaC, 1, 0);
    if (wr == 1) G8_BAR;
    G8_WAIT_V(4); G8_BAR;
    G8_STAGEB(G8_SB(1, 0), cB, 0, 1); G8_STAGEA(G8_SA(1, 0), cA, vaC, 0, 1); G8_STAGEB(G8_SB(1, 1), cB, 1, 1);
    G8_WAIT_V(6); G8_BAR;
    for (;;) {
        const bool has_next = prob.next(ui + 1, nxt);
        if (!has_next) nxt = cur;
        if (P::GATHER) {
            if (has_next) prob.gather(nxt, Rr, Cc, vaN);
            else {
#pragma unroll
                for (int h = 0; h < 2; ++h) { vaN[h][0] = vaC[h][0]; vaN[h][1] = vaC[h][1]; }
            }
        }
        const char* nA = prob.a_base(nxt); const char* nB = prob.b_base(nxt);
#pragma unroll 1
        for (int t = 0; t < nt; t += 2) {
            const bool last = (t == nt - 2);
            const char* a2 = last ? nA : cA; const char* b2 = last ? nB : cB; const int k2 = last ? 0 : t + 2;
            unsigned va2[2][2];
#pragma unroll
            for (int h = 0; h < 2; ++h) { va2[h][0] = last ? vaN[h][0] : vaC[h][0]; va2[h][1] = last ? vaN[h][1] : vaC[h][1]; }
            G8_LDB(B0, 0, 0); G8_SCHED; G8_LDA(At, 0, 0); G8_STAGEA(G8_SA(1, 1), cA, vaC, 1, t + 1);
            G8_WAIT_L(8); G8_BAR; G8_WAIT_L(0); G8_MMA(0, 0, At, B0); G8_BAR; G8_SCHED;
            G8_LDB(B1, 0, 1); G8_STAGEB(G8_SB(0, 0), b2, 0, k2);
            G8_BAR; G8_WAIT_L(0); G8_MMA(0, 1, At, B1); G8_BAR;
            G8_LDA(At, 0, 1); G8_STAGEA(G8_SA(0, 0), a2, va2, 0, k2);
            G8_BAR; G8_WAIT_L(0); G8_MMA(1, 0, At, B0); G8_BAR; G8_SCHED;
            G8_STAGEB(G8_SB(0, 1), b2, 1, k2);
            G8_WAIT_V(6); G8_BAR; G8_MMA(1, 1, At, B1); G8_BAR;
            G8_LDB(B0, 1, 0); G8_SCHED; G8_LDA(At, 1, 0); G8_STAGEA(G8_SA(0, 1), a2, va2, 1, k2);
            G8_WAIT_L(8); G8_BAR; G8_WAIT_L(0); G8_MMA(0, 0, At, B0); G8_BAR; G8_SCHED;
            G8_LDB(B1, 1, 1); G8_STAGEB(G8_SB(1, 0), b2, 0, k2 + 1);
            G8_BAR; G8_WAIT_L(0); G8_MMA(0, 1, At, B1); G8_BAR;
            G8_LDA(At, 1, 1); G8_STAGEA(G8_SA(1, 0), a2, va2, 0, k2 + 1);
            G8_BAR; G8_WAIT_L(0); G8_MMA(1, 0, At, B0); G8_BAR; G8_SCHED;
            G8_STAGEB(G8_SB(1, 1), b2, 1, k2 + 1);
            G8_WAIT_V(6); G8_BAR; G8_MMA(1, 1, At, B1); G8_BAR;
        }
        { const int l2 = TID512() & 63; prob.epi(acc, cur, wr, wc, l2 & 15, l2 >> 4); }
        if (!has_next) break;
#pragma unroll
        for (int a = 0; a < 2; ++a)
#pragma unroll
            for (int b = 0; b < 2; ++b)
#pragma unroll
                for (int m = 0; m < 4; ++m)
#pragma unroll
                    for (int n = 0; n < 2; ++n) acc[a][b][m][n] = (f32x4){0.f, 0.f, 0.f, 0.f};
        cur = nxt; cA = nA; cB = nB; ++ui;
        if (P::GATHER) {
#pragma unroll
            for (int h = 0; h < 2; ++h) { vaC[h][0] = vaN[h][0]; vaC[h][1] = vaN[h][1]; }
        }
    }
    G8_WAIT_V(0);
    if (wr == 0) G8_BAR;
    G8_BAR;
#undef G8_SA
#undef G8_SB
#undef G8_STAGEA
#undef G8_STAGEB
#undef G8_LDA
#undef G8_LDB
#undef G8_MMA
#undef G8_WAIT_V
#undef G8_WAIT_L
#undef G8_BAR
#undef G8_SCHED
}
}

struct ProbG {
    static constexpr int K = 1024; static constexpr bool PERM = false, GATHER = false;
    KP p; int layer;
    DI bool next(int i, g8::Unit& u) const {
        const int id = i * (int)gridDim.x + BIDX();
        if (id >= 256) return false;
        u.pm = id >> 2; u.pn = id & 3; u.aux = 0;
        return true;
    }
    DI const char* a_base(const g8::Unit& u) const { return (const char*)(P_hx(p) + (long)u.pm * 256 * DM); }
    DI const char* b_base(const g8::Unit& u) const { return (const char*)(P_wt_out(p) + (long)u.pn * 256 * DM); }
    DI void gather(const g8::Unit&, const int (&)[2], const int (&)[2], unsigned (&)[2][2]) const {}
    DI void epi(g8::Acc& acc, const g8::Unit& u, int wr, int wc, int fr, int fq) const {
        const float* xin = layer == 0 ? p->x : p->out;
        const float* md = P_mod(p) + (layer * 2) * 6144 + 2 * 1024;
#pragma unroll
        for (int bj = 0; bj < 2; ++bj)
#pragma unroll
            for (int n = 0; n < 2; ++n) {
                const int col = u.pn * 256 + bj * 128 + wc * 32 + n * 16 + fq * 4;
                const f32x4 mv = *(const f32x4*)(md + col);
#pragma unroll
                for (int ai = 0; ai < 2; ++ai)
#pragma unroll
                    for (int m = 0; m < 4; ++m) {
                        const long row = (long)u.pm * 256 + ai * 128 + wr * 64 + m * 16 + fr;
                        const f32x4 xv = *(const f32x4*)(xin + row * DM + col);
                        *(f32x4*)(p->out + row * DM + col) = xv + mv * acc[ai][bj][m][n];
                    }
            }
    }
};


struct ProbF {
    static constexpr int K = 512; static constexpr bool PERM = true, GATHER = false;
    KP p;
    DI bool next(int i, g8::Unit& u) const {
        const int tile = (i / 3) * (int)gridDim.x + BIDX();
        if (tile >= 256) return false;
        u.pm = tile >> 2; u.pn = tile & 3; u.aux = i % 3;
        return true;
    }
    DI const char* a_base(const g8::Unit& u) const { const u16* y = u.aux == 0 ? P_ya(p) : u.aux == 1 ? P_yb(p) : P_yc(p); return (const char*)(y + (long)u.pm * 256 * 512); }
    DI const char* b_base(const g8::Unit& u) const { const u16* w = u.aux == 0 ? P_wt_ret(p) : u.aux == 1 ? P_wt_win(p) : P_wt_na(p); return (const char*)(w + (long)u.pn * 256 * 512); }
    DI void gather(const g8::Unit&, const int (&)[2], const int (&)[2], unsigned (&)[2][2]) const {}
    DI void epi(g8::Acc& acc, const g8::Unit& u, int wr, int wc, int fr, int fq) const {
        const int b = u.aux;
        u16* z = P_z(p) + (long)b * NLAT * DM;
        const long row0 = (long)u.pm * 256 + wr * 64 + fr;
        const int col0 = u.pn * 256 + wc * 32 + fq * 8;
#pragma unroll
        for (int ai = 0; ai < 2; ++ai)
#pragma unroll
            for (int m = 0; m < 4; ++m)
#pragma unroll
                for (int bj = 0; bj < 2; ++bj) {
                    u32x4 o;
#pragma unroll
                    for (int n = 0; n < 2; ++n)
#pragma unroll
                        for (int e = 0; e < 2; ++e) o[2 * n + e] = pack2(acc[ai][bj][m][n][2 * e], acc[ai][bj][m][n][2 * e + 1]);
                    *(u32x4*)(z + (row0 + ai * 128 + m * 16) * DM + col0 + bj * 128) = o;
                }
        if (b != 2) return;
        asm volatile("" ::: "memory");
        const u16* zb = P_z(p);
        const u16* gp = P_px(p) + C_GATE;
#pragma unroll 4
        for (int g = 0; g < 16; ++g) {
            const int ai = g >> 3, m = (g >> 1) & 3, bj = g & 1;
            const long row = row0 + ai * 128 + m * 16; const int col = col0 + bj * 128;
            u32x4 zv[3], gv[3];
#pragma unroll
            for (int q = 0; q < 3; ++q) { zv[q] = *(const u32x4*)(zb + ((long)q * NLAT + row) * DM + col); gv[q] = *(const u32x4*)(gp + row * INC + q * 1024 + col); }
            u32x4 o;
#pragma unroll
            for (int e = 0; e < 4; ++e) {
                float lo = 0.f, hi = 0.f;
#pragma unroll
                for (int q = 0; q < 3; ++q) { lo += bflo(zv[q][e]) * sigmoidf_(bflo(gv[q][e])); hi += bfhi(zv[q][e]) * sigmoidf_(bfhi(gv[q][e])); }
                o[e] = pack2(lo, hi);
            }
            *(u32x4*)(P_hx(p) + row * DM + col) = o;
        }
    }
};
struct ProbJ {
    static constexpr int K = 1024; static constexpr bool PERM = true, GATHER = true;
    KP p;
    DI bool next(int i, g8::Unit& u) const {
        const int id = i * (int)gridDim.x + BIDX();
        if (id >= 1024) return false;
        u.aux = id >> 6; u.pm = (id >> 3) & 7; u.pn = id & 7;
        return true;
    }
    DI const char* a_base(const g8::Unit&) const { return (const char*)P_hx(p); }
    DI const char* b_base(const g8::Unit& u) const { return (const char*)(P_wt_gu(p) + ((long)u.aux * 2048 + u.pn * 256) * DM); }
    DI void gather(const g8::Unit& u, const int (&R)[2], const int (&C)[2], unsigned (&va)[2][2]) const {
        const int* si = P_sel_idx(p) + u.aux * 2048 + u.pm * 256;
#pragma unroll
        for (int h = 0; h < 2; ++h)
#pragma unroll
            for (int j = 0; j < 2; ++j) va[h][j] = (unsigned)(si[h * 128 + R[j]] * DM + C[j]) * 2u;
    }
    DI void epi(g8::Acc& acc, const g8::Unit& u, int wr, int wc, int fr, int fq) const {
        u16* hb = P_hid(p) + (long)u.aux * 2048 * EH;
#pragma unroll
        for (int ai = 0; ai < 2; ++ai)
#pragma unroll
            for (int m = 0; m < 4; ++m) {
                const int slot = u.pm * 256 + ai * 128 + wr * 64 + m * 16 + fr;
                const int f = u.pn * 128 + wc * 32 + fq * 8;
                u32x4 o;
#pragma unroll
                for (int n = 0; n < 2; ++n)
#pragma unroll
                    for (int e = 0; e < 2; ++e)
                        o[2 * n + e] = pack2(siluf_(acc[ai][0][m][n][2 * e]) * acc[ai][1][m][n][2 * e], siluf_(acc[ai][0][m][n][2 * e + 1]) * acc[ai][1][m][n][2 * e + 1]);
                *(u32x4*)(hb + (long)slot * EH + f) = o;
            }
    }
};
struct ProbK {
    static constexpr int K = 1024; static constexpr bool PERM = true, GATHER = false;
    KP p; int layer;
    DI bool next(int i, g8::Unit& u) const {
        const int id = i * (int)gridDim.x + BIDX();
        if (id >= 512) return false;
        u.aux = id >> 5; u.pm = (id >> 2) & 7; u.pn = id & 3;
        return true;
    }
    DI const char* a_base(const g8::Unit& u) const { return (const char*)(P_hid(p) + ((long)u.aux * 2048 + u.pm * 256) * EH); }
    DI const char* b_base(const g8::Unit& u) const { return (const char*)(P_wt_dn(p) + ((long)u.aux * 1024 + u.pn * 256) * EH); }
    DI void gather(const g8::Unit&, const int (&)[2], const int (&)[2], unsigned (&)[2][2]) const {}
    DI void epi(g8::Acc& acc, const g8::Unit& u, int wr, int wc, int fr, int fq) const {
        const float* md = P_mod(p) + (layer * 2) * 6144 + 5 * 1024;
        f32x4 mv[2][2];
#pragma unroll
        for (int bj = 0; bj < 2; ++bj)
#pragma unroll
            for (int n = 0; n < 2; ++n) mv[bj][n] = *(const f32x4*)(md + u.pn * 256 + bj * 128 + wc * 32 + fq * 8 + n * 4);
#pragma unroll
        for (int ai = 0; ai < 2; ++ai)
#pragma unroll
            for (int m = 0; m < 4; ++m) {
                const int slot = u.aux * 2048 + u.pm * 256 + ai * 128 + wr * 64 + m * 16 + fr;
                const float g = P_sel_gate(p)[slot];
                u16* yr = P_ye(p) + (long)slot * DM + u.pn * 256 + wc * 32 + fq * 8;
#pragma unroll
                for (int bj = 0; bj < 2; ++bj) {
                    u32x4 o;
#pragma unroll
                    for (int n = 0; n < 2; ++n)
#pragma unroll
                        for (int e = 0; e < 2; ++e)
                            o[2 * n + e] = pack2(acc[ai][bj][m][n][2 * e] * g * mv[bj][n][2 * e], acc[ai][bj][m][n][2 * e + 1] * g * mv[bj][n][2 * e + 1]);
                    *(u32x4*)(yr + bj * 128) = o;
                }
            }
    }
};

DI void phH_item(KP p, int layer, int item, char* smem) {
    const int lane = TIDX() & 63, wid = TIDX() >> 6;
    float* hrow = (float*)smem + wid * 2048;
    const int row0 = item * 8 + wid * 2;
    norm_row(p, layer, row0, cur_row(p, row0), p->g_ffn + layer * DM, 3, 4, P_hx(p) + (long)row0 * DM, hrow, nullptr);
    norm_row(p, layer, row0 + 1, cur_row(p, row0 + 1), p->g_ffn + layer * DM, 3, 4, P_hx(p) + (long)(row0 + 1) * DM, hrow + 1024, nullptr);
    const int e = lane & 15, kp = lane >> 4;
    const float* wr_ = p->w_router + (long)layer * 1024 * 16 + e;
    float l0 = 0.f, l1 = 0.f;
#pragma unroll 8
    for (int k = kp * 256; k < kp * 256 + 256; ++k) {
        float w = wr_[k * 16];
        l0 += hrow[k] * w; l1 += hrow[1024 + k] * w;
    }
    l0 += __shfl_xor(l0, 16); l0 += __shfl_xor(l0, 32);
    l1 += __shfl_xor(l1, 16); l1 += __shfl_xor(l1, 32);
#pragma unroll
    for (int r = 0; r < 2; ++r) {
        float lg = r == 0 ? l0 : l1;
        float mx = lg;
        mx = fmaxf(mx, __shfl_xor(mx, 1)); mx = fmaxf(mx, __shfl_xor(mx, 2)); mx = fmaxf(mx, __shfl_xor(mx, 4)); mx = fmaxf(mx, __shfl_xor(mx, 8));
        float ex = expf(lg - mx);
        float sm = ex;
        sm += __shfl_xor(sm, 1); sm += __shfl_xor(sm, 2); sm += __shfl_xor(sm, 4); sm += __shfl_xor(sm, 8);
        float a = ex / sm;
        int row = row0 + r;
        if (lane < 16) {
            if (row < NLAT) P_aff(p)[(long)e * NLAT + row] = a;
            else P_aff(p)[(long)(16 + e) * NLAT + (row - NLAT)] = a;
        }
    }
    __syncthreads();
}

DI int block_excl_scan(int v, int* sh  , int& total) {
    const int lane = TIDX() & 63, wid = TIDX() >> 6;
    int inc = v;
    for (int o = 1; o < 64; o <<= 1) { int t = __shfl_up(inc, o); if (lane >= o) inc += t; }
    __syncthreads();
    if (lane == 63) sh[wid] = inc;
    __syncthreads();
    int base = 0;
    for (int w = 0; w < wid; ++w) base += sh[w];
    total = sh[0] + sh[1] + sh[2] + sh[3];
    return base + inc - v;
}
DI void phI_item(KP p, int job, char* smem) {
    const int tid = TIDX();
    const int n = job < 16 ? NLAT : NCTX, cap = job < 16 ? CAP_LAT : CAP_CTX, rowbase = job < 16 ? 0 : NLAT;
    unsigned* keys = (unsigned*)smem;
    int* hist = (int*)(smem + 66560);
    int* sh = hist + 256;
    const float* a = P_aff(p) + (long)job * NLAT;
    __syncthreads();
    for (int i = tid; i < n; i += 256) keys[i + (i >> 6)] = __float_as_uint(a[i]);
    unsigned prefix = 0, mask = 0; int remaining = cap;
    for (int pass = 0; pass < 4; ++pass) {
        const int shift = 24 - 8 * pass;
        hist[tid] = 0;
        __syncthreads();
        for (int i = tid; i < n; i += 256) {
            unsigned k = keys[i + (i >> 6)];
            if ((k & mask) == prefix) atomicAdd(&hist[(k >> shift) & 255], 1);
        }
        __syncthreads();
        if (tid == 0) {
            int cum = 0, b = 255;
            for (; b > 0; --b) { if (cum + hist[b] >= remaining) break; cum += hist[b]; }
            sh[8] = b; sh[9] = remaining - cum;
        }
        __syncthreads();
        prefix |= ((unsigned)sh[8]) << shift; mask |= 255u << shift; remaining = sh[9];
        __syncthreads();
    }
    const unsigned T = prefix;
    const int per = n / 256;
    int ceq = 0;
    for (int i = 0; i < per; ++i) { int idx = tid * per + i; ceq += (keys[idx + (idx >> 6)] == T); }
    int tot;
    int eqb = block_excl_scan(ceq, sh, tot);
    int csel = 0, er = eqb;
    for (int i = 0; i < per; ++i) {
        int idx = tid * per + i; unsigned k = keys[idx + (idx >> 6)];
        if (k > T) ++csel; else if (k == T) { if (er < remaining) ++csel; ++er; }
    }
    int slot = block_excl_scan(csel, sh, tot);
    int* ts = P_tslot(p) + (long)job * NLAT;
    for (int i = tid; i < n; i += 256) ts[i] = -1;
    __syncthreads();
    er = eqb;
    for (int i = 0; i < per; ++i) {
        int idx = tid * per + i; unsigned k = keys[idx + (idx >> 6)];
        bool s = false;
        if (k > T) s = true; else if (k == T) { s = er < remaining; ++er; }
        if (s) { P_sel_idx(p)[job * 2048 + slot] = rowbase + idx; P_sel_gate(p)[job * 2048 + slot] = __uint_as_float(k); ts[idx] = slot; ++slot; }
    }
    __syncthreads();
}

DI void phJ_tile(KP p, int job, int mt, int nt, char* smem) {
    const int tid = TIDX(), lane = tid & 63, wid = tid >> 6, wr = wid >> 1, wc = wid & 1, fr = lane & 15, fq = lane >> 4;
    const int cap = job < 16 ? CAP_LAT : CAP_CTX, e = job & 15;
    f32x4 acc[4][4]; zero_acc<4>(acc);
    const int r0 = tid >> 2, ko = (tid & 3) * 8;
    int s0 = mt * 128 + r0, s1 = s0 + 64;
    s0 = s0 < cap ? s0 : cap - 1; s1 = s1 < cap ? s1 : cap - 1;
    const u16* a0 = P_hx(p) + (long)P_sel_idx(p)[job * 2048 + s0] * DM + ko;
    const u16* a1 = P_hx(p) + (long)P_sel_idx(p)[job * 2048 + s1] * DM + ko;
    const int f_lo = nt * 64 + (r0 & 31), f_hi = f_lo + 32, gu = (r0 >> 5) & 1;
    const u16* b0 = P_wt_gu(p) + ((long)e * 2048 + (f_lo >> 7) * 256 + gu * 128 + (f_lo & 127)) * DM + ko;
    const u16* b1 = P_wt_gu(p) + ((long)e * 2048 + (f_hi >> 7) * 256 + gu * 128 + (f_hi & 127)) * DM + ko;
    gemm_core<32>(acc, a0, a1, b0, b1, smem);
    u16* hb = job < 16 ? P_hid(p) + (long)job * 2048 * EH : P_hidc(p) + (long)(job - 16) * 32 * EH;
#pragma unroll
    for (int m = 0; m < 4; ++m)
#pragma unroll
        for (int n = 0; n < 2; ++n)
#pragma unroll
            for (int j = 0; j < 4; ++j) {
                int slot = mt * 128 + wr * 64 + m * 16 + fq * 4 + j;
                int f = nt * 64 + wc * 32 + n * 16 + fr;
                if (slot < cap) hb[(long)slot * EH + f] = f2bf(siluf_(acc[m][n][j]) * acc[m][n + 2][j]);
            }
}
DI void phK_tile(KP p, int layer, int job, int mt, int nt, char* smem) {
    const int tid = TIDX(), lane = tid & 63, wid = tid >> 6, wr = wid >> 1, wc = wid & 1, fr = lane & 15, fq = lane >> 4;
    const int cap = job < 16 ? CAP_LAT : CAP_CTX, e = job & 15;
    f32x4 acc[4][4]; zero_acc<4>(acc);
    const int r0 = tid >> 2, ko = (tid & 3) * 8;
    int s0 = mt * 128 + r0, s1 = s0 + 64;
    s0 = s0 < cap ? s0 : cap - 1; s1 = s1 < cap ? s1 : cap - 1;
    const u16* hb = job < 16 ? P_hid(p) + (long)job * 2048 * EH : P_hidc(p) + (long)(job - 16) * 32 * EH;
    const u16* a0 = hb + (long)s0 * EH + ko;
    const u16* a1 = hb + (long)s1 * EH + ko;
    const u16* b0 = P_wt_dn(p) + ((long)e * 1024 + nt * 128 + r0) * EH + ko;
    gemm_core<32>(acc, a0, a1, b0, b0 + 64 * EH, smem);
    const float* md = P_mod(p) + (layer * 2 + (job < 16 ? 0 : 1)) * 6144 + 5 * 1024;
    u16* yb_ = job < 16 ? P_ye(p) + (long)job * 2048 * DM : P_yec(p) + (long)(job - 16) * 32 * DM;
#pragma unroll
    for (int m = 0; m < 4; ++m)
#pragma unroll
        for (int j = 0; j < 4; ++j) {
            int slot = mt * 128 + wr * 64 + m * 16 + fq * 4 + j;
            if (slot < cap) {
                float g = P_sel_gate(p)[job * 2048 + slot];
#pragma unroll
                for (int n = 0; n < 4; ++n) {
                    int col = nt * 128 + wc * 64 + n * 16 + fr;
                    yb_[(long)slot * DM + col] = f2bf(acc[m][n][j] * g * md[col]);
                }
            }
        }
}

DI void run_phase(int ph, char* smem_all) {
    KP p = (KP)__builtin_amdgcn_kernarg_segment_ptr();
    asm volatile("" : "+s"(p));
    const int sb = TID512() >> 8;
    char* smem = smem_all + sb * SUB_LDS;
    const int bid = BIDX() * 2 + sb, nb = gridDim.x * 2, tid = TIDX(), wid = tid >> 6;
#ifndef ONLY_SUB
    if (ph == 0) {
        const int total = 192 + 48 + CONV_TILES;
        for (int it = bid; it < total; it += nb) {
            if (it < 192) ph0_gemv_item(p, it, smem);
            else if (it < 240) ph0_rope_item(p, it - 192);
            else convert_tile(p, 0, it - 240, smem);
        }
        return;
    }
    if (ph == NPHASE - 1) {
        for (int it = bid; it < NLAT / 4; it += nb) {
            int row = it * 4 + wid, lane = tid & 63;
            float* xr = p->out + (long)row * DM;
            float4 v[4]; float ss = 0.f;
#pragma unroll
            for (int i = 0; i < 4; ++i) v[i] = *(const float4*)(xr + i * 256 + lane * 4);
            moe_combine(p, row, v);
#pragma unroll
            for (int i = 0; i < 4; ++i) ss += v[i].x * v[i].x + v[i].y * v[i].y + v[i].z * v[i].z + v[i].w * v[i].w;
            ss = wave_sum(ss);
            float rstd = rsqrtf(ss * (1.f / DM) + 1e-6f);
#pragma unroll
            for (int i = 0; i < 4; ++i) {
                float4 g = *(const float4*)(p->g_final + i * 256 + lane * 4);
                *(float4*)(xr + i * 256 + lane * 4) = make_float4(v[i].x * rstd * g.x, v[i].y * rstd * g.y, v[i].z * rstd * g.z, v[i].w * rstd * g.w);
            }
        }
        return;
    }
    const int layer = (ph - 1) / 11, sub = (ph - 1) % 11;
#else
    const int layer = (ph - 1) / 11, sub = ONLY_SUB;
#endif
    const bool need_ctx = layer == 0;
    switch (sub) {
    case 0: {
        const int nrow_items = NROWS / 4;
        const int total = nrow_items + (layer == 1 ? CONV_TILES : 0);
        for (int it = bid; it < total; it += nb) {
            if (it < nrow_items) { int row = it * 4 + wid; norm_row(p, layer, row, resid_row(p, layer, row), p->g_mix + layer * DM, 0, 1, P_hx(p) + (long)row * DM, nullptr, layer == 1 ? (float*)cur_row(p, row) : nullptr); }
            else convert_tile(p, layer, it - nrow_items, smem);
        }
    } break;
    case 1: {
        const int total = 130 * 58;
        for (int it = bid; it < total; it += nb) {
            int g = it / (8 * 58), local = it - g * 8 * 58;
            int gsz = (130 - g * 8) < 8 ? (130 - g * 8) : 8;
            int nt = local / gsz, mt = g * 8 + local % gsz;
            phB_tile(p, mt, nt, smem);
        }
    } break;
    case 2: {
        const int n_state = NCHUNK * 8, n_win = 1024, n_na = 1024, n_cx = need_ctx ? 32 : 0;
        const int total = n_state + n_win + n_na + n_cx;
        for (int it = bid; it < total; it += nb) {
            if (it < n_win) attn_wave_item(p, layer, 0, it >> 1, (it & 1) * 4 + wid, smem);
            else if (it < n_win + n_na) { int i2 = it - n_win; attn_wave_item(p, layer, 1, i2 >> 1, (i2 & 1) * 4 + wid, smem); }
            else if (it < n_win + n_na + n_state) { int i2 = it - n_win - n_na; phC_state_item(p, layer, i2 >> 3, (i2 >> 1) & 3, i2 & 1, smem); }
            else { int i2 = it - n_win - n_na - n_state; int kind = 2 + (i2 >> 4); i2 &= 15; attn_wave_item(p, layer, kind, i2 >> 1, (i2 & 1) * 4 + wid, smem); }
        }
    } break;
    case 3: {
        for (int it = bid; it < 512; it += nb) phD_item(p, layer, it);
    } break;
    case 4: {
        const int nch = need_ctx ? NCHUNK : 128;
        for (int it = bid; it < nch * 8; it += nb) phE_item(p, layer, it >> 3, (it >> 1) & 3, it & 1, smem);
    } break;
    case 5: {
        { ProbF pf{p}; g8::gemm_phase((LAS unsigned char*)smem_all, pf); }
        if (need_ctx) {
            const int sb2 = TID512() >> 8;
            for (int it = BIDX() * 2 + sb2; it < 16; it += (int)gridDim.x * 2) phF_tile(p, 128 + (it >> 3), it & 7, smem_all + sb2 * SUB_LDS);
        }
    } break;
    case 6: {
        { ProbG pg{p, layer}; g8::gemm_phase((LAS unsigned char*)smem_all, pg); }
        if (need_ctx) {
            const int sb2 = TID512() >> 8;
            for (int it = BIDX() * 2 + sb2; it < 16; it += (int)gridDim.x * 2) phG_tile(p, layer, 128 + (it >> 3), it & 7, smem_all + sb2 * SUB_LDS);
        }
    } break;
    case 7: {
        const int nit = (need_ctx ? NROWS : NLAT) / 8;
        for (int it = bid; it < nit; it += nb) phH_item(p, layer, it, smem);
    } break;
    case 8: {
        const int njob = need_ctx ? 32 : 16;
        for (int it = bid; it < njob; it += nb) phI_item(p, it, smem);
    } break;
    case 9: {
        { ProbJ pj{p}; g8::gemm_phase((LAS unsigned char*)smem_all, pj); }
        if (need_ctx) {
            const int sb2 = TID512() >> 8;
            for (int it = BIDX() * 2 + sb2; it < 256; it += (int)gridDim.x * 2) phJ_tile(p, 16 + (it >> 4), 0, it & 15, smem_all + sb2 * SUB_LDS);
        }
    } break;
    case 10: {
        { ProbK pk{p, layer}; g8::gemm_phase((LAS unsigned char*)smem_all, pk); }
        if (need_ctx) {
            const int sb2 = TID512() >> 8;
            for (int it = BIDX() * 2 + sb2; it < 128; it += (int)gridDim.x * 2) phK_tile(p, layer, 16 + (it >> 3), 0, it & 7, smem_all + sb2 * SUB_LDS);
        }
    } break;
    }
}

__global__ void __launch_bounds__(NTHREADS, 2) mega_kernel(Params p, int ph_lo, int ph_hi) {
    __shared__ __attribute__((aligned(16))) char smem[LDS_BYTES];
    cg::grid_group grid = cg::this_grid();
#if MK_MULTI
    for (int ph = ph_lo; ph < ph_hi; ++ph) {
        if (ph > ph_lo) grid.sync();
        run_phase(ph, smem);
    }
#else
#ifdef PROBE_SUB
#define PH(n) do { if ((n) > 0) grid.sync(); run_phase((n), smem); if ((n) >= PROBE_MIN && (n) <= PROBE_MAX && (((n) - 1) % 11) == PROBE_SUB) { grid.sync(); run_phase((n), smem); } } while (0)
#else
#define PH(n) do { if ((n) > 0) grid.sync(); run_phase((n), smem); } while (0)
#endif
    PH(0); PH(1); PH(2); PH(3); PH(4); PH(5); PH(6); PH(7); PH(8); PH(9); PH(10); PH(11);
    PH(12); PH(13); PH(14); PH(15); PH(16); PH(17); PH(18); PH(19); PH(20); PH(21); PH(22); PH(23);
    static_assert(NPHASE == 24, "phase program");
#undef PH
#endif
}

extern "C" void kernel_launch(void* const* d_in, const int* in_sizes, int n_in, void* d_out, int out_size, void* d_ws, size_t ws_size,
                              hipStream_t stream) {
    static int grid_blocks = 0;
    if (!grid_blocks) {
        int dev = 0, cus = 0, per_cu = 0;
        hipGetDevice(&dev);
        hipDeviceGetAttribute(&cus, hipDeviceAttributeMultiprocessorCount, dev);
        hipOccupancyMaxActiveBlocksPerMultiprocessor(&per_cu, mega_kernel, NTHREADS, 0);
        if (per_cu < 1) per_cu = 1;
        if (per_cu > 1) per_cu = 1;
        grid_blocks = cus * per_cu;
    }
    Params p{};
    const float** ip = (const float**)&p.x;
    for (int i = 0; i < 22; ++i) ip[i] = (const float*)d_in[i];
    p.out = (float*)d_out;
    p.ws = (char*)d_ws;
    if (WS_END > ws_size) { fprintf(stderr, "kernel_launch: workspace too small: need %zu have %zu\n", (size_t)WS_END, ws_size); return; }
#if MK_MULTI
    for (int ph = 0; ph < NPHASE; ++ph) {
        hipLaunchKernelGGL(mega_kernel, dim3(grid_blocks), dim3(NTHREADS), 0, stream, p, ph, ph + 1);
    }
#else
    int lo = 0, hi = NPHASE;
    void* args[] = {&p, &lo, &hi};
    hipError_t e = hipLaunchCooperativeKernel((void*)mega_kernel, dim3(grid_blocks), dim3(NTHREADS), args, 0, stream);
    if (e != hipSuccess) fprintf(stderr, "cooperative launch failed: %s (grid %d)\n", hipGetErrorString(e), grid_blocks);
#endif
}
```

```cpp
#include <hip/hip_runtime.h>
#include <hip/hip_bf16.h>
#include <hip/hip_cooperative_groups.h>
#include <cstdio>
#include <cstdint>
namespace cg = cooperative_groups;

#ifndef MK_MULTI
#define MK_MULTI 0
#endif

#define DI __device__ __forceinline__
typedef unsigned short u16;
typedef __attribute__((ext_vector_type(8))) short bf16x8;
typedef __attribute__((ext_vector_type(4))) float f32x4;
typedef __attribute__((ext_vector_type(4))) unsigned int u32x4;

constexpr int NLAT = 16384, NCTX = 256, NROWS = NLAT + NCTX, DM = 1024, INC = 7424;
constexpr int C_QR = 0, C_KR = 512, C_VR = 1024, C_GR = 1536, C_QW = 2048, C_KW = 2560, C_VW = 2688, C_QN = 2816, C_KN = 3328, C_VN = 3840, C_GATE = 4352;
__host__ __device__ constexpr int col_qr(int h, int x) { return C_QR + (h >> 1) * 256 + x * 128 + (h & 1) * 64; }
__host__ __device__ constexpr int col_kr(int h, int x) { return C_KR + (h >> 1) * 256 + x * 128 + (h & 1) * 64; }
__host__ __device__ constexpr int col_qw(int h, int x) { return C_QW + (h >> 2) * 256 + x * 128 + (h & 3) * 32; }
__host__ __device__ constexpr int col_kw(int kh, int x) { return C_KW + x * 128 + kh * 32; }
__host__ __device__ constexpr int col_vw(int kh) { return C_KW + 64 + kh * 128; }
constexpr int NCHUNK = NROWS / 128;
constexpr int NEXP = 16, EH = 1024, CAP_LAT = 2048, CAP_CTX = 32;
constexpr int NTHREADS = 512;
constexpr int SUB_LDS = 76 * 1024;
constexpr int LDS_BYTES = 2 * SUB_LDS;
constexpr int NPHASE = 24;


constexpr size_t al256(size_t b) { return (b + 255) & ~(size_t)255; }
constexpr size_t WS_CTXRES = 0;
constexpr size_t WS_MOD = WS_CTXRES + al256((size_t)NCTX * DM * 4);
constexpr size_t WS_ROPE128 = WS_MOD + al256(2 * 2 * 6144 * 4);
constexpr size_t WS_ROPE64 = WS_ROPE128 + al256(256 * 32 * 8);
constexpr size_t WS_WT_IN = WS_ROPE64 + al256(256 * 16 * 8);
constexpr size_t WS_WT_RET = WS_WT_IN + al256((size_t)INC * DM * 2);
constexpr size_t WS_WT_WIN = WS_WT_RET + al256((size_t)1024 * 512 * 2);
constexpr size_t WS_WT_NA = WS_WT_WIN + al256((size_t)1024 * 512 * 2);
constexpr size_t WS_WT_OUT = WS_WT_NA + al256((size_t)1024 * 512 * 2);
constexpr size_t WS_WT_GU = WS_WT_OUT + al256((size_t)1024 * 1024 * 2);
constexpr size_t WS_WT_DN = WS_WT_GU + al256((size_t)NEXP * 2048 * 1024 * 2);
constexpr size_t WS_HX = WS_WT_DN + al256((size_t)NEXP * 1024 * 1024 * 2);
constexpr size_t WS_PX = WS_HX + al256((size_t)NROWS * DM * 2);
constexpr size_t WS_YA = WS_PX + al256((size_t)NROWS * INC * 2);
constexpr size_t WS_YB = WS_YA + al256((size_t)NROWS * 512 * 2);
constexpr size_t WS_YC = WS_YB + al256((size_t)NROWS * 512 * 2);
constexpr size_t WS_S = WS_YC + al256((size_t)NROWS * 512 * 2);
constexpr size_t WS_R = WS_S + al256((size_t)NCHUNK * 8 * 16384 * 4);
constexpr size_t WS_AFF = WS_R + al256((size_t)NCHUNK * 8 * 16384 * 2);
constexpr size_t WS_SELI = WS_AFF + al256((size_t)32 * NLAT * 4);
constexpr size_t WS_SELG = WS_SELI + al256(32 * 2048 * 4);
constexpr size_t WS_TSLOT = WS_SELG + al256(32 * 2048 * 4);
constexpr size_t WS_END = WS_TSLOT + al256((size_t)32 * NLAT * 4);
struct Params {
    const float *x, *c, *ctx, *c_ctx, *w_mod, *b_mod, *g_mix, *g_ffn, *w_in, *decay, *ret_gn, *w_ret, *sink, *w_win, *rpb, *w_na, *w_out,
        *w_router, *w_eg, *w_eu, *w_ed, *g_final;
    float* out;
    char* ws;
};
typedef const Params __attribute__((address_space(4)))* KP;
#define WSF(name, type, off) __device__ __forceinline__ type* P_##name(KP p) { return (type*)(p->ws + (off)); }
WSF(ctxres, float, WS_CTXRES)
WSF(mod, float, WS_MOD)
WSF(rope128, float2, WS_ROPE128)
WSF(rope64, float2, WS_ROPE64)
WSF(wt_in, u16, WS_WT_IN) WSF(wt_ret, u16, WS_WT_RET) WSF(wt_win, u16, WS_WT_WIN) WSF(wt_na, u16, WS_WT_NA) WSF(wt_out, u16, WS_WT_OUT)
WSF(wt_gu, u16, WS_WT_GU) WSF(wt_dn, u16, WS_WT_DN)
WSF(hx, u16, WS_HX)
WSF(px, u16, WS_PX)
WSF(ya, u16, WS_YA) WSF(yb, u16, WS_YB) WSF(yc, u16, WS_YC)
WSF(S, float, WS_S)
WSF(R, u16, WS_R)
WSF(aff, float, WS_AFF)
WSF(sel_idx, int, WS_SELI) WSF(sel_gate, float, WS_SELG)
WSF(hid, u16, WS_PX)
__device__ __forceinline__ u16* P_hidc(KP p) { return (u16*)(p->ws + WS_PX) + (size_t)NEXP * 2048 * 1024; }
__device__ __forceinline__ u16* P_ye(KP p) { return (u16*)(p->ws + WS_PX) + (size_t)NEXP * (2048 + 32) * 1024; }
__device__ __forceinline__ u16* P_yec(KP p) { return P_ye(p) + (size_t)NEXP * 2048 * 1024; }
__device__ __forceinline__ int* P_tslot(KP p) { return (int*)(p->ws + WS_TSLOT); }
__device__ __forceinline__ u16* P_z(KP p) { return (u16*)(p->ws + WS_S); }
__device__ __forceinline__ float* P_maccx(KP p) { return (float*)(p->ws + WS_S + (size_t)3 * NLAT * DM * 2); }
#undef WSF


DI int TIDX() { int t = threadIdx.x & 255; asm volatile("" : "+v"(t)); return t; }
DI int TID512() { int t = threadIdx.x; asm volatile("" : "+v"(t)); return t; }
DI int BIDX() { int t = blockIdx.x; asm volatile("" : "+s"(t)); return t; }
DI u16 f2bf(float x) { unsigned u = __float_as_uint(x); u += 0x7fffu + ((u >> 16) & 1u); return (u16)(u >> 16); }
DI float bf2f(u16 h) { return __uint_as_float(((unsigned)h) << 16); }
DI float bflo(unsigned w) { return __uint_as_float(w << 16); }
DI float bfhi(unsigned w) { return __uint_as_float(w & 0xffff0000u); }
typedef __bf16 bf16v2 __attribute__((ext_vector_type(2)));
typedef float f32v2 __attribute__((ext_vector_type(2)));
DI unsigned pack2(float a, float b) { f32v2 v = {a, b}; bf16v2 r = __builtin_convertvector(v, bf16v2); return __builtin_bit_cast(unsigned, r); }
DI float sigmoidf_(float x) { return 1.f / (1.f + __expf(-x)); }
DI float siluf_(float x) { return x / (1.f + __expf(-x)); }
DI float wave_sum(float v) { for (int o = 32; o > 0; o >>= 1) v += __shfl_xor(v, o); return v; }
#define MFMA16(a, b, c) __builtin_amdgcn_mfma_f32_16x16x32_bf16((a), (b), (c), 0, 0, 0)

template <int MR>
DI void zero_acc(f32x4 (&acc)[MR][4]) {
#pragma unroll
    for (int m = 0; m < MR; ++m)
#pragma unroll
        for (int n = 0; n < 4; ++n) acc[m][n] = f32x4{0.f, 0.f, 0.f, 0.f};
}

template <int KT>
DI void gemm_core(f32x4 (&acc)[4][4], const u16* a0, const u16* a1, const u16* b0, const u16* b1, char* smem) {
    const int tid = TIDX(), lane = tid & 63, wid = tid >> 6, wr = wid >> 1, wc = wid & 1, fr = lane & 15, fq = lane >> 4;
    auto stage = [&](int kt, int buf) {
        char* base = smem + buf * 16384;
        __builtin_amdgcn_global_load_lds((const unsigned*)(a0 + kt * 32), (unsigned*)(base + tid * 16), 16, 0, 0);
        __builtin_amdgcn_global_load_lds((const unsigned*)(a1 + kt * 32), (unsigned*)(base + 4096 + tid * 16), 16, 0, 0);
        __builtin_amdgcn_global_load_lds((const unsigned*)(b0 + kt * 32), (unsigned*)(base + 8192 + tid * 16), 16, 0, 0);
        __builtin_amdgcn_global_load_lds((const unsigned*)(b1 + kt * 32), (unsigned*)(base + 12288 + tid * 16), 16, 0, 0);
    };
    __syncthreads();
    stage(0, 0);
    for (int kt = 0; kt < KT; ++kt) {
        asm volatile("s_waitcnt vmcnt(0)" ::: "memory");
        __syncthreads();
        if (kt + 1 < KT) stage(kt + 1, (kt + 1) & 1);
        const char* SA = smem + (kt & 1) * 16384;
        const char* SB = SA + 8192;
        bf16x8 At[4], Bt[4];
#pragma unroll
        for (int m = 0; m < 4; ++m) At[m] = *(const bf16x8*)(SA + (wr * 64 + m * 16 + fr) * 64 + fq * 16);
#pragma unroll
        for (int n = 0; n < 4; ++n) Bt[n] = *(const bf16x8*)(SB + (wc * 64 + n * 16 + fr) * 64 + fq * 16);
#pragma unroll
        for (int m = 0; m < 4; ++m)
#pragma unroll
            for (int n = 0; n < 4; ++n) acc[m][n] = MFMA16(At[m], Bt[n], acc[m][n]);
    }
}

template <int MR>
DI void mma_lds64(f32x4 (&acc)[MR][4], const u16* As, int lda, const u16* Bs, int ldb) {
    const int tid = TIDX(), lane = tid & 63, wid = tid >> 6, wr = wid >> 1, wc = wid & 1, fr = lane & 15, fq = lane >> 4;
#pragma unroll
    for (int kk = 0; kk < 2; ++kk) {
        bf16x8 At[MR], Bt[4];
#pragma unroll
        for (int m = 0; m < MR; ++m) At[m] = *(const bf16x8*)(As + (wr * (MR * 16) + m * 16 + fr) * lda + kk * 32 + fq * 8);
#pragma unroll
        for (int n = 0; n < 4; ++n) Bt[n] = *(const bf16x8*)(Bs + (wc * 64 + n * 16 + fr) * ldb + kk * 32 + fq * 8);
#pragma unroll
        for (int m = 0; m < MR; ++m)
#pragma unroll
            for (int n = 0; n < 4; ++n) acc[m][n] = MFMA16(At[m], Bt[n], acc[m][n]);
    }
}
template <int ROWS>
DI void stage_n64(u16* dst, int ld, const u16* src, long sstride) {
    const int tid = TIDX();
#pragma unroll
    for (int i = 0; i < ROWS / 32; ++i) {
        int idx = i * 256 + tid, row = idx >> 3, ch = idx & 7;
        u32x4 v = *(const u32x4*)(src + (long)row * sstride + ch * 8);
        *(u32x4*)(dst + row * ld + ch * 8) = v;
    }
}
template <bool SCALE, int NF>
DI void stage_t64(u16* dst, int ld, const u16* src, long sstride, float scale_tok_lane  ) {
    const int tid = TIDX();
#pragma unroll
    for (int i = 0; i < NF / 32; ++i) {
        int idx = i * 256 + tid, jj = idx & 63, ch = idx >> 6;
        u32x4 v = *(const u32x4*)(src + (long)jj * sstride + ch * 8);
#pragma unroll
        for (int e = 0; e < 4; ++e) {
            float lo = bflo(v[e]), hi = bfhi(v[e]);
            if (SCALE) { lo *= scale_tok_lane; hi *= scale_tok_lane; }
            dst[(ch * 8 + 2 * e) * ld + jj] = SCALE ? f2bf(lo) : (u16)(v[e] & 0xffffu);
            dst[(ch * 8 + 2 * e + 1) * ld + jj] = SCALE ? f2bf(hi) : (u16)(v[e] >> 16);
        }
    }
}

DI void convert_tile(KP p, int layer, int tile, char* smem);

DI void ph0_gemv_item(KP p, int item, char* smem) {
    const int tid = TIDX();
    const int l = item / 96, cg_ = item % 96;
    float* sl = (float*)smem;
    float* red = (float*)(smem + 8192);
    __syncthreads();
    for (int k = tid; k < 1024; k += 256) { sl[k] = siluf_(p->c[k]); sl[1024 + k] = siluf_(p->c_ctx[k]); }
    __syncthreads();
    const int c4 = tid & 15, kp = tid >> 4;
    const int col = cg_ * 64 + c4 * 4;
    const float* w = p->w_mod + (long)l * 1024 * 6144 + col;
    float a0[4] = {0, 0, 0, 0}, a1[4] = {0, 0, 0, 0};
#pragma unroll 8
    for (int kk = 0; kk < 64; ++kk) {
        int k = kp * 64 + kk;
        float4 wv = *(const float4*)(w + (long)k * 6144);
        float s0 = sl[k], s1 = sl[1024 + k];
        a0[0] += s0 * wv.x; a0[1] += s0 * wv.y; a0[2] += s0 * wv.z; a0[3] += s0 * wv.w;
        a1[0] += s1 * wv.x; a1[1] += s1 * wv.y; a1[2] += s1 * wv.z; a1[3] += s1 * wv.w;
    }
#pragma unroll
    for (int j = 0; j < 4; ++j) { red[(kp * 2 + 0) * 64 + c4 * 4 + j] = a0[j]; red[(kp * 2 + 1) * 64 + c4 * 4 + j] = a1[j]; }
    __syncthreads();
    if (tid < 128) {
        int src = tid >> 6, cr = tid & 63;
        float s = 0.f;
        for (int q = 0; q < 16; ++q) s += red[(q * 2 + src) * 64 + cr];
        int n = cg_ * 64 + cr;
        P_mod(p)[(l * 2 + src) * 6144 + n] = s + p->b_mod[l * 6144 + n];
    }
}
DI void sincos_d(double a, float& c, float& s) {
    const double TWO_PI = 6.283185307179586476925286766559;
    double k = rint(a / TWO_PI);
    double r = a - k * TWO_PI;
    double r2 = r * r;
    double ts = r, tc = 1.0, ss = r, cc = 1.0;
    for (int i = 1; i <= 14; ++i) {
        tc = -tc * r2 / (double)((2 * i - 1) * (2 * i));
        ts = -ts * r2 / (double)((2 * i) * (2 * i + 1));
        cc += tc; ss += ts;
    }
    c = (float)cc; s = (float)ss;
}
DI void ph0_rope_item(KP p, int item) {
    int idx = item * 256 + TIDX();
    const double LN_BASE = 9.210340371976184;
    if (idx < 8192) {
        int pos = idx >> 5, f = idx & 31;
        float inv = (float)exp(-(double)f / 32.0 * LN_BASE);
        float ang = (float)pos * inv;
        float c, s; sincos_d((double)ang, c, s);
        P_rope128(p)[idx] = make_float2(c, s);
    } else {
        int i2 = idx - 8192;
        int pos = i2 >> 4, f = i2 & 15;
        float inv = (float)exp(-(double)f / 16.0 * LN_BASE);
        float ang = (float)pos * inv;
        float c, s; sincos_d((double)ang, c, s);
        P_rope64(p)[i2] = make_float2(c, s);
    }
}

constexpr int CONV_TILES = 1856 + 384 + 256 + 12288;
DI void convert_tile(KP p, int layer, int tile, char* smem) {
    const int tid = TIDX();
    const float* src; u16* dst; int K, N, mode = 0;
    if (tile < 1856) { src = p->w_in + (long)layer * 1024 * INC; dst = P_wt_in(p); K = 1024; N = INC; mode = 1; }
    else if (tile < 1856 + 384) {
        int t = tile - 1856, which = t / 128; tile = t % 128; K = 512; N = 1024;
        src = (which == 0 ? p->w_ret : which == 1 ? p->w_win : p->w_na) + (long)layer * 512 * 1024;
        dst = (which == 0 ? P_wt_ret(p) : which == 1 ? P_wt_win(p) : P_wt_na(p));
    } else if (tile < 1856 + 384 + 256) { tile -= 1856 + 384; src = p->w_out + (long)layer * 1024 * 1024; dst = P_wt_out(p); K = 1024; N = 1024; }
    else {
        int t = tile - (1856 + 384 + 256), which = t / 4096, e = (t % 4096) / 256; tile = t % 256; K = 1024; N = 1024;
        long eo = ((long)layer * NEXP + e) * 1024 * 1024;
        if (which == 0) { src = p->w_eg + eo; dst = P_wt_gu(p) + (long)e * 2048 * 1024; mode = 2; }
        else if (which == 1) { src = p->w_eu + eo; dst = P_wt_gu(p) + (long)e * 2048 * 1024; mode = 3; }
        else { src = p->w_ed + eo; dst = P_wt_dn(p) + (long)e * 1024 * 1024; }
    }
    const int ntn = N / 64;
    const int k0 = (tile / ntn) * 64, n0 = (tile % ntn) * 64;
    float* T = (float*)smem;
    __syncthreads();
#pragma unroll
    for (int i = 0; i < 4; ++i) {
        int kk = (tid >> 4) + 16 * i, n4 = tid & 15;
        float4 v = *(const float4*)(src + (long)(k0 + kk) * N + n0 + n4 * 4);
        T[kk * 65 + n4 * 4 + 0] = v.x; T[kk * 65 + n4 * 4 + 1] = v.y; T[kk * 65 + n4 * 4 + 2] = v.z; T[kk * 65 + n4 * 4 + 3] = v.w;
    }
    __syncthreads();
#pragma unroll
    for (int i = 0; i < 2; ++i) {
        int nn = (tid >> 3) + 32 * i, k8 = tid & 7;
        u32x4 o;
#pragma unroll
        for (int e = 0; e < 4; ++e) o[e] = pack2(T[(k8 * 8 + 2 * e) * 65 + nn], T[(k8 * 8 + 2 * e + 1) * 65 + nn]);
        int n = n0 + nn, drow = n;
        if (mode == 1) {
            if (n < 1024) { int hh_ = (n & 511) >> 7, o_ = n & 127; drow = (n < 512 ? col_qr(hh_, o_ >> 6) : col_kr(hh_, o_ >> 6)) + (o_ & 63); }
            else if (n >= C_QW && n < C_KW) { int m_ = n - C_QW; drow = col_qw(m_ >> 6, (m_ & 63) >> 5) + (m_ & 31); }
            else if (n >= C_KW && n < C_VW) { int m_ = n - C_KW; drow = col_kw(m_ >> 6, (m_ & 63) >> 5) + (m_ & 31); }
            else if (n >= C_VW && n < C_QN) { int m_ = n - C_VW; drow = col_vw(m_ >> 6) + (m_ & 63); }
        } else if (mode == 2) drow = (n >> 7) * 256 + (n & 127);
        else if (mode == 3) drow = (n >> 7) * 256 + 128 + (n & 127);
        *(u32x4*)(dst + (long)drow * K + k0 + k8 * 8) = o;
    }
}

DI const float* resid_row(KP p, int layer, int row) {
    if (row < NLAT) return (layer == 0 ? p->x : p->out) + (long)row * DM;
    return (layer == 0 ? p->ctx : P_ctxres(p)) + (long)(row - NLAT) * DM;
}
DI const float* cur_row(KP p, int row) { return row < NLAT ? p->out + (long)row * DM : P_ctxres(p) + (long)(row - NLAT) * DM; }
DI void moe_combine(KP p, int row, float4 (&v)[4]) {
    const int lane = TIDX() & 63;
    const bool lat = row < NLAT;
    const int* ts = P_tslot(p) + (lat ? 0 : 16) * (long)NLAT + (lat ? row : row - NLAT);
    const u16* yb_ = lat ? P_ye(p) : P_yec(p);
    const int cap = lat ? CAP_LAT : CAP_CTX;
#pragma unroll 4
    for (int e = 0; e < NEXP; ++e) {
        const int slot = ts[(long)e * NLAT];
        if (slot >= 0) {
            const u16* yr = yb_ + ((long)e * cap + slot) * DM + lane * 4;
#pragma unroll
            for (int i = 0; i < 4; ++i) {
                uint2 w = *(const uint2*)(yr + i * 256);
                v[i].x += bflo(w.x); v[i].y += bfhi(w.x); v[i].z += bflo(w.y); v[i].w += bfhi(w.y);
            }
        }
    }
}
DI void norm_row(KP p, int layer, int row, const float* xr, const float* g, int shift_idx, int scale_idx, u16* dst_row, float* keep  , float* wb  ) {
    const int lane = TIDX() & 63;
    const float* md = P_mod(p) + (layer * 2 + (row < NLAT ? 0 : 1)) * 6144;
    float4 v[4]; float ss = 0.f;
#pragma unroll
    for (int i = 0; i < 4; ++i) v[i] = *(const float4*)(xr + i * 256 + lane * 4);
    if (wb) {
        moe_combine(p, row, v);
#pragma unroll
        for (int i = 0; i < 4; ++i) *(float4*)(wb + i * 256 + lane * 4) = v[i];
    }
#pragma unroll
    for (int i = 0; i < 4; ++i) ss += v[i].x * v[i].x + v[i].y * v[i].y + v[i].z * v[i].z + v[i].w * v[i].w;
    ss = wave_sum(ss);
    float rstd = rsqrtf(ss * (1.f / DM) + 1e-6f);
#pragma unroll
    for (int i = 0; i < 4; ++i) {
        int c0 = i * 256 + lane * 4;
        float4 gg = *(const float4*)(g + c0), sh = *(const float4*)(md + shift_idx * 1024 + c0), sc = *(const float4*)(md + scale_idx * 1024 + c0);
        float o0 = v[i].x * rstd * gg.x * (1.f + sc.x) + sh.x, o1 = v[i].y * rstd * gg.y * (1.f + sc.y) + sh.y;
        float o2 = v[i].z * rstd * gg.z * (1.f + sc.z) + sh.z, o3 = v[i].w * rstd * gg.w * (1.f + sc.w) + sh.w;
        uint2 pk; pk.x = pack2(o0, o1); pk.y = pack2(o2, o3);
        *(uint2*)(dst_row + c0) = pk;
        if (keep) *(float4*)(keep + c0) = make_float4(o0, o1, o2, o3);
    }
}

DI void phB_tile(KP p, int mt, int nt, char* smem) {
    const int tid = TIDX(), lane = tid & 63, wid = tid >> 6, wr = wid >> 1, wc = wid & 1, fr = lane & 15, fq = lane >> 4;
    f32x4 acc[4][4]; zero_acc<4>(acc);
    const int r0 = tid >> 2, ko = (tid & 3) * 8;
    const u16* a0 = P_hx(p) + (long)(mt * 128 + r0) * DM + ko;
    const u16* b0 = P_wt_in(p) + (long)(nt * 128 + r0) * DM + ko;
    gemm_core<32>(acc, a0, a0 + 64 * DM, b0, b0 + 64 * DM, smem);
    const bool lat = mt < 128;
    const int type = (nt < 8) ? 1 : (nt >= 16 && nt < 21) ? 2 : 0;
    if (type != 0 && lat) {
#pragma unroll
        for (int m = 0; m < 4; ++m)
#pragma unroll
            for (int j = 0; j < 4; ++j) {
                int t = mt * 128 + wr * 64 + m * 16 + fq * 4 + j;
                int pr = t >> 6, pc = t & 63;
#pragma unroll
                for (int n = 0; n < 2; ++n) {
                    float2 cs;
                    if (type == 1) { int pos = (wc == 0) ? pr : pc; cs = P_rope128(p)[pos * 32 + n * 16 + fr]; }
                    else { int pos = (n == 0) ? pr : pc; cs = P_rope64(p)[pos * 16 + fr]; }
                    float x1 = acc[m][n][j], x2 = acc[m][n + 2][j];
                    acc[m][n][j] = x1 * cs.x - x2 * cs.y;
                    acc[m][n + 2][j] = x1 * cs.y + x2 * cs.x;
                }
            }
    }
    const float mul = (nt >= 4 && nt < 8) ? 0.08838834764831845f : ((nt >= 16 && nt < 20) || (nt >= 22 && nt < 26)) ? 0.125f : 1.f;
#pragma unroll
    for (int m = 0; m < 4; ++m)
#pragma unroll
        for (int n = 0; n < 4; ++n)
#pragma unroll
            for (int j = 0; j < 4; ++j) {
                int row = mt * 128 + wr * 64 + m * 16 + fq * 4 + j, col = nt * 128 + wc * 64 + n * 16 + fr;
                P_px(p)[(long)row * INC + col] = f2bf(acc[m][n][j] * mul);
            }
}

typedef __attribute__((ext_vector_type(16))) float f32x16;
typedef short v4s __attribute__((ext_vector_type(4)));
typedef __attribute__((address_space(3))) v4s* lds_v4s_ptr;
#define MFMA32(a, b, c) __builtin_amdgcn_mfma_f32_32x32x16_bf16((a), (b), (c), 0, 0, 0)
constexpr float LOG2E = 1.4426950408889634f;

struct FA {
    bf16x8 qf[4];
    f32x16 o[2];
    float m, l;
};
DI void fa_stage(u16* Ks, u16* Vs, const u16* px, int rowstart, int colK1, int colK2, int colV) {
    const int lane = TIDX() & 63;
#pragma unroll
    for (int i = 0; i < 8; ++i) {
        int idx = i * 64 + lane, key = idx >> 3, ch = idx & 7;
        const u16* src = px + (long)(rowstart + key) * INC;
        u32x4 kv = *(const u32x4*)(src + (ch < 4 ? colK1 + ch * 8 : colK2 + (ch - 4) * 8));
        u32x4 vv = *(const u32x4*)(src + colV + ch * 8);
        *(u32x4*)(Ks + key * 72 + ch * 8) = kv;
        *(u32x4*)(Vs + key * 72 + ch * 8) = vv;
    }
}
template <int MODE>
DI void fa_tile(FA& st, const u16* Ks, const u16* Vs, int a0, const float* rrow) {
    const int lane = TIDX() & 63, c = lane & 31, hh = lane >> 5;
    const u16* kbase = Ks + c * 72 + hh * 8;
    const u16* vbase = Vs + (4 * hh + ((lane & 15) >> 2)) * 72 + 16 * ((lane >> 4) & 1) + 4 * (lane & 3);
    f32x16 s[2];
#pragma unroll
    for (int kb = 0; kb < 2; ++kb) {
#pragma unroll
        for (int r = 0; r < 16; ++r) s[kb][r] = 0.f;
#pragma unroll
        for (int ks = 0; ks < 4; ++ks) {
            bf16x8 A = *(const bf16x8*)(kbase + kb * 32 * 72 + ks * 16);
            s[kb] = MFMA32(A, st.qf[ks], s[kb]);
        }
    }
    float mx = -3.0e38f;
    const int cq = a0 + c;
    int cs = cq - 8; cs = cs < 0 ? 0 : (cs > 48 ? 48 : cs);
#pragma unroll
    for (int kb = 0; kb < 2; ++kb)
#pragma unroll
        for (int r = 0; r < 16; ++r) {
            const int j = kb * 32 + (r & 3) + 8 * (r >> 2) + 4 * hh;
            float v = s[kb][r];
            if (MODE == 1) { int d = a0 + j - c; v = (d >= -128 && d <= 128) ? v : -1e30f; }
            if (MODE == 2) { bool ok = (j >= cs) && (j < cs + 16); int ci = j - cq + 15; ci = ci < 0 ? 0 : (ci > 30 ? 30 : ci); v = ok ? v + rrow[ci] : -1e30f; }
            v *= LOG2E;
            s[kb][r] = v;
            mx = fmaxf(mx, v);
        }
    mx = fmaxf(mx, __shfl_xor(mx, 32));
    const float mn = fmaxf(st.m, mx);
    const float alpha = __builtin_amdgcn_exp2f(st.m - mn);
    float ls = 0.f;
#pragma unroll
    for (int kb = 0; kb < 2; ++kb)
#pragma unroll
        for (int r = 0; r < 16; ++r) { float pv = __builtin_amdgcn_exp2f(s[kb][r] - mn); s[kb][r] = pv; ls += pv; }
    st.l = st.l * alpha + ls; st.m = mn;
#pragma unroll
    for (int db = 0; db < 2; ++db)
#pragma unroll
        for (int r = 0; r < 16; ++r) st.o[db][r] *= alpha;
    bf16x8 pf[2][2];
#pragma unroll
    for (int kb = 0; kb < 2; ++kb)
#pragma unroll
        for (int k2 = 0; k2 < 2; ++k2) {
            u32x4 w;
#pragma unroll
            for (int e = 0; e < 4; ++e) w[e] = pack2(s[kb][8 * k2 + 2 * e], s[kb][8 * k2 + 2 * e + 1]);
            pf[kb][k2] = __builtin_bit_cast(bf16x8, w);
        }
#pragma unroll
    for (int db = 0; db < 2; ++db)
#pragma unroll
        for (int kb = 0; kb < 2; ++kb)
#pragma unroll
            for (int k2 = 0; k2 < 2; ++k2) {
                const u16* alo = vbase + (kb * 32 + 16 * k2) * 72 + db * 32;
                v4s lo = __builtin_amdgcn_ds_read_tr16_b64_v4i16((lds_v4s_ptr)alo);
                v4s hi = __builtin_amdgcn_ds_read_tr16_b64_v4i16((lds_v4s_ptr)(alo + 8 * 72));
                bf16x8 A = __builtin_shufflevector(lo, hi, 0, 1, 2, 3, 4, 5, 6, 7);
                st.o[db] = MFMA32(A, pf[kb][k2], st.o[db]);
            }
}
DI void attn_wave_item(KP p, int layer, int kind, int blk, int h, char* smem) {
    const int lane = TIDX() & 63, wid = TIDX() >> 6, c = lane & 31, hh = lane >> 5;
    u16* Ks = (u16*)(smem + wid * 19456);
    u16* Vs = Ks + 64 * 72;
    float* rpbs = (float*)(smem + wid * 19456 + 18432);
    const bool isna = (kind == 1 || kind == 3);
    const int q0 = ((kind >= 2) ? NLAT : 0) + blk * 32;
    const int kvh = isna ? h : (h >> 2);
    const int colQ1 = isna ? C_QN + h * 64 : col_qw(h, 0), colQ2 = isna ? colQ1 + 32 : col_qw(h, 1);
    const int colK1 = isna ? C_KN + kvh * 64 : col_kw(kvh, 0), colK2 = isna ? colK1 + 32 : col_kw(kvh, 1);
    const int colV = isna ? C_VN + kvh * 64 : col_vw(kvh);
    FA st;
    {
        const u16* qrow = P_px(p) + (long)(q0 + c) * INC;
#pragma unroll
        for (int ks = 0; ks < 4; ++ks) st.qf[ks] = *(const bf16x8*)(qrow + (ks < 2 ? colQ1 + ks * 16 : colQ2 + (ks - 2) * 16) + hh * 8);
#pragma unroll
        for (int db = 0; db < 2; ++db)
#pragma unroll
            for (int r = 0; r < 16; ++r) st.o[db][r] = 0.f;
        if (isna) { st.m = -1e30f; st.l = 0.f; } else { st.m = p->sink[layer * 8 + h] * LOG2E; st.l = hh == 0 ? 1.f : 0.f; }
    }
    if (kind == 0) {
        const int t0 = (q0 >> 6) - 2;
        for (int i = 0; i < 5; ++i) {
            int start = (t0 + i) * 64;
            if (start < 0 || start >= NLAT) continue;
            fa_stage(Ks, Vs, P_px(p), start, colK1, colK2, colV);
            if (i == 0 || i == 4) fa_tile<1>(st, Ks, Vs, start - q0, nullptr);
            else fa_tile<0>(st, Ks, Vs, 0, nullptr);
        }
    } else if (kind == 1) {
        const int r = blk >> 1;
        int sr = r - 4; sr = sr < 0 ? 0 : (sr > 248 ? 248 : sr);
        const float* rp = p->rpb + ((long)layer * 8 + h) * 465 + (sr - r + 7) * 31;
        for (int i = lane; i < 248; i += 64) rpbs[i] = rp[i];
        for (int i = 0; i < 8; ++i) {
            fa_stage(Ks, Vs, P_px(p), (sr + i) * 64, colK1, colK2, colV);
            fa_tile<2>(st, Ks, Vs, (blk & 1) * 32, rpbs + i * 31);
        }
    }
    for (int i = 0; i < 4; ++i) {
        fa_stage(Ks, Vs, P_px(p), NLAT + i * 64, colK1, colK2, colV);
        fa_tile<0>(st, Ks, Vs, 0, nullptr);
    }
    u16* y = isna ? P_yc(p) : P_yb(p);
    {
        float lt = st.l + __shfl_xor(st.l, 32);
        float inv = 1.f / lt;
        u16* orow = y + (long)(q0 + c) * 512 + h * 64;
#pragma unroll
        for (int db = 0; db < 2; ++db)
#pragma unroll
            for (int g = 0; g < 4; ++g) {
                uint2 o;
                o.x = pack2(st.o[db][4 * g] * inv, st.o[db][4 * g + 1] * inv);
                o.y = pack2(st.o[db][4 * g + 2] * inv, st.o[db][4 * g + 3] * inv);
                *(uint2*)(orow + db * 32 + 8 * g + 4 * hh) = o;
            }
    }
}

DI void ret_gammas(KP p, int layer, int h, float& lgf2, float& lgb2) {
    float xf = p->decay[layer * 8 + h], xb = p->decay[layer * 8 + 4 + h];
    lgf2 = -log1pf(expf(-xf)) * 1.4426950408889634f;
    lgb2 = -log1pf(expf(-xb)) * 1.4426950408889634f;
}
DI void phC_state_item(KP p, int layer, int c, int h, int eh, char* smem) {
    const int tid = TIDX(), lane = tid & 63, wid = tid >> 6, wr = wid >> 1, wc = wid & 1, fr = lane & 15, fq = lane >> 4;
    u16* Av = (u16*)smem;
    u16* Bf = Av + 64 * 72;
    u16* Bb = Bf + 128 * 72;
    float lgf2, lgb2; ret_gammas(p, layer, h, lgf2, lgb2);
    f32x4 accF[2][4], accB[2][4]; zero_acc<2>(accF); zero_acc<2>(accB);
    const u16* base = P_px(p) + (long)c * 128 * INC;
#pragma unroll 1
    for (int jh = 0; jh < 2; ++jh) {
        const int j = jh * 64 + (tid & 63);
        const float zf = exp2f((float)(127 - j) * lgf2), zb = exp2f((float)j * lgb2);
        __syncthreads();
        stage_t64<false, 64>(Av, 72, base + (long)jh * 64 * INC + C_VR + h * 128 + eh * 64, INC, 1.f);
#pragma unroll
        for (int x = 0; x < 2; ++x) {
            stage_t64<true, 64>(Bf + x * 64 * 72, 72, base + (long)jh * 64 * INC + col_kr(h, x), INC, zf);
            stage_t64<true, 64>(Bb + x * 64 * 72, 72, base + (long)jh * 64 * INC + col_kr(h, x), INC, zb);
        }
        __syncthreads();
        mma_lds64<2>(accF, Av, 72, Bf, 72);
        mma_lds64<2>(accB, Av, 72, Bb, 72);
    }
    float* Sf = P_S(p) + ((long)(c * 4 + h) * 2 + 0) * 16384;
    float* Sb = Sf + 16384;
#pragma unroll
    for (int m = 0; m < 2; ++m)
#pragma unroll
        for (int n = 0; n < 4; ++n)
#pragma unroll
            for (int j = 0; j < 4; ++j) {
                int e = eh * 64 + wr * 32 + m * 16 + fq * 4 + j, d = wc * 64 + n * 16 + fr;
                Sf[e * 128 + d] = accF[m][n][j];
                Sb[e * 128 + d] = accB[m][n][j];
            }
}

DI void phD_item(KP p, int layer, int item) {
    const int h = item >> 7, dir = (item >> 6) & 1, pos = (item & 63) * 256 + TIDX();
    float lgf2, lgb2; ret_gammas(p, layer, h, lgf2, lgb2);
    const float decay = exp2f(128.f * (dir == 0 ? lgf2 : lgb2));
    float r = 0.f;
    const long hs = (long)(h * 2 + dir) * 16384 + pos;
    auto chunk_at = [&](int i) -> int {
        if (dir == 0) return i < 2 ? 128 + i : i - 2;
        return i < 2 ? 129 - i : 129 - i;
    };
    for (int i0 = 0; i0 < NCHUNK; i0 += 13) {
        float s[13];
#pragma unroll
        for (int u = 0; u < 13; ++u) s[u] = P_S(p)[(long)chunk_at(i0 + u) * 8 * 16384 + hs];
#pragma unroll
        for (int u = 0; u < 13; ++u) {
            P_R(p)[(long)chunk_at(i0 + u) * 8 * 16384 + hs] = f2bf(r);
            r = decay * r + s[u];
        }
    }
}

DI void phE_item(KP p, int layer, int c, int h, int ih, char* smem) {
    const int tid = TIDX(), lane = tid & 63, wid = tid >> 6, wr = wid >> 1, wc = wid & 1, fr = lane & 15, fq = lane >> 4;
    u16* R0 = (u16*)smem;
    u16* R1 = R0 + 64 * 72;
    u16* R2 = R1 + 128 * 72;
    u16* P = (u16*)smem;
    float* red = (float*)(smem + (64 + 128 + 128) * 72 * 2);
    float lgf2, lgb2; ret_gammas(p, layer, h, lgf2, lgb2);
    const u16* base = P_px(p) + (long)c * 128 * INC;
    const u16* qbase = base + (long)ih * 64 * INC;
    const u16* Rf = P_R(p) + ((long)(c * 4 + h) * 2 + 0) * 16384;
    const u16* Rb = Rf + 16384;
    f32x4 Y[2][4], T[2][4];
    zero_acc<2>(Y); zero_acc<2>(T);
#pragma unroll 1
    for (int dh = 0; dh < 2; ++dh) {
        __syncthreads();
        stage_n64<64>(R0, 72, qbase + col_qr(h, dh), INC);
        stage_n64<128>(R1, 72, Rf + dh * 64, 128);
        stage_n64<128>(R2, 72, Rb + dh * 64, 128);
        __syncthreads();
        mma_lds64<2>(Y, R0, 72, R1, 72);
        mma_lds64<2>(T, R0, 72, R2, 72);
    }
#pragma unroll
    for (int m = 0; m < 2; ++m)
#pragma unroll
        for (int j = 0; j < 4; ++j) {
            int i = ih * 64 + wr * 32 + m * 16 + fq * 4 + j;
            float xf = exp2f((float)(i + 1) * lgf2), xb = exp2f((float)(128 - i) * lgb2);
#pragma unroll
            for (int n = 0; n < 4; ++n) Y[m][n][j] = xf * Y[m][n][j] + xb * T[m][n][j];
        }
    zero_acc<2>(T);
#pragma unroll 1
    for (int dh = 0; dh < 2; ++dh) {
        __syncthreads();
        stage_n64<64>(R0, 72, qbase + col_qr(h, dh), INC);
        stage_n64<128>(R1, 72, base + col_kr(h, dh), INC);
        __syncthreads();
        mma_lds64<2>(T, R0, 72, R1, 72);
    }
    __syncthreads();
#pragma unroll
    for (int m = 0; m < 2; ++m)
#pragma unroll
        for (int n = 0; n < 4; ++n)
#pragma unroll
            for (int j = 0; j < 4; ++j) {
                int il = wr * 32 + m * 16 + fq * 4 + j, i = ih * 64 + il, jj = wc * 64 + n * 16 + fr;
                float dm = (i >= jj) ? exp2f((float)(i - jj) * lgf2) : exp2f((float)(jj - i) * lgb2);
                P[il * 136 + jj] = f2bf(T[m][n][j] * dm);
            }
#pragma unroll 1
    for (int jh = 0; jh < 2; ++jh) {
        __syncthreads();
        stage_t64<false, 128>(R2, 72, base + (long)jh * 64 * INC + C_VR + h * 128, INC, 1.f);
        __syncthreads();
        mma_lds64<2>(Y, P + jh * 64, 136, R2, 72);
    }
    float mu[2][4], rs[2][4];
#pragma unroll
    for (int m = 0; m < 2; ++m)
#pragma unroll
        for (int j = 0; j < 4; ++j) {
            float s = Y[m][0][j] + Y[m][1][j] + Y[m][2][j] + Y[m][3][j];
            s += __shfl_xor(s, 1); s += __shfl_xor(s, 2); s += __shfl_xor(s, 4); s += __shfl_xor(s, 8);
            if (fr == 0) red[(wr * 32 + m * 16 + fq * 4 + j) * 2 + wc] = s;
        }
    __syncthreads();
#pragma unroll
    for (int m = 0; m < 2; ++m)
#pragma unroll
        for (int j = 0; j < 4; ++j) { int il = wr * 32 + m * 16 + fq * 4 + j; mu[m][j] = (red[il * 2] + red[il * 2 + 1]) * (1.f / 128.f); }
    __syncthreads();
#pragma unroll
    for (int m = 0; m < 2; ++m)
#pragma unroll
        for (int j = 0; j < 4; ++j) {
            float s = 0.f;
#pragma unroll
            for (int n = 0; n < 4; ++n) { float d = Y[m][n][j] - mu[m][j]; s += d * d; }
            s += __shfl_xor(s, 1); s += __shfl_xor(s, 2); s += __shfl_xor(s, 4); s += __shfl_xor(s, 8);
            if (fr == 0) red[(wr * 32 + m * 16 + fq * 4 + j) * 2 + wc] = s;
        }
    __syncthreads();
#pragma unroll
    for (int m = 0; m < 2; ++m)
#pragma unroll
        for (int j = 0; j < 4; ++j) { int il = wr * 32 + m * 16 + fq * 4 + j; rs[m][j] = rsqrtf((red[il * 2] + red[il * 2 + 1]) * (1.f / 128.f) + 1e-6f); }
    const float* gn = p->ret_gn + layer * 512 + h * 128;
#pragma unroll
    for (int m = 0; m < 2; ++m)
#pragma unroll
        for (int n = 0; n < 4; ++n)
#pragma unroll
            for (int j = 0; j < 4; ++j) {
                int i = ih * 64 + wr * 32 + m * 16 + fq * 4 + j, e = wc * 64 + n * 16 + fr;
                long row = (long)c * 128 + i;
                float g = bf2f(P_px(p)[row * INC + C_GR + h * 128 + e]);
                float o = (Y[m][n][j] - mu[m][j]) * rs[m][j] * gn[e] * siluf_(g);
                P_ya(p)[row * 512 + h * 128 + e] = f2bf(o);
            }
    __syncthreads();
}

DI void phF_tile(KP p, int mt, int nt, char* smem) {
    const int tid = TIDX(), lane = tid & 63, wid = tid >> 6, wr = wid >> 1, wc = wid & 1, fr = lane & 15, fq = lane >> 4;
    const int r0 = tid >> 2, ko = (tid & 3) * 8;
    float* macc = P_maccx(p) - (long)NLAT * DM;
#pragma unroll 1
    for (int b = 0; b < 3; ++b) {
        const u16* y = (b == 0 ? P_ya(p) : b == 1 ? P_yb(p) : P_yc(p));
        const u16* w = (b == 0 ? P_wt_ret(p) : b == 1 ? P_wt_win(p) : P_wt_na(p));
        f32x4 acc[4][4]; zero_acc<4>(acc);
        const u16* a0 = y + (long)(mt * 128 + r0) * 512 + ko;
        const u16* b0 = w + (long)(nt * 128 + r0) * 512 + ko;
        gemm_core<16>(acc, a0, a0 + 64 * 512, b0, b0 + 64 * 512, smem);
        int zero = 0; asm volatile("" : "+v"(zero));
#pragma unroll
        for (int m = 0; m < 4; ++m)
#pragma unroll
            for (int n = 0; n < 4; ++n)
#pragma unroll
                for (int j = 0; j < 4; ++j) {
                    int row = mt * 128 + wr * 64 + m * 16 + fq * 4 + j + zero, col = nt * 128 + wc * 64 + n * 16 + fr;
                    float g = bf2f(P_px(p)[(long)row * INC + C_GATE + b * 1024 + col]);
                    float v = acc[m][n][j] * sigmoidf_(g);
                    float* mp = macc + (long)row * DM + col;
                    if (b == 0) *mp = v;
                    else if (b == 1) *mp += v;
                    else P_hx(p)[(long)row * DM + col] = f2bf(*mp + v);
                }
    }
}
DI void phG_tile(KP p, int layer, int mt, int nt, char* smem) {
    const int tid = TIDX(), lane = tid & 63, wid = tid >> 6, wr = wid >> 1, wc = wid & 1, fr = lane & 15, fq = lane >> 4;
    f32x4 acc[4][4]; zero_acc<4>(acc);
    const int r0 = tid >> 2, ko = (tid & 3) * 8;
    const u16* a0 = P_hx(p) + (long)(mt * 128 + r0) * DM + ko;
    const u16* b0 = P_wt_out(p) + (long)(nt * 128 + r0) * DM + ko;
    gemm_core<32>(acc, a0, a0 + 64 * DM, b0, b0 + 64 * DM, smem);
    const bool lat = mt < 128;
    const float* md = P_mod(p) + (layer * 2 + (lat ? 0 : 1)) * 6144 + 2 * 1024;
#pragma unroll
    for (int m = 0; m < 4; ++m)
#pragma unroll
        for (int n = 0; n < 4; ++n)
#pragma unroll
            for (int j = 0; j < 4; ++j) {
                int row = mt * 128 + wr * 64 + m * 16 + fq * 4 + j, col = nt * 128 + wc * 64 + n * 16 + fr;
                const float* xin = resid_row(p, layer, row);
                float* xo = lat ? p->out + (long)row * DM : P_ctxres(p) + (long)(row - NLAT) * DM;
                xo[col] = xin[col] + md[col] * acc[m][n][j];
            }
}


#define LAS __attribute__((address_space(3)))
namespace g8 {
constexpr int BM = 256, BK = 64, HALF = 128, HTB = HALF * BK * 2, STAGE_BYTES = 8 * HTB;
DI int lds_byte(int r, int c) { const int st = (r >> 4) * 2 + (c >> 5), rr = r & 15, cc = c & 31, ob = rr * 64 + cc * 2; return st * 1024 + (ob ^ (((ob >> 9) & 1) << 5)); }
DI void stage_rc(int b, int& R, int& C) { const int st = b / 1024, sb = b % 1024, swz = sb ^ (((sb >> 9) & 1) << 5); R = (st >> 1) * 16 + swz / 64; C = (st & 1) * 32 + (swz % 64) / 2; }
DI int perm32(int rho) { const int n = rho >> 4, i = rho & 15; return 8 * (i >> 2) + 4 * n + (i & 3); }
struct Unit { int pm, pn, aux; };
typedef f32x4 Acc[2][2][4][2];

template <class P>
DI void gemm_phase(LAS unsigned char* lds, const P& prob) {
    const int tid = TID512(), wid = __builtin_amdgcn_readfirstlane(tid >> 6), lane = tid & 63, wr = wid >> 2, wc = wid & 3, fr = lane & 15, fq = lane >> 4;
    constexpr int K = P::K, nt = K / BK;
    int Rr[2], Cc[2];
    unsigned voffA[2], voffB[2];
#pragma unroll
    for (int i = 0; i < 2; ++i) { stage_rc(tid * 16 + i * 8192, Rr[i], Cc[i]); const int Rb = P::PERM ? ((Rr[i] & ~31) + perm32(Rr[i] & 31)) : Rr[i];
        voffA[i] = (unsigned)(Rr[i] * K + Cc[i]) * 2u; voffB[i] = (unsigned)(Rb * K + Cc[i]) * 2u; }
    constexpr size_t kstep = (size_t)(BK * 2);
    constexpr size_t hstep = (size_t)HALF * K * 2;
    const unsigned ldsw = (unsigned)wid * 1024u;
    const int aoff = lds_byte(wr * 64 + fr, fq * 8), boff = lds_byte(wc * 32 + fr, fq * 8);
    unsigned vaC[2][2], vaN[2][2];
#define G8_SA(b, h) (((b) * 2 + (h)) * HTB)
#define G8_SB(b, h) ((4 + (b) * 2 + (h)) * HTB)
#define G8_STAGEA(bufoff, base, VA, h, kt) do { _Pragma("unroll") for (int _i = 0; _i < 2; ++_i) \
        __builtin_amdgcn_global_load_lds((const unsigned*)((base) + (P::GATHER ? (size_t)(VA)[h][_i] : (size_t)voffA[_i] + (size_t)(h) * hstep) + (size_t)(kt) * kstep), (LAS unsigned*)(lds + (bufoff) + ldsw + _i * 8192), 16, 0, 0); } while (0)
#define G8_STAGEB(bufoff, base, h, kt) do { _Pragma("unroll") for (int _i = 0; _i < 2; ++_i) \
        __builtin_amdgcn_global_load_lds((const unsigned*)((base) + (size_t)(h) * hstep + voffB[_i] + (size_t)(kt) * kstep), (LAS unsigned*)(lds + (bufoff) + ldsw + _i * 8192), 16, 0, 0); } while (0)
#define G8_LDA(dst, b, h) do { _Pragma("unroll") for (int m = 0; m < 4; ++m) _Pragma("unroll") for (int k = 0; k < 2; ++k) dst[m][k] = *(const LAS bf16x8*)(lds + G8_SA(b, h) + aoff + m * 2048 + k * 1024); } while (0)
#define G8_LDB(dst, b, h) do { _Pragma("unroll") for (int n = 0; n < 2; ++n) _Pragma("unroll") for (int k = 0; k < 2; ++k) dst[n][k] = *(const LAS bf16x8*)(lds + G8_SB(b, h) + boff + n * 2048 + k * 1024); } while (0)
#define G8_MMA(ai, bj, At, Bt) do { __builtin_amdgcn_s_setprio(1); _Pragma("unroll") for (int m = 0; m < 4; ++m) _Pragma("unroll") for (int n = 0; n < 2; ++n) _Pragma("unroll") for (int k = 0; k < 2; ++k) \
        acc[ai][bj][m][n] = __builtin_amdgcn_mfma_f32_16x16x32_bf16(Bt[n][k], At[m][k], acc[ai][bj][m][n], 0, 0, 0); __builtin_amdgcn_s_setprio(0); } while (0)
#define G8_WAIT_V(n) asm volatile("s_waitcnt vmcnt(" #n ")" ::: "memory")
#define G8_WAIT_L(n) asm volatile("s_waitcnt lgkmcnt(" #n ")" ::: "memory")
#define G8_BAR __builtin_amdgcn_s_barrier()
#define G8_SCHED __builtin_amdgcn_sched_barrier(0)
    Unit cur, nxt; int ui = 0;
    __syncthreads();
    if (!prob.next(0, cur)) return;
    if (P::GATHER) prob.gather(cur, Rr, Cc, vaC);
    const char* cA = prob.a_base(cur); const char* cB = prob.b_base(cur);
    Acc acc;
#pragma unroll
    for (int a = 0; a < 2; ++a)
#pragma unroll
        for (int b = 0; b < 2; ++b)
#pragma unroll
            for (int m = 0; m < 4; ++m)
#pragma unroll
                for (int n = 0; n < 2; ++n) acc[a][b][m][n] = (f32x4){0.f, 0.f, 0.f, 0.f};
    bf16x8 At[4][2], B0[2][2], B1[2][2];
    G8_STAGEB(G8_SB(0, 0), cB, 0, 0); G8_STAGEA(G8_SA(0, 0), cA, vaC, 0, 0); G8_STAGEB(G8_SB(0, 1), cB, 1, 0); G8_STAGEA(G8_SA(0, 1), cA, vaC, 1, 0);
    if (wr == 1) G8_BAR;
    G8_WAIT_V(4); G8_BAR;
    G8_STAGEB(G8_SB(1, 0), cB, 0, 1); G8_STAGEA(G8_SA(1, 0), cA, vaC, 0, 1); G8_STAGEB(G8_SB(1, 1), cB, 1, 1);
    G8_WAIT_V(6); G8_BAR;
    for (;;) {
        const bool has_next = prob.next(ui + 1, nxt);
        if (!has_next) nxt = cur;
        if (P::GATHER) {
            if (has_next) prob.gather(nxt, Rr, Cc, vaN);
            else {
#pragma unroll
                for (int h = 0; h < 2; ++h) { vaN[h][0] = vaC[h][0]; vaN[h][1] = vaC[h][1]; }
            }
        }
        const char* nA = prob.a_base(nxt); const char* nB = prob.b_base(nxt);
#pragma unroll 1
        for (int t = 0; t < nt; t += 2) {
            const bool last = (t == nt - 2);
            const char* a2 = last ? nA : cA; const char* b2 = last ? nB : cB; const int k2 = last ? 0 : t + 2;
            unsigned va2[2][2];
#pragma unroll
            for (int h = 0; h < 2; ++h) { va2[h][0] = last ? vaN[h][0] : vaC[h][0]; va2[h][1] = last ? vaN[h][1] : vaC[h][1]; }
            G8_LDB(B0, 0, 0); G8_SCHED; G8_LDA(At, 0, 0); G8_STAGEA(G8_SA(1, 1), cA, vaC, 1, t + 1);
            G8_WAIT_L(8); G8_BAR; G8_WAIT_L(0); G8_MMA(0, 0, At, B0); G8_BAR; G8_SCHED;
            G8_LDB(B1, 0, 1); G8_STAGEB(G8_SB(0, 0), b2, 0, k2);
            G8_BAR; G8_WAIT_L(0); G8_MMA(0, 1, At, B1); G8_BAR;
            G8_LDA(At, 0, 1); G8_STAGEA(G8_SA(0, 0), a2, va2, 0, k2);
            G8_BAR; G8_WAIT_L(0); G8_MMA(1, 0, At, B0); G8_BAR; G8_SCHED;
            G8_STAGEB(G8_SB(0, 1), b2, 1, k2);
            G8_WAIT_V(6); G8_BAR; G8_MMA(1, 1, At, B1); G8_BAR;
            G8_LDB(B0, 1, 0); G8_SCHED; G8_LDA(At, 1, 0); G8_STAGEA(G8_SA(0, 1), a2, va2, 1, k2);
            G8_WAIT_L(8); G8_BAR; G8_WAIT_L(0); G8_MMA(0, 0, At, B0); G8_BAR; G8_SCHED;
            G8_LDB(B1, 1, 1); G8_STAGEB(G8_SB(1, 0), b2, 0, k2 + 1);
            G8_BAR; G8_WAIT_L(0); G8_MMA(0, 1, At, B1); G8_BAR;
            G8_LDA(At, 1, 1); G8_STAGEA(G8_SA(1, 0), a2, va2, 0, k2 + 1);
            G8_BAR; G8_WAIT_L(0); G8_MMA(1, 0, At, B0); G8_BAR; G8_SCHED;
            G8_STAGEB(G8_SB(1, 1), b2, 1, k2 + 1);
            G8_WAIT_V(6); G8_BAR; G8_MMA(1, 1, At, B1); G8_BAR;
        }
        { const int l2 = TID512() & 63; prob.epi(acc, cur, wr, wc, l2 & 15, l2 >> 4); }
        if (!has_next) break;
#pragma unroll
        for (int a = 0; a < 2; ++a)
#pragma unroll
            for (int b = 0; b < 2; ++b)
#pragma unroll
                for (int m = 0; m < 4; ++m)
#pragma unroll
                    for (int n = 0; n < 2; ++n) acc[a][b][m][n] = (f32x4){0.f, 0.f, 0.f, 0.f};
        cur = nxt; cA = nA; cB = nB; ++ui;
        if (P::GATHER) {
#pragma unroll
            for (int h = 0; h < 2; ++h) { vaC[h][0] = vaN[h][0]; vaC[h][1] = vaN[h][1]; }
        }
    }
    G8_WAIT_V(0);
    if (wr == 0) G8_BAR;
    G8_BAR;
#undef G8_SA
#undef G8_SB
#undef G8_STAGEA
#undef G8_STAGEB
#undef G8_LDA
#undef G8_LDB
#undef G8_MMA
#undef G8_WAIT_V
#undef G8_WAIT_L
#undef G8_BAR
#undef G8_SCHED
}
}

struct ProbG {
    static constexpr int K = 1024; static constexpr bool PERM = false, GATHER = false;
    KP p; int layer;
    DI bool next(int i, g8::Unit& u) const {
        const int id = i * (int)gridDim.x + BIDX();
        if (id >= 256) return false;
        u.pm = id >> 2; u.pn = id & 3; u.aux = 0;
        return true;
    }
    DI const char* a_base(const g8::Unit& u) const { return (const char*)(P_hx(p) + (long)u.pm * 256 * DM); }
    DI const char* b_base(const g8::Unit& u) const { return (const char*)(P_wt_out(p) + (long)u.pn * 256 * DM); }
    DI void gather(const g8::Unit&, const int (&)[2], const int (&)[2], unsigned (&)[2][2]) const {}
    DI void epi(g8::Acc& acc, const g8::Unit& u, int wr, int wc, int fr, int fq) const {
        const float* xin = layer == 0 ? p->x : p->out;
        const float* md = P_mod(p) + (layer * 2) * 6144 + 2 * 1024;
#pragma unroll
        for (int bj = 0; bj < 2; ++bj)
#pragma unroll
            for (int n = 0; n < 2; ++n) {
                const int col = u.pn * 256 + bj * 128 + wc * 32 + n * 16 + fq * 4;
                const f32x4 mv = *(const f32x4*)(md + col);
#pragma unroll
                for (int ai = 0; ai < 2; ++ai)
#pragma unroll
                    for (int m = 0; m < 4; ++m) {
                        const long row = (long)u.pm * 256 + ai * 128 + wr * 64 + m * 16 + fr;
                        const f32x4 xv = *(const f32x4*)(xin + row * DM + col);
                        *(f32x4*)(p->out + row * DM + col) = xv + mv * acc[ai][bj][m][n];
                    }
            }
    }
};


struct ProbB {
    static constexpr int K = 1024; static constexpr bool PERM = true, GATHER = false;
    KP p;
    DI bool next(int i, g8::Unit& u) const {
        constexpr int nM = 65, nN = 29, nwg = nM * nN, NX = 8, WGM = 8;
        const long L = (long)i * (int)gridDim.x + BIDX(); if (L >= nwg) return false;
        int wgid = (int)L; { const int q = nwg / NX, r = nwg % NX, xcd = wgid % NX, off = wgid / NX; wgid = (xcd < r ? xcd * (q + 1) : r * (q + 1) + (xcd - r) * q) + off; }
        const int nig = WGM * nN, gid = wgid / nig, fm = gid * WGM, gsz = (nM - fm) < WGM ? (nM - fm) : WGM;
        u.pm = fm + ((wgid % nig) % gsz); u.pn = (wgid % nig) / gsz; u.aux = 0; return true;
    }
    DI const char* a_base(const g8::Unit& u) const { return (const char*)(P_hx(p) + (long)u.pm * 256 * DM); }
    DI const char* b_base(const g8::Unit& u) const { return (const char*)(P_wt_in(p) + (long)u.pn * 256 * DM); }
    DI void gather(const g8::Unit&, const int (&)[2], const int (&)[2], unsigned (&)[2][2]) const {}
    DI void epi(g8::Acc& acc, const g8::Unit& u, int wr, int wc, int fr, int fq) const {
        const int pn = u.pn;
        const bool lat = u.pm < 64;
        const int rk = !lat ? 0 : (pn < 4) ? 1 : (pn == 8 || pn == 9 || (pn == 10 && wc < 2)) ? 2 : 0;
        const float mul = (pn == 2 || pn == 3) ? 0.08838834764831845f : (pn == 8 || pn == 9 || pn == 11 || pn == 12) ? 0.125f : 1.f;
#pragma unroll
        for (int ai = 0; ai < 2; ++ai)
#pragma unroll
            for (int m = 0; m < 4; ++m) {
                const int row = u.pm * 256 + ai * 128 + wr * 64 + m * 16 + fr;
                if (rk != 0) {
                    const float2* tab;
                    if (rk == 1) tab = P_rope128(p) + ((wc & 1) ? (row & 63) : (row >> 6)) * 32 + fq * 8;
                    else tab = P_rope64(p) + ((fq >= 2) ? (row & 63) : (row >> 6)) * 16 + (fq & 1) * 8;
#pragma unroll
                    for (int n = 0; n < 2; ++n) {
                        const f32x4 c01 = *(const f32x4*)(tab + n * 4), c23 = *(const f32x4*)(tab + n * 4 + 2);
                        const float cs_[4] = {c01[0], c01[2], c23[0], c23[2]}, sn_[4] = {c01[1], c01[3], c23[1], c23[3]};
#pragma unroll
                        for (int e = 0; e < 4; ++e) {
                            const float x1 = acc[ai][0][m][n][e], x2 = acc[ai][1][m][n][e];
                            acc[ai][0][m][n][e] = x1 * cs_[e] - x2 * sn_[e];
                            acc[ai][1][m][n][e] = x1 * sn_[e] + x2 * cs_[e];
                        }
                    }
                }
                u16* orow = P_px(p) + (long)row * INC + pn * 256 + wc * 32 + fq * 8;
#pragma unroll
                for (int bj = 0; bj < 2; ++bj) {
                    u32x4 o;
#pragma unroll
                    for (int n = 0; n < 2; ++n)
#pragma unroll
                        for (int e = 0; e < 2; ++e) o[2 * n + e] = pack2(acc[ai][bj][m][n][2 * e] * mul, acc[ai][bj][m][n][2 * e + 1] * mul);
                    *(u32x4*)(orow + bj * 128) = o;
                }
            }
    }
};
struct ProbF {
    static constexpr int K = 512; static constexpr bool PERM = true, GATHER = false;
    KP p;
    DI bool next(int i, g8::Unit& u) const {
        const int tile = (i / 3) * (int)gridDim.x + BIDX();
        if (tile >= 256) return false;
        u.pm = tile >> 2; u.pn = tile & 3; u.aux = i % 3;
        return true;
    }
    DI const char* a_base(const g8::Unit& u) const { const u16* y = u.aux == 0 ? P_ya(p) : u.aux == 1 ? P_yb(p) : P_yc(p); return (const char*)(y + (long)u.pm * 256 * 512); }
    DI const char* b_base(const g8::Unit& u) const { const u16* w = u.aux == 0 ? P_wt_ret(p) : u.aux == 1 ? P_wt_win(p) : P_wt_na(p); return (const char*)(w + (long)u.pn * 256 * 512); }
    DI void gather(const g8::Unit&, const int (&)[2], const int (&)[2], unsigned (&)[2][2]) const {}
    DI void epi(g8::Acc& acc, const g8::Unit& u, int wr, int wc, int fr, int fq) const {
        const int b = u.aux;
        u16* z = P_z(p) + (long)b * NLAT * DM;
        const long row0 = (long)u.pm * 256 + wr * 64 + fr;
        const int col0 = u.pn * 256 + wc * 32 + fq * 8;
#pragma unroll
        for (int ai = 0; ai < 2; ++ai)
#pragma unroll
            for (int m = 0; m < 4; ++m)
#pragma unroll
                for (int bj = 0; bj < 2; ++bj) {
                    u32x4 o;
#pragma unroll
                    for (int n = 0; n < 2; ++n)
#pragma unroll
                        for (int e = 0; e < 2; ++e) o[2 * n + e] = pack2(acc[ai][bj][m][n][2 * e], acc[ai][bj][m][n][2 * e + 1]);
                    *(u32x4*)(z + (row0 + ai * 128 + m * 16) * DM + col0 + bj * 128) = o;
                }
        if (b != 2) return;
        asm volatile("" ::: "memory");
        const u16* zb = P_z(p);
        const u16* gp = P_px(p) + C_GATE;
#pragma unroll 4
        for (int g = 0; g < 16; ++g) {
            const int ai = g >> 3, m = (g >> 1) & 3, bj = g & 1;
            const long row = row0 + ai * 128 + m * 16; const int col = col0 + bj * 128;
            u32x4 zv[3], gv[3];
#pragma unroll
            for (int q = 0; q < 3; ++q) { zv[q] = *(const u32x4*)(zb + ((long)q * NLAT + row) * DM + col); gv[q] = *(const u32x4*)(gp + row * INC + q * 1024 + col); }
            u32x4 o;
#pragma unroll
            for (int e = 0; e < 4; ++e) {
                float lo = 0.f, hi = 0.f;
#pragma unroll
                for (int q = 0; q < 3; ++q) { lo += bflo(zv[q][e]) * sigmoidf_(bflo(gv[q][e])); hi += bfhi(zv[q][e]) * sigmoidf_(bfhi(gv[q][e])); }
                o[e] = pack2(lo, hi);
            }
            *(u32x4*)(P_hx(p) + row * DM + col) = o;
        }
    }
};
struct ProbJ {
    static constexpr int K = 1024; static constexpr bool PERM = true, GATHER = true;
    KP p;
    DI bool next(int i, g8::Unit& u) const {
        const int id = i * (int)gridDim.x + BIDX();
        if (id >= 1024) return false;
        u.aux = id >> 6; u.pm = (id >> 3) & 7; u.pn = id & 7;
        return true;
    }
    DI const char* a_base(const g8::Unit&) const { return (const char*)P_hx(p); }
    DI const char* b_base(const g8::Unit& u) const { return (const char*)(P_wt_gu(p) + ((long)u.aux * 2048 + u.pn * 256) * DM); }
    DI void gather(const g8::Unit& u, const int (&R)[2], const int (&C)[2], unsigned (&va)[2][2]) const {
        const int* si = P_sel_idx(p) + u.aux * 2048 + u.pm * 256;
#pragma unroll
        for (int h = 0; h < 2; ++h)
#pragma unroll
            for (int j = 0; j < 2; ++j) va[h][j] = (unsigned)(si[h * 128 + R[j]] * DM + C[j]) * 2u;
    }
    DI void epi(g8::Acc& acc, const g8::Unit& u, int wr, int wc, int fr, int fq) const {
        u16* hb = P_hid(p) + (long)u.aux * 2048 * EH;
#pragma unroll
        for (int ai = 0; ai < 2; ++ai)
#pragma unroll
            for (int m = 0; m < 4; ++m) {
                const int slot = u.pm * 256 + ai * 128 + wr * 64 + m * 16 + fr;
                const int f = u.pn * 128 + wc * 32 + fq * 8;
                u32x4 o;
#pragma unroll
                for (int n = 0; n < 2; ++n)
#pragma unroll
                    for (int e = 0; e < 2; ++e)
                        o[2 * n + e] = pack2(siluf_(acc[ai][0][m][n][2 * e]) * acc[ai][1][m][n][2 * e], siluf_(acc[ai][0][m][n][2 * e + 1]) * acc[ai][1][m][n][2 * e + 1]);
                *(u32x4*)(hb + (long)slot * EH + f) = o;
            }
    }
};
struct ProbK {
    static constexpr int K = 1024; static constexpr bool PERM = true, GATHER = false;
    KP p; int layer;
    DI bool next(int i, g8::Unit& u) const {
        const int id = i * (int)gridDim.x + BIDX();
        if (id >= 512) return false;
        u.aux = id >> 5; u.pm = (id >> 2) & 7; u.pn = id & 3;
        return true;
    }
    DI const char* a_base(const g8::Unit& u) const { return (const char*)(P_hid(p) + ((long)u.aux * 2048 + u.pm * 256) * EH); }
    DI const char* b_base(const g8::Unit& u) const { return (const char*)(P_wt_dn(p) + ((long)u.aux * 1024 + u.pn * 256) * EH); }
    DI void gather(const g8::Unit&, const int (&)[2], const int (&)[2], unsigned (&)[2][2]) const {}
    DI void epi(g8::Acc& acc, const g8::Unit& u, int wr, int wc, int fr, int fq) const {
        const float* md = P_mod(p) + (layer * 2) * 6144 + 5 * 1024;
        f32x4 mv[2][2];
#pragma unroll
        for (int bj = 0; bj < 2; ++bj)
#pragma unroll
            for (int n = 0; n < 2; ++n) mv[bj][n] = *(const f32x4*)(md + u.pn * 256 + bj * 128 + wc * 32 + fq * 8 + n * 4);
#pragma unroll
        for (int ai = 0; ai < 2; ++ai)
#pragma unroll
            for (int m = 0; m < 4; ++m) {
                const int slot = u.aux * 2048 + u.pm * 256 + ai * 128 + wr * 64 + m * 16 + fr;
                const float g = P_sel_gate(p)[slot];
                u16* yr = P_ye(p) + (long)slot * DM + u.pn * 256 + wc * 32 + fq * 8;
#pragma unroll
                for (int bj = 0; bj < 2; ++bj) {
                    u32x4 o;
#pragma unroll
                    for (int n = 0; n < 2; ++n)
#pragma unroll
                        for (int e = 0; e < 2; ++e)
                            o[2 * n + e] = pack2(acc[ai][bj][m][n][2 * e] * g * mv[bj][n][2 * e], acc[ai][bj][m][n][2 * e + 1] * g * mv[bj][n][2 * e + 1]);
                    *(u32x4*)(yr + bj * 128) = o;
                }
            }
    }
};

DI void phH_item(KP p, int layer, int item, char* smem) {
    const int lane = TIDX() & 63, wid = TIDX() >> 6;
    float* hrow = (float*)smem + wid * 2048;
    const int row0 = item * 8 + wid * 2;
    norm_row(p, layer, row0, cur_row(p, row0), p->g_ffn + layer * DM, 3, 4, P_hx(p) + (long)row0 * DM, hrow, nullptr);
    norm_row(p, layer, row0 + 1, cur_row(p, row0 + 1), p->g_ffn + layer * DM, 3, 4, P_hx(p) + (long)(row0 + 1) * DM, hrow + 1024, nullptr);
    const int e = lane & 15, kp = lane >> 4;
    const float* wr_ = p->w_router + (long)layer * 1024 * 16 + e;
    float l0 = 0.f, l1 = 0.f;
#pragma unroll 8
    for (int k = kp * 256; k < kp * 256 + 256; ++k) {
        float w = wr_[k * 16];
        l0 += hrow[k] * w; l1 += hrow[1024 + k] * w;
    }
    l0 += __shfl_xor(l0, 16); l0 += __shfl_xor(l0, 32);
    l1 += __shfl_xor(l1, 16); l1 += __shfl_xor(l1, 32);
#pragma unroll
    for (int r = 0; r < 2; ++r) {
        float lg = r == 0 ? l0 : l1;
        float mx = lg;
        mx = fmaxf(mx, __shfl_xor(mx, 1)); mx = fmaxf(mx, __shfl_xor(mx, 2)); mx = fmaxf(mx, __shfl_xor(mx, 4)); mx = fmaxf(mx, __shfl_xor(mx, 8));
        float ex = expf(lg - mx);
        float sm = ex;
        sm += __shfl_xor(sm, 1); sm += __shfl_xor(sm, 2); sm += __shfl_xor(sm, 4); sm += __shfl_xor(sm, 8);
        float a = ex / sm;
        int row = row0 + r;
        if (lane < 16) {
            if (row < NLAT) P_aff(p)[(long)e * NLAT + row] = a;
            else P_aff(p)[(long)(16 + e) * NLAT + (row - NLAT)] = a;
        }
    }
    __syncthreads();
}

DI int block_excl_scan(int v, int* sh  , int& total) {
    const int lane = TIDX() & 63, wid = TIDX() >> 6;
    int inc = v;
    for (int o = 1; o < 64; o <<= 1) { int t = __shfl_up(inc, o); if (lane >= o) inc += t; }
    __syncthreads();
    if (lane == 63) sh[wid] = inc;
    __syncthreads();
    int base = 0;
    for (int w = 0; w < wid; ++w) base += sh[w];
    total = sh[0] + sh[1] + sh[2] + sh[3];
    return base + inc - v;
}
DI void phI_item(KP p, int job, char* smem) {
    const int tid = TIDX();
    const int n = job < 16 ? NLAT : NCTX, cap = job < 16 ? CAP_LAT : CAP_CTX, rowbase = job < 16 ? 0 : NLAT;
    unsigned* keys = (unsigned*)smem;
    int* hist = (int*)(smem + 66560);
    int* sh = hist + 256;
    const float* a = P_aff(p) + (long)job * NLAT;
    __syncthreads();
    for (int i = tid; i < n; i += 256) keys[i + (i >> 6)] = __float_as_uint(a[i]);
    unsigned prefix = 0, mask = 0; int remaining = cap;
    for (int pass = 0; pass < 4; ++pass) {
        const int shift = 24 - 8 * pass;
        hist[tid] = 0;
        __syncthreads();
        for (int i = tid; i < n; i += 256) {
            unsigned k = keys[i + (i >> 6)];
            if ((k & mask) == prefix) atomicAdd(&hist[(k >> shift) & 255], 1);
        }
        __syncthreads();
        if (tid == 0) {
            int cum = 0, b = 255;
            for (; b > 0; --b) { if (cum + hist[b] >= remaining) break; cum += hist[b]; }
            sh[8] = b; sh[9] = remaining - cum;
        }
        __syncthreads();
        prefix |= ((unsigned)sh[8]) << shift; mask |= 255u << shift; remaining = sh[9];
        __syncthreads();
    }
    const unsigned T = prefix;
    const int per = n / 256;
    int ceq = 0;
    for (int i = 0; i < per; ++i) { int idx = tid * per + i; ceq += (keys[idx + (idx >> 6)] == T); }
    int tot;
    int eqb = block_excl_scan(ceq, sh, tot);
    int csel = 0, er = eqb;
    for (int i = 0; i < per; ++i) {
        int idx = tid * per + i; unsigned k = keys[idx + (idx >> 6)];
        if (k > T) ++csel; else if (k == T) { if (er < remaining) ++csel; ++er; }
    }
    int slot = block_excl_scan(csel, sh, tot);
    int* ts = P_tslot(p) + (long)job * NLAT;
    for (int i = tid; i < n; i += 256) ts[i] = -1;
    __syncthreads();
    er = eqb;
    for (int i = 0; i < per; ++i) {
        int idx = tid * per + i; unsigned k = keys[idx + (idx >> 6)];
        bool s = false;
        if (k > T) s = true; else if (k == T) { s = er < remaining; ++er; }
        if (s) { P_sel_idx(p)[job * 2048 + slot] = rowbase + idx; P_sel_gate(p)[job * 2048 + slot] = __uint_as_float(k); ts[idx] = slot; ++slot; }
    }
    __syncthreads();
}

DI void phJ_tile(KP p, int job, int mt, int nt, char* smem) {
    const int tid = TIDX(), lane = tid & 63, wid = tid >> 6, wr = wid >> 1, wc = wid & 1, fr = lane & 15, fq = lane >> 4;
    const int cap = job < 16 ? CAP_LAT : CAP_CTX, e = job & 15;
    f32x4 acc[4][4]; zero_acc<4>(acc);
    const int r0 = tid >> 2, ko = (tid & 3) * 8;
    int s0 = mt * 128 + r0, s1 = s0 + 64;
    s0 = s0 < cap ? s0 : cap - 1; s1 = s1 < cap ? s1 : cap - 1;
    const u16* a0 = P_hx(p) + (long)P_sel_idx(p)[job * 2048 + s0] * DM + ko;
    const u16* a1 = P_hx(p) + (long)P_sel_idx(p)[job * 2048 + s1] * DM + ko;
    const int f_lo = nt * 64 + (r0 & 31), f_hi = f_lo + 32, gu = (r0 >> 5) & 1;
    const u16* b0 = P_wt_gu(p) + ((long)e * 2048 + (f_lo >> 7) * 256 + gu * 128 + (f_lo & 127)) * DM + ko;
    const u16* b1 = P_wt_gu(p) + ((long)e * 2048 + (f_hi >> 7) * 256 + gu * 128 + (f_hi & 127)) * DM + ko;
    gemm_core<32>(acc, a0, a1, b0, b1, smem);
    u16* hb = job < 16 ? P_hid(p) + (long)job * 2048 * EH : P_hidc(p) + (long)(job - 16) * 32 * EH;
#pragma unroll
    for (int m = 0; m < 4; ++m)
#pragma unroll
        for (int n = 0; n < 2; ++n)
#pragma unroll
            for (int j = 0; j < 4; ++j) {
                int slot = mt * 128 + wr * 64 + m * 16 + fq * 4 + j;
                int f = nt * 64 + wc * 32 + n * 16 + fr;
                if (slot < cap) hb[(long)slot * EH + f] = f2bf(siluf_(acc[m][n][j]) * acc[m][n + 2][j]);
            }
}
DI void phK_tile(KP p, int layer, int job, int mt, int nt, char* smem) {
    const int tid = TIDX(), lane = tid & 63, wid = tid >> 6, wr = wid >> 1, wc = wid & 1, fr = lane & 15, fq = lane >> 4;
    const int cap = job < 16 ? CAP_LAT : CAP_CTX, e = job & 15;
    f32x4 acc[4][4]; zero_acc<4>(acc);
    const int r0 = tid >> 2, ko = (tid & 3) * 8;
    int s0 = mt * 128 + r0, s1 = s0 + 64;
    s0 = s0 < cap ? s0 : cap - 1; s1 = s1 < cap ? s1 : cap - 1;
    const u16* hb = job < 16 ? P_hid(p) + (long)job * 2048 * EH : P_hidc(p) + (long)(job - 16) * 32 * EH;
    const u16* a0 = hb + (long)s0 * EH + ko;
    const u16* a1 = hb + (long)s1 * EH + ko;
    const u16* b0 = P_wt_dn(p) + ((long)e * 1024 + nt * 128 + r0) * EH + ko;
    gemm_core<32>(acc, a0, a1, b0, b0 + 64 * EH, smem);
    const float* md = P_mod(p) + (layer * 2 + (job < 16 ? 0 : 1)) * 6144 + 5 * 1024;
    u16* yb_ = job < 16 ? P_ye(p) + (long)job * 2048 * DM : P_yec(p) + (long)(job - 16) * 32 * DM;
#pragma unroll
    for (int m = 0; m < 4; ++m)
#pragma unroll
        for (int j = 0; j < 4; ++j) {
            int slot = mt * 128 + wr * 64 + m * 16 + fq * 4 + j;
            if (slot < cap) {
                float g = P_sel_gate(p)[job * 2048 + slot];
#pragma unroll
                for (int n = 0; n < 4; ++n) {
                    int col = nt * 128 + wc * 64 + n * 16 + fr;
                    yb_[(long)slot * DM + col] = f2bf(acc[m][n][j] * g * md[col]);
                }
            }
        }
}

DI void run_phase(int ph, char* smem_all) {
    KP p = (KP)__builtin_amdgcn_kernarg_segment_ptr();
    asm volatile("" : "+s"(p));
    const int sb = TID512() >> 8;
    char* smem = smem_all + sb * SUB_LDS;
    const int bid = BIDX() * 2 + sb, nb = gridDim.x * 2, tid = TIDX(), wid = tid >> 6;
#ifndef ONLY_SUB
    if (ph == 0) {
        const int total = 192 + 48 + CONV_TILES;
        for (int it = bid; it < total; it += nb) {
            if (it < 192) ph0_gemv_item(p, it, smem);
            else if (it < 240) ph0_rope_item(p, it - 192);
            else convert_tile(p, 0, it - 240, smem);
        }
        return;
    }
    if (ph == NPHASE - 1) {
        for (int it = bid; it < NLAT / 4; it += nb) {
            int row = it * 4 + wid, lane = tid & 63;
            float* xr = p->out + (long)row * DM;
            float4 v[4]; float ss = 0.f;
#pragma unroll
            for (int i = 0; i < 4; ++i) v[i] = *(const float4*)(xr + i * 256 + lane * 4);
            moe_combine(p, row, v);
#pragma unroll
            for (int i = 0; i < 4; ++i) ss += v[i].x * v[i].x + v[i].y * v[i].y + v[i].z * v[i].z + v[i].w * v[i].w;
            ss = wave_sum(ss);
            float rstd = rsqrtf(ss * (1.f / DM) + 1e-6f);
#pragma unroll
            for (int i = 0; i < 4; ++i) {
                float4 g = *(const float4*)(p->g_final + i * 256 + lane * 4);
                *(float4*)(xr + i * 256 + lane * 4) = make_float4(v[i].x * rstd * g.x, v[i].y * rstd * g.y, v[i].z * rstd * g.z, v[i].w * rstd * g.w);
            }
        }
        return;
    }
    const int layer = (ph - 1) / 11, sub = (ph - 1) % 11;
#else
    const int layer = (ph - 1) / 11, sub = ONLY_SUB;
#endif
    const bool need_ctx = layer == 0;
    switch (sub) {
    case 0: {
        const int nrow_items = NROWS / 4;
        const int total = nrow_items + (layer == 1 ? CONV_TILES : 0);
        for (int it = bid; it < total; it += nb) {
            if (it < nrow_items) { int row = it * 4 + wid; norm_row(p, layer, row, resid_row(p, layer, row), p->g_mix + layer * DM, 0, 1, P_hx(p) + (long)row * DM, nullptr, layer == 1 ? (float*)cur_row(p, row) : nullptr); }
            else convert_tile(p, layer, it - nrow_items, smem);
        }
    } break;
    case 1: {
        ProbB pb{p}; g8::gemm_phase((LAS unsigned char*)smem_all, pb);
    } break;
    case 2: {
        const int n_state = NCHUNK * 8, n_win = 1024, n_na = 1024, n_cx = need_ctx ? 32 : 0;
        const int total = n_state + n_win + n_na + n_cx;
        for (int it = bid; it < total; it += nb) {
            if (it < n_win) attn_wave_item(p, layer, 0, it >> 1, (it & 1) * 4 + wid, smem);
            else if (it < n_win + n_na) { int i2 = it - n_win; attn_wave_item(p, layer, 1, i2 >> 1, (i2 & 1) * 4 + wid, smem); }
            else if (it < n_win + n_na + n_state) { int i2 = it - n_win - n_na; phC_state_item(p, layer, i2 >> 3, (i2 >> 1) & 3, i2 & 1, smem); }
            else { int i2 = it - n_win - n_na - n_state; int kind = 2 + (i2 >> 4); i2 &= 15; attn_wave_item(p, layer, kind, i2 >> 1, (i2 & 1) * 4 + wid, smem); }
        }
    } break;
    case 3: {
        for (int it = bid; it < 512; it += nb) phD_item(p, layer, it);
    } break;
    case 4: {
        const int nch = need_ctx ? NCHUNK : 128;
        for (int it = bid; it < nch * 8; it += nb) phE_item(p, layer, it >> 3, (it >> 1) & 3, it & 1, smem);
    } break;
    case 5: {
        { ProbF pf{p}; g8::gemm_phase((LAS unsigned char*)smem_all, pf); }
        if (need_ctx) {
            const int sb2 = TID512() >> 8;
            for (int it = BIDX() * 2 + sb2; it < 16; it += (int)gridDim.x * 2) phF_tile(p, 128 + (it >> 3), it & 7, smem_all + sb2 * SUB_LDS);
        }
    } break;
    case 6: {
        { ProbG pg{p, layer}; g8::gemm_phase((LAS unsigned char*)smem_all, pg); }
        if (need_ctx) {
            const int sb2 = TID512() >> 8;
            for (int it = BIDX() * 2 + sb2; it < 16; it += (int)gridDim.x * 2) phG_tile(p, layer, 128 + (it >> 3), it & 7, smem_all + sb2 * SUB_LDS);
        }
    } break;
    case 7: {
        const int nit = (need_ctx ? NROWS : NLAT) / 8;
        for (int it = bid; it < nit; it += nb) phH_item(p, layer, it, smem);
    } break;
    case 8: {
        const int njob = need_ctx ? 32 : 16;
        for (int it = bid; it < njob; it += nb) phI_item(p, it, smem);
    } break;
    case 9: {
        { ProbJ pj{p}; g8::gemm_phase((LAS unsigned char*)smem_all, pj); }
        if (need_ctx) {
            const int sb2 = TID512() >> 8;
            for (int it = BIDX() * 2 + sb2; it < 256; it += (int)gridDim.x * 2) phJ_tile(p, 16 + (it >> 4), 0, it & 15, smem_all + sb2 * SUB_LDS);
        }
    } break;
    case 10: {
        { ProbK pk{p, layer}; g8::gemm_phase((LAS unsigned char*)smem_all, pk); }
        if (need_ctx) {
            const int sb2 = TID512() >> 8;
            for (int it = BIDX() * 2 + sb2; it < 128; it += (int)gridDim.x * 2) phK_tile(p, layer, 16 + (it >> 3), 0, it & 7, smem_all + sb2 * SUB_LDS);
        }
    } break;
    }
}

__global__ void __launch_bounds__(NTHREADS, 2) mega_kernel(Params p, int ph_lo, int ph_hi) {
    __shared__ __attribute__((aligned(16))) char smem[LDS_BYTES];
    cg::grid_group grid = cg::this_grid();
#if MK_MULTI
    for (int ph = ph_lo; ph < ph_hi; ++ph) {
        if (ph > ph_lo) grid.sync();
        run_phase(ph, smem);
    }
#else
#ifdef PROBE_SUB
#define PH(n) do { if ((n) > 0) grid.sync(); run_phase((n), smem); if ((n) >= PROBE_MIN && (n) <= PROBE_MAX && (((n) - 1) % 11) == PROBE_SUB) { grid.sync(); run_phase((n), smem); } } while (0)
#else
#define PH(n) do { if ((n) > 0) grid.sync(); run_phase((n), smem); } while (0)
#endif
    PH(0); PH(1); PH(2); PH(3); PH(4); PH(5); PH(6); PH(7); PH(8); PH(9); PH(10); PH(11);
    PH(12); PH(13); PH(14); PH(15); PH(16); PH(17); PH(18); PH(19); PH(20); PH(21); PH(22); PH(23);
    static_assert(NPHASE == 24, "phase program");
#undef PH
#endif
}

extern "C" void kernel_launch(void* const* d_in, const int* in_sizes, int n_in, void* d_out, int out_size, void* d_ws, size_t ws_size,
                              hipStream_t stream) {
    static int grid_blocks = 0;
    if (!grid_blocks) {
        int dev = 0, cus = 0, per_cu = 0;
        hipGetDevice(&dev);
        hipDeviceGetAttribute(&cus, hipDeviceAttributeMultiprocessorCount, dev);
        hipOccupancyMaxActiveBlocksPerMultiprocessor(&per_cu, mega_kernel, NTHREADS, 0);
        if (per_cu < 1) per_cu = 1;
        if (per_cu > 1) per_cu = 1;
        grid_blocks = cus * per_cu;
    }
    Params p{};
    const float** ip = (const float**)&p.x;
    for (int i = 0; i < 22; ++i) ip[i] = (const float*)d_in[i];
    p.out = (float*)d_out;
    p.ws = (char*)d_ws;
    if (WS_END > ws_size) { fprintf(stderr, "kernel_launch: workspace too small: need %zu have %zu\n", (size_t)WS_END, ws_size); return; }
#if MK_MULTI
    for (int ph = 0; ph < NPHASE; ++ph) {
        hipLaunchKernelGGL(mega_kernel, dim3(grid_blocks), dim3(NTHREADS), 0, stream, p, ph, ph + 1);
    }
#else
    int lo = 0, hi = NPHASE;
    void* args[] = {&p, &lo, &hi};
    hipError_t e = hipLaunchCooperativeKernel((void*)mega_kernel, dim3(grid_blocks), dim3(NTHREADS), args, 0, stream);
    if (e != hipSuccess) fprintf(stderr, "cooperative launch failed: %s (grid %d)\n", hipGetErrorString(e), grid_blocks);
#endif
}
```

```cpp
#include <hip/hip_runtime.h>
#include <hip/hip_bf16.h>
#include <hip/hip_cooperative_groups.h>
#include <cstdio>
#include <cstdint>
namespace cg = cooperative_groups;

#ifndef MK_MULTI
#define MK_MULTI 0
#endif

#define DI __device__ __forceinline__
typedef unsigned short u16;
typedef __attribute__((ext_vector_type(8))) short bf16x8;
typedef __attribute__((ext_vector_type(4))) float f32x4;
typedef __attribute__((ext_vector_type(4))) unsigned int u32x4;

constexpr int NLAT = 16384, NCTX = 256, NROWS = NLAT + NCTX, DM = 1024, INC = 7424;
constexpr int C_QR = 0, C_KR = 512, C_VR = 1024, C_GR = 1536, C_QW = 2048, C_KW = 2560, C_VW = 2688, C_QN = 2816, C_KN = 3328, C_VN = 3840, C_GATE = 4352;
__host__ __device__ constexpr int col_qr(int h, int x) { return C_QR + (h >> 1) * 256 + x * 128 + (h & 1) * 64; }
__host__ __device__ constexpr int col_kr(int h, int x) { return C_KR + (h >> 1) * 256 + x * 128 + (h & 1) * 64; }
__host__ __device__ constexpr int col_qw(int h, int x) { return C_QW + (h >> 2) * 256 + x * 128 + (h & 3) * 32; }
__host__ __device__ constexpr int col_kw(int kh, int x) { return C_KW + x * 128 + kh * 32; }
__host__ __device__ constexpr int col_vw(int kh) { return C_KW + 64 + kh * 128; }
constexpr int NCHUNK = NROWS / 128;
constexpr int NEXP = 16, EH = 1024, CAP_LAT = 2048, CAP_CTX = 32;
constexpr int NTHREADS = 512;
constexpr int SUB_LDS = 76 * 1024;
constexpr int LDS_BYTES = 2 * SUB_LDS;
constexpr int NPHASE = 24;


constexpr size_t al256(size_t b) { return (b + 255) & ~(size_t)255; }
constexpr size_t WS_CTXRES = 0;
constexpr size_t WS_MOD = WS_CTXRES + al256((size_t)NCTX * DM * 4);
constexpr size_t WS_ROPE128 = WS_MOD + al256(2 * 2 * 6144 * 4);
constexpr size_t WS_ROPE64 = WS_ROPE128 + al256(256 * 32 * 8);
constexpr size_t WS_WT_IN = WS_ROPE64 + al256(256 * 16 * 8);
constexpr size_t WS_WT_RET = WS_WT_IN + al256((size_t)INC * DM * 2);
constexpr size_t WS_WT_WIN = WS_WT_RET + al256((size_t)1024 * 512 * 2);
constexpr size_t WS_WT_NA = WS_WT_WIN + al256((size_t)1024 * 512 * 2);
constexpr size_t WS_WT_OUT = WS_WT_NA + al256((size_t)1024 * 512 * 2);
constexpr size_t WS_WT_GU = WS_WT_OUT + al256((size_t)1024 * 1024 * 2);
constexpr size_t WS_WT_DN = WS_WT_GU + al256((size_t)NEXP * 2048 * 1024 * 2);
constexpr size_t WS_HX = WS_WT_DN + al256((size_t)NEXP * 1024 * 1024 * 2);
constexpr size_t WS_PX = WS_HX + al256((size_t)NROWS * DM * 2);
constexpr size_t WS_YA = WS_PX + al256((size_t)NROWS * INC * 2);
constexpr size_t WS_YB = WS_YA + al256((size_t)NROWS * 512 * 2);
constexpr size_t WS_YC = WS_YB + al256((size_t)NROWS * 512 * 2);
constexpr size_t WS_S = WS_YC + al256((size_t)NROWS * 512 * 2);
constexpr size_t WS_R = WS_S + al256((size_t)NCHUNK * 8 * 16384 * 4);
constexpr size_t WS_AFF = WS_R + al256((size_t)NCHUNK * 8 * 16384 * 2);
constexpr size_t WS_SELI = WS_AFF + al256((size_t)32 * NLAT * 4);
constexpr size_t WS_SELG = WS_SELI + al256(32 * 2048 * 4);
constexpr size_t WS_TSLOT = WS_SELG + al256(32 * 2048 * 4);
constexpr size_t WS_BAR = WS_TSLOT + al256((size_t)32 * NLAT * 4);
constexpr size_t WS_END = WS_BAR + al256(3456 * 4);
struct Params {
    const float *x, *c, *ctx, *c_ctx, *w_mod, *b_mod, *g_mix, *g_ffn, *w_in, *decay, *ret_gn, *w_ret, *sink, *w_win, *rpb, *w_na, *w_out,
        *w_router, *w_eg, *w_eu, *w_ed, *g_final;
    float* out;
    char* ws;
};
typedef const Params __attribute__((address_space(4)))* KP;
#define WSF(name, type, off) __device__ __forceinline__ type* P_##name(KP p) { return (type*)(p->ws + (off)); }
WSF(ctxres, float, WS_CTXRES)
WSF(mod, float, WS_MOD)
WSF(rope128, float2, WS_ROPE128)
WSF(rope64, float2, WS_ROPE64)
WSF(wt_in, u16, WS_WT_IN) WSF(wt_ret, u16, WS_WT_RET) WSF(wt_win, u16, WS_WT_WIN) WSF(wt_na, u16, WS_WT_NA) WSF(wt_out, u16, WS_WT_OUT)
WSF(wt_gu, u16, WS_WT_GU) WSF(wt_dn, u16, WS_WT_DN)
WSF(hx, u16, WS_HX)
WSF(px, u16, WS_PX)
WSF(ya, u16, WS_YA) WSF(yb, u16, WS_YB) WSF(yc, u16, WS_YC)
WSF(S, float, WS_S)
WSF(R, u16, WS_R)
WSF(aff, float, WS_AFF)
WSF(sel_idx, int, WS_SELI) WSF(sel_gate, float, WS_SELG)
WSF(hid, u16, WS_PX)
__device__ __forceinline__ u16* P_hidc(KP p) { return (u16*)(p->ws + WS_PX) + (size_t)NEXP * 2048 * 1024; }
__device__ __forceinline__ u16* P_ye(KP p) { return (u16*)(p->ws + WS_PX) + (size_t)NEXP * (2048 + 32) * 1024; }
__device__ __forceinline__ u16* P_yec(KP p) { return P_ye(p) + (size_t)NEXP * 2048 * 1024; }
__device__ __forceinline__ int* P_tslot(KP p) { return (int*)(p->ws + WS_TSLOT); }
__device__ __forceinline__ u16* P_z(KP p) { return (u16*)(p->ws + WS_S); }
__device__ __forceinline__ float* P_maccx(KP p) { return (float*)(p->ws + WS_S + (size_t)3 * NLAT * DM * 2); }
#undef WSF


DI int TIDX() { int t = threadIdx.x & 255; asm volatile("" : "+v"(t)); return t; }
DI int TID512() { int t = threadIdx.x; asm volatile("" : "+v"(t)); return t; }
DI int BIDX() { int t = blockIdx.x; asm volatile("" : "+s"(t)); return t; }
DI u16 f2bf(float x) { unsigned u = __float_as_uint(x); u += 0x7fffu + ((u >> 16) & 1u); return (u16)(u >> 16); }
DI float bf2f(u16 h) { return __uint_as_float(((unsigned)h) << 16); }
DI float bflo(unsigned w) { return __uint_as_float(w << 16); }
DI float bfhi(unsigned w) { return __uint_as_float(w & 0xffff0000u); }
typedef __bf16 bf16v2 __attribute__((ext_vector_type(2)));
typedef float f32v2 __attribute__((ext_vector_type(2)));
DI unsigned pack2(float a, float b) { f32v2 v = {a, b}; bf16v2 r = __builtin_convertvector(v, bf16v2); return __builtin_bit_cast(unsigned, r); }
DI float sigmoidf_(float x) { return 1.f / (1.f + __expf(-x)); }
DI float siluf_(float x) { return x / (1.f + __expf(-x)); }
DI float wave_sum(float v) { for (int o = 32; o > 0; o >>= 1) v += __shfl_xor(v, o); return v; }
#define MFMA16(a, b, c) __builtin_amdgcn_mfma_f32_16x16x32_bf16((a), (b), (c), 0, 0, 0)

template <int MR>
DI void zero_acc(f32x4 (&acc)[MR][4]) {
#pragma unroll
    for (int m = 0; m < MR; ++m)
#pragma unroll
        for (int n = 0; n < 4; ++n) acc[m][n] = f32x4{0.f, 0.f, 0.f, 0.f};
}

template <int KT>
DI void gemm_core(f32x4 (&acc)[4][4], const u16* a0, const u16* a1, const u16* b0, const u16* b1, char* smem) {
    const int tid = TIDX(), lane = tid & 63, wid = tid >> 6, wr = wid >> 1, wc = wid & 1, fr = lane & 15, fq = lane >> 4;
    auto stage = [&](int kt, int buf) {
        char* base = smem + buf * 16384;
        __builtin_amdgcn_global_load_lds((const unsigned*)(a0 + kt * 32), (unsigned*)(base + tid * 16), 16, 0, 0);
        __builtin_amdgcn_global_load_lds((const unsigned*)(a1 + kt * 32), (unsigned*)(base + 4096 + tid * 16), 16, 0, 0);
        __builtin_amdgcn_global_load_lds((const unsigned*)(b0 + kt * 32), (unsigned*)(base + 8192 + tid * 16), 16, 0, 0);
        __builtin_amdgcn_global_load_lds((const unsigned*)(b1 + kt * 32), (unsigned*)(base + 12288 + tid * 16), 16, 0, 0);
    };
    __syncthreads();
    stage(0, 0);
    for (int kt = 0; kt < KT; ++kt) {
        asm volatile("s_waitcnt vmcnt(0)" ::: "memory");
        __syncthreads();
        if (kt + 1 < KT) stage(kt + 1, (kt + 1) & 1);
        const char* SA = smem + (kt & 1) * 16384;
        const char* SB = SA + 8192;
        bf16x8 At[4], Bt[4];
#pragma unroll
        for (int m = 0; m < 4; ++m) At[m] = *(const bf16x8*)(SA + (wr * 64 + m * 16 + fr) * 64 + fq * 16);
#pragma unroll
        for (int n = 0; n < 4; ++n) Bt[n] = *(const bf16x8*)(SB + (wc * 64 + n * 16 + fr) * 64 + fq * 16);
#pragma unroll
        for (int m = 0; m < 4; ++m)
#pragma unroll
            for (int n = 0; n < 4; ++n) acc[m][n] = MFMA16(At[m], Bt[n], acc[m][n]);
    }
}

template <int MR>
DI void mma_lds64(f32x4 (&acc)[MR][4], const u16* As, int lda, const u16* Bs, int ldb) {
    const int tid = TIDX(), lane = tid & 63, wid = tid >> 6, wr = wid >> 1, wc = wid & 1, fr = lane & 15, fq = lane >> 4;
#pragma unroll
    for (int kk = 0; kk < 2; ++kk) {
        bf16x8 At[MR], Bt[4];
#pragma unroll
        for (int m = 0; m < MR; ++m) At[m] = *(const bf16x8*)(As + (wr * (MR * 16) + m * 16 + fr) * lda + kk * 32 + fq * 8);
#pragma unroll
        for (int n = 0; n < 4; ++n) Bt[n] = *(const bf16x8*)(Bs + (wc * 64 + n * 16 + fr) * ldb + kk * 32 + fq * 8);
#pragma unroll
        for (int m = 0; m < MR; ++m)
#pragma unroll
            for (int n = 0; n < 4; ++n) acc[m][n] = MFMA16(At[m], Bt[n], acc[m][n]);
    }
}
template <int ROWS>
DI void stage_n64(u16* dst, int ld, const u16* src, long sstride) {
    const int tid = TIDX();
#pragma unroll
    for (int i = 0; i < ROWS / 32; ++i) {
        int idx = i * 256 + tid, row = idx >> 3, ch = idx & 7;
        u32x4 v = *(const u32x4*)(src + (long)row * sstride + ch * 8);
        *(u32x4*)(dst + row * ld + ch * 8) = v;
    }
}
template <bool SCALE, int NF>
DI void stage_t64(u16* dst, int ld, const u16* src, long sstride, float scale_tok_lane  ) {
    const int tid = TIDX();
#pragma unroll
    for (int i = 0; i < NF / 32; ++i) {
        int idx = i * 256 + tid, jj = idx & 63, ch = idx >> 6;
        u32x4 v = *(const u32x4*)(src + (long)jj * sstride + ch * 8);
#pragma unroll
        for (int e = 0; e < 4; ++e) {
            float lo = bflo(v[e]), hi = bfhi(v[e]);
            if (SCALE) { lo *= scale_tok_lane; hi *= scale_tok_lane; }
            dst[(ch * 8 + 2 * e) * ld + jj] = SCALE ? f2bf(lo) : (u16)(v[e] & 0xffffu);
            dst[(ch * 8 + 2 * e + 1) * ld + jj] = SCALE ? f2bf(hi) : (u16)(v[e] >> 16);
        }
    }
}

DI void convert_tile(KP p, int layer, int tile, char* smem);

DI void ph0_gemv_item(KP p, int item, char* smem) {
    const int tid = TIDX();
    const int l = item / 96, cg_ = item % 96;
    float* sl = (float*)smem;
    float* red = (float*)(smem + 8192);
    __syncthreads();
    for (int k = tid; k < 1024; k += 256) { sl[k] = siluf_(p->c[k]); sl[1024 + k] = siluf_(p->c_ctx[k]); }
    __syncthreads();
    const int c4 = tid & 15, kp = tid >> 4;
    const int col = cg_ * 64 + c4 * 4;
    const float* w = p->w_mod + (long)l * 1024 * 6144 + col;
    float a0[4] = {0, 0, 0, 0}, a1[4] = {0, 0, 0, 0};
#pragma unroll 8
    for (int kk = 0; kk < 64; ++kk) {
        int k = kp * 64 + kk;
        float4 wv = *(const float4*)(w + (long)k * 6144);
        float s0 = sl[k], s1 = sl[1024 + k];
        a0[0] += s0 * wv.x; a0[1] += s0 * wv.y; a0[2] += s0 * wv.z; a0[3] += s0 * wv.w;
        a1[0] += s1 * wv.x; a1[1] += s1 * wv.y; a1[2] += s1 * wv.z; a1[3] += s1 * wv.w;
    }
#pragma unroll
    for (int j = 0; j < 4; ++j) { red[(kp * 2 + 0) * 64 + c4 * 4 + j] = a0[j]; red[(kp * 2 + 1) * 64 + c4 * 4 + j] = a1[j]; }
    __syncthreads();
    if (tid < 128) {
        int src = tid >> 6, cr = tid & 63;
        float s = 0.f;
        for (int q = 0; q < 16; ++q) s += red[(q * 2 + src) * 64 + cr];
        int n = cg_ * 64 + cr;
        P_mod(p)[(l * 2 + src) * 6144 + n] = s + p->b_mod[l * 6144 + n];
    }
}
DI void sincos_d(double a, float& c, float& s) {
    const double TWO_PI = 6.283185307179586476925286766559;
    double k = rint(a / TWO_PI);
    double r = a - k * TWO_PI;
    double r2 = r * r;
    double ts = r, tc = 1.0, ss = r, cc = 1.0;
    for (int i = 1; i <= 14; ++i) {
        tc = -tc * r2 / (double)((2 * i - 1) * (2 * i));
        ts = -ts * r2 / (double)((2 * i) * (2 * i + 1));
        cc += tc; ss += ts;
    }
    c = (float)cc; s = (float)ss;
}
DI void ph0_rope_item(KP p, int item) {
    int idx = item * 256 + TIDX();
    const double LN_BASE = 9.210340371976184;
    if (idx < 8192) {
        int pos = idx >> 5, f = idx & 31;
        float inv = (float)exp(-(double)f / 32.0 * LN_BASE);
        float ang = (float)pos * inv;
        float c, s; sincos_d((double)ang, c, s);
        P_rope128(p)[idx] = make_float2(c, s);
    } else {
        int i2 = idx - 8192;
        int pos = i2 >> 4, f = i2 & 15;
        float inv = (float)exp(-(double)f / 16.0 * LN_BASE);
        float ang = (float)pos * inv;
        float c, s; sincos_d((double)ang, c, s);
        P_rope64(p)[i2] = make_float2(c, s);
    }
}

constexpr int CONV_TILES = 1856 + 384 + 256 + 12288;
DI void convert_tile(KP p, int layer, int tile, char* smem) {
    const int tid = TIDX();
    const float* src; u16* dst; int K, N, mode = 0;
    if (tile < 1856) { src = p->w_in + (long)layer * 1024 * INC; dst = P_wt_in(p); K = 1024; N = INC; mode = 1; }
    else if (tile < 1856 + 384) {
        int t = tile - 1856, which = t / 128; tile = t % 128; K = 512; N = 1024;
        src = (which == 0 ? p->w_ret : which == 1 ? p->w_win : p->w_na) + (long)layer * 512 * 1024;
        dst = (which == 0 ? P_wt_ret(p) : which == 1 ? P_wt_win(p) : P_wt_na(p));
    } else if (tile < 1856 + 384 + 256) { tile -= 1856 + 384; src = p->w_out + (long)layer * 1024 * 1024; dst = P_wt_out(p); K = 1024; N = 1024; }
    else {
        int t = tile - (1856 + 384 + 256), which = t / 4096, e = (t % 4096) / 256; tile = t % 256; K = 1024; N = 1024;
        long eo = ((long)layer * NEXP + e) * 1024 * 1024;
        if (which == 0) { src = p->w_eg + eo; dst = P_wt_gu(p) + (long)e * 2048 * 1024; mode = 2; }
        else if (which == 1) { src = p->w_eu + eo; dst = P_wt_gu(p) + (long)e * 2048 * 1024; mode = 3; }
        else { src = p->w_ed + eo; dst = P_wt_dn(p) + (long)e * 1024 * 1024; }
    }
    const int ntn = N / 64;
    const int k0 = (tile / ntn) * 64, n0 = (tile % ntn) * 64;
    float* T = (float*)smem;
    __syncthreads();
#pragma unroll
    for (int i = 0; i < 4; ++i) {
        int kk = (tid >> 4) + 16 * i, n4 = tid & 15;
        float4 v = *(const float4*)(src + (long)(k0 + kk) * N + n0 + n4 * 4);
        T[kk * 65 + n4 * 4 + 0] = v.x; T[kk * 65 + n4 * 4 + 1] = v.y; T[kk * 65 + n4 * 4 + 2] = v.z; T[kk * 65 + n4 * 4 + 3] = v.w;
    }
    __syncthreads();
#pragma unroll
    for (int i = 0; i < 2; ++i) {
        int nn = (tid >> 3) + 32 * i, k8 = tid & 7;
        u32x4 o;
#pragma unroll
        for (int e = 0; e < 4; ++e) o[e] = pack2(T[(k8 * 8 + 2 * e) * 65 + nn], T[(k8 * 8 + 2 * e + 1) * 65 + nn]);
        int n = n0 + nn, drow = n;
        if (mode == 1) {
            if (n < 1024) { int hh_ = (n & 511) >> 7, o_ = n & 127; drow = (n < 512 ? col_qr(hh_, o_ >> 6) : col_kr(hh_, o_ >> 6)) + (o_ & 63); }
            else if (n >= C_QW && n < C_KW) { int m_ = n - C_QW; drow = col_qw(m_ >> 6, (m_ & 63) >> 5) + (m_ & 31); }
            else if (n >= C_KW && n < C_VW) { int m_ = n - C_KW; drow = col_kw(m_ >> 6, (m_ & 63) >> 5) + (m_ & 31); }
            else if (n >= C_VW && n < C_QN) { int m_ = n - C_VW; drow = col_vw(m_ >> 6) + (m_ & 63); }
        } else if (mode == 2) drow = (n >> 7) * 256 + (n & 127);
        else if (mode == 3) drow = (n >> 7) * 256 + 128 + (n & 127);
        *(u32x4*)(dst + (long)drow * K + k0 + k8 * 8) = o;
    }
}

DI const float* resid_row(KP p, int layer, int row) {
    if (row < NLAT) return (layer == 0 ? p->x : p->out) + (long)row * DM;
    return (layer == 0 ? p->ctx : P_ctxres(p)) + (long)(row - NLAT) * DM;
}
DI const float* cur_row(KP p, int row) { return row < NLAT ? p->out + (long)row * DM : P_ctxres(p) + (long)(row - NLAT) * DM; }
DI void moe_combine(KP p, int row, float4 (&v)[4]) {
    const int lane = TIDX() & 63;
    const bool lat = row < NLAT;
    const int* ts = P_tslot(p) + (lat ? 0 : 16) * (long)NLAT + (lat ? row : row - NLAT);
    const u16* yb_ = lat ? P_ye(p) : P_yec(p);
    const int cap = lat ? CAP_LAT : CAP_CTX;
#pragma unroll 4
    for (int e = 0; e < NEXP; ++e) {
        const int slot = ts[(long)e * NLAT];
        if (slot >= 0) {
            const u16* yr = yb_ + ((long)e * cap + slot) * DM + lane * 4;
#pragma unroll
            for (int i = 0; i < 4; ++i) {
                uint2 w = *(const uint2*)(yr + i * 256);
                v[i].x += bflo(w.x); v[i].y += bfhi(w.x); v[i].z += bflo(w.y); v[i].w += bfhi(w.y);
            }
        }
    }
}
DI void norm_row(KP p, int layer, int row, const float* xr, const float* g, int shift_idx, int scale_idx, u16* dst_row, float* keep  , float* wb  ) {
    const int lane = TIDX() & 63;
    const float* md = P_mod(p) + (layer * 2 + (row < NLAT ? 0 : 1)) * 6144;
    float4 v[4]; float ss = 0.f;
#pragma unroll
    for (int i = 0; i < 4; ++i) v[i] = *(const float4*)(xr + i * 256 + lane * 4);
    if (wb) {
        moe_combine(p, row, v);
#pragma unroll
        for (int i = 0; i < 4; ++i) *(float4*)(wb + i * 256 + lane * 4) = v[i];
    }
#pragma unroll
    for (int i = 0; i < 4; ++i) ss += v[i].x * v[i].x + v[i].y * v[i].y + v[i].z * v[i].z + v[i].w * v[i].w;
    ss = wave_sum(ss);
    float rstd = rsqrtf(ss * (1.f / DM) + 1e-6f);
#pragma unroll
    for (int i = 0; i < 4; ++i) {
        int c0 = i * 256 + lane * 4;
        float4 gg = *(const float4*)(g + c0), sh = *(const float4*)(md + shift_idx * 1024 + c0), sc = *(const float4*)(md + scale_idx * 1024 + c0);
        float o0 = v[i].x * rstd * gg.x * (1.f + sc.x) + sh.x, o1 = v[i].y * rstd * gg.y * (1.f + sc.y) + sh.y;
        float o2 = v[i].z * rstd * gg.z * (1.f + sc.z) + sh.z, o3 = v[i].w * rstd * gg.w * (1.f + sc.w) + sh.w;
        uint2 pk; pk.x = pack2(o0, o1); pk.y = pack2(o2, o3);
        *(uint2*)(dst_row + c0) = pk;
        if (keep) *(float4*)(keep + c0) = make_float4(o0, o1, o2, o3);
    }
}

DI void phB_tile(KP p, int mt, int nt, char* smem) {
    const int tid = TIDX(), lane = tid & 63, wid = tid >> 6, wr = wid >> 1, wc = wid & 1, fr = lane & 15, fq = lane >> 4;
    f32x4 acc[4][4]; zero_acc<4>(acc);
    const int r0 = tid >> 2, ko = (tid & 3) * 8;
    const u16* a0 = P_hx(p) + (long)(mt * 128 + r0) * DM + ko;
    const u16* b0 = P_wt_in(p) + (long)(nt * 128 + r0) * DM + ko;
    gemm_core<32>(acc, a0, a0 + 64 * DM, b0, b0 + 64 * DM, smem);
    const bool lat = mt < 128;
    const int type = (nt < 8) ? 1 : (nt >= 16 && nt < 21) ? 2 : 0;
    if (type != 0 && lat) {
#pragma unroll
        for (int m = 0; m < 4; ++m)
#pragma unroll
            for (int j = 0; j < 4; ++j) {
                int t = mt * 128 + wr * 64 + m * 16 + fq * 4 + j;
                int pr = t >> 6, pc = t & 63;
#pragma unroll
                for (int n = 0; n < 2; ++n) {
                    float2 cs;
                    if (type == 1) { int pos = (wc == 0) ? pr : pc; cs = P_rope128(p)[pos * 32 + n * 16 + fr]; }
                    else { int pos = (n == 0) ? pr : pc; cs = P_rope64(p)[pos * 16 + fr]; }
                    float x1 = acc[m][n][j], x2 = acc[m][n + 2][j];
                    acc[m][n][j] = x1 * cs.x - x2 * cs.y;
                    acc[m][n + 2][j] = x1 * cs.y + x2 * cs.x;
                }
            }
    }
    const float mul = (nt >= 4 && nt < 8) ? 0.08838834764831845f : ((nt >= 16 && nt < 20) || (nt >= 22 && nt < 26)) ? 0.125f : 1.f;
#pragma unroll
    for (int m = 0; m < 4; ++m)
#pragma unroll
        for (int n = 0; n < 4; ++n)
#pragma unroll
            for (int j = 0; j < 4; ++j) {
                int row = mt * 128 + wr * 64 + m * 16 + fq * 4 + j, col = nt * 128 + wc * 64 + n * 16 + fr;
                P_px(p)[(long)row * INC + col] = f2bf(acc[m][n][j] * mul);
            }
}

typedef __attribute__((ext_vector_type(16))) float f32x16;
typedef short v4s __attribute__((ext_vector_type(4)));
typedef __attribute__((address_space(3))) v4s* lds_v4s_ptr;
#define MFMA32(a, b, c) __builtin_amdgcn_mfma_f32_32x32x16_bf16((a), (b), (c), 0, 0, 0)
constexpr float LOG2E = 1.4426950408889634f;

struct FA {
    bf16x8 qf[4];
    f32x16 o[2];
    float m, l;
};
DI void fa_stage(u16* Ks, u16* Vs, const u16* px, int rowstart, int colK1, int colK2, int colV) {
    const int lane = TIDX() & 63;
#pragma unroll
    for (int i = 0; i < 8; ++i) {
        int idx = i * 64 + lane, key = idx >> 3, ch = idx & 7;
        const u16* src = px + (long)(rowstart + key) * INC;
        u32x4 kv = *(const u32x4*)(src + (ch < 4 ? colK1 + ch * 8 : colK2 + (ch - 4) * 8));
        u32x4 vv = *(const u32x4*)(src + colV + ch * 8);
        *(u32x4*)(Ks + key * 72 + ch * 8) = kv;
        *(u32x4*)(Vs + key * 72 + ch * 8) = vv;
    }
}
template <int MODE>
DI void fa_tile(FA& st, const u16* Ks, const u16* Vs, int a0, const float* rrow) {
    const int lane = TIDX() & 63, c = lane & 31, hh = lane >> 5;
    const u16* kbase = Ks + c * 72 + hh * 8;
    const u16* vbase = Vs + (4 * hh + ((lane & 15) >> 2)) * 72 + 16 * ((lane >> 4) & 1) + 4 * (lane & 3);
    f32x16 s[2];
#pragma unroll
    for (int kb = 0; kb < 2; ++kb) {
#pragma unroll
        for (int r = 0; r < 16; ++r) s[kb][r] = 0.f;
#pragma unroll
        for (int ks = 0; ks < 4; ++ks) {
            bf16x8 A = *(const bf16x8*)(kbase + kb * 32 * 72 + ks * 16);
            s[kb] = MFMA32(A, st.qf[ks], s[kb]);
        }
    }
    float mx = -3.0e38f;
    const int cq = a0 + c;
    int cs = cq - 8; cs = cs < 0 ? 0 : (cs > 48 ? 48 : cs);
#pragma unroll
    for (int kb = 0; kb < 2; ++kb)
#pragma unroll
        for (int r = 0; r < 16; ++r) {
            const int j = kb * 32 + (r & 3) + 8 * (r >> 2) + 4 * hh;
            float v = s[kb][r];
            if (MODE == 1) { int d = a0 + j - c; v = (d >= -128 && d <= 128) ? v : -1e30f; }
            if (MODE == 2) { bool ok = (j >= cs) && (j < cs + 16); int ci = j - cq + 15; ci = ci < 0 ? 0 : (ci > 30 ? 30 : ci); v = ok ? v + rrow[ci] : -1e30f; }
            v *= LOG2E;
            s[kb][r] = v;
            mx = fmaxf(mx, v);
        }
    mx = fmaxf(mx, __shfl_xor(mx, 32));
    const float mn = fmaxf(st.m, mx);
    const float alpha = __builtin_amdgcn_exp2f(st.m - mn);
    float ls = 0.f;
#pragma unroll
    for (int kb = 0; kb < 2; ++kb)
#pragma unroll
        for (int r = 0; r < 16; ++r) { float pv = __builtin_amdgcn_exp2f(s[kb][r] - mn); s[kb][r] = pv; ls += pv; }
    st.l = st.l * alpha + ls; st.m = mn;
#pragma unroll
    for (int db = 0; db < 2; ++db)
#pragma unroll
        for (int r = 0; r < 16; ++r) st.o[db][r] *= alpha;
    bf16x8 pf[2][2];
#pragma unroll
    for (int kb = 0; kb < 2; ++kb)
#pragma unroll
        for (int k2 = 0; k2 < 2; ++k2) {
            u32x4 w;
#pragma unroll
            for (int e = 0; e < 4; ++e) w[e] = pack2(s[kb][8 * k2 + 2 * e], s[kb][8 * k2 + 2 * e + 1]);
            pf[kb][k2] = __builtin_bit_cast(bf16x8, w);
        }
#pragma unroll
    for (int db = 0; db < 2; ++db)
#pragma unroll
        for (int kb = 0; kb < 2; ++kb)
#pragma unroll
            for (int k2 = 0; k2 < 2; ++k2) {
                const u16* alo = vbase + (kb * 32 + 16 * k2) * 72 + db * 32;
                v4s lo = __builtin_amdgcn_ds_read_tr16_b64_v4i16((lds_v4s_ptr)alo);
                v4s hi = __builtin_amdgcn_ds_read_tr16_b64_v4i16((lds_v4s_ptr)(alo + 8 * 72));
                bf16x8 A = __builtin_shufflevector(lo, hi, 0, 1, 2, 3, 4, 5, 6, 7);
                st.o[db] = MFMA32(A, pf[kb][k2], st.o[db]);
            }
}
DI void attn_wave_item(KP p, int layer, int kind, int blk, int h, char* smem) {
    const int lane = TIDX() & 63, wid = TIDX() >> 6, c = lane & 31, hh = lane >> 5;
    u16* Ks = (u16*)(smem + wid * 19456);
    u16* Vs = Ks + 64 * 72;
    float* rpbs = (float*)(smem + wid * 19456 + 18432);
    const bool isna = (kind == 1 || kind == 3);
    const int q0 = ((kind >= 2) ? NLAT : 0) + blk * 32;
    const int kvh = isna ? h : (h >> 2);
    const int colQ1 = isna ? C_QN + h * 64 : col_qw(h, 0), colQ2 = isna ? colQ1 + 32 : col_qw(h, 1);
    const int colK1 = isna ? C_KN + kvh * 64 : col_kw(kvh, 0), colK2 = isna ? colK1 + 32 : col_kw(kvh, 1);
    const int colV = isna ? C_VN + kvh * 64 : col_vw(kvh);
    FA st;
    {
        const u16* qrow = P_px(p) + (long)(q0 + c) * INC;
#pragma unroll
        for (int ks = 0; ks < 4; ++ks) st.qf[ks] = *(const bf16x8*)(qrow + (ks < 2 ? colQ1 + ks * 16 : colQ2 + (ks - 2) * 16) + hh * 8);
#pragma unroll
        for (int db = 0; db < 2; ++db)
#pragma unroll
            for (int r = 0; r < 16; ++r) st.o[db][r] = 0.f;
        if (isna) { st.m = -1e30f; st.l = 0.f; } else { st.m = p->sink[layer * 8 + h] * LOG2E; st.l = hh == 0 ? 1.f : 0.f; }
    }
    if (kind == 0) {
        const int t0 = (q0 >> 6) - 2;
        for (int i = 0; i < 5; ++i) {
            int start = (t0 + i) * 64;
            if (start < 0 || start >= NLAT) continue;
            fa_stage(Ks, Vs, P_px(p), start, colK1, colK2, colV);
            if (i == 0 || i == 4) fa_tile<1>(st, Ks, Vs, start - q0, nullptr);
            else fa_tile<0>(st, Ks, Vs, 0, nullptr);
        }
    } else if (kind == 1) {
        const int r = blk >> 1;
        int sr = r - 4; sr = sr < 0 ? 0 : (sr > 248 ? 248 : sr);
        const float* rp = p->rpb + ((long)layer * 8 + h) * 465 + (sr - r + 7) * 31;
        for (int i = lane; i < 248; i += 64) rpbs[i] = rp[i];
        for (int i = 0; i < 8; ++i) {
            fa_stage(Ks, Vs, P_px(p), (sr + i) * 64, colK1, colK2, colV);
            fa_tile<2>(st, Ks, Vs, (blk & 1) * 32, rpbs + i * 31);
        }
    }
    for (int i = 0; i < 4; ++i) {
        fa_stage(Ks, Vs, P_px(p), NLAT + i * 64, colK1, colK2, colV);
        fa_tile<0>(st, Ks, Vs, 0, nullptr);
    }
    u16* y = isna ? P_yc(p) : P_yb(p);
    {
        float lt = st.l + __shfl_xor(st.l, 32);
        float inv = 1.f / lt;
        u16* orow = y + (long)(q0 + c) * 512 + h * 64;
#pragma unroll
        for (int db = 0; db < 2; ++db)
#pragma unroll
            for (int g = 0; g < 4; ++g) {
                uint2 o;
                o.x = pack2(st.o[db][4 * g] * inv, st.o[db][4 * g + 1] * inv);
                o.y = pack2(st.o[db][4 * g + 2] * inv, st.o[db][4 * g + 3] * inv);
                *(uint2*)(orow + db * 32 + 8 * g + 4 * hh) = o;
            }
    }
}

DI void ret_gammas(KP p, int layer, int h, float& lgf2, float& lgb2) {
    float xf = p->decay[layer * 8 + h], xb = p->decay[layer * 8 + 4 + h];
    lgf2 = -log1pf(expf(-xf)) * 1.4426950408889634f;
    lgb2 = -log1pf(expf(-xb)) * 1.4426950408889634f;
}
DI void phC_state_item(KP p, int layer, int c, int h, int eh, char* smem) {
    const int tid = TIDX(), lane = tid & 63, wid = tid >> 6, wr = wid >> 1, wc = wid & 1, fr = lane & 15, fq = lane >> 4;
    u16* Av = (u16*)smem;
    u16* Bf = Av + 64 * 72;
    u16* Bb = Bf + 128 * 72;
    float lgf2, lgb2; ret_gammas(p, layer, h, lgf2, lgb2);
    f32x4 accF[2][4], accB[2][4]; zero_acc<2>(accF); zero_acc<2>(accB);
    const u16* base = P_px(p) + (long)c * 128 * INC;
#pragma unroll 1
    for (int jh = 0; jh < 2; ++jh) {
        const int j = jh * 64 + (tid & 63);
        const float zf = exp2f((float)(127 - j) * lgf2), zb = exp2f((float)j * lgb2);
        __syncthreads();
        stage_t64<false, 64>(Av, 72, base + (long)jh * 64 * INC + C_VR + h * 128 + eh * 64, INC, 1.f);
#pragma unroll
        for (int x = 0; x < 2; ++x) {
            stage_t64<true, 64>(Bf + x * 64 * 72, 72, base + (long)jh * 64 * INC + col_kr(h, x), INC, zf);
            stage_t64<true, 64>(Bb + x * 64 * 72, 72, base + (long)jh * 64 * INC + col_kr(h, x), INC, zb);
        }
        __syncthreads();
        mma_lds64<2>(accF, Av, 72, Bf, 72);
        mma_lds64<2>(accB, Av, 72, Bb, 72);
    }
    float* Sf = P_S(p) + ((long)(c * 4 + h) * 2 + 0) * 16384;
    float* Sb = Sf + 16384;
#pragma unroll
    for (int m = 0; m < 2; ++m)
#pragma unroll
        for (int n = 0; n < 4; ++n)
#pragma unroll
            for (int j = 0; j < 4; ++j) {
                int e = eh * 64 + wr * 32 + m * 16 + fq * 4 + j, d = wc * 64 + n * 16 + fr;
                Sf[e * 128 + d] = accF[m][n][j];
                Sb[e * 128 + d] = accB[m][n][j];
            }
}

DI void phD_item(KP p, int layer, int item) {
    const int h = item >> 7, dir = (item >> 6) & 1, pos = (item & 63) * 256 + TIDX();
    float lgf2, lgb2; ret_gammas(p, layer, h, lgf2, lgb2);
    const float decay = exp2f(128.f * (dir == 0 ? lgf2 : lgb2));
    float r = 0.f;
    const long hs = (long)(h * 2 + dir) * 16384 + pos;
    auto chunk_at = [&](int i) -> int {
        if (dir == 0) return i < 2 ? 128 + i : i - 2;
        return i < 2 ? 129 - i : 129 - i;
    };
    for (int i0 = 0; i0 < NCHUNK; i0 += 13) {
        float s[13];
#pragma unroll
        for (int u = 0; u < 13; ++u) s[u] = P_S(p)[(long)chunk_at(i0 + u) * 8 * 16384 + hs];
#pragma unroll
        for (int u = 0; u < 13; ++u) {
            P_R(p)[(long)chunk_at(i0 + u) * 8 * 16384 + hs] = f2bf(r);
            r = decay * r + s[u];
        }
    }
}

DI void phE_item(KP p, int layer, int c, int h, int ih, char* smem) {
    const int tid = TIDX(), lane = tid & 63, wid = tid >> 6, wr = wid >> 1, wc = wid & 1, fr = lane & 15, fq = lane >> 4;
    u16* R0 = (u16*)smem;
    u16* R1 = R0 + 64 * 72;
    u16* R2 = R1 + 128 * 72;
    u16* P = (u16*)smem;
    float* red = (float*)(smem + (64 + 128 + 128) * 72 * 2);
    float lgf2, lgb2; ret_gammas(p, layer, h, lgf2, lgb2);
    const u16* base = P_px(p) + (long)c * 128 * INC;
    const u16* qbase = base + (long)ih * 64 * INC;
    const u16* Rf = P_R(p) + ((long)(c * 4 + h) * 2 + 0) * 16384;
    const u16* Rb = Rf + 16384;
    f32x4 Y[2][4], T[2][4];
    zero_acc<2>(Y); zero_acc<2>(T);
#pragma unroll 1
    for (int dh = 0; dh < 2; ++dh) {
        __syncthreads();
        stage_n64<64>(R0, 72, qbase + col_qr(h, dh), INC);
        stage_n64<128>(R1, 72, Rf + dh * 64, 128);
        stage_n64<128>(R2, 72, Rb + dh * 64, 128);
        __syncthreads();
        mma_lds64<2>(Y, R0, 72, R1, 72);
        mma_lds64<2>(T, R0, 72, R2, 72);
    }
#pragma unroll
    for (int m = 0; m < 2; ++m)
#pragma unroll
        for (int j = 0; j < 4; ++j) {
            int i = ih * 64 + wr * 32 + m * 16 + fq * 4 + j;
            float xf = exp2f((float)(i + 1) * lgf2), xb = exp2f((float)(128 - i) * lgb2);
#pragma unroll
            for (int n = 0; n < 4; ++n) Y[m][n][j] = xf * Y[m][n][j] + xb * T[m][n][j];
        }
    zero_acc<2>(T);
#pragma unroll 1
    for (int dh = 0; dh < 2; ++dh) {
        __syncthreads();
        stage_n64<64>(R0, 72, qbase + col_qr(h, dh), INC);
        stage_n64<128>(R1, 72, base + col_kr(h, dh), INC);
        __syncthreads();
        mma_lds64<2>(T, R0, 72, R1, 72);
    }
    __syncthreads();
#pragma unroll
    for (int m = 0; m < 2; ++m)
#pragma unroll
        for (int n = 0; n < 4; ++n)
#pragma unroll
            for (int j = 0; j < 4; ++j) {
                int il = wr * 32 + m * 16 + fq * 4 + j, i = ih * 64 + il, jj = wc * 64 + n * 16 + fr;
                float dm = (i >= jj) ? exp2f((float)(i - jj) * lgf2) : exp2f((float)(jj - i) * lgb2);
                P[il * 136 + jj] = f2bf(T[m][n][j] * dm);
            }
#pragma unroll 1
    for (int jh = 0; jh < 2; ++jh) {
        __syncthreads();
        stage_t64<false, 128>(R2, 72, base + (long)jh * 64 * INC + C_VR + h * 128, INC, 1.f);
        __syncthreads();
        mma_lds64<2>(Y, P + jh * 64, 136, R2, 72);
    }
    float mu[2][4], rs[2][4];
#pragma unroll
    for (int m = 0; m < 2; ++m)
#pragma unroll
        for (int j = 0; j < 4; ++j) {
            float s = Y[m][0][j] + Y[m][1][j] + Y[m][2][j] + Y[m][3][j];
            s += __shfl_xor(s, 1); s += __shfl_xor(s, 2); s += __shfl_xor(s, 4); s += __shfl_xor(s, 8);
            if (fr == 0) red[(wr * 32 + m * 16 + fq * 4 + j) * 2 + wc] = s;
        }
    __syncthreads();
#pragma unroll
    for (int m = 0; m < 2; ++m)
#pragma unroll
        for (int j = 0; j < 4; ++j) { int il = wr * 32 + m * 16 + fq * 4 + j; mu[m][j] = (red[il * 2] + red[il * 2 + 1]) * (1.f / 128.f); }
    __syncthreads();
#pragma unroll
    for (int m = 0; m < 2; ++m)
#pragma unroll
        for (int j = 0; j < 4; ++j) {
            float s = 0.f;
#pragma unroll
            for (int n = 0; n < 4; ++n) { float d = Y[m][n][j] - mu[m][j]; s += d * d; }
            s += __shfl_xor(s, 1); s += __shfl_xor(s, 2); s += __shfl_xor(s, 4); s += __shfl_xor(s, 8);
            if (fr == 0) red[(wr * 32 + m * 16 + fq * 4 + j) * 2 + wc] = s;
        }
    __syncthreads();
#pragma unroll
    for (int m = 0; m < 2; ++m)
#pragma unroll
        for (int j = 0; j < 4; ++j) { int il = wr * 32 + m * 16 + fq * 4 + j; rs[m][j] = rsqrtf((red[il * 2] + red[il * 2 + 1]) * (1.f / 128.f) + 1e-6f); }
    const float* gn = p->ret_gn + layer * 512 + h * 128;
#pragma unroll
    for (int m = 0; m < 2; ++m)
#pragma unroll
        for (int n = 0; n < 4; ++n)
#pragma unroll
            for (int j = 0; j < 4; ++j) {
                int i = ih * 64 + wr * 32 + m * 16 + fq * 4 + j, e = wc * 64 + n * 16 + fr;
                long row = (long)c * 128 + i;
                float g = bf2f(P_px(p)[row * INC + C_GR + h * 128 + e]);
                float o = (Y[m][n][j] - mu[m][j]) * rs[m][j] * gn[e] * siluf_(g);
                P_ya(p)[row * 512 + h * 128 + e] = f2bf(o);
            }
    __syncthreads();
}

DI void phF_tile(KP p, int mt, int nt, char* smem) {
    const int tid = TIDX(), lane = tid & 63, wid = tid >> 6, wr = wid >> 1, wc = wid & 1, fr = lane & 15, fq = lane >> 4;
    const int r0 = tid >> 2, ko = (tid & 3) * 8;
    float* macc = P_maccx(p) - (long)NLAT * DM;
#pragma unroll 1
    for (int b = 0; b < 3; ++b) {
        const u16* y = (b == 0 ? P_ya(p) : b == 1 ? P_yb(p) : P_yc(p));
        const u16* w = (b == 0 ? P_wt_ret(p) : b == 1 ? P_wt_win(p) : P_wt_na(p));
        f32x4 acc[4][4]; zero_acc<4>(acc);
        const u16* a0 = y + (long)(mt * 128 + r0) * 512 + ko;
        const u16* b0 = w + (long)(nt * 128 + r0) * 512 + ko;
        gemm_core<16>(acc, a0, a0 + 64 * 512, b0, b0 + 64 * 512, smem);
        int zero = 0; asm volatile("" : "+v"(zero));
#pragma unroll
        for (int m = 0; m < 4; ++m)
#pragma unroll
            for (int n = 0; n < 4; ++n)
#pragma unroll
                for (int j = 0; j < 4; ++j) {
                    int row = mt * 128 + wr * 64 + m * 16 + fq * 4 + j + zero, col = nt * 128 + wc * 64 + n * 16 + fr;
                    float g = bf2f(P_px(p)[(long)row * INC + C_GATE + b * 1024 + col]);
                    float v = acc[m][n][j] * sigmoidf_(g);
                    float* mp = macc + (long)row * DM + col;
                    if (b == 0) *mp = v;
                    else if (b == 1) *mp += v;
                    else P_hx(p)[(long)row * DM + col] = f2bf(*mp + v);
                }
    }
}
DI void phG_tile(KP p, int layer, int mt, int nt, char* smem) {
    const int tid = TIDX(), lane = tid & 63, wid = tid >> 6, wr = wid >> 1, wc = wid & 1, fr = lane & 15, fq = lane >> 4;
    f32x4 acc[4][4]; zero_acc<4>(acc);
    const int r0 = tid >> 2, ko = (tid & 3) * 8;
    const u16* a0 = P_hx(p) + (long)(mt * 128 + r0) * DM + ko;
    const u16* b0 = P_wt_out(p) + (long)(nt * 128 + r0) * DM + ko;
    gemm_core<32>(acc, a0, a0 + 64 * DM, b0, b0 + 64 * DM, smem);
    const bool lat = mt < 128;
    const float* md = P_mod(p) + (layer * 2 + (lat ? 0 : 1)) * 6144 + 2 * 1024;
#pragma unroll
    for (int m = 0; m < 4; ++m)
#pragma unroll
        for (int n = 0; n < 4; ++n)
#pragma unroll
            for (int j = 0; j < 4; ++j) {
                int row = mt * 128 + wr * 64 + m * 16 + fq * 4 + j, col = nt * 128 + wc * 64 + n * 16 + fr;
                const float* xin = resid_row(p, layer, row);
                float* xo = lat ? p->out + (long)row * DM : P_ctxres(p) + (long)(row - NLAT) * DM;
                xo[col] = xin[col] + md[col] * acc[m][n][j];
            }
}


#define LAS __attribute__((address_space(3)))
namespace g8 {
constexpr int BM = 256, BK = 64, HALF = 128, HTB = HALF * BK * 2, STAGE_BYTES = 8 * HTB;
DI int lds_byte(int r, int c) { const int st = (r >> 4) * 2 + (c >> 5), rr = r & 15, cc = c & 31, ob = rr * 64 + cc * 2; return st * 1024 + (ob ^ (((ob >> 9) & 1) << 5)); }
DI void stage_rc(int b, int& R, int& C) { const int st = b / 1024, sb = b % 1024, swz = sb ^ (((sb >> 9) & 1) << 5); R = (st >> 1) * 16 + swz / 64; C = (st & 1) * 32 + (swz % 64) / 2; }
DI int perm32(int rho) { const int n = rho >> 4, i = rho & 15; return 8 * (i >> 2) + 4 * n + (i & 3); }
struct Unit { int pm, pn, aux; };
typedef f32x4 Acc[2][2][4][2];

template <class P>
DI void gemm_phase(LAS unsigned char* lds, const P& prob) {
    const int tid = TID512(), wid = __builtin_amdgcn_readfirstlane(tid >> 6), lane = tid & 63, wr = wid >> 2, wc = wid & 3, fr = lane & 15, fq = lane >> 4;
    constexpr int K = P::K, nt = K / BK;
    int Rr[2], Cc[2];
    unsigned voffA[2], voffB[2];
#pragma unroll
    for (int i = 0; i < 2; ++i) { stage_rc(tid * 16 + i * 8192, Rr[i], Cc[i]); const int Rb = P::PERM ? ((Rr[i] & ~31) + perm32(Rr[i] & 31)) : Rr[i];
        voffA[i] = (unsigned)(Rr[i] * K + Cc[i]) * 2u; voffB[i] = (unsigned)(Rb * K + Cc[i]) * 2u; }
    constexpr size_t kstep = (size_t)(BK * 2);
    constexpr size_t hstep = (size_t)HALF * K * 2;
    const unsigned ldsw = (unsigned)wid * 1024u;
    const int aoff = lds_byte(wr * 64 + fr, fq * 8), boff = lds_byte(wc * 32 + fr, fq * 8);
    unsigned vaC[2][2], vaN[2][2];
#define G8_SA(b, h) (((b) * 2 + (h)) * HTB)
#define G8_SB(b, h) ((4 + (b) * 2 + (h)) * HTB)
#define G8_STAGEA(bufoff, base, VA, h, kt) do { _Pragma("unroll") for (int _i = 0; _i < 2; ++_i) \
        __builtin_amdgcn_global_load_lds((const unsigned*)((base) + (P::GATHER ? (size_t)(VA)[h][_i] : (size_t)voffA[_i] + (size_t)(h) * hstep) + (size_t)(kt) * kstep), (LAS unsigned*)(lds + (bufoff) + ldsw + _i * 8192), 16, 0, 0); } while (0)
#define G8_STAGEB(bufoff, base, h, kt) do { _Pragma("unroll") for (int _i = 0; _i < 2; ++_i) \
        __builtin_amdgcn_global_load_lds((const unsigned*)((base) + (size_t)(h) * hstep + voffB[_i] + (size_t)(kt) * kstep), (LAS unsigned*)(lds + (bufoff) + ldsw + _i * 8192), 16, 0, 0); } while (0)
#define G8_LDA(dst, b, h) do { _Pragma("unroll") for (int m = 0; m < 4; ++m) _Pragma("unroll") for (int k = 0; k < 2; ++k) dst[m][k] = *(const LAS bf16x8*)(lds + G8_SA(b, h) + aoff + m * 2048 + k * 1024); } while (0)
#define G8_LDB(dst, b, h) do { _Pragma("unroll") for (int n = 0; n < 2; ++n) _Pragma("unroll") for (int k = 0; k < 2; ++k) dst[n][k] = *(const LAS bf16x8*)(lds + G8_SB(b, h) + boff + n * 2048 + k * 1024); } while (0)
#define G8_MMA(ai, bj, At, Bt) do { __builtin_amdgcn_s_setprio(1); _Pragma("unroll") for (int m = 0; m < 4; ++m) _Pragma("unroll") for (int n = 0; n < 2; ++n) _Pragma("unroll") for (int k = 0; k < 2; ++k) \
        acc[ai][bj][m][n] = __builtin_amdgcn_mfma_f32_16x16x32_bf16(Bt[n][k], At[m][k], acc[ai][bj][m][n], 0, 0, 0); __builtin_amdgcn_s_setprio(0); } while (0)
#define G8_WAIT_V(n) asm volatile("s_waitcnt vmcnt(" #n ")" ::: "memory")
#define G8_WAIT_L(n) asm volatile("s_waitcnt lgkmcnt(" #n ")" ::: "memory")
#define G8_BAR __builtin_amdgcn_s_barrier()
#define G8_SCHED __builtin_amdgcn_sched_barrier(0)
    Unit cur, nxt; int ui = 0;
    __syncthreads();
    if (!prob.next(0, cur)) return;
    if (P::GATHER) prob.gather(cur, Rr, Cc, vaC);
    const char* cA = prob.a_base(cur); const char* cB = prob.b_base(cur);
    Acc acc;
#pragma unroll
    for (int a = 0; a < 2; ++a)
#pragma unroll
        for (int b = 0; b < 2; ++b)
#pragma unroll
            for (int m = 0; m < 4; ++m)
#pragma unroll
                for (int n = 0; n < 2; ++n) acc[a][b][m][n] = (f32x4){0.f, 0.f, 0.f, 0.f};
    bf16x8 At[4][2], B0[2][2], B1[2][2];
    G8_STAGEB(G8_SB(0, 0), cB, 0, 0); G8_STAGEA(G8_SA(0, 0), cA, vaC, 0, 0); G8_STAGEB(G8_SB(0, 1), cB, 1, 0); G8_STAGEA(G8_SA(0, 1), cA, vaC, 1, 0);
    if (wr == 1) G8_BAR;
    G8_WAIT_V(4); G8_BAR;
    G8_STAGEB(G8_SB(1, 0), cB, 0, 1); G8_STAGEA(G8_SA(1, 0), cA, vaC, 0, 1); G8_STAGEB(G8_SB(1, 1), cB, 1, 1);
    G8_WAIT_V(6); G8_BAR;
    for (;;) {
        const bool has_next = prob.next(ui + 1, nxt);
        if (!has_next) nxt = cur;
        if (P::GATHER) {
            if (has_next) prob.gather(nxt, Rr, Cc, vaN);
            else {
#pragma unroll
                for (int h = 0; h < 2; ++h) { vaN[h][0] = vaC[h][0]; vaN[h][1] = vaC[h][1]; }
            }
        }
        const char* nA = prob.a_base(nxt); const char* nB = prob.b_base(nxt);
#pragma unroll 1
        for (int t = 0; t < nt; t += 2) {
            const bool last = (t == nt - 2);
            const char* a2 = last ? nA : cA; const char* b2 = last ? nB : cB; const int k2 = last ? 0 : t + 2;
            unsigned va2[2][2];
#pragma unroll
            for (int h = 0; h < 2; ++h) { va2[h][0] = last ? vaN[h][0] : vaC[h][0]; va2[h][1] = last ? vaN[h][1] : vaC[h][1]; }
            G8_LDB(B0, 0, 0); G8_SCHED; G8_LDA(At, 0, 0); G8_STAGEA(G8_SA(1, 1), cA, vaC, 1, t + 1);
            G8_WAIT_L(8); G8_BAR; G8_WAIT_L(0); G8_MMA(0, 0, At, B0); G8_BAR; G8_SCHED;
            G8_LDB(B1, 0, 1); G8_STAGEB(G8_SB(0, 0), b2, 0, k2);
            G8_BAR; G8_WAIT_L(0); G8_MMA(0, 1, At, B1); G8_BAR;
            G8_LDA(At, 0, 1); G8_STAGEA(G8_SA(0, 0), a2, va2, 0, k2);
            G8_BAR; G8_WAIT_L(0); G8_MMA(1, 0, At, B0); G8_BAR; G8_SCHED;
            G8_STAGEB(G8_SB(0, 1), b2, 1, k2);
            G8_WAIT_V(6); G8_BAR; G8_MMA(1, 1, At, B1); G8_BAR;
            G8_LDB(B0, 1, 0); G8_SCHED; G8_LDA(At, 1, 0); G8_STAGEA(G8_SA(0, 1), a2, va2, 1, k2);
            G8_WAIT_L(8); G8_BAR; G8_WAIT_L(0); G8_MMA(0, 0, At, B0); G8_BAR; G8_SCHED;
            G8_LDB(B1, 1, 1); G8_STAGEB(G8_SB(1, 0), b2, 0, k2 + 1);
            G8_BAR; G8_WAIT_L(0); G8_MMA(0, 1, At, B1); G8_BAR;
            G8_LDA(At, 1, 1); G8_STAGEA(G8_SA(1, 0), a2, va2, 0, k2 + 1);
            G8_BAR; G8_WAIT_L(0); G8_MMA(1, 0, At, B0); G8_BAR; G8_SCHED;
            G8_STAGEB(G8_SB(1, 1), b2, 1, k2 + 1);
            G8_WAIT_V(6); G8_BAR; G8_MMA(1, 1, At, B1); G8_BAR;
        }
        { const int l2 = TID512() & 63; prob.epi(acc, cur, wr, wc, l2 & 15, l2 >> 4); }
        if (!has_next) break;
#pragma unroll
        for (int a = 0; a < 2; ++a)
#pragma unroll
            for (int b = 0; b < 2; ++b)
#pragma unroll
                for (int m = 0; m < 4; ++m)
#pragma unroll
                    for (int n = 0; n < 2; ++n) acc[a][b][m][n] = (f32x4){0.f, 0.f, 0.f, 0.f};
        cur = nxt; cA = nA; cB = nB; ++ui;
        if (P::GATHER) {
#pragma unroll
            for (int h = 0; h < 2; ++h) { vaC[h][0] = vaN[h][0]; vaC[h][1] = vaN[h][1]; }
        }
    }
    G8_WAIT_V(0);
    if (wr == 0) G8_BAR;
    G8_BAR;
#undef G8_SA
#undef G8_SB
#undef G8_STAGEA
#undef G8_STAGEB
#undef G8_LDA
#undef G8_LDB
#undef G8_MMA
#undef G8_WAIT_V
#undef G8_WAIT_L
#undef G8_BAR
#undef G8_SCHED
}
}

struct ProbG {
    static constexpr int K = 1024; static constexpr bool PERM = false, GATHER = false;
    KP p; int layer;
    DI bool next(int i, g8::Unit& u) const {
        const int id = i * (int)gridDim.x + BIDX();
        if (id >= 256) return false;
        u.pm = id >> 2; u.pn = id & 3; u.aux = 0;
        return true;
    }
    DI const char* a_base(const g8::Unit& u) const { return (const char*)(P_hx(p) + (long)u.pm * 256 * DM); }
    DI const char* b_base(const g8::Unit& u) const { return (const char*)(P_wt_out(p) + (long)u.pn * 256 * DM); }
    DI void gather(const g8::Unit&, const int (&)[2], const int (&)[2], unsigned (&)[2][2]) const {}
    DI void epi(g8::Acc& acc, const g8::Unit& u, int wr, int wc, int fr, int fq) const {
        const float* xin = layer == 0 ? p->x : p->out;
        const float* md = P_mod(p) + (layer * 2) * 6144 + 2 * 1024;
#pragma unroll
        for (int bj = 0; bj < 2; ++bj)
#pragma unroll
            for (int n = 0; n < 2; ++n) {
                const int col = u.pn * 256 + bj * 128 + wc * 32 + n * 16 + fq * 4;
                const f32x4 mv = *(const f32x4*)(md + col);
#pragma unroll
                for (int ai = 0; ai < 2; ++ai)
#pragma unroll
                    for (int m = 0; m < 4; ++m) {
                        const long row = (long)u.pm * 256 + ai * 128 + wr * 64 + m * 16 + fr;
                        const f32x4 xv = *(const f32x4*)(xin + row * DM + col);
                        *(f32x4*)(p->out + row * DM + col) = xv + mv * acc[ai][bj][m][n];
                    }
            }
    }
};


struct ProbB {
    static constexpr int K = 1024; static constexpr bool PERM = true, GATHER = false;
    KP p;
    DI bool next(int i, g8::Unit& u) const {
        constexpr int nM = 65, nN = 29, nwg = nM * nN, NX = 8, WGM = 8;
        const long L = (long)i * (int)gridDim.x + BIDX(); if (L >= nwg) return false;
        int wgid = (int)L; { const int q = nwg / NX, r = nwg % NX, xcd = wgid % NX, off = wgid / NX; wgid = (xcd < r ? xcd * (q + 1) : r * (q + 1) + (xcd - r) * q) + off; }
        const int nig = WGM * nN, gid = wgid / nig, fm = gid * WGM, gsz = (nM - fm) < WGM ? (nM - fm) : WGM;
        u.pm = fm + ((wgid % nig) % gsz); u.pn = (wgid % nig) / gsz; u.aux = 0; return true;
    }
    DI const char* a_base(const g8::Unit& u) const { return (const char*)(P_hx(p) + (long)u.pm * 256 * DM); }
    DI const char* b_base(const g8::Unit& u) const { return (const char*)(P_wt_in(p) + (long)u.pn * 256 * DM); }
    DI void gather(const g8::Unit&, const int (&)[2], const int (&)[2], unsigned (&)[2][2]) const {}
    DI void epi(g8::Acc& acc, const g8::Unit& u, int wr, int wc, int fr, int fq) const {
        const int pn = u.pn;
        const bool lat = u.pm < 64;
        const int rk = !lat ? 0 : (pn < 4) ? 1 : (pn == 8 || pn == 9 || (pn == 10 && wc < 2)) ? 2 : 0;
        const float mul = (pn == 2 || pn == 3) ? 0.08838834764831845f : (pn == 8 || pn == 9 || pn == 11 || pn == 12) ? 0.125f : 1.f;
#pragma unroll
        for (int ai = 0; ai < 2; ++ai)
#pragma unroll
            for (int m = 0; m < 4; ++m) {
                const int row = u.pm * 256 + ai * 128 + wr * 64 + m * 16 + fr;
                if (rk != 0) {
                    const float2* tab;
                    if (rk == 1) tab = P_rope128(p) + ((wc & 1) ? (row & 63) : (row >> 6)) * 32 + fq * 8;
                    else tab = P_rope64(p) + ((fq >= 2) ? (row & 63) : (row >> 6)) * 16 + (fq & 1) * 8;
#pragma unroll
                    for (int n = 0; n < 2; ++n) {
                        const f32x4 c01 = *(const f32x4*)(tab + n * 4), c23 = *(const f32x4*)(tab + n * 4 + 2);
                        const float cs_[4] = {c01[0], c01[2], c23[0], c23[2]}, sn_[4] = {c01[1], c01[3], c23[1], c23[3]};
#pragma unroll
                        for (int e = 0; e < 4; ++e) {
                            const float x1 = acc[ai][0][m][n][e], x2 = acc[ai][1][m][n][e];
                            acc[ai][0][m][n][e] = x1 * cs_[e] - x2 * sn_[e];
                            acc[ai][1][m][n][e] = x1 * sn_[e] + x2 * cs_[e];
                        }
                    }
                }
                u16* orow = P_px(p) + (long)row * INC + pn * 256 + wc * 32 + fq * 8;
#pragma unroll
                for (int bj = 0; bj < 2; ++bj) {
                    u32x4 o;
#pragma unroll
                    for (int n = 0; n < 2; ++n)
#pragma unroll
                        for (int e = 0; e < 2; ++e) o[2 * n + e] = pack2(acc[ai][bj][m][n][2 * e] * mul, acc[ai][bj][m][n][2 * e + 1] * mul);
                    *(u32x4*)(orow + bj * 128) = o;
                }
            }
    }
};
struct ProbF {
    static constexpr int K = 512; static constexpr bool PERM = true, GATHER = false;
    KP p;
    DI bool next(int i, g8::Unit& u) const {
        const int tile = (i / 3) * (int)gridDim.x + BIDX();
        if (tile >= 256) return false;
        u.pm = tile >> 2; u.pn = tile & 3; u.aux = i % 3;
        return true;
    }
    DI const char* a_base(const g8::Unit& u) const { const u16* y = u.aux == 0 ? P_ya(p) : u.aux == 1 ? P_yb(p) : P_yc(p); return (const char*)(y + (long)u.pm * 256 * 512); }
    DI const char* b_base(const g8::Unit& u) const { const u16* w = u.aux == 0 ? P_wt_ret(p) : u.aux == 1 ? P_wt_win(p) : P_wt_na(p); return (const char*)(w + (long)u.pn * 256 * 512); }
    DI void gather(const g8::Unit&, const int (&)[2], const int (&)[2], unsigned (&)[2][2]) const {}
    DI void epi(g8::Acc& acc, const g8::Unit& u, int wr, int wc, int fr, int fq) const {
        const int b = u.aux;
        u16* z = P_z(p) + (long)b * NLAT * DM;
        const long row0 = (long)u.pm * 256 + wr * 64 + fr;
        const int col0 = u.pn * 256 + wc * 32 + fq * 8;
#pragma unroll
        for (int ai = 0; ai < 2; ++ai)
#pragma unroll
            for (int m = 0; m < 4; ++m)
#pragma unroll
                for (int bj = 0; bj < 2; ++bj) {
                    u32x4 o;
#pragma unroll
                    for (int n = 0; n < 2; ++n)
#pragma unroll
                        for (int e = 0; e < 2; ++e) o[2 * n + e] = pack2(acc[ai][bj][m][n][2 * e], acc[ai][bj][m][n][2 * e + 1]);
                    *(u32x4*)(z + (row0 + ai * 128 + m * 16) * DM + col0 + bj * 128) = o;
                }
        if (b != 2) return;
        asm volatile("" ::: "memory");
        const u16* zb = P_z(p);
        const u16* gp = P_px(p) + C_GATE;
#pragma unroll 4
        for (int g = 0; g < 16; ++g) {
            const int ai = g >> 3, m = (g >> 1) & 3, bj = g & 1;
            const long row = row0 + ai * 128 + m * 16; const int col = col0 + bj * 128;
            u32x4 zv[3], gv[3];
#pragma unroll
            for (int q = 0; q < 3; ++q) { zv[q] = *(const u32x4*)(zb + ((long)q * NLAT + row) * DM + col); gv[q] = *(const u32x4*)(gp + row * INC + q * 1024 + col); }
            u32x4 o;
#pragma unroll
            for (int e = 0; e < 4; ++e) {
                float lo = 0.f, hi = 0.f;
#pragma unroll
                for (int q = 0; q < 3; ++q) { lo += bflo(zv[q][e]) * sigmoidf_(bflo(gv[q][e])); hi += bfhi(zv[q][e]) * sigmoidf_(bfhi(gv[q][e])); }
                o[e] = pack2(lo, hi);
            }
            *(u32x4*)(P_hx(p) + row * DM + col) = o;
        }
    }
};
struct ProbJ {
    static constexpr int K = 1024; static constexpr bool PERM = true, GATHER = true;
    KP p;
    DI bool next(int i, g8::Unit& u) const {
        const int id = i * (int)gridDim.x + BIDX();
        if (id >= 1024) return false;
        u.aux = id >> 6; u.pm = (id >> 3) & 7; u.pn = id & 7;
        return true;
    }
    DI const char* a_base(const g8::Unit&) const { return (const char*)P_hx(p); }
    DI const char* b_base(const g8::Unit& u) const { return (const char*)(P_wt_gu(p) + ((long)u.aux * 2048 + u.pn * 256) * DM); }
    DI void gather(const g8::Unit& u, const int (&R)[2], const int (&C)[2], unsigned (&va)[2][2]) const {
        const int* si = P_sel_idx(p) + u.aux * 2048 + u.pm * 256;
#pragma unroll
        for (int h = 0; h < 2; ++h)
#pragma unroll
            for (int j = 0; j < 2; ++j) va[h][j] = (unsigned)(si[h * 128 + R[j]] * DM + C[j]) * 2u;
    }
    DI void epi(g8::Acc& acc, const g8::Unit& u, int wr, int wc, int fr, int fq) const {
        u16* hb = P_hid(p) + (long)u.aux * 2048 * EH;
#pragma unroll
        for (int ai = 0; ai < 2; ++ai)
#pragma unroll
            for (int m = 0; m < 4; ++m) {
                const int slot = u.pm * 256 + ai * 128 + wr * 64 + m * 16 + fr;
                const int f = u.pn * 128 + wc * 32 + fq * 8;
                u32x4 o;
#pragma unroll
                for (int n = 0; n < 2; ++n)
#pragma unroll
                    for (int e = 0; e < 2; ++e)
                        o[2 * n + e] = pack2(siluf_(acc[ai][0][m][n][2 * e]) * acc[ai][1][m][n][2 * e], siluf_(acc[ai][0][m][n][2 * e + 1]) * acc[ai][1][m][n][2 * e + 1]);
                *(u32x4*)(hb + (long)slot * EH + f) = o;
            }
    }
};
struct ProbK {
    static constexpr int K = 1024; static constexpr bool PERM = true, GATHER = false;
    KP p; int layer;
    DI bool next(int i, g8::Unit& u) const {
        const int id = i * (int)gridDim.x + BIDX();
        if (id >= 512) return false;
        u.aux = id >> 5; u.pm = (id >> 2) & 7; u.pn = id & 3;
        return true;
    }
    DI const char* a_base(const g8::Unit& u) const { return (const char*)(P_hid(p) + ((long)u.aux * 2048 + u.pm * 256) * EH); }
    DI const char* b_base(const g8::Unit& u) const { return (const char*)(P_wt_dn(p) + ((long)u.aux * 1024 + u.pn * 256) * EH); }
    DI void gather(const g8::Unit&, const int (&)[2], const int (&)[2], unsigned (&)[2][2]) const {}
    DI void epi(g8::Acc& acc, const g8::Unit& u, int wr, int wc, int fr, int fq) const {
        const float* md = P_mod(p) + (layer * 2) * 6144 + 5 * 1024;
        f32x4 mv[2][2];
#pragma unroll
        for (int bj = 0; bj < 2; ++bj)
#pragma unroll
            for (int n = 0; n < 2; ++n) mv[bj][n] = *(const f32x4*)(md + u.pn * 256 + bj * 128 + wc * 32 + fq * 8 + n * 4);
#pragma unroll
        for (int ai = 0; ai < 2; ++ai)
#pragma unroll
            for (int m = 0; m < 4; ++m) {
                const int slot = u.aux * 2048 + u.pm * 256 + ai * 128 + wr * 64 + m * 16 + fr;
                const float g = P_sel_gate(p)[slot];
                u16* yr = P_ye(p) + (long)slot * DM + u.pn * 256 + wc * 32 + fq * 8;
#pragma unroll
                for (int bj = 0; bj < 2; ++bj) {
                    u32x4 o;
#pragma unroll
                    for (int n = 0; n < 2; ++n)
#pragma unroll
                        for (int e = 0; e < 2; ++e)
                            o[2 * n + e] = pack2(acc[ai][bj][m][n][2 * e] * g * mv[bj][n][2 * e], acc[ai][bj][m][n][2 * e + 1] * g * mv[bj][n][2 * e + 1]);
                    *(u32x4*)(yr + bj * 128) = o;
                }
            }
    }
};

DI void phH_item(KP p, int layer, int item, char* smem) {
    const int lane = TIDX() & 63, wid = TIDX() >> 6;
    float* hrow = (float*)smem + wid * 4096;
    const int row0 = item * 16 + wid * 4;
#pragma unroll
    for (int r = 0; r < 4; ++r) norm_row(p, layer, row0 + r, cur_row(p, row0 + r), p->g_ffn + layer * DM, 3, 4, P_hx(p) + (long)(row0 + r) * DM, hrow + r * 1024, nullptr);
    const int e = lane & 15, kp = lane >> 4;
    const float* wr_ = p->w_router + (long)layer * 1024 * 16 + e;
    float lg[4] = {0.f, 0.f, 0.f, 0.f};
#pragma unroll 8
    for (int k = kp * 256; k < kp * 256 + 256; ++k) {
        float w = wr_[k * 16];
#pragma unroll
        for (int r = 0; r < 4; ++r) lg[r] += hrow[r * 1024 + k] * w;
    }
#pragma unroll
    for (int r = 0; r < 4; ++r) {
        float l = lg[r];
        l += __shfl_xor(l, 16); l += __shfl_xor(l, 32);
        float mx = l;
        mx = fmaxf(mx, __shfl_xor(mx, 1)); mx = fmaxf(mx, __shfl_xor(mx, 2)); mx = fmaxf(mx, __shfl_xor(mx, 4)); mx = fmaxf(mx, __shfl_xor(mx, 8));
        float ex = expf(l - mx);
        float sm = ex;
        sm += __shfl_xor(sm, 1); sm += __shfl_xor(sm, 2); sm += __shfl_xor(sm, 4); sm += __shfl_xor(sm, 8);
        float a = ex / sm;
        int row = row0 + r;
        if (lane < 16) {
            if (row < NLAT) P_aff(p)[(long)e * NLAT + row] = a;
            else P_aff(p)[(long)(16 + e) * NLAT + (row - NLAT)] = a;
        }
    }
    __syncthreads();
}

DI int block_excl_scan(int v, int* sh  , int& total) {
    const int lane = TIDX() & 63, wid = TIDX() >> 6;
    int inc = v;
    for (int o = 1; o < 64; o <<= 1) { int t = __shfl_up(inc, o); if (lane >= o) inc += t; }
    __syncthreads();
    if (lane == 63) sh[wid] = inc;
    __syncthreads();
    int base = 0;
    for (int w = 0; w < wid; ++w) base += sh[w];
    total = sh[0] + sh[1] + sh[2] + sh[3];
    return base + inc - v;
}
DI void phI_item(KP p, int job, char* smem) {
    const int tid = TIDX(), lane = tid & 63, wid = tid >> 6;
    const bool lat = job < 16;
    const int n = lat ? NLAT : NCTX, cap = lat ? CAP_LAT : CAP_CTX, rowbase = lat ? 0 : NLAT;
    int* sh = (int*)smem;
    const float* a = P_aff(p) + (long)job * NLAT;
    unsigned keys[64];
    if (lat) {
#pragma unroll
        for (int i = 0; i < 16; ++i) { u32x4 v = *(const u32x4*)(a + tid * 64 + i * 4); keys[4 * i] = v[0]; keys[4 * i + 1] = v[1]; keys[4 * i + 2] = v[2]; keys[4 * i + 3] = v[3]; }
    } else {
#pragma unroll
        for (int i = 0; i < 64; ++i) keys[i] = 0u;
        keys[0] = __float_as_uint(a[tid]);
    }
    __syncthreads();
    auto block_sum = [&](int v, int it) -> int {
        for (int o = 32; o > 0; o >>= 1) v += __shfl_xor(v, o);
        int* slot = sh + (it & 1) * 4;
        if (lane == 0) slot[wid] = v;
        __syncthreads();
        return slot[0] + slot[1] + slot[2] + slot[3];
    };
    unsigned T = 0u;
    int it = 0;
    for (int bit = 29; bit >= 0; --bit, ++it) {
        const unsigned cand = T | (1u << bit);
        int c = 0;
#pragma unroll
        for (int i = 0; i < 64; ++i) c += (keys[i] >= cand);
        if (block_sum(c, it) >= cap) T = cand;
    }
    int cgt = 0, ceq = 0;
#pragma unroll
    for (int i = 0; i < 64; ++i) { cgt += (keys[i] > T); ceq += (keys[i] == T); }
    const int remaining = cap - block_sum(cgt, it);
    __syncthreads();
    int tot;
    int er = block_excl_scan(ceq, sh + 8, tot);
    int csel = 0;
    { int e2 = er;
#pragma unroll
      for (int i = 0; i < 64; ++i) { const unsigned k = keys[i]; if (k > T) ++csel; else if (k == T) { if (e2 < remaining) ++csel; ++e2; } } }
    int slot = block_excl_scan(csel, sh + 8, tot);
    int* ts = P_tslot(p) + (long)job * NLAT;
    const int per = lat ? 64 : 1;
    const int base = tid * per;
#pragma unroll
    for (int i = 0; i < 64; ++i) {
        if (i < per) {
            const unsigned k = keys[i];
            bool sel = false;
            if (k > T) sel = true; else if (k == T) { sel = er < remaining; ++er; }
            if (sel) { P_sel_idx(p)[job * 2048 + slot] = rowbase + base + i; P_sel_gate(p)[job * 2048 + slot] = __uint_as_float(k); ts[base + i] = slot; ++slot; }
            else ts[base + i] = -1;
        }
    }
    __syncthreads();
}

DI void phJ_tile(KP p, int job, int mt, int nt, char* smem) {
    const int tid = TIDX(), lane = tid & 63, wid = tid >> 6, wr = wid >> 1, wc = wid & 1, fr = lane & 15, fq = lane >> 4;
    const int cap = job < 16 ? CAP_LAT : CAP_CTX, e = job & 15;
    f32x4 acc[4][4]; zero_acc<4>(acc);
    const int r0 = tid >> 2, ko = (tid & 3) * 8;
    int s0 = mt * 128 + r0, s1 = s0 + 64;
    s0 = s0 < cap ? s0 : cap - 1; s1 = s1 < cap ? s1 : cap - 1;
    const u16* a0 = P_hx(p) + (long)P_sel_idx(p)[job * 2048 + s0] * DM + ko;
    const u16* a1 = P_hx(p) + (long)P_sel_idx(p)[job * 2048 + s1] * DM + ko;
    const int f_lo = nt * 64 + (r0 & 31), f_hi = f_lo + 32, gu = (r0 >> 5) & 1;
    const u16* b0 = P_wt_gu(p) + ((long)e * 2048 + (f_lo >> 7) * 256 + gu * 128 + (f_lo & 127)) * DM + ko;
    const u16* b1 = P_wt_gu(p) + ((long)e * 2048 + (f_hi >> 7) * 256 + gu * 128 + (f_hi & 127)) * DM + ko;
    gemm_core<32>(acc, a0, a1, b0, b1, smem);
    u16* hb = job < 16 ? P_hid(p) + (long)job * 2048 * EH : P_hidc(p) + (long)(job - 16) * 32 * EH;
#pragma unroll
    for (int m = 0; m < 4; ++m)
#pragma unroll
        for (int n = 0; n < 2; ++n)
#pragma unroll
            for (int j = 0; j < 4; ++j) {
                int slot = mt * 128 + wr * 64 + m * 16 + fq * 4 + j;
                int f = nt * 64 + wc * 32 + n * 16 + fr;
                if (slot < cap) hb[(long)slot * EH + f] = f2bf(siluf_(acc[m][n][j]) * acc[m][n + 2][j]);
            }
}
DI void phK_tile(KP p, int layer, int job, int mt, int nt, char* smem) {
    const int tid = TIDX(), lane = tid & 63, wid = tid >> 6, wr = wid >> 1, wc = wid & 1, fr = lane & 15, fq = lane >> 4;
    const int cap = job < 16 ? CAP_LAT : CAP_CTX, e = job & 15;
    f32x4 acc[4][4]; zero_acc<4>(acc);
    const int r0 = tid >> 2, ko = (tid & 3) * 8;
    int s0 = mt * 128 + r0, s1 = s0 + 64;
    s0 = s0 < cap ? s0 : cap - 1; s1 = s1 < cap ? s1 : cap - 1;
    const u16* hb = job < 16 ? P_hid(p) + (long)job * 2048 * EH : P_hidc(p) + (long)(job - 16) * 32 * EH;
    const u16* a0 = hb + (long)s0 * EH + ko;
    const u16* a1 = hb + (long)s1 * EH + ko;
    const u16* b0 = P_wt_dn(p) + ((long)e * 1024 + nt * 128 + r0) * EH + ko;
    gemm_core<32>(acc, a0, a1, b0, b0 + 64 * EH, smem);
    const float* md = P_mod(p) + (layer * 2 + (job < 16 ? 0 : 1)) * 6144 + 5 * 1024;
    u16* yb_ = job < 16 ? P_ye(p) + (long)job * 2048 * DM : P_yec(p) + (long)(job - 16) * 32 * DM;
#pragma unroll
    for (int m = 0; m < 4; ++m)
#pragma unroll
        for (int j = 0; j < 4; ++j) {
            int slot = mt * 128 + wr * 64 + m * 16 + fq * 4 + j;
            if (slot < cap) {
                float g = P_sel_gate(p)[job * 2048 + slot];
#pragma unroll
                for (int n = 0; n < 4; ++n) {
                    int col = nt * 128 + wc * 64 + n * 16 + fr;
                    yb_[(long)slot * DM + col] = f2bf(acc[m][n][j] * g * md[col]);
                }
            }
        }
}


#define XB_TMO      128
#define XB_XCNT(j)  (256  + 64 * (j))
#define XB_XSUB(j)  (1280 + 64 * (j))
#define XB_XGEN(j)  (2304 + 64 * (j))
#define XB_TOP      3328
#define XB_TOPGEN   3392
#define XCD_BAR_WORDS 3456
#define XB_SPIN_CAP (1u << 18)
DI unsigned xb_ld(unsigned* p)              { return __hip_atomic_load(p, __ATOMIC_RELAXED, __HIP_MEMORY_SCOPE_AGENT); }
DI unsigned xb_add(unsigned* p, unsigned v) { return __hip_atomic_fetch_add(p, v, __ATOMIC_RELAXED, __HIP_MEMORY_SCOPE_AGENT); }
DI unsigned xb_xcc_id() { return (unsigned)__builtin_amdgcn_s_getreg((3 << 11) | 20) & 0xFu; }
#define XB_SPIN(cond, bar) do { unsigned _sp = 0; while (cond) { __builtin_amdgcn_s_sleep(1); \
    if ((++_sp & 255u) == 0u) { if (xb_ld(&(bar)[XB_TMO])) break; if (_sp > XB_SPIN_CAP) { atomicAdd(&(bar)[XB_TMO], 1u); break; } } } } while (0)
struct XcdBarrier { unsigned* bar; unsigned x; volatile LAS unsigned* st; };
DI XcdBarrier xcd_barrier_post(unsigned* bar, volatile LAS unsigned* st) {
    XcdBarrier b; b.bar = bar; b.x = xb_xcc_id(); b.st = st;
    if (threadIdx.x == 0) (void)xb_add(&bar[XB_XCNT(b.x)], 1u);
    return b;
}
DI void xcd_barrier_complete(unsigned* bar, unsigned x, unsigned& nloc, unsigned& nx) {
    const unsigned G = gridDim.x * gridDim.y * gridDim.z;
    unsigned sum, cnt, mine, sp = 0u;
    for (;;) {
        sum = 0u; cnt = 0u; mine = 0u;
#pragma unroll
        for (unsigned j = 0; j < 16; ++j) { const unsigned c = xb_ld(&bar[XB_XCNT(j)]); sum += c; cnt += (c > 0u) ? 1u : 0u; mine = (j == x) ? c : mine; }
        if (sum == G) break;
        __builtin_amdgcn_s_sleep(1);
        if ((++sp & 255u) == 0u) { if (xb_ld(&bar[XB_TMO])) break; if (sp > XB_SPIN_CAP) { atomicAdd(&bar[XB_TMO], 1u); break; } }
    }
    nloc = mine > 0u ? mine : 1u; nx = cnt > 0u ? cnt : 1u;
}
DI void xcd_barrier(const XcdBarrier& b) {
    asm volatile("s_waitcnt vmcnt(0)" ::: "memory");
    __syncthreads();
    if (threadIdx.x == 0) {
        unsigned* bar = b.bar;
        __builtin_amdgcn_s_waitcnt(0);
        unsigned nloc = b.st[0], nx = b.st[1];
        if (nloc == 0u) { xcd_barrier_complete(bar, b.x, nloc, nx); b.st[0] = nloc; b.st[1] = nx; }
        const unsigned old = xb_add(&bar[XB_XSUB(b.x)], 1u);
        const unsigned gen = old / nloc;
        if (old + 1u == (gen + 1u) * nloc) {
            __builtin_amdgcn_fence(__ATOMIC_RELEASE, "agent");
            asm volatile("s_waitcnt vmcnt(0)" ::: "memory");
            const unsigned og = xb_add(&bar[XB_TOP], 1u);
            const unsigned tg = og / nx;
            if (og + 1u == (tg + 1u) * nx) xb_add(&bar[XB_TOPGEN], 1u);
            else XB_SPIN(xb_ld(&bar[XB_TOPGEN]) == tg, bar);
            __builtin_amdgcn_fence(__ATOMIC_ACQUIRE, "agent");
            xb_add(&bar[XB_XGEN(b.x)], 1u);
            asm volatile("s_waitcnt vmcnt(0)" ::: "memory");
        } else {
            XB_SPIN(xb_ld(&bar[XB_XGEN(b.x)]) == gen, bar);
            __builtin_amdgcn_fence(__ATOMIC_ACQUIRE, "agent");
            asm volatile("s_waitcnt vmcnt(0)" ::: "memory");
        }
    }
    __syncthreads();
}

DI void run_phase(int ph, char* smem_all) {
    KP p = (KP)__builtin_amdgcn_kernarg_segment_ptr();
    asm volatile("" : "+s"(p));
    const int sb = TID512() >> 8;
    char* smem = smem_all + sb * SUB_LDS;
    const int bid = BIDX() * 2 + sb, nb = gridDim.x * 2, tid = TIDX(), wid = tid >> 6;
#ifndef ONLY_SUB
    if (ph == 0) {
        const int total = 192 + 48 + CONV_TILES;
        for (int it = bid; it < total; it += nb) {
            if (it < 192) ph0_gemv_item(p, it, smem);
            else if (it < 240) ph0_rope_item(p, it - 192);
            else convert_tile(p, 0, it - 240, smem);
        }
        return;
    }
    if (ph == NPHASE - 1) {
        for (int it = bid; it < NLAT / 4; it += nb) {
            int row = it * 4 + wid, lane = tid & 63;
            float* xr = p->out + (long)row * DM;
            float4 v[4]; float ss = 0.f;
#pragma unroll
            for (int i = 0; i < 4; ++i) v[i] = *(const float4*)(xr + i * 256 + lane * 4);
            moe_combine(p, row, v);
#pragma unroll
            for (int i = 0; i < 4; ++i) ss += v[i].x * v[i].x + v[i].y * v[i].y + v[i].z * v[i].z + v[i].w * v[i].w;
            ss = wave_sum(ss);
            float rstd = rsqrtf(ss * (1.f / DM) + 1e-6f);
#pragma unroll
            for (int i = 0; i < 4; ++i) {
                float4 g = *(const float4*)(p->g_final + i * 256 + lane * 4);
                *(float4*)(xr + i * 256 + lane * 4) = make_float4(v[i].x * rstd * g.x, v[i].y * rstd * g.y, v[i].z * rstd * g.z, v[i].w * rstd * g.w);
            }
        }
        return;
    }
    const int layer = (ph - 1) / 11, sub = (ph - 1) % 11;
#else
    const int layer = (ph - 1) / 11, sub = ONLY_SUB;
#endif
    const bool need_ctx = layer == 0;
    switch (sub) {
    case 0: {
        const int nrow_items = NROWS / 4;
        const int total = nrow_items + (layer == 1 ? CONV_TILES : 0);
        for (int it = bid; it < total; it += nb) {
            if (it < nrow_items) { int row = it * 4 + wid; norm_row(p, layer, row, resid_row(p, layer, row), p->g_mix + layer * DM, 0, 1, P_hx(p) + (long)row * DM, nullptr, layer == 1 ? (float*)cur_row(p, row) : nullptr); }
            else convert_tile(p, layer, it - nrow_items, smem);
        }
    } break;
    case 1: {
        ProbB pb{p}; g8::gemm_phase((LAS unsigned char*)smem_all, pb);
    } break;
    case 2: {
        const int n_state = NCHUNK * 8, n_win = 1024, n_na = 1024, n_cx = need_ctx ? 32 : 0;
        const int total = n_state + n_win + n_na + n_cx;
        for (int it = bid; it < total; it += nb) {
            if (it < n_win) attn_wave_item(p, layer, 0, it >> 1, (it & 1) * 4 + wid, smem);
            else if (it < n_win + n_na) { int i2 = it - n_win; attn_wave_item(p, layer, 1, i2 >> 1, (i2 & 1) * 4 + wid, smem); }
            else if (it < n_win + n_na + n_state) { int i2 = it - n_win - n_na; phC_state_item(p, layer, i2 >> 3, (i2 >> 1) & 3, i2 & 1, smem); }
            else { int i2 = it - n_win - n_na - n_state; int kind = 2 + (i2 >> 4); i2 &= 15; attn_wave_item(p, layer, kind, i2 >> 1, (i2 & 1) * 4 + wid, smem); }
        }
    } break;
    case 3: {
        for (int it = bid; it < 512; it += nb) phD_item(p, layer, it);
    } break;
    case 4: {
        const int nch = need_ctx ? NCHUNK : 128;
        for (int it = bid; it < nch * 8; it += nb) phE_item(p, layer, it >> 3, (it >> 1) & 3, it & 1, smem);
    } break;
    case 5: {
        { ProbF pf{p}; g8::gemm_phase((LAS unsigned char*)smem_all, pf); }
        if (need_ctx) {
            const int sb2 = TID512() >> 8;
            for (int it = BIDX() * 2 + sb2; it < 16; it += (int)gridDim.x * 2) phF_tile(p, 128 + (it >> 3), it & 7, smem_all + sb2 * SUB_LDS);
        }
    } break;
    case 6: {
        { ProbG pg{p, layer}; g8::gemm_phase((LAS unsigned char*)smem_all, pg); }
        if (need_ctx) {
            const int sb2 = TID512() >> 8;
            for (int it = BIDX() * 2 + sb2; it < 16; it += (int)gridDim.x * 2) phG_tile(p, layer, 128 + (it >> 3), it & 7, smem_all + sb2 * SUB_LDS);
        }
    } break;
    case 7: {
        const int nit = (need_ctx ? NROWS : NLAT) / 16;
        for (int it = bid; it < nit; it += nb) phH_item(p, layer, it, smem);
    } break;
    case 8: {
        const int njob = need_ctx ? 32 : 16;
        for (int it = bid; it < njob; it += nb) phI_item(p, it, smem);
    } break;
    case 9: {
        { ProbJ pj{p}; g8::gemm_phase((LAS unsigned char*)smem_all, pj); }
        if (need_ctx) {
            const int sb2 = TID512() >> 8;
            for (int it = BIDX() * 2 + sb2; it < 256; it += (int)gridDim.x * 2) phJ_tile(p, 16 + (it >> 4), 0, it & 15, smem_all + sb2 * SUB_LDS);
        }
    } break;
    case 10: {
        { ProbK pk{p, layer}; g8::gemm_phase((LAS unsigned char*)smem_all, pk); }
        if (need_ctx) {
            const int sb2 = TID512() >> 8;
            for (int it = BIDX() * 2 + sb2; it < 128; it += (int)gridDim.x * 2) phK_tile(p, layer, 16 + (it >> 3), 0, it & 7, smem_all + sb2 * SUB_LDS);
        }
    } break;
    }
}

__global__ void __launch_bounds__(NTHREADS, 2) mega_kernel(Params p, int ph_lo, int ph_hi) {
    __shared__ __attribute__((aligned(16))) char smem[LDS_BYTES + 16];
    cg::grid_group grid = cg::this_grid();
#if MK_MULTI
    for (int ph = ph_lo; ph < ph_hi; ++ph) {
        if (ph > ph_lo) grid.sync();
        run_phase(ph, smem);
    }
#else
    unsigned* barw = (unsigned*)(p.ws + WS_BAR);
    volatile LAS unsigned* xst = (volatile LAS unsigned*)(LAS char*)(smem + LDS_BYTES);
    if (threadIdx.x < 4) xst[threadIdx.x] = 0u;
    if (blockIdx.x == 0) for (int i = threadIdx.x; i < XCD_BAR_WORDS; i += NTHREADS) barw[i] = 0u;
    run_phase(0, smem);
    grid.sync();
    const XcdBarrier xb = xcd_barrier_post(barw, xst);
#ifdef PROBE_SUB
#define PH(n) do { if ((n) > 1) xcd_barrier(xb); run_phase((n), smem); if ((n) >= PROBE_MIN && (n) <= PROBE_MAX && (((n) - 1) % 11) == PROBE_SUB) { xcd_barrier(xb); run_phase((n), smem); } } while (0)
#else
#define PH(n) do { if ((n) > 1) xcd_barrier(xb); run_phase((n), smem); } while (0)
#endif
    PH(1); PH(2); PH(3); PH(4); PH(5); PH(6); PH(7); PH(8); PH(9); PH(10); PH(11);
    PH(12); PH(13); PH(14); PH(15); PH(16); PH(17); PH(18); PH(19); PH(20); PH(21); PH(22); PH(23);
    static_assert(NPHASE == 24, "phase program");
#undef PH
#endif
}

extern "C" void kernel_launch(void* const* d_in, const int* in_sizes, int n_in, void* d_out, int out_size, void* d_ws, size_t ws_size,
                              hipStream_t stream) {
    static int grid_blocks = 0;
    if (!grid_blocks) {
        int dev = 0, cus = 0, per_cu = 0;
        hipGetDevice(&dev);
        hipDeviceGetAttribute(&cus, hipDeviceAttributeMultiprocessorCount, dev);
        hipOccupancyMaxActiveBlocksPerMultiprocessor(&per_cu, mega_kernel, NTHREADS, 0);
        if (per_cu < 1) per_cu = 1;
        if (per_cu > 1) per_cu = 1;
        grid_blocks = cus * per_cu;
    }
    Params p{};
    const float** ip = (const float**)&p.x;
    for (int i = 0; i < 22; ++i) ip[i] = (const float*)d_in[i];
    p.out = (float*)d_out;
    p.ws = (char*)d_ws;
    if (WS_END > ws_size) { fprintf(stderr, "kernel_launch: workspace too small: need %zu have %zu\n", (size_t)WS_END, ws_size); return; }
#if MK_MULTI
    for (int ph = 0; ph < NPHASE; ++ph) {
        hipLaunchKernelGGL(mega_kernel, dim3(grid_blocks), dim3(NTHREADS), 0, stream, p, ph, ph + 1);
    }
#else
    int lo = 0, hi = NPHASE;
    void* args[] = {&p, &lo, &hi};
    hipError_t e = hipLaunchCooperativeKernel((void*)mega_kernel, dim3(grid_blocks), dim3(NTHREADS), args, 0, stream);
    if (e != hipSuccess) fprintf(stderr, "cooperative launch failed: %s (grid %d)\n", hipGetErrorString(e), grid_blocks);
#endif
}
```

```cpp
#include <hip/hip_runtime.h>
#include <hip/hip_bf16.h>
#include <hip/hip_cooperative_groups.h>
#include <cstdio>
#include <cstdint>
namespace cg = cooperative_groups;

#ifndef MK_MULTI
#define MK_MULTI 0
#endif

#define DI __device__ __forceinline__
typedef unsigned short u16;
typedef __attribute__((ext_vector_type(8))) short bf16x8;
typedef __attribute__((ext_vector_type(4))) float f32x4;
typedef __attribute__((ext_vector_type(4))) unsigned int u32x4;

constexpr int NLAT = 16384, NCTX = 256, NROWS = NLAT + NCTX, DM = 1024, INC = 7424;
constexpr int C_QR = 0, C_KR = 512, C_VR = 1024, C_GR = 1536, C_QW = 2048, C_KW = 2560, C_VW = 2688, C_QN = 2816, C_KN = 3328, C_VN = 3840, C_GATE = 4352;
__host__ __device__ constexpr int col_qr(int h, int x) { return C_QR + (h >> 1) * 256 + x * 128 + (h & 1) * 64; }
__host__ __device__ constexpr int col_kr(int h, int x) { return C_KR + (h >> 1) * 256 + x * 128 + (h & 1) * 64; }
__host__ __device__ constexpr int col_qw(int h, int x) { return C_QW + (h >> 2) * 256 + x * 128 + (h & 3) * 32; }
__host__ __device__ constexpr int col_kw(int kh, int x) { return C_KW + x * 128 + kh * 32; }
__host__ __device__ constexpr int col_vw(int kh) { return C_KW + 64 + kh * 128; }
constexpr int NCHUNK = NROWS / 128;
constexpr int NEXP = 16, EH = 1024, CAP_LAT = 2048, CAP_CTX = 32;
constexpr int NTHREADS = 512;
constexpr int SUB_LDS = 76 * 1024;
constexpr int LDS_BYTES = 2 * SUB_LDS;
constexpr int NPHASE = 24;


constexpr size_t al256(size_t b) { return (b + 255) & ~(size_t)255; }
constexpr size_t WS_CTXRES = 0;
constexpr size_t WS_MOD = WS_CTXRES + al256((size_t)NCTX * DM * 4);
constexpr size_t WS_ROPE128 = WS_MOD + al256(2 * 2 * 6144 * 4);
constexpr size_t WS_ROPE64 = WS_ROPE128 + al256(256 * 32 * 8);
constexpr size_t WS_WT_IN = WS_ROPE64 + al256(256 * 16 * 8);
constexpr size_t WS_WT_RET = WS_WT_IN + al256((size_t)INC * DM * 2);
constexpr size_t WS_WT_WIN = WS_WT_RET + al256((size_t)1024 * 512 * 2);
constexpr size_t WS_WT_NA = WS_WT_WIN + al256((size_t)1024 * 512 * 2);
constexpr size_t WS_WT_OUT = WS_WT_NA + al256((size_t)1024 * 512 * 2);
constexpr size_t WS_WT_GU = WS_WT_OUT + al256((size_t)1024 * 1024 * 2);
constexpr size_t WS_WT_DN = WS_WT_GU + al256((size_t)NEXP * 2048 * 1024 * 2);
constexpr size_t WS_HX = WS_WT_DN + al256((size_t)NEXP * 1024 * 1024 * 2);
constexpr size_t WS_PX = WS_HX + al256((size_t)NROWS * DM * 2);
constexpr size_t WS_YA = WS_PX + al256((size_t)NROWS * INC * 2);
constexpr size_t WS_YB = WS_YA + al256((size_t)NROWS * 512 * 2);
constexpr size_t WS_YC = WS_YB + al256((size_t)NROWS * 512 * 2);
constexpr size_t WS_S = WS_YC + al256((size_t)NROWS * 512 * 2);
constexpr size_t WS_R = WS_S + al256((size_t)NCHUNK * 8 * 16384 * 4);
constexpr size_t WS_AFF = WS_R + al256((size_t)NCHUNK * 8 * 16384 * 2);
constexpr size_t WS_SELI = WS_AFF + al256((size_t)32 * NLAT * 4);
constexpr size_t WS_SELG = WS_SELI + al256(32 * 2048 * 4);
constexpr size_t WS_TSLOT = WS_SELG + al256(32 * 2048 * 4);
constexpr size_t WS_BAR = WS_TSLOT + al256((size_t)32 * NLAT * 4);
constexpr size_t WS_END = WS_BAR + al256(3456 * 4);
struct Params {
    const float *x, *c, *ctx, *c_ctx, *w_mod, *b_mod, *g_mix, *g_ffn, *w_in, *decay, *ret_gn, *w_ret, *sink, *w_win, *rpb, *w_na, *w_out,
        *w_router, *w_eg, *w_eu, *w_ed, *g_final;
    float* out;
    char* ws;
};
typedef const Params __attribute__((address_space(4)))* KP;
#define WSF(name, type, off) __device__ __forceinline__ type* P_##name(KP p) { return (type*)(p->ws + (off)); }
WSF(ctxres, float, WS_CTXRES)
WSF(mod, float, WS_MOD)
WSF(rope128, float2, WS_ROPE128)
WSF(rope64, float2, WS_ROPE64)
WSF(wt_in, u16, WS_WT_IN) WSF(wt_ret, u16, WS_WT_RET) WSF(wt_win, u16, WS_WT_WIN) WSF(wt_na, u16, WS_WT_NA) WSF(wt_out, u16, WS_WT_OUT)
WSF(wt_gu, u16, WS_WT_GU) WSF(wt_dn, u16, WS_WT_DN)
WSF(hx, u16, WS_HX)
WSF(px, u16, WS_PX)
WSF(ya, u16, WS_YA) WSF(yb, u16, WS_YB) WSF(yc, u16, WS_YC)
WSF(S, float, WS_S)
WSF(R, u16, WS_R)
WSF(aff, float, WS_AFF)
WSF(sel_idx, int, WS_SELI) WSF(sel_gate, float, WS_SELG)
WSF(hid, u16, WS_PX)
__device__ __forceinline__ u16* P_hidc(KP p) { return (u16*)(p->ws + WS_PX) + (size_t)NEXP * 2048 * 1024; }
__device__ __forceinline__ u16* P_ye(KP p) { return (u16*)(p->ws + WS_PX) + (size_t)NEXP * (2048 + 32) * 1024; }
__device__ __forceinline__ u16* P_yec(KP p) { return P_ye(p) + (size_t)NEXP * 2048 * 1024; }
__device__ __forceinline__ int* P_tslot(KP p) { return (int*)(p->ws + WS_TSLOT); }
__device__ __forceinline__ u16* P_z(KP p) { return (u16*)(p->ws + WS_S); }
__device__ __forceinline__ float* P_maccx(KP p) { return (float*)(p->ws + WS_S + (size_t)3 * NLAT * DM * 2); }
#undef WSF


DI int TIDX() { int t = threadIdx.x & 255; asm volatile("" : "+v"(t)); return t; }
DI int TID512() { int t = threadIdx.x; asm volatile("" : "+v"(t)); return t; }
DI int BIDX() { int t = blockIdx.x; asm volatile("" : "+s"(t)); return t; }
DI u16 f2bf(float x) { unsigned u = __float_as_uint(x); u += 0x7fffu + ((u >> 16) & 1u); return (u16)(u >> 16); }
DI float bf2f(u16 h) { return __uint_as_float(((unsigned)h) << 16); }
DI float bflo(unsigned w) { return __uint_as_float(w << 16); }
DI float bfhi(unsigned w) { return __uint_as_float(w & 0xffff0000u); }
typedef __bf16 bf16v2 __attribute__((ext_vector_type(2)));
typedef float f32v2 __attribute__((ext_vector_type(2)));
DI unsigned pack2(float a, float b) { f32v2 v = {a, b}; bf16v2 r = __builtin_convertvector(v, bf16v2); return __builtin_bit_cast(unsigned, r); }
DI float sigmoidf_(float x) { return 1.f / (1.f + __expf(-x)); }
DI float siluf_(float x) { return x / (1.f + __expf(-x)); }
DI float wave_sum(float v) { for (int o = 32; o > 0; o >>= 1) v += __shfl_xor(v, o); return v; }
#define MFMA16(a, b, c) __builtin_amdgcn_mfma_f32_16x16x32_bf16((a), (b), (c), 0, 0, 0)

template <int MR>
DI void zero_acc(f32x4 (&acc)[MR][4]) {
#pragma unroll
    for (int m = 0; m < MR; ++m)
#pragma unroll
        for (int n = 0; n < 4; ++n) acc[m][n] = f32x4{0.f, 0.f, 0.f, 0.f};
}

template <int KT>
DI void gemm_core(f32x4 (&acc)[4][4], const u16* a0, const u16* a1, const u16* b0, const u16* b1, char* smem) {
    const int tid = TIDX(), lane = tid & 63, wid = tid >> 6, wr = wid >> 1, wc = wid & 1, fr = lane & 15, fq = lane >> 4;
    auto stage = [&](int kt, int buf) {
        char* base = smem + buf * 16384;
        __builtin_amdgcn_global_load_lds((const unsigned*)(a0 + kt * 32), (unsigned*)(base + tid * 16), 16, 0, 0);
        __builtin_amdgcn_global_load_lds((const unsigned*)(a1 + kt * 32), (unsigned*)(base + 4096 + tid * 16), 16, 0, 0);
        __builtin_amdgcn_global_load_lds((const unsigned*)(b0 + kt * 32), (unsigned*)(base + 8192 + tid * 16), 16, 0, 0);
        __builtin_amdgcn_global_load_lds((const unsigned*)(b1 + kt * 32), (unsigned*)(base + 12288 + tid * 16), 16, 0, 0);
    };
    __syncthreads();
    stage(0, 0);
    for (int kt = 0; kt < KT; ++kt) {
        asm volatile("s_waitcnt vmcnt(0)" ::: "memory");
        __syncthreads();
        if (kt + 1 < KT) stage(kt + 1, (kt + 1) & 1);
        const char* SA = smem + (kt & 1) * 16384;
        const char* SB = SA + 8192;
        bf16x8 At[4], Bt[4];
#pragma unroll
        for (int m = 0; m < 4; ++m) At[m] = *(const bf16x8*)(SA + (wr * 64 + m * 16 + fr) * 64 + fq * 16);
#pragma unroll
        for (int n = 0; n < 4; ++n) Bt[n] = *(const bf16x8*)(SB + (wc * 64 + n * 16 + fr) * 64 + fq * 16);
#pragma unroll
        for (int m = 0; m < 4; ++m)
#pragma unroll
            for (int n = 0; n < 4; ++n) acc[m][n] = MFMA16(At[m], Bt[n], acc[m][n]);
    }
}

template <int MR>
DI void mma_lds64(f32x4 (&acc)[MR][4], const u16* As, int lda, const u16* Bs, int ldb) {
    const int tid = TIDX(), lane = tid & 63, wid = tid >> 6, wr = wid >> 1, wc = wid & 1, fr = lane & 15, fq = lane >> 4;
#pragma unroll
    for (int kk = 0; kk < 2; ++kk) {
        bf16x8 At[MR], Bt[4];
#pragma unroll
        for (int m = 0; m < MR; ++m) At[m] = *(const bf16x8*)(As + (wr * (MR * 16) + m * 16 + fr) * lda + kk * 32 + fq * 8);
#pragma unroll
        for (int n = 0; n < 4; ++n) Bt[n] = *(const bf16x8*)(Bs + (wc * 64 + n * 16 + fr) * ldb + kk * 32 + fq * 8);
#pragma unroll
        for (int m = 0; m < MR; ++m)
#pragma unroll
            for (int n = 0; n < 4; ++n) acc[m][n] = MFMA16(At[m], Bt[n], acc[m][n]);
    }
}
template <int ROWS>
DI void stage_n64(u16* dst, int ld, const u16* src, long sstride) {
    const int tid = TIDX();
#pragma unroll
    for (int i = 0; i < ROWS / 32; ++i) {
        int idx = i * 256 + tid, row = idx >> 3, ch = idx & 7;
        u32x4 v = *(const u32x4*)(src + (long)row * sstride + ch * 8);
        *(u32x4*)(dst + row * ld + ch * 8) = v;
    }
}
template <bool SCALE, int NF>
DI void stage_t64(u16* dst, int ld, const u16* src, long sstride, float scale_tok_lane  ) {
    const int tid = TIDX();
#pragma unroll
    for (int i = 0; i < NF / 32; ++i) {
        int idx = i * 256 + tid, jj = idx & 63, ch = idx >> 6;
        u32x4 v = *(const u32x4*)(src + (long)jj * sstride + ch * 8);
#pragma unroll
        for (int e = 0; e < 4; ++e) {
            float lo = bflo(v[e]), hi = bfhi(v[e]);
            if (SCALE) { lo *= scale_tok_lane; hi *= scale_tok_lane; }
            dst[(ch * 8 + 2 * e) * ld + jj] = SCALE ? f2bf(lo) : (u16)(v[e] & 0xffffu);
            dst[(ch * 8 + 2 * e + 1) * ld + jj] = SCALE ? f2bf(hi) : (u16)(v[e] >> 16);
        }
    }
}

DI void convert_tile(KP p, int layer, int tile, char* smem);

DI void ph0_gemv_item(KP p, int item, char* smem) {
    const int tid = TIDX();
    const int l = item / 96, cg_ = item % 96;
    float* sl = (float*)smem;
    float* red = (float*)(smem + 8192);
    __syncthreads();
    for (int k = tid; k < 1024; k += 256) { sl[k] = siluf_(p->c[k]); sl[1024 + k] = siluf_(p->c_ctx[k]); }
    __syncthreads();
    const int c4 = tid & 15, kp = tid >> 4;
    const int col = cg_ * 64 + c4 * 4;
    const float* w = p->w_mod + (long)l * 1024 * 6144 + col;
    float a0[4] = {0, 0, 0, 0}, a1[4] = {0, 0, 0, 0};
#pragma unroll 8
    for (int kk = 0; kk < 64; ++kk) {
        int k = kp * 64 + kk;
        float4 wv = *(const float4*)(w + (long)k * 6144);
        float s0 = sl[k], s1 = sl[1024 + k];
        a0[0] += s0 * wv.x; a0[1] += s0 * wv.y; a0[2] += s0 * wv.z; a0[3] += s0 * wv.w;
        a1[0] += s1 * wv.x; a1[1] += s1 * wv.y; a1[2] += s1 * wv.z; a1[3] += s1 * wv.w;
    }
#pragma unroll
    for (int j = 0; j < 4; ++j) { red[(kp * 2 + 0) * 64 + c4 * 4 + j] = a0[j]; red[(kp * 2 + 1) * 64 + c4 * 4 + j] = a1[j]; }
    __syncthreads();
    if (tid < 128) {
        int src = tid >> 6, cr = tid & 63;
        float s = 0.f;
        for (int q = 0; q < 16; ++q) s += red[(q * 2 + src) * 64 + cr];
        int n = cg_ * 64 + cr;
        P_mod(p)[(l * 2 + src) * 6144 + n] = s + p->b_mod[l * 6144 + n];
    }
}
DI void sincos_d(double a, float& c, float& s) {
    const double TWO_PI = 6.283185307179586476925286766559;
    double k = rint(a / TWO_PI);
    double r = a - k * TWO_PI;
    double r2 = r * r;
    double ts = r, tc = 1.0, ss = r, cc = 1.0;
    for (int i = 1; i <= 14; ++i) {
        tc = -tc * r2 / (double)((2 * i - 1) * (2 * i));
        ts = -ts * r2 / (double)((2 * i) * (2 * i + 1));
        cc += tc; ss += ts;
    }
    c = (float)cc; s = (float)ss;
}
DI void ph0_rope_item(KP p, int item) {
    int idx = item * 256 + TIDX();
    const double LN_BASE = 9.210340371976184;
    if (idx < 8192) {
        int pos = idx >> 5, f = idx & 31;
        float inv = (float)exp(-(double)f / 32.0 * LN_BASE);
        float ang = (float)pos * inv;
        float c, s; sincos_d((double)ang, c, s);
        P_rope128(p)[idx] = make_float2(c, s);
    } else {
        int i2 = idx - 8192;
        int pos = i2 >> 4, f = i2 & 15;
        float inv = (float)exp(-(double)f / 16.0 * LN_BASE);
        float ang = (float)pos * inv;
        float c, s; sincos_d((double)ang, c, s);
        P_rope64(p)[i2] = make_float2(c, s);
    }
}

constexpr int CONV_TILES = 1856 + 384 + 256 + 12288;
constexpr int CONV_DENSE = 1856 + 384 + 256;
DI void convert_tile(KP p, int layer, int tile, char* smem) {
    const int tid = TIDX();
    const float* src; u16* dst; int K, N, mode = 0;
    if (tile < 1856) { src = p->w_in + (long)layer * 1024 * INC; dst = P_wt_in(p); K = 1024; N = INC; mode = 1; }
    else if (tile < 1856 + 384) {
        int t = tile - 1856, which = t / 128; tile = t % 128; K = 512; N = 1024;
        src = (which == 0 ? p->w_ret : which == 1 ? p->w_win : p->w_na) + (long)layer * 512 * 1024;
        dst = (which == 0 ? P_wt_ret(p) : which == 1 ? P_wt_win(p) : P_wt_na(p));
    } else if (tile < 1856 + 384 + 256) { tile -= 1856 + 384; src = p->w_out + (long)layer * 1024 * 1024; dst = P_wt_out(p); K = 1024; N = 1024; }
    else {
        int t = tile - (1856 + 384 + 256), which = t / 4096, e = (t % 4096) / 256; tile = t % 256; K = 1024; N = 1024;
        long eo = ((long)layer * NEXP + e) * 1024 * 1024;
        if (which == 0) { src = p->w_eg + eo; dst = P_wt_gu(p) + (long)e * 2048 * 1024; mode = 2; }
        else if (which == 1) { src = p->w_eu + eo; dst = P_wt_gu(p) + (long)e * 2048 * 1024; mode = 3; }
        else { src = p->w_ed + eo; dst = P_wt_dn(p) + (long)e * 1024 * 1024; }
    }
    const int ntn = N / 64;
    const int k0 = (tile / ntn) * 64, n0 = (tile % ntn) * 64;
    const int lane = tid & 63, w = tid >> 6;
    const int n = n0 + lane;
    int drow = n;
    if (mode == 1) {
        if (n < 1024) { int hh_ = (n & 511) >> 7, o_ = n & 127; drow = (n < 512 ? col_qr(hh_, o_ >> 6) : col_kr(hh_, o_ >> 6)) + (o_ & 63); }
        else if (n >= C_QW && n < C_KW) { int m_ = n - C_QW; drow = col_qw(m_ >> 6, (m_ & 63) >> 5) + (m_ & 31); }
        else if (n >= C_KW && n < C_VW) { int m_ = n - C_KW; drow = col_kw(m_ >> 6, (m_ & 63) >> 5) + (m_ & 31); }
        else if (n >= C_VW && n < C_QN) { int m_ = n - C_VW; drow = col_vw(m_ >> 6) + (m_ & 63); }
    } else if (mode == 2) drow = (n >> 7) * 256 + (n & 127);
    else if (mode == 3) drow = (n >> 7) * 256 + 128 + (n & 127);
    const float* sp = src + (long)(k0 + w * 16) * N + n;
    float v[16];
#pragma unroll
    for (int j = 0; j < 16; ++j) v[j] = sp[(long)j * N];
#pragma unroll
    for (int g = 0; g < 2; ++g) {
        u32x4 o;
#pragma unroll
        for (int e = 0; e < 4; ++e) o[e] = pack2(v[g * 8 + 2 * e], v[g * 8 + 2 * e + 1]);
        *(u32x4*)(dst + (long)drow * K + k0 + w * 16 + g * 8) = o;
    }
}

DI const float* resid_row(KP p, int layer, int row) {
    if (row < NLAT) return (layer == 0 ? p->x : p->out) + (long)row * DM;
    return (layer == 0 ? p->ctx : P_ctxres(p)) + (long)(row - NLAT) * DM;
}
DI const float* cur_row(KP p, int row) { return row < NLAT ? p->out + (long)row * DM : P_ctxres(p) + (long)(row - NLAT) * DM; }
DI void moe_combine(KP p, int row, float4 (&v)[4]) {
    const int lane = TIDX() & 63;
    const bool lat = row < NLAT;
    const int* ts = P_tslot(p) + (lat ? 0 : 16) * (long)NLAT + (lat ? row : row - NLAT);
    const u16* yb_ = lat ? P_ye(p) : P_yec(p);
    const int cap = lat ? CAP_LAT : CAP_CTX;
#pragma unroll 4
    for (int e = 0; e < NEXP; ++e) {
        const int slot = ts[(long)e * NLAT];
        if (slot >= 0) {
            const u16* yr = yb_ + ((long)e * cap + slot) * DM + lane * 4;
#pragma unroll
            for (int i = 0; i < 4; ++i) {
                uint2 w = *(const uint2*)(yr + i * 256);
                v[i].x += bflo(w.x); v[i].y += bfhi(w.x); v[i].z += bflo(w.y); v[i].w += bfhi(w.y);
            }
        }
    }
}
DI void norm_row(KP p, int layer, int row, const float* xr, const float* g, int shift_idx, int scale_idx, u16* dst_row, float* keep  , float* wb  ) {
    const int lane = TIDX() & 63;
    const float* md = P_mod(p) + (layer * 2 + (row < NLAT ? 0 : 1)) * 6144;
    float4 v[4]; float ss = 0.f;
#pragma unroll
    for (int i = 0; i < 4; ++i) v[i] = *(const float4*)(xr + i * 256 + lane * 4);
    if (wb) {
        moe_combine(p, row, v);
#pragma unroll
        for (int i = 0; i < 4; ++i) *(float4*)(wb + i * 256 + lane * 4) = v[i];
    }
#pragma unroll
    for (int i = 0; i < 4; ++i) ss += v[i].x * v[i].x + v[i].y * v[i].y + v[i].z * v[i].z + v[i].w * v[i].w;
    ss = wave_sum(ss);
    float rstd = rsqrtf(ss * (1.f / DM) + 1e-6f);
#pragma unroll
    for (int i = 0; i < 4; ++i) {
        int c0 = i * 256 + lane * 4;
        float4 gg = *(const float4*)(g + c0), sh = *(const float4*)(md + shift_idx * 1024 + c0), sc = *(const float4*)(md + scale_idx * 1024 + c0);
        float o0 = v[i].x * rstd * gg.x * (1.f + sc.x) + sh.x, o1 = v[i].y * rstd * gg.y * (1.f + sc.y) + sh.y;
        float o2 = v[i].z * rstd * gg.z * (1.f + sc.z) + sh.z, o3 = v[i].w * rstd * gg.w * (1.f + sc.w) + sh.w;
        uint2 pk; pk.x = pack2(o0, o1); pk.y = pack2(o2, o3);
        *(uint2*)(dst_row + c0) = pk;
        if (keep) *(float4*)(keep + c0) = make_float4(o0, o1, o2, o3);
    }
}

DI void phB_tile(KP p, int mt, int nt, char* smem) {
    const int tid = TIDX(), lane = tid & 63, wid = tid >> 6, wr = wid >> 1, wc = wid & 1, fr = lane & 15, fq = lane >> 4;
    f32x4 acc[4][4]; zero_acc<4>(acc);
    const int r0 = tid >> 2, ko = (tid & 3) * 8;
    const u16* a0 = P_hx(p) + (long)(mt * 128 + r0) * DM + ko;
    const u16* b0 = P_wt_in(p) + (long)(nt * 128 + r0) * DM + ko;
    gemm_core<32>(acc, a0, a0 + 64 * DM, b0, b0 + 64 * DM, smem);
    const bool lat = mt < 128;
    const int type = (nt < 8) ? 1 : (nt >= 16 && nt < 21) ? 2 : 0;
    if (type != 0 && lat) {
#pragma unroll
        for (int m = 0; m < 4; ++m)
#pragma unroll
            for (int j = 0; j < 4; ++j) {
                int t = mt * 128 + wr * 64 + m * 16 + fq * 4 + j;
                int pr = t >> 6, pc = t & 63;
#pragma unroll
                for (int n = 0; n < 2; ++n) {
                    float2 cs;
                    if (type == 1) { int pos = (wc == 0) ? pr : pc; cs = P_rope128(p)[pos * 32 + n * 16 + fr]; }
                    else { int pos = (n == 0) ? pr : pc; cs = P_rope64(p)[pos * 16 + fr]; }
                    float x1 = acc[m][n][j], x2 = acc[m][n + 2][j];
                    acc[m][n][j] = x1 * cs.x - x2 * cs.y;
                    acc[m][n + 2][j] = x1 * cs.y + x2 * cs.x;
                }
            }
    }
    const float mul = (nt >= 4 && nt < 8) ? 0.08838834764831845f : ((nt >= 16 && nt < 20) || (nt >= 22 && nt < 26)) ? 0.125f : 1.f;
#pragma unroll
    for (int m = 0; m < 4; ++m)
#pragma unroll
        for (int n = 0; n < 4; ++n)
#pragma unroll
            for (int j = 0; j < 4; ++j) {
                int row = mt * 128 + wr * 64 + m * 16 + fq * 4 + j, col = nt * 128 + wc * 64 + n * 16 + fr;
                P_px(p)[(long)row * INC + col] = f2bf(acc[m][n][j] * mul);
            }
}

typedef __attribute__((ext_vector_type(16))) float f32x16;
typedef short v4s __attribute__((ext_vector_type(4)));
typedef __attribute__((address_space(3))) v4s* lds_v4s_ptr;
#define MFMA32(a, b, c) __builtin_amdgcn_mfma_f32_32x32x16_bf16((a), (b), (c), 0, 0, 0)
constexpr float LOG2E = 1.4426950408889634f;

struct FA {
    bf16x8 qf[4];
    f32x16 o[2];
    float m, l;
};
DI void fa_stage(u16* Ks, u16* Vs, const u16* px, int rowstart, int colK1, int colK2, int colV) {
    const int lane = TIDX() & 63;
#pragma unroll
    for (int i = 0; i < 8; ++i) {
        int idx = i * 64 + lane, key = idx >> 3, ch = idx & 7;
        const u16* src = px + (long)(rowstart + key) * INC;
        u32x4 kv = *(const u32x4*)(src + (ch < 4 ? colK1 + ch * 8 : colK2 + (ch - 4) * 8));
        u32x4 vv = *(const u32x4*)(src + colV + ch * 8);
        *(u32x4*)(Ks + key * 72 + ch * 8) = kv;
        *(u32x4*)(Vs + key * 72 + ch * 8) = vv;
    }
}
template <int MODE>
DI void fa_tile(FA& st, const u16* Ks, const u16* Vs, int a0, const float* rrow) {
    const int lane = TIDX() & 63, c = lane & 31, hh = lane >> 5;
    const u16* kbase = Ks + c * 72 + hh * 8;
    const u16* vbase = Vs + (4 * hh + ((lane & 15) >> 2)) * 72 + 16 * ((lane >> 4) & 1) + 4 * (lane & 3);
    f32x16 s[2];
#pragma unroll
    for (int kb = 0; kb < 2; ++kb) {
#pragma unroll
        for (int r = 0; r < 16; ++r) s[kb][r] = 0.f;
#pragma unroll
        for (int ks = 0; ks < 4; ++ks) {
            bf16x8 A = *(const bf16x8*)(kbase + kb * 32 * 72 + ks * 16);
            s[kb] = MFMA32(A, st.qf[ks], s[kb]);
        }
    }
    float mx = -3.0e38f;
    const int cq = a0 + c;
    int cs = cq - 8; cs = cs < 0 ? 0 : (cs > 48 ? 48 : cs);
#pragma unroll
    for (int kb = 0; kb < 2; ++kb)
#pragma unroll
        for (int r = 0; r < 16; ++r) {
            const int j = kb * 32 + (r & 3) + 8 * (r >> 2) + 4 * hh;
            float v = s[kb][r];
            if (MODE == 1) { int d = a0 + j - c; v = (d >= -128 && d <= 128) ? v : -1e30f; }
            if (MODE == 2) { bool ok = (j >= cs) && (j < cs + 16); int ci = j - cq + 15; ci = ci < 0 ? 0 : (ci > 30 ? 30 : ci); v = ok ? v + rrow[ci] : -1e30f; }
            v *= LOG2E;
            s[kb][r] = v;
            mx = fmaxf(mx, v);
        }
    mx = fmaxf(mx, __shfl_xor(mx, 32));
    const float mn = fmaxf(st.m, mx);
    const float alpha = __builtin_amdgcn_exp2f(st.m - mn);
    float ls = 0.f;
#pragma unroll
    for (int kb = 0; kb < 2; ++kb)
#pragma unroll
        for (int r = 0; r < 16; ++r) { float pv = __builtin_amdgcn_exp2f(s[kb][r] - mn); s[kb][r] = pv; ls += pv; }
    st.l = st.l * alpha + ls; st.m = mn;
#pragma unroll
    for (int db = 0; db < 2; ++db)
#pragma unroll
        for (int r = 0; r < 16; ++r) st.o[db][r] *= alpha;
    bf16x8 pf[2][2];
#pragma unroll
    for (int kb = 0; kb < 2; ++kb)
#pragma unroll
        for (int k2 = 0; k2 < 2; ++k2) {
            u32x4 w;
#pragma unroll
            for (int e = 0; e < 4; ++e) w[e] = pack2(s[kb][8 * k2 + 2 * e], s[kb][8 * k2 + 2 * e + 1]);
            pf[kb][k2] = __builtin_bit_cast(bf16x8, w);
        }
#pragma unroll
    for (int db = 0; db < 2; ++db)
#pragma unroll
        for (int kb = 0; kb < 2; ++kb)
#pragma unroll
            for (int k2 = 0; k2 < 2; ++k2) {
                const u16* alo = vbase + (kb * 32 + 16 * k2) * 72 + db * 32;
                v4s lo = __builtin_amdgcn_ds_read_tr16_b64_v4i16((lds_v4s_ptr)alo);
                v4s hi = __builtin_amdgcn_ds_read_tr16_b64_v4i16((lds_v4s_ptr)(alo + 8 * 72));
                bf16x8 A = __builtin_shufflevector(lo, hi, 0, 1, 2, 3, 4, 5, 6, 7);
                st.o[db] = MFMA32(A, pf[kb][k2], st.o[db]);
            }
}
DI void attn_wave_item(KP p, int layer, int kind, int blk, int h, char* smem) {
    const int lane = TIDX() & 63, wid = TIDX() >> 6, c = lane & 31, hh = lane >> 5;
    u16* Ks = (u16*)(smem + wid * 19456);
    u16* Vs = Ks + 64 * 72;
    float* rpbs = (float*)(smem + wid * 19456 + 18432);
    const bool isna = (kind == 1 || kind == 3);
    const int q0 = ((kind >= 2) ? NLAT : 0) + blk * 32;
    const int kvh = isna ? h : (h >> 2);
    const int colQ1 = isna ? C_QN + h * 64 : col_qw(h, 0), colQ2 = isna ? colQ1 + 32 : col_qw(h, 1);
    const int colK1 = isna ? C_KN + kvh * 64 : col_kw(kvh, 0), colK2 = isna ? colK1 + 32 : col_kw(kvh, 1);
    const int colV = isna ? C_VN + kvh * 64 : col_vw(kvh);
    FA st;
    {
        const u16* qrow = P_px(p) + (long)(q0 + c) * INC;
#pragma unroll
        for (int ks = 0; ks < 4; ++ks) st.qf[ks] = *(const bf16x8*)(qrow + (ks < 2 ? colQ1 + ks * 16 : colQ2 + (ks - 2) * 16) + hh * 8);
#pragma unroll
        for (int db = 0; db < 2; ++db)
#pragma unroll
            for (int r = 0; r < 16; ++r) st.o[db][r] = 0.f;
        if (isna) { st.m = -1e30f; st.l = 0.f; } else { st.m = p->sink[layer * 8 + h] * LOG2E; st.l = hh == 0 ? 1.f : 0.f; }
    }
    if (kind == 0) {
        const int t0 = (q0 >> 6) - 2;
        for (int i = 0; i < 5; ++i) {
            int start = (t0 + i) * 64;
            if (start < 0 || start >= NLAT) continue;
            fa_stage(Ks, Vs, P_px(p), start, colK1, colK2, colV);
            if (i == 0 || i == 4) fa_tile<1>(st, Ks, Vs, start - q0, nullptr);
            else fa_tile<0>(st, Ks, Vs, 0, nullptr);
        }
    } else if (kind == 1) {
        const int r = blk >> 1;
        int sr = r - 4; sr = sr < 0 ? 0 : (sr > 248 ? 248 : sr);
        const float* rp = p->rpb + ((long)layer * 8 + h) * 465 + (sr - r + 7) * 31;
        for (int i = lane; i < 248; i += 64) rpbs[i] = rp[i];
        for (int i = 0; i < 8; ++i) {
            fa_stage(Ks, Vs, P_px(p), (sr + i) * 64, colK1, colK2, colV);
            fa_tile<2>(st, Ks, Vs, (blk & 1) * 32, rpbs + i * 31);
        }
    }
    for (int i = 0; i < 4; ++i) {
        fa_stage(Ks, Vs, P_px(p), NLAT + i * 64, colK1, colK2, colV);
        fa_tile<0>(st, Ks, Vs, 0, nullptr);
    }
    u16* y = isna ? P_yc(p) : P_yb(p);
    {
        float lt = st.l + __shfl_xor(st.l, 32);
        float inv = 1.f / lt;
        u16* orow = y + (long)(q0 + c) * 512 + h * 64;
#pragma unroll
        for (int db = 0; db < 2; ++db)
#pragma unroll
            for (int g = 0; g < 4; ++g) {
                uint2 o;
                o.x = pack2(st.o[db][4 * g] * inv, st.o[db][4 * g + 1] * inv);
                o.y = pack2(st.o[db][4 * g + 2] * inv, st.o[db][4 * g + 3] * inv);
                *(uint2*)(orow + db * 32 + 8 * g + 4 * hh) = o;
            }
    }
}

DI void ret_gammas(KP p, int layer, int h, float& lgf2, float& lgb2) {
    float xf = p->decay[layer * 8 + h], xb = p->decay[layer * 8 + 4 + h];
    lgf2 = -log1pf(expf(-xf)) * 1.4426950408889634f;
    lgb2 = -log1pf(expf(-xb)) * 1.4426950408889634f;
}
DI void phC_state_item(KP p, int layer, int c, int h, int eh, char* smem) {
    const int tid = TIDX(), lane = tid & 63, wid = tid >> 6, wr = wid >> 1, wc = wid & 1, fr = lane & 15, fq = lane >> 4;
    u16* Av = (u16*)smem;
    u16* Bf = Av + 64 * 72;
    u16* Bb = Bf + 128 * 72;
    float lgf2, lgb2; ret_gammas(p, layer, h, lgf2, lgb2);
    f32x4 accF[2][4], accB[2][4]; zero_acc<2>(accF); zero_acc<2>(accB);
    const u16* base = P_px(p) + (long)c * 128 * INC;
#pragma unroll 1
    for (int jh = 0; jh < 2; ++jh) {
        const int j = jh * 64 + (tid & 63);
        const float zf = exp2f((float)(127 - j) * lgf2), zb = exp2f((float)j * lgb2);
        __syncthreads();
        stage_t64<false, 64>(Av, 72, base + (long)jh * 64 * INC + C_VR + h * 128 + eh * 64, INC, 1.f);
#pragma unroll
        for (int x = 0; x < 2; ++x) {
            stage_t64<true, 64>(Bf + x * 64 * 72, 72, base + (long)jh * 64 * INC + col_kr(h, x), INC, zf);
            stage_t64<true, 64>(Bb + x * 64 * 72, 72, base + (long)jh * 64 * INC + col_kr(h, x), INC, zb);
        }
        __syncthreads();
        mma_lds64<2>(accF, Av, 72, Bf, 72);
        mma_lds64<2>(accB, Av, 72, Bb, 72);
    }
    float* Sf = P_S(p) + ((long)(c * 4 + h) * 2 + 0) * 16384;
    float* Sb = Sf + 16384;
#pragma unroll
    for (int m = 0; m < 2; ++m)
#pragma unroll
        for (int n = 0; n < 4; ++n)
#pragma unroll
            for (int j = 0; j < 4; ++j) {
                int e = eh * 64 + wr * 32 + m * 16 + fq * 4 + j, d = wc * 64 + n * 16 + fr;
                Sf[e * 128 + d] = accF[m][n][j];
                Sb[e * 128 + d] = accB[m][n][j];
            }
}

DI void phD_item(KP p, int layer, int item) {
    const int h = item >> 7, dir = (item >> 6) & 1, pos = (item & 63) * 256 + TIDX();
    float lgf2, lgb2; ret_gammas(p, layer, h, lgf2, lgb2);
    const float decay = exp2f(128.f * (dir == 0 ? lgf2 : lgb2));
    float r = 0.f;
    const long hs = (long)(h * 2 + dir) * 16384 + pos;
    auto chunk_at = [&](int i) -> int {
        if (dir == 0) return i < 2 ? 128 + i : i - 2;
        return i < 2 ? 129 - i : 129 - i;
    };
    for (int i0 = 0; i0 < NCHUNK; i0 += 13) {
        float s[13];
#pragma unroll
        for (int u = 0; u < 13; ++u) s[u] = P_S(p)[(long)chunk_at(i0 + u) * 8 * 16384 + hs];
#pragma unroll
        for (int u = 0; u < 13; ++u) {
            P_R(p)[(long)chunk_at(i0 + u) * 8 * 16384 + hs] = f2bf(r);
            r = decay * r + s[u];
        }
    }
}

DI void phE_item(KP p, int layer, int c, int h, int ih, char* smem) {
    const int tid = TIDX(), lane = tid & 63, wid = tid >> 6, wr = wid >> 1, wc = wid & 1, fr = lane & 15, fq = lane >> 4;
    u16* R0 = (u16*)smem;
    u16* R1 = R0 + 64 * 72;
    u16* R2 = R1 + 128 * 72;
    u16* P = (u16*)smem;
    float* red = (float*)(smem + (64 + 128 + 128) * 72 * 2);
    float lgf2, lgb2; ret_gammas(p, layer, h, lgf2, lgb2);
    const u16* base = P_px(p) + (long)c * 128 * INC;
    const u16* qbase = base + (long)ih * 64 * INC;
    const u16* Rf = P_R(p) + ((long)(c * 4 + h) * 2 + 0) * 16384;
    const u16* Rb = Rf + 16384;
    f32x4 Y[2][4], T[2][4];
    zero_acc<2>(Y); zero_acc<2>(T);
#pragma unroll 1
    for (int dh = 0; dh < 2; ++dh) {
        __syncthreads();
        stage_n64<64>(R0, 72, qbase + col_qr(h, dh), INC);
        stage_n64<128>(R1, 72, Rf + dh * 64, 128);
        stage_n64<128>(R2, 72, Rb + dh * 64, 128);
        __syncthreads();
        mma_lds64<2>(Y, R0, 72, R1, 72);
        mma_lds64<2>(T, R0, 72, R2, 72);
    }
#pragma unroll
    for (int m = 0; m < 2; ++m)
#pragma unroll
        for (int j = 0; j < 4; ++j) {
            int i = ih * 64 + wr * 32 + m * 16 + fq * 4 + j;
            float xf = exp2f((float)(i + 1) * lgf2), xb = exp2f((float)(128 - i) * lgb2);
#pragma unroll
            for (int n = 0; n < 4; ++n) Y[m][n][j] = xf * Y[m][n][j] + xb * T[m][n][j];
        }
    zero_acc<2>(T);
#pragma unroll 1
    for (int dh = 0; dh < 2; ++dh) {
        __syncthreads();
        stage_n64<64>(R0, 72, qbase + col_qr(h, dh), INC);
        stage_n64<128>(R1, 72, base + col_kr(h, dh), INC);
        __syncthreads();
        mma_lds64<2>(T, R0, 72, R1, 72);
    }
    __syncthreads();
#pragma unroll
    for (int m = 0; m < 2; ++m)
#pragma unroll
        for (int n = 0; n < 4; ++n)
#pragma unroll
            for (int j = 0; j < 4; ++j) {
                int il = wr * 32 + m * 16 + fq * 4 + j, i = ih * 64 + il, jj = wc * 64 + n * 16 + fr;
                float dm = (i >= jj) ? exp2f((float)(i - jj) * lgf2) : exp2f((float)(jj - i) * lgb2);
                P[il * 136 + jj] = f2bf(T[m][n][j] * dm);
            }
#pragma unroll 1
    for (int jh = 0; jh < 2; ++jh) {
        __syncthreads();
        stage_t64<false, 128>(R2, 72, base + (long)jh * 64 * INC + C_VR + h * 128, INC, 1.f);
        __syncthreads();
        mma_lds64<2>(Y, P + jh * 64, 136, R2, 72);
    }
    float mu[2][4], rs[2][4];
#pragma unroll
    for (int m = 0; m < 2; ++m)
#pragma unroll
        for (int j = 0; j < 4; ++j) {
            float s = Y[m][0][j] + Y[m][1][j] + Y[m][2][j] + Y[m][3][j];
            s += __shfl_xor(s, 1); s += __shfl_xor(s, 2); s += __shfl_xor(s, 4); s += __shfl_xor(s, 8);
            if (fr == 0) red[(wr * 32 + m * 16 + fq * 4 + j) * 2 + wc] = s;
        }
    __syncthreads();
#pragma unroll
    for (int m = 0; m < 2; ++m)
#pragma unroll
        for (int j = 0; j < 4; ++j) { int il = wr * 32 + m * 16 + fq * 4 + j; mu[m][j] = (red[il * 2] + red[il * 2 + 1]) * (1.f / 128.f); }
    __syncthreads();
#pragma unroll
    for (int m = 0; m < 2; ++m)
#pragma unroll
        for (int j = 0; j < 4; ++j) {
            float s = 0.f;
#pragma unroll
            for (int n = 0; n < 4; ++n) { float d = Y[m][n][j] - mu[m][j]; s += d * d; }
            s += __shfl_xor(s, 1); s += __shfl_xor(s, 2); s += __shfl_xor(s, 4); s += __shfl_xor(s, 8);
            if (fr == 0) red[(wr * 32 + m * 16 + fq * 4 + j) * 2 + wc] = s;
        }
    __syncthreads();
#pragma unroll
    for (int m = 0; m < 2; ++m)
#pragma unroll
        for (int j = 0; j < 4; ++j) { int il = wr * 32 + m * 16 + fq * 4 + j; rs[m][j] = rsqrtf((red[il * 2] + red[il * 2 + 1]) * (1.f / 128.f) + 1e-6f); }
    const float* gn = p->ret_gn + layer * 512 + h * 128;
#pragma unroll
    for (int m = 0; m < 2; ++m)
#pragma unroll
        for (int n = 0; n < 4; ++n)
#pragma unroll
            for (int j = 0; j < 4; ++j) {
                int i = ih * 64 + wr * 32 + m * 16 + fq * 4 + j, e = wc * 64 + n * 16 + fr;
                long row = (long)c * 128 + i;
                float g = bf2f(P_px(p)[row * INC + C_GR + h * 128 + e]);
                float o = (Y[m][n][j] - mu[m][j]) * rs[m][j] * gn[e] * siluf_(g);
                P_ya(p)[row * 512 + h * 128 + e] = f2bf(o);
            }
    __syncthreads();
}

DI void phF_tile(KP p, int mt, int nt, char* smem) {
    const int tid = TIDX(), lane = tid & 63, wid = tid >> 6, wr = wid >> 1, wc = wid & 1, fr = lane & 15, fq = lane >> 4;
    const int r0 = tid >> 2, ko = (tid & 3) * 8;
    float* macc = P_maccx(p) - (long)NLAT * DM;
#pragma unroll 1
    for (int b = 0; b < 3; ++b) {
        const u16* y = (b == 0 ? P_ya(p) : b == 1 ? P_yb(p) : P_yc(p));
        const u16* w = (b == 0 ? P_wt_ret(p) : b == 1 ? P_wt_win(p) : P_wt_na(p));
        f32x4 acc[4][4]; zero_acc<4>(acc);
        const u16* a0 = y + (long)(mt * 128 + r0) * 512 + ko;
        const u16* b0 = w + (long)(nt * 128 + r0) * 512 + ko;
        gemm_core<16>(acc, a0, a0 + 64 * 512, b0, b0 + 64 * 512, smem);
        int zero = 0; asm volatile("" : "+v"(zero));
#pragma unroll
        for (int m = 0; m < 4; ++m)
#pragma unroll
            for (int n = 0; n < 4; ++n)
#pragma unroll
                for (int j = 0; j < 4; ++j) {
                    int row = mt * 128 + wr * 64 + m * 16 + fq * 4 + j + zero, col = nt * 128 + wc * 64 + n * 16 + fr;
                    float g = bf2f(P_px(p)[(long)row * INC + C_GATE + b * 1024 + col]);
                    float v = acc[m][n][j] * sigmoidf_(g);
                    float* mp = macc + (long)row * DM + col;
                    if (b == 0) *mp = v;
                    else if (b == 1) *mp += v;
                    else P_hx(p)[(long)row * DM + col] = f2bf(*mp + v);
                }
    }
}
DI void phG_tile(KP p, int layer, int mt, int nt, char* smem) {
    const int tid = TIDX(), lane = tid & 63, wid = tid >> 6, wr = wid >> 1, wc = wid & 1, fr = lane & 15, fq = lane >> 4;
    f32x4 acc[4][4]; zero_acc<4>(acc);
    const int r0 = tid >> 2, ko = (tid & 3) * 8;
    const u16* a0 = P_hx(p) + (long)(mt * 128 + r0) * DM + ko;
    const u16* b0 = P_wt_out(p) + (long)(nt * 128 + r0) * DM + ko;
    gemm_core<32>(acc, a0, a0 + 64 * DM, b0, b0 + 64 * DM, smem);
    const bool lat = mt < 128;
    const float* md = P_mod(p) + (layer * 2 + (lat ? 0 : 1)) * 6144 + 2 * 1024;
#pragma unroll
    for (int m = 0; m < 4; ++m)
#pragma unroll
        for (int n = 0; n < 4; ++n)
#pragma unroll
            for (int j = 0; j < 4; ++j) {
                int row = mt * 128 + wr * 64 + m * 16 + fq * 4 + j, col = nt * 128 + wc * 64 + n * 16 + fr;
                const float* xin = resid_row(p, layer, row);
                float* xo = lat ? p->out + (long)row * DM : P_ctxres(p) + (long)(row - NLAT) * DM;
                xo[col] = xin[col] + md[col] * acc[m][n][j];
            }
}


#define LAS __attribute__((address_space(3)))
namespace g8 {
constexpr int BM = 256, BK = 64, HALF = 128, HTB = HALF * BK * 2, STAGE_BYTES = 8 * HTB;
DI int lds_byte(int r, int c) { const int st = (r >> 4) * 2 + (c >> 5), rr = r & 15, cc = c & 31, ob = rr * 64 + cc * 2; return st * 1024 + (ob ^ (((ob >> 9) & 1) << 5)); }
DI void stage_rc(int b, int& R, int& C) { const int st = b / 1024, sb = b % 1024, swz = sb ^ (((sb >> 9) & 1) << 5); R = (st >> 1) * 16 + swz / 64; C = (st & 1) * 32 + (swz % 64) / 2; }
DI int perm32(int rho) { const int n = rho >> 4, i = rho & 15; return 8 * (i >> 2) + 4 * n + (i & 3); }
struct Unit { int pm, pn, aux; };
typedef f32x4 Acc[2][2][4][2];

template <class P>
DI void gemm_phase(LAS unsigned char* lds, const P& prob) {
    const int tid = TID512(), wid = __builtin_amdgcn_readfirstlane(tid >> 6), lane = tid & 63, wr = wid >> 2, wc = wid & 3, fr = lane & 15, fq = lane >> 4;
    constexpr int K = P::K, nt = K / BK;
    int Rr[2], Cc[2];
    unsigned voffA[2], voffB[2];
#pragma unroll
    for (int i = 0; i < 2; ++i) { stage_rc(tid * 16 + i * 8192, Rr[i], Cc[i]); const int Rb = P::PERM ? ((Rr[i] & ~31) + perm32(Rr[i] & 31)) : Rr[i];
        voffA[i] = (unsigned)(Rr[i] * K + Cc[i]) * 2u; voffB[i] = (unsigned)(Rb * K + Cc[i]) * 2u; }
    constexpr size_t kstep = (size_t)(BK * 2);
    constexpr size_t hstep = (size_t)HALF * K * 2;
    const unsigned ldsw = (unsigned)wid * 1024u;
    const int aoff = lds_byte(wr * 64 + fr, fq * 8), boff = lds_byte(wc * 32 + fr, fq * 8);
    unsigned vaC[2][2], vaN[2][2];
#define G8_SA(b, h) (((b) * 2 + (h)) * HTB)
#define G8_SB(b, h) ((4 + (b) * 2 + (h)) * HTB)
#define G8_STAGEA(bufoff, base, VA, h, kt) do { _Pragma("unroll") for (int _i = 0; _i < 2; ++_i) \
        __builtin_amdgcn_global_load_lds((const unsigned*)((base) + (P::GATHER ? (size_t)(VA)[h][_i] : (size_t)voffA[_i] + (size_t)(h) * hstep) + (size_t)(kt) * kstep), (LAS unsigned*)(lds + (bufoff) + ldsw + _i * 8192), 16, 0, 0); } while (0)
#define G8_STAGEB(bufoff, base, h, kt) do { _Pragma("unroll") for (int _i = 0; _i < 2; ++_i) \
        __builtin_amdgcn_global_load_lds((const unsigned*)((base) + (size_t)(h) * hstep + voffB[_i] + (size_t)(kt) * kstep), (LAS unsigned*)(lds + (bufoff) + ldsw + _i * 8192), 16, 0, 0); } while (0)
#define G8_LDA(dst, b, h) do { _Pragma("unroll") for (int m = 0; m < 4; ++m) _Pragma("unroll") for (int k = 0; k < 2; ++k) dst[m][k] = *(const LAS bf16x8*)(lds + G8_SA(b, h) + aoff + m * 2048 + k * 1024); } while (0)
#define G8_LDB(dst, b, h) do { _Pragma("unroll") for (int n = 0; n < 2; ++n) _Pragma("unroll") for (int k = 0; k < 2; ++k) dst[n][k] = *(const LAS bf16x8*)(lds + G8_SB(b, h) + boff + n * 2048 + k * 1024); } while (0)
#define G8_MMA(ai, bj, At, Bt) do { __builtin_amdgcn_s_setprio(1); _Pragma("unroll") for (int m = 0; m < 4; ++m) _Pragma("unroll") for (int n = 0; n < 2; ++n) _Pragma("unroll") for (int k = 0; k < 2; ++k) \
        acc[ai][bj][m][n] = __builtin_amdgcn_mfma_f32_16x16x32_bf16(Bt[n][k], At[m][k], acc[ai][bj][m][n], 0, 0, 0); __builtin_amdgcn_s_setprio(0); } while (0)
#define G8_WAIT_V(n) asm volatile("s_waitcnt vmcnt(" #n ")" ::: "memory")
#define G8_WAIT_L(n) asm volatile("s_waitcnt lgkmcnt(" #n ")" ::: "memory")
#define G8_BAR __builtin_amdgcn_s_barrier()
#define G8_SCHED __builtin_amdgcn_sched_barrier(0)
    Unit cur, nxt; int ui = 0;
    __syncthreads();
    if (!prob.next(0, cur)) return;
    if (P::GATHER) prob.gather(cur, Rr, Cc, vaC);
    const char* cA = prob.a_base(cur); const char* cB = prob.b_base(cur);
    Acc acc;
#pragma unroll
    for (int a = 0; a < 2; ++a)
#pragma unroll
        for (int b = 0; b < 2; ++b)
#pragma unroll
            for (int m = 0; m < 4; ++m)
#pragma unroll
                for (int n = 0; n < 2; ++n) acc[a][b][m][n] = (f32x4){0.f, 0.f, 0.f, 0.f};
    bf16x8 At[4][2], B0[2][2], B1[2][2];
    G8_STAGEB(G8_SB(0, 0), cB, 0, 0); G8_STAGEA(G8_SA(0, 0), cA, vaC, 0, 0); G8_STAGEB(G8_SB(0, 1), cB, 1, 0); G8_STAGEA(G8_SA(0, 1), cA, vaC, 1, 0);
    if (wr == 1) G8_BAR;
    G8_WAIT_V(4); G8_BAR;
    G8_STAGEB(G8_SB(1, 0), cB, 0, 1); G8_STAGEA(G8_SA(1, 0), cA, vaC, 0, 1); G8_STAGEB(G8_SB(1, 1), cB, 1, 1);
    G8_WAIT_V(6); G8_BAR;
    for (;;) {
        const bool has_next = prob.next(ui + 1, nxt);
        if (!has_next) nxt = cur;
        if (P::GATHER) {
            if (has_next) prob.gather(nxt, Rr, Cc, vaN);
            else {
#pragma unroll
                for (int h = 0; h < 2; ++h) { vaN[h][0] = vaC[h][0]; vaN[h][1] = vaC[h][1]; }
            }
        }
        const char* nA = prob.a_base(nxt); const char* nB = prob.b_base(nxt);
#pragma unroll 1
        for (int t = 0; t < nt; t += 2) {
            const bool last = (t == nt - 2);
            const char* a2 = last ? nA : cA; const char* b2 = last ? nB : cB; const int k2 = last ? 0 : t + 2;
            unsigned va2[2][2];
#pragma unroll
            for (int h = 0; h < 2; ++h) { va2[h][0] = last ? vaN[h][0] : vaC[h][0]; va2[h][1] = last ? vaN[h][1] : vaC[h][1]; }
            G8_LDB(B0, 0, 0); G8_SCHED; G8_LDA(At, 0, 0); G8_STAGEA(G8_SA(1, 1), cA, vaC, 1, t + 1);
            G8_WAIT_L(8); G8_BAR; G8_WAIT_L(0); G8_MMA(0, 0, At, B0); G8_BAR; G8_SCHED;
            G8_LDB(B1, 0, 1); G8_STAGEB(G8_SB(0, 0), b2, 0, k2);
            G8_BAR; G8_WAIT_L(0); G8_MMA(0, 1, At, B1); G8_BAR;
            G8_LDA(At, 0, 1); G8_STAGEA(G8_SA(0, 0), a2, va2, 0, k2);
            G8_BAR; G8_WAIT_L(0); G8_MMA(1, 0, At, B0); G8_BAR; G8_SCHED;
            G8_STAGEB(G8_SB(0, 1), b2, 1, k2);
            G8_WAIT_V(6); G8_BAR; G8_MMA(1, 1, At, B1); G8_BAR;
            G8_LDB(B0, 1, 0); G8_SCHED; G8_LDA(At, 1, 0); G8_STAGEA(G8_SA(0, 1), a2, va2, 1, k2);
            G8_WAIT_L(8); G8_BAR; G8_WAIT_L(0); G8_MMA(0, 0, At, B0); G8_BAR; G8_SCHED;
            G8_LDB(B1, 1, 1); G8_STAGEB(G8_SB(1, 0), b2, 0, k2 + 1);
            G8_BAR; G8_WAIT_L(0); G8_MMA(0, 1, At, B1); G8_BAR;
            G8_LDA(At, 1, 1); G8_STAGEA(G8_SA(1, 0), a2, va2, 0, k2 + 1);
            G8_BAR; G8_WAIT_L(0); G8_MMA(1, 0, At, B0); G8_BAR; G8_SCHED;
            G8_STAGEB(G8_SB(1, 1), b2, 1, k2 + 1);
            G8_WAIT_V(6); G8_BAR; G8_MMA(1, 1, At, B1); G8_BAR;
        }
        { const int l2 = TID512() & 63; prob.epi(acc, cur, wr, wc, l2 & 15, l2 >> 4); }
        if (!has_next) break;
#pragma unroll
        for (int a = 0; a < 2; ++a)
#pragma unroll
            for (int b = 0; b < 2; ++b)
#pragma unroll
                for (int m = 0; m < 4; ++m)
#pragma unroll
                    for (int n = 0; n < 2; ++n) acc[a][b][m][n] = (f32x4){0.f, 0.f, 0.f, 0.f};
        cur = nxt; cA = nA; cB = nB; ++ui;
        if (P::GATHER) {
#pragma unroll
            for (int h = 0; h < 2; ++h) { vaC[h][0] = vaN[h][0]; vaC[h][1] = vaN[h][1]; }
        }
    }
    G8_WAIT_V(0);
    if (wr == 0) G8_BAR;
    G8_BAR;
#undef G8_SA
#undef G8_SB
#undef G8_STAGEA
#undef G8_STAGEB
#undef G8_LDA
#undef G8_LDB
#undef G8_MMA
#undef G8_WAIT_V
#undef G8_WAIT_L
#undef G8_BAR
#undef G8_SCHED
}
}

struct ProbG {
    static constexpr int K = 1024; static constexpr bool PERM = false, GATHER = false;
    KP p; int layer;
    DI bool next(int i, g8::Unit& u) const {
        const int id = i * (int)gridDim.x + BIDX();
        if (id >= 256) return false;
        u.pm = id >> 2; u.pn = id & 3; u.aux = 0;
        return true;
    }
    DI const char* a_base(const g8::Unit& u) const { return (const char*)(P_hx(p) + (long)u.pm * 256 * DM); }
    DI const char* b_base(const g8::Unit& u) const { return (const char*)(P_wt_out(p) + (long)u.pn * 256 * DM); }
    DI void gather(const g8::Unit&, const int (&)[2], const int (&)[2], unsigned (&)[2][2]) const {}
    DI void epi(g8::Acc& acc, const g8::Unit& u, int wr, int wc, int fr, int fq) const {
        const float* xin = layer == 0 ? p->x : p->out;
        const float* md = P_mod(p) + (layer * 2) * 6144 + 2 * 1024;
#pragma unroll
        for (int bj = 0; bj < 2; ++bj)
#pragma unroll
            for (int n = 0; n < 2; ++n) {
                const int col = u.pn * 256 + bj * 128 + wc * 32 + n * 16 + fq * 4;
                const f32x4 mv = *(const f32x4*)(md + col);
#pragma unroll
                for (int ai = 0; ai < 2; ++ai)
#pragma unroll
                    for (int m = 0; m < 4; ++m) {
                        const long row = (long)u.pm * 256 + ai * 128 + wr * 64 + m * 16 + fr;
                        const f32x4 xv = *(const f32x4*)(xin + row * DM + col);
                        *(f32x4*)(p->out + row * DM + col) = xv + mv * acc[ai][bj][m][n];
                    }
            }
    }
};


struct ProbB {
    static constexpr int K = 1024; static constexpr bool PERM = true, GATHER = false;
    KP p;
    DI bool next(int i, g8::Unit& u) const {
        constexpr int nM = 65, nN = 29, nwg = nM * nN, NX = 8, WGM = 8;
        const long L = (long)i * (int)gridDim.x + BIDX(); if (L >= nwg) return false;
        int wgid = (int)L; { const int q = nwg / NX, r = nwg % NX, xcd = wgid % NX, off = wgid / NX; wgid = (xcd < r ? xcd * (q + 1) : r * (q + 1) + (xcd - r) * q) + off; }
        const int nig = WGM * nN, gid = wgid / nig, fm = gid * WGM, gsz = (nM - fm) < WGM ? (nM - fm) : WGM;
        u.pm = fm + ((wgid % nig) % gsz); u.pn = (wgid % nig) / gsz; u.aux = 0; return true;
    }
    DI const char* a_base(const g8::Unit& u) const { return (const char*)(P_hx(p) + (long)u.pm * 256 * DM); }
    DI const char* b_base(const g8::Unit& u) const { return (const char*)(P_wt_in(p) + (long)u.pn * 256 * DM); }
    DI void gather(const g8::Unit&, const int (&)[2], const int (&)[2], unsigned (&)[2][2]) const {}
    DI void epi(g8::Acc& acc, const g8::Unit& u, int wr, int wc, int fr, int fq) const {
        const int pn = u.pn;
        const bool lat = u.pm < 64;
        const int rk = !lat ? 0 : (pn < 4) ? 1 : (pn == 8 || pn == 9 || (pn == 10 && wc < 2)) ? 2 : 0;
        const float mul = (pn == 2 || pn == 3) ? 0.08838834764831845f : (pn == 8 || pn == 9 || pn == 11 || pn == 12) ? 0.125f : 1.f;
#pragma unroll
        for (int ai = 0; ai < 2; ++ai)
#pragma unroll
            for (int m = 0; m < 4; ++m) {
                const int row = u.pm * 256 + ai * 128 + wr * 64 + m * 16 + fr;
                if (rk != 0) {
                    const float2* tab;
                    if (rk == 1) tab = P_rope128(p) + ((wc & 1) ? (row & 63) : (row >> 6)) * 32 + fq * 8;
                    else tab = P_rope64(p) + ((fq >= 2) ? (row & 63) : (row >> 6)) * 16 + (fq & 1) * 8;
#pragma unroll
                    for (int n = 0; n < 2; ++n) {
                        const f32x4 c01 = *(const f32x4*)(tab + n * 4), c23 = *(const f32x4*)(tab + n * 4 + 2);
                        const float cs_[4] = {c01[0], c01[2], c23[0], c23[2]}, sn_[4] = {c01[1], c01[3], c23[1], c23[3]};
#pragma unroll
                        for (int e = 0; e < 4; ++e) {
                            const float x1 = acc[ai][0][m][n][e], x2 = acc[ai][1][m][n][e];
                            acc[ai][0][m][n][e] = x1 * cs_[e] - x2 * sn_[e];
                            acc[ai][1][m][n][e] = x1 * sn_[e] + x2 * cs_[e];
                        }
                    }
                }
                u16* orow = P_px(p) + (long)row * INC + pn * 256 + wc * 32 + fq * 8;
#pragma unroll
                for (int bj = 0; bj < 2; ++bj) {
                    u32x4 o;
#pragma unroll
                    for (int n = 0; n < 2; ++n)
#pragma unroll
                        for (int e = 0; e < 2; ++e) o[2 * n + e] = pack2(acc[ai][bj][m][n][2 * e] * mul, acc[ai][bj][m][n][2 * e + 1] * mul);
                    *(u32x4*)(orow + bj * 128) = o;
                }
            }
    }
};
struct ProbF {
    static constexpr int K = 512; static constexpr bool PERM = true, GATHER = false;
    KP p;
    DI bool next(int i, g8::Unit& u) const {
        const int tile = (i / 3) * (int)gridDim.x + BIDX();
        if (tile >= 256) return false;
        u.pm = tile >> 2; u.pn = tile & 3; u.aux = i % 3;
        return true;
    }
    DI const char* a_base(const g8::Unit& u) const { const u16* y = u.aux == 0 ? P_ya(p) : u.aux == 1 ? P_yb(p) : P_yc(p); return (const char*)(y + (long)u.pm * 256 * 512); }
    DI const char* b_base(const g8::Unit& u) const { const u16* w = u.aux == 0 ? P_wt_ret(p) : u.aux == 1 ? P_wt_win(p) : P_wt_na(p); return (const char*)(w + (long)u.pn * 256 * 512); }
    DI void gather(const g8::Unit&, const int (&)[2], const int (&)[2], unsigned (&)[2][2]) const {}
    DI void epi(g8::Acc& acc, const g8::Unit& u, int wr, int wc, int fr, int fq) const {
        const int b = u.aux;
        u16* z = P_z(p) + (long)b * NLAT * DM;
        const long row0 = (long)u.pm * 256 + wr * 64 + fr;
        const int col0 = u.pn * 256 + wc * 32 + fq * 8;
#pragma unroll
        for (int ai = 0; ai < 2; ++ai)
#pragma unroll
            for (int m = 0; m < 4; ++m)
#pragma unroll
                for (int bj = 0; bj < 2; ++bj) {
                    u32x4 o;
#pragma unroll
                    for (int n = 0; n < 2; ++n)
#pragma unroll
                        for (int e = 0; e < 2; ++e) o[2 * n + e] = pack2(acc[ai][bj][m][n][2 * e], acc[ai][bj][m][n][2 * e + 1]);
                    *(u32x4*)(z + (row0 + ai * 128 + m * 16) * DM + col0 + bj * 128) = o;
                }
        if (b != 2) return;
        asm volatile("" ::: "memory");
        const u16* zb = P_z(p);
        const u16* gp = P_px(p) + C_GATE;
#pragma unroll 4
        for (int g = 0; g < 16; ++g) {
            const int ai = g >> 3, m = (g >> 1) & 3, bj = g & 1;
            const long row = row0 + ai * 128 + m * 16; const int col = col0 + bj * 128;
            u32x4 zv[3], gv[3];
#pragma unroll
            for (int q = 0; q < 3; ++q) { zv[q] = *(const u32x4*)(zb + ((long)q * NLAT + row) * DM + col); gv[q] = *(const u32x4*)(gp + row * INC + q * 1024 + col); }
            u32x4 o;
#pragma unroll
            for (int e = 0; e < 4; ++e) {
                float lo = 0.f, hi = 0.f;
#pragma unroll
                for (int q = 0; q < 3; ++q) { lo += bflo(zv[q][e]) * sigmoidf_(bflo(gv[q][e])); hi += bfhi(zv[q][e]) * sigmoidf_(bfhi(gv[q][e])); }
                o[e] = pack2(lo, hi);
            }
            *(u32x4*)(P_hx(p) + row * DM + col) = o;
        }
    }
};
struct ProbJ {
    static constexpr int K = 1024; static constexpr bool PERM = true, GATHER = true;
    KP p;
    DI bool next(int i, g8::Unit& u) const {
        const int id = i * (int)gridDim.x + BIDX();
        if (id >= 1024) return false;
        u.aux = id >> 6; u.pm = (id >> 3) & 7; u.pn = id & 7;
        return true;
    }
    DI const char* a_base(const g8::Unit&) const { return (const char*)P_hx(p); }
    DI const char* b_base(const g8::Unit& u) const { return (const char*)(P_wt_gu(p) + ((long)u.aux * 2048 + u.pn * 256) * DM); }
    DI void gather(const g8::Unit& u, const int (&R)[2], const int (&C)[2], unsigned (&va)[2][2]) const {
        const int* si = P_sel_idx(p) + u.aux * 2048 + u.pm * 256;
#pragma unroll
        for (int h = 0; h < 2; ++h)
#pragma unroll
            for (int j = 0; j < 2; ++j) va[h][j] = (unsigned)(si[h * 128 + R[j]] * DM + C[j]) * 2u;
    }
    DI void epi(g8::Acc& acc, const g8::Unit& u, int wr, int wc, int fr, int fq) const {
        u16* hb = P_hid(p) + (long)u.aux * 2048 * EH;
#pragma unroll
        for (int ai = 0; ai < 2; ++ai)
#pragma unroll
            for (int m = 0; m < 4; ++m) {
                const int slot = u.pm * 256 + ai * 128 + wr * 64 + m * 16 + fr;
                const int f = u.pn * 128 + wc * 32 + fq * 8;
                u32x4 o;
#pragma unroll
                for (int n = 0; n < 2; ++n)
#pragma unroll
                    for (int e = 0; e < 2; ++e)
                        o[2 * n + e] = pack2(siluf_(acc[ai][0][m][n][2 * e]) * acc[ai][1][m][n][2 * e], siluf_(acc[ai][0][m][n][2 * e + 1]) * acc[ai][1][m][n][2 * e + 1]);
                *(u32x4*)(hb + (long)slot * EH + f) = o;
            }
    }
};
struct ProbK {
    static constexpr int K = 1024; static constexpr bool PERM = true, GATHER = false;
    KP p; int layer;
    DI bool next(int i, g8::Unit& u) const {
        const int id = i * (int)gridDim.x + BIDX();
        if (id >= 512) return false;
        u.aux = id >> 5; u.pm = (id >> 2) & 7; u.pn = id & 3;
        return true;
    }
    DI const char* a_base(const g8::Unit& u) const { return (const char*)(P_hid(p) + ((long)u.aux * 2048 + u.pm * 256) * EH); }
    DI const char* b_base(const g8::Unit& u) const { return (const char*)(P_wt_dn(p) + ((long)u.aux * 1024 + u.pn * 256) * EH); }
    DI void gather(const g8::Unit&, const int (&)[2], const int (&)[2], unsigned (&)[2][2]) const {}
    DI void epi(g8::Acc& acc, const g8::Unit& u, int wr, int wc, int fr, int fq) const {
        const float* md = P_mod(p) + (layer * 2) * 6144 + 5 * 1024;
        f32x4 mv[2][2];
#pragma unroll
        for (int bj = 0; bj < 2; ++bj)
#pragma unroll
            for (int n = 0; n < 2; ++n) mv[bj][n] = *(const f32x4*)(md + u.pn * 256 + bj * 128 + wc * 32 + fq * 8 + n * 4);
#pragma unroll
        for (int ai = 0; ai < 2; ++ai)
#pragma unroll
            for (int m = 0; m < 4; ++m) {
                const int slot = u.aux * 2048 + u.pm * 256 + ai * 128 + wr * 64 + m * 16 + fr;
                const float g = P_sel_gate(p)[slot];
                u16* yr = P_ye(p) + (long)slot * DM + u.pn * 256 + wc * 32 + fq * 8;
#pragma unroll
                for (int bj = 0; bj < 2; ++bj) {
                    u32x4 o;
#pragma unroll
                    for (int n = 0; n < 2; ++n)
#pragma unroll
                        for (int e = 0; e < 2; ++e)
                            o[2 * n + e] = pack2(acc[ai][bj][m][n][2 * e] * g * mv[bj][n][2 * e], acc[ai][bj][m][n][2 * e + 1] * g * mv[bj][n][2 * e + 1]);
                    *(u32x4*)(yr + bj * 128) = o;
                }
            }
    }
};

DI void phH_item(KP p, int layer, int item, char* smem) {
    const int lane = TIDX() & 63, wid = TIDX() >> 6;
    float* hrow = (float*)smem + wid * 4096;
    const int row0 = item * 16 + wid * 4;
#pragma unroll
    for (int r = 0; r < 4; ++r) norm_row(p, layer, row0 + r, cur_row(p, row0 + r), p->g_ffn + layer * DM, 3, 4, P_hx(p) + (long)(row0 + r) * DM, hrow + r * 1024, nullptr);
    const int e = lane & 15, kp = lane >> 4;
    const float* wr_ = p->w_router + (long)layer * 1024 * 16 + e;
    float lg[4] = {0.f, 0.f, 0.f, 0.f};
#pragma unroll 8
    for (int k = kp * 256; k < kp * 256 + 256; ++k) {
        float w = wr_[k * 16];
#pragma unroll
        for (int r = 0; r < 4; ++r) lg[r] += hrow[r * 1024 + k] * w;
    }
#pragma unroll
    for (int r = 0; r < 4; ++r) {
        float l = lg[r];
        l += __shfl_xor(l, 16); l += __shfl_xor(l, 32);
        float mx = l;
        mx = fmaxf(mx, __shfl_xor(mx, 1)); mx = fmaxf(mx, __shfl_xor(mx, 2)); mx = fmaxf(mx, __shfl_xor(mx, 4)); mx = fmaxf(mx, __shfl_xor(mx, 8));
        float ex = expf(l - mx);
        float sm = ex;
        sm += __shfl_xor(sm, 1); sm += __shfl_xor(sm, 2); sm += __shfl_xor(sm, 4); sm += __shfl_xor(sm, 8);
        float a = ex / sm;
        int row = row0 + r;
        if (lane < 16) {
            if (row < NLAT) P_aff(p)[(long)e * NLAT + row] = a;
            else P_aff(p)[(long)(16 + e) * NLAT + (row - NLAT)] = a;
        }
    }
    __syncthreads();
}

DI int block_excl_scan(int v, int* sh  , int& total) {
    const int lane = TIDX() & 63, wid = TIDX() >> 6;
    int inc = v;
    for (int o = 1; o < 64; o <<= 1) { int t = __shfl_up(inc, o); if (lane >= o) inc += t; }
    __syncthreads();
    if (lane == 63) sh[wid] = inc;
    __syncthreads();
    int base = 0;
    for (int w = 0; w < wid; ++w) base += sh[w];
    total = sh[0] + sh[1] + sh[2] + sh[3];
    return base + inc - v;
}
DI void phI_item(KP p, int job, char* smem) {
    const int tid = TIDX(), lane = tid & 63, wid = tid >> 6;
    const bool lat = job < 16;
    const int n = lat ? NLAT : NCTX, cap = lat ? CAP_LAT : CAP_CTX, rowbase = lat ? 0 : NLAT;
    int* sh = (int*)smem;
    const float* a = P_aff(p) + (long)job * NLAT;
    unsigned keys[64];
    if (lat) {
#pragma unroll
        for (int i = 0; i < 16; ++i) { u32x4 v = *(const u32x4*)(a + tid * 64 + i * 4); keys[4 * i] = v[0]; keys[4 * i + 1] = v[1]; keys[4 * i + 2] = v[2]; keys[4 * i + 3] = v[3]; }
    } else {
#pragma unroll
        for (int i = 0; i < 64; ++i) keys[i] = 0u;
        keys[0] = __float_as_uint(a[tid]);
    }
    __syncthreads();
    auto block_sum = [&](int v, int it) -> int {
        for (int o = 32; o > 0; o >>= 1) v += __shfl_xor(v, o);
        int* slot = sh + (it & 1) * 4;
        if (lane == 0) slot[wid] = v;
        __syncthreads();
        return slot[0] + slot[1] + slot[2] + slot[3];
    };
    unsigned T = 0u;
    int it = 0;
    for (int bit = 29; bit >= 0; --bit, ++it) {
        const unsigned cand = T | (1u << bit);
        int c = 0;
#pragma unroll
        for (int i = 0; i < 64; ++i) c += (keys[i] >= cand);
        if (block_sum(c, it) >= cap) T = cand;
    }
    int cgt = 0, ceq = 0;
#pragma unroll
    for (int i = 0; i < 64; ++i) { cgt += (keys[i] > T); ceq += (keys[i] == T); }
    const int remaining = cap - block_sum(cgt, it);
    __syncthreads();
    int tot;
    int er = block_excl_scan(ceq, sh + 8, tot);
    int csel = 0;
    { int e2 = er;
#pragma unroll
      for (int i = 0; i < 64; ++i) { const unsigned k = keys[i]; if (k > T) ++csel; else if (k == T) { if (e2 < remaining) ++csel; ++e2; } } }
    int slot = block_excl_scan(csel, sh + 8, tot);
    int* ts = P_tslot(p) + (long)job * NLAT;
    const int per = lat ? 64 : 1;
    const int base = tid * per;
#pragma unroll
    for (int i = 0; i < 64; ++i) {
        if (i < per) {
            const unsigned k = keys[i];
            bool sel = false;
            if (k > T) sel = true; else if (k == T) { sel = er < remaining; ++er; }
            if (sel) { P_sel_idx(p)[job * 2048 + slot] = rowbase + base + i; P_sel_gate(p)[job * 2048 + slot] = __uint_as_float(k); ts[base + i] = slot; ++slot; }
            else ts[base + i] = -1;
        }
    }
    __syncthreads();
}

DI void phJ_tile(KP p, int job, int mt, int nt, char* smem) {
    const int tid = TIDX(), lane = tid & 63, wid = tid >> 6, wr = wid >> 1, wc = wid & 1, fr = lane & 15, fq = lane >> 4;
    const int cap = job < 16 ? CAP_LAT : CAP_CTX, e = job & 15;
    f32x4 acc[4][4]; zero_acc<4>(acc);
    const int r0 = tid >> 2, ko = (tid & 3) * 8;
    int s0 = mt * 128 + r0, s1 = s0 + 64;
    s0 = s0 < cap ? s0 : cap - 1; s1 = s1 < cap ? s1 : cap - 1;
    const u16* a0 = P_hx(p) + (long)P_sel_idx(p)[job * 2048 + s0] * DM + ko;
    const u16* a1 = P_hx(p) + (long)P_sel_idx(p)[job * 2048 + s1] * DM + ko;
    const int f_lo = nt * 64 + (r0 & 31), f_hi = f_lo + 32, gu = (r0 >> 5) & 1;
    const u16* b0 = P_wt_gu(p) + ((long)e * 2048 + (f_lo >> 7) * 256 + gu * 128 + (f_lo & 127)) * DM + ko;
    const u16* b1 = P_wt_gu(p) + ((long)e * 2048 + (f_hi >> 7) * 256 + gu * 128 + (f_hi & 127)) * DM + ko;
    gemm_core<32>(acc, a0, a1, b0, b1, smem);
    u16* hb = job < 16 ? P_hid(p) + (long)job * 2048 * EH : P_hidc(p) + (long)(job - 16) * 32 * EH;
#pragma unroll
    for (int m = 0; m < 4; ++m)
#pragma unroll
        for (int n = 0; n < 2; ++n)
#pragma unroll
            for (int j = 0; j < 4; ++j) {
                int slot = mt * 128 + wr * 64 + m * 16 + fq * 4 + j;
                int f = nt * 64 + wc * 32 + n * 16 + fr;
                if (slot < cap) hb[(long)slot * EH + f] = f2bf(siluf_(acc[m][n][j]) * acc[m][n + 2][j]);
            }
}
DI void phK_tile(KP p, int layer, int job, int mt, int nt, char* smem) {
    const int tid = TIDX(), lane = tid & 63, wid = tid >> 6, wr = wid >> 1, wc = wid & 1, fr = lane & 15, fq = lane >> 4;
    const int cap = job < 16 ? CAP_LAT : CAP_CTX, e = job & 15;
    f32x4 acc[4][4]; zero_acc<4>(acc);
    const int r0 = tid >> 2, ko = (tid & 3) * 8;
    int s0 = mt * 128 + r0, s1 = s0 + 64;
    s0 = s0 < cap ? s0 : cap - 1; s1 = s1 < cap ? s1 : cap - 1;
    const u16* hb = job < 16 ? P_hid(p) + (long)job * 2048 * EH : P_hidc(p) + (long)(job - 16) * 32 * EH;
    const u16* a0 = hb + (long)s0 * EH + ko;
    const u16* a1 = hb + (long)s1 * EH + ko;
    const u16* b0 = P_wt_dn(p) + ((long)e * 1024 + nt * 128 + r0) * EH + ko;
    gemm_core<32>(acc, a0, a1, b0, b0 + 64 * EH, smem);
    const float* md = P_mod(p) + (layer * 2 + (job < 16 ? 0 : 1)) * 6144 + 5 * 1024;
    u16* yb_ = job < 16 ? P_ye(p) + (long)job * 2048 * DM : P_yec(p) + (long)(job - 16) * 32 * DM;
#pragma unroll
    for (int m = 0; m < 4; ++m)
#pragma unroll
        for (int j = 0; j < 4; ++j) {
            int slot = mt * 128 + wr * 64 + m * 16 + fq * 4 + j;
            if (slot < cap) {
                float g = P_sel_gate(p)[job * 2048 + slot];
#pragma unroll
                for (int n = 0; n < 4; ++n) {
                    int col = nt * 128 + wc * 64 + n * 16 + fr;
                    yb_[(long)slot * DM + col] = f2bf(acc[m][n][j] * g * md[col]);
                }
            }
        }
}


#define XB_TMO      128
#define XB_XCNT(j)  (256  + 64 * (j))
#define XB_XSUB(j)  (1280 + 64 * (j))
#define XB_XGEN(j)  (2304 + 64 * (j))
#define XB_TOP      3328
#define XB_TOPGEN   3392
#define XCD_BAR_WORDS 3456
#define XB_SPIN_CAP (1u << 18)
DI unsigned xb_ld(unsigned* p)              { return __hip_atomic_load(p, __ATOMIC_RELAXED, __HIP_MEMORY_SCOPE_AGENT); }
DI unsigned xb_add(unsigned* p, unsigned v) { return __hip_atomic_fetch_add(p, v, __ATOMIC_RELAXED, __HIP_MEMORY_SCOPE_AGENT); }
DI unsigned xb_xcc_id() { return (unsigned)__builtin_amdgcn_s_getreg((3 << 11) | 20) & 0xFu; }
#define XB_SPIN(cond, bar) do { unsigned _sp = 0; while (cond) { __builtin_amdgcn_s_sleep(1); \
    if ((++_sp & 255u) == 0u) { if (xb_ld(&(bar)[XB_TMO])) break; if (_sp > XB_SPIN_CAP) { atomicAdd(&(bar)[XB_TMO], 1u); break; } } } } while (0)
struct XcdBarrier { unsigned* bar; unsigned x; volatile LAS unsigned* st; };
DI XcdBarrier xcd_barrier_post(unsigned* bar, volatile LAS unsigned* st) {
    XcdBarrier b; b.bar = bar; b.x = xb_xcc_id(); b.st = st;
    if (threadIdx.x == 0) (void)xb_add(&bar[XB_XCNT(b.x)], 1u);
    return b;
}
DI void xcd_barrier_complete(unsigned* bar, unsigned x, unsigned& nloc, unsigned& nx) {
    const unsigned G = gridDim.x * gridDim.y * gridDim.z;
    unsigned sum, cnt, mine, sp = 0u;
    for (;;) {
        sum = 0u; cnt = 0u; mine = 0u;
#pragma unroll
        for (unsigned j = 0; j < 16; ++j) { const unsigned c = xb_ld(&bar[XB_XCNT(j)]); sum += c; cnt += (c > 0u) ? 1u : 0u; mine = (j == x) ? c : mine; }
        if (sum == G) break;
        __builtin_amdgcn_s_sleep(1);
        if ((++sp & 255u) == 0u) { if (xb_ld(&bar[XB_TMO])) break; if (sp > XB_SPIN_CAP) { atomicAdd(&bar[XB_TMO], 1u); break; } }
    }
    nloc = mine > 0u ? mine : 1u; nx = cnt > 0u ? cnt : 1u;
}
DI void xcd_barrier(const XcdBarrier& b) {
    asm volatile("s_waitcnt vmcnt(0)" ::: "memory");
    __syncthreads();
    if (threadIdx.x == 0) {
        unsigned* bar = b.bar;
        __builtin_amdgcn_s_waitcnt(0);
        unsigned nloc = b.st[0], nx = b.st[1];
        if (nloc == 0u) { xcd_barrier_complete(bar, b.x, nloc, nx); b.st[0] = nloc; b.st[1] = nx; }
        const unsigned old = xb_add(&bar[XB_XSUB(b.x)], 1u);
        const unsigned gen = old / nloc;
        if (old + 1u == (gen + 1u) * nloc) {
            __builtin_amdgcn_fence(__ATOMIC_RELEASE, "agent");
            asm volatile("s_waitcnt vmcnt(0)" ::: "memory");
            const unsigned og = xb_add(&bar[XB_TOP], 1u);
            const unsigned tg = og / nx;
            if (og + 1u == (tg + 1u) * nx) xb_add(&bar[XB_TOPGEN], 1u);
            else XB_SPIN(xb_ld(&bar[XB_TOPGEN]) == tg, bar);
            __builtin_amdgcn_fence(__ATOMIC_ACQUIRE, "agent");
            xb_add(&bar[XB_XGEN(b.x)], 1u);
            asm volatile("s_waitcnt vmcnt(0)" ::: "memory");
        } else {
            XB_SPIN(xb_ld(&bar[XB_XGEN(b.x)]) == gen, bar);
            __builtin_amdgcn_fence(__ATOMIC_ACQUIRE, "agent");
            asm volatile("s_waitcnt vmcnt(0)" ::: "memory");
        }
    }
    __syncthreads();
}

DI void run_phase(int ph, char* smem_all) {
    KP p = (KP)__builtin_amdgcn_kernarg_segment_ptr();
    asm volatile("" : "+s"(p));
    const int sb = TID512() >> 8;
    char* smem = smem_all + sb * SUB_LDS;
    const int bid = BIDX() * 2 + sb, nb = gridDim.x * 2, tid = TIDX(), wid = tid >> 6;
#ifndef ONLY_SUB
    if (ph == 0) {
        const int total = 192 + 48 + CONV_DENSE;
        for (int it = bid; it < total; it += nb) {
            if (it < 192) ph0_gemv_item(p, it, smem);
            else if (it < 240) ph0_rope_item(p, it - 192);
            else convert_tile(p, 0, it - 240, smem);
        }
        return;
    }
    if (ph == NPHASE - 1) {
        for (int it = bid; it < NLAT / 4; it += nb) {
            int row = it * 4 + wid, lane = tid & 63;
            float* xr = p->out + (long)row * DM;
            float4 v[4]; float ss = 0.f;
#pragma unroll
            for (int i = 0; i < 4; ++i) v[i] = *(const float4*)(xr + i * 256 + lane * 4);
            moe_combine(p, row, v);
#pragma unroll
            for (int i = 0; i < 4; ++i) ss += v[i].x * v[i].x + v[i].y * v[i].y + v[i].z * v[i].z + v[i].w * v[i].w;
            ss = wave_sum(ss);
            float rstd = rsqrtf(ss * (1.f / DM) + 1e-6f);
#pragma unroll
            for (int i = 0; i < 4; ++i) {
                float4 g = *(const float4*)(p->g_final + i * 256 + lane * 4);
                *(float4*)(xr + i * 256 + lane * 4) = make_float4(v[i].x * rstd * g.x, v[i].y * rstd * g.y, v[i].z * rstd * g.z, v[i].w * rstd * g.w);
            }
        }
        return;
    }
    const int layer = (ph - 1) / 11, sub = (ph - 1) % 11;
#else
    const int layer = (ph - 1) / 11, sub = ONLY_SUB;
#endif
    const bool need_ctx = layer == 0;
    switch (sub) {
    case 0: {
        const int nrow_items = NROWS / 4;
        const int total = nrow_items + (layer == 1 ? CONV_DENSE : 0);
        for (int it = bid; it < total; it += nb) {
            if (it < nrow_items) { int row = it * 4 + wid; norm_row(p, layer, row, resid_row(p, layer, row), p->g_mix + layer * DM, 0, 1, P_hx(p) + (long)row * DM, nullptr, layer == 1 ? (float*)cur_row(p, row) : nullptr); }
            else convert_tile(p, layer, it - nrow_items, smem);
        }
    } break;
    case 1: {
        ProbB pb{p}; g8::gemm_phase((LAS unsigned char*)smem_all, pb);
    } break;
    case 2: {
        const int n_state = NCHUNK * 8, n_win = 1024, n_na = 1024, n_cx = need_ctx ? 32 : 0;
        const int total = n_state + n_win + n_na + n_cx;
        for (int it = bid; it < total; it += nb) {
            if (it < n_win) attn_wave_item(p, layer, 0, it >> 1, (it & 1) * 4 + wid, smem);
            else if (it < n_win + n_na) { int i2 = it - n_win; attn_wave_item(p, layer, 1, i2 >> 1, (i2 & 1) * 4 + wid, smem); }
            else if (it < n_win + n_na + n_state) { int i2 = it - n_win - n_na; phC_state_item(p, layer, i2 >> 3, (i2 >> 1) & 3, i2 & 1, smem); }
            else { int i2 = it - n_win - n_na - n_state; int kind = 2 + (i2 >> 4); i2 &= 15; attn_wave_item(p, layer, kind, i2 >> 1, (i2 & 1) * 4 + wid, smem); }
        }
    } break;
    case 3: {
        for (int it = bid; it < 512; it += nb) phD_item(p, layer, it);
    } break;
    case 4: {
        const int nch = need_ctx ? NCHUNK : 128;
        for (int it = bid; it < nch * 8; it += nb) phE_item(p, layer, it >> 3, (it >> 1) & 3, it & 1, smem);
    } break;
    case 5: {
        { ProbF pf{p}; g8::gemm_phase((LAS unsigned char*)smem_all, pf); }
        if (need_ctx) {
            const int sb2 = TID512() >> 8;
            for (int it = BIDX() * 2 + sb2; it < 16; it += (int)gridDim.x * 2) phF_tile(p, 128 + (it >> 3), it & 7, smem_all + sb2 * SUB_LDS);
        }
    } break;
    case 6: {
        { ProbG pg{p, layer}; g8::gemm_phase((LAS unsigned char*)smem_all, pg); }
        if (need_ctx) {
            const int sb2 = TID512() >> 8;
            for (int it = BIDX() * 2 + sb2; it < 16; it += (int)gridDim.x * 2) phG_tile(p, layer, 128 + (it >> 3), it & 7, smem_all + sb2 * SUB_LDS);
        }
    } break;
    case 7: {
        const int nit = (need_ctx ? NROWS : NLAT) / 16;
        for (int it = bid; it < nit; it += nb) phH_item(p, layer, it, smem);
    } break;
    case 8: {
        const int njob = need_ctx ? 32 : 16;
        for (int it = bid; it < njob + (CONV_TILES - CONV_DENSE); it += nb) {
            if (it < njob) phI_item(p, it, smem);
            else convert_tile(p, layer, CONV_DENSE + it - njob, smem);
        }
    } break;
    case 9: {
        { ProbJ pj{p}; g8::gemm_phase((LAS unsigned char*)smem_all, pj); }
        if (need_ctx) {
            const int sb2 = TID512() >> 8;
            for (int it = BIDX() * 2 + sb2; it < 256; it += (int)gridDim.x * 2) phJ_tile(p, 16 + (it >> 4), 0, it & 15, smem_all + sb2 * SUB_LDS);
        }
    } break;
    case 10: {
        { ProbK pk{p, layer}; g8::gemm_phase((LAS unsigned char*)smem_all, pk); }
        if (need_ctx) {
            const int sb2 = TID512() >> 8;
            for (int it = BIDX() * 2 + sb2; it < 128; it += (int)gridDim.x * 2) phK_tile(p, layer, 16 + (it >> 3), 0, it & 7, smem_all + sb2 * SUB_LDS);
        }
    } break;
    }
}

__global__ void __launch_bounds__(NTHREADS, 2) mega_kernel(Params p, int ph_lo, int ph_hi) {
    __shared__ __attribute__((aligned(16))) char smem[LDS_BYTES + 16];
    cg::grid_group grid = cg::this_grid();
#if MK_MULTI
    for (int ph = ph_lo; ph < ph_hi; ++ph) {
        if (ph > ph_lo) grid.sync();
        run_phase(ph, smem);
    }
#else
    unsigned* barw = (unsigned*)(p.ws + WS_BAR);
    volatile LAS unsigned* xst = (volatile LAS unsigned*)(LAS char*)(smem + LDS_BYTES);
    if (threadIdx.x < 4) xst[threadIdx.x] = 0u;
    if (blockIdx.x == 0) for (int i = threadIdx.x; i < XCD_BAR_WORDS; i += NTHREADS) barw[i] = 0u;
    run_phase(0, smem);
    grid.sync();
    const XcdBarrier xb = xcd_barrier_post(barw, xst);
#ifdef PROBE_SUB
#define PH(n) do { if ((n) > 1) xcd_barrier(xb); run_phase((n), smem); if ((n) >= PROBE_MIN && (n) <= PROBE_MAX && (((n) - 1) % 11) == PROBE_SUB) { xcd_barrier(xb); run_phase((n), smem); } } while (0)
#else
#define PH(n) do { if ((n) > 1) xcd_barrier(xb); run_phase((n), smem); } while (0)
#endif
    PH(1); PH(2); PH(3); PH(4); PH(5); PH(6); PH(7); PH(8); PH(9); PH(10); PH(11);
    PH(12); PH(13); PH(14); PH(15); PH(16); PH(17); PH(18); PH(19); PH(20); PH(21); PH(22); PH(23);
    static_assert(NPHASE == 24, "phase program");
#undef PH
#endif
}

extern "C" void kernel_launch(void* const* d_in, const int* in_sizes, int n_in, void* d_out, int out_size, void* d_ws, size_t ws_size,
                              hipStream_t stream) {
    static int grid_blocks = 0;
    if (!grid_blocks) {
        int dev = 0, cus = 0, per_cu = 0;
        hipGetDevice(&dev);
        hipDeviceGetAttribute(&cus, hipDeviceAttributeMultiprocessorCount, dev);
        hipOccupancyMaxActiveBlocksPerMultiprocessor(&per_cu, mega_kernel, NTHREADS, 0);
        if (per_cu < 1) per_cu = 1;
        if (per_cu > 1) per_cu = 1;
        grid_blocks = cus * per_cu;
    }
    Params p{};
    const float** ip = (const float**)&p.x;
    for (int i = 0; i < 22; ++i) ip[i] = (const float*)d_in[i];
    p.out = (float*)d_out;
    p.ws = (char*)d_ws;
    if (WS_END > ws_size) { fprintf(stderr, "kernel_launch: workspace too small: need %zu have %zu\n", (size_t)WS_END, ws_size); return; }
#if MK_MULTI
    for (int ph = 0; ph < NPHASE; ++ph) {
        hipLaunchKernelGGL(mega_kernel, dim3(grid_blocks), dim3(NTHREADS), 0, stream, p, ph, ph + 1);
    }
#else
    int lo = 0, hi = NPHASE;
    void* args[] = {&p, &lo, &hi};
    hipError_t e = hipLaunchCooperativeKernel((void*)mega_kernel, dim3(grid_blocks), dim3(NTHREADS), args, 0, stream);
    if (e != hipSuccess) fprintf(stderr, "cooperative launch failed: %s (grid %d)\n", hipGetErrorString(e), grid_blocks);
#endif
}
```

```cpp
#include <hip/hip_runtime.h>
#include <hip/hip_bf16.h>
#include <hip/hip_cooperative_groups.h>
#include <cstdio>
#include <cstdint>
namespace cg = cooperative_groups;

#ifndef MK_MULTI
#define MK_MULTI 0
#endif

#define DI __device__ __forceinline__
typedef unsigned short u16;
typedef __attribute__((ext_vector_type(8))) short bf16x8;
typedef __attribute__((ext_vector_type(4))) float f32x4;
typedef __attribute__((ext_vector_type(4))) unsigned int u32x4;

constexpr int NLAT = 16384, NCTX = 256, NROWS = NLAT + NCTX, DM = 1024, INC = 7424;
constexpr int C_QR = 0, C_KR = 512, C_VR = 1024, C_GR = 1536, C_QW = 2048, C_KW = 2560, C_VW = 2688, C_QN = 2816, C_KN = 3328, C_VN = 3840, C_GATE = 4352;
__host__ __device__ constexpr int col_qr(int h, int x) { return C_QR + (h >> 1) * 256 + x * 128 + (h & 1) * 64; }
__host__ __device__ constexpr int col_kr(int h, int x) { return C_KR + (h >> 1) * 256 + x * 128 + (h & 1) * 64; }
__host__ __device__ constexpr int col_qw(int h, int x) { return C_QW + (h >> 2) * 256 + x * 128 + (h & 3) * 32; }
__host__ __device__ constexpr int col_kw(int kh, int x) { return C_KW + x * 128 + kh * 32; }
__host__ __device__ constexpr int col_vw(int kh) { return C_KW + 64 + kh * 128; }
constexpr int NCHUNK = NROWS / 128;
constexpr int NEXP = 16, EH = 1024, CAP_LAT = 2048, CAP_CTX = 32;
constexpr int NTHREADS = 512;
constexpr int SUB_LDS = 76 * 1024;
constexpr int LDS_BYTES = 2 * SUB_LDS;
constexpr int NPHASE = 24;


constexpr size_t al256(size_t b) { return (b + 255) & ~(size_t)255; }
constexpr size_t WS_CTXRES = 0;
constexpr size_t WS_MOD = WS_CTXRES + al256((size_t)NCTX * DM * 4);
constexpr size_t WS_ROPE128 = WS_MOD + al256(2 * 2 * 6144 * 4);
constexpr size_t WS_ROPE64 = WS_ROPE128 + al256(256 * 32 * 8);
constexpr size_t WS_WT_IN = WS_ROPE64 + al256(256 * 16 * 8);
constexpr size_t WS_WT_RET = WS_WT_IN + al256((size_t)INC * DM * 2);
constexpr size_t WS_WT_WIN = WS_WT_RET + al256((size_t)1024 * 512 * 2);
constexpr size_t WS_WT_NA = WS_WT_WIN + al256((size_t)1024 * 512 * 2);
constexpr size_t WS_WT_OUT = WS_WT_NA + al256((size_t)1024 * 512 * 2);
constexpr size_t WS_WT_GU = WS_WT_OUT + al256((size_t)1024 * 1024 * 2);
constexpr size_t WS_WT_DN = WS_WT_GU + al256((size_t)NEXP * 2048 * 1024 * 2);
constexpr size_t WS_HX = WS_WT_DN + al256((size_t)NEXP * 1024 * 1024 * 2);
constexpr size_t WS_PX = WS_HX + al256((size_t)NROWS * DM * 2);
constexpr size_t WS_YA = WS_PX + al256((size_t)NROWS * INC * 2);
constexpr size_t WS_YB = WS_YA + al256((size_t)NROWS * 512 * 2);
constexpr size_t WS_YC = WS_YB + al256((size_t)NROWS * 512 * 2);
constexpr size_t WS_S = WS_YC + al256((size_t)NROWS * 512 * 2);
constexpr size_t WS_R = WS_S + al256((size_t)NCHUNK * 8 * 16384 * 4);
constexpr size_t WS_AFF = WS_R + al256((size_t)NCHUNK * 8 * 16384 * 2);
constexpr size_t WS_SELI = WS_AFF + al256((size_t)32 * NLAT * 4);
constexpr size_t WS_SELG = WS_SELI + al256(32 * 2048 * 4);
constexpr size_t WS_TSLOT = WS_SELG + al256(32 * 2048 * 4);
constexpr size_t WS_BAR = WS_TSLOT + al256((size_t)32 * NLAT * 4);
constexpr size_t WS_MACCX = WS_BAR + al256(3456 * 4);
constexpr size_t WS_END = WS_MACCX + al256((size_t)NCTX * DM * 4);
struct Params {
    const float *x, *c, *ctx, *c_ctx, *w_mod, *b_mod, *g_mix, *g_ffn, *w_in, *decay, *ret_gn, *w_ret, *sink, *w_win, *rpb, *w_na, *w_out,
        *w_router, *w_eg, *w_eu, *w_ed, *g_final;
    float* out;
    char* ws;
};
typedef const Params __attribute__((address_space(4)))* KP;
#define WSF(name, type, off) __device__ __forceinline__ type* P_##name(KP p) { return (type*)(p->ws + (off)); }
WSF(ctxres, float, WS_CTXRES)
WSF(mod, float, WS_MOD)
WSF(rope128, float2, WS_ROPE128)
WSF(rope64, float2, WS_ROPE64)
WSF(wt_in, u16, WS_WT_IN) WSF(wt_ret, u16, WS_WT_RET) WSF(wt_win, u16, WS_WT_WIN) WSF(wt_na, u16, WS_WT_NA) WSF(wt_out, u16, WS_WT_OUT)
WSF(wt_gu, u16, WS_WT_GU) WSF(wt_dn, u16, WS_WT_DN)
WSF(hx, u16, WS_HX)
WSF(px, u16, WS_PX)
WSF(ya, u16, WS_YA) WSF(yb, u16, WS_YB) WSF(yc, u16, WS_YC)
WSF(S, float, WS_S)
WSF(R, u16, WS_R)
WSF(aff, float, WS_AFF)
WSF(sel_idx, int, WS_SELI) WSF(sel_gate, float, WS_SELG)
WSF(hid, u16, WS_PX)
__device__ __forceinline__ u16* P_hidc(KP p) { return (u16*)(p->ws + WS_PX) + (size_t)NEXP * 2048 * 1024; }
__device__ __forceinline__ u16* P_ye(KP p) { return (u16*)(p->ws + WS_PX) + (size_t)NEXP * (2048 + 32) * 1024; }
__device__ __forceinline__ u16* P_yec(KP p) { return P_ye(p) + (size_t)NEXP * 2048 * 1024; }
__device__ __forceinline__ int* P_tslot(KP p) { return (int*)(p->ws + WS_TSLOT); }
__device__ __forceinline__ u16* P_z(KP p) { return (u16*)(p->ws + WS_S); }
__device__ __forceinline__ float* P_maccx(KP p) { return (float*)(p->ws + WS_MACCX); }
#undef WSF


DI int TIDX() { int t = threadIdx.x & 255; asm volatile("" : "+v"(t)); return t; }
DI int TID512() { int t = threadIdx.x; asm volatile("" : "+v"(t)); return t; }
DI int BIDX() { int t = blockIdx.x; asm volatile("" : "+s"(t)); return t; }
DI u16 f2bf(float x) { unsigned u = __float_as_uint(x); u += 0x7fffu + ((u >> 16) & 1u); return (u16)(u >> 16); }
DI float bf2f(u16 h) { return __uint_as_float(((unsigned)h) << 16); }
DI float bflo(unsigned w) { return __uint_as_float(w << 16); }
DI float bfhi(unsigned w) { return __uint_as_float(w & 0xffff0000u); }
typedef __bf16 bf16v2 __attribute__((ext_vector_type(2)));
typedef float f32v2 __attribute__((ext_vector_type(2)));
DI unsigned pack2(float a, float b) { f32v2 v = {a, b}; bf16v2 r = __builtin_convertvector(v, bf16v2); return __builtin_bit_cast(unsigned, r); }
DI float sigmoidf_(float x) { return 1.f / (1.f + __expf(-x)); }
DI float siluf_(float x) { return x / (1.f + __expf(-x)); }
DI float wave_sum(float v) { for (int o = 32; o > 0; o >>= 1) v += __shfl_xor(v, o); return v; }
#define MFMA16(a, b, c) __builtin_amdgcn_mfma_f32_16x16x32_bf16((a), (b), (c), 0, 0, 0)

template <int MR>
DI void zero_acc(f32x4 (&acc)[MR][4]) {
#pragma unroll
    for (int m = 0; m < MR; ++m)
#pragma unroll
        for (int n = 0; n < 4; ++n) acc[m][n] = f32x4{0.f, 0.f, 0.f, 0.f};
}

template <int KT>
DI void gemm_core(f32x4 (&acc)[4][4], const u16* a0, const u16* a1, const u16* b0, const u16* b1, char* smem) {
    const int tid = TIDX(), lane = tid & 63, wid = tid >> 6, wr = wid >> 1, wc = wid & 1, fr = lane & 15, fq = lane >> 4;
    auto stage = [&](int kt, int buf) {
        char* base = smem + buf * 16384;
        __builtin_amdgcn_global_load_lds((const unsigned*)(a0 + kt * 32), (unsigned*)(base + tid * 16), 16, 0, 0);
        __builtin_amdgcn_global_load_lds((const unsigned*)(a1 + kt * 32), (unsigned*)(base + 4096 + tid * 16), 16, 0, 0);
        __builtin_amdgcn_global_load_lds((const unsigned*)(b0 + kt * 32), (unsigned*)(base + 8192 + tid * 16), 16, 0, 0);
        __builtin_amdgcn_global_load_lds((const unsigned*)(b1 + kt * 32), (unsigned*)(base + 12288 + tid * 16), 16, 0, 0);
    };
    __syncthreads();
    stage(0, 0);
    for (int kt = 0; kt < KT; ++kt) {
        asm volatile("s_waitcnt vmcnt(0)" ::: "memory");
        __syncthreads();
        if (kt + 1 < KT) stage(kt + 1, (kt + 1) & 1);
        const char* SA = smem + (kt & 1) * 16384;
        const char* SB = SA + 8192;
        bf16x8 At[4], Bt[4];
#pragma unroll
        for (int m = 0; m < 4; ++m) At[m] = *(const bf16x8*)(SA + (wr * 64 + m * 16 + fr) * 64 + fq * 16);
#pragma unroll
        for (int n = 0; n < 4; ++n) Bt[n] = *(const bf16x8*)(SB + (wc * 64 + n * 16 + fr) * 64 + fq * 16);
#pragma unroll
        for (int m = 0; m < 4; ++m)
#pragma unroll
            for (int n = 0; n < 4; ++n) acc[m][n] = MFMA16(At[m], Bt[n], acc[m][n]);
    }
}

template <int KT>
DI void gemm_core_af32(f32x4 (&acc)[4][4], const float* a0f, const float* a1f, const u16* b0, const u16* b1, char* smem) {
    const int tid = TIDX(), lane = tid & 63, wid = tid >> 6, wr = wid >> 1, wc = wid & 1, fr = lane & 15, fq = lane >> 4;
    f32x4 ar[4];
    auto loadA = [&](int kt) { ar[0] = *(const f32x4*)(a0f + kt * 32); ar[1] = *(const f32x4*)(a0f + kt * 32 + 4); ar[2] = *(const f32x4*)(a1f + kt * 32); ar[3] = *(const f32x4*)(a1f + kt * 32 + 4); };
    auto storeA = [&](int buf) {
        char* base = smem + buf * 16384;
        u32x4 w0, w1;
        w0[0] = pack2(ar[0][0], ar[0][1]); w0[1] = pack2(ar[0][2], ar[0][3]); w0[2] = pack2(ar[1][0], ar[1][1]); w0[3] = pack2(ar[1][2], ar[1][3]);
        w1[0] = pack2(ar[2][0], ar[2][1]); w1[1] = pack2(ar[2][2], ar[2][3]); w1[2] = pack2(ar[3][0], ar[3][1]); w1[3] = pack2(ar[3][2], ar[3][3]);
        *(u32x4*)(base + tid * 16) = w0; *(u32x4*)(base + 4096 + tid * 16) = w1;
    };
    auto stageB = [&](int kt, int buf) {
        char* base = smem + buf * 16384;
        __builtin_amdgcn_global_load_lds((const unsigned*)(b0 + kt * 32), (unsigned*)(base + 8192 + tid * 16), 16, 0, 0);
        __builtin_amdgcn_global_load_lds((const unsigned*)(b1 + kt * 32), (unsigned*)(base + 12288 + tid * 16), 16, 0, 0);
    };
    __syncthreads();
    loadA(0); stageB(0, 0); storeA(0);
    for (int kt = 0; kt < KT; ++kt) {
        asm volatile("s_waitcnt vmcnt(0)" ::: "memory");
        __syncthreads();
        if (kt + 1 < KT) { loadA(kt + 1); stageB(kt + 1, (kt + 1) & 1); }
        const char* SA = smem + (kt & 1) * 16384;
        const char* SB = SA + 8192;
        bf16x8 At[4], Bt[4];
#pragma unroll
        for (int m = 0; m < 4; ++m) At[m] = *(const bf16x8*)(SA + (wr * 64 + m * 16 + fr) * 64 + fq * 16);
#pragma unroll
        for (int n = 0; n < 4; ++n) Bt[n] = *(const bf16x8*)(SB + (wc * 64 + n * 16 + fr) * 64 + fq * 16);
#pragma unroll
        for (int m = 0; m < 4; ++m)
#pragma unroll
            for (int n = 0; n < 4; ++n) acc[m][n] = MFMA16(At[m], Bt[n], acc[m][n]);
        if (kt + 1 < KT) storeA((kt + 1) & 1);
    }
}

template <int MR>
DI void mma_lds64(f32x4 (&acc)[MR][4], const u16* As, int lda, const u16* Bs, int ldb) {
    const int tid = TIDX(), lane = tid & 63, wid = tid >> 6, wr = wid >> 1, wc = wid & 1, fr = lane & 15, fq = lane >> 4;
#pragma unroll
    for (int kk = 0; kk < 2; ++kk) {
        bf16x8 At[MR], Bt[4];
#pragma unroll
        for (int m = 0; m < MR; ++m) At[m] = *(const bf16x8*)(As + (wr * (MR * 16) + m * 16 + fr) * lda + kk * 32 + fq * 8);
#pragma unroll
        for (int n = 0; n < 4; ++n) Bt[n] = *(const bf16x8*)(Bs + (wc * 64 + n * 16 + fr) * ldb + kk * 32 + fq * 8);
#pragma unroll
        for (int m = 0; m < MR; ++m)
#pragma unroll
            for (int n = 0; n < 4; ++n) acc[m][n] = MFMA16(At[m], Bt[n], acc[m][n]);
    }
}
template <int ROWS>
DI void stage_n64(u16* dst, int ld, const u16* src, long sstride) {
    const int tid = TIDX();
#pragma unroll
    for (int i = 0; i < ROWS / 32; ++i) {
        int idx = i * 256 + tid, row = idx >> 3, ch = idx & 7;
        u32x4 v = *(const u32x4*)(src + (long)row * sstride + ch * 8);
        *(u32x4*)(dst + row * ld + ch * 8) = v;
    }
}
template <bool SCALE, int NF>
DI void stage_t64(u16* dst, int ld, const u16* src, long sstride, float scale_tok_lane  ) {
    const int tid = TIDX();
#pragma unroll
    for (int i = 0; i < NF / 32; ++i) {
        int idx = i * 256 + tid, jj = idx & 63, ch = idx >> 6;
        u32x4 v = *(const u32x4*)(src + (long)jj * sstride + ch * 8);
#pragma unroll
        for (int e = 0; e < 4; ++e) {
            float lo = bflo(v[e]), hi = bfhi(v[e]);
            if (SCALE) { lo *= scale_tok_lane; hi *= scale_tok_lane; }
            dst[(ch * 8 + 2 * e) * ld + jj] = SCALE ? f2bf(lo) : (u16)(v[e] & 0xffffu);
            dst[(ch * 8 + 2 * e + 1) * ld + jj] = SCALE ? f2bf(hi) : (u16)(v[e] >> 16);
        }
    }
}

DI void convert_tile(KP p, int layer, int tile, char* smem);

DI void ph0_gemv_item(KP p, int item, char* smem) {
    const int tid = TIDX();
    const int l = item / 96, cg_ = item % 96;
    float* sl = (float*)smem;
    float* red = (float*)(smem + 8192);
    __syncthreads();
    for (int k = tid; k < 1024; k += 256) { sl[k] = siluf_(p->c[k]); sl[1024 + k] = siluf_(p->c_ctx[k]); }
    __syncthreads();
    const int c4 = tid & 15, kp = tid >> 4;
    const int col = cg_ * 64 + c4 * 4;
    const float* w = p->w_mod + (long)l * 1024 * 6144 + col;
    float a0[4] = {0, 0, 0, 0}, a1[4] = {0, 0, 0, 0};
#pragma unroll 8
    for (int kk = 0; kk < 64; ++kk) {
        int k = kp * 64 + kk;
        float4 wv = *(const float4*)(w + (long)k * 6144);
        float s0 = sl[k], s1 = sl[1024 + k];
        a0[0] += s0 * wv.x; a0[1] += s0 * wv.y; a0[2] += s0 * wv.z; a0[3] += s0 * wv.w;
        a1[0] += s1 * wv.x; a1[1] += s1 * wv.y; a1[2] += s1 * wv.z; a1[3] += s1 * wv.w;
    }
#pragma unroll
    for (int j = 0; j < 4; ++j) { red[(kp * 2 + 0) * 64 + c4 * 4 + j] = a0[j]; red[(kp * 2 + 1) * 64 + c4 * 4 + j] = a1[j]; }
    __syncthreads();
    if (tid < 128) {
        int src = tid >> 6, cr = tid & 63;
        float s = 0.f;
        for (int q = 0; q < 16; ++q) s += red[(q * 2 + src) * 64 + cr];
        int n = cg_ * 64 + cr;
        P_mod(p)[(l * 2 + src) * 6144 + n] = s + p->b_mod[l * 6144 + n];
    }
}
DI void sincos_d(double a, float& c, float& s) {
    const double TWO_PI = 6.283185307179586476925286766559;
    double k = rint(a / TWO_PI);
    double r = a - k * TWO_PI;
    double r2 = r * r;
    double ts = r, tc = 1.0, ss = r, cc = 1.0;
    for (int i = 1; i <= 14; ++i) {
        tc = -tc * r2 / (double)((2 * i - 1) * (2 * i));
        ts = -ts * r2 / (double)((2 * i) * (2 * i + 1));
        cc += tc; ss += ts;
    }
    c = (float)cc; s = (float)ss;
}
DI void ph0_rope_item(KP p, int item) {
    int idx = item * 256 + TIDX();
    const double LN_BASE = 9.210340371976184;
    if (idx < 8192) {
        int pos = idx >> 5, f = idx & 31;
        float inv = (float)exp(-(double)f / 32.0 * LN_BASE);
        float ang = (float)pos * inv;
        float c, s; sincos_d((double)ang, c, s);
        P_rope128(p)[idx] = make_float2(c, s);
    } else {
        int i2 = idx - 8192;
        int pos = i2 >> 4, f = i2 & 15;
        float inv = (float)exp(-(double)f / 16.0 * LN_BASE);
        float ang = (float)pos * inv;
        float c, s; sincos_d((double)ang, c, s);
        P_rope64(p)[i2] = make_float2(c, s);
    }
}

constexpr int CONV_TILES = 1856 + 384 + 256 + 12288;
constexpr int CONV_DENSE = 1856 + 384 + 256;
DI void convert_tile(KP p, int layer, int tile, char* smem) {
    const int tid = TIDX();
    const float* src; u16* dst; int K, N, mode = 0;
    if (tile < 1856) { src = p->w_in + (long)layer * 1024 * INC; dst = P_wt_in(p); K = 1024; N = INC; mode = 1; }
    else if (tile < 1856 + 384) {
        int t = tile - 1856, which = t / 128; tile = t % 128; K = 512; N = 1024;
        src = (which == 0 ? p->w_ret : which == 1 ? p->w_win : p->w_na) + (long)layer * 512 * 1024;
        dst = (which == 0 ? P_wt_ret(p) : which == 1 ? P_wt_win(p) : P_wt_na(p));
    } else if (tile < 1856 + 384 + 256) { tile -= 1856 + 384; src = p->w_out + (long)layer * 1024 * 1024; dst = P_wt_out(p); K = 1024; N = 1024; }
    else {
        int t = tile - (1856 + 384 + 256), which = t / 4096, e = (t % 4096) / 256; tile = t % 256; K = 1024; N = 1024;
        long eo = ((long)layer * NEXP + e) * 1024 * 1024;
        if (which == 0) { src = p->w_eg + eo; dst = P_wt_gu(p) + (long)e * 2048 * 1024; mode = 2; }
        else if (which == 1) { src = p->w_eu + eo; dst = P_wt_gu(p) + (long)e * 2048 * 1024; mode = 3; }
        else { src = p->w_ed + eo; dst = P_wt_dn(p) + (long)e * 1024 * 1024; }
    }
    const int ntn = N / 64;
    const int k0 = (tile / ntn) * 64, n0 = (tile % ntn) * 64;
    const int lane = tid & 63, w = tid >> 6;
    const int n = n0 + lane;
    int drow = n;
    if (mode == 1) {
        if (n < 1024) { int hh_ = (n & 511) >> 7, o_ = n & 127; drow = (n < 512 ? col_qr(hh_, o_ >> 6) : col_kr(hh_, o_ >> 6)) + (o_ & 63); }
        else if (n >= C_QW && n < C_KW) { int m_ = n - C_QW; drow = col_qw(m_ >> 6, (m_ & 63) >> 5) + (m_ & 31); }
        else if (n >= C_KW && n < C_VW) { int m_ = n - C_KW; drow = col_kw(m_ >> 6, (m_ & 63) >> 5) + (m_ & 31); }
        else if (n >= C_VW && n < C_QN) { int m_ = n - C_VW; drow = col_vw(m_ >> 6) + (m_ & 63); }
    } else if (mode == 2) drow = (n >> 7) * 256 + (n & 127);
    else if (mode == 3) drow = (n >> 7) * 256 + 128 + (n & 127);
    const float* sp = src + (long)(k0 + w * 16) * N + n;
    float v[16];
#pragma unroll
    for (int j = 0; j < 16; ++j) v[j] = sp[(long)j * N];
#pragma unroll
    for (int g = 0; g < 2; ++g) {
        u32x4 o;
#pragma unroll
        for (int e = 0; e < 4; ++e) o[e] = pack2(v[g * 8 + 2 * e], v[g * 8 + 2 * e + 1]);
        *(u32x4*)(dst + (long)drow * K + k0 + w * 16 + g * 8) = o;
    }
}

DI const float* resid_row(KP p, int layer, int row) {
    if (row < NLAT) return (layer == 0 ? p->x : p->out) + (long)row * DM;
    return (layer == 0 ? p->ctx : P_ctxres(p)) + (long)(row - NLAT) * DM;
}
DI const float* cur_row(KP p, int row) { return row < NLAT ? p->out + (long)row * DM : P_ctxres(p) + (long)(row - NLAT) * DM; }
DI void moe_combine(KP p, int row, float4 (&v)[4]) {
    const int lane = TIDX() & 63;
    const bool lat = row < NLAT;
    const int* ts = P_tslot(p) + (lat ? 0 : 16) * (long)NLAT + (lat ? row : row - NLAT);
    const u16* yb_ = lat ? P_ye(p) : P_yec(p);
    const int cap = lat ? CAP_LAT : CAP_CTX;
#pragma unroll 4
    for (int e = 0; e < NEXP; ++e) {
        const int slot = ts[(long)e * NLAT];
        if (slot >= 0) {
            const u16* yr = yb_ + ((long)e * cap + slot) * DM + lane * 4;
#pragma unroll
            for (int i = 0; i < 4; ++i) {
                uint2 w = *(const uint2*)(yr + i * 256);
                v[i].x += bflo(w.x); v[i].y += bfhi(w.x); v[i].z += bflo(w.y); v[i].w += bfhi(w.y);
            }
        }
    }
}
DI void norm_row(KP p, int layer, int row, const float* xr, const float* g, int shift_idx, int scale_idx, u16* dst_row, float* keep  , float* wb  ) {
    const int lane = TIDX() & 63;
    const float* md = P_mod(p) + (layer * 2 + (row < NLAT ? 0 : 1)) * 6144;
    float4 v[4]; float ss = 0.f;
#pragma unroll
    for (int i = 0; i < 4; ++i) v[i] = *(const float4*)(xr + i * 256 + lane * 4);
    if (wb) {
        moe_combine(p, row, v);
#pragma unroll
        for (int i = 0; i < 4; ++i) *(float4*)(wb + i * 256 + lane * 4) = v[i];
    }
#pragma unroll
    for (int i = 0; i < 4; ++i) ss += v[i].x * v[i].x + v[i].y * v[i].y + v[i].z * v[i].z + v[i].w * v[i].w;
    ss = wave_sum(ss);
    float rstd = rsqrtf(ss * (1.f / DM) + 1e-6f);
#pragma unroll
    for (int i = 0; i < 4; ++i) {
        int c0 = i * 256 + lane * 4;
        float4 gg = *(const float4*)(g + c0), sh = *(const float4*)(md + shift_idx * 1024 + c0), sc = *(const float4*)(md + scale_idx * 1024 + c0);
        float o0 = v[i].x * rstd * gg.x * (1.f + sc.x) + sh.x, o1 = v[i].y * rstd * gg.y * (1.f + sc.y) + sh.y;
        float o2 = v[i].z * rstd * gg.z * (1.f + sc.z) + sh.z, o3 = v[i].w * rstd * gg.w * (1.f + sc.w) + sh.w;
        uint2 pk; pk.x = pack2(o0, o1); pk.y = pack2(o2, o3);
        *(uint2*)(dst_row + c0) = pk;
        if (keep) *(float4*)(keep + c0) = make_float4(o0, o1, o2, o3);
    }
}

DI void phB_tile(KP p, int mt, int nt, char* smem) {
    const int tid = TIDX(), lane = tid & 63, wid = tid >> 6, wr = wid >> 1, wc = wid & 1, fr = lane & 15, fq = lane >> 4;
    f32x4 acc[4][4]; zero_acc<4>(acc);
    const int r0 = tid >> 2, ko = (tid & 3) * 8;
    const u16* a0 = P_hx(p) + (long)(mt * 128 + r0) * DM + ko;
    const u16* b0 = P_wt_in(p) + (long)(nt * 128 + r0) * DM + ko;
    gemm_core<32>(acc, a0, a0 + 64 * DM, b0, b0 + 64 * DM, smem);
    const bool lat = mt < 128;
    const int type = (nt < 8) ? 1 : (nt >= 16 && nt < 21) ? 2 : 0;
    if (type != 0 && lat) {
#pragma unroll
        for (int m = 0; m < 4; ++m)
#pragma unroll
            for (int j = 0; j < 4; ++j) {
                int t = mt * 128 + wr * 64 + m * 16 + fq * 4 + j;
                int pr = t >> 6, pc = t & 63;
#pragma unroll
                for (int n = 0; n < 2; ++n) {
                    float2 cs;
                    if (type == 1) { int pos = (wc == 0) ? pr : pc; cs = P_rope128(p)[pos * 32 + n * 16 + fr]; }
                    else { int pos = (n == 0) ? pr : pc; cs = P_rope64(p)[pos * 16 + fr]; }
                    float x1 = acc[m][n][j], x2 = acc[m][n + 2][j];
                    acc[m][n][j] = x1 * cs.x - x2 * cs.y;
                    acc[m][n + 2][j] = x1 * cs.y + x2 * cs.x;
                }
            }
    }
    const float mul = (nt >= 4 && nt < 8) ? 0.08838834764831845f : ((nt >= 16 && nt < 20) || (nt >= 22 && nt < 26)) ? 0.125f : 1.f;
#pragma unroll
    for (int m = 0; m < 4; ++m)
#pragma unroll
        for (int n = 0; n < 4; ++n)
#pragma unroll
            for (int j = 0; j < 4; ++j) {
                int row = mt * 128 + wr * 64 + m * 16 + fq * 4 + j, col = nt * 128 + wc * 64 + n * 16 + fr;
                P_px(p)[(long)row * INC + col] = f2bf(acc[m][n][j] * mul);
            }
}

typedef __attribute__((ext_vector_type(16))) float f32x16;
typedef short v4s __attribute__((ext_vector_type(4)));
typedef __attribute__((address_space(3))) v4s* lds_v4s_ptr;
#define MFMA32(a, b, c) __builtin_amdgcn_mfma_f32_32x32x16_bf16((a), (b), (c), 0, 0, 0)
constexpr float LOG2E = 1.4426950408889634f;

struct FA {
    bf16x8 qf[4];
    f32x16 o[2];
    float m, l;
};
DI void fa_stage(u16* Ks, u16* Vs, const u16* px, int rowstart, int colK1, int colK2, int colV) {
    const int lane = TIDX() & 63;
#pragma unroll
    for (int i = 0; i < 8; ++i) {
        int idx = i * 64 + lane, key = idx >> 3, ch = idx & 7;
        const u16* src = px + (long)(rowstart + key) * INC;
        u32x4 kv = *(const u32x4*)(src + (ch < 4 ? colK1 + ch * 8 : colK2 + (ch - 4) * 8));
        u32x4 vv = *(const u32x4*)(src + colV + ch * 8);
        *(u32x4*)(Ks + key * 72 + ch * 8) = kv;
        *(u32x4*)(Vs + key * 72 + ch * 8) = vv;
    }
}
template <int MODE>
DI void fa_tile(FA& st, const u16* Ks, const u16* Vs, int a0, const float* rrow) {
    const int lane = TIDX() & 63, c = lane & 31, hh = lane >> 5;
    const u16* kbase = Ks + c * 72 + hh * 8;
    const u16* vbase = Vs + (4 * hh + ((lane & 15) >> 2)) * 72 + 16 * ((lane >> 4) & 1) + 4 * (lane & 3);
    f32x16 s[2];
#pragma unroll
    for (int kb = 0; kb < 2; ++kb) {
#pragma unroll
        for (int r = 0; r < 16; ++r) s[kb][r] = 0.f;
#pragma unroll
        for (int ks = 0; ks < 4; ++ks) {
            bf16x8 A = *(const bf16x8*)(kbase + kb * 32 * 72 + ks * 16);
            s[kb] = MFMA32(A, st.qf[ks], s[kb]);
        }
    }
    float mx = -3.0e38f;
    const int cq = a0 + c;
    int cs = cq - 8; cs = cs < 0 ? 0 : (cs > 48 ? 48 : cs);
#pragma unroll
    for (int kb = 0; kb < 2; ++kb)
#pragma unroll
        for (int r = 0; r < 16; ++r) {
            const int j = kb * 32 + (r & 3) + 8 * (r >> 2) + 4 * hh;
            float v = s[kb][r];
            if (MODE == 1) { int d = a0 + j - c; v = (d >= -128 && d <= 128) ? v : -1e30f; }
            if (MODE == 2) { bool ok = (j >= cs) && (j < cs + 16); int ci = j - cq + 15; ci = ci < 0 ? 0 : (ci > 30 ? 30 : ci); v = ok ? v + rrow[ci] : -1e30f; }
            v *= LOG2E;
            s[kb][r] = v;
            mx = fmaxf(mx, v);
        }
    mx = fmaxf(mx, __shfl_xor(mx, 32));
    const float mn = fmaxf(st.m, mx);
    const float alpha = __builtin_amdgcn_exp2f(st.m - mn);
    float ls = 0.f;
#pragma unroll
    for (int kb = 0; kb < 2; ++kb)
#pragma unroll
        for (int r = 0; r < 16; ++r) { float pv = __builtin_amdgcn_exp2f(s[kb][r] - mn); s[kb][r] = pv; ls += pv; }
    st.l = st.l * alpha + ls; st.m = mn;
#pragma unroll
    for (int db = 0; db < 2; ++db)
#pragma unroll
        for (int r = 0; r < 16; ++r) st.o[db][r] *= alpha;
    bf16x8 pf[2][2];
#pragma unroll
    for (int kb = 0; kb < 2; ++kb)
#pragma unroll
        for (int k2 = 0; k2 < 2; ++k2) {
            u32x4 w;
#pragma unroll
            for (int e = 0; e < 4; ++e) w[e] = pack2(s[kb][8 * k2 + 2 * e], s[kb][8 * k2 + 2 * e + 1]);
            pf[kb][k2] = __builtin_bit_cast(bf16x8, w);
        }
#pragma unroll
    for (int db = 0; db < 2; ++db)
#pragma unroll
        for (int kb = 0; kb < 2; ++kb)
#pragma unroll
            for (int k2 = 0; k2 < 2; ++k2) {
                const u16* alo = vbase + (kb * 32 + 16 * k2) * 72 + db * 32;
                v4s lo = __builtin_amdgcn_ds_read_tr16_b64_v4i16((lds_v4s_ptr)alo);
                v4s hi = __builtin_amdgcn_ds_read_tr16_b64_v4i16((lds_v4s_ptr)(alo + 8 * 72));
                bf16x8 A = __builtin_shufflevector(lo, hi, 0, 1, 2, 3, 4, 5, 6, 7);
                st.o[db] = MFMA32(A, pf[kb][k2], st.o[db]);
            }
}
DI void attn_block_item(KP p, int layer, int kind, int ia, int ib, char* smem) {
    const int tid = TIDX(), lane = tid & 63, wid = tid >> 6, c = lane & 31, hh = lane >> 5;
    u16* KV = (u16*)smem;
    float* rpbs = (float*)(smem + 36864) + wid * 256;
    const bool isna = (kind == 1 || kind == 3);
    int h, q0, a_half = 0, kvh;
    if (kind == 0) { h = ib * 4 + wid; kvh = ib; q0 = ia * 32; }
    else if (kind == 1) { h = ib; kvh = ib; q0 = (2 * ia + (wid >> 1)) * 64 + (wid & 1) * 32; a_half = (wid & 1) * 32; }
    else if (kind == 2) { h = ib * 4 + wid; kvh = ib; q0 = NLAT + ia * 32; }
    else { h = ib; kvh = ib; q0 = NLAT + (ia * 4 + wid) * 32; }
    const int colQ1 = isna ? C_QN + h * 64 : col_qw(h, 0), colQ2 = isna ? colQ1 + 32 : col_qw(h, 1);
    const int colK1 = isna ? C_KN + kvh * 64 : col_kw(kvh, 0), colK2 = isna ? colK1 + 32 : col_kw(kvh, 1);
    const int colV = isna ? C_VN + kvh * 64 : col_vw(kvh);
    FA st;
    {
        const u16* qrow = P_px(p) + (long)(q0 + c) * INC;
#pragma unroll
        for (int ks = 0; ks < 4; ++ks) st.qf[ks] = *(const bf16x8*)(qrow + (ks < 2 ? colQ1 + ks * 16 : colQ2 + (ks - 2) * 16) + hh * 8);
#pragma unroll
        for (int db = 0; db < 2; ++db)
#pragma unroll
            for (int r = 0; r < 16; ++r) st.o[db][r] = 0.f;
        if (isna) { st.m = -1e30f; st.l = 0.f; } else { st.m = p->sink[layer * 8 + h] * LOG2E; st.l = hh == 0 ? 1.f : 0.f; }
    }
    const int r0 = 2 * ia, rq = r0 + (wid >> 1);
    int sr0 = r0 - 4; sr0 = sr0 < 0 ? 0 : (sr0 > 248 ? 248 : sr0);
    int srq = rq - 4; srq = srq < 0 ? 0 : (srq > 248 ? 248 : srq);
    int sr1 = r0 + 1 - 4; sr1 = sr1 < 0 ? 0 : (sr1 > 248 ? 248 : sr1);
    if (kind == 1) {
        const float* rp = p->rpb + ((long)layer * 8 + h) * 465 + (srq - rq + 7) * 31;
        for (int i = lane; i < 248; i += 64) rpbs[i] = rp[i];
    }
    const int nloc = kind == 0 ? 5 : kind == 1 ? 9 : 0, nt = nloc + 4;
    const int wt0 = (q0 >> 6) - 2;
    auto tile_row = [&](int i) -> int {
        if (i >= nloc) return NLAT + (i - nloc) * 64;
        if (kind == 0) { const int s0 = ((ia * 32) >> 6) - 2 + i; return (s0 < 0 || s0 >= NLAT / 64) ? -1 : s0 * 64; }
        const int kr = sr0 + i; return (kr > sr1 + 7) ? -1 : kr * 64;
    };
    const int skey = tid >> 4, sc16 = tid & 15;
    const int scol = sc16 < 8 ? (sc16 < 4 ? colK1 + sc16 * 8 : colK2 + (sc16 - 4) * 8) : colV + (sc16 - 8) * 8;
    const int sdst = (sc16 < 8 ? 0 : 64 * 72) + skey * 72 + (sc16 & 7) * 8;
    u32x4 pre[4];
    auto load_tile = [&](int row0) {
#pragma unroll
        for (int j = 0; j < 4; ++j) pre[j] = *(const u32x4*)(P_px(p) + (long)(row0 + skey + 16 * j) * INC + scol);
    };
    auto store_tile = [&](int buf) {
#pragma unroll
        for (int j = 0; j < 4; ++j) *(u32x4*)(KV + buf * (2 * 64 * 72) + sdst + 16 * j * 72) = pre[j];
    };
    __syncthreads();
    int rowc = tile_row(0);
    if (rowc >= 0) { load_tile(rowc); store_tile(0); }
    __syncthreads();
    for (int i = 0; i < nt; ++i) {
        const int rown = (i + 1 < nt) ? tile_row(i + 1) : -1;
        if (rown >= 0) load_tile(rown);
        if (rowc >= 0) {
            const u16* Ks = KV + (i & 1) * (2 * 64 * 72);
            const u16* Vs = Ks + 64 * 72;
            if (i >= nloc) fa_tile<0>(st, Ks, Vs, 0, nullptr);
            else if (kind == 0) { if (i == 0 || i == 4) fa_tile<1>(st, Ks, Vs, rowc - q0, nullptr); else fa_tile<0>(st, Ks, Vs, 0, nullptr); }
            else { const int kr = sr0 + i; if (kr >= srq && kr < srq + 8) fa_tile<2>(st, Ks, Vs, a_half, rpbs + (kr - srq) * 31); }
        }
        if (rown >= 0) store_tile((i + 1) & 1);
        rowc = rown;
        __syncthreads();
    }
    u16* y = isna ? P_yc(p) : P_yb(p);
    {
        float lt = st.l + __shfl_xor(st.l, 32);
        float inv = 1.f / lt;
        u16* orow = y + (long)(q0 + c) * 512 + h * 64;
#pragma unroll
        for (int db = 0; db < 2; ++db)
#pragma unroll
            for (int g = 0; g < 4; ++g) {
                uint2 o;
                o.x = pack2(st.o[db][4 * g] * inv, st.o[db][4 * g + 1] * inv);
                o.y = pack2(st.o[db][4 * g + 2] * inv, st.o[db][4 * g + 3] * inv);
                *(uint2*)(orow + db * 32 + 8 * g + 4 * hh) = o;
            }
    }
}

DI void ret_gammas(KP p, int layer, int h, float& lgf2, float& lgb2) {
    float xf = p->decay[layer * 8 + h], xb = p->decay[layer * 8 + 4 + h];
    lgf2 = -log1pf(expf(-xf)) * 1.4426950408889634f;
    lgb2 = -log1pf(expf(-xb)) * 1.4426950408889634f;
}
DI void phC_state_item(KP p, int layer, int c, int h, int eh, char* smem) {
    const int tid = TIDX(), lane = tid & 63, wid = tid >> 6, wr = wid >> 1, wc = wid & 1, fr = lane & 15, fq = lane >> 4;
    u16* Av = (u16*)smem;
    u16* Bf = Av + 64 * 72;
    u16* Bb = Bf + 128 * 72;
    float lgf2, lgb2; ret_gammas(p, layer, h, lgf2, lgb2);
    f32x4 accF[2][4], accB[2][4]; zero_acc<2>(accF); zero_acc<2>(accB);
    const u16* base = P_px(p) + (long)c * 128 * INC;
#pragma unroll 1
    for (int jh = 0; jh < 2; ++jh) {
        const int j = jh * 64 + (tid & 63);
        const float zf = exp2f((float)(127 - j) * lgf2), zb = exp2f((float)j * lgb2);
        __syncthreads();
        stage_t64<false, 64>(Av, 72, base + (long)jh * 64 * INC + C_VR + h * 128 + eh * 64, INC, 1.f);
#pragma unroll
        for (int x = 0; x < 2; ++x) {
            stage_t64<true, 64>(Bf + x * 64 * 72, 72, base + (long)jh * 64 * INC + col_kr(h, x), INC, zf);
            stage_t64<true, 64>(Bb + x * 64 * 72, 72, base + (long)jh * 64 * INC + col_kr(h, x), INC, zb);
        }
        __syncthreads();
        mma_lds64<2>(accF, Av, 72, Bf, 72);
        mma_lds64<2>(accB, Av, 72, Bb, 72);
    }
    float* Sf = P_S(p) + ((long)(c * 4 + h) * 2 + 0) * 16384;
    float* Sb = Sf + 16384;
#pragma unroll
    for (int m = 0; m < 2; ++m)
#pragma unroll
        for (int n = 0; n < 4; ++n)
#pragma unroll
            for (int j = 0; j < 4; ++j) {
                int e = eh * 64 + wr * 32 + m * 16 + fq * 4 + j, d = wc * 64 + n * 16 + fr;
                Sf[e * 128 + d] = accF[m][n][j];
                Sb[e * 128 + d] = accB[m][n][j];
            }
}

DI void phD_item(KP p, int layer, int item) {
    const int h = item >> 7, dir = (item >> 6) & 1, pos = (item & 63) * 256 + TIDX();
    float lgf2, lgb2; ret_gammas(p, layer, h, lgf2, lgb2);
    const float decay = exp2f(128.f * (dir == 0 ? lgf2 : lgb2));
    float r = 0.f;
    const long hs = (long)(h * 2 + dir) * 16384 + pos;
    auto chunk_at = [&](int i) -> int {
        if (dir == 0) return i < 2 ? 128 + i : i - 2;
        return i < 2 ? 129 - i : 129 - i;
    };
    for (int i0 = 0; i0 < NCHUNK; i0 += 13) {
        float s[13];
#pragma unroll
        for (int u = 0; u < 13; ++u) s[u] = P_S(p)[(long)chunk_at(i0 + u) * 8 * 16384 + hs];
#pragma unroll
        for (int u = 0; u < 13; ++u) {
            P_R(p)[(long)chunk_at(i0 + u) * 8 * 16384 + hs] = f2bf(r);
            r = decay * r + s[u];
        }
    }
}

DI void phE_item(KP p, int layer, int c, int h, int ih, char* smem) {
    const int tid = TIDX(), lane = tid & 63, wid = tid >> 6, wr = wid >> 1, wc = wid & 1, fr = lane & 15, fq = lane >> 4;
    u16* R0 = (u16*)smem;
    u16* R1 = R0 + 64 * 72;
    u16* R2 = R1 + 128 * 72;
    u16* P = (u16*)smem;
    float* red = (float*)(smem + (64 + 128 + 128) * 72 * 2);
    float lgf2, lgb2; ret_gammas(p, layer, h, lgf2, lgb2);
    const u16* base = P_px(p) + (long)c * 128 * INC;
    const u16* qbase = base + (long)ih * 64 * INC;
    const u16* Rf = P_R(p) + ((long)(c * 4 + h) * 2 + 0) * 16384;
    const u16* Rb = Rf + 16384;
    f32x4 Y[2][4], T[2][4];
    zero_acc<2>(Y); zero_acc<2>(T);
#pragma unroll 1
    for (int dh = 0; dh < 2; ++dh) {
        __syncthreads();
        stage_n64<64>(R0, 72, qbase + col_qr(h, dh), INC);
        stage_n64<128>(R1, 72, Rf + dh * 64, 128);
        stage_n64<128>(R2, 72, Rb + dh * 64, 128);
        __syncthreads();
        mma_lds64<2>(Y, R0, 72, R1, 72);
        mma_lds64<2>(T, R0, 72, R2, 72);
    }
#pragma unroll
    for (int m = 0; m < 2; ++m)
#pragma unroll
        for (int j = 0; j < 4; ++j) {
            int i = ih * 64 + wr * 32 + m * 16 + fq * 4 + j;
            float xf = exp2f((float)(i + 1) * lgf2), xb = exp2f((float)(128 - i) * lgb2);
#pragma unroll
            for (int n = 0; n < 4; ++n) Y[m][n][j] = xf * Y[m][n][j] + xb * T[m][n][j];
        }
    zero_acc<2>(T);
#pragma unroll 1
    for (int dh = 0; dh < 2; ++dh) {
        __syncthreads();
        stage_n64<64>(R0, 72, qbase + col_qr(h, dh), INC);
        stage_n64<128>(R1, 72, base + col_kr(h, dh), INC);
        __syncthreads();
        mma_lds64<2>(T, R0, 72, R1, 72);
    }
    __syncthreads();
#pragma unroll
    for (int m = 0; m < 2; ++m)
#pragma unroll
        for (int n = 0; n < 4; ++n)
#pragma unroll
            for (int j = 0; j < 4; ++j) {
                int il = wr * 32 + m * 16 + fq * 4 + j, i = ih * 64 + il, jj = wc * 64 + n * 16 + fr;
                float dm = (i >= jj) ? exp2f((float)(i - jj) * lgf2) : exp2f((float)(jj - i) * lgb2);
                P[il * 136 + jj] = f2bf(T[m][n][j] * dm);
            }
#pragma unroll 1
    for (int jh = 0; jh < 2; ++jh) {
        __syncthreads();
        stage_t64<false, 128>(R2, 72, base + (long)jh * 64 * INC + C_VR + h * 128, INC, 1.f);
        __syncthreads();
        mma_lds64<2>(Y, P + jh * 64, 136, R2, 72);
    }
    float mu[2][4], rs[2][4];
#pragma unroll
    for (int m = 0; m < 2; ++m)
#pragma unroll
        for (int j = 0; j < 4; ++j) {
            float s = Y[m][0][j] + Y[m][1][j] + Y[m][2][j] + Y[m][3][j];
            s += __shfl_xor(s, 1); s += __shfl_xor(s, 2); s += __shfl_xor(s, 4); s += __shfl_xor(s, 8);
            if (fr == 0) red[(wr * 32 + m * 16 + fq * 4 + j) * 2 + wc] = s;
        }
    __syncthreads();
#pragma unroll
    for (int m = 0; m < 2; ++m)
#pragma unroll
        for (int j = 0; j < 4; ++j) { int il = wr * 32 + m * 16 + fq * 4 + j; mu[m][j] = (red[il * 2] + red[il * 2 + 1]) * (1.f / 128.f); }
    __syncthreads();
#pragma unroll
    for (int m = 0; m < 2; ++m)
#pragma unroll
        for (int j = 0; j < 4; ++j) {
            float s = 0.f;
#pragma unroll
            for (int n = 0; n < 4; ++n) { float d = Y[m][n][j] - mu[m][j]; s += d * d; }
            s += __shfl_xor(s, 1); s += __shfl_xor(s, 2); s += __shfl_xor(s, 4); s += __shfl_xor(s, 8);
            if (fr == 0) red[(wr * 32 + m * 16 + fq * 4 + j) * 2 + wc] = s;
        }
    __syncthreads();
#pragma unroll
    for (int m = 0; m < 2; ++m)
#pragma unroll
        for (int j = 0; j < 4; ++j) { int il = wr * 32 + m * 16 + fq * 4 + j; rs[m][j] = rsqrtf((red[il * 2] + red[il * 2 + 1]) * (1.f / 128.f) + 1e-6f); }
    const float* gn = p->ret_gn + layer * 512 + h * 128;
#pragma unroll
    for (int m = 0; m < 2; ++m)
#pragma unroll
        for (int n = 0; n < 4; ++n)
#pragma unroll
            for (int j = 0; j < 4; ++j) {
                int i = ih * 64 + wr * 32 + m * 16 + fq * 4 + j, e = wc * 64 + n * 16 + fr;
                long row = (long)c * 128 + i;
                float g = bf2f(P_px(p)[row * INC + C_GR + h * 128 + e]);
                float o = (Y[m][n][j] - mu[m][j]) * rs[m][j] * gn[e] * siluf_(g);
                P_ya(p)[row * 512 + h * 128 + e] = f2bf(o);
            }
    __syncthreads();
}

DI void phF_tile(KP p, int mt, int nt, int b, char* smem) {
    const int tid = TIDX(), lane = tid & 63, wid = tid >> 6, wr = wid >> 1, wc = wid & 1, fr = lane & 15, fq = lane >> 4;
    const int r0 = tid >> 2, ko = (tid & 3) * 8;
    float* macc = P_maccx(p) - (long)NLAT * DM;
    const u16* y = (b == 0 ? P_ya(p) : b == 1 ? P_yb(p) : P_yc(p));
    const u16* w = (b == 0 ? P_wt_ret(p) : b == 1 ? P_wt_win(p) : P_wt_na(p));
    f32x4 acc[4][4]; zero_acc<4>(acc);
    const u16* a0 = y + (long)(mt * 128 + r0) * 512 + ko;
    const u16* b0 = w + (long)(nt * 128 + r0) * 512 + ko;
    gemm_core<16>(acc, a0, a0 + 64 * 512, b0, b0 + 64 * 512, smem);
#pragma unroll
    for (int m = 0; m < 4; ++m)
#pragma unroll
        for (int n = 0; n < 4; ++n)
#pragma unroll
            for (int j = 0; j < 4; ++j) {
                int row = mt * 128 + wr * 64 + m * 16 + fq * 4 + j, col = nt * 128 + wc * 64 + n * 16 + fr;
                float g = bf2f(P_px(p)[(long)row * INC + C_GATE + b * 1024 + col]);
                unsafeAtomicAdd(macc + (long)row * DM + col, acc[m][n][j] * sigmoidf_(g));
            }
}
DI void phG_tile(KP p, int layer, int mt, int nt, char* smem) {
    const int tid = TIDX(), lane = tid & 63, wid = tid >> 6, wr = wid >> 1, wc = wid & 1, fr = lane & 15, fq = lane >> 4;
    f32x4 acc[4][4]; zero_acc<4>(acc);
    const int r0 = tid >> 2, ko = (tid & 3) * 8;
    const float* a0 = P_maccx(p) + (long)((mt - 128) * 128 + r0) * DM + ko;
    const u16* b0 = P_wt_out(p) + (long)(nt * 128 + r0) * DM + ko;
    gemm_core_af32<32>(acc, a0, a0 + 64 * DM, b0, b0 + 64 * DM, smem);
    const bool lat = mt < 128;
    const float* md = P_mod(p) + (layer * 2 + (lat ? 0 : 1)) * 6144 + 2 * 1024;
#pragma unroll
    for (int m = 0; m < 4; ++m)
#pragma unroll
        for (int n = 0; n < 4; ++n)
#pragma unroll
            for (int j = 0; j < 4; ++j) {
                int row = mt * 128 + wr * 64 + m * 16 + fq * 4 + j, col = nt * 128 + wc * 64 + n * 16 + fr;
                const float* xin = resid_row(p, layer, row);
                float* xo = lat ? p->out + (long)row * DM : P_ctxres(p) + (long)(row - NLAT) * DM;
                xo[col] = xin[col] + md[col] * acc[m][n][j];
            }
}


#define LAS __attribute__((address_space(3)))
namespace g8 {
constexpr int BM = 256, BK = 64, HALF = 128, HTB = HALF * BK * 2, STAGE_BYTES = 8 * HTB;
DI int lds_byte(int r, int c) { const int st = (r >> 4) * 2 + (c >> 5), rr = r & 15, cc = c & 31, ob = rr * 64 + cc * 2; return st * 1024 + (ob ^ (((ob >> 9) & 1) << 5)); }
DI void stage_rc(int b, int& R, int& C) { const int st = b / 1024, sb = b % 1024, swz = sb ^ (((sb >> 9) & 1) << 5); R = (st >> 1) * 16 + swz / 64; C = (st & 1) * 32 + (swz % 64) / 2; }
DI int perm32(int rho) { const int n = rho >> 4, i = rho & 15; return 8 * (i >> 2) + 4 * n + (i & 3); }
struct Unit { int pm, pn, aux; };
typedef f32x4 Acc[2][2][4][2];

template <class P>
DI void gemm_phase(LAS unsigned char* lds, const P& prob) {
    const int tid = TID512(), wid = __builtin_amdgcn_readfirstlane(tid >> 6), lane = tid & 63, wr = wid >> 2, wc = wid & 3, fr = lane & 15, fq = lane >> 4;
    constexpr int K = P::K, nt = K / BK;
    int Rr[2], Cc[2];
    unsigned voffA[2], voffB[2];
#pragma unroll
    for (int i = 0; i < 2; ++i) { stage_rc(tid * 16 + i * 8192, Rr[i], Cc[i]); const int Rb = P::PERM ? ((Rr[i] & ~31) + perm32(Rr[i] & 31)) : Rr[i];
        voffA[i] = (unsigned)(Rr[i] * K + Cc[i]) * 2u; voffB[i] = (unsigned)(Rb * K + Cc[i]) * 2u; }
    constexpr size_t kstep = (size_t)(BK * 2);
    constexpr size_t hstep = (size_t)HALF * K * 2;
    const unsigned ldsw = (unsigned)wid * 1024u;
    const int aoff = lds_byte(wr * 64 + fr, fq * 8), boff = lds_byte(wc * 32 + fr, fq * 8);
    unsigned vaC[2][2], vaN[2][2];
#define G8_SA(b, h) (((b) * 2 + (h)) * HTB)
#define G8_SB(b, h) ((4 + (b) * 2 + (h)) * HTB)
#define G8_STAGEA(bufoff, base, VA, h, kt) do { _Pragma("unroll") for (int _i = 0; _i < 2; ++_i) \
        __builtin_amdgcn_global_load_lds((const unsigned*)((base) + (P::GATHER ? (size_t)(VA)[h][_i] : (size_t)voffA[_i] + (size_t)(h) * hstep) + (size_t)(kt) * kstep), (LAS unsigned*)(lds + (bufoff) + ldsw + _i * 8192), 16, 0, 0); } while (0)
#define G8_STAGEB(bufoff, base, h, kt) do { _Pragma("unroll") for (int _i = 0; _i < 2; ++_i) \
        __builtin_amdgcn_global_load_lds((const unsigned*)((base) + (size_t)(h) * hstep + voffB[_i] + (size_t)(kt) * kstep), (LAS unsigned*)(lds + (bufoff) + ldsw + _i * 8192), 16, 0, 0); } while (0)
#define G8_LDA(dst, b, h) do { _Pragma("unroll") for (int m = 0; m < 4; ++m) _Pragma("unroll") for (int k = 0; k < 2; ++k) dst[m][k] = *(const LAS bf16x8*)(lds + G8_SA(b, h) + aoff + m * 2048 + k * 1024); } while (0)
#define G8_LDB(dst, b, h) do { _Pragma("unroll") for (int n = 0; n < 2; ++n) _Pragma("unroll") for (int k = 0; k < 2; ++k) dst[n][k] = *(const LAS bf16x8*)(lds + G8_SB(b, h) + boff + n * 2048 + k * 1024); } while (0)
#define G8_MMA(ai, bj, At, Bt) do { __builtin_amdgcn_s_setprio(1); _Pragma("unroll") for (int m = 0; m < 4; ++m) _Pragma("unroll") for (int n = 0; n < 2; ++n) _Pragma("unroll") for (int k = 0; k < 2; ++k) \
        acc[ai][bj][m][n] = __builtin_amdgcn_mfma_f32_16x16x32_bf16(Bt[n][k], At[m][k], acc[ai][bj][m][n], 0, 0, 0); __builtin_amdgcn_s_setprio(0); } while (0)
#define G8_WAIT_V(n) asm volatile("s_waitcnt vmcnt(" #n ")" ::: "memory")
#define G8_WAIT_L(n) asm volatile("s_waitcnt lgkmcnt(" #n ")" ::: "memory")
#define G8_BAR __builtin_amdgcn_s_barrier()
#define G8_SCHED __builtin_amdgcn_sched_barrier(0)
    Unit cur, nxt; int ui = 0;
    __syncthreads();
    if (!prob.next(0, cur)) return;
    if (P::GATHER) prob.gather(cur, Rr, Cc, vaC);
    const char* cA = prob.a_base(cur); const char* cB = prob.b_base(cur);
    Acc acc;
#pragma unroll
    for (int a = 0; a < 2; ++a)
#pragma unroll
        for (int b = 0; b < 2; ++b)
#pragma unroll
            for (int m = 0; m < 4; ++m)
#pragma unroll
                for (int n = 0; n < 2; ++n) acc[a][b][m][n] = (f32x4){0.f, 0.f, 0.f, 0.f};
    bf16x8 At[4][2], B0[2][2], B1[2][2];
    G8_STAGEB(G8_SB(0, 0), cB, 0, 0); G8_STAGEA(G8_SA(0, 0), cA, vaC, 0, 0); G8_STAGEB(G8_SB(0, 1), cB, 1, 0); G8_STAGEA(G8_SA(0, 1), cA, vaC, 1, 0);
    if (wr == 1) G8_BAR;
    G8_WAIT_V(4); G8_BAR;
    G8_STAGEB(G8_SB(1, 0), cB, 0, 1); G8_STAGEA(G8_SA(1, 0), cA, vaC, 0, 1); G8_STAGEB(G8_SB(1, 1), cB, 1, 1);
    G8_WAIT_V(6); G8_BAR;
    for (;;) {
        const bool has_next = prob.next(ui + 1, nxt);
        if (!has_next) nxt = cur;
        if (P::GATHER) {
            if (has_next) prob.gather(nxt, Rr, Cc, vaN);
            else {
#pragma unroll
                for (int h = 0; h < 2; ++h) { vaN[h][0] = vaC[h][0]; vaN[h][1] = vaC[h][1]; }
            }
        }
        const char* nA = prob.a_base(nxt); const char* nB = prob.b_base(nxt);
#pragma unroll 1
        for (int t = 0; t < nt; t += 2) {
            const bool last = (t == nt - 2);
            const char* a2 = last ? nA : cA; const char* b2 = last ? nB : cB; const int k2 = last ? 0 : t + 2;
            unsigned va2[2][2];
#pragma unroll
            for (int h = 0; h < 2; ++h) { va2[h][0] = last ? vaN[h][0] : vaC[h][0]; va2[h][1] = last ? vaN[h][1] : vaC[h][1]; }
            G8_LDB(B0, 0, 0); G8_SCHED; G8_LDA(At, 0, 0); G8_STAGEA(G8_SA(1, 1), cA, vaC, 1, t + 1);
            G8_WAIT_L(8); G8_BAR; G8_WAIT_L(0); G8_MMA(0, 0, At, B0); G8_BAR; G8_SCHED;
            G8_LDB(B1, 0, 1); G8_STAGEB(G8_SB(0, 0), b2, 0, k2);
            G8_BAR; G8_WAIT_L(0); G8_MMA(0, 1, At, B1); G8_BAR;
            G8_LDA(At, 0, 1); G8_STAGEA(G8_SA(0, 0), a2, va2, 0, k2);
            G8_BAR; G8_WAIT_L(0); G8_MMA(1, 0, At, B0); G8_BAR; G8_SCHED;
            G8_STAGEB(G8_SB(0, 1), b2, 1, k2);
            G8_WAIT_V(6); G8_BAR; G8_MMA(1, 1, At, B1); G8_BAR;
            G8_LDB(B0, 1, 0); G8_SCHED; G8_LDA(At, 1, 0); G8_STAGEA(G8_SA(0, 1), a2, va2, 1, k2);
            G8_WAIT_L(8); G8_BAR; G8_WAIT_L(0); G8_MMA(0, 0, At, B0); G8_BAR; G8_SCHED;
            G8_LDB(B1, 1, 1); G8_STAGEB(G8_SB(1, 0), b2, 0, k2 + 1);
            G8_BAR; G8_WAIT_L(0); G8_MMA(0, 1, At, B1); G8_BAR;
            G8_LDA(At, 1, 1); G8_STAGEA(G8_SA(1, 0), a2, va2, 0, k2 + 1);
            G8_BAR; G8_WAIT_L(0); G8_MMA(1, 0, At, B0); G8_BAR; G8_SCHED;
            G8_STAGEB(G8_SB(1, 1), b2, 1, k2 + 1);
            G8_WAIT_V(6); G8_BAR; G8_MMA(1, 1, At, B1); G8_BAR;
        }
        { const int l2 = TID512() & 63; prob.epi(acc, cur, wr, wc, l2 & 15, l2 >> 4); }
        if (!has_next) break;
#pragma unroll
        for (int a = 0; a < 2; ++a)
#pragma unroll
            for (int b = 0; b < 2; ++b)
#pragma unroll
                for (int m = 0; m < 4; ++m)
#pragma unroll
                    for (int n = 0; n < 2; ++n) acc[a][b][m][n] = (f32x4){0.f, 0.f, 0.f, 0.f};
        cur = nxt; cA = nA; cB = nB; ++ui;
        if (P::GATHER) {
#pragma unroll
            for (int h = 0; h < 2; ++h) { vaC[h][0] = vaN[h][0]; vaC[h][1] = vaN[h][1]; }
        }
    }
    G8_WAIT_V(0);
    if (wr == 0) G8_BAR;
    G8_BAR;
#undef G8_SA
#undef G8_SB
#undef G8_STAGEA
#undef G8_STAGEB
#undef G8_LDA
#undef G8_LDB
#undef G8_MMA
#undef G8_WAIT_V
#undef G8_WAIT_L
#undef G8_BAR
#undef G8_SCHED
}
}

struct ProbG {
    static constexpr int K = 1024; static constexpr bool PERM = false, GATHER = false;
    KP p; int layer;
    DI bool next(int i, g8::Unit& u) const {
        const int id = i * (int)gridDim.x + BIDX();
        if (id >= 256) return false;
        u.pm = id >> 2; u.pn = id & 3; u.aux = 0;
        return true;
    }
    DI const char* a_base(const g8::Unit& u) const { return (const char*)(P_hx(p) + (long)u.pm * 256 * DM); }
    DI const char* b_base(const g8::Unit& u) const { return (const char*)(P_wt_out(p) + (long)u.pn * 256 * DM); }
    DI void gather(const g8::Unit&, const int (&)[2], const int (&)[2], unsigned (&)[2][2]) const {}
    DI void epi(g8::Acc& acc, const g8::Unit& u, int wr, int wc, int fr, int fq) const {
        const float* xin = layer == 0 ? p->x : p->out;
        const float* md = P_mod(p) + (layer * 2) * 6144 + 2 * 1024;
#pragma unroll
        for (int bj = 0; bj < 2; ++bj)
#pragma unroll
            for (int n = 0; n < 2; ++n) {
                const int col = u.pn * 256 + bj * 128 + wc * 32 + n * 16 + fq * 4;
                const f32x4 mv = *(const f32x4*)(md + col);
#pragma unroll
                for (int ai = 0; ai < 2; ++ai)
#pragma unroll
                    for (int m = 0; m < 4; ++m) {
                        const long row = (long)u.pm * 256 + ai * 128 + wr * 64 + m * 16 + fr;
                        const f32x4 xv = *(const f32x4*)(xin + row * DM + col);
                        *(f32x4*)(p->out + row * DM + col) = xv + mv * acc[ai][bj][m][n];
                    }
            }
    }
};


struct ProbB {
    static constexpr int K = 1024; static constexpr bool PERM = true, GATHER = false;
    KP p;
    DI bool next(int i, g8::Unit& u) const {
        constexpr int nM = 65, nN = 29, nwg = nM * nN, NX = 8, WGM = 8;
        const long L = (long)i * (int)gridDim.x + BIDX(); if (L >= nwg) return false;
        int wgid = (int)L; { const int q = nwg / NX, r = nwg % NX, xcd = wgid % NX, off = wgid / NX; wgid = (xcd < r ? xcd * (q + 1) : r * (q + 1) + (xcd - r) * q) + off; }
        const int nig = WGM * nN, gid = wgid / nig, fm = gid * WGM, gsz = (nM - fm) < WGM ? (nM - fm) : WGM;
        u.pm = fm + ((wgid % nig) % gsz); u.pn = (wgid % nig) / gsz; u.aux = 0; return true;
    }
    DI const char* a_base(const g8::Unit& u) const { return (const char*)(P_hx(p) + (long)u.pm * 256 * DM); }
    DI const char* b_base(const g8::Unit& u) const { return (const char*)(P_wt_in(p) + (long)u.pn * 256 * DM); }
    DI void gather(const g8::Unit&, const int (&)[2], const int (&)[2], unsigned (&)[2][2]) const {}
    DI void epi(g8::Acc& acc, const g8::Unit& u, int wr, int wc, int fr, int fq) const {
        const int pn = u.pn;
        const bool lat = u.pm < 64;
        const int rk = !lat ? 0 : (pn < 4) ? 1 : (pn == 8 || pn == 9 || (pn == 10 && wc < 2)) ? 2 : 0;
        const float mul = (pn == 2 || pn == 3) ? 0.08838834764831845f : (pn == 8 || pn == 9 || pn == 11 || pn == 12) ? 0.125f : 1.f;
#pragma unroll
        for (int ai = 0; ai < 2; ++ai)
#pragma unroll
            for (int m = 0; m < 4; ++m) {
                const int row = u.pm * 256 + ai * 128 + wr * 64 + m * 16 + fr;
                if (rk != 0) {
                    const float2* tab;
                    if (rk == 1) tab = P_rope128(p) + ((wc & 1) ? (row & 63) : (row >> 6)) * 32 + fq * 8;
                    else tab = P_rope64(p) + ((fq >= 2) ? (row & 63) : (row >> 6)) * 16 + (fq & 1) * 8;
#pragma unroll
                    for (int n = 0; n < 2; ++n) {
                        const f32x4 c01 = *(const f32x4*)(tab + n * 4), c23 = *(const f32x4*)(tab + n * 4 + 2);
                        const float cs_[4] = {c01[0], c01[2], c23[0], c23[2]}, sn_[4] = {c01[1], c01[3], c23[1], c23[3]};
#pragma unroll
                        for (int e = 0; e < 4; ++e) {
                            const float x1 = acc[ai][0][m][n][e], x2 = acc[ai][1][m][n][e];
                            acc[ai][0][m][n][e] = x1 * cs_[e] - x2 * sn_[e];
                            acc[ai][1][m][n][e] = x1 * sn_[e] + x2 * cs_[e];
                        }
                    }
                }
                u16* orow = P_px(p) + (long)row * INC + pn * 256 + wc * 32 + fq * 8;
#pragma unroll
                for (int bj = 0; bj < 2; ++bj) {
                    u32x4 o;
#pragma unroll
                    for (int n = 0; n < 2; ++n)
#pragma unroll
                        for (int e = 0; e < 2; ++e) o[2 * n + e] = pack2(acc[ai][bj][m][n][2 * e] * mul, acc[ai][bj][m][n][2 * e + 1] * mul);
                    *(u32x4*)(orow + bj * 128) = o;
                }
            }
    }
};
struct ProbF {
    static constexpr int K = 512; static constexpr bool PERM = true, GATHER = false;
    KP p;
    DI bool next(int i, g8::Unit& u) const {
        const int tile = (i / 3) * (int)gridDim.x + BIDX();
        if (tile >= 256) return false;
        u.pm = tile >> 2; u.pn = tile & 3; u.aux = i % 3;
        return true;
    }
    DI const char* a_base(const g8::Unit& u) const { const u16* y = u.aux == 0 ? P_ya(p) : u.aux == 1 ? P_yb(p) : P_yc(p); return (const char*)(y + (long)u.pm * 256 * 512); }
    DI const char* b_base(const g8::Unit& u) const { const u16* w = u.aux == 0 ? P_wt_ret(p) : u.aux == 1 ? P_wt_win(p) : P_wt_na(p); return (const char*)(w + (long)u.pn * 256 * 512); }
    DI void gather(const g8::Unit&, const int (&)[2], const int (&)[2], unsigned (&)[2][2]) const {}
    DI void epi(g8::Acc& acc, const g8::Unit& u, int wr, int wc, int fr, int fq) const {
        const int b = u.aux;
        const long row0 = (long)u.pm * 256 + wr * 64 + fr;
        const int col0 = u.pn * 256 + wc * 32 + fq * 8;
        if (b != 2) {
            u16* z = P_z(p) + (long)b * NLAT * DM;
#pragma unroll
            for (int ai = 0; ai < 2; ++ai)
#pragma unroll
                for (int m = 0; m < 4; ++m)
#pragma unroll
                    for (int bj = 0; bj < 2; ++bj) {
                        u32x4 o;
#pragma unroll
                        for (int n = 0; n < 2; ++n)
#pragma unroll
                            for (int e = 0; e < 2; ++e) o[2 * n + e] = pack2(acc[ai][bj][m][n][2 * e], acc[ai][bj][m][n][2 * e + 1]);
                        *(u32x4*)(z + (row0 + ai * 128 + m * 16) * DM + col0 + bj * 128) = o;
                    }
            return;
        }
        const u16* zb = P_z(p);
        const u16* gp = P_px(p) + C_GATE;
#pragma unroll
        for (int ai = 0; ai < 2; ++ai)
#pragma unroll
            for (int m = 0; m < 4; ++m)
#pragma unroll
                for (int bj = 0; bj < 2; ++bj) {
                    const long row = row0 + ai * 128 + m * 16; const int col = col0 + bj * 128;
                    u32x4 zv[2], gv[3];
#pragma unroll
                    for (int q = 0; q < 2; ++q) zv[q] = *(const u32x4*)(zb + ((long)q * NLAT + row) * DM + col);
#pragma unroll
                    for (int q = 0; q < 3; ++q) gv[q] = *(const u32x4*)(gp + row * INC + q * 1024 + col);
                    u32x4 o;
#pragma unroll
                    for (int e = 0; e < 4; ++e) {
                        const int n = e >> 1, e2 = (e & 1) * 2;
                        float lo = acc[ai][bj][m][n][e2] * sigmoidf_(bflo(gv[2][e])), hi = acc[ai][bj][m][n][e2 + 1] * sigmoidf_(bfhi(gv[2][e]));
#pragma unroll
                        for (int q = 0; q < 2; ++q) { lo += bflo(zv[q][e]) * sigmoidf_(bflo(gv[q][e])); hi += bfhi(zv[q][e]) * sigmoidf_(bfhi(gv[q][e])); }
                        o[e] = pack2(lo, hi);
                    }
                    *(u32x4*)(P_hx(p) + row * DM + col) = o;
                }
    }
};
struct ProbJ {
    static constexpr int K = 1024; static constexpr bool PERM = true, GATHER = true;
    KP p;
    DI bool next(int i, g8::Unit& u) const {
        const int id = i * (int)gridDim.x + BIDX();
        if (id >= 1024) return false;
        u.aux = id >> 6; u.pm = (id >> 3) & 7; u.pn = id & 7;
        return true;
    }
    DI const char* a_base(const g8::Unit&) const { return (const char*)P_hx(p); }
    DI const char* b_base(const g8::Unit& u) const { return (const char*)(P_wt_gu(p) + ((long)u.aux * 2048 + u.pn * 256) * DM); }
    DI void gather(const g8::Unit& u, const int (&R)[2], const int (&C)[2], unsigned (&va)[2][2]) const {
        const int* si = P_sel_idx(p) + u.aux * 2048 + u.pm * 256;
#pragma unroll
        for (int h = 0; h < 2; ++h)
#pragma unroll
            for (int j = 0; j < 2; ++j) va[h][j] = (unsigned)(si[h * 128 + R[j]] * DM + C[j]) * 2u;
    }
    DI void epi(g8::Acc& acc, const g8::Unit& u, int wr, int wc, int fr, int fq) const {
        u16* hb = P_hid(p) + (long)u.aux * 2048 * EH;
#pragma unroll
        for (int ai = 0; ai < 2; ++ai)
#pragma unroll
            for (int m = 0; m < 4; ++m) {
                const int slot = u.pm * 256 + ai * 128 + wr * 64 + m * 16 + fr;
                const int f = u.pn * 128 + wc * 32 + fq * 8;
                u32x4 o;
#pragma unroll
                for (int n = 0; n < 2; ++n)
#pragma unroll
                    for (int e = 0; e < 2; ++e)
                        o[2 * n + e] = pack2(siluf_(acc[ai][0][m][n][2 * e]) * acc[ai][1][m][n][2 * e], siluf_(acc[ai][0][m][n][2 * e + 1]) * acc[ai][1][m][n][2 * e + 1]);
                *(u32x4*)(hb + (long)slot * EH + f) = o;
            }
    }
};
struct ProbK {
    static constexpr int K = 1024; static constexpr bool PERM = true, GATHER = false;
    KP p; int layer;
    DI bool next(int i, g8::Unit& u) const {
        const int id = i * (int)gridDim.x + BIDX();
        if (id >= 512) return false;
        u.aux = id >> 5; u.pm = (id >> 2) & 7; u.pn = id & 3;
        return true;
    }
    DI const char* a_base(const g8::Unit& u) const { return (const char*)(P_hid(p) + ((long)u.aux * 2048 + u.pm * 256) * EH); }
    DI const char* b_base(const g8::Unit& u) const { return (const char*)(P_wt_dn(p) + ((long)u.aux * 1024 + u.pn * 256) * EH); }
    DI void gather(const g8::Unit&, const int (&)[2], const int (&)[2], unsigned (&)[2][2]) const {}
    DI void epi(g8::Acc& acc, const g8::Unit& u, int wr, int wc, int fr, int fq) const {
        const float* md = P_mod(p) + (layer * 2) * 6144 + 5 * 1024;
        f32x4 mv[2][2];
#pragma unroll
        for (int bj = 0; bj < 2; ++bj)
#pragma unroll
            for (int n = 0; n < 2; ++n) mv[bj][n] = *(const f32x4*)(md + u.pn * 256 + bj * 128 + wc * 32 + fq * 8 + n * 4);
#pragma unroll
        for (int ai = 0; ai < 2; ++ai)
#pragma unroll
            for (int m = 0; m < 4; ++m) {
                const int slot = u.aux * 2048 + u.pm * 256 + ai * 128 + wr * 64 + m * 16 + fr;
                const float g = P_sel_gate(p)[slot];
                u16* yr = P_ye(p) + (long)slot * DM + u.pn * 256 + wc * 32 + fq * 8;
#pragma unroll
                for (int bj = 0; bj < 2; ++bj) {
                    u32x4 o;
#pragma unroll
                    for (int n = 0; n < 2; ++n)
#pragma unroll
                        for (int e = 0; e < 2; ++e)
                            o[2 * n + e] = pack2(acc[ai][bj][m][n][2 * e] * g * mv[bj][n][2 * e], acc[ai][bj][m][n][2 * e + 1] * g * mv[bj][n][2 * e + 1]);
                    *(u32x4*)(yr + bj * 128) = o;
                }
            }
    }
};

DI void phH_item(KP p, int layer, int item, char* smem) {
    const int lane = TIDX() & 63, wid = TIDX() >> 6;
    float* hrow = (float*)smem + wid * 4096;
    const int row0 = item * 16 + wid * 4;
#pragma unroll
    for (int r = 0; r < 4; ++r) norm_row(p, layer, row0 + r, cur_row(p, row0 + r), p->g_ffn + layer * DM, 3, 4, P_hx(p) + (long)(row0 + r) * DM, hrow + r * 1024, nullptr);
    const int e = lane & 15, kp = lane >> 4;
    const float* wr_ = p->w_router + (long)layer * 1024 * 16 + e;
    float lg[4] = {0.f, 0.f, 0.f, 0.f};
#pragma unroll 8
    for (int k = kp * 256; k < kp * 256 + 256; ++k) {
        float w = wr_[k * 16];
#pragma unroll
        for (int r = 0; r < 4; ++r) lg[r] += hrow[r * 1024 + k] * w;
    }
#pragma unroll
    for (int r = 0; r < 4; ++r) {
        float l = lg[r];
        l += __shfl_xor(l, 16); l += __shfl_xor(l, 32);
        float mx = l;
        mx = fmaxf(mx, __shfl_xor(mx, 1)); mx = fmaxf(mx, __shfl_xor(mx, 2)); mx = fmaxf(mx, __shfl_xor(mx, 4)); mx = fmaxf(mx, __shfl_xor(mx, 8));
        float ex = expf(l - mx);
        float sm = ex;
        sm += __shfl_xor(sm, 1); sm += __shfl_xor(sm, 2); sm += __shfl_xor(sm, 4); sm += __shfl_xor(sm, 8);
        float a = ex / sm;
        int row = row0 + r;
        if (lane < 16) {
            if (row < NLAT) P_aff(p)[(long)e * NLAT + row] = a;
            else P_aff(p)[(long)(16 + e) * NLAT + (row - NLAT)] = a;
        }
    }
    __syncthreads();
}

DI int block_excl_scan(int v, int* sh  , int& total) {
    const int lane = TIDX() & 63, wid = TIDX() >> 6;
    int inc = v;
    for (int o = 1; o < 64; o <<= 1) { int t = __shfl_up(inc, o); if (lane >= o) inc += t; }
    __syncthreads();
    if (lane == 63) sh[wid] = inc;
    __syncthreads();
    int base = 0;
    for (int w = 0; w < wid; ++w) base += sh[w];
    total = sh[0] + sh[1] + sh[2] + sh[3];
    return base + inc - v;
}
DI void phI_item(KP p, int job, char* smem) {
    const int tid = TIDX(), lane = tid & 63, wid = tid >> 6;
    const bool lat = job < 16;
    const int n = lat ? NLAT : NCTX, cap = lat ? CAP_LAT : CAP_CTX, rowbase = lat ? 0 : NLAT;
    int* sh = (int*)smem;
    const float* a = P_aff(p) + (long)job * NLAT;
    unsigned keys[64];
    if (lat) {
#pragma unroll
        for (int i = 0; i < 16; ++i) { u32x4 v = *(const u32x4*)(a + tid * 64 + i * 4); keys[4 * i] = v[0]; keys[4 * i + 1] = v[1]; keys[4 * i + 2] = v[2]; keys[4 * i + 3] = v[3]; }
    } else {
#pragma unroll
        for (int i = 0; i < 64; ++i) keys[i] = 0u;
        keys[0] = __float_as_uint(a[tid]);
    }
    __syncthreads();
    auto block_sum = [&](int v, int it) -> int {
        for (int o = 32; o > 0; o >>= 1) v += __shfl_xor(v, o);
        int* slot = sh + (it & 1) * 4;
        if (lane == 0) slot[wid] = v;
        __syncthreads();
        return slot[0] + slot[1] + slot[2] + slot[3];
    };
    unsigned T = 0u;
    int it = 0;
    for (int bit = 29; bit >= 0; --bit, ++it) {
        const unsigned cand = T | (1u << bit);
        int c = 0;
#pragma unroll
        for (int i = 0; i < 64; ++i) c += (keys[i] >= cand);
        if (block_sum(c, it) >= cap) T = cand;
    }
    int cgt = 0, ceq = 0;
#pragma unroll
    for (int i = 0; i < 64; ++i) { cgt += (keys[i] > T); ceq += (keys[i] == T); }
    const int remaining = cap - block_sum(cgt, it);
    __syncthreads();
    int tot;
    int er = block_excl_scan(ceq, sh + 8, tot);
    int csel = 0;
    { int e2 = er;
#pragma unroll
      for (int i = 0; i < 64; ++i) { const unsigned k = keys[i]; if (k > T) ++csel; else if (k == T) { if (e2 < remaining) ++csel; ++e2; } } }
    int slot = block_excl_scan(csel, sh + 8, tot);
    int* ts = P_tslot(p) + (long)job * NLAT;
    const int per = lat ? 64 : 1;
    const int base = tid * per;
#pragma unroll
    for (int i = 0; i < 64; ++i) {
        if (i < per) {
            const unsigned k = keys[i];
            bool sel = false;
            if (k > T) sel = true; else if (k == T) { sel = er < remaining; ++er; }
            if (sel) { P_sel_idx(p)[job * 2048 + slot] = rowbase + base + i; P_sel_gate(p)[job * 2048 + slot] = __uint_as_float(k); ts[base + i] = slot; ++slot; }
            else ts[base + i] = -1;
        }
    }
    __syncthreads();
}

DI void phJ_tile(KP p, int job, int mt, int nt, char* smem) {
    const int tid = TIDX(), lane = tid & 63, wid = tid >> 6, wr = wid >> 1, wc = wid & 1, fr = lane & 15, fq = lane >> 4;
    const int cap = job < 16 ? CAP_LAT : CAP_CTX, e = job & 15;
    f32x4 acc[4][4]; zero_acc<4>(acc);
    const int r0 = tid >> 2, ko = (tid & 3) * 8;
    int s0 = mt * 128 + r0, s1 = s0 + 64;
    s0 = s0 < cap ? s0 : cap - 1; s1 = s1 < cap ? s1 : cap - 1;
    const u16* a0 = P_hx(p) + (long)P_sel_idx(p)[job * 2048 + s0] * DM + ko;
    const u16* a1 = P_hx(p) + (long)P_sel_idx(p)[job * 2048 + s1] * DM + ko;
    const int f_lo = nt * 64 + (r0 & 31), f_hi = f_lo + 32, gu = (r0 >> 5) & 1;
    const u16* b0 = P_wt_gu(p) + ((long)e * 2048 + (f_lo >> 7) * 256 + gu * 128 + (f_lo & 127)) * DM + ko;
    const u16* b1 = P_wt_gu(p) + ((long)e * 2048 + (f_hi >> 7) * 256 + gu * 128 + (f_hi & 127)) * DM + ko;
    gemm_core<32>(acc, a0, a1, b0, b1, smem);
    u16* hb = job < 16 ? P_hid(p) + (long)job * 2048 * EH : P_hidc(p) + (long)(job - 16) * 32 * EH;
#pragma unroll
    for (int m = 0; m < 4; ++m)
#pragma unroll
        for (int n = 0; n < 2; ++n)
#pragma unroll
            for (int j = 0; j < 4; ++j) {
                int slot = mt * 128 + wr * 64 + m * 16 + fq * 4 + j;
                int f = nt * 64 + wc * 32 + n * 16 + fr;
                if (slot < cap) hb[(long)slot * EH + f] = f2bf(siluf_(acc[m][n][j]) * acc[m][n + 2][j]);
            }
}
DI void phK_tile(KP p, int layer, int job, int mt, int nt, char* smem) {
    const int tid = TIDX(), lane = tid & 63, wid = tid >> 6, wr = wid >> 1, wc = wid & 1, fr = lane & 15, fq = lane >> 4;
    const int cap = job < 16 ? CAP_LAT : CAP_CTX, e = job & 15;
    f32x4 acc[4][4]; zero_acc<4>(acc);
    const int r0 = tid >> 2, ko = (tid & 3) * 8;
    int s0 = mt * 128 + r0, s1 = s0 + 64;
    s0 = s0 < cap ? s0 : cap - 1; s1 = s1 < cap ? s1 : cap - 1;
    const u16* hb = job < 16 ? P_hid(p) + (long)job * 2048 * EH : P_hidc(p) + (long)(job - 16) * 32 * EH;
    const u16* a0 = hb + (long)s0 * EH + ko;
    const u16* a1 = hb + (long)s1 * EH + ko;
    const u16* b0 = P_wt_dn(p) + ((long)e * 1024 + nt * 128 + r0) * EH + ko;
    gemm_core<32>(acc, a0, a1, b0, b0 + 64 * EH, smem);
    const float* md = P_mod(p) + (layer * 2 + (job < 16 ? 0 : 1)) * 6144 + 5 * 1024;
    u16* yb_ = job < 16 ? P_ye(p) + (long)job * 2048 * DM : P_yec(p) + (long)(job - 16) * 32 * DM;
#pragma unroll
    for (int m = 0; m < 4; ++m)
#pragma unroll
        for (int j = 0; j < 4; ++j) {
            int slot = mt * 128 + wr * 64 + m * 16 + fq * 4 + j;
            if (slot < cap) {
                float g = P_sel_gate(p)[job * 2048 + slot];
#pragma unroll
                for (int n = 0; n < 4; ++n) {
                    int col = nt * 128 + wc * 64 + n * 16 + fr;
                    yb_[(long)slot * DM + col] = f2bf(acc[m][n][j] * g * md[col]);
                }
            }
        }
}


#define XB_TMO      128
#define XB_XCNT(j)  (256  + 64 * (j))
#define XB_XSUB(j)  (1280 + 64 * (j))
#define XB_XGEN(j)  (2304 + 64 * (j))
#define XB_TOP      3328
#define XB_TOPGEN   3392
#define XCD_BAR_WORDS 3456
#define XB_SPIN_CAP (1u << 18)
DI unsigned xb_ld(unsigned* p)              { return __hip_atomic_load(p, __ATOMIC_RELAXED, __HIP_MEMORY_SCOPE_AGENT); }
DI unsigned xb_add(unsigned* p, unsigned v) { return __hip_atomic_fetch_add(p, v, __ATOMIC_RELAXED, __HIP_MEMORY_SCOPE_AGENT); }
DI unsigned xb_xcc_id() { return (unsigned)__builtin_amdgcn_s_getreg((3 << 11) | 20) & 0xFu; }
#define XB_SPIN(cond, bar) do { unsigned _sp = 0; while (cond) { __builtin_amdgcn_s_sleep(1); \
    if ((++_sp & 255u) == 0u) { if (xb_ld(&(bar)[XB_TMO])) break; if (_sp > XB_SPIN_CAP) { atomicAdd(&(bar)[XB_TMO], 1u); break; } } } } while (0)
struct XcdBarrier { unsigned* bar; unsigned x; volatile LAS unsigned* st; };
DI XcdBarrier xcd_barrier_post(unsigned* bar, volatile LAS unsigned* st) {
    XcdBarrier b; b.bar = bar; b.x = xb_xcc_id(); b.st = st;
    if (threadIdx.x == 0) (void)xb_add(&bar[XB_XCNT(b.x)], 1u);
    return b;
}
DI void xcd_barrier_complete(unsigned* bar, unsigned x, unsigned& nloc, unsigned& nx) {
    const unsigned G = gridDim.x * gridDim.y * gridDim.z;
    unsigned sum, cnt, mine, sp = 0u;
    for (;;) {
        sum = 0u; cnt = 0u; mine = 0u;
#pragma unroll
        for (unsigned j = 0; j < 16; ++j) { const unsigned c = xb_ld(&bar[XB_XCNT(j)]); sum += c; cnt += (c > 0u) ? 1u : 0u; mine = (j == x) ? c : mine; }
        if (sum == G) break;
        __builtin_amdgcn_s_sleep(1);
        if ((++sp & 255u) == 0u) { if (xb_ld(&bar[XB_TMO])) break; if (sp > XB_SPIN_CAP) { atomicAdd(&bar[XB_TMO], 1u); break; } }
    }
    nloc = mine > 0u ? mine : 1u; nx = cnt > 0u ? cnt : 1u;
}
DI void xcd_barrier(const XcdBarrier& b) {
    asm volatile("s_waitcnt vmcnt(0)" ::: "memory");
    __syncthreads();
    if (threadIdx.x == 0) {
        unsigned* bar = b.bar;
        __builtin_amdgcn_s_waitcnt(0);
        unsigned nloc = b.st[0], nx = b.st[1];
        if (nloc == 0u) { xcd_barrier_complete(bar, b.x, nloc, nx); b.st[0] = nloc; b.st[1] = nx; }
        const unsigned old = xb_add(&bar[XB_XSUB(b.x)], 1u);
        const unsigned gen = old / nloc;
        if (old + 1u == (gen + 1u) * nloc) {
            __builtin_amdgcn_fence(__ATOMIC_RELEASE, "agent");
            asm volatile("s_waitcnt vmcnt(0)" ::: "memory");
            const unsigned og = xb_add(&bar[XB_TOP], 1u);
            const unsigned tg = og / nx;
            if (og + 1u == (tg + 1u) * nx) xb_add(&bar[XB_TOPGEN], 1u);
            else XB_SPIN(xb_ld(&bar[XB_TOPGEN]) == tg, bar);
            __builtin_amdgcn_fence(__ATOMIC_ACQUIRE, "agent");
            xb_add(&bar[XB_XGEN(b.x)], 1u);
            asm volatile("s_waitcnt vmcnt(0)" ::: "memory");
        } else {
            XB_SPIN(xb_ld(&bar[XB_XGEN(b.x)]) == gen, bar);
            __builtin_amdgcn_fence(__ATOMIC_ACQUIRE, "agent");
            asm volatile("s_waitcnt vmcnt(0)" ::: "memory");
        }
    }
    __syncthreads();
}

DI void run_phase(int ph, char* smem_all, int variant = 0) {
    KP p = (KP)__builtin_amdgcn_kernarg_segment_ptr();
    asm volatile("" : "+s"(p));
    const int sb = TID512() >> 8;
    char* smem = smem_all + sb * SUB_LDS;
    const int bid = BIDX() * 2 + sb, nb = gridDim.x * 2, tid = TIDX(), wid = tid >> 6;
#ifndef ONLY_SUB
    if (ph == 0) {
        const int total = 192 + 48 + CONV_DENSE;
        for (int it = bid; it < total; it += nb) {
            if (it < 192) ph0_gemv_item(p, it, smem);
            else if (it < 240) ph0_rope_item(p, it - 192);
            else convert_tile(p, 0, it - 240, smem);
        }
        return;
    }
    if (ph == NPHASE - 1) {
        for (int it = bid; it < NLAT / 4; it += nb) {
            int row = it * 4 + wid, lane = tid & 63;
            float* xr = p->out + (long)row * DM;
            float4 v[4]; float ss = 0.f;
#pragma unroll
            for (int i = 0; i < 4; ++i) v[i] = *(const float4*)(xr + i * 256 + lane * 4);
            moe_combine(p, row, v);
#pragma unroll
            for (int i = 0; i < 4; ++i) ss += v[i].x * v[i].x + v[i].y * v[i].y + v[i].z * v[i].z + v[i].w * v[i].w;
            ss = wave_sum(ss);
            float rstd = rsqrtf(ss * (1.f / DM) + 1e-6f);
#pragma unroll
            for (int i = 0; i < 4; ++i) {
                float4 g = *(const float4*)(p->g_final + i * 256 + lane * 4);
                *(float4*)(xr + i * 256 + lane * 4) = make_float4(v[i].x * rstd * g.x, v[i].y * rstd * g.y, v[i].z * rstd * g.z, v[i].w * rstd * g.w);
            }
        }
        return;
    }
    const int layer = (ph - 1) / 11, sub = (ph - 1) % 11;
#else
    const int layer = (ph - 1) / 11, sub = ONLY_SUB;
#endif
    const bool need_ctx = layer == 0;
    switch (sub) {
    case 0: {
        const int nrow_items = NROWS / 4;
        const int total = nrow_items + (layer == 1 ? CONV_DENSE : 0);
        for (int it = bid; it < total; it += nb) {
            if (it < nrow_items) { int row = it * 4 + wid; norm_row(p, layer, row, resid_row(p, layer, row), p->g_mix + layer * DM, 0, 1, P_hx(p) + (long)row * DM, nullptr, layer == 1 ? (float*)cur_row(p, row) : nullptr); }
            else convert_tile(p, layer, it - nrow_items, smem);
        }
    } break;
    case 1: {
        ProbB pb{p}; g8::gemm_phase((LAS unsigned char*)smem_all, pb);
    } break;
    case 2: {
        const int n_state = NCHUNK * 8, n_win = 1024, n_na = 1024, n_cx = need_ctx ? 32 : 0;
        const int total = n_state + n_win + n_na + n_cx;
        for (int it = bid; it < total; it += nb) {
            if (variant == 1 && it >= n_na && it < n_na + n_win) continue;
            if (variant == 1 && it >= n_na + n_win) continue;
            if (variant == 2 && (it < n_na || it >= n_na + n_win)) continue;
            if (variant == 3 && (it < n_na + n_win || it >= n_na + n_win + n_state)) continue;
            if (it < n_na) attn_block_item(p, layer, 1, it >> 3, it & 7, smem);
            else if (it < n_na + n_win) { int i2 = it - n_na; attn_block_item(p, layer, 0, i2 >> 1, i2 & 1, smem); }
            else if (it < n_win + n_na + n_state) { int i2 = it - n_win - n_na; phC_state_item(p, layer, i2 >> 3, (i2 >> 1) & 3, i2 & 1, smem); }
            else { int i2 = it - n_win - n_na - n_state; if (i2 < 16) attn_block_item(p, layer, 2, i2 >> 1, i2 & 1, smem); else { i2 -= 16; attn_block_item(p, layer, 3, i2 >> 3, i2 & 7, smem); } }
        }
    } break;
    case 3: {
        for (int it = bid; it < 512; it += nb) phD_item(p, layer, it);
    } break;
    case 4: {
        const int nch = need_ctx ? NCHUNK : 128;
        for (int it = bid; it < nch * 8; it += nb) phE_item(p, layer, it >> 3, (it >> 1) & 3, it & 1, smem);
        if (need_ctx && bid >= nb - 64) {
            float* z = P_maccx(p) + (long)(bid - (nb - 64)) * 4096 + tid * 16;
#pragma unroll
            for (int i = 0; i < 4; ++i) *(f32x4*)(z + i * 4) = f32x4{0.f, 0.f, 0.f, 0.f};
        }
    } break;
    case 5: {
        { ProbF pf{p}; g8::gemm_phase((LAS unsigned char*)smem_all, pf); }
        if (need_ctx) {
            const int sb2 = TID512() >> 8;
            for (int it = BIDX() * 2 + sb2; it < 48; it += (int)gridDim.x * 2) { const int tile = it / 3; phF_tile(p, 128 + (tile >> 3), tile & 7, it % 3, smem_all + sb2 * SUB_LDS); }
        }
    } break;
    case 6: {
        { ProbG pg{p, layer}; g8::gemm_phase((LAS unsigned char*)smem_all, pg); }
        if (need_ctx) {
            const int sb2 = TID512() >> 8;
            for (int it = BIDX() * 2 + sb2; it < 16; it += (int)gridDim.x * 2) phG_tile(p, layer, 128 + (it >> 3), it & 7, smem_all + sb2 * SUB_LDS);
        }
    } break;
    case 7: {
        const int nit = (need_ctx ? NROWS : NLAT) / 16;
        for (int it = bid; it < nit; it += nb) phH_item(p, layer, it, smem);
    } break;
    case 8: {
        const int njob = need_ctx ? 32 : 16;
        for (int it = bid; it < njob + (CONV_TILES - CONV_DENSE); it += nb) {
            if (it < njob) phI_item(p, it, smem);
            else convert_tile(p, layer, CONV_DENSE + it - njob, smem);
        }
    } break;
    case 9: {
        { ProbJ pj{p}; g8::gemm_phase((LAS unsigned char*)smem_all, pj); }
        if (need_ctx) {
            const int sb2 = TID512() >> 8;
            for (int it = BIDX() * 2 + sb2; it < 256; it += (int)gridDim.x * 2) phJ_tile(p, 16 + (it >> 4), 0, it & 15, smem_all + sb2 * SUB_LDS);
        }
    } break;
    case 10: {
        { ProbK pk{p, layer}; g8::gemm_phase((LAS unsigned char*)smem_all, pk); }
        if (need_ctx) {
            const int sb2 = TID512() >> 8;
            for (int it = BIDX() * 2 + sb2; it < 128; it += (int)gridDim.x * 2) phK_tile(p, layer, 16 + (it >> 3), 0, it & 7, smem_all + sb2 * SUB_LDS);
        }
    } break;
    }
}

__global__ void __launch_bounds__(NTHREADS, 2) mega_kernel(Params p, int ph_lo, int ph_hi) {
    __shared__ __attribute__((aligned(16))) char smem[LDS_BYTES + 16];
    cg::grid_group grid = cg::this_grid();
#if MK_MULTI
    for (int ph = ph_lo; ph < ph_hi; ++ph) {
        if (ph > ph_lo) grid.sync();
        run_phase(ph, smem);
    }
#else
    unsigned* barw = (unsigned*)(p.ws + WS_BAR);
    volatile LAS unsigned* xst = (volatile LAS unsigned*)(LAS char*)(smem + LDS_BYTES);
    if (threadIdx.x < 4) xst[threadIdx.x] = 0u;
    if (blockIdx.x == 0) for (int i = threadIdx.x; i < XCD_BAR_WORDS; i += NTHREADS) barw[i] = 0u;
    run_phase(0, smem);
    grid.sync();
    const XcdBarrier xb = xcd_barrier_post(barw, xst);
#ifdef PROBE_SUB
#define PH(n) do { if ((n) > 1) xcd_barrier(xb); run_phase((n), smem); if ((n) >= PROBE_MIN && (n) <= PROBE_MAX && (((n) - 1) % 11) == PROBE_SUB) { xcd_barrier(xb); run_phase((n), smem, PROBE_VARIANT); } } while (0)
#else
#define PH(n) do { if ((n) > 1) xcd_barrier(xb); run_phase((n), smem); } while (0)
#endif
    PH(1); PH(2); PH(3); PH(4); PH(5); PH(6); PH(7); PH(8); PH(9); PH(10); PH(11);
    PH(12); PH(13); PH(14); PH(15); PH(16); PH(17); PH(18); PH(19); PH(20); PH(21); PH(22); PH(23);
    static_assert(NPHASE == 24, "phase program");
#undef PH
#endif
}

extern "C" void kernel_launch(void* const* d_in, const int* in_sizes, int n_in, void* d_out, int out_size, void* d_ws, size_t ws_size,
                              hipStream_t stream) {
    static int grid_blocks = 0;
    if (!grid_blocks) {
        int dev = 0, cus = 0, per_cu = 0;
        hipGetDevice(&dev);
        hipDeviceGetAttribute(&cus, hipDeviceAttributeMultiprocessorCount, dev);
        hipOccupancyMaxActiveBlocksPerMultiprocessor(&per_cu, mega_kernel, NTHREADS, 0);
        if (per_cu < 1) per_cu = 1;
        if (per_cu > 1) per_cu = 1;
        grid_blocks = cus * per_cu;
    }
    Params p{};
    const float** ip = (const float**)&p.x;
    for (int i = 0; i < 22; ++i) ip[i] = (const float*)d_in[i];
    p.out = (float*)d_out;
    p.ws = (char*)d_ws;
    if (WS_END > ws_size) { fprintf(stderr, "kernel_launch: workspace too small: need %zu have %zu\n", (size_t)WS_END, ws_size); return; }
#if MK_MULTI
    for (int ph = 0; ph < NPHASE; ++ph) {
        hipLaunchKernelGGL(mega_kernel, dim3(grid_blocks), dim3(NTHREADS), 0, stream, p, ph, ph + 1);
    }
#else
    int lo = 0, hi = NPHASE;
    void* args[] = {&p, &lo, &hi};
    hipError_t e = hipLaunchCooperativeKernel((void*)mega_kernel, dim3(grid_blocks), dim3(NTHREADS), args, 0, stream);
    if (e != hipSuccess) fprintf(stderr, "cooperative launch failed: %s (grid %d)\n", hipGetErrorString(e), grid_blocks);
#endif
}
```

```cpp
#include <hip/hip_runtime.h>
#include <hip/hip_bf16.h>
#include <hip/hip_cooperative_groups.h>
#include <cstdio>
#include <cstdint>
namespace cg = cooperative_groups;

#ifndef MK_MULTI
#define MK_MULTI 0
#endif

#define DI __device__ __forceinline__
typedef unsigned short u16;
typedef __attribute__((ext_vector_type(8))) short bf16x8;
typedef __attribute__((ext_vector_type(4))) float f32x4;
typedef __attribute__((ext_vector_type(4))) unsigned int u32x4;

constexpr int NLAT = 16384, NCTX = 256, NROWS = NLAT + NCTX, DM = 1024, INC = 7424;
constexpr int C_QR = 0, C_KR = 512, C_VR = 1024, C_GR = 1536, C_QW = 2048, C_KW = 2560, C_VW = 2688, C_QN = 2816, C_KN = 3328, C_VN = 3840, C_GATE = 4352;
__host__ __device__ constexpr int col_qr(int h, int x) { return C_QR + (h >> 1) * 256 + x * 128 + (h & 1) * 64; }
__host__ __device__ constexpr int col_kr(int h, int x) { return C_KR + (h >> 1) * 256 + x * 128 + (h & 1) * 64; }
__host__ __device__ constexpr int col_qw(int h, int x) { return C_QW + (h >> 2) * 256 + x * 128 + (h & 3) * 32; }
__host__ __device__ constexpr int col_kw(int kh, int x) { return C_KW + x * 128 + kh * 32; }
__host__ __device__ constexpr int col_vw(int kh) { return C_KW + 64 + kh * 128; }
constexpr int NCHUNK = NROWS / 128;
constexpr int NEXP = 16, EH = 1024, CAP_LAT = 2048, CAP_CTX = 32;
constexpr int NTHREADS = 512;
constexpr int SUB_LDS = 76 * 1024;
constexpr int LDS_BYTES = 2 * SUB_LDS;
constexpr int NPHASE = 24;


constexpr size_t al256(size_t b) { return (b + 255) & ~(size_t)255; }
constexpr size_t WS_CTXRES = 0;
constexpr size_t WS_MOD = WS_CTXRES + al256((size_t)NCTX * DM * 4);
constexpr size_t WS_ROPE128 = WS_MOD + al256(2 * 2 * 6144 * 4);
constexpr size_t WS_ROPE64 = WS_ROPE128 + al256(256 * 32 * 8);
constexpr size_t WS_WT_IN = WS_ROPE64 + al256(256 * 16 * 8);
constexpr size_t WS_WT_RET = WS_WT_IN + al256((size_t)INC * DM * 2);
constexpr size_t WS_WT_WIN = WS_WT_RET + al256((size_t)1024 * 512 * 2);
constexpr size_t WS_WT_NA = WS_WT_WIN + al256((size_t)1024 * 512 * 2);
constexpr size_t WS_WT_OUT = WS_WT_NA + al256((size_t)1024 * 512 * 2);
constexpr size_t WS_WT_GU = WS_WT_OUT + al256((size_t)1024 * 1024 * 2);
constexpr size_t WS_WT_DN = WS_WT_GU + al256((size_t)NEXP * 2048 * 1024 * 2);
constexpr size_t WS_HX = WS_WT_DN + al256((size_t)NEXP * 1024 * 1024 * 2);
constexpr size_t WS_PX = WS_HX + al256((size_t)NROWS * DM * 2);
constexpr size_t WS_YA = WS_PX + al256((size_t)NROWS * INC * 2);
constexpr size_t WS_YB = WS_YA + al256((size_t)NROWS * 512 * 2);
constexpr size_t WS_YC = WS_YB + al256((size_t)NROWS * 512 * 2);
constexpr size_t WS_S = WS_YC + al256((size_t)NROWS * 512 * 2);
constexpr size_t WS_R = WS_S + al256((size_t)NCHUNK * 8 * 16384 * 4);
constexpr size_t WS_AFF = WS_R + al256((size_t)NCHUNK * 8 * 16384 * 2);
constexpr size_t WS_SELI = WS_AFF + al256((size_t)32 * NLAT * 4);
constexpr size_t WS_SELG = WS_SELI + al256(32 * 2048 * 4);
constexpr size_t WS_TSLOT = WS_SELG + al256(32 * 2048 * 4);
constexpr size_t WS_BAR = WS_TSLOT + al256((size_t)32 * NLAT * 4);
constexpr size_t WS_MACCX = WS_BAR + al256(3456 * 4);
constexpr size_t WS_END = WS_MACCX + al256((size_t)NCTX * DM * 4);
struct Params {
    const float *x, *c, *ctx, *c_ctx, *w_mod, *b_mod, *g_mix, *g_ffn, *w_in, *decay, *ret_gn, *w_ret, *sink, *w_win, *rpb, *w_na, *w_out,
        *w_router, *w_eg, *w_eu, *w_ed, *g_final;
    float* out;
    char* ws;
};
typedef const Params __attribute__((address_space(4)))* KP;
#define WSF(name, type, off) __device__ __forceinline__ type* P_##name(KP p) { return (type*)(p->ws + (off)); }
WSF(ctxres, float, WS_CTXRES)
WSF(mod, float, WS_MOD)
WSF(rope128, float2, WS_ROPE128)
WSF(rope64, float2, WS_ROPE64)
WSF(wt_in, u16, WS_WT_IN) WSF(wt_ret, u16, WS_WT_RET) WSF(wt_win, u16, WS_WT_WIN) WSF(wt_na, u16, WS_WT_NA) WSF(wt_out, u16, WS_WT_OUT)
WSF(wt_gu, u16, WS_WT_GU) WSF(wt_dn, u16, WS_WT_DN)
WSF(hx, u16, WS_HX)
WSF(px, u16, WS_PX)
WSF(ya, u16, WS_YA) WSF(yb, u16, WS_YB) WSF(yc, u16, WS_YC)
WSF(S, float, WS_S)
WSF(R, u16, WS_R)
WSF(aff, float, WS_AFF)
WSF(sel_idx, int, WS_SELI) WSF(sel_gate, float, WS_SELG)
WSF(hid, u16, WS_PX)
__device__ __forceinline__ u16* P_hidc(KP p) { return (u16*)(p->ws + WS_PX) + (size_t)NEXP * 2048 * 1024; }
__device__ __forceinline__ u16* P_ye(KP p) { return (u16*)(p->ws + WS_PX) + (size_t)NEXP * (2048 + 32) * 1024; }
__device__ __forceinline__ u16* P_yec(KP p) { return P_ye(p) + (size_t)NEXP * 2048 * 1024; }
__device__ __forceinline__ int* P_tslot(KP p) { return (int*)(p->ws + WS_TSLOT); }
__device__ __forceinline__ u16* P_z(KP p) { return (u16*)(p->ws + WS_S); }
__device__ __forceinline__ float* P_maccx(KP p) { return (float*)(p->ws + WS_MACCX); }
#undef WSF


DI int TIDX() { int t = threadIdx.x & 255; asm volatile("" : "+v"(t)); return t; }
DI int TID512() { int t = threadIdx.x; asm volatile("" : "+v"(t)); return t; }
DI int BIDX() { int t = blockIdx.x; asm volatile("" : "+s"(t)); return t; }
DI u16 f2bf(float x) { unsigned u = __float_as_uint(x); u += 0x7fffu + ((u >> 16) & 1u); return (u16)(u >> 16); }
DI float bf2f(u16 h) { return __uint_as_float(((unsigned)h) << 16); }
DI float bflo(unsigned w) { return __uint_as_float(w << 16); }
DI float bfhi(unsigned w) { return __uint_as_float(w & 0xffff0000u); }
typedef __bf16 bf16v2 __attribute__((ext_vector_type(2)));
typedef float f32v2 __attribute__((ext_vector_type(2)));
DI unsigned pack2(float a, float b) { f32v2 v = {a, b}; bf16v2 r = __builtin_convertvector(v, bf16v2); return __builtin_bit_cast(unsigned, r); }
DI float sigmoidf_(float x) { return 1.f / (1.f + __expf(-x)); }
DI float siluf_(float x) { return x / (1.f + __expf(-x)); }
DI float wave_sum(float v) { for (int o = 32; o > 0; o >>= 1) v += __shfl_xor(v, o); return v; }
#define MFMA16(a, b, c) __builtin_amdgcn_mfma_f32_16x16x32_bf16((a), (b), (c), 0, 0, 0)

template <int MR>
DI void zero_acc(f32x4 (&acc)[MR][4]) {
#pragma unroll
    for (int m = 0; m < MR; ++m)
#pragma unroll
        for (int n = 0; n < 4; ++n) acc[m][n] = f32x4{0.f, 0.f, 0.f, 0.f};
}

template <int KT>
DI void gemm_core(f32x4 (&acc)[4][4], const u16* a0, const u16* a1, const u16* b0, const u16* b1, char* smem) {
    const int tid = TIDX(), lane = tid & 63, wid = tid >> 6, wr = wid >> 1, wc = wid & 1, fr = lane & 15, fq = lane >> 4;
    auto stage = [&](int kt, int buf) {
        char* base = smem + buf * 16384;
        __builtin_amdgcn_global_load_lds((const unsigned*)(a0 + kt * 32), (unsigned*)(base + tid * 16), 16, 0, 0);
        __builtin_amdgcn_global_load_lds((const unsigned*)(a1 + kt * 32), (unsigned*)(base + 4096 + tid * 16), 16, 0, 0);
        __builtin_amdgcn_global_load_lds((const unsigned*)(b0 + kt * 32), (unsigned*)(base + 8192 + tid * 16), 16, 0, 0);
        __builtin_amdgcn_global_load_lds((const unsigned*)(b1 + kt * 32), (unsigned*)(base + 12288 + tid * 16), 16, 0, 0);
    };
    __syncthreads();
    stage(0, 0);
#pragma unroll 1
    for (int kt = 0; kt < KT; ++kt) {
        asm volatile("s_waitcnt vmcnt(0)" ::: "memory");
        __syncthreads();
        if (kt + 1 < KT) stage(kt + 1, (kt + 1) & 1);
        const char* SA = smem + (kt & 1) * 16384;
        const char* SB = SA + 8192;
        bf16x8 At[4], Bt[4];
#pragma unroll
        for (int m = 0; m < 4; ++m) At[m] = *(const bf16x8*)(SA + (wr * 64 + m * 16 + fr) * 64 + fq * 16);
#pragma unroll
        for (int n = 0; n < 4; ++n) Bt[n] = *(const bf16x8*)(SB + (wc * 64 + n * 16 + fr) * 64 + fq * 16);
#pragma unroll
        for (int m = 0; m < 4; ++m)
#pragma unroll
            for (int n = 0; n < 4; ++n) acc[m][n] = MFMA16(At[m], Bt[n], acc[m][n]);
    }
}

template <int KT>
DI void gemm_core_af32(f32x4 (&acc)[4][4], const float* a0f, const float* a1f, const u16* b0, const u16* b1, char* smem) {
    const int tid = TIDX(), lane = tid & 63, wid = tid >> 6, wr = wid >> 1, wc = wid & 1, fr = lane & 15, fq = lane >> 4;
    f32x4 ar[4];
    auto loadA = [&](int kt) { ar[0] = *(const f32x4*)(a0f + kt * 32); ar[1] = *(const f32x4*)(a0f + kt * 32 + 4); ar[2] = *(const f32x4*)(a1f + kt * 32); ar[3] = *(const f32x4*)(a1f + kt * 32 + 4); };
    auto storeA = [&](int buf) {
        char* base = smem + buf * 16384;
        u32x4 w0, w1;
        w0[0] = pack2(ar[0][0], ar[0][1]); w0[1] = pack2(ar[0][2], ar[0][3]); w0[2] = pack2(ar[1][0], ar[1][1]); w0[3] = pack2(ar[1][2], ar[1][3]);
        w1[0] = pack2(ar[2][0], ar[2][1]); w1[1] = pack2(ar[2][2], ar[2][3]); w1[2] = pack2(ar[3][0], ar[3][1]); w1[3] = pack2(ar[3][2], ar[3][3]);
        *(u32x4*)(base + tid * 16) = w0; *(u32x4*)(base + 4096 + tid * 16) = w1;
    };
    auto stageB = [&](int kt, int buf) {
        char* base = smem + buf * 16384;
        __builtin_amdgcn_global_load_lds((const unsigned*)(b0 + kt * 32), (unsigned*)(base + 8192 + tid * 16), 16, 0, 0);
        __builtin_amdgcn_global_load_lds((const unsigned*)(b1 + kt * 32), (unsigned*)(base + 12288 + tid * 16), 16, 0, 0);
    };
    __syncthreads();
    loadA(0); stageB(0, 0); storeA(0);
#pragma unroll 1
    for (int kt = 0; kt < KT; ++kt) {
        asm volatile("s_waitcnt vmcnt(0)" ::: "memory");
        __syncthreads();
        if (kt + 1 < KT) { loadA(kt + 1); stageB(kt + 1, (kt + 1) & 1); }
        const char* SA = smem + (kt & 1) * 16384;
        const char* SB = SA + 8192;
        bf16x8 At[4], Bt[4];
#pragma unroll
        for (int m = 0; m < 4; ++m) At[m] = *(const bf16x8*)(SA + (wr * 64 + m * 16 + fr) * 64 + fq * 16);
#pragma unroll
        for (int n = 0; n < 4; ++n) Bt[n] = *(const bf16x8*)(SB + (wc * 64 + n * 16 + fr) * 64 + fq * 16);
#pragma unroll
        for (int m = 0; m < 4; ++m)
#pragma unroll
            for (int n = 0; n < 4; ++n) acc[m][n] = MFMA16(At[m], Bt[n], acc[m][n]);
        if (kt + 1 < KT) storeA((kt + 1) & 1);
    }
}

template <int MR>
DI void mma_lds64(f32x4 (&acc)[MR][4], const u16* As, int lda, const u16* Bs, int ldb) {
    const int tid = TIDX(), lane = tid & 63, wid = tid >> 6, wr = wid >> 1, wc = wid & 1, fr = lane & 15, fq = lane >> 4;
#pragma unroll
    for (int kk = 0; kk < 2; ++kk) {
        bf16x8 At[MR], Bt[4];
#pragma unroll
        for (int m = 0; m < MR; ++m) At[m] = *(const bf16x8*)(As + (wr * (MR * 16) + m * 16 + fr) * lda + kk * 32 + fq * 8);
#pragma unroll
        for (int n = 0; n < 4; ++n) Bt[n] = *(const bf16x8*)(Bs + (wc * 64 + n * 16 + fr) * ldb + kk * 32 + fq * 8);
#pragma unroll
        for (int m = 0; m < MR; ++m)
#pragma unroll
            for (int n = 0; n < 4; ++n) acc[m][n] = MFMA16(At[m], Bt[n], acc[m][n]);
    }
}
template <int ROWS>
DI void stage_n64(u16* dst, int ld, const u16* src, long sstride) {
    const int tid = TIDX();
#pragma unroll
    for (int i = 0; i < ROWS / 32; ++i) {
        int idx = i * 256 + tid, row = idx >> 3, ch = idx & 7;
        u32x4 v = *(const u32x4*)(src + (long)row * sstride + ch * 8);
        *(u32x4*)(dst + row * ld + ch * 8) = v;
    }
}
template <bool SCALE, int NF>
DI void stage_t64(u16* dst, int ld, const u16* src, long sstride, float scale_tok_lane  ) {
    const int tid = TIDX();
#pragma unroll
    for (int i = 0; i < NF / 32; ++i) {
        int idx = i * 256 + tid, jj = idx & 63, ch = idx >> 6;
        u32x4 v = *(const u32x4*)(src + (long)jj * sstride + ch * 8);
#pragma unroll
        for (int e = 0; e < 4; ++e) {
            float lo = bflo(v[e]), hi = bfhi(v[e]);
            if (SCALE) { lo *= scale_tok_lane; hi *= scale_tok_lane; }
            dst[(ch * 8 + 2 * e) * ld + jj] = SCALE ? f2bf(lo) : (u16)(v[e] & 0xffffu);
            dst[(ch * 8 + 2 * e + 1) * ld + jj] = SCALE ? f2bf(hi) : (u16)(v[e] >> 16);
        }
    }
}

DI void convert_tile(KP p, int layer, int tile, char* smem);

DI void ph0_gemv_item(KP p, int item, char* smem) {
    const int tid = TIDX();
    const int l = item / 96, cg_ = item % 96;
    float* sl = (float*)smem;
    float* red = (float*)(smem + 8192);
    __syncthreads();
    for (int k = tid; k < 1024; k += 256) { sl[k] = siluf_(p->c[k]); sl[1024 + k] = siluf_(p->c_ctx[k]); }
    __syncthreads();
    const int c4 = tid & 15, kp = tid >> 4;
    const int col = cg_ * 64 + c4 * 4;
    const float* w = p->w_mod + (long)l * 1024 * 6144 + col;
    float a0[4] = {0, 0, 0, 0}, a1[4] = {0, 0, 0, 0};
#pragma unroll 8
    for (int kk = 0; kk < 64; ++kk) {
        int k = kp * 64 + kk;
        float4 wv = *(const float4*)(w + (long)k * 6144);
        float s0 = sl[k], s1 = sl[1024 + k];
        a0[0] += s0 * wv.x; a0[1] += s0 * wv.y; a0[2] += s0 * wv.z; a0[3] += s0 * wv.w;
        a1[0] += s1 * wv.x; a1[1] += s1 * wv.y; a1[2] += s1 * wv.z; a1[3] += s1 * wv.w;
    }
#pragma unroll
    for (int j = 0; j < 4; ++j) { red[(kp * 2 + 0) * 64 + c4 * 4 + j] = a0[j]; red[(kp * 2 + 1) * 64 + c4 * 4 + j] = a1[j]; }
    __syncthreads();
    if (tid < 128) {
        int src = tid >> 6, cr = tid & 63;
        float s = 0.f;
        for (int q = 0; q < 16; ++q) s += red[(q * 2 + src) * 64 + cr];
        int n = cg_ * 64 + cr;
        P_mod(p)[(l * 2 + src) * 6144 + n] = s + p->b_mod[l * 6144 + n];
    }
}
DI void sincos_d(double a, float& c, float& s) {
    const double TWO_PI = 6.283185307179586476925286766559;
    double k = rint(a / TWO_PI);
    double r = a - k * TWO_PI;
    double r2 = r * r;
    double ts = r, tc = 1.0, ss = r, cc = 1.0;
    for (int i = 1; i <= 14; ++i) {
        tc = -tc * r2 / (double)((2 * i - 1) * (2 * i));
        ts = -ts * r2 / (double)((2 * i) * (2 * i + 1));
        cc += tc; ss += ts;
    }
    c = (float)cc; s = (float)ss;
}
DI void ph0_rope_item(KP p, int item) {
    int idx = item * 256 + TIDX();
    const double LN_BASE = 9.210340371976184;
    if (idx < 8192) {
        int pos = idx >> 5, f = idx & 31;
        float inv = (float)exp(-(double)f / 32.0 * LN_BASE);
        float ang = (float)pos * inv;
        float c, s; sincos_d((double)ang, c, s);
        P_rope128(p)[idx] = make_float2(c, s);
    } else {
        int i2 = idx - 8192;
        int pos = i2 >> 4, f = i2 & 15;
        float inv = (float)exp(-(double)f / 16.0 * LN_BASE);
        float ang = (float)pos * inv;
        float c, s; sincos_d((double)ang, c, s);
        P_rope64(p)[i2] = make_float2(c, s);
    }
}

constexpr int CONV_TILES = 928 + 192 + 128 + 6144;
constexpr int CONV_DENSE = 928 + 192 + 128;
struct ConvTile { const float* sp; u16* dp; int N, K, mode, n0; };
DI ConvTile conv_setup(KP p, int layer, int tile) {
    const float* src; u16* dst; int K, N, mode = 0;
    if (tile < 928) { src = p->w_in + (long)layer * 1024 * INC; dst = P_wt_in(p); K = 1024; N = INC; mode = 1; }
    else if (tile < 928 + 192) {
        int t = tile - 928, which = t / 64; tile = t % 64; K = 512; N = 1024;
        src = (which == 0 ? p->w_ret : which == 1 ? p->w_win : p->w_na) + (long)layer * 512 * 1024;
        dst = (which == 0 ? P_wt_ret(p) : which == 1 ? P_wt_win(p) : P_wt_na(p));
    } else if (tile < 928 + 192 + 128) { tile -= 928 + 192; src = p->w_out + (long)layer * 1024 * 1024; dst = P_wt_out(p); K = 1024; N = 1024; }
    else {
        int t = tile - (928 + 192 + 128), which = t / 2048, e = (t % 2048) / 128; tile = t % 128; K = 1024; N = 1024;
        long eo = ((long)layer * NEXP + e) * 1024 * 1024;
        if (which == 0) { src = p->w_eg + eo; dst = P_wt_gu(p) + (long)e * 2048 * 1024; mode = 2; }
        else if (which == 1) { src = p->w_eu + eo; dst = P_wt_gu(p) + (long)e * 2048 * 1024; mode = 3; }
        else { src = p->w_ed + eo; dst = P_wt_dn(p) + (long)e * 1024 * 1024; }
    }
    const int ntn = N / 64;
    const int k0 = (tile / ntn) * 128, n0 = (tile % ntn) * 64;
    ConvTile c; c.sp = src + (long)k0 * N + n0; c.dp = dst + k0; c.N = N; c.K = K; c.mode = mode; c.n0 = n0;
    return c;
}
DI int conv_drow(int mode, int n) {
    if (mode == 1) {
        if (n < 1024) { int hh_ = (n & 511) >> 7, o_ = n & 127; return (n < 512 ? col_qr(hh_, o_ >> 6) : col_kr(hh_, o_ >> 6)) + (o_ & 63); }
        if (n >= C_QW && n < C_KW) { int m_ = n - C_QW; return col_qw(m_ >> 6, (m_ & 63) >> 5) + (m_ & 31); }
        if (n >= C_KW && n < C_VW) { int m_ = n - C_KW; return col_kw(m_ >> 6, (m_ & 63) >> 5) + (m_ & 31); }
        if (n >= C_VW && n < C_QN) { int m_ = n - C_VW; return col_vw(m_ >> 6) + (m_ & 63); }
        return n;
    }
    if (mode == 2) return (n >> 7) * 256 + (n & 127);
    if (mode == 3) return (n >> 7) * 256 + 128 + (n & 127);
    return n;
}
DI void convert_tiles(KP p, int layer, int first, int last, int step, char* smem) {
    const int tid = TIDX(), lane = tid & 63, w = tid >> 6;
    unsigned* T = (unsigned*)smem;
    float v[32];
    ConvTile c;
    if (first < last) {
        c = conv_setup(p, layer, first);
        const float* sp = c.sp + (long)(w * 32) * c.N + lane;
#pragma unroll
        for (int j = 0; j < 32; ++j) v[j] = sp[(long)j * c.N];
    }
    for (int t = first; t < last; t += step) {
        __syncthreads();
#pragma unroll
        for (int e = 0; e < 16; ++e) T[lane * 66 + w * 16 + e] = pack2(v[2 * e], v[2 * e + 1]);
        const ConvTile cur = c;
        if (t + step < last) {
            c = conv_setup(p, layer, t + step);
            const float* sp = c.sp + (long)(w * 32) * c.N + lane;
#pragma unroll
            for (int j = 0; j < 32; ++j) v[j] = sp[(long)j * c.N];
        }
        __syncthreads();
#pragma unroll
        for (int i = 0; i < 4; ++i) {
            const int idx = i * 256 + tid, nn = idx >> 4, ch = idx & 15;
            const u32x4 o = *(const u32x4*)(T + nn * 66 + ch * 4);
            *(u32x4*)(cur.dp + (long)conv_drow(cur.mode, cur.n0 + nn) * cur.K + ch * 8) = o;
        }
    }
}

DI const float* resid_row(KP p, int layer, int row) {
    if (row < NLAT) return (layer == 0 ? p->x : p->out) + (long)row * DM;
    return (layer == 0 ? p->ctx : P_ctxres(p)) + (long)(row - NLAT) * DM;
}
DI const float* cur_row(KP p, int row) { return row < NLAT ? p->out + (long)row * DM : P_ctxres(p) + (long)(row - NLAT) * DM; }
DI void moe_combine(KP p, int row, float4 (&v)[4]) {
    const int lane = TIDX() & 63;
    const bool lat = row < NLAT;
    const int* ts = P_tslot(p) + (lat ? 0 : 16) * (long)NLAT + (lat ? row : row - NLAT);
    const u16* yb_ = lat ? P_ye(p) : P_yec(p);
    const int cap = lat ? CAP_LAT : CAP_CTX;
#pragma unroll 4
    for (int e = 0; e < NEXP; ++e) {
        const int slot = ts[(long)e * NLAT];
        if (slot >= 0) {
            const u16* yr = yb_ + ((long)e * cap + slot) * DM + lane * 4;
#pragma unroll
            for (int i = 0; i < 4; ++i) {
                uint2 w = *(const uint2*)(yr + i * 256);
                v[i].x += bflo(w.x); v[i].y += bfhi(w.x); v[i].z += bflo(w.y); v[i].w += bfhi(w.y);
            }
        }
    }
}
DI void norm_row(KP p, int layer, int row, const float* xr, const float* g, int shift_idx, int scale_idx, u16* dst_row, float* keep  , float* wb  ) {
    const int lane = TIDX() & 63;
    const float* md = P_mod(p) + (layer * 2 + (row < NLAT ? 0 : 1)) * 6144;
    float4 v[4]; float ss = 0.f;
#pragma unroll
    for (int i = 0; i < 4; ++i) v[i] = *(const float4*)(xr + i * 256 + lane * 4);
    if (wb) {
        moe_combine(p, row, v);
#pragma unroll
        for (int i = 0; i < 4; ++i) *(float4*)(wb + i * 256 + lane * 4) = v[i];
    }
#pragma unroll
    for (int i = 0; i < 4; ++i) ss += v[i].x * v[i].x + v[i].y * v[i].y + v[i].z * v[i].z + v[i].w * v[i].w;
    ss = wave_sum(ss);
    float rstd = rsqrtf(ss * (1.f / DM) + 1e-6f);
#pragma unroll
    for (int i = 0; i < 4; ++i) {
        int c0 = i * 256 + lane * 4;
        float4 gg = *(const float4*)(g + c0), sh = *(const float4*)(md + shift_idx * 1024 + c0), sc = *(const float4*)(md + scale_idx * 1024 + c0);
        float o0 = v[i].x * rstd * gg.x * (1.f + sc.x) + sh.x, o1 = v[i].y * rstd * gg.y * (1.f + sc.y) + sh.y;
        float o2 = v[i].z * rstd * gg.z * (1.f + sc.z) + sh.z, o3 = v[i].w * rstd * gg.w * (1.f + sc.w) + sh.w;
        uint2 pk; pk.x = pack2(o0, o1); pk.y = pack2(o2, o3);
        *(uint2*)(dst_row + c0) = pk;
        if (keep) *(float4*)(keep + c0) = make_float4(o0, o1, o2, o3);
    }
}

DI void norm_rows4(KP p, int layer, int row0, const float* g, int shift_idx, int scale_idx, bool first_layer_src, bool combine, float* keep = nullptr  ) {
    const int lane = TIDX() & 63;
    const float* md = P_mod(p) + (layer * 2 + (row0 < NLAT ? 0 : 1)) * 6144;
    float4 v[4][4];
#pragma unroll
    for (int r = 0; r < 4; ++r) {
        const float* xr = first_layer_src ? resid_row(p, 0, row0 + r) : cur_row(p, row0 + r);
#pragma unroll
        for (int i = 0; i < 4; ++i) v[r][i] = *(const float4*)(xr + i * 256 + lane * 4);
    }
    float4 gg[4], sh[4], sc[4];
#pragma unroll
    for (int i = 0; i < 4; ++i) { const int c0 = i * 256 + lane * 4; gg[i] = *(const float4*)(g + c0); sh[i] = *(const float4*)(md + shift_idx * 1024 + c0); sc[i] = *(const float4*)(md + scale_idx * 1024 + c0); }
#pragma unroll
    for (int r = 0; r < 4; ++r) {
        const int row = row0 + r;
        if (first_layer_src && row >= NLAT) {
            float* wb = (float*)cur_row(p, row);
#pragma unroll
            for (int i = 0; i < 4; ++i) *(float4*)(wb + i * 256 + lane * 4) = v[r][i];
        }
        if (combine) {
            moe_combine(p, row, v[r]);
            float* wb = (float*)cur_row(p, row);
#pragma unroll
            for (int i = 0; i < 4; ++i) *(float4*)(wb + i * 256 + lane * 4) = v[r][i];
        }
        float ss = 0.f;
#pragma unroll
        for (int i = 0; i < 4; ++i) ss += v[r][i].x * v[r][i].x + v[r][i].y * v[r][i].y + v[r][i].z * v[r][i].z + v[r][i].w * v[r][i].w;
        ss = wave_sum(ss);
        const float rstd = rsqrtf(ss * (1.f / DM) + 1e-6f);
        u16* dst_row = P_hx(p) + (long)row * DM;
#pragma unroll
        for (int i = 0; i < 4; ++i) {
            const int c0 = i * 256 + lane * 4;
            float o0 = v[r][i].x * rstd * gg[i].x * (1.f + sc[i].x) + sh[i].x, o1 = v[r][i].y * rstd * gg[i].y * (1.f + sc[i].y) + sh[i].y;
            float o2 = v[r][i].z * rstd * gg[i].z * (1.f + sc[i].z) + sh[i].z, o3 = v[r][i].w * rstd * gg[i].w * (1.f + sc[i].w) + sh[i].w;
            uint2 pk; pk.x = pack2(o0, o1); pk.y = pack2(o2, o3);
            *(uint2*)(dst_row + c0) = pk;
            if (keep) *(float4*)(keep + r * 1024 + c0) = make_float4(o0, o1, o2, o3);
        }
    }
}

DI void phB_tile(KP p, int mt, int nt, char* smem) {
    const int tid = TIDX(), lane = tid & 63, wid = tid >> 6, wr = wid >> 1, wc = wid & 1, fr = lane & 15, fq = lane >> 4;
    f32x4 acc[4][4]; zero_acc<4>(acc);
    const int r0 = tid >> 2, ko = (tid & 3) * 8;
    const u16* a0 = P_hx(p) + (long)(mt * 128 + r0) * DM + ko;
    const u16* b0 = P_wt_in(p) + (long)(nt * 128 + r0) * DM + ko;
    gemm_core<32>(acc, a0, a0 + 64 * DM, b0, b0 + 64 * DM, smem);
    const bool lat = mt < 128;
    const int type = (nt < 8) ? 1 : (nt >= 16 && nt < 21) ? 2 : 0;
    if (type != 0 && lat) {
#pragma unroll
        for (int m = 0; m < 4; ++m)
#pragma unroll
            for (int j = 0; j < 4; ++j) {
                int t = mt * 128 + wr * 64 + m * 16 + fq * 4 + j;
                int pr = t >> 6, pc = t & 63;
#pragma unroll
                for (int n = 0; n < 2; ++n) {
                    float2 cs;
                    if (type == 1) { int pos = (wc == 0) ? pr : pc; cs = P_rope128(p)[pos * 32 + n * 16 + fr]; }
                    else { int pos = (n == 0) ? pr : pc; cs = P_rope64(p)[pos * 16 + fr]; }
                    float x1 = acc[m][n][j], x2 = acc[m][n + 2][j];
                    acc[m][n][j] = x1 * cs.x - x2 * cs.y;
                    acc[m][n + 2][j] = x1 * cs.y + x2 * cs.x;
                }
            }
    }
    const float mul = (nt >= 4 && nt < 8) ? 0.08838834764831845f : ((nt >= 16 && nt < 20) || (nt >= 22 && nt < 26)) ? 0.125f : 1.f;
#pragma unroll
    for (int m = 0; m < 4; ++m)
#pragma unroll
        for (int n = 0; n < 4; ++n)
#pragma unroll
            for (int j = 0; j < 4; ++j) {
                int row = mt * 128 + wr * 64 + m * 16 + fq * 4 + j, col = nt * 128 + wc * 64 + n * 16 + fr;
                P_px(p)[(long)row * INC + col] = f2bf(acc[m][n][j] * mul);
            }
}

typedef __attribute__((ext_vector_type(16))) float f32x16;
typedef short v4s __attribute__((ext_vector_type(4)));
typedef __attribute__((address_space(3))) v4s* lds_v4s_ptr;
#define MFMA32(a, b, c) __builtin_amdgcn_mfma_f32_32x32x16_bf16((a), (b), (c), 0, 0, 0)
constexpr float LOG2E = 1.4426950408889634f;

struct FA {
    bf16x8 qf[4];
    f32x16 o[2];
    float m, l;
};
DI void fa_stage(u16* Ks, u16* Vs, const u16* px, int rowstart, int colK1, int colK2, int colV) {
    const int lane = TIDX() & 63;
#pragma unroll
    for (int i = 0; i < 8; ++i) {
        int idx = i * 64 + lane, key = idx >> 3, ch = idx & 7;
        const u16* src = px + (long)(rowstart + key) * INC;
        u32x4 kv = *(const u32x4*)(src + (ch < 4 ? colK1 + ch * 8 : colK2 + (ch - 4) * 8));
        u32x4 vv = *(const u32x4*)(src + colV + ch * 8);
        *(u32x4*)(Ks + key * 72 + ch * 8) = kv;
        *(u32x4*)(Vs + key * 72 + ch * 8) = vv;
    }
}
template <int MODE>
DI void fa_tile(FA& st, const u16* Ks, const u16* Vs, int a0, const float* rrow) {
    const int lane = TIDX() & 63, c = lane & 31, hh = lane >> 5;
    const u16* kbase = Ks + c * 72 + hh * 8;
    const u16* vbase = Vs + (4 * hh + ((lane & 15) >> 2)) * 72 + 16 * ((lane >> 4) & 1) + 4 * (lane & 3);
    f32x16 s[2];
#pragma unroll
    for (int kb = 0; kb < 2; ++kb) {
#pragma unroll
        for (int r = 0; r < 16; ++r) s[kb][r] = 0.f;
#pragma unroll
        for (int ks = 0; ks < 4; ++ks) {
            bf16x8 A = *(const bf16x8*)(kbase + kb * 32 * 72 + ks * 16);
            s[kb] = MFMA32(A, st.qf[ks], s[kb]);
        }
    }
    float mx = -3.0e38f;
    const int cq = a0 + c;
    int cs = cq - 8; cs = cs < 0 ? 0 : (cs > 48 ? 48 : cs);
#pragma unroll
    for (int kb = 0; kb < 2; ++kb)
#pragma unroll
        for (int r = 0; r < 16; ++r) {
            const int j = kb * 32 + (r & 3) + 8 * (r >> 2) + 4 * hh;
            float v = s[kb][r];
            if (MODE == 1) { int d = a0 + j - c; v = (d >= -128 && d <= 128) ? v : -1e30f; }
            if (MODE == 2) { bool ok = (j >= cs) && (j < cs + 16); int ci = j - cq + 15; ci = ci < 0 ? 0 : (ci > 30 ? 30 : ci); v = ok ? v + rrow[ci] : -1e30f; }
            v *= LOG2E;
            s[kb][r] = v;
            mx = fmaxf(mx, v);
        }
    mx = fmaxf(mx, __shfl_xor(mx, 32));
    const float mn = fmaxf(st.m, mx);
    const float alpha = __builtin_amdgcn_exp2f(st.m - mn);
    float ls = 0.f;
#pragma unroll
    for (int kb = 0; kb < 2; ++kb)
#pragma unroll
        for (int r = 0; r < 16; ++r) { float pv = __builtin_amdgcn_exp2f(s[kb][r] - mn); s[kb][r] = pv; ls += pv; }
    st.l = st.l * alpha + ls; st.m = mn;
#pragma unroll
    for (int db = 0; db < 2; ++db)
#pragma unroll
        for (int r = 0; r < 16; ++r) st.o[db][r] *= alpha;
    bf16x8 pf[2][2];
#pragma unroll
    for (int kb = 0; kb < 2; ++kb)
#pragma unroll
        for (int k2 = 0; k2 < 2; ++k2) {
            u32x4 w;
#pragma unroll
            for (int e = 0; e < 4; ++e) w[e] = pack2(s[kb][8 * k2 + 2 * e], s[kb][8 * k2 + 2 * e + 1]);
            pf[kb][k2] = __builtin_bit_cast(bf16x8, w);
        }
#pragma unroll
    for (int db = 0; db < 2; ++db)
#pragma unroll
        for (int kb = 0; kb < 2; ++kb)
#pragma unroll
            for (int k2 = 0; k2 < 2; ++k2) {
                const u16* alo = vbase + (kb * 32 + 16 * k2) * 72 + db * 32;
                v4s lo = __builtin_amdgcn_ds_read_tr16_b64_v4i16((lds_v4s_ptr)alo);
                v4s hi = __builtin_amdgcn_ds_read_tr16_b64_v4i16((lds_v4s_ptr)(alo + 8 * 72));
                bf16x8 A = __builtin_shufflevector(lo, hi, 0, 1, 2, 3, 4, 5, 6, 7);
                st.o[db] = MFMA32(A, pf[kb][k2], st.o[db]);
            }
}
DI void fa_tile_na32(FA& st, const u16* Ks, const u16* Vs, int koff, bool rowok, int cs, const float* brow) {
    const int lane = TIDX() & 63, c = lane & 31, hh = lane >> 5;
    const u16* kbase = Ks + (koff + c) * 72 + hh * 8;
    const u16* vbase = Vs + (koff + 4 * hh + ((lane & 15) >> 2)) * 72 + 16 * ((lane >> 4) & 1) + 4 * (lane & 3);
    f32x16 s;
#pragma unroll
    for (int r = 0; r < 16; ++r) s[r] = 0.f;
#pragma unroll
    for (int ks = 0; ks < 4; ++ks) {
        bf16x8 A = *(const bf16x8*)(kbase + ks * 16);
        s = MFMA32(A, st.qf[ks], s);
    }
    float mx = -3.0e38f;
    const int lo = cs - koff;
#pragma unroll
    for (int r = 0; r < 16; ++r) {
        const int jj = (r & 3) + 8 * (r >> 2) + 4 * hh;
        const bool ok = rowok && (jj >= lo) && (jj < lo + 16);
        float v = ok ? (s[r] + brow[jj]) * LOG2E : -1.4e30f;
        s[r] = v;
        mx = fmaxf(mx, v);
    }
    mx = fmaxf(mx, __shfl_xor(mx, 32));
    const float mn = fmaxf(st.m, mx);
    const float alpha = __builtin_amdgcn_exp2f(st.m - mn);
    float ls = 0.f;
#pragma unroll
    for (int r = 0; r < 16; ++r) { float pv = __builtin_amdgcn_exp2f(s[r] - mn); s[r] = pv; ls += pv; }
    st.l = st.l * alpha + ls; st.m = mn;
#pragma unroll
    for (int db = 0; db < 2; ++db)
#pragma unroll
        for (int r = 0; r < 16; ++r) st.o[db][r] *= alpha;
    bf16x8 pf[2];
#pragma unroll
    for (int k2 = 0; k2 < 2; ++k2) {
        u32x4 w;
#pragma unroll
        for (int e = 0; e < 4; ++e) w[e] = pack2(s[8 * k2 + 2 * e], s[8 * k2 + 2 * e + 1]);
        pf[k2] = __builtin_bit_cast(bf16x8, w);
    }
#pragma unroll
    for (int db = 0; db < 2; ++db)
#pragma unroll
        for (int k2 = 0; k2 < 2; ++k2) {
            const u16* alo = vbase + (16 * k2) * 72 + db * 32;
            v4s lo_ = __builtin_amdgcn_ds_read_tr16_b64_v4i16((lds_v4s_ptr)alo);
            v4s hi_ = __builtin_amdgcn_ds_read_tr16_b64_v4i16((lds_v4s_ptr)(alo + 8 * 72));
            bf16x8 A = __builtin_shufflevector(lo_, hi_, 0, 1, 2, 3, 4, 5, 6, 7);
            st.o[db] = MFMA32(A, pf[k2], st.o[db]);
        }
}
DI void attn_block_item(KP p, int layer, int kind, int ia, int ib, char* smem) {
    const int tid = TIDX(), lane = tid & 63, wid = tid >> 6, c = lane & 31, hh = lane >> 5;
    u16* KV = (u16*)smem;
    float* rpbs = (float*)(smem + 36864) + 64 + wid * 512;
    const bool isna = (kind == 1 || kind == 3);
    int h, q0, a_half = 0, kvh;
    if (kind == 0) { h = ib * 4 + wid; kvh = ib; q0 = ia * 32; }
    else if (kind == 1) { h = ib; kvh = ib; q0 = 2 * ia * 64; }
    else if (kind == 2) { h = ib * 4 + wid; kvh = ib; q0 = NLAT + ia * 32; }
    else { h = ib; kvh = ib; q0 = NLAT + (ia * 4 + wid) * 32; }
    const int colQ1 = isna ? C_QN + h * 64 : col_qw(h, 0), colQ2 = isna ? colQ1 + 32 : col_qw(h, 1);
    const int colK1 = isna ? C_KN + kvh * 64 : col_kw(kvh, 0), colK2 = isna ? colK1 + 32 : col_kw(kvh, 1);
    const int colV = isna ? C_VN + kvh * 64 : col_vw(kvh);
    FA st;
    {
        const int tq = (kind == 1) ? q0 + (c >> 4) * 64 + wid * 16 + (c & 15) : q0 + c;
        const u16* qrow = P_px(p) + (long)tq * INC;
#pragma unroll
        for (int ks = 0; ks < 4; ++ks) st.qf[ks] = *(const bf16x8*)(qrow + (ks < 2 ? colQ1 + ks * 16 : colQ2 + (ks - 2) * 16) + hh * 8);
#pragma unroll
        for (int db = 0; db < 2; ++db)
#pragma unroll
            for (int r = 0; r < 16; ++r) st.o[db][r] = 0.f;
        if (isna) { st.m = -1e30f; st.l = 0.f; } else { st.m = p->sink[layer * 8 + h] * LOG2E; st.l = hh == 0 ? 1.f : 0.f; }
    }
    const int r0 = 2 * ia, rq = r0 + (c >> 4), cq = wid * 16 + (c & 15);
    int sr0 = r0 - 4; sr0 = sr0 < 0 ? 0 : (sr0 > 248 ? 248 : sr0);
    int srq = rq - 4; srq = srq < 0 ? 0 : (srq > 248 ? 248 : srq);
    int sr1 = r0 + 1 - 4; sr1 = sr1 < 0 ? 0 : (sr1 > 248 ? 248 : sr1);
    int csq = cq - 8; csq = csq < 0 ? 0 : (csq > 48 ? 48 : csq);
    const int koff = wid == 0 ? 0 : wid == 1 ? 8 : wid == 2 ? 24 : 32;
    const float* bq = rpbs + (7 - rq) * 31 + koff - cq + 15;
    if (kind == 1) {
        const float* rp = p->rpb + ((long)layer * 8 + h) * 465;
        for (int i = lane; i < 465; i += 64) rpbs[i] = rp[i];
    }
    const int nloc = kind == 0 ? 5 : kind == 1 ? 9 : 0, nt = nloc + 4;
    const int wt0 = (q0 >> 6) - 2;
    auto tile_row = [&](int i) -> int {
        if (i >= nloc) return NLAT + (i - nloc) * 64;
        if (kind == 0) { const int s0 = ((ia * 32) >> 6) - 2 + i; return (s0 < 0 || s0 >= NLAT / 64) ? -1 : s0 * 64; }
        const int kr = sr0 + i; return (kr > sr1 + 7) ? -1 : kr * 64;
    };
    const int skey = tid >> 4, sc16 = tid & 15;
    const int scol = sc16 < 8 ? (sc16 < 4 ? colK1 + sc16 * 8 : colK2 + (sc16 - 4) * 8) : colV + (sc16 - 8) * 8;
    const int sdst = (sc16 < 8 ? 0 : 64 * 72) + skey * 72 + (sc16 & 7) * 8;
    u32x4 pre[4];
    auto load_tile = [&](int row0) {
#pragma unroll
        for (int j = 0; j < 4; ++j) pre[j] = *(const u32x4*)(P_px(p) + (long)(row0 + skey + 16 * j) * INC + scol);
    };
    auto store_tile = [&](int buf) {
#pragma unroll
        for (int j = 0; j < 4; ++j) *(u32x4*)(KV + buf * (2 * 64 * 72) + sdst + 16 * j * 72) = pre[j];
    };
    __syncthreads();
    int rowc = tile_row(0);
    if (rowc >= 0) { load_tile(rowc); store_tile(0); }
    __syncthreads();
    for (int i = 0; i < nt; ++i) {
        const int rown = (i + 1 < nt) ? tile_row(i + 1) : -1;
        if (rown >= 0) load_tile(rown);
        if (rowc >= 0) {
            const u16* Ks = KV + (i & 1) * (2 * 64 * 72);
            const u16* Vs = Ks + 64 * 72;
            if (i >= nloc) fa_tile<0>(st, Ks, Vs, 0, nullptr);
            else if (kind == 0) { if (i == 0 || i == 4) fa_tile<1>(st, Ks, Vs, rowc - q0, nullptr); else fa_tile<0>(st, Ks, Vs, 0, nullptr); }
            else { const int kr = sr0 + i; fa_tile_na32(st, Ks, Vs, koff, kr >= srq && kr < srq + 8, csq, bq + kr * 31); }
        }
        if (rown >= 0) store_tile((i + 1) & 1);
        rowc = rown;
        __syncthreads();
    }
    u16* y = isna ? P_yc(p) : P_yb(p);
    {
        float lt = st.l + __shfl_xor(st.l, 32);
        float inv = 1.f / lt;
        u16* ob = KV + wid * (32 * 72);
#pragma unroll
        for (int db = 0; db < 2; ++db)
#pragma unroll
            for (int g = 0; g < 4; ++g) {
                uint2 o;
                o.x = pack2(st.o[db][4 * g] * inv, st.o[db][4 * g + 1] * inv);
                o.y = pack2(st.o[db][4 * g + 2] * inv, st.o[db][4 * g + 3] * inv);
                *(uint2*)(ob + c * 72 + db * 32 + 8 * g + 4 * hh) = o;
            }
#pragma unroll
        for (int i = 0; i < 4; ++i) {
            const int idx = i * 64 + lane, qi = idx >> 3, ch = idx & 7;
            const int tq = (kind == 1) ? q0 + (qi >> 4) * 64 + wid * 16 + (qi & 15) : q0 + qi;
            *(u32x4*)(y + (long)tq * 512 + h * 64 + ch * 8) = *(const u32x4*)(ob + qi * 72 + ch * 8);
        }
    }
}

DI void ret_gammas(KP p, int layer, int h, float& lgf2, float& lgb2) {
    float xf = p->decay[layer * 8 + h], xb = p->decay[layer * 8 + 4 + h];
    lgf2 = -log1pf(expf(-xf)) * 1.4426950408889634f;
    lgb2 = -log1pf(expf(-xb)) * 1.4426950408889634f;
}
DI void phC_state_item(KP p, int layer, int c, int h, int eh, char* smem) {
    const int tid = TIDX(), lane = tid & 63, wid = tid >> 6, wr = wid >> 1, wc = wid & 1, fr = lane & 15, fq = lane >> 4;
    u16* Av = (u16*)smem;
    u16* Bf = Av + 64 * 72;
    u16* Bb = Bf + 128 * 72;
    float lgf2, lgb2; ret_gammas(p, layer, h, lgf2, lgb2);
    f32x4 accF[2][4], accB[2][4]; zero_acc<2>(accF); zero_acc<2>(accB);
    const u16* base = P_px(p) + (long)c * 128 * INC;
#pragma unroll 1
    for (int jh = 0; jh < 2; ++jh) {
        const int j = jh * 64 + (tid & 63);
        const float zf = exp2f((float)(127 - j) * lgf2), zb = exp2f((float)j * lgb2);
        __syncthreads();
        stage_t64<false, 64>(Av, 72, base + (long)jh * 64 * INC + C_VR + h * 128 + eh * 64, INC, 1.f);
#pragma unroll
        for (int x = 0; x < 2; ++x) {
            stage_t64<true, 64>(Bf + x * 64 * 72, 72, base + (long)jh * 64 * INC + col_kr(h, x), INC, zf);
            stage_t64<true, 64>(Bb + x * 64 * 72, 72, base + (long)jh * 64 * INC + col_kr(h, x), INC, zb);
        }
        __syncthreads();
        mma_lds64<2>(accF, Av, 72, Bf, 72);
        mma_lds64<2>(accB, Av, 72, Bb, 72);
    }
    float* Sf = P_S(p) + ((long)(c * 4 + h) * 2 + 0) * 16384;
    float* Sb = Sf + 16384;
#pragma unroll
    for (int m = 0; m < 2; ++m)
#pragma unroll
        for (int n = 0; n < 4; ++n)
#pragma unroll
            for (int j = 0; j < 4; ++j) {
                int e = eh * 64 + wr * 32 + m * 16 + fq * 4 + j, d = wc * 64 + n * 16 + fr;
                Sf[e * 128 + d] = accF[m][n][j];
                Sb[e * 128 + d] = accB[m][n][j];
            }
}

DI void phD_item(KP p, int layer, int item) {
    const int h = item >> 7, dir = (item >> 6) & 1, pos = (item & 63) * 256 + TIDX();
    float lgf2, lgb2; ret_gammas(p, layer, h, lgf2, lgb2);
    const float decay = exp2f(128.f * (dir == 0 ? lgf2 : lgb2));
    float r = 0.f;
    const long hs = (long)(h * 2 + dir) * 16384 + pos;
    auto chunk_at = [&](int i) -> int {
        if (dir == 0) return i < 2 ? 128 + i : i - 2;
        return i < 2 ? 129 - i : 129 - i;
    };
    for (int i0 = 0; i0 < NCHUNK; i0 += 13) {
        float s[13];
#pragma unroll
        for (int u = 0; u < 13; ++u) s[u] = P_S(p)[(long)chunk_at(i0 + u) * 8 * 16384 + hs];
#pragma unroll
        for (int u = 0; u < 13; ++u) {
            P_R(p)[(long)chunk_at(i0 + u) * 8 * 16384 + hs] = f2bf(r);
            r = decay * r + s[u];
        }
    }
}

DI void phE_item(KP p, int layer, int c, int h, int ih, char* smem) {
    const int tid = TIDX(), lane = tid & 63, wid = tid >> 6, wr = wid >> 1, wc = wid & 1, fr = lane & 15, fq = lane >> 4;
    u16* R0 = (u16*)smem;
    u16* R1 = R0 + 64 * 72;
    u16* R2 = R1 + 128 * 72;
    u16* P = (u16*)smem;
    float* red = (float*)(smem + (64 + 128 + 128) * 72 * 2);
    float lgf2, lgb2; ret_gammas(p, layer, h, lgf2, lgb2);
    const u16* base = P_px(p) + (long)c * 128 * INC;
    const u16* qbase = base + (long)ih * 64 * INC;
    const u16* Rf = P_R(p) + ((long)(c * 4 + h) * 2 + 0) * 16384;
    const u16* Rb = Rf + 16384;
    f32x4 Y[2][4], T[2][4];
    zero_acc<2>(Y); zero_acc<2>(T);
#pragma unroll 1
    for (int dh = 0; dh < 2; ++dh) {
        __syncthreads();
        stage_n64<64>(R0, 72, qbase + col_qr(h, dh), INC);
        stage_n64<128>(R1, 72, Rf + dh * 64, 128);
        stage_n64<128>(R2, 72, Rb + dh * 64, 128);
        __syncthreads();
        mma_lds64<2>(Y, R0, 72, R1, 72);
        mma_lds64<2>(T, R0, 72, R2, 72);
    }
#pragma unroll
    for (int m = 0; m < 2; ++m)
#pragma unroll
        for (int j = 0; j < 4; ++j) {
            int i = ih * 64 + wr * 32 + m * 16 + fq * 4 + j;
            float xf = exp2f((float)(i + 1) * lgf2), xb = exp2f((float)(128 - i) * lgb2);
#pragma unroll
            for (int n = 0; n < 4; ++n) Y[m][n][j] = xf * Y[m][n][j] + xb * T[m][n][j];
        }
    zero_acc<2>(T);
#pragma unroll 1
    for (int dh = 0; dh < 2; ++dh) {
        __syncthreads();
        stage_n64<64>(R0, 72, qbase + col_qr(h, dh), INC);
        stage_n64<128>(R1, 72, base + col_kr(h, dh), INC);
        __syncthreads();
        mma_lds64<2>(T, R0, 72, R1, 72);
    }
    __syncthreads();
#pragma unroll
    for (int m = 0; m < 2; ++m)
#pragma unroll
        for (int n = 0; n < 4; ++n)
#pragma unroll
            for (int j = 0; j < 4; ++j) {
                int il = wr * 32 + m * 16 + fq * 4 + j, i = ih * 64 + il, jj = wc * 64 + n * 16 + fr;
                float dm = (i >= jj) ? exp2f((float)(i - jj) * lgf2) : exp2f((float)(jj - i) * lgb2);
                P[il * 136 + jj] = f2bf(T[m][n][j] * dm);
            }
#pragma unroll 1
    for (int jh = 0; jh < 2; ++jh) {
        __syncthreads();
        stage_t64<false, 128>(R2, 72, base + (long)jh * 64 * INC + C_VR + h * 128, INC, 1.f);
        __syncthreads();
        mma_lds64<2>(Y, P + jh * 64, 136, R2, 72);
    }
    float mu[2][4], rs[2][4];
#pragma unroll
    for (int m = 0; m < 2; ++m)
#pragma unroll
        for (int j = 0; j < 4; ++j) {
            float s = Y[m][0][j] + Y[m][1][j] + Y[m][2][j] + Y[m][3][j];
            s += __shfl_xor(s, 1); s += __shfl_xor(s, 2); s += __shfl_xor(s, 4); s += __shfl_xor(s, 8);
            if (fr == 0) red[(wr * 32 + m * 16 + fq * 4 + j) * 2 + wc] = s;
        }
    __syncthreads();
#pragma unroll
    for (int m = 0; m < 2; ++m)
#pragma unroll
        for (int j = 0; j < 4; ++j) { int il = wr * 32 + m * 16 + fq * 4 + j; mu[m][j] = (red[il * 2] + red[il * 2 + 1]) * (1.f / 128.f); }
    __syncthreads();
#pragma unroll
    for (int m = 0; m < 2; ++m)
#pragma unroll
        for (int j = 0; j < 4; ++j) {
            float s = 0.f;
#pragma unroll
            for (int n = 0; n < 4; ++n) { float d = Y[m][n][j] - mu[m][j]; s += d * d; }
            s += __shfl_xor(s, 1); s += __shfl_xor(s, 2); s += __shfl_xor(s, 4); s += __shfl_xor(s, 8);
            if (fr == 0) red[(wr * 32 + m * 16 + fq * 4 + j) * 2 + wc] = s;
        }
    __syncthreads();
#pragma unroll
    for (int m = 0; m < 2; ++m)
#pragma unroll
        for (int j = 0; j < 4; ++j) { int il = wr * 32 + m * 16 + fq * 4 + j; rs[m][j] = rsqrtf((red[il * 2] + red[il * 2 + 1]) * (1.f / 128.f) + 1e-6f); }
    const float* gn = p->ret_gn + layer * 512 + h * 128;
#pragma unroll
    for (int m = 0; m < 2; ++m)
#pragma unroll
        for (int n = 0; n < 4; ++n)
#pragma unroll
            for (int j = 0; j < 4; ++j) {
                int i = ih * 64 + wr * 32 + m * 16 + fq * 4 + j, e = wc * 64 + n * 16 + fr;
                long row = (long)c * 128 + i;
                float g = bf2f(P_px(p)[row * INC + C_GR + h * 128 + e]);
                float o = (Y[m][n][j] - mu[m][j]) * rs[m][j] * gn[e] * siluf_(g);
                P_ya(p)[row * 512 + h * 128 + e] = f2bf(o);
            }
    __syncthreads();
}

DI void phF_tile(KP p, int mt, int nt, int b, int ks, char* smem) {
    const int tid = TIDX(), lane = tid & 63, wid = tid >> 6, wr = wid >> 1, wc = wid & 1, fr = lane & 15, fq = lane >> 4;
    const int r0 = tid >> 2, ko = (tid & 3) * 8 + ks * 64;
    float* macc = P_maccx(p) - (long)NLAT * DM;
    const u16* y = (b == 0 ? P_ya(p) : b == 1 ? P_yb(p) : P_yc(p));
    const u16* w = (b == 0 ? P_wt_ret(p) : b == 1 ? P_wt_win(p) : P_wt_na(p));
    f32x4 acc[4][4]; zero_acc<4>(acc);
    const u16* a0 = y + (long)(mt * 128 + r0) * 512 + ko;
    const u16* b0 = w + (long)(nt * 128 + r0) * 512 + ko;
    gemm_core<2>(acc, a0, a0 + 64 * 512, b0, b0 + 64 * 512, smem);
    int zero = 0; asm volatile("" : "+v"(zero));
#pragma unroll
    for (int m = 0; m < 4; ++m)
#pragma unroll
        for (int n = 0; n < 4; ++n)
#pragma unroll
            for (int j = 0; j < 4; ++j) {
                int row = mt * 128 + wr * 64 + m * 16 + fq * 4 + j + zero, col = nt * 128 + wc * 64 + n * 16 + fr;
                float g = bf2f(P_px(p)[(long)row * INC + C_GATE + b * 1024 + col]);
                unsafeAtomicAdd(macc + (long)row * DM + col, acc[m][n][j] * sigmoidf_(g));
            }
}
DI void phG_tile(KP p, int layer, int mt, int nt, int ks, char* smem) {
    const int tid = TIDX(), lane = tid & 63, wid = tid >> 6, wr = wid >> 1, wc = wid & 1, fr = lane & 15, fq = lane >> 4;
    f32x4 acc[4][4]; zero_acc<4>(acc);
    const int r0 = tid >> 2, ko = (tid & 3) * 8 + ks * 32;
    const float* a0 = P_maccx(p) + (long)((mt - 128) * 128 + r0) * DM + ko;
    const u16* b0 = P_wt_out(p) + (long)(nt * 128 + r0) * DM + ko;
    gemm_core_af32<1>(acc, a0, a0 + 64 * DM, b0, b0 + 64 * DM, smem);
    const float* md = P_mod(p) + (layer * 2 + 1) * 6144 + 2 * 1024;
    int zero = 0; asm volatile("" : "+v"(zero));
#pragma unroll
    for (int m = 0; m < 4; ++m)
#pragma unroll
        for (int n = 0; n < 4; ++n)
#pragma unroll
            for (int j = 0; j < 4; ++j) {
                int row = mt * 128 + wr * 64 + m * 16 + fq * 4 + j + zero, col = nt * 128 + wc * 64 + n * 16 + fr;
                unsafeAtomicAdd(P_ctxres(p) + (long)(row - NLAT) * DM + col, md[col] * acc[m][n][j]);
            }
}


#define LAS __attribute__((address_space(3)))
namespace g8 {
constexpr int BM = 256, BK = 64, HALF = 128, HTB = HALF * BK * 2, STAGE_BYTES = 8 * HTB;
DI int lds_byte(int r, int c) { const int st = (r >> 4) * 2 + (c >> 5), rr = r & 15, cc = c & 31, ob = rr * 64 + cc * 2; return st * 1024 + (ob ^ (((ob >> 9) & 1) << 5)); }
DI void stage_rc(int b, int& R, int& C) { const int st = b / 1024, sb = b % 1024, swz = sb ^ (((sb >> 9) & 1) << 5); R = (st >> 1) * 16 + swz / 64; C = (st & 1) * 32 + (swz % 64) / 2; }
DI int perm32(int rho) { const int n = rho >> 4, i = rho & 15; return 8 * (i >> 2) + 4 * n + (i & 3); }
struct Unit { int pm, pn, aux; };
typedef f32x4 Acc[2][2][4][2];

template <class P>
DI void gemm_phase(LAS unsigned char* lds, const P& prob) {
    const int tid = TID512(), wid = __builtin_amdgcn_readfirstlane(tid >> 6), lane = tid & 63, wr = wid >> 2, wc = wid & 3, fr = lane & 15, fq = lane >> 4;
    constexpr int K = P::K, nt = K / BK;
    int Rr[2], Cc[2];
    unsigned voffA[2], voffB[2];
#pragma unroll
    for (int i = 0; i < 2; ++i) { stage_rc(tid * 16 + i * 8192, Rr[i], Cc[i]); const int Rb = P::PERM ? ((Rr[i] & ~31) + perm32(Rr[i] & 31)) : Rr[i];
        voffA[i] = (unsigned)(Rr[i] * K + Cc[i]) * 2u; voffB[i] = (unsigned)(Rb * K + Cc[i]) * 2u; }
    constexpr size_t kstep = (size_t)(BK * 2);
    constexpr size_t hstep = (size_t)HALF * K * 2;
    const unsigned ldsw = (unsigned)wid * 1024u;
    const int aoff = lds_byte(wr * 64 + fr, fq * 8), boff = lds_byte(wc * 32 + fr, fq * 8);
    unsigned vaC[2][2], vaN[2][2];
#define G8_SA(b, h) (((b) * 2 + (h)) * HTB)
#define G8_SB(b, h) ((4 + (b) * 2 + (h)) * HTB)
#define G8_STAGEA(bufoff, base, VA, h, kt) do { _Pragma("unroll") for (int _i = 0; _i < 2; ++_i) \
        __builtin_amdgcn_global_load_lds((const unsigned*)((base) + (P::GATHER ? (size_t)(VA)[h][_i] : (size_t)voffA[_i] + (size_t)(h) * hstep) + (size_t)(kt) * kstep), (LAS unsigned*)(lds + (bufoff) + ldsw + _i * 8192), 16, 0, 0); } while (0)
#define G8_STAGEB(bufoff, base, h, kt) do { _Pragma("unroll") for (int _i = 0; _i < 2; ++_i) \
        __builtin_amdgcn_global_load_lds((const unsigned*)((base) + (size_t)(h) * hstep + voffB[_i] + (size_t)(kt) * kstep), (LAS unsigned*)(lds + (bufoff) + ldsw + _i * 8192), 16, 0, 0); } while (0)
#define G8_LDA(dst, b, h) do { _Pragma("unroll") for (int m = 0; m < 4; ++m) _Pragma("unroll") for (int k = 0; k < 2; ++k) dst[m][k] = *(const LAS bf16x8*)(lds + G8_SA(b, h) + aoff + m * 2048 + k * 1024); } while (0)
#define G8_LDB(dst, b, h) do { _Pragma("unroll") for (int n = 0; n < 2; ++n) _Pragma("unroll") for (int k = 0; k < 2; ++k) dst[n][k] = *(const LAS bf16x8*)(lds + G8_SB(b, h) + boff + n * 2048 + k * 1024); } while (0)
#define G8_MMA(ai, bj, At, Bt) do { __builtin_amdgcn_s_setprio(1); _Pragma("unroll") for (int m = 0; m < 4; ++m) _Pragma("unroll") for (int n = 0; n < 2; ++n) _Pragma("unroll") for (int k = 0; k < 2; ++k) \
        acc[ai][bj][m][n] = __builtin_amdgcn_mfma_f32_16x16x32_bf16(Bt[n][k], At[m][k], acc[ai][bj][m][n], 0, 0, 0); __builtin_amdgcn_s_setprio(0); } while (0)
#define G8_WAIT_V(n) asm volatile("s_waitcnt vmcnt(" #n ")" ::: "memory")
#define G8_WAIT_L(n) asm volatile("s_waitcnt lgkmcnt(" #n ")" ::: "memory")
#define G8_BAR __builtin_amdgcn_s_barrier()
#define G8_SCHED __builtin_amdgcn_sched_barrier(0)
    Unit cur, nxt; int ui = 0;
    __syncthreads();
    if (!prob.next(0, cur)) return;
    if (P::GATHER) prob.gather(cur, Rr, Cc, vaC);
    const char* cA = prob.a_base(cur); const char* cB = prob.b_base(cur);
    Acc acc;
#pragma unroll
    for (int a = 0; a < 2; ++a)
#pragma unroll
        for (int b = 0; b < 2; ++b)
#pragma unroll
            for (int m = 0; m < 4; ++m)
#pragma unroll
                for (int n = 0; n < 2; ++n) acc[a][b][m][n] = (f32x4){0.f, 0.f, 0.f, 0.f};
    bf16x8 At[4][2], B0[2][2], B1[2][2];
    G8_STAGEB(G8_SB(0, 0), cB, 0, 0); G8_STAGEA(G8_SA(0, 0), cA, vaC, 0, 0); G8_STAGEB(G8_SB(0, 1), cB, 1, 0); G8_STAGEA(G8_SA(0, 1), cA, vaC, 1, 0);
    if (wr == 1) G8_BAR;
    G8_WAIT_V(4); G8_BAR;
    G8_STAGEB(G8_SB(1, 0), cB, 0, 1); G8_STAGEA(G8_SA(1, 0), cA, vaC, 0, 1); G8_STAGEB(G8_SB(1, 1), cB, 1, 1);
    G8_WAIT_V(6); G8_BAR;
    for (;;) {
        const bool has_next = prob.next(ui + 1, nxt);
        if (!has_next) nxt = cur;
        if (P::GATHER) {
            if (has_next) prob.gather(nxt, Rr, Cc, vaN);
            else {
#pragma unroll
                for (int h = 0; h < 2; ++h) { vaN[h][0] = vaC[h][0]; vaN[h][1] = vaC[h][1]; }
            }
        }
        const char* nA = prob.a_base(nxt); const char* nB = prob.b_base(nxt);
#pragma unroll 1
        for (int t = 0; t < nt; t += 2) {
            const bool last = (t == nt - 2);
            const char* a2 = last ? nA : cA; const char* b2 = last ? nB : cB; const int k2 = last ? 0 : t + 2;
            unsigned va2[2][2];
#pragma unroll
            for (int h = 0; h < 2; ++h) { va2[h][0] = last ? vaN[h][0] : vaC[h][0]; va2[h][1] = last ? vaN[h][1] : vaC[h][1]; }
            G8_LDB(B0, 0, 0); G8_SCHED; G8_LDA(At, 0, 0); G8_STAGEA(G8_SA(1, 1), cA, vaC, 1, t + 1);
            G8_WAIT_L(8); G8_BAR; G8_WAIT_L(0); G8_MMA(0, 0, At, B0); G8_BAR; G8_SCHED;
            G8_LDB(B1, 0, 1); G8_STAGEB(G8_SB(0, 0), b2, 0, k2);
            G8_BAR; G8_WAIT_L(0); G8_MMA(0, 1, At, B1); G8_BAR;
            G8_LDA(At, 0, 1); G8_STAGEA(G8_SA(0, 0), a2, va2, 0, k2);
            G8_BAR; G8_WAIT_L(0); G8_MMA(1, 0, At, B0); G8_BAR; G8_SCHED;
            G8_STAGEB(G8_SB(0, 1), b2, 1, k2);
            G8_WAIT_V(6); G8_BAR; G8_MMA(1, 1, At, B1); G8_BAR;
            G8_LDB(B0, 1, 0); G8_SCHED; G8_LDA(At, 1, 0); G8_STAGEA(G8_SA(0, 1), a2, va2, 1, k2);
            G8_WAIT_L(8); G8_BAR; G8_WAIT_L(0); G8_MMA(0, 0, At, B0); G8_BAR; G8_SCHED;
            G8_LDB(B1, 1, 1); G8_STAGEB(G8_SB(1, 0), b2, 0, k2 + 1);
            G8_BAR; G8_WAIT_L(0); G8_MMA(0, 1, At, B1); G8_BAR;
            G8_LDA(At, 1, 1); G8_STAGEA(G8_SA(1, 0), a2, va2, 0, k2 + 1);
            G8_BAR; G8_WAIT_L(0); G8_MMA(1, 0, At, B0); G8_BAR; G8_SCHED;
            G8_STAGEB(G8_SB(1, 1), b2, 1, k2 + 1);
            G8_WAIT_V(6); G8_BAR; G8_MMA(1, 1, At, B1); G8_BAR;
        }
        { const int l2 = TID512() & 63; prob.epi(acc, cur, wr, wc, l2 & 15, l2 >> 4); }
        if (!has_next) break;
#pragma unroll
        for (int a = 0; a < 2; ++a)
#pragma unroll
            for (int b = 0; b < 2; ++b)
#pragma unroll
                for (int m = 0; m < 4; ++m)
#pragma unroll
                    for (int n = 0; n < 2; ++n) acc[a][b][m][n] = (f32x4){0.f, 0.f, 0.f, 0.f};
        cur = nxt; cA = nA; cB = nB; ++ui;
        if (P::GATHER) {
#pragma unroll
            for (int h = 0; h < 2; ++h) { vaC[h][0] = vaN[h][0]; vaC[h][1] = vaN[h][1]; }
        }
    }
    G8_WAIT_V(0);
    if (wr == 0) G8_BAR;
    G8_BAR;
#undef G8_SA
#undef G8_SB
#undef G8_STAGEA
#undef G8_STAGEB
#undef G8_LDA
#undef G8_LDB
#undef G8_MMA
#undef G8_WAIT_V
#undef G8_WAIT_L
#undef G8_BAR
#undef G8_SCHED
}
}

struct ProbG {
    static constexpr int K = 1024; static constexpr bool PERM = false, GATHER = false;
    KP p; int layer;
    DI bool next(int i, g8::Unit& u) const {
        const int id = i * (int)gridDim.x + BIDX();
        if (id >= 256) return false;
        u.pm = id >> 2; u.pn = id & 3; u.aux = 0;
        return true;
    }
    DI const char* a_base(const g8::Unit& u) const { return (const char*)(P_hx(p) + (long)u.pm * 256 * DM); }
    DI const char* b_base(const g8::Unit& u) const { return (const char*)(P_wt_out(p) + (long)u.pn * 256 * DM); }
    DI void gather(const g8::Unit&, const int (&)[2], const int (&)[2], unsigned (&)[2][2]) const {}
    DI void epi(g8::Acc& acc, const g8::Unit& u, int wr, int wc, int fr, int fq) const {
        const float* xin = layer == 0 ? p->x : p->out;
        const float* md = P_mod(p) + (layer * 2) * 6144 + 2 * 1024;
#pragma unroll
        for (int bj = 0; bj < 2; ++bj)
#pragma unroll
            for (int n = 0; n < 2; ++n) {
                const int col = u.pn * 256 + bj * 128 + wc * 32 + n * 16 + fq * 4;
                const f32x4 mv = *(const f32x4*)(md + col);
#pragma unroll
                for (int ai = 0; ai < 2; ++ai)
#pragma unroll
                    for (int m = 0; m < 4; ++m) {
                        const long row = (long)u.pm * 256 + ai * 128 + wr * 64 + m * 16 + fr;
                        const f32x4 xv = *(const f32x4*)(xin + row * DM + col);
                        *(f32x4*)(p->out + row * DM + col) = xv + mv * acc[ai][bj][m][n];
                    }
            }
    }
};


struct ProbB {
    static constexpr int K = 1024; static constexpr bool PERM = true, GATHER = false;
    KP p;
    DI bool next(int i, g8::Unit& u) const {
        constexpr int nM = 65, nN = 29, nwg = nM * nN, NX = 8, WGM = 8;
        const long L = (long)i * (int)gridDim.x + BIDX(); if (L >= nwg) return false;
        int wgid = (int)L; { const int q = nwg / NX, r = nwg % NX, xcd = wgid % NX, off = wgid / NX; wgid = (xcd < r ? xcd * (q + 1) : r * (q + 1) + (xcd - r) * q) + off; }
        const int nig = WGM * nN, gid = wgid / nig, fm = gid * WGM, gsz = (nM - fm) < WGM ? (nM - fm) : WGM;
        u.pm = fm + ((wgid % nig) % gsz); u.pn = (wgid % nig) / gsz; u.aux = 0; return true;
    }
    DI const char* a_base(const g8::Unit& u) const { return (const char*)(P_hx(p) + (long)u.pm * 256 * DM); }
    DI const char* b_base(const g8::Unit& u) const { return (const char*)(P_wt_in(p) + (long)u.pn * 256 * DM); }
    DI void gather(const g8::Unit&, const int (&)[2], const int (&)[2], unsigned (&)[2][2]) const {}
    DI void epi(g8::Acc& acc, const g8::Unit& u, int wr, int wc, int fr, int fq) const {
        const int pn = u.pn;
        const bool lat = u.pm < 64;
        const int rk = !lat ? 0 : (pn < 4) ? 1 : (pn == 8 || pn == 9 || (pn == 10 && wc < 2)) ? 2 : 0;
        const float mul = (pn == 2 || pn == 3) ? 0.08838834764831845f : (pn == 8 || pn == 9 || pn == 11 || pn == 12) ? 0.125f : 1.f;
#pragma unroll
        for (int ai = 0; ai < 2; ++ai)
#pragma unroll
            for (int m = 0; m < 4; ++m) {
                const int row = u.pm * 256 + ai * 128 + wr * 64 + m * 16 + fr;
                if (rk != 0) {
                    const float2* tab;
                    if (rk == 1) tab = P_rope128(p) + ((wc & 1) ? (row & 63) : (row >> 6)) * 32 + fq * 8;
                    else tab = P_rope64(p) + ((fq >= 2) ? (row & 63) : (row >> 6)) * 16 + (fq & 1) * 8;
#pragma unroll
                    for (int n = 0; n < 2; ++n) {
                        const f32x4 c01 = *(const f32x4*)(tab + n * 4), c23 = *(const f32x4*)(tab + n * 4 + 2);
                        const float cs_[4] = {c01[0], c01[2], c23[0], c23[2]}, sn_[4] = {c01[1], c01[3], c23[1], c23[3]};
#pragma unroll
                        for (int e = 0; e < 4; ++e) {
                            const float x1 = acc[ai][0][m][n][e], x2 = acc[ai][1][m][n][e];
                            acc[ai][0][m][n][e] = x1 * cs_[e] - x2 * sn_[e];
                            acc[ai][1][m][n][e] = x1 * sn_[e] + x2 * cs_[e];
                        }
                    }
                }
                u16* orow = P_px(p) + (long)row * INC + pn * 256 + wc * 32 + fq * 8;
#pragma unroll
                for (int bj = 0; bj < 2; ++bj) {
                    u32x4 o;
#pragma unroll
                    for (int n = 0; n < 2; ++n)
#pragma unroll
                        for (int e = 0; e < 2; ++e) o[2 * n + e] = pack2(acc[ai][bj][m][n][2 * e] * mul, acc[ai][bj][m][n][2 * e + 1] * mul);
                    *(u32x4*)(orow + bj * 128) = o;
                }
            }
    }
};
struct ProbF {
    static constexpr int K = 512; static constexpr bool PERM = true, GATHER = false;
    KP p;
    DI bool next(int i, g8::Unit& u) const {
        const int tile = (i / 3) * (int)gridDim.x + BIDX();
        if (tile >= 256) return false;
        u.pm = tile >> 2; u.pn = tile & 3; u.aux = i % 3;
        return true;
    }
    DI const char* a_base(const g8::Unit& u) const { const u16* y = u.aux == 0 ? P_ya(p) : u.aux == 1 ? P_yb(p) : P_yc(p); return (const char*)(y + (long)u.pm * 256 * 512); }
    DI const char* b_base(const g8::Unit& u) const { const u16* w = u.aux == 0 ? P_wt_ret(p) : u.aux == 1 ? P_wt_win(p) : P_wt_na(p); return (const char*)(w + (long)u.pn * 256 * 512); }
    DI void gather(const g8::Unit&, const int (&)[2], const int (&)[2], unsigned (&)[2][2]) const {}
    DI void epi(g8::Acc& acc, const g8::Unit& u, int wr, int wc, int fr, int fq) const {
        const int b = u.aux;
        const long row0 = (long)u.pm * 256 + wr * 64 + fr;
        const int col0 = u.pn * 256 + wc * 32 + fq * 8;
        if (b != 2) {
            u16* z = P_z(p) + (long)b * NLAT * DM;
#pragma unroll
            for (int ai = 0; ai < 2; ++ai)
#pragma unroll
                for (int m = 0; m < 4; ++m)
#pragma unroll
                    for (int bj = 0; bj < 2; ++bj) {
                        u32x4 o;
#pragma unroll
                        for (int n = 0; n < 2; ++n)
#pragma unroll
                            for (int e = 0; e < 2; ++e) o[2 * n + e] = pack2(acc[ai][bj][m][n][2 * e], acc[ai][bj][m][n][2 * e + 1]);
                        *(u32x4*)(z + (row0 + ai * 128 + m * 16) * DM + col0 + bj * 128) = o;
                    }
            return;
        }
        const u16* zb = P_z(p);
        const u16* gp = P_px(p) + C_GATE;
#pragma unroll
        for (int ai = 0; ai < 2; ++ai)
#pragma unroll
            for (int m = 0; m < 4; ++m)
#pragma unroll
                for (int bj = 0; bj < 2; ++bj) {
                    const long row = row0 + ai * 128 + m * 16; const int col = col0 + bj * 128;
                    u32x4 zv[2], gv[3];
#pragma unroll
                    for (int q = 0; q < 2; ++q) zv[q] = *(const u32x4*)(zb + ((long)q * NLAT + row) * DM + col);
#pragma unroll
                    for (int q = 0; q < 3; ++q) gv[q] = *(const u32x4*)(gp + row * INC + q * 1024 + col);
                    u32x4 o;
#pragma unroll
                    for (int e = 0; e < 4; ++e) {
                        const int n = e >> 1, e2 = (e & 1) * 2;
                        float lo = acc[ai][bj][m][n][e2] * sigmoidf_(bflo(gv[2][e])), hi = acc[ai][bj][m][n][e2 + 1] * sigmoidf_(bfhi(gv[2][e]));
#pragma unroll
                        for (int q = 0; q < 2; ++q) { lo += bflo(zv[q][e]) * sigmoidf_(bflo(gv[q][e])); hi += bfhi(zv[q][e]) * sigmoidf_(bfhi(gv[q][e])); }
                        o[e] = pack2(lo, hi);
                    }
                    *(u32x4*)(P_hx(p) + row * DM + col) = o;
                }
    }
};
struct ProbJ {
    static constexpr int K = 1024; static constexpr bool PERM = true, GATHER = true;
    KP p;
    DI bool next(int i, g8::Unit& u) const {
        const int id = i * (int)gridDim.x + BIDX();
        if (id >= 1024) return false;
        u.aux = id >> 6; u.pm = (id >> 3) & 7; u.pn = id & 7;
        return true;
    }
    DI const char* a_base(const g8::Unit&) const { return (const char*)P_hx(p); }
    DI const char* b_base(const g8::Unit& u) const { return (const char*)(P_wt_gu(p) + ((long)u.aux * 2048 + u.pn * 256) * DM); }
    DI void gather(const g8::Unit& u, const int (&R)[2], const int (&C)[2], unsigned (&va)[2][2]) const {
        const int* si = P_sel_idx(p) + u.aux * 2048 + u.pm * 256;
#pragma unroll
        for (int h = 0; h < 2; ++h)
#pragma unroll
            for (int j = 0; j < 2; ++j) va[h][j] = (unsigned)(si[h * 128 + R[j]] * DM + C[j]) * 2u;
    }
    DI void epi(g8::Acc& acc, const g8::Unit& u, int wr, int wc, int fr, int fq) const {
        u16* hb = P_hid(p) + (long)u.aux * 2048 * EH;
#pragma unroll
        for (int ai = 0; ai < 2; ++ai)
#pragma unroll
            for (int m = 0; m < 4; ++m) {
                const int slot = u.pm * 256 + ai * 128 + wr * 64 + m * 16 + fr;
                const int f = u.pn * 128 + wc * 32 + fq * 8;
                u32x4 o;
#pragma unroll
                for (int n = 0; n < 2; ++n)
#pragma unroll
                    for (int e = 0; e < 2; ++e)
                        o[2 * n + e] = pack2(siluf_(acc[ai][0][m][n][2 * e]) * acc[ai][1][m][n][2 * e], siluf_(acc[ai][0][m][n][2 * e + 1]) * acc[ai][1][m][n][2 * e + 1]);
                *(u32x4*)(hb + (long)slot * EH + f) = o;
            }
    }
};
struct ProbK {
    static constexpr int K = 1024; static constexpr bool PERM = true, GATHER = false;
    KP p; int layer;
    DI bool next(int i, g8::Unit& u) const {
        const int id = i * (int)gridDim.x + BIDX();
        if (id >= 512) return false;
        u.aux = id >> 5; u.pm = (id >> 2) & 7; u.pn = id & 3;
        return true;
    }
    DI const char* a_base(const g8::Unit& u) const { return (const char*)(P_hid(p) + ((long)u.aux * 2048 + u.pm * 256) * EH); }
    DI const char* b_base(const g8::Unit& u) const { return (const char*)(P_wt_dn(p) + ((long)u.aux * 1024 + u.pn * 256) * EH); }
    DI void gather(const g8::Unit&, const int (&)[2], const int (&)[2], unsigned (&)[2][2]) const {}
    DI void epi(g8::Acc& acc, const g8::Unit& u, int wr, int wc, int fr, int fq) const {
        const float* md = P_mod(p) + (layer * 2) * 6144 + 5 * 1024;
        f32x4 mv[2][2];
#pragma unroll
        for (int bj = 0; bj < 2; ++bj)
#pragma unroll
            for (int n = 0; n < 2; ++n) mv[bj][n] = *(const f32x4*)(md + u.pn * 256 + bj * 128 + wc * 32 + fq * 8 + n * 4);
#pragma unroll
        for (int ai = 0; ai < 2; ++ai)
#pragma unroll
            for (int m = 0; m < 4; ++m) {
                const int slot = u.aux * 2048 + u.pm * 256 + ai * 128 + wr * 64 + m * 16 + fr;
                const float g = P_sel_gate(p)[slot];
                u16* yr = P_ye(p) + (long)slot * DM + u.pn * 256 + wc * 32 + fq * 8;
#pragma unroll
                for (int bj = 0; bj < 2; ++bj) {
                    u32x4 o;
#pragma unroll
                    for (int n = 0; n < 2; ++n)
#pragma unroll
                        for (int e = 0; e < 2; ++e)
                            o[2 * n + e] = pack2(acc[ai][bj][m][n][2 * e] * g * mv[bj][n][2 * e], acc[ai][bj][m][n][2 * e + 1] * g * mv[bj][n][2 * e + 1]);
                    *(u32x4*)(yr + bj * 128) = o;
                }
            }
    }
};

DI void phH_item(KP p, int layer, int item, char* smem) {
    const int lane = TIDX() & 63, wid = TIDX() >> 6;
    float* hrow = (float*)smem + wid * 4096;
    const int row0 = item * 16 + wid * 4;
    norm_rows4(p, layer, row0, p->g_ffn + layer * DM, 3, 4, false, false, hrow);
    const int e = lane & 15, kp = lane >> 4;
    const float* wr_ = p->w_router + (long)layer * 1024 * 16 + e;
    float lg[4] = {0.f, 0.f, 0.f, 0.f};
#pragma unroll 8
    for (int k = kp * 256; k < kp * 256 + 256; ++k) {
        float w = wr_[k * 16];
#pragma unroll
        for (int r = 0; r < 4; ++r) lg[r] += hrow[r * 1024 + k] * w;
    }
#pragma unroll
    for (int r = 0; r < 4; ++r) {
        float l = lg[r];
        l += __shfl_xor(l, 16); l += __shfl_xor(l, 32);
        float mx = l;
        mx = fmaxf(mx, __shfl_xor(mx, 1)); mx = fmaxf(mx, __shfl_xor(mx, 2)); mx = fmaxf(mx, __shfl_xor(mx, 4)); mx = fmaxf(mx, __shfl_xor(mx, 8));
        float ex = expf(l - mx);
        float sm = ex;
        sm += __shfl_xor(sm, 1); sm += __shfl_xor(sm, 2); sm += __shfl_xor(sm, 4); sm += __shfl_xor(sm, 8);
        float a = ex / sm;
        int row = row0 + r;
        if (lane < 16) {
            if (row < NLAT) P_aff(p)[(long)e * NLAT + row] = a;
            else P_aff(p)[(long)(16 + e) * NLAT + (row - NLAT)] = a;
        }
    }
    __syncthreads();
}

DI int block_excl_scan(int v, int* sh  , int& total) {
    const int lane = TIDX() & 63, wid = TIDX() >> 6;
    int inc = v;
    for (int o = 1; o < 64; o <<= 1) { int t = __shfl_up(inc, o); if (lane >= o) inc += t; }
    __syncthreads();
    if (lane == 63) sh[wid] = inc;
    __syncthreads();
    int base = 0;
    for (int w = 0; w < wid; ++w) base += sh[w];
    total = sh[0] + sh[1] + sh[2] + sh[3];
    return base + inc - v;
}
DI void phI_item(KP p, int job, char* smem) {
    const int tid = TIDX(), lane = tid & 63, wid = tid >> 6;
    const bool lat = job < 16;
    const int n = lat ? NLAT : NCTX, cap = lat ? CAP_LAT : CAP_CTX, rowbase = lat ? 0 : NLAT;
    int* sh = (int*)smem;
    const float* a = P_aff(p) + (long)job * NLAT;
    unsigned keys[64];
    if (lat) {
#pragma unroll
        for (int i = 0; i < 16; ++i) { u32x4 v = *(const u32x4*)(a + tid * 64 + i * 4); keys[4 * i] = v[0]; keys[4 * i + 1] = v[1]; keys[4 * i + 2] = v[2]; keys[4 * i + 3] = v[3]; }
    } else {
#pragma unroll
        for (int i = 0; i < 64; ++i) keys[i] = 0u;
        keys[0] = __float_as_uint(a[tid]);
    }
    __syncthreads();
    auto block_sum = [&](int v, int it) -> int {
        for (int o = 32; o > 0; o >>= 1) v += __shfl_xor(v, o);
        int* slot = sh + (it & 1) * 4;
        if (lane == 0) slot[wid] = v;
        __syncthreads();
        return slot[0] + slot[1] + slot[2] + slot[3];
    };
    int* hist = sh + 32;
    unsigned T = 0u, pmask = 0u; int remaining = cap;
#pragma unroll 1
    for (int pass = 0; pass < 3; ++pass) {
        const int shift = pass == 0 ? 19 : pass == 1 ? 8 : 0, nb_ = pass == 2 ? 256 : 2048;
        for (int i = tid; i < 2048; i += 256) hist[i] = 0;
        __syncthreads();
#pragma unroll
        for (int i = 0; i < 64; ++i) { const unsigned k = keys[i]; if (k != 0u && (k & pmask) == T) atomicAdd(&hist[(k >> shift) & (nb_ - 1)], 1); }
        __syncthreads();
        int mine = 0;
        const int top = nb_ - 1 - 8 * tid;
        if (top >= 7) {
#pragma unroll
            for (int q = 0; q < 8; ++q) mine += hist[top - q];
        }
        int tot_;
        const int above = block_excl_scan(mine, sh + 8, tot_);
        if (top >= 7 && above < remaining && above + mine >= remaining) {
            int cum = above, q = 0;
            for (; q < 7; ++q) { const int hv = hist[top - q]; if (cum + hv >= remaining) break; cum += hv; }
            sh[16] = top - q; sh[17] = remaining - cum;
        }
        __syncthreads();
        T |= ((unsigned)sh[16]) << shift; pmask |= ((unsigned)(nb_ - 1)) << shift; remaining = sh[17];
        __syncthreads();
    }
    int ceq = 0;
#pragma unroll
    for (int i = 0; i < 64; ++i) ceq += (keys[i] == T);
    const int it = 0; (void)it; (void)block_sum;
    __syncthreads();
    int tot;
    int er = block_excl_scan(ceq, sh + 8, tot);
    int csel = 0;
    { int e2 = er;
#pragma unroll
      for (int i = 0; i < 64; ++i) { const unsigned k = keys[i]; if (k > T) ++csel; else if (k == T) { if (e2 < remaining) ++csel; ++e2; } } }
    int slot = block_excl_scan(csel, sh + 8, tot);
    int* ts = P_tslot(p) + (long)job * NLAT;
    const int per = lat ? 64 : 1;
    const int base = tid * per;
#pragma unroll
    for (int i = 0; i < 64; ++i) {
        if (i < per) {
            const unsigned k = keys[i];
            bool sel = false;
            if (k > T) sel = true; else if (k == T) { sel = er < remaining; ++er; }
            if (sel) { P_sel_idx(p)[job * 2048 + slot] = rowbase + base + i; P_sel_gate(p)[job * 2048 + slot] = __uint_as_float(k); ts[base + i] = slot; ++slot; }
            else ts[base + i] = -1;
        }
    }
    __syncthreads();
}

DI void phJ_tile(KP p, int job, int mt, int nt, char* smem) {
    const int tid = TIDX(), lane = tid & 63, wid = tid >> 6, wr = wid >> 1, wc = wid & 1, fr = lane & 15, fq = lane >> 4;
    const int cap = job < 16 ? CAP_LAT : CAP_CTX, e = job & 15;
    f32x4 acc[4][4]; zero_acc<4>(acc);
    const int r0 = tid >> 2, ko = (tid & 3) * 8;
    int s0 = mt * 128 + r0, s1 = s0 + 64;
    s0 = s0 < cap ? s0 : cap - 1; s1 = s1 < cap ? s1 : cap - 1;
    const u16* a0 = P_hx(p) + (long)P_sel_idx(p)[job * 2048 + s0] * DM + ko;
    const u16* a1 = P_hx(p) + (long)P_sel_idx(p)[job * 2048 + s1] * DM + ko;
    const int f_lo = nt * 64 + (r0 & 31), f_hi = f_lo + 32, gu = (r0 >> 5) & 1;
    const u16* b0 = P_wt_gu(p) + ((long)e * 2048 + (f_lo >> 7) * 256 + gu * 128 + (f_lo & 127)) * DM + ko;
    const u16* b1 = P_wt_gu(p) + ((long)e * 2048 + (f_hi >> 7) * 256 + gu * 128 + (f_hi & 127)) * DM + ko;
    gemm_core<32>(acc, a0, a1, b0, b1, smem);
    u16* hb = job < 16 ? P_hid(p) + (long)job * 2048 * EH : P_hidc(p) + (long)(job - 16) * 32 * EH;
#pragma unroll
    for (int m = 0; m < 4; ++m)
#pragma unroll
        for (int n = 0; n < 2; ++n)
#pragma unroll
            for (int j = 0; j < 4; ++j) {
                int slot = mt * 128 + wr * 64 + m * 16 + fq * 4 + j;
                int f = nt * 64 + wc * 32 + n * 16 + fr;
                if (slot < cap) hb[(long)slot * EH + f] = f2bf(siluf_(acc[m][n][j]) * acc[m][n + 2][j]);
            }
}
DI void phK_tile(KP p, int layer, int job, int mt, int nt, char* smem) {
    const int tid = TIDX(), lane = tid & 63, wid = tid >> 6, wr = wid >> 1, wc = wid & 1, fr = lane & 15, fq = lane >> 4;
    const int cap = job < 16 ? CAP_LAT : CAP_CTX, e = job & 15;
    f32x4 acc[4][4]; zero_acc<4>(acc);
    const int r0 = tid >> 2, ko = (tid & 3) * 8;
    int s0 = mt * 128 + r0, s1 = s0 + 64;
    s0 = s0 < cap ? s0 : cap - 1; s1 = s1 < cap ? s1 : cap - 1;
    const u16* hb = job < 16 ? P_hid(p) + (long)job * 2048 * EH : P_hidc(p) + (long)(job - 16) * 32 * EH;
    const u16* a0 = hb + (long)s0 * EH + ko;
    const u16* a1 = hb + (long)s1 * EH + ko;
    const u16* b0 = P_wt_dn(p) + ((long)e * 1024 + nt * 128 + r0) * EH + ko;
    gemm_core<32>(acc, a0, a1, b0, b0 + 64 * EH, smem);
    const float* md = P_mod(p) + (layer * 2 + (job < 16 ? 0 : 1)) * 6144 + 5 * 1024;
    u16* yb_ = job < 16 ? P_ye(p) + (long)job * 2048 * DM : P_yec(p) + (long)(job - 16) * 32 * DM;
#pragma unroll
    for (int m = 0; m < 4; ++m)
#pragma unroll
        for (int j = 0; j < 4; ++j) {
            int slot = mt * 128 + wr * 64 + m * 16 + fq * 4 + j;
            if (slot < cap) {
                float g = P_sel_gate(p)[job * 2048 + slot];
#pragma unroll
                for (int n = 0; n < 4; ++n) {
                    int col = nt * 128 + wc * 64 + n * 16 + fr;
                    yb_[(long)slot * DM + col] = f2bf(acc[m][n][j] * g * md[col]);
                }
            }
        }
}


#define XB_TMO      128
#define XB_XCNT(j)  (256  + 64 * (j))
#define XB_XSUB(j)  (1280 + 64 * (j))
#define XB_XGEN(j)  (2304 + 64 * (j))
#define XB_TOP      3328
#define XB_TOPGEN   3392
#define XCD_BAR_WORDS 3456
#define XB_SPIN_CAP (1u << 18)
DI unsigned xb_ld(unsigned* p)              { return __hip_atomic_load(p, __ATOMIC_RELAXED, __HIP_MEMORY_SCOPE_AGENT); }
DI unsigned xb_add(unsigned* p, unsigned v) { return __hip_atomic_fetch_add(p, v, __ATOMIC_RELAXED, __HIP_MEMORY_SCOPE_AGENT); }
DI unsigned xb_xcc_id() { return (unsigned)__builtin_amdgcn_s_getreg((3 << 11) | 20) & 0xFu; }
#define XB_SPIN(cond, bar) do { unsigned _sp = 0; while (cond) { __builtin_amdgcn_s_sleep(1); \
    if ((++_sp & 255u) == 0u) { if (xb_ld(&(bar)[XB_TMO])) break; if (_sp > XB_SPIN_CAP) { atomicAdd(&(bar)[XB_TMO], 1u); break; } } } } while (0)
struct XcdBarrier { unsigned* bar; unsigned x; volatile LAS unsigned* st; };
DI XcdBarrier xcd_barrier_post(unsigned* bar, volatile LAS unsigned* st) {
    XcdBarrier b; b.bar = bar; b.x = xb_xcc_id(); b.st = st;
    if (threadIdx.x == 0) (void)xb_add(&bar[XB_XCNT(b.x)], 1u);
    return b;
}
DI void xcd_barrier_complete(unsigned* bar, unsigned x, unsigned& nloc, unsigned& nx) {
    const unsigned G = gridDim.x * gridDim.y * gridDim.z;
    unsigned sum, cnt, mine, sp = 0u;
    for (;;) {
        sum = 0u; cnt = 0u; mine = 0u;
#pragma unroll
        for (unsigned j = 0; j < 16; ++j) { const unsigned c = xb_ld(&bar[XB_XCNT(j)]); sum += c; cnt += (c > 0u) ? 1u : 0u; mine = (j == x) ? c : mine; }
        if (sum == G) break;
        __builtin_amdgcn_s_sleep(1);
        if ((++sp & 255u) == 0u) { if (xb_ld(&bar[XB_TMO])) break; if (sp > XB_SPIN_CAP) { atomicAdd(&bar[XB_TMO], 1u); break; } }
    }
    nloc = mine > 0u ? mine : 1u; nx = cnt > 0u ? cnt : 1u;
}
DI void xcd_barrier(const XcdBarrier& b) {
    asm volatile("s_waitcnt vmcnt(0)" ::: "memory");
    __syncthreads();
    if (threadIdx.x == 0) {
        unsigned* bar = b.bar;
        __builtin_amdgcn_s_waitcnt(0);
        unsigned nloc = b.st[0], nx = b.st[1];
        if (nloc == 0u) { xcd_barrier_complete(bar, b.x, nloc, nx); b.st[0] = nloc; b.st[1] = nx; }
        const unsigned old = xb_add(&bar[XB_XSUB(b.x)], 1u);
        const unsigned gen = old / nloc;
        if (old + 1u == (gen + 1u) * nloc) {
            __builtin_amdgcn_fence(__ATOMIC_RELEASE, "agent");
            asm volatile("s_waitcnt vmcnt(0)" ::: "memory");
            const unsigned og = xb_add(&bar[XB_TOP], 1u);
            const unsigned tg = og / nx;
            if (og + 1u == (tg + 1u) * nx) xb_add(&bar[XB_TOPGEN], 1u);
            else XB_SPIN(xb_ld(&bar[XB_TOPGEN]) == tg, bar);
            __builtin_amdgcn_fence(__ATOMIC_ACQUIRE, "agent");
            xb_add(&bar[XB_XGEN(b.x)], 1u);
            asm volatile("s_waitcnt vmcnt(0)" ::: "memory");
        } else {
            XB_SPIN(xb_ld(&bar[XB_XGEN(b.x)]) == gen, bar);
            __builtin_amdgcn_fence(__ATOMIC_ACQUIRE, "agent");
            asm volatile("s_waitcnt vmcnt(0)" ::: "memory");
        }
    }
    __syncthreads();
}

DI void run_phase(int ph, char* smem_all, int variant = 0) {
    KP p = (KP)__builtin_amdgcn_kernarg_segment_ptr();
    asm volatile("" : "+s"(p));
    const int sb = TID512() >> 8;
    char* smem = smem_all + sb * SUB_LDS;
    const int bid = BIDX() * 2 + sb, nb = gridDim.x * 2, tid = TIDX(), wid = tid >> 6;
#ifndef ONLY_SUB
    if (ph == 0) {
        for (int it = bid; it < 240; it += nb) {
            if (it < 192) ph0_gemv_item(p, it, smem);
            else ph0_rope_item(p, it - 192);
        }
        convert_tiles(p, 0, bid, CONV_DENSE, nb, smem);
        return;
    }
    if (ph == NPHASE - 1) {
        for (int it = bid; it < NLAT / 16; it += nb) {
            const int row0 = it * 16 + wid * 4, lane = tid & 63;
            float4 v[4][4];
#pragma unroll
            for (int r = 0; r < 4; ++r)
#pragma unroll
                for (int i = 0; i < 4; ++i) v[r][i] = *(const float4*)(p->out + (long)(row0 + r) * DM + i * 256 + lane * 4);
            float4 g[4];
#pragma unroll
            for (int i = 0; i < 4; ++i) g[i] = *(const float4*)(p->g_final + i * 256 + lane * 4);
#pragma unroll
            for (int r = 0; r < 4; ++r) {
                moe_combine(p, row0 + r, v[r]);
                float ss = 0.f;
#pragma unroll
                for (int i = 0; i < 4; ++i) ss += v[r][i].x * v[r][i].x + v[r][i].y * v[r][i].y + v[r][i].z * v[r][i].z + v[r][i].w * v[r][i].w;
                ss = wave_sum(ss);
                const float rstd = rsqrtf(ss * (1.f / DM) + 1e-6f);
                float* xr = p->out + (long)(row0 + r) * DM;
#pragma unroll
                for (int i = 0; i < 4; ++i)
                    *(float4*)(xr + i * 256 + lane * 4) = make_float4(v[r][i].x * rstd * g[i].x, v[r][i].y * rstd * g[i].y, v[r][i].z * rstd * g[i].z, v[r][i].w * rstd * g[i].w);
            }
        }
        return;
    }
    const int layer = (ph - 1) / 11, sub = (ph - 1) % 11;
#else
    const int layer = (ph - 1) / 11, sub = ONLY_SUB;
#endif
    const bool need_ctx = layer == 0;
    switch (sub) {
    case 0: {
        const int nrow_items = NROWS / 16;
        for (int it = bid; it < nrow_items; it += nb) norm_rows4(p, layer, it * 16 + wid * 4, p->g_mix + layer * DM, 0, 1, layer == 0, layer == 1);
        if (layer == 1) convert_tiles(p, layer, bid, CONV_DENSE, nb, smem);
    } break;
    case 1: {
        ProbB pb{p}; g8::gemm_phase((LAS unsigned char*)smem_all, pb);
    } break;
    case 2: {
        const int n_state = NCHUNK * 8, n_win = 1024, n_na = 1024, n_cx = need_ctx ? 32 : 0;
        const int total = n_state + n_win + n_na + n_cx;
        for (int it = bid; it < total; it += nb) {
            if (variant == 1 && it >= n_na && it < n_na + n_win) continue;
            if (variant == 1 && it >= n_na + n_win) continue;
            if (variant == 2 && (it < n_na || it >= n_na + n_win)) continue;
            if (variant == 3 && (it < n_na + n_win || it >= n_na + n_win + n_state)) continue;
            if (it < n_na) attn_block_item(p, layer, 1, it >> 3, it & 7, smem);
            else if (it < n_na + n_win) { int i2 = it - n_na; attn_block_item(p, layer, 0, i2 >> 1, i2 & 1, smem); }
            else if (it < n_win + n_na + n_state) { int i2 = it - n_win - n_na; phC_state_item(p, layer, i2 >> 3, (i2 >> 1) & 3, i2 & 1, smem); }
            else { int i2 = it - n_win - n_na - n_state; if (i2 < 16) attn_block_item(p, layer, 2, i2 >> 1, i2 & 1, smem); else { i2 -= 16; attn_block_item(p, layer, 3, i2 >> 3, i2 & 7, smem); } }
        }
    } break;
    case 3: {
        for (int it = bid; it < 512; it += nb) phD_item(p, layer, it);
    } break;
    case 4: {
        const int nch = need_ctx ? NCHUNK : 128;
        for (int it = bid; it < nch * 8; it += nb) phE_item(p, layer, it >> 3, (it >> 1) & 3, it & 1, smem);
        if (need_ctx && bid >= nb - 64) {
            float* z = P_maccx(p) + (long)(bid - (nb - 64)) * 4096 + tid * 16;
#pragma unroll
            for (int i = 0; i < 4; ++i) *(f32x4*)(z + i * 4) = f32x4{0.f, 0.f, 0.f, 0.f};
        }
    } break;
    case 5: {
        { ProbF pf{p}; g8::gemm_phase((LAS unsigned char*)smem_all, pf); }
        if (need_ctx) {
            const int sb2 = TID512() >> 8;
            for (int it = BIDX() * 2 + sb2; it < 384; it += (int)gridDim.x * 2) { const int tb = it >> 3, tile = tb / 3; phF_tile(p, 128 + (tile >> 3), tile & 7, tb % 3, it & 7, smem_all + sb2 * SUB_LDS); }
        }
    } break;
    case 6: {
        { ProbG pg{p, layer}; g8::gemm_phase((LAS unsigned char*)smem_all, pg); }
        if (need_ctx) {
            const int sb2 = TID512() >> 8;
            for (int it = BIDX() * 2 + sb2; it < 512; it += (int)gridDim.x * 2) { const int tile = it >> 5; phG_tile(p, layer, 128 + (tile >> 3), tile & 7, it & 31, smem_all + sb2 * SUB_LDS); }
        }
    } break;
    case 7: {
        const int nit = (need_ctx ? NROWS : NLAT) / 16;
        for (int it = bid; it < nit; it += nb) phH_item(p, layer, it, smem);
    } break;
    case 8: {
        const int njob = need_ctx ? 32 : 16;
        for (int it = bid; it < njob; it += nb) phI_item(p, it, smem);
        convert_tiles(p, layer, CONV_DENSE + bid, CONV_TILES, nb, smem);
    } break;
    case 9: {
        { ProbJ pj{p}; g8::gemm_phase((LAS unsigned char*)smem_all, pj); }
        if (need_ctx) {
            const int sb2 = TID512() >> 8;
            for (int it = BIDX() * 2 + sb2; it < 256; it += (int)gridDim.x * 2) phJ_tile(p, 16 + (it >> 4), 0, it & 15, smem_all + sb2 * SUB_LDS);
        }
    } break;
    case 10: {
        { ProbK pk{p, layer}; g8::gemm_phase((LAS unsigned char*)smem_all, pk); }
        if (need_ctx) {
            const int sb2 = TID512() >> 8;
            for (int it = BIDX() * 2 + sb2; it < 128; it += (int)gridDim.x * 2) phK_tile(p, layer, 16 + (it >> 3), 0, it & 7, smem_all + sb2 * SUB_LDS);
        }
    } break;
    }
}

__global__ void __launch_bounds__(NTHREADS, 2) mega_kernel(Params p, int ph_lo, int ph_hi) {
    __shared__ __attribute__((aligned(16))) char smem[LDS_BYTES + 16];
    cg::grid_group grid = cg::this_grid();
#if MK_MULTI
    for (int ph = ph_lo; ph < ph_hi; ++ph) {
        if (ph > ph_lo) grid.sync();
        run_phase(ph, smem);
    }
#else
    unsigned* barw = (unsigned*)(p.ws + WS_BAR);
    volatile LAS unsigned* xst = (volatile LAS unsigned*)(LAS char*)(smem + LDS_BYTES);
    if (threadIdx.x < 4) xst[threadIdx.x] = 0u;
    if (blockIdx.x == 0) for (int i = threadIdx.x; i < XCD_BAR_WORDS; i += NTHREADS) barw[i] = 0u;
    run_phase(0, smem);
    grid.sync();
    const XcdBarrier xb = xcd_barrier_post(barw, xst);
#ifdef PROBE_SUB
#define PH(n) do { if ((n) > 1) xcd_barrier(xb); run_phase((n), smem); if ((n) >= PROBE_MIN && (n) <= PROBE_MAX && (((n) - 1) % 11) == PROBE_SUB) { xcd_barrier(xb); run_phase((n), smem, PROBE_VARIANT); } } while (0)
#else
#define PH(n) do { if ((n) > 1) xcd_barrier(xb); run_phase((n), smem); } while (0)
#endif
    PH(1); PH(2); PH(3); PH(4); PH(5); PH(6); PH(7); PH(8); PH(9); PH(10); PH(11);
    PH(12); PH(13); PH(14); PH(15); PH(16); PH(17); PH(18); PH(19); PH(20); PH(21); PH(22); PH(23);
    static_assert(NPHASE == 24, "phase program");
#undef PH
#endif
}

extern "C" void kernel_launch(void* const* d_in, const int* in_sizes, int n_in, void* d_out, int out_size, void* d_ws, size_t ws_size,
                              hipStream_t stream) {
    static int grid_blocks = 0;
    if (!grid_blocks) {
        int dev = 0, cus = 0, per_cu = 0;
        hipGetDevice(&dev);
        hipDeviceGetAttribute(&cus, hipDeviceAttributeMultiprocessorCount, dev);
        hipOccupancyMaxActiveBlocksPerMultiprocessor(&per_cu, mega_kernel, NTHREADS, 0);
        if (per_cu < 1) per_cu = 1;
        if (per_cu > 1) per_cu = 1;
        grid_blocks = cus * per_cu;
    }
    Params p{};
    const float** ip = (const float**)&p.x;
    for (int i = 0; i < 22; ++i) ip[i] = (const float*)d_in[i];
    p.out = (float*)d_out;
    p.ws = (char*)d_ws;
    if (WS_END > ws_size) { fprintf(stderr, "kernel_launch: workspace too small: need %zu have %zu\n", (size_t)WS_END, ws_size); return; }
#if MK_MULTI
    for (int ph = 0; ph < NPHASE; ++ph) {
        hipLaunchKernelGGL(mega_kernel, dim3(grid_blocks), dim3(NTHREADS), 0, stream, p, ph, ph + 1);
    }
#else
    int lo = 0, hi = NPHASE;
    void* args[] = {&p, &lo, &hi};
    hipError_t e = hipLaunchCooperativeKernel((void*)mega_kernel, dim3(grid_blocks), dim3(NTHREADS), args, 0, stream);
    if (e != hipSuccess) fprintf(stderr, "cooperative launch failed: %s (grid %d)\n", hipGetErrorString(e), grid_blocks);
#endif
}
```

```cpp
#include <hip/hip_runtime.h>
#include <hip/hip_bf16.h>
#include <hip/hip_cooperative_groups.h>
#include <cstdio>
#include <cstdint>
namespace cg = cooperative_groups;

#ifndef MK_MULTI
#define MK_MULTI 0
#endif

#define DI __device__ __forceinline__
typedef unsigned short u16;
typedef __attribute__((ext_vector_type(8))) short bf16x8;
typedef __attribute__((ext_vector_type(4))) float f32x4;
typedef __attribute__((ext_vector_type(4))) unsigned int u32x4;

constexpr int NLAT = 16384, NCTX = 256, NROWS = NLAT + NCTX, DM = 1024, INC = 7424;
constexpr int C_QR = 0, C_KR = 512, C_VR = 1024, C_GR = 1536, C_QW = 2048, C_KW = 2560, C_VW = 2688, C_QN = 2816, C_KN = 3328, C_VN = 3840, C_GATE = 4352;
__host__ __device__ constexpr int col_qr(int h, int x) { return C_QR + (h >> 1) * 256 + x * 128 + (h & 1) * 64; }
__host__ __device__ constexpr int col_kr(int h, int x) { return C_KR + (h >> 1) * 256 + x * 128 + (h & 1) * 64; }
__host__ __device__ constexpr int col_qw(int h, int x) { return C_QW + (h >> 2) * 256 + x * 128 + (h & 3) * 32; }
__host__ __device__ constexpr int col_kw(int kh, int x) { return C_KW + x * 128 + kh * 32; }
__host__ __device__ constexpr int col_vw(int kh) { return C_KW + 64 + kh * 128; }
constexpr int NCHUNK = NROWS / 128;
constexpr int NEXP = 16, EH = 1024, CAP_LAT = 2048, CAP_CTX = 32;
constexpr int NTHREADS = 512;
constexpr int SUB_LDS = 76 * 1024;
constexpr int LDS_BYTES = 2 * SUB_LDS;
constexpr int NPHASE = 24;


constexpr size_t al256(size_t b) { return (b + 255) & ~(size_t)255; }
constexpr size_t WS_CTXRES = 0;
constexpr size_t WS_MOD = WS_CTXRES + al256((size_t)NCTX * DM * 4);
constexpr size_t WS_ROPE128 = WS_MOD + al256(2 * 2 * 6144 * 4);
constexpr size_t WS_ROPE64 = WS_ROPE128 + al256(256 * 32 * 8);
constexpr size_t WS_WT_IN = WS_ROPE64 + al256(256 * 16 * 8);
constexpr size_t WS_WT_RET = WS_WT_IN + al256((size_t)INC * DM * 2);
constexpr size_t WS_WT_WIN = WS_WT_RET + al256((size_t)1024 * 512 * 2);
constexpr size_t WS_WT_NA = WS_WT_WIN + al256((size_t)1024 * 512 * 2);
constexpr size_t WS_WT_OUT = WS_WT_NA + al256((size_t)1024 * 512 * 2);
constexpr size_t WS_WT_GU = WS_WT_OUT + al256((size_t)1024 * 1024 * 2);
constexpr size_t WS_WT_DN = WS_WT_GU + al256((size_t)NEXP * 2048 * 1024 * 2);
constexpr size_t WS_HX = WS_WT_DN + al256((size_t)NEXP * 1024 * 1024 * 2);
constexpr size_t WS_PX = WS_HX + al256((size_t)NROWS * DM * 2);
constexpr size_t WS_YA = WS_PX + al256((size_t)NROWS * INC * 2);
constexpr size_t WS_YB = WS_YA + al256((size_t)NROWS * 512 * 2);
constexpr size_t WS_YC = WS_YB + al256((size_t)NROWS * 512 * 2);
constexpr size_t WS_S = WS_YC + al256((size_t)NROWS * 512 * 2);
constexpr size_t WS_R = WS_S + al256((size_t)NCHUNK * 8 * 16384 * 4);
constexpr size_t WS_AFF = WS_R + al256((size_t)NCHUNK * 8 * 16384 * 2);
constexpr size_t WS_SELI = WS_AFF + al256((size_t)32 * NLAT * 4);
constexpr size_t WS_SELG = WS_SELI + al256(32 * 2048 * 4);
constexpr size_t WS_TSLOT = WS_SELG + al256(32 * 2048 * 4);
constexpr size_t WS_BAR = WS_TSLOT + al256((size_t)32 * NLAT * 4);
constexpr size_t WS_MACCX = WS_BAR + al256(3456 * 4);
constexpr size_t WS_END = WS_MACCX + al256((size_t)NCTX * DM * 4);
struct Params {
    const float *x, *c, *ctx, *c_ctx, *w_mod, *b_mod, *g_mix, *g_ffn, *w_in, *decay, *ret_gn, *w_ret, *sink, *w_win, *rpb, *w_na, *w_out,
        *w_router, *w_eg, *w_eu, *w_ed, *g_final;
    float* out;
    char* ws;
};
typedef const Params __attribute__((address_space(4)))* KP;
#define WSF(name, type, off) __device__ __forceinline__ type* P_##name(KP p) { return (type*)(p->ws + (off)); }
WSF(ctxres, float, WS_CTXRES)
WSF(mod, float, WS_MOD)
WSF(rope128, float2, WS_ROPE128)
WSF(rope64, float2, WS_ROPE64)
WSF(wt_in, u16, WS_WT_IN) WSF(wt_ret, u16, WS_WT_RET) WSF(wt_win, u16, WS_WT_WIN) WSF(wt_na, u16, WS_WT_NA) WSF(wt_out, u16, WS_WT_OUT)
WSF(wt_gu, u16, WS_WT_GU) WSF(wt_dn, u16, WS_WT_DN)
WSF(hx, u16, WS_HX)
WSF(px, u16, WS_PX)
WSF(ya, u16, WS_YA) WSF(yb, u16, WS_YB) WSF(yc, u16, WS_YC)
WSF(S, float, WS_S)
WSF(R, u16, WS_R)
WSF(aff, float, WS_AFF)
WSF(sel_idx, int, WS_SELI) WSF(sel_gate, float, WS_SELG)
WSF(hid, u16, WS_PX)
__device__ __forceinline__ u16* P_hidc(KP p) { return (u16*)(p->ws + WS_PX) + (size_t)NEXP * 2048 * 1024; }
__device__ __forceinline__ u16* P_ye(KP p) { return (u16*)(p->ws + WS_PX) + (size_t)NEXP * (2048 + 32) * 1024; }
__device__ __forceinline__ u16* P_yec(KP p) { return P_ye(p) + (size_t)NEXP * 2048 * 1024; }
__device__ __forceinline__ int* P_tslot(KP p) { return (int*)(p->ws + WS_TSLOT); }
__device__ __forceinline__ u16* P_z(KP p) { return (u16*)(p->ws + WS_S); }
__device__ __forceinline__ float* P_maccx(KP p) { return (float*)(p->ws + WS_MACCX); }
#undef WSF


DI int TIDX() { int t = threadIdx.x & 255; asm volatile("" : "+v"(t)); return t; }
DI int TID512() { int t = threadIdx.x; asm volatile("" : "+v"(t)); return t; }
DI int BIDX() { int t = blockIdx.x; asm volatile("" : "+s"(t)); return t; }
DI u16 f2bf(float x) { unsigned u = __float_as_uint(x); u += 0x7fffu + ((u >> 16) & 1u); return (u16)(u >> 16); }
DI float bf2f(u16 h) { return __uint_as_float(((unsigned)h) << 16); }
DI float bflo(unsigned w) { return __uint_as_float(w << 16); }
DI float bfhi(unsigned w) { return __uint_as_float(w & 0xffff0000u); }
typedef __bf16 bf16v2 __attribute__((ext_vector_type(2)));
typedef float f32v2 __attribute__((ext_vector_type(2)));
DI unsigned pack2(float a, float b) { f32v2 v = {a, b}; bf16v2 r = __builtin_convertvector(v, bf16v2); return __builtin_bit_cast(unsigned, r); }
DI float sigmoidf_(float x) { return 1.f / (1.f + __expf(-x)); }
DI float siluf_(float x) { return x / (1.f + __expf(-x)); }
DI float wave_sum(float v) { for (int o = 32; o > 0; o >>= 1) v += __shfl_xor(v, o); return v; }
#define MFMA16(a, b, c) __builtin_amdgcn_mfma_f32_16x16x32_bf16((a), (b), (c), 0, 0, 0)

template <int MR>
DI void zero_acc(f32x4 (&acc)[MR][4]) {
#pragma unroll
    for (int m = 0; m < MR; ++m)
#pragma unroll
        for (int n = 0; n < 4; ++n) acc[m][n] = f32x4{0.f, 0.f, 0.f, 0.f};
}

template <int KT>
DI void gemm_core(f32x4 (&acc)[4][4], const u16* a0, const u16* a1, const u16* b0, const u16* b1, char* smem) {
    const int tid = TIDX(), lane = tid & 63, wid = tid >> 6, wr = wid >> 1, wc = wid & 1, fr = lane & 15, fq = lane >> 4;
    auto stage = [&](int kt, int buf) {
        char* base = smem + buf * 16384;
        __builtin_amdgcn_global_load_lds((const unsigned*)(a0 + kt * 32), (unsigned*)(base + tid * 16), 16, 0, 0);
        __builtin_amdgcn_global_load_lds((const unsigned*)(a1 + kt * 32), (unsigned*)(base + 4096 + tid * 16), 16, 0, 0);
        __builtin_amdgcn_global_load_lds((const unsigned*)(b0 + kt * 32), (unsigned*)(base + 8192 + tid * 16), 16, 0, 0);
        __builtin_amdgcn_global_load_lds((const unsigned*)(b1 + kt * 32), (unsigned*)(base + 12288 + tid * 16), 16, 0, 0);
    };
    __syncthreads();
    stage(0, 0);
#pragma unroll 1
    for (int kt = 0; kt < KT; ++kt) {
        asm volatile("s_waitcnt vmcnt(0)" ::: "memory");
        __syncthreads();
        if (kt + 1 < KT) stage(kt + 1, (kt + 1) & 1);
        const char* SA = smem + (kt & 1) * 16384;
        const char* SB = SA + 8192;
        bf16x8 At[4], Bt[4];
#pragma unroll
        for (int m = 0; m < 4; ++m) At[m] = *(const bf16x8*)(SA + (wr * 64 + m * 16 + fr) * 64 + fq * 16);
#pragma unroll
        for (int n = 0; n < 4; ++n) Bt[n] = *(const bf16x8*)(SB + (wc * 64 + n * 16 + fr) * 64 + fq * 16);
#pragma unroll
        for (int m = 0; m < 4; ++m)
#pragma unroll
            for (int n = 0; n < 4; ++n) acc[m][n] = MFMA16(At[m], Bt[n], acc[m][n]);
    }
}

template <int KT>
DI void gemm_core_af32(f32x4 (&acc)[4][4], const float* a0f, const float* a1f, const u16* b0, const u16* b1, char* smem) {
    const int tid = TIDX(), lane = tid & 63, wid = tid >> 6, wr = wid >> 1, wc = wid & 1, fr = lane & 15, fq = lane >> 4;
    f32x4 ar[4];
    auto loadA = [&](int kt) { ar[0] = *(const f32x4*)(a0f + kt * 32); ar[1] = *(const f32x4*)(a0f + kt * 32 + 4); ar[2] = *(const f32x4*)(a1f + kt * 32); ar[3] = *(const f32x4*)(a1f + kt * 32 + 4); };
    auto storeA = [&](int buf) {
        char* base = smem + buf * 16384;
        u32x4 w0, w1;
        w0[0] = pack2(ar[0][0], ar[0][1]); w0[1] = pack2(ar[0][2], ar[0][3]); w0[2] = pack2(ar[1][0], ar[1][1]); w0[3] = pack2(ar[1][2], ar[1][3]);
        w1[0] = pack2(ar[2][0], ar[2][1]); w1[1] = pack2(ar[2][2], ar[2][3]); w1[2] = pack2(ar[3][0], ar[3][1]); w1[3] = pack2(ar[3][2], ar[3][3]);
        *(u32x4*)(base + tid * 16) = w0; *(u32x4*)(base + 4096 + tid * 16) = w1;
    };
    auto stageB = [&](int kt, int buf) {
        char* base = smem + buf * 16384;
        __builtin_amdgcn_global_load_lds((const unsigned*)(b0 + kt * 32), (unsigned*)(base + 8192 + tid * 16), 16, 0, 0);
        __builtin_amdgcn_global_load_lds((const unsigned*)(b1 + kt * 32), (unsigned*)(base + 12288 + tid * 16), 16, 0, 0);
    };
    __syncthreads();
    loadA(0); stageB(0, 0); storeA(0);
#pragma unroll 1
    for (int kt = 0; kt < KT; ++kt) {
        asm volatile("s_waitcnt vmcnt(0)" ::: "memory");
        __syncthreads();
        if (kt + 1 < KT) { loadA(kt + 1); stageB(kt + 1, (kt + 1) & 1); }
        const char* SA = smem + (kt & 1) * 16384;
        const char* SB = SA + 8192;
        bf16x8 At[4], Bt[4];
#pragma unroll
        for (int m = 0; m < 4; ++m) At[m] = *(const bf16x8*)(SA + (wr * 64 + m * 16 + fr) * 64 + fq * 16);
#pragma unroll
        for (int n = 0; n < 4; ++n) Bt[n] = *(const bf16x8*)(SB + (wc * 64 + n * 16 + fr) * 64 + fq * 16);
#pragma unroll
        for (int m = 0; m < 4; ++m)
#pragma unroll
            for (int n = 0; n < 4; ++n) acc[m][n] = MFMA16(At[m], Bt[n], acc[m][n]);
        if (kt + 1 < KT) storeA((kt + 1) & 1);
    }
}

template <int MR>
DI void mma_lds64(f32x4 (&acc)[MR][4], const u16* As, int lda, const u16* Bs, int ldb) {
    const int tid = TIDX(), lane = tid & 63, wid = tid >> 6, wr = wid >> 1, wc = wid & 1, fr = lane & 15, fq = lane >> 4;
#pragma unroll
    for (int kk = 0; kk < 2; ++kk) {
        bf16x8 At[MR], Bt[4];
#pragma unroll
        for (int m = 0; m < MR; ++m) At[m] = *(const bf16x8*)(As + (wr * (MR * 16) + m * 16 + fr) * lda + kk * 32 + fq * 8);
#pragma unroll
        for (int n = 0; n < 4; ++n) Bt[n] = *(const bf16x8*)(Bs + (wc * 64 + n * 16 + fr) * ldb + kk * 32 + fq * 8);
#pragma unroll
        for (int m = 0; m < MR; ++m)
#pragma unroll
            for (int n = 0; n < 4; ++n) acc[m][n] = MFMA16(At[m], Bt[n], acc[m][n]);
    }
}
typedef short v4s_ __attribute__((ext_vector_type(4)));
typedef __attribute__((address_space(3))) v4s_* lds_v4s_ptr_;
DI bf16x8 frag_tr(const u16* M, int ld, int k0, int c0) {
    const int lane = TIDX() & 63, i = lane & 15, g = lane >> 4;
    const u16* a = M + (k0 + 8 * g + (i >> 2)) * ld + c0 + 4 * (i & 3);
    v4s_ lo = __builtin_amdgcn_ds_read_tr16_b64_v4i16((lds_v4s_ptr_)a);
    v4s_ hi = __builtin_amdgcn_ds_read_tr16_b64_v4i16((lds_v4s_ptr_)(a + 4 * ld));
    return __builtin_shufflevector(lo, hi, 0, 1, 2, 3, 4, 5, 6, 7);
}
template <int MR>
DI void mma_lds64_btr(f32x4 (&acc)[MR][4], const u16* As, int lda, const u16* Bm, int ldb) {
    const int tid = TIDX(), lane = tid & 63, wid = tid >> 6, wr = wid >> 1, wc = wid & 1, fr = lane & 15, fq = lane >> 4;
#pragma unroll
    for (int kk = 0; kk < 2; ++kk) {
        bf16x8 At[MR], Bt[4];
#pragma unroll
        for (int m = 0; m < MR; ++m) At[m] = *(const bf16x8*)(As + (wr * (MR * 16) + m * 16 + fr) * lda + kk * 32 + fq * 8);
#pragma unroll
        for (int n = 0; n < 4; ++n) Bt[n] = frag_tr(Bm, ldb, kk * 32, wc * 64 + n * 16);
#pragma unroll
        for (int m = 0; m < MR; ++m)
#pragma unroll
            for (int n = 0; n < 4; ++n) acc[m][n] = MFMA16(At[m], Bt[n], acc[m][n]);
    }
}
template <int MR>
DI void mma_lds64_tt(f32x4 (&acc)[MR][4], const u16* Am, int lda, const u16* Bm, int ldb) {
    const int tid = TIDX(), wid = tid >> 6, wr = wid >> 1, wc = wid & 1;
#pragma unroll
    for (int kk = 0; kk < 2; ++kk) {
        bf16x8 At[MR], Bt[4];
#pragma unroll
        for (int m = 0; m < MR; ++m) At[m] = frag_tr(Am, lda, kk * 32, wr * (MR * 16) + m * 16);
#pragma unroll
        for (int n = 0; n < 4; ++n) Bt[n] = frag_tr(Bm, ldb, kk * 32, wc * 64 + n * 16);
#pragma unroll
        for (int m = 0; m < MR; ++m)
#pragma unroll
            for (int n = 0; n < 4; ++n) acc[m][n] = MFMA16(At[m], Bt[n], acc[m][n]);
    }
}
template <bool SCALE, int NCH>
DI void stage_rows64(u16* dst, int ld, const u16* src0, const u16* src1, long sstride, float z0  , float zstep_unused) {
    const int tid = TIDX();
#pragma unroll
    for (int i = 0; i < NCH / 4; ++i) {
        const int idx = i * 256 + tid, row = idx / NCH, ch = idx % NCH;
        u32x4 v = *(const u32x4*)((ch < 8 ? src0 + ch * 8 : src1 + (ch - 8) * 8) + (long)row * sstride);
        *(u32x4*)(dst + row * ld + ch * 8) = v;
    }
}
template <int ROWS>
DI void stage_n64(u16* dst, int ld, const u16* src, long sstride) {
    const int tid = TIDX();
#pragma unroll
    for (int i = 0; i < ROWS / 32; ++i) {
        int idx = i * 256 + tid, row = idx >> 3, ch = idx & 7;
        u32x4 v = *(const u32x4*)(src + (long)row * sstride + ch * 8);
        *(u32x4*)(dst + row * ld + ch * 8) = v;
    }
}
template <bool SCALE, int NF>
DI void stage_t64(u16* dst, int ld, const u16* src, long sstride, float scale_tok_lane  ) {
    const int tid = TIDX();
#pragma unroll
    for (int i = 0; i < NF / 32; ++i) {
        int idx = i * 256 + tid, jj = idx & 63, ch = idx >> 6;
        u32x4 v = *(const u32x4*)(src + (long)jj * sstride + ch * 8);
#pragma unroll
        for (int e = 0; e < 4; ++e) {
            float lo = bflo(v[e]), hi = bfhi(v[e]);
            if (SCALE) { lo *= scale_tok_lane; hi *= scale_tok_lane; }
            dst[(ch * 8 + 2 * e) * ld + jj] = SCALE ? f2bf(lo) : (u16)(v[e] & 0xffffu);
            dst[(ch * 8 + 2 * e + 1) * ld + jj] = SCALE ? f2bf(hi) : (u16)(v[e] >> 16);
        }
    }
}

DI void convert_tile(KP p, int layer, int tile, char* smem);

DI void ph0_gemv_item(KP p, int item, char* smem) {
    const int tid = TIDX();
    const int l = item / 96, cg_ = item % 96;
    float* sl = (float*)smem;
    float* red = (float*)(smem + 8192);
    __syncthreads();
    for (int k = tid; k < 1024; k += 256) { sl[k] = siluf_(p->c[k]); sl[1024 + k] = siluf_(p->c_ctx[k]); }
    __syncthreads();
    const int c4 = tid & 15, kp = tid >> 4;
    const int col = cg_ * 64 + c4 * 4;
    const float* w = p->w_mod + (long)l * 1024 * 6144 + col;
    float a0[4] = {0, 0, 0, 0}, a1[4] = {0, 0, 0, 0};
#pragma unroll 8
    for (int kk = 0; kk < 64; ++kk) {
        int k = kp * 64 + kk;
        float4 wv = *(const float4*)(w + (long)k * 6144);
        float s0 = sl[k], s1 = sl[1024 + k];
        a0[0] += s0 * wv.x; a0[1] += s0 * wv.y; a0[2] += s0 * wv.z; a0[3] += s0 * wv.w;
        a1[0] += s1 * wv.x; a1[1] += s1 * wv.y; a1[2] += s1 * wv.z; a1[3] += s1 * wv.w;
    }
#pragma unroll
    for (int j = 0; j < 4; ++j) { red[(kp * 2 + 0) * 64 + c4 * 4 + j] = a0[j]; red[(kp * 2 + 1) * 64 + c4 * 4 + j] = a1[j]; }
    __syncthreads();
    if (tid < 128) {
        int src = tid >> 6, cr = tid & 63;
        float s = 0.f;
        for (int q = 0; q < 16; ++q) s += red[(q * 2 + src) * 64 + cr];
        int n = cg_ * 64 + cr;
        P_mod(p)[(l * 2 + src) * 6144 + n] = s + p->b_mod[l * 6144 + n];
    }
}
DI void sincos_d(double a, float& c, float& s) {
    const double TWO_PI = 6.283185307179586476925286766559;
    double k = rint(a / TWO_PI);
    double r = a - k * TWO_PI;
    double r2 = r * r;
    double ts = r, tc = 1.0, ss = r, cc = 1.0;
    for (int i = 1; i <= 14; ++i) {
        tc = -tc * r2 / (double)((2 * i - 1) * (2 * i));
        ts = -ts * r2 / (double)((2 * i) * (2 * i + 1));
        cc += tc; ss += ts;
    }
    c = (float)cc; s = (float)ss;
}
DI void ph0_rope_item(KP p, int item) {
    int idx = item * 256 + TIDX();
    const double LN_BASE = 9.210340371976184;
    if (idx < 8192) {
        int pos = idx >> 5, f = idx & 31;
        float inv = (float)exp(-(double)f / 32.0 * LN_BASE);
        float ang = (float)pos * inv;
        float c, s; sincos_d((double)ang, c, s);
        P_rope128(p)[idx] = make_float2(c, s);
    } else {
        int i2 = idx - 8192;
        int pos = i2 >> 4, f = i2 & 15;
        float inv = (float)exp(-(double)f / 16.0 * LN_BASE);
        float ang = (float)pos * inv;
        float c, s; sincos_d((double)ang, c, s);
        P_rope64(p)[i2] = make_float2(c, s);
    }
}

constexpr int CONV_TILES = 928 + 192 + 128 + 6144;
constexpr int CONV_DENSE = 928 + 192 + 128;
struct ConvTile { const float* sp; u16* dp; int N, K, mode, n0; };
DI ConvTile conv_setup(KP p, int layer, int tile) {
    const float* src; u16* dst; int K, N, mode = 0;
    if (tile < 928) { src = p->w_in + (long)layer * 1024 * INC; dst = P_wt_in(p); K = 1024; N = INC; mode = 1; }
    else if (tile < 928 + 192) {
        int t = tile - 928, which = t / 64; tile = t % 64; K = 512; N = 1024;
        src = (which == 0 ? p->w_ret : which == 1 ? p->w_win : p->w_na) + (long)layer * 512 * 1024;
        dst = (which == 0 ? P_wt_ret(p) : which == 1 ? P_wt_win(p) : P_wt_na(p));
    } else if (tile < 928 + 192 + 128) { tile -= 928 + 192; src = p->w_out + (long)layer * 1024 * 1024; dst = P_wt_out(p); K = 1024; N = 1024; }
    else {
        int t = tile - (928 + 192 + 128), which = t / 2048, e = (t % 2048) / 128; tile = t % 128; K = 1024; N = 1024;
        long eo = ((long)layer * NEXP + e) * 1024 * 1024;
        if (which == 0) { src = p->w_eg + eo; dst = P_wt_gu(p) + (long)e * 2048 * 1024; mode = 2; }
        else if (which == 1) { src = p->w_eu + eo; dst = P_wt_gu(p) + (long)e * 2048 * 1024; mode = 3; }
        else { src = p->w_ed + eo; dst = P_wt_dn(p) + (long)e * 1024 * 1024; }
    }
    const int ntn = N / 64;
    const int k0 = (tile / ntn) * 128, n0 = (tile % ntn) * 64;
    ConvTile c; c.sp = src + (long)k0 * N + n0; c.dp = dst + k0; c.N = N; c.K = K; c.mode = mode; c.n0 = n0;
    return c;
}
DI int conv_drow(int mode, int n) {
    if (mode == 1) {
        if (n < 1024) { int hh_ = (n & 511) >> 7, o_ = n & 127; return (n < 512 ? col_qr(hh_, o_ >> 6) : col_kr(hh_, o_ >> 6)) + (o_ & 63); }
        if (n >= C_QW && n < C_KW) { int m_ = n - C_QW; return col_qw(m_ >> 6, (m_ & 63) >> 5) + (m_ & 31); }
        if (n >= C_KW && n < C_VW) { int m_ = n - C_KW; return col_kw(m_ >> 6, (m_ & 63) >> 5) + (m_ & 31); }
        if (n >= C_VW && n < C_QN) { int m_ = n - C_VW; return col_vw(m_ >> 6) + (m_ & 63); }
        return n;
    }
    if (mode == 2) return (n >> 7) * 256 + (n & 127);
    if (mode == 3) return (n >> 7) * 256 + 128 + (n & 127);
    return n;
}
DI void convert_tiles(KP p, int layer, int first, int last, int step, char* smem) {
    const int tid = TIDX(), lane = tid & 63, w = tid >> 6;
    unsigned* T = (unsigned*)smem;
    float v[32];
    ConvTile c;
    if (first < last) {
        c = conv_setup(p, layer, first);
        const float* sp = c.sp + (long)(w * 32) * c.N + lane;
#pragma unroll
        for (int j = 0; j < 32; ++j) v[j] = sp[(long)j * c.N];
    }
    for (int t = first; t < last; t += step) {
        __syncthreads();
#pragma unroll
        for (int e = 0; e < 16; ++e) T[lane * 66 + w * 16 + e] = pack2(v[2 * e], v[2 * e + 1]);
        const ConvTile cur = c;
        if (t + step < last) {
            c = conv_setup(p, layer, t + step);
            const float* sp = c.sp + (long)(w * 32) * c.N + lane;
#pragma unroll
            for (int j = 0; j < 32; ++j) v[j] = sp[(long)j * c.N];
        }
        __syncthreads();
#pragma unroll
        for (int i = 0; i < 4; ++i) {
            const int idx = i * 256 + tid, nn = idx >> 4, ch = idx & 15;
            const u32x4 o = *(const u32x4*)(T + nn * 66 + ch * 4);
            *(u32x4*)(cur.dp + (long)conv_drow(cur.mode, cur.n0 + nn) * cur.K + ch * 8) = o;
        }
    }
}

DI void convert_tiles4(KP p, int layer, int first, int last, int step, char* smem) {
    const int tid = TIDX(), lane = tid & 63, w = tid >> 6;
    unsigned* T = (unsigned*)smem;
    for (int t = first; t < last; t += 4 * step) {
        float v[4][32];
        ConvTile c[4];
#pragma unroll
        for (int q = 0; q < 4; ++q) {
            const int tq = t + q * step;
            c[q] = conv_setup(p, layer, tq < last ? tq : first);
            if (tq < last) {
                const float* sp = c[q].sp + (long)(w * 32) * c[q].N + lane;
#pragma unroll
                for (int j = 0; j < 32; ++j) v[q][j] = sp[(long)j * c[q].N];
            }
        }
        __syncthreads();
#pragma unroll
        for (int q = 0; q < 4; ++q)
#pragma unroll
            for (int e = 0; e < 16; ++e) T[q * (64 * 66) + lane * 66 + w * 16 + e] = pack2(v[q][2 * e], v[q][2 * e + 1]);
        __syncthreads();
#pragma unroll
        for (int q = 0; q < 4; ++q) {
            if (t + q * step < last) {
#pragma unroll
                for (int i = 0; i < 4; ++i) {
                    const int idx = i * 256 + tid, nn = idx >> 4, ch = idx & 15;
                    const u32x4 o = *(const u32x4*)(T + q * (64 * 66) + nn * 66 + ch * 4);
                    *(u32x4*)(c[q].dp + (long)conv_drow(c[q].mode, c[q].n0 + nn) * c[q].K + ch * 8) = o;
                }
            }
        }
    }
}

DI const float* resid_row(KP p, int layer, int row) {
    if (row < NLAT) return (layer == 0 ? p->x : p->out) + (long)row * DM;
    return (layer == 0 ? p->ctx : P_ctxres(p)) + (long)(row - NLAT) * DM;
}
DI const float* cur_row(KP p, int row) { return row < NLAT ? p->out + (long)row * DM : P_ctxres(p) + (long)(row - NLAT) * DM; }
DI void moe_combine(KP p, int row, float4 (&v)[4]) {
    const int lane = TIDX() & 63;
    const bool lat = row < NLAT;
    const int* ts = P_tslot(p) + (lat ? 0 : 16) * (long)NLAT + (lat ? row : row - NLAT);
    const u16* yb_ = lat ? P_ye(p) : P_yec(p);
    const int cap = lat ? CAP_LAT : CAP_CTX;
#pragma unroll 4
    for (int e = 0; e < NEXP; ++e) {
        const int slot = ts[(long)e * NLAT];
        if (slot >= 0) {
            const u16* yr = yb_ + ((long)e * cap + slot) * DM + lane * 4;
#pragma unroll
            for (int i = 0; i < 4; ++i) {
                uint2 w = *(const uint2*)(yr + i * 256);
                v[i].x += bflo(w.x); v[i].y += bfhi(w.x); v[i].z += bflo(w.y); v[i].w += bfhi(w.y);
            }
        }
    }
}
DI void norm_row(KP p, int layer, int row, const float* xr, const float* g, int shift_idx, int scale_idx, u16* dst_row, float* keep  , float* wb  ) {
    const int lane = TIDX() & 63;
    const float* md = P_mod(p) + (layer * 2 + (row < NLAT ? 0 : 1)) * 6144;
    float4 v[4]; float ss = 0.f;
#pragma unroll
    for (int i = 0; i < 4; ++i) v[i] = *(const float4*)(xr + i * 256 + lane * 4);
    if (wb) {
        moe_combine(p, row, v);
#pragma unroll
        for (int i = 0; i < 4; ++i) *(float4*)(wb + i * 256 + lane * 4) = v[i];
    }
#pragma unroll
    for (int i = 0; i < 4; ++i) ss += v[i].x * v[i].x + v[i].y * v[i].y + v[i].z * v[i].z + v[i].w * v[i].w;
    ss = wave_sum(ss);
    float rstd = rsqrtf(ss * (1.f / DM) + 1e-6f);
#pragma unroll
    for (int i = 0; i < 4; ++i) {
        int c0 = i * 256 + lane * 4;
        float4 gg = *(const float4*)(g + c0), sh = *(const float4*)(md + shift_idx * 1024 + c0), sc = *(const float4*)(md + scale_idx * 1024 + c0);
        float o0 = v[i].x * rstd * gg.x * (1.f + sc.x) + sh.x, o1 = v[i].y * rstd * gg.y * (1.f + sc.y) + sh.y;
        float o2 = v[i].z * rstd * gg.z * (1.f + sc.z) + sh.z, o3 = v[i].w * rstd * gg.w * (1.f + sc.w) + sh.w;
        uint2 pk; pk.x = pack2(o0, o1); pk.y = pack2(o2, o3);
        *(uint2*)(dst_row + c0) = pk;
        if (keep) *(float4*)(keep + c0) = make_float4(o0, o1, o2, o3);
    }
}

DI void norm_rows4(KP p, int layer, int row0, const float* g, int shift_idx, int scale_idx, bool first_layer_src, bool combine, float* keep = nullptr  ) {
    const int lane = TIDX() & 63;
    const float* md = P_mod(p) + (layer * 2 + (row0 < NLAT ? 0 : 1)) * 6144;
    float4 v[4][4];
#pragma unroll
    for (int r = 0; r < 4; ++r) {
        const float* xr = first_layer_src ? resid_row(p, 0, row0 + r) : cur_row(p, row0 + r);
#pragma unroll
        for (int i = 0; i < 4; ++i) v[r][i] = *(const float4*)(xr + i * 256 + lane * 4);
    }
    float4 gg[4], sh[4], sc[4];
#pragma unroll
    for (int i = 0; i < 4; ++i) { const int c0 = i * 256 + lane * 4; gg[i] = *(const float4*)(g + c0); sh[i] = *(const float4*)(md + shift_idx * 1024 + c0); sc[i] = *(const float4*)(md + scale_idx * 1024 + c0); }
#pragma unroll
    for (int r = 0; r < 4; ++r) {
        const int row = row0 + r;
        if (first_layer_src && row >= NLAT) {
            float* wb = (float*)cur_row(p, row);
#pragma unroll
            for (int i = 0; i < 4; ++i) *(float4*)(wb + i * 256 + lane * 4) = v[r][i];
        }
        if (combine) {
            moe_combine(p, row, v[r]);
            float* wb = (float*)cur_row(p, row);
#pragma unroll
            for (int i = 0; i < 4; ++i) *(float4*)(wb + i * 256 + lane * 4) = v[r][i];
        }
        float ss = 0.f;
#pragma unroll
        for (int i = 0; i < 4; ++i) ss += v[r][i].x * v[r][i].x + v[r][i].y * v[r][i].y + v[r][i].z * v[r][i].z + v[r][i].w * v[r][i].w;
        ss = wave_sum(ss);
        const float rstd = rsqrtf(ss * (1.f / DM) + 1e-6f);
        u16* dst_row = P_hx(p) + (long)row * DM;
#pragma unroll
        for (int i = 0; i < 4; ++i) {
            const int c0 = i * 256 + lane * 4;
            float o0 = v[r][i].x * rstd * gg[i].x * (1.f + sc[i].x) + sh[i].x, o1 = v[r][i].y * rstd * gg[i].y * (1.f + sc[i].y) + sh[i].y;
            float o2 = v[r][i].z * rstd * gg[i].z * (1.f + sc[i].z) + sh[i].z, o3 = v[r][i].w * rstd * gg[i].w * (1.f + sc[i].w) + sh[i].w;
            uint2 pk; pk.x = pack2(o0, o1); pk.y = pack2(o2, o3);
            *(uint2*)(dst_row + c0) = pk;
            if (keep) *(float4*)(keep + r * 1024 + c0) = make_float4(o0, o1, o2, o3);
        }
    }
}

DI void phB_tile(KP p, int mt, int nt, char* smem) {
    const int tid = TIDX(), lane = tid & 63, wid = tid >> 6, wr = wid >> 1, wc = wid & 1, fr = lane & 15, fq = lane >> 4;
    f32x4 acc[4][4]; zero_acc<4>(acc);
    const int r0 = tid >> 2, ko = (tid & 3) * 8;
    const u16* a0 = P_hx(p) + (long)(mt * 128 + r0) * DM + ko;
    const u16* b0 = P_wt_in(p) + (long)(nt * 128 + r0) * DM + ko;
    gemm_core<32>(acc, a0, a0 + 64 * DM, b0, b0 + 64 * DM, smem);
    const bool lat = mt < 128;
    const int type = (nt < 8) ? 1 : (nt >= 16 && nt < 21) ? 2 : 0;
    if (type != 0 && lat) {
#pragma unroll
        for (int m = 0; m < 4; ++m)
#pragma unroll
            for (int j = 0; j < 4; ++j) {
                int t = mt * 128 + wr * 64 + m * 16 + fq * 4 + j;
                int pr = t >> 6, pc = t & 63;
#pragma unroll
                for (int n = 0; n < 2; ++n) {
                    float2 cs;
                    if (type == 1) { int pos = (wc == 0) ? pr : pc; cs = P_rope128(p)[pos * 32 + n * 16 + fr]; }
                    else { int pos = (n == 0) ? pr : pc; cs = P_rope64(p)[pos * 16 + fr]; }
                    float x1 = acc[m][n][j], x2 = acc[m][n + 2][j];
                    acc[m][n][j] = x1 * cs.x - x2 * cs.y;
                    acc[m][n + 2][j] = x1 * cs.y + x2 * cs.x;
                }
            }
    }
    const float mul = (nt >= 4 && nt < 8) ? 0.08838834764831845f : ((nt >= 16 && nt < 20) || (nt >= 22 && nt < 26)) ? 0.125f : 1.f;
#pragma unroll
    for (int m = 0; m < 4; ++m)
#pragma unroll
        for (int n = 0; n < 4; ++n)
#pragma unroll
            for (int j = 0; j < 4; ++j) {
                int row = mt * 128 + wr * 64 + m * 16 + fq * 4 + j, col = nt * 128 + wc * 64 + n * 16 + fr;
                P_px(p)[(long)row * INC + col] = f2bf(acc[m][n][j] * mul);
            }
}

typedef __attribute__((ext_vector_type(16))) float f32x16;
typedef short v4s __attribute__((ext_vector_type(4)));
typedef __attribute__((address_space(3))) v4s* lds_v4s_ptr;
#define MFMA32(a, b, c) __builtin_amdgcn_mfma_f32_32x32x16_bf16((a), (b), (c), 0, 0, 0)
constexpr float LOG2E = 1.4426950408889634f;

struct FA {
    bf16x8 qf[4];
    f32x16 o[2];
    float m, l;
};
DI void fa_stage(u16* Ks, u16* Vs, const u16* px, int rowstart, int colK1, int colK2, int colV) {
    const int lane = TIDX() & 63;
#pragma unroll
    for (int i = 0; i < 8; ++i) {
        int idx = i * 64 + lane, key = idx >> 3, ch = idx & 7;
        const u16* src = px + (long)(rowstart + key) * INC;
        u32x4 kv = *(const u32x4*)(src + (ch < 4 ? colK1 + ch * 8 : colK2 + (ch - 4) * 8));
        u32x4 vv = *(const u32x4*)(src + colV + ch * 8);
        *(u32x4*)(Ks + key * 72 + ch * 8) = kv;
        *(u32x4*)(Vs + key * 72 + ch * 8) = vv;
    }
}
template <int MODE>
DI void fa_tile(FA& st, const u16* Ks, const u16* Vs, int a0, const float* rrow) {
    const int lane = TIDX() & 63, c = lane & 31, hh = lane >> 5;
    const u16* kbase = Ks + c * 72 + hh * 8;
    const u16* vbase = Vs + (4 * hh + ((lane & 15) >> 2)) * 72 + 16 * ((lane >> 4) & 1) + 4 * (lane & 3);
    f32x16 s[2];
#pragma unroll
    for (int kb = 0; kb < 2; ++kb) {
#pragma unroll
        for (int r = 0; r < 16; ++r) s[kb][r] = 0.f;
#pragma unroll
        for (int ks = 0; ks < 4; ++ks) {
            bf16x8 A = *(const bf16x8*)(kbase + kb * 32 * 72 + ks * 16);
            s[kb] = MFMA32(A, st.qf[ks], s[kb]);
        }
    }
    float mx = -3.0e38f;
    const int cq = a0 + c;
    int cs = cq - 8; cs = cs < 0 ? 0 : (cs > 48 ? 48 : cs);
#pragma unroll
    for (int kb = 0; kb < 2; ++kb)
#pragma unroll
        for (int r = 0; r < 16; ++r) {
            const int j = kb * 32 + (r & 3) + 8 * (r >> 2) + 4 * hh;
            float v = s[kb][r];
            if (MODE == 1) { int d = a0 + j - c; v = (d >= -128 && d <= 128) ? v : -1e30f; }
            if (MODE == 2) { bool ok = (j >= cs) && (j < cs + 16); int ci = j - cq + 15; ci = ci < 0 ? 0 : (ci > 30 ? 30 : ci); v = ok ? v + rrow[ci] : -1e30f; }
            v *= LOG2E;
            s[kb][r] = v;
            mx = fmaxf(mx, v);
        }
    mx = fmaxf(mx, __shfl_xor(mx, 32));
    const float mn = fmaxf(st.m, mx);
    const float alpha = __builtin_amdgcn_exp2f(st.m - mn);
    float ls = 0.f;
#pragma unroll
    for (int kb = 0; kb < 2; ++kb)
#pragma unroll
        for (int r = 0; r < 16; ++r) { float pv = __builtin_amdgcn_exp2f(s[kb][r] - mn); s[kb][r] = pv; ls += pv; }
    st.l = st.l * alpha + ls; st.m = mn;
#pragma unroll
    for (int db = 0; db < 2; ++db)
#pragma unroll
        for (int r = 0; r < 16; ++r) st.o[db][r] *= alpha;
    bf16x8 pf[2][2];
#pragma unroll
    for (int kb = 0; kb < 2; ++kb)
#pragma unroll
        for (int k2 = 0; k2 < 2; ++k2) {
            u32x4 w;
#pragma unroll
            for (int e = 0; e < 4; ++e) w[e] = pack2(s[kb][8 * k2 + 2 * e], s[kb][8 * k2 + 2 * e + 1]);
            pf[kb][k2] = __builtin_bit_cast(bf16x8, w);
        }
#pragma unroll
    for (int db = 0; db < 2; ++db)
#pragma unroll
        for (int kb = 0; kb < 2; ++kb)
#pragma unroll
            for (int k2 = 0; k2 < 2; ++k2) {
                const u16* alo = vbase + (kb * 32 + 16 * k2) * 72 + db * 32;
                v4s lo = __builtin_amdgcn_ds_read_tr16_b64_v4i16((lds_v4s_ptr)alo);
                v4s hi = __builtin_amdgcn_ds_read_tr16_b64_v4i16((lds_v4s_ptr)(alo + 8 * 72));
                bf16x8 A = __builtin_shufflevector(lo, hi, 0, 1, 2, 3, 4, 5, 6, 7);
                st.o[db] = MFMA32(A, pf[kb][k2], st.o[db]);
            }
}
DI void fa_tile_na32(FA& st, const u16* Ks, const u16* Vs, int koff, bool rowok, int cs, const float* brow) {
    const int lane = TIDX() & 63, c = lane & 31, hh = lane >> 5;
    const u16* kbase = Ks + (koff + c) * 72 + hh * 8;
    const u16* vbase = Vs + (koff + 4 * hh + ((lane & 15) >> 2)) * 72 + 16 * ((lane >> 4) & 1) + 4 * (lane & 3);
    f32x16 s;
#pragma unroll
    for (int r = 0; r < 16; ++r) s[r] = 0.f;
#pragma unroll
    for (int ks = 0; ks < 4; ++ks) {
        bf16x8 A = *(const bf16x8*)(kbase + ks * 16);
        s = MFMA32(A, st.qf[ks], s);
    }
    float mx = -3.0e38f;
    const int lo = cs - koff;
#pragma unroll
    for (int r = 0; r < 16; ++r) {
        const int jj = (r & 3) + 8 * (r >> 2) + 4 * hh;
        const bool ok = rowok && (jj >= lo) && (jj < lo + 16);
        float v = ok ? (s[r] + brow[jj]) * LOG2E : -1.4e30f;
        s[r] = v;
        mx = fmaxf(mx, v);
    }
    mx = fmaxf(mx, __shfl_xor(mx, 32));
    const float mn = fmaxf(st.m, mx);
    const float alpha = __builtin_amdgcn_exp2f(st.m - mn);
    float ls = 0.f;
#pragma unroll
    for (int r = 0; r < 16; ++r) { float pv = __builtin_amdgcn_exp2f(s[r] - mn); s[r] = pv; ls += pv; }
    st.l = st.l * alpha + ls; st.m = mn;
#pragma unroll
    for (int db = 0; db < 2; ++db)
#pragma unroll
        for (int r = 0; r < 16; ++r) st.o[db][r] *= alpha;
    bf16x8 pf[2];
#pragma unroll
    for (int k2 = 0; k2 < 2; ++k2) {
        u32x4 w;
#pragma unroll
        for (int e = 0; e < 4; ++e) w[e] = pack2(s[8 * k2 + 2 * e], s[8 * k2 + 2 * e + 1]);
        pf[k2] = __builtin_bit_cast(bf16x8, w);
    }
#pragma unroll
    for (int db = 0; db < 2; ++db)
#pragma unroll
        for (int k2 = 0; k2 < 2; ++k2) {
            const u16* alo = vbase + (16 * k2) * 72 + db * 32;
            v4s lo_ = __builtin_amdgcn_ds_read_tr16_b64_v4i16((lds_v4s_ptr)alo);
            v4s hi_ = __builtin_amdgcn_ds_read_tr16_b64_v4i16((lds_v4s_ptr)(alo + 8 * 72));
            bf16x8 A = __builtin_shufflevector(lo_, hi_, 0, 1, 2, 3, 4, 5, 6, 7);
            st.o[db] = MFMA32(A, pf[k2], st.o[db]);
        }
}
DI void attn_block_item(KP p, int layer, int kind, int ia, int ib, char* smem) {
    const int tid = TIDX(), lane = tid & 63, wid = tid >> 6, c = lane & 31, hh = lane >> 5;
    u16* KV = (u16*)smem;
    float* rpbs = (float*)(smem + 36864) + 64 + wid * 512;
    const bool isna = (kind == 1 || kind == 3);
    int h, q0, a_half = 0, kvh;
    if (kind == 0) { h = ib * 4 + wid; kvh = ib; q0 = ia * 32; }
    else if (kind == 1) { h = ib; kvh = ib; q0 = 2 * ia * 64; }
    else if (kind == 2) { h = ib * 4 + wid; kvh = ib; q0 = NLAT + ia * 32; }
    else { h = ib; kvh = ib; q0 = NLAT + (ia * 4 + wid) * 32; }
    const int colQ1 = isna ? C_QN + h * 64 : col_qw(h, 0), colQ2 = isna ? colQ1 + 32 : col_qw(h, 1);
    const int colK1 = isna ? C_KN + kvh * 64 : col_kw(kvh, 0), colK2 = isna ? colK1 + 32 : col_kw(kvh, 1);
    const int colV = isna ? C_VN + kvh * 64 : col_vw(kvh);
    FA st;
    {
        const int tq = (kind == 1) ? q0 + (c >> 4) * 64 + wid * 16 + (c & 15) : q0 + c;
        const u16* qrow = P_px(p) + (long)tq * INC;
#pragma unroll
        for (int ks = 0; ks < 4; ++ks) st.qf[ks] = *(const bf16x8*)(qrow + (ks < 2 ? colQ1 + ks * 16 : colQ2 + (ks - 2) * 16) + hh * 8);
#pragma unroll
        for (int db = 0; db < 2; ++db)
#pragma unroll
            for (int r = 0; r < 16; ++r) st.o[db][r] = 0.f;
        if (isna) { st.m = -1e30f; st.l = 0.f; } else { st.m = p->sink[layer * 8 + h] * LOG2E; st.l = hh == 0 ? 1.f : 0.f; }
    }
    const int r0 = 2 * ia, rq = r0 + (c >> 4), cq = wid * 16 + (c & 15);
    int sr0 = r0 - 4; sr0 = sr0 < 0 ? 0 : (sr0 > 248 ? 248 : sr0);
    int srq = rq - 4; srq = srq < 0 ? 0 : (srq > 248 ? 248 : srq);
    int sr1 = r0 + 1 - 4; sr1 = sr1 < 0 ? 0 : (sr1 > 248 ? 248 : sr1);
    int csq = cq - 8; csq = csq < 0 ? 0 : (csq > 48 ? 48 : csq);
    const int koff = wid == 0 ? 0 : wid == 1 ? 8 : wid == 2 ? 24 : 32;
    const float* bq = rpbs + (7 - rq) * 31 + koff - cq + 15;
    if (kind == 1) {
        const float* rp = p->rpb + ((long)layer * 8 + h) * 465;
        for (int i = lane; i < 465; i += 64) rpbs[i] = rp[i];
    }
    const int nloc = kind == 0 ? 5 : kind == 1 ? 9 : 0, nt = nloc + 4;
    const int wt0 = (q0 >> 6) - 2;
    auto tile_row = [&](int i) -> int {
        if (i >= nloc) return NLAT + (i - nloc) * 64;
        if (kind == 0) { const int s0 = ((ia * 32) >> 6) - 2 + i; return (s0 < 0 || s0 >= NLAT / 64) ? -1 : s0 * 64; }
        const int kr = sr0 + i; return (kr > sr1 + 7) ? -1 : kr * 64;
    };
    const int skey = tid >> 4, sc16 = tid & 15;
    const int scol = sc16 < 8 ? (sc16 < 4 ? colK1 + sc16 * 8 : colK2 + (sc16 - 4) * 8) : colV + (sc16 - 8) * 8;
    const int sdst = (sc16 < 8 ? 0 : 64 * 72) + skey * 72 + (sc16 & 7) * 8;
    u32x4 pre[4];
    auto load_tile = [&](int row0) {
#pragma unroll
        for (int j = 0; j < 4; ++j) pre[j] = *(const u32x4*)(P_px(p) + (long)(row0 + skey + 16 * j) * INC + scol);
    };
    auto store_tile = [&](int buf) {
#pragma unroll
        for (int j = 0; j < 4; ++j) *(u32x4*)(KV + buf * (2 * 64 * 72) + sdst + 16 * j * 72) = pre[j];
    };
    __syncthreads();
    int rowc = tile_row(0);
    if (rowc >= 0) { load_tile(rowc); store_tile(0); }
    __syncthreads();
    for (int i = 0; i < nt; ++i) {
        const int rown = (i + 1 < nt) ? tile_row(i + 1) : -1;
        if (rown >= 0) load_tile(rown);
        if (rowc >= 0) {
            const u16* Ks = KV + (i & 1) * (2 * 64 * 72);
            const u16* Vs = Ks + 64 * 72;
            if (i >= nloc) fa_tile<0>(st, Ks, Vs, 0, nullptr);
            else if (kind == 0) { if (i == 0 || i == 4) fa_tile<1>(st, Ks, Vs, rowc - q0, nullptr); else fa_tile<0>(st, Ks, Vs, 0, nullptr); }
            else { const int kr = sr0 + i; fa_tile_na32(st, Ks, Vs, koff, kr >= srq && kr < srq + 8, csq, bq + kr * 31); }
        }
        if (rown >= 0) store_tile((i + 1) & 1);
        rowc = rown;
        __syncthreads();
    }
    u16* y = isna ? P_yc(p) : P_yb(p);
    {
        float lt = st.l + __shfl_xor(st.l, 32);
        float inv = 1.f / lt;
        u16* ob = KV + wid * (32 * 72);
#pragma unroll
        for (int db = 0; db < 2; ++db)
#pragma unroll
            for (int g = 0; g < 4; ++g) {
                uint2 o;
                o.x = pack2(st.o[db][4 * g] * inv, st.o[db][4 * g + 1] * inv);
                o.y = pack2(st.o[db][4 * g + 2] * inv, st.o[db][4 * g + 3] * inv);
                *(uint2*)(ob + c * 72 + db * 32 + 8 * g + 4 * hh) = o;
            }
#pragma unroll
        for (int i = 0; i < 4; ++i) {
            const int idx = i * 64 + lane, qi = idx >> 3, ch = idx & 7;
            const int tq = (kind == 1) ? q0 + (qi >> 4) * 64 + wid * 16 + (qi & 15) : q0 + qi;
            *(u32x4*)(y + (long)tq * 512 + h * 64 + ch * 8) = *(const u32x4*)(ob + qi * 72 + ch * 8);
        }
    }
}

DI void ret_gammas(KP p, int layer, int h, float& lgf2, float& lgb2) {
    float xf = p->decay[layer * 8 + h], xb = p->decay[layer * 8 + 4 + h];
    lgf2 = -log1pf(expf(-xf)) * 1.4426950408889634f;
    lgb2 = -log1pf(expf(-xb)) * 1.4426950408889634f;
}
DI void phC_state_item(KP p, int layer, int c, int h, int eh, char* smem) {
    const int tid = TIDX(), lane = tid & 63, wid = tid >> 6, wr = wid >> 1, wc = wid & 1, fr = lane & 15, fq = lane >> 4;
    u16* Vr = (u16*)smem;
    u16* Kf = Vr + 64 * 72;
    u16* Kb = Kf + 64 * 136;
    float lgf2, lgb2; ret_gammas(p, layer, h, lgf2, lgb2);
    f32x4 accF[2][4], accB[2][4]; zero_acc<2>(accF); zero_acc<2>(accB);
    const u16* base = P_px(p) + (long)c * 128 * INC;
    u32x4 pv[2], pk[4];
    auto load_half = [&](int jh) {
        const u16* rb = base + (long)jh * 64 * INC;
#pragma unroll
        for (int i = 0; i < 2; ++i) { const int idx = i * 256 + tid, row = idx >> 3, ch = idx & 7; pv[i] = *(const u32x4*)(rb + (long)row * INC + C_VR + h * 128 + eh * 64 + ch * 8); }
#pragma unroll
        for (int i = 0; i < 4; ++i) { const int idx = i * 256 + tid, row = idx >> 4, ch = idx & 15; pk[i] = *(const u32x4*)(rb + (long)row * INC + (ch < 8 ? col_kr(h, 0) + ch * 8 : col_kr(h, 1) + (ch - 8) * 8)); }
    };
    auto store_half = [&](int jh) {
#pragma unroll
        for (int i = 0; i < 2; ++i) { const int idx = i * 256 + tid, row = idx >> 3, ch = idx & 7; *(u32x4*)(Vr + row * 72 + ch * 8) = pv[i]; }
#pragma unroll
        for (int i = 0; i < 4; ++i) {
            const int idx = i * 256 + tid, row = idx >> 4, ch = idx & 15, j = jh * 64 + row;
            const float zf = exp2f((float)(127 - j) * lgf2), zb = exp2f((float)j * lgb2);
            u32x4 of, ob;
#pragma unroll
            for (int e = 0; e < 4; ++e) { const float lo = bflo(pk[i][e]), hi = bfhi(pk[i][e]); of[e] = pack2(lo * zf, hi * zf); ob[e] = pack2(lo * zb, hi * zb); }
            *(u32x4*)(Kf + row * 136 + ch * 8) = of;
            *(u32x4*)(Kb + row * 136 + ch * 8) = ob;
        }
    };
    load_half(0);
    __syncthreads();
    store_half(0);
    load_half(1);
    __syncthreads();
    mma_lds64_tt<2>(accF, Vr, 72, Kf, 136);
    mma_lds64_tt<2>(accB, Vr, 72, Kb, 136);
    __syncthreads();
    store_half(1);
    __syncthreads();
    mma_lds64_tt<2>(accF, Vr, 72, Kf, 136);
    mma_lds64_tt<2>(accB, Vr, 72, Kb, 136);
    float* Sf = P_S(p) + ((long)(c * 4 + h) * 2 + 0) * 16384;
    float* Sb = Sf + 16384;
#pragma unroll
    for (int m = 0; m < 2; ++m)
#pragma unroll
        for (int n = 0; n < 4; ++n)
#pragma unroll
            for (int j = 0; j < 4; ++j) {
                int e = eh * 64 + wr * 32 + m * 16 + fq * 4 + j, d = wc * 64 + n * 16 + fr;
                Sf[e * 128 + d] = accF[m][n][j];
                Sb[e * 128 + d] = accB[m][n][j];
            }
}

DI void phD_item(KP p, int layer, int item) {
    const int h = item >> 7, dir = (item >> 6) & 1, pos = (item & 63) * 256 + TIDX();
    float lgf2, lgb2; ret_gammas(p, layer, h, lgf2, lgb2);
    const float decay = exp2f(128.f * (dir == 0 ? lgf2 : lgb2));
    float r = 0.f;
    const long hs = (long)(h * 2 + dir) * 16384 + pos;
    auto chunk_at = [&](int i) -> int {
        if (dir == 0) return i < 2 ? 128 + i : i - 2;
        return i < 2 ? 129 - i : 129 - i;
    };
    for (int i0 = 0; i0 < NCHUNK; i0 += 13) {
        float s[13];
#pragma unroll
        for (int u = 0; u < 13; ++u) s[u] = P_S(p)[(long)chunk_at(i0 + u) * 8 * 16384 + hs];
#pragma unroll
        for (int u = 0; u < 13; ++u) {
            P_R(p)[(long)chunk_at(i0 + u) * 8 * 16384 + hs] = f2bf(r);
            r = decay * r + s[u];
        }
    }
}

DI void phE_item(KP p, int layer, int c, int h, int ih, char* smem) {
    const int tid = TIDX(), lane = tid & 63, wid = tid >> 6, wr = wid >> 1, wc = wid & 1, fr = lane & 15, fq = lane >> 4;
    u16* Qs = (u16*)smem;
    u16* X = Qs + 64 * 136;
    u16* P = X + 128 * 136;
    float* red = (float*)(P + 64 * 136);
    float lgf2, lgb2; ret_gammas(p, layer, h, lgf2, lgb2);
    const u16* base = P_px(p) + (long)c * 128 * INC;
    const u16* Rf = P_R(p) + ((long)(c * 4 + h) * 2 + 0) * 16384;
    const u16* Rb = Rf + 16384;
    const int ch = tid & 15, rw = tid >> 4;
    const int qkcol = ch < 8 ? ch * 8 : (ch - 8) * 8;
    u32x4 pre[8];
    auto load_rows = [&](const u16* src, long stride, int nrow16) {
#pragma unroll
        for (int i = 0; i < 8; ++i) if (i < nrow16) pre[i] = *(const u32x4*)(src + (long)(rw + 16 * i) * stride);
    };
    auto store_rows = [&](u16* dst, int nrow16) {
#pragma unroll
        for (int i = 0; i < 8; ++i) if (i < nrow16) *(u32x4*)(dst + (rw + 16 * i) * 136 + ch * 8) = pre[i];
    };
    f32x4 Y[2][4], T[2][4];
    zero_acc<2>(Y); zero_acc<2>(T);
    __syncthreads();
    load_rows(base + (long)ih * 64 * INC + (ch < 8 ? col_qr(h, 0) : col_qr(h, 1)) + qkcol, INC, 4); store_rows(Qs, 4);
    load_rows(Rf + ch * 8, 128, 8); store_rows(X, 8);
    load_rows(Rb + ch * 8, 128, 8);
    __syncthreads();
    mma_lds64<2>(Y, Qs, 136, X, 136); mma_lds64<2>(Y, Qs + 64, 136, X + 64, 136);
    __syncthreads();
    store_rows(X, 8);
    load_rows(base + (ch < 8 ? col_kr(h, 0) : col_kr(h, 1)) + qkcol, INC, 8);
    __syncthreads();
    mma_lds64<2>(T, Qs, 136, X, 136); mma_lds64<2>(T, Qs + 64, 136, X + 64, 136);
#pragma unroll
    for (int m = 0; m < 2; ++m)
#pragma unroll
        for (int j = 0; j < 4; ++j) {
            int i = ih * 64 + wr * 32 + m * 16 + fq * 4 + j;
            float xf = exp2f((float)(i + 1) * lgf2), xb = exp2f((float)(128 - i) * lgb2);
#pragma unroll
            for (int n = 0; n < 4; ++n) Y[m][n][j] = xf * Y[m][n][j] + xb * T[m][n][j];
        }
    zero_acc<2>(T);
    __syncthreads();
    store_rows(X, 8);
    load_rows(base + C_VR + h * 128 + ch * 8, INC, 8);
    __syncthreads();
    mma_lds64<2>(T, Qs, 136, X, 136); mma_lds64<2>(T, Qs + 64, 136, X + 64, 136);
#pragma unroll
    for (int m = 0; m < 2; ++m)
#pragma unroll
        for (int n = 0; n < 4; ++n)
#pragma unroll
            for (int j = 0; j < 4; ++j) {
                int il = wr * 32 + m * 16 + fq * 4 + j, i = ih * 64 + il, jj = wc * 64 + n * 16 + fr;
                float dm = (i >= jj) ? exp2f((float)(i - jj) * lgf2) : exp2f((float)(jj - i) * lgb2);
                P[il * 136 + jj] = f2bf(T[m][n][j] * dm);
            }
    __syncthreads();
    store_rows(X, 8);
    __syncthreads();
    mma_lds64_btr<2>(Y, P, 136, X, 136); mma_lds64_btr<2>(Y, P + 64, 136, X + 64 * 136, 136);
    float mu[2][4], rs[2][4];
#pragma unroll
    for (int m = 0; m < 2; ++m)
#pragma unroll
        for (int j = 0; j < 4; ++j) {
            float s = Y[m][0][j] + Y[m][1][j] + Y[m][2][j] + Y[m][3][j];
            s += __shfl_xor(s, 1); s += __shfl_xor(s, 2); s += __shfl_xor(s, 4); s += __shfl_xor(s, 8);
            if (fr == 0) red[(wr * 32 + m * 16 + fq * 4 + j) * 2 + wc] = s;
        }
    __syncthreads();
#pragma unroll
    for (int m = 0; m < 2; ++m)
#pragma unroll
        for (int j = 0; j < 4; ++j) { int il = wr * 32 + m * 16 + fq * 4 + j; mu[m][j] = (red[il * 2] + red[il * 2 + 1]) * (1.f / 128.f); }
    __syncthreads();
#pragma unroll
    for (int m = 0; m < 2; ++m)
#pragma unroll
        for (int j = 0; j < 4; ++j) {
            float s = 0.f;
#pragma unroll
            for (int n = 0; n < 4; ++n) { float d = Y[m][n][j] - mu[m][j]; s += d * d; }
            s += __shfl_xor(s, 1); s += __shfl_xor(s, 2); s += __shfl_xor(s, 4); s += __shfl_xor(s, 8);
            if (fr == 0) red[(wr * 32 + m * 16 + fq * 4 + j) * 2 + wc] = s;
        }
    __syncthreads();
#pragma unroll
    for (int m = 0; m < 2; ++m)
#pragma unroll
        for (int j = 0; j < 4; ++j) { int il = wr * 32 + m * 16 + fq * 4 + j; rs[m][j] = rsqrtf((red[il * 2] + red[il * 2 + 1]) * (1.f / 128.f) + 1e-6f); }
    const float* gn = p->ret_gn + layer * 512 + h * 128;
#pragma unroll
    for (int m = 0; m < 2; ++m)
#pragma unroll
        for (int n = 0; n < 4; ++n)
#pragma unroll
            for (int j = 0; j < 4; ++j) {
                int i = ih * 64 + wr * 32 + m * 16 + fq * 4 + j, e = wc * 64 + n * 16 + fr;
                long row = (long)c * 128 + i;
                float g = bf2f(P_px(p)[row * INC + C_GR + h * 128 + e]);
                float o = (Y[m][n][j] - mu[m][j]) * rs[m][j] * gn[e] * siluf_(g);
                P_ya(p)[row * 512 + h * 128 + e] = f2bf(o);
            }
    __syncthreads();
}

DI void phF_tile(KP p, int mt, int nt, int b, int ks, char* smem) {
    const int tid = TIDX(), lane = tid & 63, wid = tid >> 6, wr = wid >> 1, wc = wid & 1, fr = lane & 15, fq = lane >> 4;
    const int r0 = tid >> 2, ko = (tid & 3) * 8 + ks * 64;
    float* macc = P_maccx(p) - (long)NLAT * DM;
    const u16* y = (b == 0 ? P_ya(p) : b == 1 ? P_yb(p) : P_yc(p));
    const u16* w = (b == 0 ? P_wt_ret(p) : b == 1 ? P_wt_win(p) : P_wt_na(p));
    f32x4 acc[4][4]; zero_acc<4>(acc);
    const u16* a0 = y + (long)(mt * 128 + r0) * 512 + ko;
    const u16* b0 = w + (long)(nt * 128 + r0) * 512 + ko;
    gemm_core<2>(acc, a0, a0 + 64 * 512, b0, b0 + 64 * 512, smem);
    int zero = 0; asm volatile("" : "+v"(zero));
#pragma unroll
    for (int m = 0; m < 4; ++m)
#pragma unroll
        for (int n = 0; n < 4; ++n)
#pragma unroll
            for (int j = 0; j < 4; ++j) {
                int row = mt * 128 + wr * 64 + m * 16 + fq * 4 + j + zero, col = nt * 128 + wc * 64 + n * 16 + fr;
                float g = bf2f(P_px(p)[(long)row * INC + C_GATE + b * 1024 + col]);
                unsafeAtomicAdd(macc + (long)row * DM + col, acc[m][n][j] * sigmoidf_(g));
            }
}
DI void phG_tile(KP p, int layer, int mt, int nt, int ks, char* smem) {
    const int tid = TIDX(), lane = tid & 63, wid = tid >> 6, wr = wid >> 1, wc = wid & 1, fr = lane & 15, fq = lane >> 4;
    f32x4 acc[4][4]; zero_acc<4>(acc);
    const int r0 = tid >> 2, ko = (tid & 3) * 8 + ks * 32;
    const float* a0 = P_maccx(p) + (long)((mt - 128) * 128 + r0) * DM + ko;
    const u16* b0 = P_wt_out(p) + (long)(nt * 128 + r0) * DM + ko;
    gemm_core_af32<1>(acc, a0, a0 + 64 * DM, b0, b0 + 64 * DM, smem);
    const float* md = P_mod(p) + (layer * 2 + 1) * 6144 + 2 * 1024;
    int zero = 0; asm volatile("" : "+v"(zero));
#pragma unroll
    for (int m = 0; m < 4; ++m)
#pragma unroll
        for (int n = 0; n < 4; ++n)
#pragma unroll
            for (int j = 0; j < 4; ++j) {
                int row = mt * 128 + wr * 64 + m * 16 + fq * 4 + j + zero, col = nt * 128 + wc * 64 + n * 16 + fr;
                unsafeAtomicAdd(P_ctxres(p) + (long)(row - NLAT) * DM + col, md[col] * acc[m][n][j]);
            }
}


#define LAS __attribute__((address_space(3)))
namespace g8 {
constexpr int BM = 256, BK = 64, HALF = 128, HTB = HALF * BK * 2, STAGE_BYTES = 8 * HTB;
DI int lds_byte(int r, int c) { const int st = (r >> 4) * 2 + (c >> 5), rr = r & 15, cc = c & 31, ob = rr * 64 + cc * 2; return st * 1024 + (ob ^ (((ob >> 9) & 1) << 5)); }
DI void stage_rc(int b, int& R, int& C) { const int st = b / 1024, sb = b % 1024, swz = sb ^ (((sb >> 9) & 1) << 5); R = (st >> 1) * 16 + swz / 64; C = (st & 1) * 32 + (swz % 64) / 2; }
DI int perm32(int rho) { const int n = rho >> 4, i = rho & 15; return 8 * (i >> 2) + 4 * n + (i & 3); }
struct Unit { int pm, pn, aux; };
typedef f32x4 Acc[2][2][4][2];

template <class P>
DI void gemm_phase(LAS unsigned char* lds, const P& prob) {
    const int tid = TID512(), wid = __builtin_amdgcn_readfirstlane(tid >> 6), lane = tid & 63, wr = wid >> 2, wc = wid & 3, fr = lane & 15, fq = lane >> 4;
    constexpr int K = P::K, nt = K / BK;
    int Rr[2], Cc[2];
    unsigned voffA[2], voffB[2];
#pragma unroll
    for (int i = 0; i < 2; ++i) { stage_rc(tid * 16 + i * 8192, Rr[i], Cc[i]); const int Rb = P::PERM ? ((Rr[i] & ~31) + perm32(Rr[i] & 31)) : Rr[i];
        voffA[i] = (unsigned)(Rr[i] * K + Cc[i]) * 2u; voffB[i] = (unsigned)(Rb * K + Cc[i]) * 2u; }
    constexpr size_t kstep = (size_t)(BK * 2);
    constexpr size_t hstep = (size_t)HALF * K * 2;
    const unsigned ldsw = (unsigned)wid * 1024u;
    const int aoff = lds_byte(wr * 64 + fr, fq * 8), boff = lds_byte(wc * 32 + fr, fq * 8);
    unsigned vaC[2][2], vaN[2][2];
#define G8_SA(b, h) (((b) * 2 + (h)) * HTB)
#define G8_SB(b, h) ((4 + (b) * 2 + (h)) * HTB)
#define G8_STAGEA(bufoff, base, VA, h, kt) do { _Pragma("unroll") for (int _i = 0; _i < 2; ++_i) \
        __builtin_amdgcn_global_load_lds((const unsigned*)((base) + (P::GATHER ? (size_t)(VA)[h][_i] : (size_t)voffA[_i] + (size_t)(h) * hstep) + (size_t)(kt) * kstep), (LAS unsigned*)(lds + (bufoff) + ldsw + _i * 8192), 16, 0, 0); } while (0)
#define G8_STAGEB(bufoff, base, h, kt) do { _Pragma("unroll") for (int _i = 0; _i < 2; ++_i) \
        __builtin_amdgcn_global_load_lds((const unsigned*)((base) + (size_t)(h) * hstep + voffB[_i] + (size_t)(kt) * kstep), (LAS unsigned*)(lds + (bufoff) + ldsw + _i * 8192), 16, 0, 0); } while (0)
#define G8_LDA(dst, b, h) do { _Pragma("unroll") for (int m = 0; m < 4; ++m) _Pragma("unroll") for (int k = 0; k < 2; ++k) dst[m][k] = *(const LAS bf16x8*)(lds + G8_SA(b, h) + aoff + m * 2048 + k * 1024); } while (0)
#define G8_LDB(dst, b, h) do { _Pragma("unroll") for (int n = 0; n < 2; ++n) _Pragma("unroll") for (int k = 0; k < 2; ++k) dst[n][k] = *(const LAS bf16x8*)(lds + G8_SB(b, h) + boff + n * 2048 + k * 1024); } while (0)
#define G8_MMA(ai, bj, At, Bt) do { __builtin_amdgcn_s_setprio(1); _Pragma("unroll") for (int m = 0; m < 4; ++m) _Pragma("unroll") for (int n = 0; n < 2; ++n) _Pragma("unroll") for (int k = 0; k < 2; ++k) \
        acc[ai][bj][m][n] = __builtin_amdgcn_mfma_f32_16x16x32_bf16(Bt[n][k], At[m][k], acc[ai][bj][m][n], 0, 0, 0); __builtin_amdgcn_s_setprio(0); } while (0)
#define G8_WAIT_V(n) asm volatile("s_waitcnt vmcnt(" #n ")" ::: "memory")
#define G8_WAIT_L(n) asm volatile("s_waitcnt lgkmcnt(" #n ")" ::: "memory")
#define G8_BAR __builtin_amdgcn_s_barrier()
#define G8_SCHED __builtin_amdgcn_sched_barrier(0)
    Unit cur, nxt; int ui = 0;
    __syncthreads();
    if (!prob.next(0, cur)) return;
    if (P::GATHER) prob.gather(cur, Rr, Cc, vaC);
    const char* cA = prob.a_base(cur); const char* cB = prob.b_base(cur);
    Acc acc;
#pragma unroll
    for (int a = 0; a < 2; ++a)
#pragma unroll
        for (int b = 0; b < 2; ++b)
#pragma unroll
            for (int m = 0; m < 4; ++m)
#pragma unroll
                for (int n = 0; n < 2; ++n) acc[a][b][m][n] = (f32x4){0.f, 0.f, 0.f, 0.f};
    bf16x8 At[4][2], B0[2][2], B1[2][2];
    G8_STAGEB(G8_SB(0, 0), cB, 0, 0); G8_STAGEA(G8_SA(0, 0), cA, vaC, 0, 0); G8_STAGEB(G8_SB(0, 1), cB, 1, 0); G8_STAGEA(G8_SA(0, 1), cA, vaC, 1, 0);
    if (wr == 1) G8_BAR;
    G8_WAIT_V(4); G8_BAR;
    G8_STAGEB(G8_SB(1, 0), cB, 0, 1); G8_STAGEA(G8_SA(1, 0), cA, vaC, 0, 1); G8_STAGEB(G8_SB(1, 1), cB, 1, 1);
    G8_WAIT_V(6); G8_BAR;
    for (;;) {
        const bool has_next = prob.next(ui + 1, nxt);
        if (!has_next) nxt = cur;
        if (P::GATHER) {
            if (has_next) prob.gather(nxt, Rr, Cc, vaN);
            else {
#pragma unroll
                for (int h = 0; h < 2; ++h) { vaN[h][0] = vaC[h][0]; vaN[h][1] = vaC[h][1]; }
            }
        }
        const char* nA = prob.a_base(nxt); const char* nB = prob.b_base(nxt);
#pragma unroll 1
        for (int t = 0; t < nt; t += 2) {
            const bool last = (t == nt - 2);
            const char* a2 = last ? nA : cA; const char* b2 = last ? nB : cB; const int k2 = last ? 0 : t + 2;
            unsigned va2[2][2];
#pragma unroll
            for (int h = 0; h < 2; ++h) { va2[h][0] = last ? vaN[h][0] : vaC[h][0]; va2[h][1] = last ? vaN[h][1] : vaC[h][1]; }
            G8_LDB(B0, 0, 0); G8_SCHED; G8_LDA(At, 0, 0); G8_STAGEA(G8_SA(1, 1), cA, vaC, 1, t + 1);
            G8_WAIT_L(8); G8_BAR; G8_WAIT_L(0); G8_MMA(0, 0, At, B0); G8_BAR; G8_SCHED;
            G8_LDB(B1, 0, 1); G8_STAGEB(G8_SB(0, 0), b2, 0, k2);
            G8_BAR; G8_WAIT_L(0); G8_MMA(0, 1, At, B1); G8_BAR;
            G8_LDA(At, 0, 1); G8_STAGEA(G8_SA(0, 0), a2, va2, 0, k2);
            G8_BAR; G8_WAIT_L(0); G8_MMA(1, 0, At, B0); G8_BAR; G8_SCHED;
            G8_STAGEB(G8_SB(0, 1), b2, 1, k2);
            G8_WAIT_V(6); G8_BAR; G8_MMA(1, 1, At, B1); G8_BAR;
            G8_LDB(B0, 1, 0); G8_SCHED; G8_LDA(At, 1, 0); G8_STAGEA(G8_SA(0, 1), a2, va2, 1, k2);
            G8_WAIT_L(8); G8_BAR; G8_WAIT_L(0); G8_MMA(0, 0, At, B0); G8_BAR; G8_SCHED;
            G8_LDB(B1, 1, 1); G8_STAGEB(G8_SB(1, 0), b2, 0, k2 + 1);
            G8_BAR; G8_WAIT_L(0); G8_MMA(0, 1, At, B1); G8_BAR;
            G8_LDA(At, 1, 1); G8_STAGEA(G8_SA(1, 0), a2, va2, 0, k2 + 1);
            G8_BAR; G8_WAIT_L(0); G8_MMA(1, 0, At, B0); G8_BAR; G8_SCHED;
            G8_STAGEB(G8_SB(1, 1), b2, 1, k2 + 1);
            G8_WAIT_V(6); G8_BAR; G8_MMA(1, 1, At, B1); G8_BAR;
        }
        { const int l2 = TID512() & 63; prob.epi(acc, cur, wr, wc, l2 & 15, l2 >> 4); }
        if (!has_next) break;
#pragma unroll
        for (int a = 0; a < 2; ++a)
#pragma unroll
            for (int b = 0; b < 2; ++b)
#pragma unroll
                for (int m = 0; m < 4; ++m)
#pragma unroll
                    for (int n = 0; n < 2; ++n) acc[a][b][m][n] = (f32x4){0.f, 0.f, 0.f, 0.f};
        cur = nxt; cA = nA; cB = nB; ++ui;
        if (P::GATHER) {
#pragma unroll
            for (int h = 0; h < 2; ++h) { vaC[h][0] = vaN[h][0]; vaC[h][1] = vaN[h][1]; }
        }
    }
    G8_WAIT_V(0);
    if (wr == 0) G8_BAR;
    G8_BAR;
#undef G8_SA
#undef G8_SB
#undef G8_STAGEA
#undef G8_STAGEB
#undef G8_LDA
#undef G8_LDB
#undef G8_MMA
#undef G8_WAIT_V
#undef G8_WAIT_L
#undef G8_BAR
#undef G8_SCHED
}
}

struct ProbG {
    static constexpr int K = 1024; static constexpr bool PERM = false, GATHER = false;
    KP p; int layer;
    DI bool next(int i, g8::Unit& u) const {
        const int id = i * (int)gridDim.x + BIDX();
        if (id >= 256) return false;
        if (gridDim.x == 256) { const int x = id & 7, y = id >> 3; u.pm = x * 8 + (y >> 2); u.pn = y & 3; } else { u.pm = id >> 2; u.pn = id & 3; }
        u.aux = 0;
        return true;
    }
    DI const char* a_base(const g8::Unit& u) const { return (const char*)(P_hx(p) + (long)u.pm * 256 * DM); }
    DI const char* b_base(const g8::Unit& u) const { return (const char*)(P_wt_out(p) + (long)u.pn * 256 * DM); }
    DI void gather(const g8::Unit&, const int (&)[2], const int (&)[2], unsigned (&)[2][2]) const {}
    DI void epi(g8::Acc& acc, const g8::Unit& u, int wr, int wc, int fr, int fq) const {
        const float* xin = layer == 0 ? p->x : p->out;
        const float* md = P_mod(p) + (layer * 2) * 6144 + 2 * 1024;
#pragma unroll
        for (int bj = 0; bj < 2; ++bj)
#pragma unroll
            for (int n = 0; n < 2; ++n) {
                const int col = u.pn * 256 + bj * 128 + wc * 32 + n * 16 + fq * 4;
                const f32x4 mv = *(const f32x4*)(md + col);
#pragma unroll
                for (int ai = 0; ai < 2; ++ai)
#pragma unroll
                    for (int m = 0; m < 4; ++m) {
                        const long row = (long)u.pm * 256 + ai * 128 + wr * 64 + m * 16 + fr;
                        const f32x4 xv = *(const f32x4*)(xin + row * DM + col);
                        *(f32x4*)(p->out + row * DM + col) = xv + mv * acc[ai][bj][m][n];
                    }
            }
    }
};


constexpr int B_SPARE = 20;
constexpr int CONV_INB = 2560;
struct ProbB {
    static constexpr int K = 1024; static constexpr bool PERM = true, GATHER = false;
    KP p;
    DI bool next(int i, g8::Unit& u) const {
        constexpr int nM = 65, nN = 29, nwg = nM * nN, NX = 8, WGM = 8;
        const int nwork = (int)gridDim.x - B_SPARE;
        if (BIDX() >= nwork) return false;
        const long L = (long)i * nwork + BIDX(); if (L >= nwg) return false;
        int wgid = (int)L; { const int q = nwg / NX, r = nwg % NX, xcd = wgid % NX, off = wgid / NX; wgid = (xcd < r ? xcd * (q + 1) : r * (q + 1) + (xcd - r) * q) + off; }
        const int nig = WGM * nN, gid = wgid / nig, fm = gid * WGM, gsz = (nM - fm) < WGM ? (nM - fm) : WGM;
        u.pm = fm + ((wgid % nig) % gsz); u.pn = (wgid % nig) / gsz; u.aux = 0; return true;
    }
    DI const char* a_base(const g8::Unit& u) const { return (const char*)(P_hx(p) + (long)u.pm * 256 * DM); }
    DI const char* b_base(const g8::Unit& u) const { return (const char*)(P_wt_in(p) + (long)u.pn * 256 * DM); }
    DI void gather(const g8::Unit&, const int (&)[2], const int (&)[2], unsigned (&)[2][2]) const {}
    DI void epi(g8::Acc& acc, const g8::Unit& u, int wr, int wc, int fr, int fq) const {
        const int pn = u.pn;
        const bool lat = u.pm < 64;
        const int rk = !lat ? 0 : (pn < 4) ? 1 : (pn == 8 || pn == 9 || (pn == 10 && wc < 2)) ? 2 : 0;
        const float mul = (pn == 2 || pn == 3) ? 0.08838834764831845f : (pn == 8 || pn == 9 || pn == 11 || pn == 12) ? 0.125f : 1.f;
#pragma unroll
        for (int ai = 0; ai < 2; ++ai)
#pragma unroll
            for (int m = 0; m < 4; ++m) {
                const int row = u.pm * 256 + ai * 128 + wr * 64 + m * 16 + fr;
                if (rk != 0) {
                    const float2* tab;
                    if (rk == 1) tab = P_rope128(p) + ((wc & 1) ? (row & 63) : (row >> 6)) * 32 + fq * 8;
                    else tab = P_rope64(p) + ((fq >= 2) ? (row & 63) : (row >> 6)) * 16 + (fq & 1) * 8;
#pragma unroll
                    for (int n = 0; n < 2; ++n) {
                        const f32x4 c01 = *(const f32x4*)(tab + n * 4), c23 = *(const f32x4*)(tab + n * 4 + 2);
                        const float cs_[4] = {c01[0], c01[2], c23[0], c23[2]}, sn_[4] = {c01[1], c01[3], c23[1], c23[3]};
#pragma unroll
                        for (int e = 0; e < 4; ++e) {
                            const float x1 = acc[ai][0][m][n][e], x2 = acc[ai][1][m][n][e];
                            acc[ai][0][m][n][e] = x1 * cs_[e] - x2 * sn_[e];
                            acc[ai][1][m][n][e] = x1 * sn_[e] + x2 * cs_[e];
                        }
                    }
                }
                u16* orow = P_px(p) + (long)row * INC + pn * 256 + wc * 32 + fq * 8;
#pragma unroll
                for (int bj = 0; bj < 2; ++bj) {
                    u32x4 o;
#pragma unroll
                    for (int n = 0; n < 2; ++n)
#pragma unroll
                        for (int e = 0; e < 2; ++e) o[2 * n + e] = pack2(acc[ai][bj][m][n][2 * e] * mul, acc[ai][bj][m][n][2 * e + 1] * mul);
                    *(u32x4*)(orow + bj * 128) = o;
                }
            }
    }
};
struct ProbF {
    static constexpr int K = 512; static constexpr bool PERM = true, GATHER = false;
    KP p;
    DI bool next(int i, g8::Unit& u) const {
        const int tile = (i / 3) * (int)gridDim.x + BIDX();
        if (tile >= 256) return false;
        if (gridDim.x == 256) { const int x = tile & 7, y = tile >> 3; u.pm = x * 8 + (y >> 2); u.pn = y & 3; } else { u.pm = tile >> 2; u.pn = tile & 3; }
        u.aux = i % 3;
        return true;
    }
    DI const char* a_base(const g8::Unit& u) const { const u16* y = u.aux == 0 ? P_ya(p) : u.aux == 1 ? P_yb(p) : P_yc(p); return (const char*)(y + (long)u.pm * 256 * 512); }
    DI const char* b_base(const g8::Unit& u) const { const u16* w = u.aux == 0 ? P_wt_ret(p) : u.aux == 1 ? P_wt_win(p) : P_wt_na(p); return (const char*)(w + (long)u.pn * 256 * 512); }
    DI void gather(const g8::Unit&, const int (&)[2], const int (&)[2], unsigned (&)[2][2]) const {}
    DI void epi(g8::Acc& acc, const g8::Unit& u, int wr, int wc, int fr, int fq) const {
        const int b = u.aux;
        const long row0 = (long)u.pm * 256 + wr * 64 + fr;
        const int col0 = u.pn * 256 + wc * 32 + fq * 8;
        if (b != 2) {
            u16* z = P_z(p) + (long)b * NLAT * DM;
#pragma unroll
            for (int ai = 0; ai < 2; ++ai)
#pragma unroll
                for (int m = 0; m < 4; ++m)
#pragma unroll
                    for (int bj = 0; bj < 2; ++bj) {
                        u32x4 o;
#pragma unroll
                        for (int n = 0; n < 2; ++n)
#pragma unroll
                            for (int e = 0; e < 2; ++e) o[2 * n + e] = pack2(acc[ai][bj][m][n][2 * e], acc[ai][bj][m][n][2 * e + 1]);
                        *(u32x4*)(z + (row0 + ai * 128 + m * 16) * DM + col0 + bj * 128) = o;
                    }
            return;
        }
        const u16* zb = P_z(p);
        const u16* gp = P_px(p) + C_GATE;
#pragma unroll
        for (int ai = 0; ai < 2; ++ai)
#pragma unroll
            for (int m = 0; m < 4; ++m)
#pragma unroll
                for (int bj = 0; bj < 2; ++bj) {
                    const long row = row0 + ai * 128 + m * 16; const int col = col0 + bj * 128;
                    u32x4 zv[2], gv[3];
#pragma unroll
                    for (int q = 0; q < 2; ++q) zv[q] = *(const u32x4*)(zb + ((long)q * NLAT + row) * DM + col);
#pragma unroll
                    for (int q = 0; q < 3; ++q) gv[q] = *(const u32x4*)(gp + row * INC + q * 1024 + col);
                    u32x4 o;
#pragma unroll
                    for (int e = 0; e < 4; ++e) {
                        const int n = e >> 1, e2 = (e & 1) * 2;
                        float lo = acc[ai][bj][m][n][e2] * sigmoidf_(bflo(gv[2][e])), hi = acc[ai][bj][m][n][e2 + 1] * sigmoidf_(bfhi(gv[2][e]));
#pragma unroll
                        for (int q = 0; q < 2; ++q) { lo += bflo(zv[q][e]) * sigmoidf_(bflo(gv[q][e])); hi += bfhi(zv[q][e]) * sigmoidf_(bfhi(gv[q][e])); }
                        o[e] = pack2(lo, hi);
                    }
                    *(u32x4*)(P_hx(p) + row * DM + col) = o;
                }
    }
};
struct ProbJ {
    static constexpr int K = 1024; static constexpr bool PERM = true, GATHER = true;
    KP p;
    DI bool next(int i, g8::Unit& u) const {
        const int id = i * (int)gridDim.x + BIDX();
        if (id >= 1024) return false;
        if (gridDim.x == 256) {
            const int x = BIDX() & 7, y = BIDX() >> 3;
            u.aux = 4 * i + (x >> 1); u.pm = (x & 1) * 4 + (y >> 3); u.pn = y & 7;
        } else { u.aux = id >> 6; u.pm = (id >> 3) & 7; u.pn = id & 7; }
        return true;
    }
    DI const char* a_base(const g8::Unit&) const { return (const char*)P_hx(p); }
    DI const char* b_base(const g8::Unit& u) const { return (const char*)(P_wt_gu(p) + ((long)u.aux * 2048 + u.pn * 256) * DM); }
    DI void gather(const g8::Unit& u, const int (&R)[2], const int (&C)[2], unsigned (&va)[2][2]) const {
        const int* si = P_sel_idx(p) + u.aux * 2048 + u.pm * 256;
#pragma unroll
        for (int h = 0; h < 2; ++h)
#pragma unroll
            for (int j = 0; j < 2; ++j) va[h][j] = (unsigned)(si[h * 128 + R[j]] * DM + C[j]) * 2u;
    }
    DI void epi(g8::Acc& acc, const g8::Unit& u, int wr, int wc, int fr, int fq) const {
        u16* hb = P_hid(p) + (long)u.aux * 2048 * EH;
#pragma unroll
        for (int ai = 0; ai < 2; ++ai)
#pragma unroll
            for (int m = 0; m < 4; ++m) {
                const int slot = u.pm * 256 + ai * 128 + wr * 64 + m * 16 + fr;
                const int f = u.pn * 128 + wc * 32 + fq * 8;
                u32x4 o;
#pragma unroll
                for (int n = 0; n < 2; ++n)
#pragma unroll
                    for (int e = 0; e < 2; ++e)
                        o[2 * n + e] = pack2(siluf_(acc[ai][0][m][n][2 * e]) * acc[ai][1][m][n][2 * e], siluf_(acc[ai][0][m][n][2 * e + 1]) * acc[ai][1][m][n][2 * e + 1]);
                *(u32x4*)(hb + (long)slot * EH + f) = o;
            }
    }
};
struct ProbK {
    static constexpr int K = 1024; static constexpr bool PERM = true, GATHER = false;
    KP p; int layer;
    DI bool next(int i, g8::Unit& u) const {
        const int id = i * (int)gridDim.x + BIDX();
        if (id >= 512) return false;
        if (gridDim.x == 256) { const int x = BIDX() & 7, y = BIDX() >> 3; u.aux = 8 * i + x; u.pm = y >> 2; u.pn = y & 3; }
        else { u.aux = id >> 5; u.pm = (id >> 2) & 7; u.pn = id & 3; }
        return true;
    }
    DI const char* a_base(const g8::Unit& u) const { return (const char*)(P_hid(p) + ((long)u.aux * 2048 + u.pm * 256) * EH); }
    DI const char* b_base(const g8::Unit& u) const { return (const char*)(P_wt_dn(p) + ((long)u.aux * 1024 + u.pn * 256) * EH); }
    DI void gather(const g8::Unit&, const int (&)[2], const int (&)[2], unsigned (&)[2][2]) const {}
    DI void epi(g8::Acc& acc, const g8::Unit& u, int wr, int wc, int fr, int fq) const {
        const float* md = P_mod(p) + (layer * 2) * 6144 + 5 * 1024;
        f32x4 mv[2][2];
#pragma unroll
        for (int bj = 0; bj < 2; ++bj)
#pragma unroll
            for (int n = 0; n < 2; ++n) mv[bj][n] = *(const f32x4*)(md + u.pn * 256 + bj * 128 + wc * 32 + fq * 8 + n * 4);
#pragma unroll
        for (int ai = 0; ai < 2; ++ai)
#pragma unroll
            for (int m = 0; m < 4; ++m) {
                const int slot = u.aux * 2048 + u.pm * 256 + ai * 128 + wr * 64 + m * 16 + fr;
                const float g = P_sel_gate(p)[slot];
                u16* yr = P_ye(p) + (long)slot * DM + u.pn * 256 + wc * 32 + fq * 8;
#pragma unroll
                for (int bj = 0; bj < 2; ++bj) {
                    u32x4 o;
#pragma unroll
                    for (int n = 0; n < 2; ++n)
#pragma unroll
                        for (int e = 0; e < 2; ++e)
                            o[2 * n + e] = pack2(acc[ai][bj][m][n][2 * e] * g * mv[bj][n][2 * e], acc[ai][bj][m][n][2 * e + 1] * g * mv[bj][n][2 * e + 1]);
                    *(u32x4*)(yr + bj * 128) = o;
                }
            }
    }
};

DI void phH_item(KP p, int layer, int item, char* smem) {
    const int lane = TIDX() & 63, wid = TIDX() >> 6;
    float* hrow = (float*)smem + wid * 4096;
    const int row0 = item * 16 + wid * 4;
    norm_rows4(p, layer, row0, p->g_ffn + layer * DM, 3, 4, false, false, hrow);
    const int e = lane & 15, kp = lane >> 4;
    const float* wr_ = p->w_router + (long)layer * 1024 * 16 + e;
    float lg[4] = {0.f, 0.f, 0.f, 0.f};
#pragma unroll 8
    for (int k = kp * 256; k < kp * 256 + 256; ++k) {
        float w = wr_[k * 16];
#pragma unroll
        for (int r = 0; r < 4; ++r) lg[r] += hrow[r * 1024 + k] * w;
    }
#pragma unroll
    for (int r = 0; r < 4; ++r) {
        float l = lg[r];
        l += __shfl_xor(l, 16); l += __shfl_xor(l, 32);
        float mx = l;
        mx = fmaxf(mx, __shfl_xor(mx, 1)); mx = fmaxf(mx, __shfl_xor(mx, 2)); mx = fmaxf(mx, __shfl_xor(mx, 4)); mx = fmaxf(mx, __shfl_xor(mx, 8));
        float ex = expf(l - mx);
        float sm = ex;
        sm += __shfl_xor(sm, 1); sm += __shfl_xor(sm, 2); sm += __shfl_xor(sm, 4); sm += __shfl_xor(sm, 8);
        float a = ex / sm;
        int row = row0 + r;
        if (lane < 16) {
            if (row < NLAT) P_aff(p)[(long)e * NLAT + row] = a;
            else P_aff(p)[(long)(16 + e) * NLAT + (row - NLAT)] = a;
        }
    }
    __syncthreads();
}

DI int block_excl_scan(int v, int* sh  , int& total) {
    const int lane = TIDX() & 63, wid = TIDX() >> 6;
    int inc = v;
    for (int o = 1; o < 64; o <<= 1) { int t = __shfl_up(inc, o); if (lane >= o) inc += t; }
    __syncthreads();
    if (lane == 63) sh[wid] = inc;
    __syncthreads();
    int base = 0;
    for (int w = 0; w < wid; ++w) base += sh[w];
    total = sh[0] + sh[1] + sh[2] + sh[3];
    return base + inc - v;
}
DI void phI_item(KP p, int job, char* smem) {
    const int tid = TIDX(), lane = tid & 63, wid = tid >> 6;
    const bool lat = job < 16;
    const int n = lat ? NLAT : NCTX, cap = lat ? CAP_LAT : CAP_CTX, rowbase = lat ? 0 : NLAT;
    int* sh = (int*)smem;
    const float* a = P_aff(p) + (long)job * NLAT;
    unsigned keys[64];
    if (lat) {
#pragma unroll
        for (int i = 0; i < 16; ++i) { u32x4 v = *(const u32x4*)(a + tid * 64 + i * 4); keys[4 * i] = v[0]; keys[4 * i + 1] = v[1]; keys[4 * i + 2] = v[2]; keys[4 * i + 3] = v[3]; }
    } else {
#pragma unroll
        for (int i = 0; i < 64; ++i) keys[i] = 0u;
        keys[0] = __float_as_uint(a[tid]);
    }
    __syncthreads();
    auto block_sum = [&](int v, int it) -> int {
        for (int o = 32; o > 0; o >>= 1) v += __shfl_xor(v, o);
        int* slot = sh + (it & 1) * 4;
        if (lane == 0) slot[wid] = v;
        __syncthreads();
        return slot[0] + slot[1] + slot[2] + slot[3];
    };
    int* hist = sh + 32;
    unsigned T = 0u, pmask = 0u; int remaining = cap;
#pragma unroll 1
    for (int pass = 0; pass < 3; ++pass) {
        const int shift = pass == 0 ? 19 : pass == 1 ? 8 : 0, nb_ = pass == 2 ? 256 : 2048;
        for (int i = tid; i < 2048; i += 256) hist[i] = 0;
        __syncthreads();
#pragma unroll
        for (int i = 0; i < 64; ++i) { const unsigned k = keys[i]; if (k != 0u && (k & pmask) == T) atomicAdd(&hist[(k >> shift) & (nb_ - 1)], 1); }
        __syncthreads();
        int mine = 0;
        const int top = nb_ - 1 - 8 * tid;
        if (top >= 7) {
#pragma unroll
            for (int q = 0; q < 8; ++q) mine += hist[top - q];
        }
        int tot_;
        const int above = block_excl_scan(mine, sh + 8, tot_);
        if (top >= 7 && above < remaining && above + mine >= remaining) {
            int cum = above, q = 0;
            for (; q < 7; ++q) { const int hv = hist[top - q]; if (cum + hv >= remaining) break; cum += hv; }
            sh[16] = top - q; sh[17] = remaining - cum;
        }
        __syncthreads();
        T |= ((unsigned)sh[16]) << shift; pmask |= ((unsigned)(nb_ - 1)) << shift; remaining = sh[17];
        __syncthreads();
    }
    int ceq = 0;
#pragma unroll
    for (int i = 0; i < 64; ++i) ceq += (keys[i] == T);
    const int it = 0; (void)it; (void)block_sum;
    __syncthreads();
    int tot;
    int er = block_excl_scan(ceq, sh + 8, tot);
    int csel = 0;
    { int e2 = er;
#pragma unroll
      for (int i = 0; i < 64; ++i) { const unsigned k = keys[i]; if (k > T) ++csel; else if (k == T) { if (e2 < remaining) ++csel; ++e2; } } }
    int slot = block_excl_scan(csel, sh + 8, tot);
    int* ts = P_tslot(p) + (long)job * NLAT;
    const int per = lat ? 64 : 1;
    const int base = tid * per;
#pragma unroll
    for (int i = 0; i < 64; ++i) {
        if (i < per) {
            const unsigned k = keys[i];
            bool sel = false;
            if (k > T) sel = true; else if (k == T) { sel = er < remaining; ++er; }
            if (sel) { P_sel_idx(p)[job * 2048 + slot] = rowbase + base + i; P_sel_gate(p)[job * 2048 + slot] = __uint_as_float(k); ts[base + i] = slot; ++slot; }
            else ts[base + i] = -1;
        }
    }
    __syncthreads();
}

DI void phJ_tile(KP p, int job, int mt, int nt, char* smem) {
    const int tid = TIDX(), lane = tid & 63, wid = tid >> 6, wr = wid >> 1, wc = wid & 1, fr = lane & 15, fq = lane >> 4;
    const int cap = job < 16 ? CAP_LAT : CAP_CTX, e = job & 15;
    f32x4 acc[4][4]; zero_acc<4>(acc);
    const int r0 = tid >> 2, ko = (tid & 3) * 8;
    int s0 = mt * 128 + r0, s1 = s0 + 64;
    s0 = s0 < cap ? s0 : cap - 1; s1 = s1 < cap ? s1 : cap - 1;
    const u16* a0 = P_hx(p) + (long)P_sel_idx(p)[job * 2048 + s0] * DM + ko;
    const u16* a1 = P_hx(p) + (long)P_sel_idx(p)[job * 2048 + s1] * DM + ko;
    const int f_lo = nt * 64 + (r0 & 31), f_hi = f_lo + 32, gu = (r0 >> 5) & 1;
    const u16* b0 = P_wt_gu(p) + ((long)e * 2048 + (f_lo >> 7) * 256 + gu * 128 + (f_lo & 127)) * DM + ko;
    const u16* b1 = P_wt_gu(p) + ((long)e * 2048 + (f_hi >> 7) * 256 + gu * 128 + (f_hi & 127)) * DM + ko;
    gemm_core<32>(acc, a0, a1, b0, b1, smem);
    u16* hb = job < 16 ? P_hid(p) + (long)job * 2048 * EH : P_hidc(p) + (long)(job - 16) * 32 * EH;
#pragma unroll
    for (int m = 0; m < 4; ++m)
#pragma unroll
        for (int n = 0; n < 2; ++n)
#pragma unroll
            for (int j = 0; j < 4; ++j) {
                int slot = mt * 128 + wr * 64 + m * 16 + fq * 4 + j;
                int f = nt * 64 + wc * 32 + n * 16 + fr;
                if (slot < cap) hb[(long)slot * EH + f] = f2bf(siluf_(acc[m][n][j]) * acc[m][n + 2][j]);
            }
}
DI void phK_tile(KP p, int layer, int job, int mt, int nt, char* smem) {
    const int tid = TIDX(), lane = tid & 63, wid = tid >> 6, wr = wid >> 1, wc = wid & 1, fr = lane & 15, fq = lane >> 4;
    const int cap = job < 16 ? CAP_LAT : CAP_CTX, e = job & 15;
    f32x4 acc[4][4]; zero_acc<4>(acc);
    const int r0 = tid >> 2, ko = (tid & 3) * 8;
    int s0 = mt * 128 + r0, s1 = s0 + 64;
    s0 = s0 < cap ? s0 : cap - 1; s1 = s1 < cap ? s1 : cap - 1;
    const u16* hb = job < 16 ? P_hid(p) + (long)job * 2048 * EH : P_hidc(p) + (long)(job - 16) * 32 * EH;
    const u16* a0 = hb + (long)s0 * EH + ko;
    const u16* a1 = hb + (long)s1 * EH + ko;
    const u16* b0 = P_wt_dn(p) + ((long)e * 1024 + nt * 128 + r0) * EH + ko;
    gemm_core<32>(acc, a0, a1, b0, b0 + 64 * EH, smem);
    const float* md = P_mod(p) + (layer * 2 + (job < 16 ? 0 : 1)) * 6144 + 5 * 1024;
    u16* yb_ = job < 16 ? P_ye(p) + (long)job * 2048 * DM : P_yec(p) + (long)(job - 16) * 32 * DM;
#pragma unroll
    for (int m = 0; m < 4; ++m)
#pragma unroll
        for (int j = 0; j < 4; ++j) {
            int slot = mt * 128 + wr * 64 + m * 16 + fq * 4 + j;
            if (slot < cap) {
                float g = P_sel_gate(p)[job * 2048 + slot];
#pragma unroll
                for (int n = 0; n < 4; ++n) {
                    int col = nt * 128 + wc * 64 + n * 16 + fr;
                    yb_[(long)slot * DM + col] = f2bf(acc[m][n][j] * g * md[col]);
                }
            }
        }
}


#define XB_TMO      128
#define XB_XCNT(j)  (256  + 64 * (j))
#define XB_XSUB(j)  (1280 + 64 * (j))
#define XB_XGEN(j)  (2304 + 64 * (j))
#define XB_TOP      3328
#define XB_TOPGEN   3392
#define XCD_BAR_WORDS 3456
#define XB_SPIN_CAP (1u << 18)
DI unsigned xb_ld(unsigned* p)              { return __hip_atomic_load(p, __ATOMIC_RELAXED, __HIP_MEMORY_SCOPE_AGENT); }
DI unsigned xb_add(unsigned* p, unsigned v) { return __hip_atomic_fetch_add(p, v, __ATOMIC_RELAXED, __HIP_MEMORY_SCOPE_AGENT); }
DI unsigned xb_xcc_id() { return (unsigned)__builtin_amdgcn_s_getreg((3 << 11) | 20) & 0xFu; }
#define XB_SPIN(cond, bar) do { unsigned _sp = 0; while (cond) { __builtin_amdgcn_s_sleep(1); \
    if ((++_sp & 255u) == 0u) { if (xb_ld(&(bar)[XB_TMO])) break; if (_sp > XB_SPIN_CAP) { atomicAdd(&(bar)[XB_TMO], 1u); break; } } } } while (0)
struct XcdBarrier { unsigned* bar; unsigned x; volatile LAS unsigned* st; };
DI XcdBarrier xcd_barrier_post(unsigned* bar, volatile LAS unsigned* st) {
    XcdBarrier b; b.bar = bar; b.x = xb_xcc_id(); b.st = st;
    if (threadIdx.x == 0) (void)xb_add(&bar[XB_XCNT(b.x)], 1u);
    return b;
}
DI void xcd_barrier_complete(unsigned* bar, unsigned x, unsigned& nloc, unsigned& nx) {
    const unsigned G = gridDim.x * gridDim.y * gridDim.z;
    unsigned sum, cnt, mine, sp = 0u;
    for (;;) {
        sum = 0u; cnt = 0u; mine = 0u;
#pragma unroll
        for (unsigned j = 0; j < 16; ++j) { const unsigned c = xb_ld(&bar[XB_XCNT(j)]); sum += c; cnt += (c > 0u) ? 1u : 0u; mine = (j == x) ? c : mine; }
        if (sum == G) break;
        __builtin_amdgcn_s_sleep(1);
        if ((++sp & 255u) == 0u) { if (xb_ld(&bar[XB_TMO])) break; if (sp > XB_SPIN_CAP) { atomicAdd(&bar[XB_TMO], 1u); break; } }
    }
    nloc = mine > 0u ? mine : 1u; nx = cnt > 0u ? cnt : 1u;
}
DI void xcd_barrier(const XcdBarrier& b) {
    asm volatile("s_waitcnt vmcnt(0)" ::: "memory");
    __syncthreads();
    if (threadIdx.x == 0) {
        unsigned* bar = b.bar;
        __builtin_amdgcn_s_waitcnt(0);
        unsigned nloc = b.st[0], nx = b.st[1];
        if (nloc == 0u) { xcd_barrier_complete(bar, b.x, nloc, nx); b.st[0] = nloc; b.st[1] = nx; }
        const unsigned old = xb_add(&bar[XB_XSUB(b.x)], 1u);
        const unsigned gen = old / nloc;
        if (old + 1u == (gen + 1u) * nloc) {
            __builtin_amdgcn_fence(__ATOMIC_RELEASE, "agent");
            asm volatile("s_waitcnt vmcnt(0)" ::: "memory");
            const unsigned og = xb_add(&bar[XB_TOP], 1u);
            const unsigned tg = og / nx;
            if (og + 1u == (tg + 1u) * nx) xb_add(&bar[XB_TOPGEN], 1u);
            else XB_SPIN(xb_ld(&bar[XB_TOPGEN]) == tg, bar);
            __builtin_amdgcn_fence(__ATOMIC_ACQUIRE, "agent");
            xb_add(&bar[XB_XGEN(b.x)], 1u);
            asm volatile("s_waitcnt vmcnt(0)" ::: "memory");
        } else {
            XB_SPIN(xb_ld(&bar[XB_XGEN(b.x)]) == gen, bar);
            __builtin_amdgcn_fence(__ATOMIC_ACQUIRE, "agent");
            asm volatile("s_waitcnt vmcnt(0)" ::: "memory");
        }
    }
    __syncthreads();
}

DI void run_phase(int ph, char* smem_all, int variant = 0) {
    KP p = (KP)__builtin_amdgcn_kernarg_segment_ptr();
    asm volatile("" : "+s"(p));
    const int sb = TID512() >> 8;
    char* smem = smem_all + sb * SUB_LDS;
    const int bid = BIDX() * 2 + sb, nb = gridDim.x * 2, tid = TIDX(), wid = tid >> 6;
#ifndef ONLY_SUB
    if (ph == 0) {
        for (int it = bid; it < 240; it += nb) {
            if (it < 192) ph0_gemv_item(p, it, smem);
            else ph0_rope_item(p, it - 192);
        }
        convert_tiles(p, 0, bid, CONV_DENSE, nb, smem);
        return;
    }
    if (ph == NPHASE - 1) {
        for (int it = bid; it < NLAT / 16; it += nb) {
            const int row0 = it * 16 + wid * 4, lane = tid & 63;
            float4 v[4][4];
#pragma unroll
            for (int r = 0; r < 4; ++r)
#pragma unroll
                for (int i = 0; i < 4; ++i) v[r][i] = *(const float4*)(p->out + (long)(row0 + r) * DM + i * 256 + lane * 4);
            float4 g[4];
#pragma unroll
            for (int i = 0; i < 4; ++i) g[i] = *(const float4*)(p->g_final + i * 256 + lane * 4);
#pragma unroll
            for (int r = 0; r < 4; ++r) {
                moe_combine(p, row0 + r, v[r]);
                float ss = 0.f;
#pragma unroll
                for (int i = 0; i < 4; ++i) ss += v[r][i].x * v[r][i].x + v[r][i].y * v[r][i].y + v[r][i].z * v[r][i].z + v[r][i].w * v[r][i].w;
                ss = wave_sum(ss);
                const float rstd = rsqrtf(ss * (1.f / DM) + 1e-6f);
                float* xr = p->out + (long)(row0 + r) * DM;
#pragma unroll
                for (int i = 0; i < 4; ++i)
                    *(float4*)(xr + i * 256 + lane * 4) = make_float4(v[r][i].x * rstd * g[i].x, v[r][i].y * rstd * g[i].y, v[r][i].z * rstd * g[i].z, v[r][i].w * rstd * g[i].w);
            }
        }
        return;
    }
    const int layer = (ph - 1) / 11, sub = (ph - 1) % 11;
#else
    const int layer = (ph - 1) / 11, sub = ONLY_SUB;
#endif
    const bool need_ctx = layer == 0;
    switch (sub) {
    case 0: {
        const int nrow_items = NROWS / 16;
        for (int it = bid; it < nrow_items; it += nb) norm_rows4(p, layer, it * 16 + wid * 4, p->g_mix + layer * DM, 0, 1, layer == 0, layer == 1);
        if (layer == 1) convert_tiles(p, layer, bid, CONV_DENSE, nb, smem);
    } break;
    case 1: {
        { ProbB pb{p}; g8::gemm_phase((LAS unsigned char*)smem_all, pb); }
        const int nwork = (int)gridDim.x - B_SPARE;
        if (BIDX() >= nwork) {
            const int sb2 = TID512() >> 8, q = (BIDX() - nwork) * 2 + sb2;
            convert_tiles4(p, layer, CONV_DENSE + q, CONV_DENSE + CONV_INB, 2 * B_SPARE, smem_all + sb2 * SUB_LDS);
        }
    } break;
    case 2: {
        const int n_state = NCHUNK * 8, n_win = 1024, n_na = 1024, n_cx = need_ctx ? 32 : 0;
        const int total = n_state + n_win + n_na + n_cx;
        for (int it = bid; it < total; it += nb) {
            if (variant == 1 && it >= n_na && it < n_na + n_win) continue;
            if (variant == 1 && it >= n_na + n_win) continue;
            if (variant == 2 && (it < n_na || it >= n_na + n_win)) continue;
            if (variant == 3 && (it < n_na + n_win || it >= n_na + n_win + n_state)) continue;
            if (it < n_na) attn_block_item(p, layer, 1, it >> 3, it & 7, smem);
            else if (it < n_na + n_win) { int i2 = it - n_na; attn_block_item(p, layer, 0, i2 >> 1, i2 & 1, smem); }
            else if (it < n_win + n_na + n_state) { int i2 = it - n_win - n_na; phC_state_item(p, layer, i2 >> 3, (i2 >> 1) & 3, i2 & 1, smem); }
            else { int i2 = it - n_win - n_na - n_state; if (i2 < 16) attn_block_item(p, layer, 2, i2 >> 1, i2 & 1, smem); else { i2 -= 16; attn_block_item(p, layer, 3, i2 >> 3, i2 & 7, smem); } }
        }
    } break;
    case 3: {
        for (int it = bid; it < 512; it += nb) phD_item(p, layer, it);
    } break;
    case 4: {
        const int nch = need_ctx ? NCHUNK : 128;
        for (int it = bid; it < nch * 8; it += nb) phE_item(p, layer, it >> 3, (it >> 1) & 3, it & 1, smem);
        if (need_ctx && bid >= nb - 64) {
            float* z = P_maccx(p) + (long)(bid - (nb - 64)) * 4096 + tid * 16;
#pragma unroll
            for (int i = 0; i < 4; ++i) *(f32x4*)(z + i * 4) = f32x4{0.f, 0.f, 0.f, 0.f};
        }
    } break;
    case 5: {
        { ProbF pf{p}; g8::gemm_phase((LAS unsigned char*)smem_all, pf); }
        if (need_ctx) {
            const int sb2 = TID512() >> 8;
            for (int it = BIDX() * 2 + sb2; it < 384; it += (int)gridDim.x * 2) { const int tb = it >> 3, tile = tb / 3; phF_tile(p, 128 + (tile >> 3), tile & 7, tb % 3, it & 7, smem_all + sb2 * SUB_LDS); }
        }
    } break;
    case 6: {
        { ProbG pg{p, layer}; g8::gemm_phase((LAS unsigned char*)smem_all, pg); }
        if (need_ctx) {
            const int sb2 = TID512() >> 8;
            for (int it = BIDX() * 2 + sb2; it < 512; it += (int)gridDim.x * 2) { const int tile = it >> 5; phG_tile(p, layer, 128 + (tile >> 3), tile & 7, it & 31, smem_all + sb2 * SUB_LDS); }
        }
    } break;
    case 7: {
        const int nit = (need_ctx ? NROWS : NLAT) / 16;
        for (int it = bid; it < nit; it += nb) phH_item(p, layer, it, smem);
    } break;
    case 8: {
        const int njob = need_ctx ? 32 : 16;
        for (int it = bid; it < njob; it += nb) phI_item(p, it, smem);
        convert_tiles(p, layer, CONV_DENSE + CONV_INB + bid, CONV_TILES, nb, smem);
    } break;
    case 9: {
        { ProbJ pj{p}; g8::gemm_phase((LAS unsigned char*)smem_all, pj); }
        if (need_ctx) {
            const int sb2 = TID512() >> 8;
            for (int it = BIDX() * 2 + sb2; it < 256; it += (int)gridDim.x * 2) phJ_tile(p, 16 + (it >> 4), 0, it & 15, smem_all + sb2 * SUB_LDS);
        }
    } break;
    case 10: {
        { ProbK pk{p, layer}; g8::gemm_phase((LAS unsigned char*)smem_all, pk); }
        if (need_ctx) {
            const int sb2 = TID512() >> 8;
            for (int it = BIDX() * 2 + sb2; it < 128; it += (int)gridDim.x * 2) phK_tile(p, layer, 16 + (it >> 3), 0, it & 7, smem_all + sb2 * SUB_LDS);
        }
    } break;
    }
}

__global__ void __launch_bounds__(NTHREADS, 2) mega_kernel(Params p, int ph_lo, int ph_hi) {
    __shared__ __attribute__((aligned(16))) char smem[LDS_BYTES + 16];
    cg::grid_group grid = cg::this_grid();
#if MK_MULTI
    for (int ph = ph_lo; ph < ph_hi; ++ph) {
        if (ph > ph_lo) grid.sync();
        run_phase(ph, smem);
    }
#else
    unsigned* barw = (unsigned*)(p.ws + WS_BAR);
    volatile LAS unsigned* xst = (volatile LAS unsigned*)(LAS char*)(smem + LDS_BYTES);
    if (threadIdx.x < 4) xst[threadIdx.x] = 0u;
    if (blockIdx.x == 0) for (int i = threadIdx.x; i < XCD_BAR_WORDS; i += NTHREADS) barw[i] = 0u;
    run_phase(0, smem);
    grid.sync();
    const XcdBarrier xb = xcd_barrier_post(barw, xst);
#ifdef PROBE_SUB
#define PH(n) do { if ((n) > 1) xcd_barrier(xb); run_phase((n), smem); if ((n) >= PROBE_MIN && (n) <= PROBE_MAX && (((n) - 1) % 11) == PROBE_SUB) { xcd_barrier(xb); run_phase((n), smem, PROBE_VARIANT); } } while (0)
#else
#define PH(n) do { if ((n) > 1) xcd_barrier(xb); run_phase((n), smem); } while (0)
#endif
    PH(1); PH(2); PH(3); PH(4); PH(5); PH(6); PH(7); PH(8); PH(9); PH(10); PH(11);
    PH(12); PH(13); PH(14); PH(15); PH(16); PH(17); PH(18); PH(19); PH(20); PH(21); PH(22); PH(23);
    static_assert(NPHASE == 24, "phase program");
#undef PH
#endif
}

extern "C" void kernel_launch(void* const* d_in, const int* in_sizes, int n_in, void* d_out, int out_size, void* d_ws, size_t ws_size,
                              hipStream_t stream) {
    static int grid_blocks = 0;
    if (!grid_blocks) {
        int dev = 0, cus = 0, per_cu = 0;
        hipGetDevice(&dev);
        hipDeviceGetAttribute(&cus, hipDeviceAttributeMultiprocessorCount, dev);
        hipOccupancyMaxActiveBlocksPerMultiprocessor(&per_cu, mega_kernel, NTHREADS, 0);
        if (per_cu < 1) per_cu = 1;
        if (per_cu > 1) per_cu = 1;
        grid_blocks = cus * per_cu;
    }
    Params p{};
    const float** ip = (const float**)&p.x;
    for (int i = 0; i < 22; ++i) ip[i] = (const float*)d_in[i];
    p.out = (float*)d_out;
    p.ws = (char*)d_ws;
    if (WS_END > ws_size) { fprintf(stderr, "kernel_launch: workspace too small: need %zu have %zu\n", (size_t)WS_END, ws_size); return; }
#if MK_MULTI
    for (int ph = 0; ph < NPHASE; ++ph) {
        hipLaunchKernelGGL(mega_kernel, dim3(grid_blocks), dim3(NTHREADS), 0, stream, p, ph, ph + 1);
    }
#else
    int lo = 0, hi = NPHASE;
    void* args[] = {&p, &lo, &hi};
    hipError_t e = hipLaunchCooperativeKernel((void*)mega_kernel, dim3(grid_blocks), dim3(NTHREADS), args, 0, stream);
    if (e != hipSuccess) fprintf(stderr, "cooperative launch failed: %s (grid %d)\n", hipGetErrorString(e), grid_blocks);
#endif
}
```

```cpp
#include <hip/hip_runtime.h>
#include <hip/hip_bf16.h>
#include <hip/hip_cooperative_groups.h>
#include <cstdio>
#include <cstdint>
namespace cg = cooperative_groups;

#ifndef MK_MULTI
#define MK_MULTI 0
#endif

#define DI __device__ __forceinline__
typedef unsigned short u16;
typedef __attribute__((ext_vector_type(8))) short bf16x8;
typedef __attribute__((ext_vector_type(4))) float f32x4;
typedef __attribute__((ext_vector_type(4))) unsigned int u32x4;

constexpr int NLAT = 16384, NCTX = 256, NROWS = NLAT + NCTX, DM = 1024, INC = 7424;
constexpr int C_QR = 0, C_KR = 512, C_VR = 1024, C_GR = 1536, C_QW = 2048, C_KW = 2560, C_VW = 2688, C_QN = 2816, C_KN = 3328, C_VN = 3840, C_GATE = 4352;
__host__ __device__ constexpr int col_qr(int h, int x) { return C_QR + (h >> 1) * 256 + x * 128 + (h & 1) * 64; }
__host__ __device__ constexpr int col_kr(int h, int x) { return C_KR + (h >> 1) * 256 + x * 128 + (h & 1) * 64; }
__host__ __device__ constexpr int col_qw(int h, int x) { return C_QW + (h >> 2) * 256 + x * 128 + (h & 3) * 32; }
__host__ __device__ constexpr int col_kw(int kh, int x) { return C_KW + x * 128 + kh * 32; }
__host__ __device__ constexpr int col_vw(int kh) { return C_KW + 64 + kh * 128; }
constexpr int NCHUNK = NROWS / 128;
constexpr int NEXP = 16, EH = 1024, CAP_LAT = 2048, CAP_CTX = 32;
constexpr int NTHREADS = 512;
constexpr int SUB_LDS = 76 * 1024;
constexpr int LDS_BYTES = 2 * SUB_LDS;
constexpr int NPHASE = 24;


constexpr size_t al256(size_t b) { return (b + 255) & ~(size_t)255; }
constexpr size_t WS_CTXRES = 0;
constexpr size_t WS_MOD = WS_CTXRES + al256((size_t)NCTX * DM * 4);
constexpr size_t WS_ROPE128 = WS_MOD + al256(2 * 2 * 6144 * 4);
constexpr size_t WS_ROPE64 = WS_ROPE128 + al256(256 * 32 * 8);
constexpr size_t WS_WT_IN = WS_ROPE64 + al256(256 * 16 * 8);
constexpr size_t WS_WT_RET = WS_WT_IN + al256((size_t)INC * DM * 2);
constexpr size_t WS_WT_WIN = WS_WT_RET + al256((size_t)1024 * 512 * 2);
constexpr size_t WS_WT_NA = WS_WT_WIN + al256((size_t)1024 * 512 * 2);
constexpr size_t WS_WT_OUT = WS_WT_NA + al256((size_t)1024 * 512 * 2);
constexpr size_t WS_WT_GU = WS_WT_OUT + al256((size_t)1024 * 1024 * 2);
constexpr size_t WS_WT_DN = WS_WT_GU + al256((size_t)NEXP * 2048 * 1024 * 2);
constexpr size_t WS_HX = WS_WT_DN + al256((size_t)NEXP * 1024 * 1024 * 2);
constexpr size_t WS_PX = WS_HX + al256((size_t)NROWS * DM * 2);
constexpr size_t WS_YA = WS_PX + al256((size_t)NROWS * INC * 2);
constexpr size_t WS_YB = WS_YA + al256((size_t)NROWS * 512 * 2);
constexpr size_t WS_YC = WS_YB + al256((size_t)NROWS * 512 * 2);
constexpr size_t WS_S = WS_YC + al256((size_t)NROWS * 512 * 2);
constexpr size_t WS_R = WS_S + al256((size_t)NCHUNK * 8 * 16384 * 4);
constexpr size_t WS_AFF = WS_R + al256((size_t)NCHUNK * 8 * 16384 * 2);
constexpr size_t WS_SELI = WS_AFF + al256((size_t)32 * NLAT * 4);
constexpr size_t WS_SELG = WS_SELI + al256(32 * 2048 * 4);
constexpr size_t WS_TSLOT = WS_SELG + al256(32 * 2048 * 4);
constexpr size_t WS_BAR = WS_TSLOT + al256((size_t)32 * NLAT * 4);
constexpr size_t WS_MACCX = WS_BAR + al256(3456 * 4);
constexpr size_t WS_END = WS_MACCX + al256((size_t)NCTX * DM * 4);
struct Params {
    const float *x, *c, *ctx, *c_ctx, *w_mod, *b_mod, *g_mix, *g_ffn, *w_in, *decay, *ret_gn, *w_ret, *sink, *w_win, *rpb, *w_na, *w_out,
        *w_router, *w_eg, *w_eu, *w_ed, *g_final;
    float* out;
    char* ws;
};
typedef const Params __attribute__((address_space(4)))* KP;
#define WSF(name, type, off) __device__ __forceinline__ type* P_##name(KP p) { return (type*)(p->ws + (off)); }
WSF(ctxres, float, WS_CTXRES)
WSF(mod, float, WS_MOD)
WSF(rope128, float2, WS_ROPE128)
WSF(rope64, float2, WS_ROPE64)
WSF(wt_in, u16, WS_WT_IN) WSF(wt_ret, u16, WS_WT_RET) WSF(wt_win, u16, WS_WT_WIN) WSF(wt_na, u16, WS_WT_NA) WSF(wt_out, u16, WS_WT_OUT)
WSF(wt_gu, u16, WS_WT_GU) WSF(wt_dn, u16, WS_WT_DN)
WSF(hx, u16, WS_HX)
WSF(px, u16, WS_PX)
WSF(ya, u16, WS_YA) WSF(yb, u16, WS_YB) WSF(yc, u16, WS_YC)
WSF(S, float, WS_S)
WSF(R, u16, WS_R)
WSF(aff, float, WS_AFF)
WSF(sel_idx, int, WS_SELI) WSF(sel_gate, float, WS_SELG)
WSF(hid, u16, WS_PX)
__device__ __forceinline__ u16* P_hidc(KP p) { return (u16*)(p->ws + WS_PX) + (size_t)NEXP * 2048 * 1024; }
__device__ __forceinline__ u16* P_ye(KP p) { return (u16*)(p->ws + WS_PX) + (size_t)NEXP * (2048 + 32) * 1024; }
__device__ __forceinline__ u16* P_yec(KP p) { return P_ye(p) + (size_t)NEXP * 2048 * 1024; }
__device__ __forceinline__ int* P_tslot(KP p) { return (int*)(p->ws + WS_TSLOT); }
__device__ __forceinline__ u16* P_z(KP p) { return (u16*)(p->ws + WS_S); }
__device__ __forceinline__ float* P_maccx(KP p) { return (float*)(p->ws + WS_MACCX); }
#undef WSF


DI int TIDX() { int t = threadIdx.x & 255; asm volatile("" : "+v"(t)); return t; }
DI int TID512() { int t = threadIdx.x; asm volatile("" : "+v"(t)); return t; }
DI int BIDX() { int t = blockIdx.x; asm volatile("" : "+s"(t)); return t; }
DI u16 f2bf(float x) { unsigned u = __float_as_uint(x); u += 0x7fffu + ((u >> 16) & 1u); return (u16)(u >> 16); }
DI float bf2f(u16 h) { return __uint_as_float(((unsigned)h) << 16); }
DI float bflo(unsigned w) { return __uint_as_float(w << 16); }
DI float bfhi(unsigned w) { return __uint_as_float(w & 0xffff0000u); }
typedef __bf16 bf16v2 __attribute__((ext_vector_type(2)));
typedef float f32v2 __attribute__((ext_vector_type(2)));
DI unsigned pack2(float a, float b) { f32v2 v = {a, b}; bf16v2 r = __builtin_convertvector(v, bf16v2); return __builtin_bit_cast(unsigned, r); }
DI float sigmoidf_(float x) { return 1.f / (1.f + __expf(-x)); }
DI float siluf_(float x) { return x / (1.f + __expf(-x)); }
DI float wave_sum(float v) { for (int o = 32; o > 0; o >>= 1) v += __shfl_xor(v, o); return v; }
#define MFMA16(a, b, c) __builtin_amdgcn_mfma_f32_16x16x32_bf16((a), (b), (c), 0, 0, 0)

template <int MR>
DI void zero_acc(f32x4 (&acc)[MR][4]) {
#pragma unroll
    for (int m = 0; m < MR; ++m)
#pragma unroll
        for (int n = 0; n < 4; ++n) acc[m][n] = f32x4{0.f, 0.f, 0.f, 0.f};
}

template <int KT>
DI void gemm_core(f32x4 (&acc)[4][4], const u16* a0, const u16* a1, const u16* b0, const u16* b1, char* smem) {
    const int tid = TIDX(), lane = tid & 63, wid = tid >> 6, wr = wid >> 1, wc = wid & 1, fr = lane & 15, fq = lane >> 4;
    auto stage = [&](int kt, int buf) {
        char* base = smem + buf * 16384;
        __builtin_amdgcn_global_load_lds((const unsigned*)(a0 + kt * 32), (unsigned*)(base + tid * 16), 16, 0, 0);
        __builtin_amdgcn_global_load_lds((const unsigned*)(a1 + kt * 32), (unsigned*)(base + 4096 + tid * 16), 16, 0, 0);
        __builtin_amdgcn_global_load_lds((const unsigned*)(b0 + kt * 32), (unsigned*)(base + 8192 + tid * 16), 16, 0, 0);
        __builtin_amdgcn_global_load_lds((const unsigned*)(b1 + kt * 32), (unsigned*)(base + 12288 + tid * 16), 16, 0, 0);
    };
    __syncthreads();
    stage(0, 0);
#pragma unroll 1
    for (int kt = 0; kt < KT; ++kt) {
        asm volatile("s_waitcnt vmcnt(0)" ::: "memory");
        __syncthreads();
        if (kt + 1 < KT) stage(kt + 1, (kt + 1) & 1);
        const char* SA = smem + (kt & 1) * 16384;
        const char* SB = SA + 8192;
        bf16x8 At[4], Bt[4];
#pragma unroll
        for (int m = 0; m < 4; ++m) At[m] = *(const bf16x8*)(SA + (wr * 64 + m * 16 + fr) * 64 + fq * 16);
#pragma unroll
        for (int n = 0; n < 4; ++n) Bt[n] = *(const bf16x8*)(SB + (wc * 64 + n * 16 + fr) * 64 + fq * 16);
#pragma unroll
        for (int m = 0; m < 4; ++m)
#pragma unroll
            for (int n = 0; n < 4; ++n) acc[m][n] = MFMA16(At[m], Bt[n], acc[m][n]);
    }
}

template <int KT>
DI void gemm_core_af32(f32x4 (&acc)[4][4], const float* a0f, const float* a1f, const u16* b0, const u16* b1, char* smem) {
    const int tid = TIDX(), lane = tid & 63, wid = tid >> 6, wr = wid >> 1, wc = wid & 1, fr = lane & 15, fq = lane >> 4;
    f32x4 ar[4];
    auto loadA = [&](int kt) { ar[0] = *(const f32x4*)(a0f + kt * 32); ar[1] = *(const f32x4*)(a0f + kt * 32 + 4); ar[2] = *(const f32x4*)(a1f + kt * 32); ar[3] = *(const f32x4*)(a1f + kt * 32 + 4); };
    auto storeA = [&](int buf) {
        char* base = smem + buf * 16384;
        u32x4 w0, w1;
        w0[0] = pack2(ar[0][0], ar[0][1]); w0[1] = pack2(ar[0][2], ar[0][3]); w0[2] = pack2(ar[1][0], ar[1][1]); w0[3] = pack2(ar[1][2], ar[1][3]);
        w1[0] = pack2(ar[2][0], ar[2][1]); w1[1] = pack2(ar[2][2], ar[2][3]); w1[2] = pack2(ar[3][0], ar[3][1]); w1[3] = pack2(ar[3][2], ar[3][3]);
        *(u32x4*)(base + tid * 16) = w0; *(u32x4*)(base + 4096 + tid * 16) = w1;
    };
    auto stageB = [&](int kt, int buf) {
        char* base = smem + buf * 16384;
        __builtin_amdgcn_global_load_lds((const unsigned*)(b0 + kt * 32), (unsigned*)(base + 8192 + tid * 16), 16, 0, 0);
        __builtin_amdgcn_global_load_lds((const unsigned*)(b1 + kt * 32), (unsigned*)(base + 12288 + tid * 16), 16, 0, 0);
    };
    __syncthreads();
    loadA(0); stageB(0, 0); storeA(0);
#pragma unroll 1
    for (int kt = 0; kt < KT; ++kt) {
        asm volatile("s_waitcnt vmcnt(0)" ::: "memory");
        __syncthreads();
        if (kt + 1 < KT) { loadA(kt + 1); stageB(kt + 1, (kt + 1) & 1); }
        const char* SA = smem + (kt & 1) * 16384;
        const char* SB = SA + 8192;
        bf16x8 At[4], Bt[4];
#pragma unroll
        for (int m = 0; m < 4; ++m) At[m] = *(const bf16x8*)(SA + (wr * 64 + m * 16 + fr) * 64 + fq * 16);
#pragma unroll
        for (int n = 0; n < 4; ++n) Bt[n] = *(const bf16x8*)(SB + (wc * 64 + n * 16 + fr) * 64 + fq * 16);
#pragma unroll
        for (int m = 0; m < 4; ++m)
#pragma unroll
            for (int n = 0; n < 4; ++n) acc[m][n] = MFMA16(At[m], Bt[n], acc[m][n]);
        if (kt + 1 < KT) storeA((kt + 1) & 1);
    }
}

template <int MR>
DI void mma_lds64(f32x4 (&acc)[MR][4], const u16* As, int lda, const u16* Bs, int ldb) {
    const int tid = TIDX(), lane = tid & 63, wid = tid >> 6, wr = wid >> 1, wc = wid & 1, fr = lane & 15, fq = lane >> 4;
#pragma unroll
    for (int kk = 0; kk < 2; ++kk) {
        bf16x8 At[MR], Bt[4];
#pragma unroll
        for (int m = 0; m < MR; ++m) At[m] = *(const bf16x8*)(As + (wr * (MR * 16) + m * 16 + fr) * lda + kk * 32 + fq * 8);
#pragma unroll
        for (int n = 0; n < 4; ++n) Bt[n] = *(const bf16x8*)(Bs + (wc * 64 + n * 16 + fr) * ldb + kk * 32 + fq * 8);
#pragma unroll
        for (int m = 0; m < MR; ++m)
#pragma unroll
            for (int n = 0; n < 4; ++n) acc[m][n] = MFMA16(At[m], Bt[n], acc[m][n]);
    }
}
typedef short v4s_ __attribute__((ext_vector_type(4)));
typedef __attribute__((address_space(3))) v4s_* lds_v4s_ptr_;
DI bf16x8 frag_tr(const u16* M, int ld, int k0, int c0) {
    const int lane = TIDX() & 63, i = lane & 15, g = lane >> 4;
    const u16* a = M + (k0 + 8 * g + (i >> 2)) * ld + c0 + 4 * (i & 3);
    v4s_ lo = __builtin_amdgcn_ds_read_tr16_b64_v4i16((lds_v4s_ptr_)a);
    v4s_ hi = __builtin_amdgcn_ds_read_tr16_b64_v4i16((lds_v4s_ptr_)(a + 4 * ld));
    return __builtin_shufflevector(lo, hi, 0, 1, 2, 3, 4, 5, 6, 7);
}
template <int MR>
DI void mma_lds64_btr(f32x4 (&acc)[MR][4], const u16* As, int lda, const u16* Bm, int ldb) {
    const int tid = TIDX(), lane = tid & 63, wid = tid >> 6, wr = wid >> 1, wc = wid & 1, fr = lane & 15, fq = lane >> 4;
#pragma unroll
    for (int kk = 0; kk < 2; ++kk) {
        bf16x8 At[MR], Bt[4];
#pragma unroll
        for (int m = 0; m < MR; ++m) At[m] = *(const bf16x8*)(As + (wr * (MR * 16) + m * 16 + fr) * lda + kk * 32 + fq * 8);
#pragma unroll
        for (int n = 0; n < 4; ++n) Bt[n] = frag_tr(Bm, ldb, kk * 32, wc * 64 + n * 16);
#pragma unroll
        for (int m = 0; m < MR; ++m)
#pragma unroll
            for (int n = 0; n < 4; ++n) acc[m][n] = MFMA16(At[m], Bt[n], acc[m][n]);
    }
}
template <int MR>
DI void mma_lds64_tt(f32x4 (&acc)[MR][4], const u16* Am, int lda, const u16* Bm, int ldb) {
    const int tid = TIDX(), wid = tid >> 6, wr = wid >> 1, wc = wid & 1;
#pragma unroll
    for (int kk = 0; kk < 2; ++kk) {
        bf16x8 At[MR], Bt[4];
#pragma unroll
        for (int m = 0; m < MR; ++m) At[m] = frag_tr(Am, lda, kk * 32, wr * (MR * 16) + m * 16);
#pragma unroll
        for (int n = 0; n < 4; ++n) Bt[n] = frag_tr(Bm, ldb, kk * 32, wc * 64 + n * 16);
#pragma unroll
        for (int m = 0; m < MR; ++m)
#pragma unroll
            for (int n = 0; n < 4; ++n) acc[m][n] = MFMA16(At[m], Bt[n], acc[m][n]);
    }
}
template <bool SCALE, int NCH>
DI void stage_rows64(u16* dst, int ld, const u16* src0, const u16* src1, long sstride, float z0  , float zstep_unused) {
    const int tid = TIDX();
#pragma unroll
    for (int i = 0; i < NCH / 4; ++i) {
        const int idx = i * 256 + tid, row = idx / NCH, ch = idx % NCH;
        u32x4 v = *(const u32x4*)((ch < 8 ? src0 + ch * 8 : src1 + (ch - 8) * 8) + (long)row * sstride);
        *(u32x4*)(dst + row * ld + ch * 8) = v;
    }
}
template <int ROWS>
DI void stage_n64(u16* dst, int ld, const u16* src, long sstride) {
    const int tid = TIDX();
#pragma unroll
    for (int i = 0; i < ROWS / 32; ++i) {
        int idx = i * 256 + tid, row = idx >> 3, ch = idx & 7;
        u32x4 v = *(const u32x4*)(src + (long)row * sstride + ch * 8);
        *(u32x4*)(dst + row * ld + ch * 8) = v;
    }
}
template <bool SCALE, int NF>
DI void stage_t64(u16* dst, int ld, const u16* src, long sstride, float scale_tok_lane  ) {
    const int tid = TIDX();
#pragma unroll
    for (int i = 0; i < NF / 32; ++i) {
        int idx = i * 256 + tid, jj = idx & 63, ch = idx >> 6;
        u32x4 v = *(const u32x4*)(src + (long)jj * sstride + ch * 8);
#pragma unroll
        for (int e = 0; e < 4; ++e) {
            float lo = bflo(v[e]), hi = bfhi(v[e]);
            if (SCALE) { lo *= scale_tok_lane; hi *= scale_tok_lane; }
            dst[(ch * 8 + 2 * e) * ld + jj] = SCALE ? f2bf(lo) : (u16)(v[e] & 0xffffu);
            dst[(ch * 8 + 2 * e + 1) * ld + jj] = SCALE ? f2bf(hi) : (u16)(v[e] >> 16);
        }
    }
}

DI void convert_tile(KP p, int layer, int tile, char* smem);

DI void ph0_gemv_item(KP p, int item, char* smem) {
    const int tid = TIDX();
    const int l = item / 96, cg_ = item % 96;
    float* sl = (float*)smem;
    float* red = (float*)(smem + 8192);
    __syncthreads();
    for (int k = tid; k < 1024; k += 256) { sl[k] = siluf_(p->c[k]); sl[1024 + k] = siluf_(p->c_ctx[k]); }
    __syncthreads();
    const int c4 = tid & 15, kp = tid >> 4;
    const int col = cg_ * 64 + c4 * 4;
    const float* w = p->w_mod + (long)l * 1024 * 6144 + col;
    float a0[4] = {0, 0, 0, 0}, a1[4] = {0, 0, 0, 0};
#pragma unroll 8
    for (int kk = 0; kk < 64; ++kk) {
        int k = kp * 64 + kk;
        float4 wv = *(const float4*)(w + (long)k * 6144);
        float s0 = sl[k], s1 = sl[1024 + k];
        a0[0] += s0 * wv.x; a0[1] += s0 * wv.y; a0[2] += s0 * wv.z; a0[3] += s0 * wv.w;
        a1[0] += s1 * wv.x; a1[1] += s1 * wv.y; a1[2] += s1 * wv.z; a1[3] += s1 * wv.w;
    }
#pragma unroll
    for (int j = 0; j < 4; ++j) { red[(kp * 2 + 0) * 64 + c4 * 4 + j] = a0[j]; red[(kp * 2 + 1) * 64 + c4 * 4 + j] = a1[j]; }
    __syncthreads();
    if (tid < 128) {
        int src = tid >> 6, cr = tid & 63;
        float s = 0.f;
        for (int q = 0; q < 16; ++q) s += red[(q * 2 + src) * 64 + cr];
        int n = cg_ * 64 + cr;
        P_mod(p)[(l * 2 + src) * 6144 + n] = s + p->b_mod[l * 6144 + n];
    }
}
DI void sincos_d(double a, float& c, float& s) {
    const double TWO_PI = 6.283185307179586476925286766559;
    double k = rint(a / TWO_PI);
    double r = a - k * TWO_PI;
    double r2 = r * r;
    double ts = r, tc = 1.0, ss = r, cc = 1.0;
    for (int i = 1; i <= 14; ++i) {
        tc = -tc * r2 / (double)((2 * i - 1) * (2 * i));
        ts = -ts * r2 / (double)((2 * i) * (2 * i + 1));
        cc += tc; ss += ts;
    }
    c = (float)cc; s = (float)ss;
}
DI void ph0_rope_item(KP p, int item) {
    int idx = item * 256 + TIDX();
    const double LN_BASE = 9.210340371976184;
    if (idx < 8192) {
        int pos = idx >> 5, f = idx & 31;
        float inv = (float)exp(-(double)f / 32.0 * LN_BASE);
        float ang = (float)pos * inv;
        float c, s; sincos_d((double)ang, c, s);
        P_rope128(p)[idx] = make_float2(c, s);
    } else {
        int i2 = idx - 8192;
        int pos = i2 >> 4, f = i2 & 15;
        float inv = (float)exp(-(double)f / 16.0 * LN_BASE);
        float ang = (float)pos * inv;
        float c, s; sincos_d((double)ang, c, s);
        P_rope64(p)[i2] = make_float2(c, s);
    }
}

constexpr int CONV_TILES = 928 + 192 + 128 + 6144;
constexpr int CONV_DENSE = 928 + 192 + 128;
struct ConvTile { const float* sp; u16* dp; int N, K, mode, n0; };
DI ConvTile conv_setup(KP p, int layer, int tile) {
    const float* src; u16* dst; int K, N, mode = 0;
    if (tile < 928) { src = p->w_in + (long)layer * 1024 * INC; dst = P_wt_in(p); K = 1024; N = INC; mode = 1; }
    else if (tile < 928 + 192) {
        int t = tile - 928, which = t / 64; tile = t % 64; K = 512; N = 1024;
        src = (which == 0 ? p->w_ret : which == 1 ? p->w_win : p->w_na) + (long)layer * 512 * 1024;
        dst = (which == 0 ? P_wt_ret(p) : which == 1 ? P_wt_win(p) : P_wt_na(p));
    } else if (tile < 928 + 192 + 128) { tile -= 928 + 192; src = p->w_out + (long)layer * 1024 * 1024; dst = P_wt_out(p); K = 1024; N = 1024; }
    else {
        int t = tile - (928 + 192 + 128), which = t / 2048, e = (t % 2048) / 128; tile = t % 128; K = 1024; N = 1024;
        long eo = ((long)layer * NEXP + e) * 1024 * 1024;
        if (which == 0) { src = p->w_eg + eo; dst = P_wt_gu(p) + (long)e * 2048 * 1024; mode = 2; }
        else if (which == 1) { src = p->w_eu + eo; dst = P_wt_gu(p) + (long)e * 2048 * 1024; mode = 3; }
        else { src = p->w_ed + eo; dst = P_wt_dn(p) + (long)e * 1024 * 1024; }
    }
    const int ntn = N / 64;
    const int k0 = (tile / ntn) * 128, n0 = (tile % ntn) * 64;
    ConvTile c; c.sp = src + (long)k0 * N + n0; c.dp = dst + k0; c.N = N; c.K = K; c.mode = mode; c.n0 = n0;
    return c;
}
DI int conv_drow(int mode, int n) {
    if (mode == 1) {
        if (n < 1024) { int hh_ = (n & 511) >> 7, o_ = n & 127; return (n < 512 ? col_qr(hh_, o_ >> 6) : col_kr(hh_, o_ >> 6)) + (o_ & 63); }
        if (n >= C_QW && n < C_KW) { int m_ = n - C_QW; return col_qw(m_ >> 6, (m_ & 63) >> 5) + (m_ & 31); }
        if (n >= C_KW && n < C_VW) { int m_ = n - C_KW; return col_kw(m_ >> 6, (m_ & 63) >> 5) + (m_ & 31); }
        if (n >= C_VW && n < C_QN) { int m_ = n - C_VW; return col_vw(m_ >> 6) + (m_ & 63); }
        return n;
    }
    if (mode == 2) return (n >> 7) * 256 + (n & 127);
    if (mode == 3) return (n >> 7) * 256 + 128 + (n & 127);
    return n;
}
DI void convert_tiles(KP p, int layer, int first, int last, int step, char* smem) {
    const int tid = TIDX(), lane = tid & 63, w = tid >> 6;
    unsigned* T = (unsigned*)smem;
    float v[32];
    ConvTile c;
    if (first < last) {
        c = conv_setup(p, layer, first);
        const float* sp = c.sp + (long)(w * 32) * c.N + lane;
#pragma unroll
        for (int j = 0; j < 32; ++j) v[j] = sp[(long)j * c.N];
    }
    for (int t = first; t < last; t += step) {
        __syncthreads();
#pragma unroll
        for (int e = 0; e < 16; ++e) T[lane * 66 + w * 16 + e] = pack2(v[2 * e], v[2 * e + 1]);
        const ConvTile cur = c;
        if (t + step < last) {
            c = conv_setup(p, layer, t + step);
            const float* sp = c.sp + (long)(w * 32) * c.N + lane;
#pragma unroll
            for (int j = 0; j < 32; ++j) v[j] = sp[(long)j * c.N];
        }
        __syncthreads();
#pragma unroll
        for (int i = 0; i < 4; ++i) {
            const int idx = i * 256 + tid, nn = idx >> 4, ch = idx & 15;
            const u32x4 o = *(const u32x4*)(T + nn * 66 + ch * 4);
            *(u32x4*)(cur.dp + (long)conv_drow(cur.mode, cur.n0 + nn) * cur.K + ch * 8) = o;
        }
    }
}

DI void convert_tiles4(KP p, int layer, int first, int last, int step, char* smem) {
    const int tid = TIDX(), lane = tid & 63, w = tid >> 6;
    unsigned* T = (unsigned*)smem;
    for (int t = first; t < last; t += 4 * step) {
        float v[4][32];
        ConvTile c[4];
#pragma unroll
        for (int q = 0; q < 4; ++q) {
            const int tq = t + q * step;
            c[q] = conv_setup(p, layer, tq < last ? tq : first);
            if (tq < last) {
                const float* sp = c[q].sp + (long)(w * 32) * c[q].N + lane;
#pragma unroll
                for (int j = 0; j < 32; ++j) v[q][j] = sp[(long)j * c[q].N];
            }
        }
        __syncthreads();
#pragma unroll
        for (int q = 0; q < 4; ++q)
#pragma unroll
            for (int e = 0; e < 16; ++e) T[q * (64 * 66) + lane * 66 + w * 16 + e] = pack2(v[q][2 * e], v[q][2 * e + 1]);
        __syncthreads();
#pragma unroll
        for (int q = 0; q < 4; ++q) {
            if (t + q * step < last) {
#pragma unroll
                for (int i = 0; i < 4; ++i) {
                    const int idx = i * 256 + tid, nn = idx >> 4, ch = idx & 15;
                    const u32x4 o = *(const u32x4*)(T + q * (64 * 66) + nn * 66 + ch * 4);
                    *(u32x4*)(c[q].dp + (long)conv_drow(c[q].mode, c[q].n0 + nn) * c[q].K + ch * 8) = o;
                }
            }
        }
    }
}

DI const float* resid_row(KP p, int layer, int row) {
    if (row < NLAT) return (layer == 0 ? p->x : p->out) + (long)row * DM;
    return (layer == 0 ? p->ctx : P_ctxres(p)) + (long)(row - NLAT) * DM;
}
DI const float* cur_row(KP p, int row) { return row < NLAT ? p->out + (long)row * DM : P_ctxres(p) + (long)(row - NLAT) * DM; }
DI void moe_combine(KP p, int row, float4 (&v)[4]) {
    const int lane = TIDX() & 63;
    const bool lat = row < NLAT;
    const int* ts = P_tslot(p) + (lat ? 0 : 16) * (long)NLAT + (lat ? row : row - NLAT);
    const u16* yb_ = lat ? P_ye(p) : P_yec(p);
    const int cap = lat ? CAP_LAT : CAP_CTX;
#pragma unroll 4
    for (int e = 0; e < NEXP; ++e) {
        const int slot = ts[(long)e * NLAT];
        if (slot >= 0) {
            const u16* yr = yb_ + ((long)e * cap + slot) * DM + lane * 4;
#pragma unroll
            for (int i = 0; i < 4; ++i) {
                uint2 w = *(const uint2*)(yr + i * 256);
                v[i].x += bflo(w.x); v[i].y += bfhi(w.x); v[i].z += bflo(w.y); v[i].w += bfhi(w.y);
            }
        }
    }
}
DI void norm_row(KP p, int layer, int row, const float* xr, const float* g, int shift_idx, int scale_idx, u16* dst_row, float* keep  , float* wb  ) {
    const int lane = TIDX() & 63;
    const float* md = P_mod(p) + (layer * 2 + (row < NLAT ? 0 : 1)) * 6144;
    float4 v[4]; float ss = 0.f;
#pragma unroll
    for (int i = 0; i < 4; ++i) v[i] = *(const float4*)(xr + i * 256 + lane * 4);
    if (wb) {
        moe_combine(p, row, v);
#pragma unroll
        for (int i = 0; i < 4; ++i) *(float4*)(wb + i * 256 + lane * 4) = v[i];
    }
#pragma unroll
    for (int i = 0; i < 4; ++i) ss += v[i].x * v[i].x + v[i].y * v[i].y + v[i].z * v[i].z + v[i].w * v[i].w;
    ss = wave_sum(ss);
    float rstd = rsqrtf(ss * (1.f / DM) + 1e-6f);
#pragma unroll
    for (int i = 0; i < 4; ++i) {
        int c0 = i * 256 + lane * 4;
        float4 gg = *(const float4*)(g + c0), sh = *(const float4*)(md + shift_idx * 1024 + c0), sc = *(const float4*)(md + scale_idx * 1024 + c0);
        float o0 = v[i].x * rstd * gg.x * (1.f + sc.x) + sh.x, o1 = v[i].y * rstd * gg.y * (1.f + sc.y) + sh.y;
        float o2 = v[i].z * rstd * gg.z * (1.f + sc.z) + sh.z, o3 = v[i].w * rstd * gg.w * (1.f + sc.w) + sh.w;
        uint2 pk; pk.x = pack2(o0, o1); pk.y = pack2(o2, o3);
        *(uint2*)(dst_row + c0) = pk;
        if (keep) *(float4*)(keep + c0) = make_float4(o0, o1, o2, o3);
    }
}

DI void norm_rows4(KP p, int layer, int row0, const float* g, int shift_idx, int scale_idx, bool first_layer_src, bool combine, float* keep = nullptr  ) {
    const int lane = TIDX() & 63;
    const float* md = P_mod(p) + (layer * 2 + (row0 < NLAT ? 0 : 1)) * 6144;
    float4 v[4][4];
#pragma unroll
    for (int r = 0; r < 4; ++r) {
        const float* xr = first_layer_src ? resid_row(p, 0, row0 + r) : cur_row(p, row0 + r);
#pragma unroll
        for (int i = 0; i < 4; ++i) v[r][i] = *(const float4*)(xr + i * 256 + lane * 4);
    }
    float4 gg[4], sh[4], sc[4];
#pragma unroll
    for (int i = 0; i < 4; ++i) { const int c0 = i * 256 + lane * 4; gg[i] = *(const float4*)(g + c0); sh[i] = *(const float4*)(md + shift_idx * 1024 + c0); sc[i] = *(const float4*)(md + scale_idx * 1024 + c0); }
#pragma unroll
    for (int r = 0; r < 4; ++r) {
        const int row = row0 + r;
        if (first_layer_src && row >= NLAT) {
            float* wb = (float*)cur_row(p, row);
#pragma unroll
            for (int i = 0; i < 4; ++i) *(float4*)(wb + i * 256 + lane * 4) = v[r][i];
        }
        if (combine) {
            moe_combine(p, row, v[r]);
            float* wb = (float*)cur_row(p, row);
#pragma unroll
            for (int i = 0; i < 4; ++i) *(float4*)(wb + i * 256 + lane * 4) = v[r][i];
        }
        float ss = 0.f;
#pragma unroll
        for (int i = 0; i < 4; ++i) ss += v[r][i].x * v[r][i].x + v[r][i].y * v[r][i].y + v[r][i].z * v[r][i].z + v[r][i].w * v[r][i].w;
        ss = wave_sum(ss);
        const float rstd = rsqrtf(ss * (1.f / DM) + 1e-6f);
        u16* dst_row = P_hx(p) + (long)row * DM;
#pragma unroll
        for (int i = 0; i < 4; ++i) {
            const int c0 = i * 256 + lane * 4;
            float o0 = v[r][i].x * rstd * gg[i].x * (1.f + sc[i].x) + sh[i].x, o1 = v[r][i].y * rstd * gg[i].y * (1.f + sc[i].y) + sh[i].y;
            float o2 = v[r][i].z * rstd * gg[i].z * (1.f + sc[i].z) + sh[i].z, o3 = v[r][i].w * rstd * gg[i].w * (1.f + sc[i].w) + sh[i].w;
            uint2 pk; pk.x = pack2(o0, o1); pk.y = pack2(o2, o3);
            *(uint2*)(dst_row + c0) = pk;
            if (keep) *(float4*)(keep + r * 1024 + c0) = make_float4(o0, o1, o2, o3);
        }
    }
}

DI void phB_tile(KP p, int mt, int nt, char* smem) {
    const int tid = TIDX(), lane = tid & 63, wid = tid >> 6, wr = wid >> 1, wc = wid & 1, fr = lane & 15, fq = lane >> 4;
    f32x4 acc[4][4]; zero_acc<4>(acc);
    const int r0 = tid >> 2, ko = (tid & 3) * 8;
    const u16* a0 = P_hx(p) + (long)(mt * 128 + r0) * DM + ko;
    const u16* b0 = P_wt_in(p) + (long)(nt * 128 + r0) * DM + ko;
    gemm_core<32>(acc, a0, a0 + 64 * DM, b0, b0 + 64 * DM, smem);
    const bool lat = mt < 128;
    const int type = (nt < 8) ? 1 : (nt >= 16 && nt < 21) ? 2 : 0;
    if (type != 0 && lat) {
#pragma unroll
        for (int m = 0; m < 4; ++m)
#pragma unroll
            for (int j = 0; j < 4; ++j) {
                int t = mt * 128 + wr * 64 + m * 16 + fq * 4 + j;
                int pr = t >> 6, pc = t & 63;
#pragma unroll
                for (int n = 0; n < 2; ++n) {
                    float2 cs;
                    if (type == 1) { int pos = (wc == 0) ? pr : pc; cs = P_rope128(p)[pos * 32 + n * 16 + fr]; }
                    else { int pos = (n == 0) ? pr : pc; cs = P_rope64(p)[pos * 16 + fr]; }
                    float x1 = acc[m][n][j], x2 = acc[m][n + 2][j];
                    acc[m][n][j] = x1 * cs.x - x2 * cs.y;
                    acc[m][n + 2][j] = x1 * cs.y + x2 * cs.x;
                }
            }
    }
    const float mul = (nt >= 4 && nt < 8) ? 0.08838834764831845f : ((nt >= 16 && nt < 20) || (nt >= 22 && nt < 26)) ? 0.125f : 1.f;
#pragma unroll
    for (int m = 0; m < 4; ++m)
#pragma unroll
        for (int n = 0; n < 4; ++n)
#pragma unroll
            for (int j = 0; j < 4; ++j) {
                int row = mt * 128 + wr * 64 + m * 16 + fq * 4 + j, col = nt * 128 + wc * 64 + n * 16 + fr;
                P_px(p)[(long)row * INC + col] = f2bf(acc[m][n][j] * mul);
            }
}

typedef __attribute__((ext_vector_type(16))) float f32x16;
typedef short v4s __attribute__((ext_vector_type(4)));
typedef __attribute__((address_space(3))) v4s* lds_v4s_ptr;
#define MFMA32(a, b, c) __builtin_amdgcn_mfma_f32_32x32x16_bf16((a), (b), (c), 0, 0, 0)
constexpr float LOG2E = 1.4426950408889634f;

struct FA {
    bf16x8 qf[4];
    f32x16 o[2];
    float m, l;
};
DI void fa_stage(u16* Ks, u16* Vs, const u16* px, int rowstart, int colK1, int colK2, int colV) {
    const int lane = TIDX() & 63;
#pragma unroll
    for (int i = 0; i < 8; ++i) {
        int idx = i * 64 + lane, key = idx >> 3, ch = idx & 7;
        const u16* src = px + (long)(rowstart + key) * INC;
        u32x4 kv = *(const u32x4*)(src + (ch < 4 ? colK1 + ch * 8 : colK2 + (ch - 4) * 8));
        u32x4 vv = *(const u32x4*)(src + colV + ch * 8);
        *(u32x4*)(Ks + key * 72 + ch * 8) = kv;
        *(u32x4*)(Vs + key * 72 + ch * 8) = vv;
    }
}
template <int MODE>
DI void fa_tile(FA& st, const u16* Ks, const u16* Vs, int a0, const float* rrow) {
    const int lane = TIDX() & 63, c = lane & 31, hh = lane >> 5;
    const u16* kbase = Ks + c * 72 + hh * 8;
    const u16* vbase = Vs + (4 * hh + ((lane & 15) >> 2)) * 72 + 16 * ((lane >> 4) & 1) + 4 * (lane & 3);
    f32x16 s[2];
#pragma unroll
    for (int kb = 0; kb < 2; ++kb) {
#pragma unroll
        for (int r = 0; r < 16; ++r) s[kb][r] = 0.f;
#pragma unroll
        for (int ks = 0; ks < 4; ++ks) {
            bf16x8 A = *(const bf16x8*)(kbase + kb * 32 * 72 + ks * 16);
            s[kb] = MFMA32(A, st.qf[ks], s[kb]);
        }
    }
    float mx = -3.0e38f;
    const int cq = a0 + c;
    int cs = cq - 8; cs = cs < 0 ? 0 : (cs > 48 ? 48 : cs);
#pragma unroll
    for (int kb = 0; kb < 2; ++kb)
#pragma unroll
        for (int r = 0; r < 16; ++r) {
            const int j = kb * 32 + (r & 3) + 8 * (r >> 2) + 4 * hh;
            float v = s[kb][r];
            if (MODE == 1) { int d = a0 + j - c; v = (d >= -128 && d <= 128) ? v : -1e30f; }
            if (MODE == 2) { bool ok = (j >= cs) && (j < cs + 16); int ci = j - cq + 15; ci = ci < 0 ? 0 : (ci > 30 ? 30 : ci); v = ok ? v + rrow[ci] : -1e30f; }
            s[kb][r] = v;
            mx = fmaxf(mx, v);
        }
    mx = fmaxf(mx, __shfl_xor(mx, 32));
    const float mn = fmaxf(st.m, mx);
    const float alpha = __builtin_amdgcn_exp2f(st.m - mn);
    float ls = 0.f;
#pragma unroll
    for (int kb = 0; kb < 2; ++kb)
#pragma unroll
        for (int r = 0; r < 16; ++r) { float pv = __builtin_amdgcn_exp2f(s[kb][r] - mn); s[kb][r] = pv; ls += pv; }
    st.l = st.l * alpha + ls; st.m = mn;
    if (__any(alpha != 1.f)) {
#pragma unroll
        for (int db = 0; db < 2; ++db)
#pragma unroll
            for (int r = 0; r < 16; ++r) st.o[db][r] *= alpha;
    }
    bf16x8 pf[2][2];
#pragma unroll
    for (int kb = 0; kb < 2; ++kb)
#pragma unroll
        for (int k2 = 0; k2 < 2; ++k2) {
            u32x4 w;
#pragma unroll
            for (int e = 0; e < 4; ++e) w[e] = pack2(s[kb][8 * k2 + 2 * e], s[kb][8 * k2 + 2 * e + 1]);
            pf[kb][k2] = __builtin_bit_cast(bf16x8, w);
        }
#pragma unroll
    for (int db = 0; db < 2; ++db)
#pragma unroll
        for (int kb = 0; kb < 2; ++kb)
#pragma unroll
            for (int k2 = 0; k2 < 2; ++k2) {
                const u16* alo = vbase + (kb * 32 + 16 * k2) * 72 + db * 32;
                v4s lo = __builtin_amdgcn_ds_read_tr16_b64_v4i16((lds_v4s_ptr)alo);
                v4s hi = __builtin_amdgcn_ds_read_tr16_b64_v4i16((lds_v4s_ptr)(alo + 8 * 72));
                bf16x8 A = __builtin_shufflevector(lo, hi, 0, 1, 2, 3, 4, 5, 6, 7);
                st.o[db] = MFMA32(A, pf[kb][k2], st.o[db]);
            }
}
DI void fa_tile_na32(FA& st, const u16* Ks, const u16* Vs, int koff, bool rowok, int cs, const float* brow) {
    const int lane = TIDX() & 63, c = lane & 31, hh = lane >> 5;
    const u16* kbase = Ks + (koff + c) * 72 + hh * 8;
    const u16* vbase = Vs + (koff + 4 * hh + ((lane & 15) >> 2)) * 72 + 16 * ((lane >> 4) & 1) + 4 * (lane & 3);
    f32x16 s;
#pragma unroll
    for (int r = 0; r < 16; ++r) s[r] = 0.f;
#pragma unroll
    for (int ks = 0; ks < 4; ++ks) {
        bf16x8 A = *(const bf16x8*)(kbase + ks * 16);
        s = MFMA32(A, st.qf[ks], s);
    }
    float mx = -3.0e38f;
    const int lo = cs - koff;
#pragma unroll
    for (int r = 0; r < 16; ++r) {
        const int jj = (r & 3) + 8 * (r >> 2) + 4 * hh;
        const bool ok = rowok && (jj >= lo) && (jj < lo + 16);
        float v = ok ? s[r] + brow[jj] : -1.4e30f;
        s[r] = v;
        mx = fmaxf(mx, v);
    }
    mx = fmaxf(mx, __shfl_xor(mx, 32));
    const float mn = fmaxf(st.m, mx);
    const float alpha = __builtin_amdgcn_exp2f(st.m - mn);
    float ls = 0.f;
#pragma unroll
    for (int r = 0; r < 16; ++r) { float pv = __builtin_amdgcn_exp2f(s[r] - mn); s[r] = pv; ls += pv; }
    st.l = st.l * alpha + ls; st.m = mn;
    if (__any(alpha != 1.f)) {
#pragma unroll
        for (int db = 0; db < 2; ++db)
#pragma unroll
            for (int r = 0; r < 16; ++r) st.o[db][r] *= alpha;
    }
    bf16x8 pf[2];
#pragma unroll
    for (int k2 = 0; k2 < 2; ++k2) {
        u32x4 w;
#pragma unroll
        for (int e = 0; e < 4; ++e) w[e] = pack2(s[8 * k2 + 2 * e], s[8 * k2 + 2 * e + 1]);
        pf[k2] = __builtin_bit_cast(bf16x8, w);
    }
#pragma unroll
    for (int db = 0; db < 2; ++db)
#pragma unroll
        for (int k2 = 0; k2 < 2; ++k2) {
            const u16* alo = vbase + (16 * k2) * 72 + db * 32;
            v4s lo_ = __builtin_amdgcn_ds_read_tr16_b64_v4i16((lds_v4s_ptr)alo);
            v4s hi_ = __builtin_amdgcn_ds_read_tr16_b64_v4i16((lds_v4s_ptr)(alo + 8 * 72));
            bf16x8 A = __builtin_shufflevector(lo_, hi_, 0, 1, 2, 3, 4, 5, 6, 7);
            st.o[db] = MFMA32(A, pf[k2], st.o[db]);
        }
}
DI void attn_block_item(KP p, int layer, int kind, int ia, int ib, char* smem) {
    const int tid = TIDX(), lane = tid & 63, wid = tid >> 6, c = lane & 31, hh = lane >> 5;
    u16* KV = (u16*)smem;
    float* rpbs = (float*)(smem + 36864) + 64 + wid * 512;
    const bool isna = (kind == 1 || kind == 3);
    int h, q0, a_half = 0, kvh;
    if (kind == 0) { h = ib * 4 + wid; kvh = ib; q0 = ia * 32; }
    else if (kind == 1) { h = ib; kvh = ib; q0 = 2 * ia * 64; }
    else if (kind == 2) { h = ib * 4 + wid; kvh = ib; q0 = NLAT + ia * 32; }
    else { h = ib; kvh = ib; q0 = NLAT + (ia * 4 + wid) * 32; }
    const int colQ1 = isna ? C_QN + h * 64 : col_qw(h, 0), colQ2 = isna ? colQ1 + 32 : col_qw(h, 1);
    const int colK1 = isna ? C_KN + kvh * 64 : col_kw(kvh, 0), colK2 = isna ? colK1 + 32 : col_kw(kvh, 1);
    const int colV = isna ? C_VN + kvh * 64 : col_vw(kvh);
    FA st;
    {
        const int tq = (kind == 1) ? q0 + (c >> 4) * 64 + wid * 16 + (c & 15) : q0 + c;
        const u16* qrow = P_px(p) + (long)tq * INC;
#pragma unroll
        for (int ks = 0; ks < 4; ++ks) st.qf[ks] = *(const bf16x8*)(qrow + (ks < 2 ? colQ1 + ks * 16 : colQ2 + (ks - 2) * 16) + hh * 8);
#pragma unroll
        for (int db = 0; db < 2; ++db)
#pragma unroll
            for (int r = 0; r < 16; ++r) st.o[db][r] = 0.f;
        if (isna) { st.m = -1e30f; st.l = 0.f; } else { st.m = p->sink[layer * 8 + h] * LOG2E; st.l = hh == 0 ? 1.f : 0.f; }
    }
    const int r0 = 2 * ia, rq = r0 + (c >> 4), cq = wid * 16 + (c & 15);
    int sr0 = r0 - 4; sr0 = sr0 < 0 ? 0 : (sr0 > 248 ? 248 : sr0);
    int srq = rq - 4; srq = srq < 0 ? 0 : (srq > 248 ? 248 : srq);
    int sr1 = r0 + 1 - 4; sr1 = sr1 < 0 ? 0 : (sr1 > 248 ? 248 : sr1);
    int csq = cq - 8; csq = csq < 0 ? 0 : (csq > 48 ? 48 : csq);
    const int koff = wid == 0 ? 0 : wid == 1 ? 8 : wid == 2 ? 24 : 32;
    const float* bq = rpbs + (7 - rq) * 31 + koff - cq + 15;
    if (kind == 1) {
        const float* rp = p->rpb + ((long)layer * 8 + h) * 465;
        for (int i = lane; i < 465; i += 64) rpbs[i] = rp[i] * LOG2E;
    }
    const int nloc = kind == 0 ? 5 : kind == 1 ? 9 : 0, nt = nloc + 4;
    const int wt0 = (q0 >> 6) - 2;
    auto tile_row = [&](int i) -> int {
        if (i >= nloc) return NLAT + (i - nloc) * 64;
        if (kind == 0) { const int s0 = ((ia * 32) >> 6) - 2 + i; return (s0 < 0 || s0 >= NLAT / 64) ? -1 : s0 * 64; }
        const int kr = sr0 + i; return (kr > sr1 + 7) ? -1 : kr * 64;
    };
    const int skey = tid >> 4, sc16 = tid & 15;
    const int scol = sc16 < 8 ? (sc16 < 4 ? colK1 + sc16 * 8 : colK2 + (sc16 - 4) * 8) : colV + (sc16 - 8) * 8;
    const int sdst = (sc16 < 8 ? 0 : 64 * 72) + skey * 72 + (sc16 & 7) * 8;
    u32x4 preA[4], preB[4];
#define ATT_LOAD(SET, row0) do { _Pragma("unroll") for (int j = 0; j < 4; ++j) SET[j] = *(const u32x4*)(P_px(p) + (long)((row0) + skey + 16 * j) * INC + scol); } while (0)
#define ATT_STORE(SET, buf) do { _Pragma("unroll") for (int j = 0; j < 4; ++j) *(u32x4*)(KV + (buf) * (2 * 64 * 72) + sdst + 16 * j * 72) = SET[j]; } while (0)
    auto compute = [&](int i, int rowc) {
        if (rowc < 0) return;
        const u16* Ks = KV + (i & 1) * (2 * 64 * 72);
        const u16* Vs = Ks + 64 * 72;
        if (i >= nloc) fa_tile<0>(st, Ks, Vs, 0, nullptr);
        else if (kind == 0) { if (i == 0 || i == 4) fa_tile<1>(st, Ks, Vs, rowc - q0, nullptr); else fa_tile<0>(st, Ks, Vs, 0, nullptr); }
        else { const int kr = sr0 + i; fa_tile_na32(st, Ks, Vs, koff, kr >= srq && kr < srq + 8, csq, bq + kr * 31); }
    };
    __syncthreads();
    int row0_ = tile_row(0), row1_ = tile_row(1);
    if (row0_ >= 0) { ATT_LOAD(preA, row0_); ATT_STORE(preA, 0); }
    if (row1_ >= 0) ATT_LOAD(preB, row1_);
    __syncthreads();
    int rowc = row0_, rown = row1_;
    for (int i = 0; i < nt; i += 2) {
        const int r2 = (i + 2 < nt) ? tile_row(i + 2) : -1;
        if (r2 >= 0) ATT_LOAD(preA, r2);
        compute(i, rowc);
        if (i + 1 < nt && rown >= 0) ATT_STORE(preB, 1);
        __syncthreads();
        if (i + 1 >= nt) break;
        const int r3 = (i + 3 < nt) ? tile_row(i + 3) : -1;
        if (r3 >= 0) ATT_LOAD(preB, r3);
        compute(i + 1, rown);
        if (r2 >= 0) ATT_STORE(preA, 0);
        __syncthreads();
        rowc = r2; rown = r3;
    }
#undef ATT_LOAD
#undef ATT_STORE
    u16* y = isna ? P_yc(p) : P_yb(p);
    {
        float lt = st.l + __shfl_xor(st.l, 32);
        float inv = 1.f / lt;
        u16* ob = KV + wid * (32 * 72);
#pragma unroll
        for (int db = 0; db < 2; ++db)
#pragma unroll
            for (int g = 0; g < 4; ++g) {
                uint2 o;
                o.x = pack2(st.o[db][4 * g] * inv, st.o[db][4 * g + 1] * inv);
                o.y = pack2(st.o[db][4 * g + 2] * inv, st.o[db][4 * g + 3] * inv);
                *(uint2*)(ob + c * 72 + db * 32 + 8 * g + 4 * hh) = o;
            }
#pragma unroll
        for (int i = 0; i < 4; ++i) {
            const int idx = i * 64 + lane, qi = idx >> 3, ch = idx & 7;
            const int tq = (kind == 1) ? q0 + (qi >> 4) * 64 + wid * 16 + (qi & 15) : q0 + qi;
            *(u32x4*)(y + (long)tq * 512 + h * 64 + ch * 8) = *(const u32x4*)(ob + qi * 72 + ch * 8);
        }
    }
}

DI void ret_gammas(KP p, int layer, int h, float& lgf2, float& lgb2) {
    float xf = p->decay[layer * 8 + h], xb = p->decay[layer * 8 + 4 + h];
    lgf2 = -log1pf(expf(-xf)) * 1.4426950408889634f;
    lgb2 = -log1pf(expf(-xb)) * 1.4426950408889634f;
}
DI void phC_state_item(KP p, int layer, int c, int h, int eh, char* smem) {
    const int tid = TIDX(), lane = tid & 63, wid = tid >> 6, wr = wid >> 1, wc = wid & 1, fr = lane & 15, fq = lane >> 4;
    u16* Vr = (u16*)smem;
    u16* Kf = Vr + 64 * 72;
    u16* Kb = Kf + 64 * 136;
    float lgf2, lgb2; ret_gammas(p, layer, h, lgf2, lgb2);
    f32x4 accF[2][4], accB[2][4]; zero_acc<2>(accF); zero_acc<2>(accB);
    const u16* base = P_px(p) + (long)c * 128 * INC;
    u32x4 pv[2], pk[4];
    auto load_half = [&](int jh) {
        const u16* rb = base + (long)jh * 64 * INC;
#pragma unroll
        for (int i = 0; i < 2; ++i) { const int idx = i * 256 + tid, row = idx >> 3, ch = idx & 7; pv[i] = *(const u32x4*)(rb + (long)row * INC + C_VR + h * 128 + eh * 64 + ch * 8); }
#pragma unroll
        for (int i = 0; i < 4; ++i) { const int idx = i * 256 + tid, row = idx >> 4, ch = idx & 15; pk[i] = *(const u32x4*)(rb + (long)row * INC + (ch < 8 ? col_kr(h, 0) + ch * 8 : col_kr(h, 1) + (ch - 8) * 8)); }
    };
    auto store_half = [&](int jh) {
#pragma unroll
        for (int i = 0; i < 2; ++i) { const int idx = i * 256 + tid, row = idx >> 3, ch = idx & 7; *(u32x4*)(Vr + row * 72 + ch * 8) = pv[i]; }
#pragma unroll
        for (int i = 0; i < 4; ++i) {
            const int idx = i * 256 + tid, row = idx >> 4, ch = idx & 15, j = jh * 64 + row;
            const float zf = exp2f((float)(127 - j) * lgf2), zb = exp2f((float)j * lgb2);
            u32x4 of, ob;
#pragma unroll
            for (int e = 0; e < 4; ++e) { const float lo = bflo(pk[i][e]), hi = bfhi(pk[i][e]); of[e] = pack2(lo * zf, hi * zf); ob[e] = pack2(lo * zb, hi * zb); }
            *(u32x4*)(Kf + row * 136 + ch * 8) = of;
            *(u32x4*)(Kb + row * 136 + ch * 8) = ob;
        }
    };
    load_half(0);
    __syncthreads();
    store_half(0);
    load_half(1);
    __syncthreads();
    mma_lds64_tt<2>(accF, Vr, 72, Kf, 136);
    mma_lds64_tt<2>(accB, Vr, 72, Kb, 136);
    __syncthreads();
    store_half(1);
    __syncthreads();
    mma_lds64_tt<2>(accF, Vr, 72, Kf, 136);
    mma_lds64_tt<2>(accB, Vr, 72, Kb, 136);
    float* Sf = P_S(p) + ((long)(c * 4 + h) * 2 + 0) * 16384;
    float* Sb = Sf + 16384;
#pragma unroll
    for (int m = 0; m < 2; ++m)
#pragma unroll
        for (int n = 0; n < 4; ++n)
#pragma unroll
            for (int j = 0; j < 4; ++j) {
                int e = eh * 64 + wr * 32 + m * 16 + fq * 4 + j, d = wc * 64 + n * 16 + fr;
                Sf[e * 128 + d] = accF[m][n][j];
                Sb[e * 128 + d] = accB[m][n][j];
            }
}

DI void phD_item(KP p, int layer, int item) {
    const int h = item >> 7, dir = (item >> 6) & 1, pos = (item & 63) * 256 + TIDX();
    float lgf2, lgb2; ret_gammas(p, layer, h, lgf2, lgb2);
    const float decay = exp2f(128.f * (dir == 0 ? lgf2 : lgb2));
    float r = 0.f;
    const long hs = (long)(h * 2 + dir) * 16384 + pos;
    auto chunk_at = [&](int i) -> int {
        if (dir == 0) return i < 2 ? 128 + i : i - 2;
        return i < 2 ? 129 - i : 129 - i;
    };
    for (int i0 = 0; i0 < NCHUNK; i0 += 13) {
        float s[13];
#pragma unroll
        for (int u = 0; u < 13; ++u) s[u] = P_S(p)[(long)chunk_at(i0 + u) * 8 * 16384 + hs];
#pragma unroll
        for (int u = 0; u < 13; ++u) {
            P_R(p)[(long)chunk_at(i0 + u) * 8 * 16384 + hs] = f2bf(r);
            r = decay * r + s[u];
        }
    }
}

DI void phE_item(KP p, int layer, int c, int h, int ih, char* smem) {
    const int tid = TIDX(), lane = tid & 63, wid = tid >> 6, wr = wid >> 1, wc = wid & 1, fr = lane & 15, fq = lane >> 4;
    u16* Qs = (u16*)smem;
    u16* X = Qs + 64 * 136;
    u16* P = X + 128 * 136;
    float* red = (float*)(P + 64 * 136);
    float lgf2, lgb2; ret_gammas(p, layer, h, lgf2, lgb2);
    const u16* base = P_px(p) + (long)c * 128 * INC;
    const u16* Rf = P_R(p) + ((long)(c * 4 + h) * 2 + 0) * 16384;
    const u16* Rb = Rf + 16384;
    const int ch = tid & 15, rw = tid >> 4;
    const int qkcol = ch < 8 ? ch * 8 : (ch - 8) * 8;
    u32x4 pre[8];
    auto load_rows = [&](const u16* src, long stride, int nrow16) {
#pragma unroll
        for (int i = 0; i < 8; ++i) if (i < nrow16) pre[i] = *(const u32x4*)(src + (long)(rw + 16 * i) * stride);
    };
    auto store_rows = [&](u16* dst, int nrow16) {
#pragma unroll
        for (int i = 0; i < 8; ++i) if (i < nrow16) *(u32x4*)(dst + (rw + 16 * i) * 136 + ch * 8) = pre[i];
    };
    f32x4 Y[2][4], T[2][4];
    zero_acc<2>(Y); zero_acc<2>(T);
    __syncthreads();
    load_rows(base + (long)ih * 64 * INC + (ch < 8 ? col_qr(h, 0) : col_qr(h, 1)) + qkcol, INC, 4); store_rows(Qs, 4);
    load_rows(Rf + ch * 8, 128, 8); store_rows(X, 8);
    load_rows(Rb + ch * 8, 128, 8);
    __syncthreads();
    mma_lds64<2>(Y, Qs, 136, X, 136); mma_lds64<2>(Y, Qs + 64, 136, X + 64, 136);
    __syncthreads();
    store_rows(X, 8);
    load_rows(base + (ch < 8 ? col_kr(h, 0) : col_kr(h, 1)) + qkcol, INC, 8);
    __syncthreads();
    mma_lds64<2>(T, Qs, 136, X, 136); mma_lds64<2>(T, Qs + 64, 136, X + 64, 136);
#pragma unroll
    for (int m = 0; m < 2; ++m)
#pragma unroll
        for (int j = 0; j < 4; ++j) {
            int i = ih * 64 + wr * 32 + m * 16 + fq * 4 + j;
            float xf = exp2f((float)(i + 1) * lgf2), xb = exp2f((float)(128 - i) * lgb2);
#pragma unroll
            for (int n = 0; n < 4; ++n) Y[m][n][j] = xf * Y[m][n][j] + xb * T[m][n][j];
        }
    zero_acc<2>(T);
    __syncthreads();
    store_rows(X, 8);
    load_rows(base + C_VR + h * 128 + ch * 8, INC, 8);
    __syncthreads();
    mma_lds64<2>(T, Qs, 136, X, 136); mma_lds64<2>(T, Qs + 64, 136, X + 64, 136);
#pragma unroll
    for (int m = 0; m < 2; ++m)
#pragma unroll
        for (int n = 0; n < 4; ++n)
#pragma unroll
            for (int j = 0; j < 4; ++j) {
                int il = wr * 32 + m * 16 + fq * 4 + j, i = ih * 64 + il, jj = wc * 64 + n * 16 + fr;
                float dm = (i >= jj) ? exp2f((float)(i - jj) * lgf2) : exp2f((float)(jj - i) * lgb2);
                P[il * 136 + jj] = f2bf(T[m][n][j] * dm);
            }
    __syncthreads();
    store_rows(X, 8);
    __syncthreads();
    mma_lds64_btr<2>(Y, P, 136, X, 136); mma_lds64_btr<2>(Y, P + 64, 136, X + 64 * 136, 136);
    float mu[2][4], rs[2][4];
#pragma unroll
    for (int m = 0; m < 2; ++m)
#pragma unroll
        for (int j = 0; j < 4; ++j) {
            float s = Y[m][0][j] + Y[m][1][j] + Y[m][2][j] + Y[m][3][j];
            s += __shfl_xor(s, 1); s += __shfl_xor(s, 2); s += __shfl_xor(s, 4); s += __shfl_xor(s, 8);
            if (fr == 0) red[(wr * 32 + m * 16 + fq * 4 + j) * 2 + wc] = s;
        }
    __syncthreads();
#pragma unroll
    for (int m = 0; m < 2; ++m)
#pragma unroll
        for (int j = 0; j < 4; ++j) { int il = wr * 32 + m * 16 + fq * 4 + j; mu[m][j] = (red[il * 2] + red[il * 2 + 1]) * (1.f / 128.f); }
    __syncthreads();
#pragma unroll
    for (int m = 0; m < 2; ++m)
#pragma unroll
        for (int j = 0; j < 4; ++j) {
            float s = 0.f;
#pragma unroll
            for (int n = 0; n < 4; ++n) { float d = Y[m][n][j] - mu[m][j]; s += d * d; }
            s += __shfl_xor(s, 1); s += __shfl_xor(s, 2); s += __shfl_xor(s, 4); s += __shfl_xor(s, 8);
            if (fr == 0) red[(wr * 32 + m * 16 + fq * 4 + j) * 2 + wc] = s;
        }
    __syncthreads();
#pragma unroll
    for (int m = 0; m < 2; ++m)
#pragma unroll
        for (int j = 0; j < 4; ++j) { int il = wr * 32 + m * 16 + fq * 4 + j; rs[m][j] = rsqrtf((red[il * 2] + red[il * 2 + 1]) * (1.f / 128.f) + 1e-6f); }
    const float* gn = p->ret_gn + layer * 512 + h * 128;
#pragma unroll
    for (int m = 0; m < 2; ++m)
#pragma unroll
        for (int n = 0; n < 4; ++n)
#pragma unroll
            for (int j = 0; j < 4; ++j) {
                int i = ih * 64 + wr * 32 + m * 16 + fq * 4 + j, e = wc * 64 + n * 16 + fr;
                long row = (long)c * 128 + i;
                float g = bf2f(P_px(p)[row * INC + C_GR + h * 128 + e]);
                float o = (Y[m][n][j] - mu[m][j]) * rs[m][j] * gn[e] * siluf_(g);
                P_ya(p)[row * 512 + h * 128 + e] = f2bf(o);
            }
    __syncthreads();
}

DI void phF_tile(KP p, int mt, int nt, int b, int ks, char* smem) {
    const int tid = TIDX(), lane = tid & 63, wid = tid >> 6, wr = wid >> 1, wc = wid & 1, fr = lane & 15, fq = lane >> 4;
    const int r0 = tid >> 2, ko = (tid & 3) * 8 + ks * 64;
    float* macc = P_maccx(p) - (long)NLAT * DM;
    const u16* y = (b == 0 ? P_ya(p) : b == 1 ? P_yb(p) : P_yc(p));
    const u16* w = (b == 0 ? P_wt_ret(p) : b == 1 ? P_wt_win(p) : P_wt_na(p));
    f32x4 acc[4][4]; zero_acc<4>(acc);
    const u16* a0 = y + (long)(mt * 128 + r0) * 512 + ko;
    const u16* b0 = w + (long)(nt * 128 + r0) * 512 + ko;
    gemm_core<2>(acc, a0, a0 + 64 * 512, b0, b0 + 64 * 512, smem);
    int zero = 0; asm volatile("" : "+v"(zero));
#pragma unroll
    for (int m = 0; m < 4; ++m)
#pragma unroll
        for (int n = 0; n < 4; ++n)
#pragma unroll
            for (int j = 0; j < 4; ++j) {
                int row = mt * 128 + wr * 64 + m * 16 + fq * 4 + j + zero, col = nt * 128 + wc * 64 + n * 16 + fr;
                float g = bf2f(P_px(p)[(long)row * INC + C_GATE + b * 1024 + col]);
                unsafeAtomicAdd(macc + (long)row * DM + col, acc[m][n][j] * sigmoidf_(g));
            }
}
DI void phG_tile(KP p, int layer, int mt, int nt, int ks, char* smem) {
    const int tid = TIDX(), lane = tid & 63, wid = tid >> 6, wr = wid >> 1, wc = wid & 1, fr = lane & 15, fq = lane >> 4;
    f32x4 acc[4][4]; zero_acc<4>(acc);
    const int r0 = tid >> 2, ko = (tid & 3) * 8 + ks * 32;
    const float* a0 = P_maccx(p) + (long)((mt - 128) * 128 + r0) * DM + ko;
    const u16* b0 = P_wt_out(p) + (long)(nt * 128 + r0) * DM + ko;
    gemm_core_af32<1>(acc, a0, a0 + 64 * DM, b0, b0 + 64 * DM, smem);
    const float* md = P_mod(p) + (layer * 2 + 1) * 6144 + 2 * 1024;
    int zero = 0; asm volatile("" : "+v"(zero));
#pragma unroll
    for (int m = 0; m < 4; ++m)
#pragma unroll
        for (int n = 0; n < 4; ++n)
#pragma unroll
            for (int j = 0; j < 4; ++j) {
                int row = mt * 128 + wr * 64 + m * 16 + fq * 4 + j + zero, col = nt * 128 + wc * 64 + n * 16 + fr;
                unsafeAtomicAdd(P_ctxres(p) + (long)(row - NLAT) * DM + col, md[col] * acc[m][n][j]);
            }
}


#define LAS __attribute__((address_space(3)))
namespace g8 {
constexpr int BM = 256, BK = 64, HALF = 128, HTB = HALF * BK * 2, STAGE_BYTES = 8 * HTB;
DI int lds_byte(int r, int c) { const int st = (r >> 4) * 2 + (c >> 5), rr = r & 15, cc = c & 31, ob = rr * 64 + cc * 2; return st * 1024 + (ob ^ (((ob >> 9) & 1) << 5)); }
DI void stage_rc(int b, int& R, int& C) { const int st = b / 1024, sb = b % 1024, swz = sb ^ (((sb >> 9) & 1) << 5); R = (st >> 1) * 16 + swz / 64; C = (st & 1) * 32 + (swz % 64) / 2; }
DI int perm32(int rho) { const int n = rho >> 4, i = rho & 15; return 8 * (i >> 2) + 4 * n + (i & 3); }
struct Unit { int pm, pn, aux; };
typedef f32x4 Acc[2][2][4][2];

template <class P>
DI void gemm_phase(LAS unsigned char* lds, const P& prob) {
    const int tid = TID512(), wid = __builtin_amdgcn_readfirstlane(tid >> 6), lane = tid & 63, wr = wid >> 2, wc = wid & 3, fr = lane & 15, fq = lane >> 4;
    constexpr int K = P::K, nt = K / BK;
    int Rr[2], Cc[2];
    unsigned voffA[2], voffB[2];
#pragma unroll
    for (int i = 0; i < 2; ++i) { stage_rc(tid * 16 + i * 8192, Rr[i], Cc[i]); const int Rb = P::PERM ? ((Rr[i] & ~31) + perm32(Rr[i] & 31)) : Rr[i];
        voffA[i] = (unsigned)(Rr[i] * K + Cc[i]) * 2u; voffB[i] = (unsigned)(Rb * K + Cc[i]) * 2u; }
    constexpr size_t kstep = (size_t)(BK * 2);
    constexpr size_t hstep = (size_t)HALF * K * 2;
    const unsigned ldsw = (unsigned)wid * 1024u;
    const int aoff = lds_byte(wr * 64 + fr, fq * 8), boff = lds_byte(wc * 32 + fr, fq * 8);
    unsigned vaC[2][2], vaN[2][2];
#define G8_SA(b, h) (((b) * 2 + (h)) * HTB)
#define G8_SB(b, h) ((4 + (b) * 2 + (h)) * HTB)
#define G8_STAGEA(bufoff, base, VA, h, kt) do { _Pragma("unroll") for (int _i = 0; _i < 2; ++_i) \
        __builtin_amdgcn_global_load_lds((const unsigned*)((base) + (P::GATHER ? (size_t)(VA)[h][_i] : (size_t)voffA[_i] + (size_t)(h) * hstep) + (size_t)(kt) * kstep), (LAS unsigned*)(lds + (bufoff) + ldsw + _i * 8192), 16, 0, 0); } while (0)
#define G8_STAGEB(bufoff, base, h, kt) do { _Pragma("unroll") for (int _i = 0; _i < 2; ++_i) \
        __builtin_amdgcn_global_load_lds((const unsigned*)((base) + (size_t)(h) * hstep + voffB[_i] + (size_t)(kt) * kstep), (LAS unsigned*)(lds + (bufoff) + ldsw + _i * 8192), 16, 0, 0); } while (0)
#define G8_LDA(dst, b, h) do { _Pragma("unroll") for (int m = 0; m < 4; ++m) _Pragma("unroll") for (int k = 0; k < 2; ++k) dst[m][k] = *(const LAS bf16x8*)(lds + G8_SA(b, h) + aoff + m * 2048 + k * 1024); } while (0)
#define G8_LDB(dst, b, h) do { _Pragma("unroll") for (int n = 0; n < 2; ++n) _Pragma("unroll") for (int k = 0; k < 2; ++k) dst[n][k] = *(const LAS bf16x8*)(lds + G8_SB(b, h) + boff + n * 2048 + k * 1024); } while (0)
#define G8_MMA(ai, bj, At, Bt) do { __builtin_amdgcn_s_setprio(1); _Pragma("unroll") for (int m = 0; m < 4; ++m) _Pragma("unroll") for (int n = 0; n < 2; ++n) _Pragma("unroll") for (int k = 0; k < 2; ++k) \
        acc[ai][bj][m][n] = __builtin_amdgcn_mfma_f32_16x16x32_bf16(Bt[n][k], At[m][k], acc[ai][bj][m][n], 0, 0, 0); __builtin_amdgcn_s_setprio(0); } while (0)
#define G8_WAIT_V(n) asm volatile("s_waitcnt vmcnt(" #n ")" ::: "memory")
#define G8_WAIT_L(n) asm volatile("s_waitcnt lgkmcnt(" #n ")" ::: "memory")
#define G8_BAR __builtin_amdgcn_s_barrier()
#define G8_SCHED __builtin_amdgcn_sched_barrier(0)
    Unit cur, nxt; int ui = 0;
    __syncthreads();
    if (!prob.next(0, cur)) return;
    if (P::GATHER) prob.gather(cur, Rr, Cc, vaC);
    const char* cA = prob.a_base(cur); const char* cB = prob.b_base(cur);
    Acc acc;
#pragma unroll
    for (int a = 0; a < 2; ++a)
#pragma unroll
        for (int b = 0; b < 2; ++b)
#pragma unroll
            for (int m = 0; m < 4; ++m)
#pragma unroll
                for (int n = 0; n < 2; ++n) acc[a][b][m][n] = (f32x4){0.f, 0.f, 0.f, 0.f};
    bf16x8 At[4][2], B0[2][2], B1[2][2];
    G8_STAGEB(G8_SB(0, 0), cB, 0, 0); G8_STAGEA(G8_SA(0, 0), cA, vaC, 0, 0); G8_STAGEB(G8_SB(0, 1), cB, 1, 0); G8_STAGEA(G8_SA(0, 1), cA, vaC, 1, 0);
    if (wr == 1) G8_BAR;
    G8_WAIT_V(4); G8_BAR;
    G8_STAGEB(G8_SB(1, 0), cB, 0, 1); G8_STAGEA(G8_SA(1, 0), cA, vaC, 0, 1); G8_STAGEB(G8_SB(1, 1), cB, 1, 1);
    G8_WAIT_V(6); G8_BAR;
    for (;;) {
        const bool has_next = prob.next(ui + 1, nxt);
        if (!has_next) nxt = cur;
        if (P::GATHER) {
            if (has_next) prob.gather(nxt, Rr, Cc, vaN);
            else {
#pragma unroll
                for (int h = 0; h < 2; ++h) { vaN[h][0] = vaC[h][0]; vaN[h][1] = vaC[h][1]; }
            }
        }
        const char* nA = prob.a_base(nxt); const char* nB = prob.b_base(nxt);
#pragma unroll 1
        for (int t = 0; t < nt; t += 2) {
            const bool last = (t == nt - 2);
            const char* a2 = last ? nA : cA; const char* b2 = last ? nB : cB; const int k2 = last ? 0 : t + 2;
            unsigned va2[2][2];
#pragma unroll
            for (int h = 0; h < 2; ++h) { va2[h][0] = last ? vaN[h][0] : vaC[h][0]; va2[h][1] = last ? vaN[h][1] : vaC[h][1]; }
            G8_LDB(B0, 0, 0); G8_SCHED; G8_LDA(At, 0, 0); G8_STAGEA(G8_SA(1, 1), cA, vaC, 1, t + 1);
            G8_WAIT_L(8); G8_BAR; G8_WAIT_L(0); G8_MMA(0, 0, At, B0); G8_BAR; G8_SCHED;
            G8_LDB(B1, 0, 1); G8_STAGEB(G8_SB(0, 0), b2, 0, k2);
            G8_BAR; G8_WAIT_L(0); G8_MMA(0, 1, At, B1); G8_BAR;
            G8_LDA(At, 0, 1); G8_STAGEA(G8_SA(0, 0), a2, va2, 0, k2);
            G8_BAR; G8_WAIT_L(0); G8_MMA(1, 0, At, B0); G8_BAR; G8_SCHED;
            G8_STAGEB(G8_SB(0, 1), b2, 1, k2);
            G8_WAIT_V(6); G8_BAR; G8_MMA(1, 1, At, B1); G8_BAR;
            G8_LDB(B0, 1, 0); G8_SCHED; G8_LDA(At, 1, 0); G8_STAGEA(G8_SA(0, 1), a2, va2, 1, k2);
            G8_WAIT_L(8); G8_BAR; G8_WAIT_L(0); G8_MMA(0, 0, At, B0); G8_BAR; G8_SCHED;
            G8_LDB(B1, 1, 1); G8_STAGEB(G8_SB(1, 0), b2, 0, k2 + 1);
            G8_BAR; G8_WAIT_L(0); G8_MMA(0, 1, At, B1); G8_BAR;
            G8_LDA(At, 1, 1); G8_STAGEA(G8_SA(1, 0), a2, va2, 0, k2 + 1);
            G8_BAR; G8_WAIT_L(0); G8_MMA(1, 0, At, B0); G8_BAR; G8_SCHED;
            G8_STAGEB(G8_SB(1, 1), b2, 1, k2 + 1);
            G8_WAIT_V(6); G8_BAR; G8_MMA(1, 1, At, B1); G8_BAR;
        }
        { const int l2 = TID512() & 63; prob.epi(acc, cur, wr, wc, l2 & 15, l2 >> 4); }
        if (!has_next) break;
#pragma unroll
        for (int a = 0; a < 2; ++a)
#pragma unroll
            for (int b = 0; b < 2; ++b)
#pragma unroll
                for (int m = 0; m < 4; ++m)
#pragma unroll
                    for (int n = 0; n < 2; ++n) acc[a][b][m][n] = (f32x4){0.f, 0.f, 0.f, 0.f};
        cur = nxt; cA = nA; cB = nB; ++ui;
        if (P::GATHER) {
#pragma unroll
            for (int h = 0; h < 2; ++h) { vaC[h][0] = vaN[h][0]; vaC[h][1] = vaN[h][1]; }
        }
    }
    G8_WAIT_V(0);
    if (wr == 0) G8_BAR;
    G8_BAR;
#undef G8_SA
#undef G8_SB
#undef G8_STAGEA
#undef G8_STAGEB
#undef G8_LDA
#undef G8_LDB
#undef G8_MMA
#undef G8_WAIT_V
#undef G8_WAIT_L
#undef G8_BAR
#undef G8_SCHED
}
}

struct ProbG {
    static constexpr int K = 1024; static constexpr bool PERM = false, GATHER = false;
    KP p; int layer;
    DI bool next(int i, g8::Unit& u) const {
        const int id = i * (int)gridDim.x + BIDX();
        if (id >= 256) return false;
        if (gridDim.x == 256) { const int x = id & 7, y = id >> 3; u.pm = x * 8 + (y >> 2); u.pn = y & 3; } else { u.pm = id >> 2; u.pn = id & 3; }
        u.aux = 0;
        return true;
    }
    DI const char* a_base(const g8::Unit& u) const { return (const char*)(P_hx(p) + (long)u.pm * 256 * DM); }
    DI const char* b_base(const g8::Unit& u) const { return (const char*)(P_wt_out(p) + (long)u.pn * 256 * DM); }
    DI void gather(const g8::Unit&, const int (&)[2], const int (&)[2], unsigned (&)[2][2]) const {}
    DI void epi(g8::Acc& acc, const g8::Unit& u, int wr, int wc, int fr, int fq) const {
        const float* xin = layer == 0 ? p->x : p->out;
        const float* md = P_mod(p) + (layer * 2) * 6144 + 2 * 1024;
#pragma unroll
        for (int bj = 0; bj < 2; ++bj)
#pragma unroll
            for (int n = 0; n < 2; ++n) {
                const int col = u.pn * 256 + bj * 128 + wc * 32 + n * 16 + fq * 4;
                const f32x4 mv = *(const f32x4*)(md + col);
#pragma unroll
                for (int ai = 0; ai < 2; ++ai)
#pragma unroll
                    for (int m = 0; m < 4; ++m) {
                        const long row = (long)u.pm * 256 + ai * 128 + wr * 64 + m * 16 + fr;
                        const f32x4 xv = *(const f32x4*)(xin + row * DM + col);
                        *(f32x4*)(p->out + row * DM + col) = xv + mv * acc[ai][bj][m][n];
                    }
            }
    }
};


constexpr int B_SPARE = 20;
constexpr int CONV_INB = 2560;
struct ProbB {
    static constexpr int K = 1024; static constexpr bool PERM = true, GATHER = false;
    KP p;
    DI bool next(int i, g8::Unit& u) const {
        constexpr int nM = 65, nN = 29, nwg = nM * nN, NX = 8, WGM = 8;
        const int nwork = (int)gridDim.x - B_SPARE;
        if (BIDX() >= nwork) return false;
        const long L = (long)i * nwork + BIDX(); if (L >= nwg) return false;
        int wgid = (int)L; { const int q = nwg / NX, r = nwg % NX, xcd = wgid % NX, off = wgid / NX; wgid = (xcd < r ? xcd * (q + 1) : r * (q + 1) + (xcd - r) * q) + off; }
        const int nig = WGM * nN, gid = wgid / nig, fm = gid * WGM, gsz = (nM - fm) < WGM ? (nM - fm) : WGM;
        u.pm = fm + ((wgid % nig) % gsz); u.pn = (wgid % nig) / gsz; u.aux = 0; return true;
    }
    DI const char* a_base(const g8::Unit& u) const { return (const char*)(P_hx(p) + (long)u.pm * 256 * DM); }
    DI const char* b_base(const g8::Unit& u) const { return (const char*)(P_wt_in(p) + (long)u.pn * 256 * DM); }
    DI void gather(const g8::Unit&, const int (&)[2], const int (&)[2], unsigned (&)[2][2]) const {}
    DI void epi(g8::Acc& acc, const g8::Unit& u, int wr, int wc, int fr, int fq) const {
        const int pn = u.pn;
        const bool lat = u.pm < 64;
        const int rk = !lat ? 0 : (pn < 4) ? 1 : (pn == 8 || pn == 9 || (pn == 10 && wc < 2)) ? 2 : 0;
        const float mul = (pn == 2 || pn == 3) ? 0.08838834764831845f : (pn == 8 || pn == 9 || pn == 11 || pn == 12) ? 0.125f * 1.4426950408889634f : 1.f;
#pragma unroll
        for (int ai = 0; ai < 2; ++ai)
#pragma unroll
            for (int m = 0; m < 4; ++m) {
                const int row = u.pm * 256 + ai * 128 + wr * 64 + m * 16 + fr;
                if (rk != 0) {
                    const float2* tab;
                    if (rk == 1) tab = P_rope128(p) + ((wc & 1) ? (row & 63) : (row >> 6)) * 32 + fq * 8;
                    else tab = P_rope64(p) + ((fq >= 2) ? (row & 63) : (row >> 6)) * 16 + (fq & 1) * 8;
#pragma unroll
                    for (int n = 0; n < 2; ++n) {
                        const f32x4 c01 = *(const f32x4*)(tab + n * 4), c23 = *(const f32x4*)(tab + n * 4 + 2);
                        const float cs_[4] = {c01[0], c01[2], c23[0], c23[2]}, sn_[4] = {c01[1], c01[3], c23[1], c23[3]};
#pragma unroll
                        for (int e = 0; e < 4; ++e) {
                            const float x1 = acc[ai][0][m][n][e], x2 = acc[ai][1][m][n][e];
                            acc[ai][0][m][n][e] = x1 * cs_[e] - x2 * sn_[e];
                            acc[ai][1][m][n][e] = x1 * sn_[e] + x2 * cs_[e];
                        }
                    }
                }
                u16* orow = P_px(p) + (long)row * INC + pn * 256 + wc * 32 + fq * 8;
#pragma unroll
                for (int bj = 0; bj < 2; ++bj) {
                    u32x4 o;
#pragma unroll
                    for (int n = 0; n < 2; ++n)
#pragma unroll
                        for (int e = 0; e < 2; ++e) o[2 * n + e] = pack2(acc[ai][bj][m][n][2 * e] * mul, acc[ai][bj][m][n][2 * e + 1] * mul);
                    *(u32x4*)(orow + bj * 128) = o;
                }
            }
    }
};
struct ProbF {
    static constexpr int K = 512; static constexpr bool PERM = true, GATHER = false;
    KP p;
    DI bool next(int i, g8::Unit& u) const {
        const int tile = (i / 3) * (int)gridDim.x + BIDX();
        if (tile >= 256) return false;
        if (gridDim.x == 256) { const int x = tile & 7, y = tile >> 3; u.pm = x * 8 + (y >> 2); u.pn = y & 3; } else { u.pm = tile >> 2; u.pn = tile & 3; }
        u.aux = i % 3;
        return true;
    }
    DI const char* a_base(const g8::Unit& u) const { const u16* y = u.aux == 0 ? P_ya(p) : u.aux == 1 ? P_yb(p) : P_yc(p); return (const char*)(y + (long)u.pm * 256 * 512); }
    DI const char* b_base(const g8::Unit& u) const { const u16* w = u.aux == 0 ? P_wt_ret(p) : u.aux == 1 ? P_wt_win(p) : P_wt_na(p); return (const char*)(w + (long)u.pn * 256 * 512); }
    DI void gather(const g8::Unit&, const int (&)[2], const int (&)[2], unsigned (&)[2][2]) const {}
    DI void epi(g8::Acc& acc, const g8::Unit& u, int wr, int wc, int fr, int fq) const {
        const int b = u.aux;
        const long row0 = (long)u.pm * 256 + wr * 64 + fr;
        const int col0 = u.pn * 256 + wc * 32 + fq * 8;
        if (b != 2) {
            u16* z = P_z(p) + (long)b * NLAT * DM;
#pragma unroll
            for (int ai = 0; ai < 2; ++ai)
#pragma unroll
                for (int m = 0; m < 4; ++m)
#pragma unroll
                    for (int bj = 0; bj < 2; ++bj) {
                        u32x4 o;
#pragma unroll
                        for (int n = 0; n < 2; ++n)
#pragma unroll
                            for (int e = 0; e < 2; ++e) o[2 * n + e] = pack2(acc[ai][bj][m][n][2 * e], acc[ai][bj][m][n][2 * e + 1]);
                        *(u32x4*)(z + (row0 + ai * 128 + m * 16) * DM + col0 + bj * 128) = o;
                    }
            return;
        }
        const u16* zb = P_z(p);
        const u16* gp = P_px(p) + C_GATE;
#pragma unroll
        for (int ai = 0; ai < 2; ++ai)
#pragma unroll
            for (int m = 0; m < 4; ++m)
#pragma unroll
                for (int bj = 0; bj < 2; ++bj) {
                    const long row = row0 + ai * 128 + m * 16; const int col = col0 + bj * 128;
                    u32x4 zv[2], gv[3];
#pragma unroll
                    for (int q = 0; q < 2; ++q) zv[q] = *(const u32x4*)(zb + ((long)q * NLAT + row) * DM + col);
#pragma unroll
                    for (int q = 0; q < 3; ++q) gv[q] = *(const u32x4*)(gp + row * INC + q * 1024 + col);
                    u32x4 o;
#pragma unroll
                    for (int e = 0; e < 4; ++e) {
                        const int n = e >> 1, e2 = (e & 1) * 2;
                        float lo = acc[ai][bj][m][n][e2] * sigmoidf_(bflo(gv[2][e])), hi = acc[ai][bj][m][n][e2 + 1] * sigmoidf_(bfhi(gv[2][e]));
#pragma unroll
                        for (int q = 0; q < 2; ++q) { lo += bflo(zv[q][e]) * sigmoidf_(bflo(gv[q][e])); hi += bfhi(zv[q][e]) * sigmoidf_(bfhi(gv[q][e])); }
                        o[e] = pack2(lo, hi);
                    }
                    *(u32x4*)(P_hx(p) + row * DM + col) = o;
                }
    }
};
struct ProbJ {
    static constexpr int K = 1024; static constexpr bool PERM = true, GATHER = true;
    KP p;
    DI bool next(int i, g8::Unit& u) const {
        const int id = i * (int)gridDim.x + BIDX();
        if (id >= 1024) return false;
        if (gridDim.x == 256) {
            const int x = BIDX() & 7, y = BIDX() >> 3;
            u.aux = 4 * i + (x >> 1); u.pm = (x & 1) * 4 + (y >> 3); u.pn = y & 7;
        } else { u.aux = id >> 6; u.pm = (id >> 3) & 7; u.pn = id & 7; }
        return true;
    }
    DI const char* a_base(const g8::Unit&) const { return (const char*)P_hx(p); }
    DI const char* b_base(const g8::Unit& u) const { return (const char*)(P_wt_gu(p) + ((long)u.aux * 2048 + u.pn * 256) * DM); }
    DI void gather(const g8::Unit& u, const int (&R)[2], const int (&C)[2], unsigned (&va)[2][2]) const {
        const int* si = P_sel_idx(p) + u.aux * 2048 + u.pm * 256;
#pragma unroll
        for (int h = 0; h < 2; ++h)
#pragma unroll
            for (int j = 0; j < 2; ++j) va[h][j] = (unsigned)(si[h * 128 + R[j]] * DM + C[j]) * 2u;
    }
    DI void epi(g8::Acc& acc, const g8::Unit& u, int wr, int wc, int fr, int fq) const {
        u16* hb = P_hid(p) + (long)u.aux * 2048 * EH;
#pragma unroll
        for (int ai = 0; ai < 2; ++ai)
#pragma unroll
            for (int m = 0; m < 4; ++m) {
                const int slot = u.pm * 256 + ai * 128 + wr * 64 + m * 16 + fr;
                const int f = u.pn * 128 + wc * 32 + fq * 8;
                u32x4 o;
#pragma unroll
                for (int n = 0; n < 2; ++n)
#pragma unroll
                    for (int e = 0; e < 2; ++e)
                        o[2 * n + e] = pack2(siluf_(acc[ai][0][m][n][2 * e]) * acc[ai][1][m][n][2 * e], siluf_(acc[ai][0][m][n][2 * e + 1]) * acc[ai][1][m][n][2 * e + 1]);
                *(u32x4*)(hb + (long)slot * EH + f) = o;
            }
    }
};
struct ProbK {
    static constexpr int K = 1024; static constexpr bool PERM = true, GATHER = false;
    KP p; int layer;
    DI bool next(int i, g8::Unit& u) const {
        const int id = i * (int)gridDim.x + BIDX();
        if (id >= 512) return false;
        if (gridDim.x == 256) { const int x = BIDX() & 7, y = BIDX() >> 3; u.aux = 8 * i + x; u.pm = y >> 2; u.pn = y & 3; }
        else { u.aux = id >> 5; u.pm = (id >> 2) & 7; u.pn = id & 3; }
        return true;
    }
    DI const char* a_base(const g8::Unit& u) const { return (const char*)(P_hid(p) + ((long)u.aux * 2048 + u.pm * 256) * EH); }
    DI const char* b_base(const g8::Unit& u) const { return (const char*)(P_wt_dn(p) + ((long)u.aux * 1024 + u.pn * 256) * EH); }
    DI void gather(const g8::Unit&, const int (&)[2], const int (&)[2], unsigned (&)[2][2]) const {}
    DI void epi(g8::Acc& acc, const g8::Unit& u, int wr, int wc, int fr, int fq) const {
        const float* md = P_mod(p) + (layer * 2) * 6144 + 5 * 1024;
        f32x4 mv[2][2];
#pragma unroll
        for (int bj = 0; bj < 2; ++bj)
#pragma unroll
            for (int n = 0; n < 2; ++n) mv[bj][n] = *(const f32x4*)(md + u.pn * 256 + bj * 128 + wc * 32 + fq * 8 + n * 4);
#pragma unroll
        for (int ai = 0; ai < 2; ++ai)
#pragma unroll
            for (int m = 0; m < 4; ++m) {
                const int slot = u.aux * 2048 + u.pm * 256 + ai * 128 + wr * 64 + m * 16 + fr;
                const float g = P_sel_gate(p)[slot];
                u16* yr = P_ye(p) + (long)slot * DM + u.pn * 256 + wc * 32 + fq * 8;
#pragma unroll
                for (int bj = 0; bj < 2; ++bj) {
                    u32x4 o;
#pragma unroll
                    for (int n = 0; n < 2; ++n)
#pragma unroll
                        for (int e = 0; e < 2; ++e)
                            o[2 * n + e] = pack2(acc[ai][bj][m][n][2 * e] * g * mv[bj][n][2 * e], acc[ai][bj][m][n][2 * e + 1] * g * mv[bj][n][2 * e + 1]);
                    *(u32x4*)(yr + bj * 128) = o;
                }
            }
    }
};

DI void phH_item(KP p, int layer, int item, char* smem) {
    const int lane = TIDX() & 63, wid = TIDX() >> 6;
    float* hrow = (float*)smem + wid * 4096;
    const int row0 = item * 16 + wid * 4;
    norm_rows4(p, layer, row0, p->g_ffn + layer * DM, 3, 4, false, false, hrow);
    const int e = lane & 15, kp = lane >> 4;
    const float* wr_ = p->w_router + (long)layer * 1024 * 16 + e;
    float lg[4] = {0.f, 0.f, 0.f, 0.f};
#pragma unroll 8
    for (int k = kp * 256; k < kp * 256 + 256; ++k) {
        float w = wr_[k * 16];
#pragma unroll
        for (int r = 0; r < 4; ++r) lg[r] += hrow[r * 1024 + k] * w;
    }
#pragma unroll
    for (int r = 0; r < 4; ++r) {
        float l = lg[r];
        l += __shfl_xor(l, 16); l += __shfl_xor(l, 32);
        float mx = l;
        mx = fmaxf(mx, __shfl_xor(mx, 1)); mx = fmaxf(mx, __shfl_xor(mx, 2)); mx = fmaxf(mx, __shfl_xor(mx, 4)); mx = fmaxf(mx, __shfl_xor(mx, 8));
        float ex = expf(l - mx);
        float sm = ex;
        sm += __shfl_xor(sm, 1); sm += __shfl_xor(sm, 2); sm += __shfl_xor(sm, 4); sm += __shfl_xor(sm, 8);
        float a = ex / sm;
        int row = row0 + r;
        if (lane < 16) {
            if (row < NLAT) P_aff(p)[(long)e * NLAT + row] = a;
            else P_aff(p)[(long)(16 + e) * NLAT + (row - NLAT)] = a;
        }
    }
    __syncthreads();
}

DI int block_excl_scan(int v, int* sh  , int& total) {
    const int lane = TIDX() & 63, wid = TIDX() >> 6;
    int inc = v;
    for (int o = 1; o < 64; o <<= 1) { int t = __shfl_up(inc, o); if (lane >= o) inc += t; }
    __syncthreads();
    if (lane == 63) sh[wid] = inc;
    __syncthreads();
    int base = 0;
    for (int w = 0; w < wid; ++w) base += sh[w];
    total = sh[0] + sh[1] + sh[2] + sh[3];
    return base + inc - v;
}
DI void phI_item(KP p, int job, char* smem) {
    const int tid = TIDX(), lane = tid & 63, wid = tid >> 6;
    const bool lat = job < 16;
    const int n = lat ? NLAT : NCTX, cap = lat ? CAP_LAT : CAP_CTX, rowbase = lat ? 0 : NLAT;
    int* sh = (int*)smem;
    const float* a = P_aff(p) + (long)job * NLAT;
    unsigned keys[64];
    if (lat) {
#pragma unroll
        for (int i = 0; i < 16; ++i) { u32x4 v = *(const u32x4*)(a + tid * 64 + i * 4); keys[4 * i] = v[0]; keys[4 * i + 1] = v[1]; keys[4 * i + 2] = v[2]; keys[4 * i + 3] = v[3]; }
    } else {
#pragma unroll
        for (int i = 0; i < 64; ++i) keys[i] = 0u;
        keys[0] = __float_as_uint(a[tid]);
    }
    __syncthreads();
    auto block_sum = [&](int v, int it) -> int {
        for (int o = 32; o > 0; o >>= 1) v += __shfl_xor(v, o);
        int* slot = sh + (it & 1) * 4;
        if (lane == 0) slot[wid] = v;
        __syncthreads();
        return slot[0] + slot[1] + slot[2] + slot[3];
    };
    int* hist = sh + 32;
    unsigned T = 0u, pmask = 0u; int remaining = cap;
#pragma unroll 1
    for (int pass = 0; pass < 3; ++pass) {
        const int shift = pass == 0 ? 19 : pass == 1 ? 8 : 0, nb_ = pass == 2 ? 256 : 2048;
        for (int i = tid; i < 2048; i += 256) hist[i] = 0;
        __syncthreads();
#pragma unroll
        for (int i = 0; i < 64; ++i) { const unsigned k = keys[i]; if (k != 0u && (k & pmask) == T) atomicAdd(&hist[(k >> shift) & (nb_ - 1)], 1); }
        __syncthreads();
        int mine = 0;
        const int top = nb_ - 1 - 8 * tid;
        if (top >= 7) {
#pragma unroll
            for (int q = 0; q < 8; ++q) mine += hist[top - q];
        }
        int tot_;
        const int above = block_excl_scan(mine, sh + 8, tot_);
        if (top >= 7 && above < remaining && above + mine >= remaining) {
            int cum = above, q = 0;
            for (; q < 7; ++q) { const int hv = hist[top - q]; if (cum + hv >= remaining) break; cum += hv; }
            sh[16] = top - q; sh[17] = remaining - cum;
        }
        __syncthreads();
        T |= ((unsigned)sh[16]) << shift; pmask |= ((unsigned)(nb_ - 1)) << shift; remaining = sh[17];
        __syncthreads();
    }
    int ceq = 0;
#pragma unroll
    for (int i = 0; i < 64; ++i) ceq += (keys[i] == T);
    const int it = 0; (void)it; (void)block_sum;
    __syncthreads();
    int tot;
    int er = block_excl_scan(ceq, sh + 8, tot);
    int csel = 0;
    { int e2 = er;
#pragma unroll
      for (int i = 0; i < 64; ++i) { const unsigned k = keys[i]; if (k > T) ++csel; else if (k == T) { if (e2 < remaining) ++csel; ++e2; } } }
    int slot = block_excl_scan(csel, sh + 8, tot);
    int* ts = P_tslot(p) + (long)job * NLAT;
    const int per = lat ? 64 : 1;
    const int base = tid * per;
#pragma unroll
    for (int i = 0; i < 64; ++i) {
        if (i < per) {
            const unsigned k = keys[i];
            bool sel = false;
            if (k > T) sel = true; else if (k == T) { sel = er < remaining; ++er; }
            if (sel) { P_sel_idx(p)[job * 2048 + slot] = rowbase + base + i; P_sel_gate(p)[job * 2048 + slot] = __uint_as_float(k); ts[base + i] = slot; ++slot; }
            else ts[base + i] = -1;
        }
    }
    __syncthreads();
}

DI void phJ_tile(KP p, int job, int mt, int nt, char* smem) {
    const int tid = TIDX(), lane = tid & 63, wid = tid >> 6, wr = wid >> 1, wc = wid & 1, fr = lane & 15, fq = lane >> 4;
    const int cap = job < 16 ? CAP_LAT : CAP_CTX, e = job & 15;
    f32x4 acc[4][4]; zero_acc<4>(acc);
    const int r0 = tid >> 2, ko = (tid & 3) * 8;
    int s0 = mt * 128 + r0, s1 = s0 + 64;
    s0 = s0 < cap ? s0 : cap - 1; s1 = s1 < cap ? s1 : cap - 1;
    const u16* a0 = P_hx(p) + (long)P_sel_idx(p)[job * 2048 + s0] * DM + ko;
    const u16* a1 = P_hx(p) + (long)P_sel_idx(p)[job * 2048 + s1] * DM + ko;
    const int f_lo = nt * 64 + (r0 & 31), f_hi = f_lo + 32, gu = (r0 >> 5) & 1;
    const u16* b0 = P_wt_gu(p) + ((long)e * 2048 + (f_lo >> 7) * 256 + gu * 128 + (f_lo & 127)) * DM + ko;
    const u16* b1 = P_wt_gu(p) + ((long)e * 2048 + (f_hi >> 7) * 256 + gu * 128 + (f_hi & 127)) * DM + ko;
    gemm_core<32>(acc, a0, a1, b0, b1, smem);
    u16* hb = job < 16 ? P_hid(p) + (long)job * 2048 * EH : P_hidc(p) + (long)(job - 16) * 32 * EH;
#pragma unroll
    for (int m = 0; m < 4; ++m)
#pragma unroll
        for (int n = 0; n < 2; ++n)
#pragma unroll
            for (int j = 0; j < 4; ++j) {
                int slot = mt * 128 + wr * 64 + m * 16 + fq * 4 + j;
                int f = nt * 64 + wc * 32 + n * 16 + fr;
                if (slot < cap) hb[(long)slot * EH + f] = f2bf(siluf_(acc[m][n][j]) * acc[m][n + 2][j]);
            }
}
DI void phK_tile(KP p, int layer, int job, int mt, int nt, char* smem) {
    const int tid = TIDX(), lane = tid & 63, wid = tid >> 6, wr = wid >> 1, wc = wid & 1, fr = lane & 15, fq = lane >> 4;
    const int cap = job < 16 ? CAP_LAT : CAP_CTX, e = job & 15;
    f32x4 acc[4][4]; zero_acc<4>(acc);
    const int r0 = tid >> 2, ko = (tid & 3) * 8;
    int s0 = mt * 128 + r0, s1 = s0 + 64;
    s0 = s0 < cap ? s0 : cap - 1; s1 = s1 < cap ? s1 : cap - 1;
    const u16* hb = job < 16 ? P_hid(p) + (long)job * 2048 * EH : P_hidc(p) + (long)(job - 16) * 32 * EH;
    const u16* a0 = hb + (long)s0 * EH + ko;
    const u16* a1 = hb + (long)s1 * EH + ko;
    const u16* b0 = P_wt_dn(p) + ((long)e * 1024 + nt * 128 + r0) * EH + ko;
    gemm_core<32>(acc, a0, a1, b0, b0 + 64 * EH, smem);
    const float* md = P_mod(p) + (layer * 2 + (job < 16 ? 0 : 1)) * 6144 + 5 * 1024;
    u16* yb_ = job < 16 ? P_ye(p) + (long)job * 2048 * DM : P_yec(p) + (long)(job - 16) * 32 * DM;
#pragma unroll
    for (int m = 0; m < 4; ++m)
#pragma unroll
        for (int j = 0; j < 4; ++j) {
            int slot = mt * 128 + wr * 64 + m * 16 + fq * 4 + j;
            if (slot < cap) {
                float g = P_sel_gate(p)[job * 2048 + slot];
#pragma unroll
                for (int n = 0; n < 4; ++n) {
                    int col = nt * 128 + wc * 64 + n * 16 + fr;
                    yb_[(long)slot * DM + col] = f2bf(acc[m][n][j] * g * md[col]);
                }
            }
        }
}


#define XB_TMO      128
#define XB_XCNT(j)  (256  + 64 * (j))
#define XB_XSUB(j)  (1280 + 64 * (j))
#define XB_XGEN(j)  (2304 + 64 * (j))
#define XB_TOP      3328
#define XB_TOPGEN   3392
#define XCD_BAR_WORDS 3456
#define XB_SPIN_CAP (1u << 18)
DI unsigned xb_ld(unsigned* p)              { return __hip_atomic_load(p, __ATOMIC_RELAXED, __HIP_MEMORY_SCOPE_AGENT); }
DI unsigned xb_add(unsigned* p, unsigned v) { return __hip_atomic_fetch_add(p, v, __ATOMIC_RELAXED, __HIP_MEMORY_SCOPE_AGENT); }
DI unsigned xb_xcc_id() { return (unsigned)__builtin_amdgcn_s_getreg((3 << 11) | 20) & 0xFu; }
#define XB_SPIN(cond, bar) do { unsigned _sp = 0; while (cond) { __builtin_amdgcn_s_sleep(1); \
    if ((++_sp & 255u) == 0u) { if (xb_ld(&(bar)[XB_TMO])) break; if (_sp > XB_SPIN_CAP) { atomicAdd(&(bar)[XB_TMO], 1u); break; } } } } while (0)
struct XcdBarrier { unsigned* bar; unsigned x; volatile LAS unsigned* st; };
DI XcdBarrier xcd_barrier_post(unsigned* bar, volatile LAS unsigned* st) {
    XcdBarrier b; b.bar = bar; b.x = xb_xcc_id(); b.st = st;
    if (threadIdx.x == 0) (void)xb_add(&bar[XB_XCNT(b.x)], 1u);
    return b;
}
DI void xcd_barrier_complete(unsigned* bar, unsigned x, unsigned& nloc, unsigned& nx) {
    const unsigned G = gridDim.x * gridDim.y * gridDim.z;
    unsigned sum, cnt, mine, sp = 0u;
    for (;;) {
        sum = 0u; cnt = 0u; mine = 0u;
#pragma unroll
        for (unsigned j = 0; j < 16; ++j) { const unsigned c = xb_ld(&bar[XB_XCNT(j)]); sum += c; cnt += (c > 0u) ? 1u : 0u; mine = (j == x) ? c : mine; }
        if (sum == G) break;
        __builtin_amdgcn_s_sleep(1);
        if ((++sp & 255u) == 0u) { if (xb_ld(&bar[XB_TMO])) break; if (sp > XB_SPIN_CAP) { atomicAdd(&bar[XB_TMO], 1u); break; } }
    }
    nloc = mine > 0u ? mine : 1u; nx = cnt > 0u ? cnt : 1u;
}
DI void xcd_barrier(const XcdBarrier& b) {
    asm volatile("s_waitcnt vmcnt(0)" ::: "memory");
    __syncthreads();
    if (threadIdx.x == 0) {
        unsigned* bar = b.bar;
        __builtin_amdgcn_s_waitcnt(0);
        unsigned nloc = b.st[0], nx = b.st[1];
        if (nloc == 0u) { xcd_barrier_complete(bar, b.x, nloc, nx); b.st[0] = nloc; b.st[1] = nx; }
        const unsigned old = xb_add(&bar[XB_XSUB(b.x)], 1u);
        const unsigned gen = old / nloc;
        if (old + 1u == (gen + 1u) * nloc) {
            __builtin_amdgcn_fence(__ATOMIC_RELEASE, "agent");
            asm volatile("s_waitcnt vmcnt(0)" ::: "memory");
            const unsigned og = xb_add(&bar[XB_TOP], 1u);
            const unsigned tg = og / nx;
            if (og + 1u == (tg + 1u) * nx) xb_add(&bar[XB_TOPGEN], 1u);
            else XB_SPIN(xb_ld(&bar[XB_TOPGEN]) == tg, bar);
            __builtin_amdgcn_fence(__ATOMIC_ACQUIRE, "agent");
            xb_add(&bar[XB_XGEN(b.x)], 1u);
            asm volatile("s_waitcnt vmcnt(0)" ::: "memory");
        } else {
            XB_SPIN(xb_ld(&bar[XB_XGEN(b.x)]) == gen, bar);
            __builtin_amdgcn_fence(__ATOMIC_ACQUIRE, "agent");
            asm volatile("s_waitcnt vmcnt(0)" ::: "memory");
        }
    }
    __syncthreads();
}

DI void run_phase(int ph, char* smem_all, int variant = 0) {
    KP p = (KP)__builtin_amdgcn_kernarg_segment_ptr();
    asm volatile("" : "+s"(p));
    const int sb = TID512() >> 8;
    char* smem = smem_all + sb * SUB_LDS;
    const int bid = BIDX() * 2 + sb, nb = gridDim.x * 2, tid = TIDX(), wid = tid >> 6;
#ifndef ONLY_SUB
    if (ph == 0) {
        for (int it = bid; it < 240; it += nb) {
            if (it < 192) ph0_gemv_item(p, it, smem);
            else ph0_rope_item(p, it - 192);
        }
        convert_tiles(p, 0, bid, CONV_DENSE, nb, smem);
        return;
    }
    if (ph == NPHASE - 1) {
        for (int it = bid; it < NLAT / 16; it += nb) {
            const int row0 = it * 16 + wid * 4, lane = tid & 63;
            float4 v[4][4];
#pragma unroll
            for (int r = 0; r < 4; ++r)
#pragma unroll
                for (int i = 0; i < 4; ++i) v[r][i] = *(const float4*)(p->out + (long)(row0 + r) * DM + i * 256 + lane * 4);
            float4 g[4];
#pragma unroll
            for (int i = 0; i < 4; ++i) g[i] = *(const float4*)(p->g_final + i * 256 + lane * 4);
#pragma unroll
            for (int r = 0; r < 4; ++r) {
                moe_combine(p, row0 + r, v[r]);
                float ss = 0.f;
#pragma unroll
                for (int i = 0; i < 4; ++i) ss += v[r][i].x * v[r][i].x + v[r][i].y * v[r][i].y + v[r][i].z * v[r][i].z + v[r][i].w * v[r][i].w;
                ss = wave_sum(ss);
                const float rstd = rsqrtf(ss * (1.f / DM) + 1e-6f);
                float* xr = p->out + (long)(row0 + r) * DM;
#pragma unroll
                for (int i = 0; i < 4; ++i)
                    *(float4*)(xr + i * 256 + lane * 4) = make_float4(v[r][i].x * rstd * g[i].x, v[r][i].y * rstd * g[i].y, v[r][i].z * rstd * g[i].z, v[r][i].w * rstd * g[i].w);
            }
        }
        return;
    }
    const int layer = (ph - 1) / 11, sub = (ph - 1) % 11;
#else
    const int layer = (ph - 1) / 11, sub = ONLY_SUB;
#endif
    const bool need_ctx = layer == 0;
    switch (sub) {
    case 0: {
        const int nrow_items = NROWS / 16;
        for (int it = bid; it < nrow_items; it += nb) norm_rows4(p, layer, it * 16 + wid * 4, p->g_mix + layer * DM, 0, 1, layer == 0, layer == 1);
        if (layer == 1) convert_tiles(p, layer, bid, CONV_DENSE, nb, smem);
    } break;
    case 1: {
        { ProbB pb{p}; g8::gemm_phase((LAS unsigned char*)smem_all, pb); }
        const int nwork = (int)gridDim.x - B_SPARE;
        if (BIDX() >= nwork) {
            const int sb2 = TID512() >> 8, q = (BIDX() - nwork) * 2 + sb2;
            convert_tiles4(p, layer, CONV_DENSE + q, CONV_DENSE + CONV_INB, 2 * B_SPARE, smem_all + sb2 * SUB_LDS);
        }
    } break;
    case 2: {
        const int n_state = NCHUNK * 8, n_win = 1024, n_na = 1024, n_cx = need_ctx ? 32 : 0;
        const int total = n_state + n_win + n_na + n_cx;
        for (int it = bid; it < total; it += nb) {
            if (variant == 1 && it >= n_na && it < n_na + n_win) continue;
            if (variant == 1 && it >= n_na + n_win) continue;
            if (variant == 2 && (it < n_na || it >= n_na + n_win)) continue;
            if (variant == 3 && (it < n_na + n_win || it >= n_na + n_win + n_state)) continue;
            if (it < n_na) attn_block_item(p, layer, 1, it >> 3, it & 7, smem);
            else if (it < n_na + n_win) { int i2 = it - n_na; attn_block_item(p, layer, 0, i2 >> 1, i2 & 1, smem); }
            else if (it < n_win + n_na + n_state) { int i2 = it - n_win - n_na; phC_state_item(p, layer, i2 >> 3, (i2 >> 1) & 3, i2 & 1, smem); }
            else { int i2 = it - n_win - n_na - n_state; if (i2 < 16) attn_block_item(p, layer, 2, i2 >> 1, i2 & 1, smem); else { i2 -= 16; attn_block_item(p, layer, 3, i2 >> 3, i2 & 7, smem); } }
        }
    } break;
    case 3: {
        for (int it = bid; it < 512; it += nb) phD_item(p, layer, it);
    } break;
    case 4: {
        const int nch = need_ctx ? NCHUNK : 128;
        for (int it = bid; it < nch * 8; it += nb) phE_item(p, layer, it >> 3, (it >> 1) & 3, it & 1, smem);
        if (need_ctx && bid >= nb - 64) {
            float* z = P_maccx(p) + (long)(bid - (nb - 64)) * 4096 + tid * 16;
#pragma unroll
            for (int i = 0; i < 4; ++i) *(f32x4*)(z + i * 4) = f32x4{0.f, 0.f, 0.f, 0.f};
        }
    } break;
    case 5: {
        { ProbF pf{p}; g8::gemm_phase((LAS unsigned char*)smem_all, pf); }
        if (need_ctx) {
            const int sb2 = TID512() >> 8;
            for (int it = BIDX() * 2 + sb2; it < 384; it += (int)gridDim.x * 2) { const int tb = it >> 3, tile = tb / 3; phF_tile(p, 128 + (tile >> 3), tile & 7, tb % 3, it & 7, smem_all + sb2 * SUB_LDS); }
        }
    } break;
    case 6: {
        { ProbG pg{p, layer}; g8::gemm_phase((LAS unsigned char*)smem_all, pg); }
        if (need_ctx) {
            const int sb2 = TID512() >> 8;
            for (int it = BIDX() * 2 + sb2; it < 512; it += (int)gridDim.x * 2) { const int tile = it >> 5; phG_tile(p, layer, 128 + (tile >> 3), tile & 7, it & 31, smem_all + sb2 * SUB_LDS); }
        }
    } break;
    case 7: {
        const int nit = (need_ctx ? NROWS : NLAT) / 16;
        for (int it = bid; it < nit; it += nb) phH_item(p, layer, it, smem);
    } break;
    case 8: {
        const int njob = need_ctx ? 32 : 16;
        for (int it = bid; it < njob; it += nb) phI_item(p, it, smem);
        convert_tiles(p, layer, CONV_DENSE + CONV_INB + bid, CONV_TILES, nb, smem);
    } break;
    case 9: {
        { ProbJ pj{p}; g8::gemm_phase((LAS unsigned char*)smem_all, pj); }
        if (need_ctx) {
            const int sb2 = TID512() >> 8;
            for (int it = BIDX() * 2 + sb2; it < 256; it += (int)gridDim.x * 2) phJ_tile(p, 16 + (it >> 4), 0, it & 15, smem_all + sb2 * SUB_LDS);
        }
    } break;
    case 10: {
        { ProbK pk{p, layer}; g8::gemm_phase((LAS unsigned char*)smem_all, pk); }
        if (need_ctx) {
            const int sb2 = TID512() >> 8;
            for (int it = BIDX() * 2 + sb2; it < 128; it += (int)gridDim.x * 2) phK_tile(p, layer, 16 + (it >> 3), 0, it & 7, smem_all + sb2 * SUB_LDS);
        }
    } break;
    }
}

__global__ void __launch_bounds__(NTHREADS, 2) mega_kernel(Params p, int ph_lo, int ph_hi) {
    __shared__ __attribute__((aligned(16))) char smem[LDS_BYTES + 16];
    cg::grid_group grid = cg::this_grid();
#if MK_MULTI
    for (int ph = ph_lo; ph < ph_hi; ++ph) {
        if (ph > ph_lo) grid.sync();
        run_phase(ph, smem);
    }
#else
    unsigned* barw = (unsigned*)(p.ws + WS_BAR);
    volatile LAS unsigned* xst = (volatile LAS unsigned*)(LAS char*)(smem + LDS_BYTES);
    if (threadIdx.x < 4) xst[threadIdx.x] = 0u;
    if (blockIdx.x == 0) for (int i = threadIdx.x; i < XCD_BAR_WORDS; i += NTHREADS) barw[i] = 0u;
    run_phase(0, smem);
    grid.sync();
    const XcdBarrier xb = xcd_barrier_post(barw, xst);
#ifdef PROBE_SUB
#define PH(n) do { if ((n) > 1) xcd_barrier(xb); run_phase((n), smem); if ((n) >= PROBE_MIN && (n) <= PROBE_MAX && (((n) - 1) % 11) == PROBE_SUB) { xcd_barrier(xb); run_phase((n), smem, PROBE_VARIANT); } } while (0)
#else
#define PH(n) do { if ((n) > 1) xcd_barrier(xb); run_phase((n), smem); } while (0)
#endif
    PH(1); PH(2); PH(3); PH(4); PH(5); PH(6); PH(7); PH(8); PH(9); PH(10); PH(11);
    PH(12); PH(13); PH(14); PH(15); PH(16); PH(17); PH(18); PH(19); PH(20); PH(21); PH(22); PH(23);
    static_assert(NPHASE == 24, "phase program");
#undef PH
#endif
}

extern "C" void kernel_launch(void* const* d_in, const int* in_sizes, int n_in, void* d_out, int out_size, void* d_ws, size_t ws_size,
                              hipStream_t stream) {
    static int grid_blocks = 0;
    if (!grid_blocks) {
        int dev = 0, cus = 0, per_cu = 0;
        hipGetDevice(&dev);
        hipDeviceGetAttribute(&cus, hipDeviceAttributeMultiprocessorCount, dev);
        hipOccupancyMaxActiveBlocksPerMultiprocessor(&per_cu, mega_kernel, NTHREADS, 0);
        if (per_cu < 1) per_cu = 1;
        if (per_cu > 1) per_cu = 1;
        grid_blocks = cus * per_cu;
    }
    Params p{};
    const float** ip = (const float**)&p.x;
    for (int i = 0; i < 22; ++i) ip[i] = (const float*)d_in[i];
    p.out = (float*)d_out;
    p.ws = (char*)d_ws;
    if (WS_END > ws_size) { fprintf(stderr, "kernel_launch: workspace too small: need %zu have %zu\n", (size_t)WS_END, ws_size); return; }
#if MK_MULTI
    for (int ph = 0; ph < NPHASE; ++ph) {
        hipLaunchKernelGGL(mega_kernel, dim3(grid_blocks), dim3(NTHREADS), 0, stream, p, ph, ph + 1);
    }
#else
    int lo = 0, hi = NPHASE;
    void* args[] = {&p, &lo, &hi};
    hipError_t e = hipLaunchCooperativeKernel((void*)mega_kernel, dim3(grid_blocks), dim3(NTHREADS), args, 0, stream);
    if (e != hipSuccess) fprintf(stderr, "cooperative launch failed: %s (grid %d)\n", hipGetErrorString(e), grid_blocks);
#endif
}
```

```cpp
#include <hip/hip_runtime.h>
#include <hip/hip_bf16.h>
#include <hip/hip_cooperative_groups.h>
#include <cstdio>
#include <cstdint>
namespace cg = cooperative_groups;

#ifndef MK_MULTI
#define MK_MULTI 0
#endif

#define DI __device__ __forceinline__
typedef unsigned short u16;
typedef __attribute__((ext_vector_type(8))) short bf16x8;
typedef __attribute__((ext_vector_type(4))) float f32x4;
typedef __attribute__((ext_vector_type(4))) unsigned int u32x4;

constexpr int NLAT = 16384, NCTX = 256, NROWS = NLAT + NCTX, DM = 1024, INC = 7424;
constexpr int C_QR = 0, C_KR = 512, C_VR = 1024, C_GR = 1536, C_QW = 2048, C_KW = 2560, C_VW = 2688, C_QN = 2816, C_KN = 3328, C_VN = 3840, C_GATE = 4352;
__host__ __device__ constexpr int col_qr(int h, int x) { return C_QR + (h >> 1) * 256 + x * 128 + (h & 1) * 64; }
__host__ __device__ constexpr int col_kr(int h, int x) { return C_KR + (h >> 1) * 256 + x * 128 + (h & 1) * 64; }
__host__ __device__ constexpr int col_qw(int h, int x) { return C_QW + (h >> 2) * 256 + x * 128 + (h & 3) * 32; }
__host__ __device__ constexpr int col_kw(int kh, int x) { return C_KW + x * 128 + kh * 32; }
__host__ __device__ constexpr int col_vw(int kh) { return C_KW + 64 + kh * 128; }
constexpr int NCHUNK = NROWS / 128;
constexpr int NEXP = 16, EH = 1024, CAP_LAT = 2048, CAP_CTX = 32;
constexpr int NTHREADS = 512;
constexpr int SUB_LDS = 76 * 1024;
constexpr int LDS_BYTES = 2 * SUB_LDS;
constexpr int NPHASE = 24;


constexpr size_t al256(size_t b) { return (b + 255) & ~(size_t)255; }
constexpr size_t WS_CTXRES = 0;
constexpr size_t WS_MOD = WS_CTXRES + al256((size_t)NCTX * DM * 4);
constexpr size_t WS_ROPE128 = WS_MOD + al256(2 * 2 * 6144 * 4);
constexpr size_t WS_ROPE64 = WS_ROPE128 + al256(256 * 32 * 8);
constexpr size_t WS_WT_IN = WS_ROPE64 + al256(256 * 16 * 8);
constexpr size_t WS_WT_RET = WS_WT_IN + al256((size_t)INC * DM * 2);
constexpr size_t WS_WT_WIN = WS_WT_RET + al256((size_t)1024 * 512 * 2);
constexpr size_t WS_WT_NA = WS_WT_WIN + al256((size_t)1024 * 512 * 2);
constexpr size_t WS_WT_OUT = WS_WT_NA + al256((size_t)1024 * 512 * 2);
constexpr size_t WS_WT_GU = WS_WT_OUT + al256((size_t)1024 * 1024 * 2);
constexpr size_t WS_WT_DN = WS_WT_GU + al256((size_t)NEXP * 2048 * 1024 * 2);
constexpr size_t WS_HX = WS_WT_DN + al256((size_t)NEXP * 1024 * 1024 * 2);
constexpr size_t WS_PX = WS_HX + al256((size_t)NROWS * DM * 2);
constexpr size_t WS_YA = WS_PX + al256((size_t)NROWS * INC * 2);
constexpr size_t WS_YB = WS_YA + al256((size_t)NROWS * 512 * 2);
constexpr size_t WS_YC = WS_YB + al256((size_t)NROWS * 512 * 2);
constexpr size_t WS_S = WS_YC + al256((size_t)NROWS * 512 * 2);
constexpr size_t WS_R = WS_S + al256((size_t)NCHUNK * 8 * 16384 * 4);
constexpr size_t WS_AFF = WS_R + al256((size_t)NCHUNK * 8 * 16384 * 2);
constexpr size_t WS_SELI = WS_AFF + al256((size_t)32 * NLAT * 4);
constexpr size_t WS_SELG = WS_SELI + al256(32 * 2048 * 4);
constexpr size_t WS_TSLOT = WS_SELG + al256(32 * 2048 * 4);
constexpr size_t WS_BAR = WS_TSLOT + al256((size_t)32 * NLAT * 4);
constexpr size_t WS_MACCX = WS_BAR + al256(3456 * 4);
constexpr size_t WS_END = WS_MACCX + al256((size_t)NCTX * DM * 4);
struct Params {
    const float *x, *c, *ctx, *c_ctx, *w_mod, *b_mod, *g_mix, *g_ffn, *w_in, *decay, *ret_gn, *w_ret, *sink, *w_win, *rpb, *w_na, *w_out,
        *w_router, *w_eg, *w_eu, *w_ed, *g_final;
    float* out;
    char* ws;
};
typedef const Params __attribute__((address_space(4)))* KP;
#define WSF(name, type, off) __device__ __forceinline__ type* P_##name(KP p) { return (type*)(p->ws + (off)); }
WSF(ctxres, float, WS_CTXRES)
WSF(mod, float, WS_MOD)
WSF(rope128, float2, WS_ROPE128)
WSF(rope64, float2, WS_ROPE64)
WSF(wt_in, u16, WS_WT_IN) WSF(wt_ret, u16, WS_WT_RET) WSF(wt_win, u16, WS_WT_WIN) WSF(wt_na, u16, WS_WT_NA) WSF(wt_out, u16, WS_WT_OUT)
WSF(wt_gu, u16, WS_WT_GU) WSF(wt_dn, u16, WS_WT_DN)
WSF(hx, u16, WS_HX)
WSF(px, u16, WS_PX)
WSF(ya, u16, WS_YA) WSF(yb, u16, WS_YB) WSF(yc, u16, WS_YC)
WSF(S, float, WS_S)
WSF(R, u16, WS_R)
WSF(aff, float, WS_AFF)
WSF(sel_idx, int, WS_SELI) WSF(sel_gate, float, WS_SELG)
WSF(hid, u16, WS_PX)
__device__ __forceinline__ u16* P_hidc(KP p) { return (u16*)(p->ws + WS_PX) + (size_t)NEXP * 2048 * 1024; }
__device__ __forceinline__ u16* P_ye(KP p) { return (u16*)(p->ws + WS_PX) + (size_t)NEXP * (2048 + 32) * 1024; }
__device__ __forceinline__ u16* P_yec(KP p) { return P_ye(p) + (size_t)NEXP * 2048 * 1024; }
__device__ __forceinline__ int* P_tslot(KP p) { return (int*)(p->ws + WS_TSLOT); }
__device__ __forceinline__ u16* P_z(KP p) { return (u16*)(p->ws + WS_S); }
__device__ __forceinline__ float* P_maccx(KP p) { return (float*)(p->ws + WS_MACCX); }
#undef WSF


DI int TIDX() { int t = threadIdx.x & 255; asm volatile("" : "+v"(t)); return t; }
DI int TID512() { int t = threadIdx.x; asm volatile("" : "+v"(t)); return t; }
DI int BIDX() { int t = blockIdx.x; asm volatile("" : "+s"(t)); return t; }
DI u16 f2bf(float x) { unsigned u = __float_as_uint(x); u += 0x7fffu + ((u >> 16) & 1u); return (u16)(u >> 16); }
DI float bf2f(u16 h) { return __uint_as_float(((unsigned)h) << 16); }
DI float bflo(unsigned w) { return __uint_as_float(w << 16); }
DI float bfhi(unsigned w) { return __uint_as_float(w & 0xffff0000u); }
typedef __bf16 bf16v2 __attribute__((ext_vector_type(2)));
typedef float f32v2 __attribute__((ext_vector_type(2)));
DI unsigned pack2(float a, float b) { f32v2 v = {a, b}; bf16v2 r = __builtin_convertvector(v, bf16v2); return __builtin_bit_cast(unsigned, r); }
DI float sigmoidf_(float x) { return 1.f / (1.f + __expf(-x)); }
DI float siluf_(float x) { return x / (1.f + __expf(-x)); }
DI float wave_sum(float v) { for (int o = 32; o > 0; o >>= 1) v += __shfl_xor(v, o); return v; }
#define MFMA16(a, b, c) __builtin_amdgcn_mfma_f32_16x16x32_bf16((a), (b), (c), 0, 0, 0)

template <int MR>
DI void zero_acc(f32x4 (&acc)[MR][4]) {
#pragma unroll
    for (int m = 0; m < MR; ++m)
#pragma unroll
        for (int n = 0; n < 4; ++n) acc[m][n] = f32x4{0.f, 0.f, 0.f, 0.f};
}

template <int KT>
DI void gemm_core(f32x4 (&acc)[4][4], const u16* a0, const u16* a1, const u16* b0, const u16* b1, char* smem) {
    const int tid = TIDX(), lane = tid & 63, wid = tid >> 6, wr = wid >> 1, wc = wid & 1, fr = lane & 15, fq = lane >> 4;
    auto stage = [&](int kt, int buf) {
        char* base = smem + buf * 16384;
        __builtin_amdgcn_global_load_lds((const unsigned*)(a0 + kt * 32), (unsigned*)(base + tid * 16), 16, 0, 0);
        __builtin_amdgcn_global_load_lds((const unsigned*)(a1 + kt * 32), (unsigned*)(base + 4096 + tid * 16), 16, 0, 0);
        __builtin_amdgcn_global_load_lds((const unsigned*)(b0 + kt * 32), (unsigned*)(base + 8192 + tid * 16), 16, 0, 0);
        __builtin_amdgcn_global_load_lds((const unsigned*)(b1 + kt * 32), (unsigned*)(base + 12288 + tid * 16), 16, 0, 0);
    };
    __syncthreads();
    stage(0, 0);
#pragma unroll 1
    for (int kt = 0; kt < KT; ++kt) {
        asm volatile("s_waitcnt vmcnt(0)" ::: "memory");
        __syncthreads();
        if (kt + 1 < KT) stage(kt + 1, (kt + 1) & 1);
        const char* SA = smem + (kt & 1) * 16384;
        const char* SB = SA + 8192;
        bf16x8 At[4], Bt[4];
#pragma unroll
        for (int m = 0; m < 4; ++m) At[m] = *(const bf16x8*)(SA + (wr * 64 + m * 16 + fr) * 64 + fq * 16);
#pragma unroll
        for (int n = 0; n < 4; ++n) Bt[n] = *(const bf16x8*)(SB + (wc * 64 + n * 16 + fr) * 64 + fq * 16);
#pragma unroll
        for (int m = 0; m < 4; ++m)
#pragma unroll
            for (int n = 0; n < 4; ++n) acc[m][n] = MFMA16(At[m], Bt[n], acc[m][n]);
    }
}

template <int KT>
DI void gemm_core_af32(f32x4 (&acc)[4][4], const float* a0f, const float* a1f, const u16* b0, const u16* b1, char* smem) {
    const int tid = TIDX(), lane = tid & 63, wid = tid >> 6, wr = wid >> 1, wc = wid & 1, fr = lane & 15, fq = lane >> 4;
    f32x4 ar[4];
    auto loadA = [&](int kt) { ar[0] = *(const f32x4*)(a0f + kt * 32); ar[1] = *(const f32x4*)(a0f + kt * 32 + 4); ar[2] = *(const f32x4*)(a1f + kt * 32); ar[3] = *(const f32x4*)(a1f + kt * 32 + 4); };
    auto storeA = [&](int buf) {
        char* base = smem + buf * 16384;
        u32x4 w0, w1;
        w0[0] = pack2(ar[0][0], ar[0][1]); w0[1] = pack2(ar[0][2], ar[0][3]); w0[2] = pack2(ar[1][0], ar[1][1]); w0[3] = pack2(ar[1][2], ar[1][3]);
        w1[0] = pack2(ar[2][0], ar[2][1]); w1[1] = pack2(ar[2][2], ar[2][3]); w1[2] = pack2(ar[3][0], ar[3][1]); w1[3] = pack2(ar[3][2], ar[3][3]);
        *(u32x4*)(base + tid * 16) = w0; *(u32x4*)(base + 4096 + tid * 16) = w1;
    };
    auto stageB = [&](int kt, int buf) {
        char* base = smem + buf * 16384;
        __builtin_amdgcn_global_load_lds((const unsigned*)(b0 + kt * 32), (unsigned*)(base + 8192 + tid * 16), 16, 0, 0);
        __builtin_amdgcn_global_load_lds((const unsigned*)(b1 + kt * 32), (unsigned*)(base + 12288 + tid * 16), 16, 0, 0);
    };
    __syncthreads();
    loadA(0); stageB(0, 0); storeA(0);
#pragma unroll 1
    for (int kt = 0; kt < KT; ++kt) {
        asm volatile("s_waitcnt vmcnt(0)" ::: "memory");
        __syncthreads();
        if (kt + 1 < KT) { loadA(kt + 1); stageB(kt + 1, (kt + 1) & 1); }
        const char* SA = smem + (kt & 1) * 16384;
        const char* SB = SA + 8192;
        bf16x8 At[4], Bt[4];
#pragma unroll
        for (int m = 0; m < 4; ++m) At[m] = *(const bf16x8*)(SA + (wr * 64 + m * 16 + fr) * 64 + fq * 16);
#pragma unroll
        for (int n = 0; n < 4; ++n) Bt[n] = *(const bf16x8*)(SB + (wc * 64 + n * 16 + fr) * 64 + fq * 16);
#pragma unroll
        for (int m = 0; m < 4; ++m)
#pragma unroll
            for (int n = 0; n < 4; ++n) acc[m][n] = MFMA16(At[m], Bt[n], acc[m][n]);
        if (kt + 1 < KT) storeA((kt + 1) & 1);
    }
}

template <int MR>
DI void mma_lds64(f32x4 (&acc)[MR][4], const u16* As, int lda, const u16* Bs, int ldb) {
    const int tid = TIDX(), lane = tid & 63, wid = tid >> 6, wr = wid >> 1, wc = wid & 1, fr = lane & 15, fq = lane >> 4;
#pragma unroll
    for (int kk = 0; kk < 2; ++kk) {
        bf16x8 At[MR], Bt[4];
#pragma unroll
        for (int m = 0; m < MR; ++m) At[m] = *(const bf16x8*)(As + (wr * (MR * 16) + m * 16 + fr) * lda + kk * 32 + fq * 8);
#pragma unroll
        for (int n = 0; n < 4; ++n) Bt[n] = *(const bf16x8*)(Bs + (wc * 64 + n * 16 + fr) * ldb + kk * 32 + fq * 8);
#pragma unroll
        for (int m = 0; m < MR; ++m)
#pragma unroll
            for (int n = 0; n < 4; ++n) acc[m][n] = MFMA16(At[m], Bt[n], acc[m][n]);
    }
}
typedef short v4s_ __attribute__((ext_vector_type(4)));
typedef __attribute__((address_space(3))) v4s_* lds_v4s_ptr_;
DI bf16x8 frag_tr(const u16* M, int ld, int k0, int c0) {
    const int lane = TIDX() & 63, i = lane & 15, g = lane >> 4;
    const u16* a = M + (k0 + 8 * g + (i >> 2)) * ld + c0 + 4 * (i & 3);
    v4s_ lo = __builtin_amdgcn_ds_read_tr16_b64_v4i16((lds_v4s_ptr_)a);
    v4s_ hi = __builtin_amdgcn_ds_read_tr16_b64_v4i16((lds_v4s_ptr_)(a + 4 * ld));
    return __builtin_shufflevector(lo, hi, 0, 1, 2, 3, 4, 5, 6, 7);
}
template <int MR>
DI void mma_lds64_btr(f32x4 (&acc)[MR][4], const u16* As, int lda, const u16* Bm, int ldb) {
    const int tid = TIDX(), lane = tid & 63, wid = tid >> 6, wr = wid >> 1, wc = wid & 1, fr = lane & 15, fq = lane >> 4;
#pragma unroll
    for (int kk = 0; kk < 2; ++kk) {
        bf16x8 At[MR], Bt[4];
#pragma unroll
        for (int m = 0; m < MR; ++m) At[m] = *(const bf16x8*)(As + (wr * (MR * 16) + m * 16 + fr) * lda + kk * 32 + fq * 8);
#pragma unroll
        for (int n = 0; n < 4; ++n) Bt[n] = frag_tr(Bm, ldb, kk * 32, wc * 64 + n * 16);
#pragma unroll
        for (int m = 0; m < MR; ++m)
#pragma unroll
            for (int n = 0; n < 4; ++n) acc[m][n] = MFMA16(At[m], Bt[n], acc[m][n]);
    }
}
template <int MR>
DI void mma_lds64_tt(f32x4 (&acc)[MR][4], const u16* Am, int lda, const u16* Bm, int ldb) {
    const int tid = TIDX(), wid = tid >> 6, wr = wid >> 1, wc = wid & 1;
#pragma unroll
    for (int kk = 0; kk < 2; ++kk) {
        bf16x8 At[MR], Bt[4];
#pragma unroll
        for (int m = 0; m < MR; ++m) At[m] = frag_tr(Am, lda, kk * 32, wr * (MR * 16) + m * 16);
#pragma unroll
        for (int n = 0; n < 4; ++n) Bt[n] = frag_tr(Bm, ldb, kk * 32, wc * 64 + n * 16);
#pragma unroll
        for (int m = 0; m < MR; ++m)
#pragma unroll
            for (int n = 0; n < 4; ++n) acc[m][n] = MFMA16(At[m], Bt[n], acc[m][n]);
    }
}
template <bool SCALE, int NCH>
DI void stage_rows64(u16* dst, int ld, const u16* src0, const u16* src1, long sstride, float z0  , float zstep_unused) {
    const int tid = TIDX();
#pragma unroll
    for (int i = 0; i < NCH / 4; ++i) {
        const int idx = i * 256 + tid, row = idx / NCH, ch = idx % NCH;
        u32x4 v = *(const u32x4*)((ch < 8 ? src0 + ch * 8 : src1 + (ch - 8) * 8) + (long)row * sstride);
        *(u32x4*)(dst + row * ld + ch * 8) = v;
    }
}
template <int ROWS>
DI void stage_n64(u16* dst, int ld, const u16* src, long sstride) {
    const int tid = TIDX();
#pragma unroll
    for (int i = 0; i < ROWS / 32; ++i) {
        int idx = i * 256 + tid, row = idx >> 3, ch = idx & 7;
        u32x4 v = *(const u32x4*)(src + (long)row * sstride + ch * 8);
        *(u32x4*)(dst + row * ld + ch * 8) = v;
    }
}
template <bool SCALE, int NF>
DI void stage_t64(u16* dst, int ld, const u16* src, long sstride, float scale_tok_lane  ) {
    const int tid = TIDX();
#pragma unroll
    for (int i = 0; i < NF / 32; ++i) {
        int idx = i * 256 + tid, jj = idx & 63, ch = idx >> 6;
        u32x4 v = *(const u32x4*)(src + (long)jj * sstride + ch * 8);
#pragma unroll
        for (int e = 0; e < 4; ++e) {
            float lo = bflo(v[e]), hi = bfhi(v[e]);
            if (SCALE) { lo *= scale_tok_lane; hi *= scale_tok_lane; }
            dst[(ch * 8 + 2 * e) * ld + jj] = SCALE ? f2bf(lo) : (u16)(v[e] & 0xffffu);
            dst[(ch * 8 + 2 * e + 1) * ld + jj] = SCALE ? f2bf(hi) : (u16)(v[e] >> 16);
        }
    }
}

DI void convert_tile(KP p, int layer, int tile, char* smem);

DI void ph0_gemv_item(KP p, int item, char* smem) {
    const int tid = TIDX();
    const int l = item / 96, cg_ = item % 96;
    float* sl = (float*)smem;
    float* red = (float*)(smem + 8192);
    __syncthreads();
    for (int k = tid; k < 1024; k += 256) { sl[k] = siluf_(p->c[k]); sl[1024 + k] = siluf_(p->c_ctx[k]); }
    __syncthreads();
    const int c4 = tid & 15, kp = tid >> 4;
    const int col = cg_ * 64 + c4 * 4;
    const float* w = p->w_mod + (long)l * 1024 * 6144 + col;
    float a0[4] = {0, 0, 0, 0}, a1[4] = {0, 0, 0, 0};
#pragma unroll 8
    for (int kk = 0; kk < 64; ++kk) {
        int k = kp * 64 + kk;
        float4 wv = *(const float4*)(w + (long)k * 6144);
        float s0 = sl[k], s1 = sl[1024 + k];
        a0[0] += s0 * wv.x; a0[1] += s0 * wv.y; a0[2] += s0 * wv.z; a0[3] += s0 * wv.w;
        a1[0] += s1 * wv.x; a1[1] += s1 * wv.y; a1[2] += s1 * wv.z; a1[3] += s1 * wv.w;
    }
#pragma unroll
    for (int j = 0; j < 4; ++j) { red[(kp * 2 + 0) * 64 + c4 * 4 + j] = a0[j]; red[(kp * 2 + 1) * 64 + c4 * 4 + j] = a1[j]; }
    __syncthreads();
    if (tid < 128) {
        int src = tid >> 6, cr = tid & 63;
        float s = 0.f;
        for (int q = 0; q < 16; ++q) s += red[(q * 2 + src) * 64 + cr];
        int n = cg_ * 64 + cr;
        P_mod(p)[(l * 2 + src) * 6144 + n] = s + p->b_mod[l * 6144 + n];
    }
}
DI void sincos_d(double a, float& c, float& s) {
    const double TWO_PI = 6.283185307179586476925286766559;
    double k = rint(a / TWO_PI);
    double r = a - k * TWO_PI;
    double r2 = r * r;
    double ts = r, tc = 1.0, ss = r, cc = 1.0;
    for (int i = 1; i <= 14; ++i) {
        tc = -tc * r2 / (double)((2 * i - 1) * (2 * i));
        ts = -ts * r2 / (double)((2 * i) * (2 * i + 1));
        cc += tc; ss += ts;
    }
    c = (float)cc; s = (float)ss;
}
DI void ph0_rope_item(KP p, int item) {
    int idx = item * 256 + TIDX();
    const double LN_BASE = 9.210340371976184;
    if (idx < 8192) {
        int pos = idx >> 5, f = idx & 31;
        float inv = (float)exp(-(double)f / 32.0 * LN_BASE);
        float ang = (float)pos * inv;
        float c, s; sincos_d((double)ang, c, s);
        P_rope128(p)[idx] = make_float2(c, s);
    } else {
        int i2 = idx - 8192;
        int pos = i2 >> 4, f = i2 & 15;
        float inv = (float)exp(-(double)f / 16.0 * LN_BASE);
        float ang = (float)pos * inv;
        float c, s; sincos_d((double)ang, c, s);
        P_rope64(p)[i2] = make_float2(c, s);
    }
}

constexpr int CONV_TILES = 928 + 192 + 128 + 6144;
constexpr int CONV_DENSE = 928 + 192 + 128;
struct ConvTile { const float* sp; u16* dp; int N, K, mode, n0; };
DI ConvTile conv_setup(KP p, int layer, int tile) {
    const float* src; u16* dst; int K, N, mode = 0;
    if (tile < 928) { src = p->w_in + (long)layer * 1024 * INC; dst = P_wt_in(p); K = 1024; N = INC; mode = 1; }
    else if (tile < 928 + 192) {
        int t = tile - 928, which = t / 64; tile = t % 64; K = 512; N = 1024;
        src = (which == 0 ? p->w_ret : which == 1 ? p->w_win : p->w_na) + (long)layer * 512 * 1024;
        dst = (which == 0 ? P_wt_ret(p) : which == 1 ? P_wt_win(p) : P_wt_na(p));
    } else if (tile < 928 + 192 + 128) { tile -= 928 + 192; src = p->w_out + (long)layer * 1024 * 1024; dst = P_wt_out(p); K = 1024; N = 1024; }
    else {
        int t = tile - (928 + 192 + 128), which = t / 2048, e = (t % 2048) / 128; tile = t % 128; K = 1024; N = 1024;
        long eo = ((long)layer * NEXP + e) * 1024 * 1024;
        if (which == 0) { src = p->w_eg + eo; dst = P_wt_gu(p) + (long)e * 2048 * 1024; mode = 2; }
        else if (which == 1) { src = p->w_eu + eo; dst = P_wt_gu(p) + (long)e * 2048 * 1024; mode = 3; }
        else { src = p->w_ed + eo; dst = P_wt_dn(p) + (long)e * 1024 * 1024; }
    }
    const int ntn = N / 64;
    const int k0 = (tile / ntn) * 128, n0 = (tile % ntn) * 64;
    ConvTile c; c.sp = src + (long)k0 * N + n0; c.dp = dst + k0; c.N = N; c.K = K; c.mode = mode; c.n0 = n0;
    return c;
}
DI int conv_drow(int mode, int n) {
    if (mode == 1) {
        if (n < 1024) { int hh_ = (n & 511) >> 7, o_ = n & 127; return (n < 512 ? col_qr(hh_, o_ >> 6) : col_kr(hh_, o_ >> 6)) + (o_ & 63); }
        if (n >= C_QW && n < C_KW) { int m_ = n - C_QW; return col_qw(m_ >> 6, (m_ & 63) >> 5) + (m_ & 31); }
        if (n >= C_KW && n < C_VW) { int m_ = n - C_KW; return col_kw(m_ >> 6, (m_ & 63) >> 5) + (m_ & 31); }
        if (n >= C_VW && n < C_QN) { int m_ = n - C_VW; return col_vw(m_ >> 6) + (m_ & 63); }
        return n;
    }
    if (mode == 2) return (n >> 7) * 256 + (n & 127);
    if (mode == 3) return (n >> 7) * 256 + 128 + (n & 127);
    return n;
}
DI void convert_tiles(KP p, int layer, int first, int last, int step, char* smem) {
    const int tid = TIDX(), lane = tid & 63, w = tid >> 6;
    unsigned* T = (unsigned*)smem;
    float v[32];
    ConvTile c;
    if (first < last) {
        c = conv_setup(p, layer, first);
        const float* sp = c.sp + (long)(w * 32) * c.N + lane;
#pragma unroll
        for (int j = 0; j < 32; ++j) v[j] = sp[(long)j * c.N];
    }
    for (int t = first; t < last; t += step) {
        __syncthreads();
#pragma unroll
        for (int e = 0; e < 16; ++e) T[lane * 66 + w * 16 + e] = pack2(v[2 * e], v[2 * e + 1]);
        const ConvTile cur = c;
        if (t + step < last) {
            c = conv_setup(p, layer, t + step);
            const float* sp = c.sp + (long)(w * 32) * c.N + lane;
#pragma unroll
            for (int j = 0; j < 32; ++j) v[j] = sp[(long)j * c.N];
        }
        __syncthreads();
#pragma unroll
        for (int i = 0; i < 4; ++i) {
            const int idx = i * 256 + tid, nn = idx >> 4, ch = idx & 15;
            const u32x4 o = *(const u32x4*)(T + nn * 66 + ch * 4);
            *(u32x4*)(cur.dp + (long)conv_drow(cur.mode, cur.n0 + nn) * cur.K + ch * 8) = o;
        }
    }
}

DI void convert_tiles4(KP p, int layer, int first, int last, int step, char* smem) {
    const int tid = TIDX(), lane = tid & 63, w = tid >> 6;
    unsigned* T = (unsigned*)smem;
    for (int t = first; t < last; t += 4 * step) {
        float v[4][32];
        ConvTile c[4];
#pragma unroll
        for (int q = 0; q < 4; ++q) {
            const int tq = t + q * step;
            c[q] = conv_setup(p, layer, tq < last ? tq : first);
            if (tq < last) {
                const float* sp = c[q].sp + (long)(w * 32) * c[q].N + lane;
#pragma unroll
                for (int j = 0; j < 32; ++j) v[q][j] = sp[(long)j * c[q].N];
            }
        }
        __syncthreads();
#pragma unroll
        for (int q = 0; q < 4; ++q)
#pragma unroll
            for (int e = 0; e < 16; ++e) T[q * (64 * 66) + lane * 66 + w * 16 + e] = pack2(v[q][2 * e], v[q][2 * e + 1]);
        __syncthreads();
#pragma unroll
        for (int q = 0; q < 4; ++q) {
            if (t + q * step < last) {
#pragma unroll
                for (int i = 0; i < 4; ++i) {
                    const int idx = i * 256 + tid, nn = idx >> 4, ch = idx & 15;
                    const u32x4 o = *(const u32x4*)(T + q * (64 * 66) + nn * 66 + ch * 4);
                    *(u32x4*)(c[q].dp + (long)conv_drow(c[q].mode, c[q].n0 + nn) * c[q].K + ch * 8) = o;
                }
            }
        }
    }
}

DI const float* resid_row(KP p, int layer, int row) {
    if (row < NLAT) return (layer == 0 ? p->x : p->out) + (long)row * DM;
    return (layer == 0 ? p->ctx : P_ctxres(p)) + (long)(row - NLAT) * DM;
}
DI const float* cur_row(KP p, int row) { return row < NLAT ? p->out + (long)row * DM : P_ctxres(p) + (long)(row - NLAT) * DM; }
DI void moe_combine(KP p, int row, float4 (&v)[4]) {
    const int lane = TIDX() & 63;
    const bool lat = row < NLAT;
    const int* ts = P_tslot(p) + (lat ? 0 : 16) * (long)NLAT + (lat ? row : row - NLAT);
    const u16* yb_ = lat ? P_ye(p) : P_yec(p);
    const int cap = lat ? CAP_LAT : CAP_CTX;
#pragma unroll 4
    for (int e = 0; e < NEXP; ++e) {
        const int slot = ts[(long)e * NLAT];
        if (slot >= 0) {
            const u16* yr = yb_ + ((long)e * cap + slot) * DM + lane * 4;
#pragma unroll
            for (int i = 0; i < 4; ++i) {
                uint2 w = *(const uint2*)(yr + i * 256);
                v[i].x += bflo(w.x); v[i].y += bfhi(w.x); v[i].z += bflo(w.y); v[i].w += bfhi(w.y);
            }
        }
    }
}
DI void norm_row(KP p, int layer, int row, const float* xr, const float* g, int shift_idx, int scale_idx, u16* dst_row, float* keep  , float* wb  ) {
    const int lane = TIDX() & 63;
    const float* md = P_mod(p) + (layer * 2 + (row < NLAT ? 0 : 1)) * 6144;
    float4 v[4]; float ss = 0.f;
#pragma unroll
    for (int i = 0; i < 4; ++i) v[i] = *(const float4*)(xr + i * 256 + lane * 4);
    if (wb) {
        moe_combine(p, row, v);
#pragma unroll
        for (int i = 0; i < 4; ++i) *(float4*)(wb + i * 256 + lane * 4) = v[i];
    }
#pragma unroll
    for (int i = 0; i < 4; ++i) ss += v[i].x * v[i].x + v[i].y * v[i].y + v[i].z * v[i].z + v[i].w * v[i].w;
    ss = wave_sum(ss);
    float rstd = rsqrtf(ss * (1.f / DM) + 1e-6f);
#pragma unroll
    for (int i = 0; i < 4; ++i) {
        int c0 = i * 256 + lane * 4;
        float4 gg = *(const float4*)(g + c0), sh = *(const float4*)(md + shift_idx * 1024 + c0), sc = *(const float4*)(md + scale_idx * 1024 + c0);
        float o0 = v[i].x * rstd * gg.x * (1.f + sc.x) + sh.x, o1 = v[i].y * rstd * gg.y * (1.f + sc.y) + sh.y;
        float o2 = v[i].z * rstd * gg.z * (1.f + sc.z) + sh.z, o3 = v[i].w * rstd * gg.w * (1.f + sc.w) + sh.w;
        uint2 pk; pk.x = pack2(o0, o1); pk.y = pack2(o2, o3);
        *(uint2*)(dst_row + c0) = pk;
        if (keep) *(float4*)(keep + c0) = make_float4(o0, o1, o2, o3);
    }
}

DI void norm_rows4(KP p, int layer, int row0, const float* g, int shift_idx, int scale_idx, bool first_layer_src, bool combine, float* keep = nullptr  ) {
    const int lane = TIDX() & 63;
    const float* md = P_mod(p) + (layer * 2 + (row0 < NLAT ? 0 : 1)) * 6144;
    float4 v[4][4];
#pragma unroll
    for (int r = 0; r < 4; ++r) {
        const float* xr = first_layer_src ? resid_row(p, 0, row0 + r) : cur_row(p, row0 + r);
#pragma unroll
        for (int i = 0; i < 4; ++i) v[r][i] = *(const float4*)(xr + i * 256 + lane * 4);
    }
    float4 gg[4], sh[4], sc[4];
#pragma unroll
    for (int i = 0; i < 4; ++i) { const int c0 = i * 256 + lane * 4; gg[i] = *(const float4*)(g + c0); sh[i] = *(const float4*)(md + shift_idx * 1024 + c0); sc[i] = *(const float4*)(md + scale_idx * 1024 + c0); }
#pragma unroll
    for (int r = 0; r < 4; ++r) {
        const int row = row0 + r;
        if (first_layer_src && row >= NLAT) {
            float* wb = (float*)cur_row(p, row);
#pragma unroll
            for (int i = 0; i < 4; ++i) *(float4*)(wb + i * 256 + lane * 4) = v[r][i];
        }
        if (combine) {
            moe_combine(p, row, v[r]);
            float* wb = (float*)cur_row(p, row);
#pragma unroll
            for (int i = 0; i < 4; ++i) *(float4*)(wb + i * 256 + lane * 4) = v[r][i];
        }
        float ss = 0.f;
#pragma unroll
        for (int i = 0; i < 4; ++i) ss += v[r][i].x * v[r][i].x + v[r][i].y * v[r][i].y + v[r][i].z * v[r][i].z + v[r][i].w * v[r][i].w;
        ss = wave_sum(ss);
        const float rstd = rsqrtf(ss * (1.f / DM) + 1e-6f);
        u16* dst_row = P_hx(p) + (long)row * DM;
#pragma unroll
        for (int i = 0; i < 4; ++i) {
            const int c0 = i * 256 + lane * 4;
            float o0 = v[r][i].x * rstd * gg[i].x * (1.f + sc[i].x) + sh[i].x, o1 = v[r][i].y * rstd * gg[i].y * (1.f + sc[i].y) + sh[i].y;
            float o2 = v[r][i].z * rstd * gg[i].z * (1.f + sc[i].z) + sh[i].z, o3 = v[r][i].w * rstd * gg[i].w * (1.f + sc[i].w) + sh[i].w;
            uint2 pk; pk.x = pack2(o0, o1); pk.y = pack2(o2, o3);
            *(uint2*)(dst_row + c0) = pk;
            if (keep) *(float4*)(keep + r * 1024 + c0) = make_float4(o0, o1, o2, o3);
        }
    }
}

DI void phB_tile(KP p, int mt, int nt, char* smem) {
    const int tid = TIDX(), lane = tid & 63, wid = tid >> 6, wr = wid >> 1, wc = wid & 1, fr = lane & 15, fq = lane >> 4;
    f32x4 acc[4][4]; zero_acc<4>(acc);
    const int r0 = tid >> 2, ko = (tid & 3) * 8;
    const u16* a0 = P_hx(p) + (long)(mt * 128 + r0) * DM + ko;
    const u16* b0 = P_wt_in(p) + (long)(nt * 128 + r0) * DM + ko;
    gemm_core<32>(acc, a0, a0 + 64 * DM, b0, b0 + 64 * DM, smem);
    const bool lat = mt < 128;
    const int type = (nt < 8) ? 1 : (nt >= 16 && nt < 21) ? 2 : 0;
    if (type != 0 && lat) {
#pragma unroll
        for (int m = 0; m < 4; ++m)
#pragma unroll
            for (int j = 0; j < 4; ++j) {
                int t = mt * 128 + wr * 64 + m * 16 + fq * 4 + j;
                int pr = t >> 6, pc = t & 63;
#pragma unroll
                for (int n = 0; n < 2; ++n) {
                    float2 cs;
                    if (type == 1) { int pos = (wc == 0) ? pr : pc; cs = P_rope128(p)[pos * 32 + n * 16 + fr]; }
                    else { int pos = (n == 0) ? pr : pc; cs = P_rope64(p)[pos * 16 + fr]; }
                    float x1 = acc[m][n][j], x2 = acc[m][n + 2][j];
                    acc[m][n][j] = x1 * cs.x - x2 * cs.y;
                    acc[m][n + 2][j] = x1 * cs.y + x2 * cs.x;
                }
            }
    }
    const float mul = (nt >= 4 && nt < 8) ? 0.08838834764831845f : ((nt >= 16 && nt < 20) || (nt >= 22 && nt < 26)) ? 0.125f : 1.f;
#pragma unroll
    for (int m = 0; m < 4; ++m)
#pragma unroll
        for (int n = 0; n < 4; ++n)
#pragma unroll
            for (int j = 0; j < 4; ++j) {
                int row = mt * 128 + wr * 64 + m * 16 + fq * 4 + j, col = nt * 128 + wc * 64 + n * 16 + fr;
                P_px(p)[(long)row * INC + col] = f2bf(acc[m][n][j] * mul);
            }
}

typedef __attribute__((ext_vector_type(16))) float f32x16;
typedef short v4s __attribute__((ext_vector_type(4)));
typedef __attribute__((address_space(3))) v4s* lds_v4s_ptr;
#define MFMA32(a, b, c) __builtin_amdgcn_mfma_f32_32x32x16_bf16((a), (b), (c), 0, 0, 0)
constexpr float LOG2E = 1.4426950408889634f;

struct FA {
    bf16x8 qf[4];
    f32x16 o[2];
    float m, l;
};
DI void fa_stage(u16* Ks, u16* Vs, const u16* px, int rowstart, int colK1, int colK2, int colV) {
    const int lane = TIDX() & 63;
#pragma unroll
    for (int i = 0; i < 8; ++i) {
        int idx = i * 64 + lane, key = idx >> 3, ch = idx & 7;
        const u16* src = px + (long)(rowstart + key) * INC;
        u32x4 kv = *(const u32x4*)(src + (ch < 4 ? colK1 + ch * 8 : colK2 + (ch - 4) * 8));
        u32x4 vv = *(const u32x4*)(src + colV + ch * 8);
        *(u32x4*)(Ks + key * 72 + ch * 8) = kv;
        *(u32x4*)(Vs + key * 72 + ch * 8) = vv;
    }
}
template <int MODE>
DI void fa_tile(FA& st, const u16* Ks, const u16* Vs, int a0, const float* rrow) {
    const int lane = TIDX() & 63, c = lane & 31, hh = lane >> 5;
    const u16* kbase = Ks + c * 72 + hh * 8;
    const u16* vbase = Vs + (4 * hh + ((lane & 15) >> 2)) * 72 + 16 * ((lane >> 4) & 1) + 4 * (lane & 3);
    f32x16 s[2];
#pragma unroll
    for (int kb = 0; kb < 2; ++kb) {
#pragma unroll
        for (int r = 0; r < 16; ++r) s[kb][r] = 0.f;
#pragma unroll
        for (int ks = 0; ks < 4; ++ks) {
            bf16x8 A = *(const bf16x8*)(kbase + kb * 32 * 72 + ks * 16);
            s[kb] = MFMA32(A, st.qf[ks], s[kb]);
        }
    }
    float mx = -3.0e38f;
    const int cq = a0 + c;
    int cs = cq - 8; cs = cs < 0 ? 0 : (cs > 48 ? 48 : cs);
#pragma unroll
    for (int kb = 0; kb < 2; ++kb)
#pragma unroll
        for (int r = 0; r < 16; ++r) {
            const int j = kb * 32 + (r & 3) + 8 * (r >> 2) + 4 * hh;
            float v = s[kb][r];
            if (MODE == 1) { int d = a0 + j - c; v = (d >= -128 && d <= 128) ? v : -1e30f; }
            if (MODE == 2) { bool ok = (j >= cs) && (j < cs + 16); int ci = j - cq + 15; ci = ci < 0 ? 0 : (ci > 30 ? 30 : ci); v = ok ? v + rrow[ci] : -1e30f; }
            v *= LOG2E;
            s[kb][r] = v;
            mx = fmaxf(mx, v);
        }
    mx = fmaxf(mx, __shfl_xor(mx, 32));
    const float mn = fmaxf(st.m, mx);
    const float alpha = __builtin_amdgcn_exp2f(st.m - mn);
    float ls = 0.f;
#pragma unroll
    for (int kb = 0; kb < 2; ++kb)
#pragma unroll
        for (int r = 0; r < 16; ++r) { float pv = __builtin_amdgcn_exp2f(s[kb][r] - mn); s[kb][r] = pv; ls += pv; }
    st.l = st.l * alpha + ls; st.m = mn;
#pragma unroll
    for (int db = 0; db < 2; ++db)
#pragma unroll
        for (int r = 0; r < 16; ++r) st.o[db][r] *= alpha;
    bf16x8 pf[2][2];
#pragma unroll
    for (int kb = 0; kb < 2; ++kb)
#pragma unroll
        for (int k2 = 0; k2 < 2; ++k2) {
            u32x4 w;
#pragma unroll
            for (int e = 0; e < 4; ++e) w[e] = pack2(s[kb][8 * k2 + 2 * e], s[kb][8 * k2 + 2 * e + 1]);
            pf[kb][k2] = __builtin_bit_cast(bf16x8, w);
        }
#pragma unroll
    for (int db = 0; db < 2; ++db)
#pragma unroll
        for (int kb = 0; kb < 2; ++kb)
#pragma unroll
            for (int k2 = 0; k2 < 2; ++k2) {
                const u16* alo = vbase + (kb * 32 + 16 * k2) * 72 + db * 32;
                v4s lo = __builtin_amdgcn_ds_read_tr16_b64_v4i16((lds_v4s_ptr)alo);
                v4s hi = __builtin_amdgcn_ds_read_tr16_b64_v4i16((lds_v4s_ptr)(alo + 8 * 72));
                bf16x8 A = __builtin_shufflevector(lo, hi, 0, 1, 2, 3, 4, 5, 6, 7);
                st.o[db] = MFMA32(A, pf[kb][k2], st.o[db]);
            }
}
DI void fa_tile_na32(FA& st, const u16* Ks, const u16* Vs, int koff, bool rowok, int cs, const float* brow) {
    const int lane = TIDX() & 63, c = lane & 31, hh = lane >> 5;
    const u16* kbase = Ks + (koff + c) * 72 + hh * 8;
    const u16* vbase = Vs + (koff + 4 * hh + ((lane & 15) >> 2)) * 72 + 16 * ((lane >> 4) & 1) + 4 * (lane & 3);
    f32x16 s;
#pragma unroll
    for (int r = 0; r < 16; ++r) s[r] = 0.f;
#pragma unroll
    for (int ks = 0; ks < 4; ++ks) {
        bf16x8 A = *(const bf16x8*)(kbase + ks * 16);
        s = MFMA32(A, st.qf[ks], s);
    }
    float mx = -3.0e38f;
    const int lo = cs - koff;
#pragma unroll
    for (int r = 0; r < 16; ++r) {
        const int jj = (r & 3) + 8 * (r >> 2) + 4 * hh;
        const bool ok = rowok && (jj >= lo) && (jj < lo + 16);
        float v = ok ? (s[r] + brow[jj]) * LOG2E : -1.4e30f;
        s[r] = v;
        mx = fmaxf(mx, v);
    }
    mx = fmaxf(mx, __shfl_xor(mx, 32));
    const float mn = fmaxf(st.m, mx);
    const float alpha = __builtin_amdgcn_exp2f(st.m - mn);
    float ls = 0.f;
#pragma unroll
    for (int r = 0; r < 16; ++r) { float pv = __builtin_amdgcn_exp2f(s[r] - mn); s[r] = pv; ls += pv; }
    st.l = st.l * alpha + ls; st.m = mn;
#pragma unroll
    for (int db = 0; db < 2; ++db)
#pragma unroll
        for (int r = 0; r < 16; ++r) st.o[db][r] *= alpha;
    bf16x8 pf[2];
#pragma unroll
    for (int k2 = 0; k2 < 2; ++k2) {
        u32x4 w;
#pragma unroll
        for (int e = 0; e < 4; ++e) w[e] = pack2(s[8 * k2 + 2 * e], s[8 * k2 + 2 * e + 1]);
        pf[k2] = __builtin_bit_cast(bf16x8, w);
    }
#pragma unroll
    for (int db = 0; db < 2; ++db)
#pragma unroll
        for (int k2 = 0; k2 < 2; ++k2) {
            const u16* alo = vbase + (16 * k2) * 72 + db * 32;
            v4s lo_ = __builtin_amdgcn_ds_read_tr16_b64_v4i16((lds_v4s_ptr)alo);
            v4s hi_ = __builtin_amdgcn_ds_read_tr16_b64_v4i16((lds_v4s_ptr)(alo + 8 * 72));
            bf16x8 A = __builtin_shufflevector(lo_, hi_, 0, 1, 2, 3, 4, 5, 6, 7);
            st.o[db] = MFMA32(A, pf[k2], st.o[db]);
        }
}
DI void attn_block_item(KP p, int layer, int kind, int ia, int ib, char* smem) {
    const int tid = TIDX(), lane = tid & 63, wid = tid >> 6, c = lane & 31, hh = lane >> 5;
    u16* KV = (u16*)smem;
    float* rpbs = (float*)(smem + 36864) + 64 + wid * 512;
    const bool isna = (kind == 1 || kind == 3);
    int h, q0, a_half = 0, kvh;
    if (kind == 0) { h = ib * 4 + wid; kvh = ib; q0 = ia * 32; }
    else if (kind == 1) { h = ib; kvh = ib; q0 = 2 * ia * 64; }
    else if (kind == 2) { h = ib * 4 + wid; kvh = ib; q0 = NLAT + ia * 32; }
    else { h = ib; kvh = ib; q0 = NLAT + (ia * 4 + wid) * 32; }
    const int colQ1 = isna ? C_QN + h * 64 : col_qw(h, 0), colQ2 = isna ? colQ1 + 32 : col_qw(h, 1);
    const int colK1 = isna ? C_KN + kvh * 64 : col_kw(kvh, 0), colK2 = isna ? colK1 + 32 : col_kw(kvh, 1);
    const int colV = isna ? C_VN + kvh * 64 : col_vw(kvh);
    FA st;
    {
        const int tq = (kind == 1) ? q0 + (c >> 4) * 64 + wid * 16 + (c & 15) : q0 + c;
        const u16* qrow = P_px(p) + (long)tq * INC;
#pragma unroll
        for (int ks = 0; ks < 4; ++ks) st.qf[ks] = *(const bf16x8*)(qrow + (ks < 2 ? colQ1 + ks * 16 : colQ2 + (ks - 2) * 16) + hh * 8);
#pragma unroll
        for (int db = 0; db < 2; ++db)
#pragma unroll
            for (int r = 0; r < 16; ++r) st.o[db][r] = 0.f;
        if (isna) { st.m = -1e30f; st.l = 0.f; } else { st.m = p->sink[layer * 8 + h] * LOG2E; st.l = hh == 0 ? 1.f : 0.f; }
    }
    const int r0 = 2 * ia, rq = r0 + (c >> 4), cq = wid * 16 + (c & 15);
    int sr0 = r0 - 4; sr0 = sr0 < 0 ? 0 : (sr0 > 248 ? 248 : sr0);
    int srq = rq - 4; srq = srq < 0 ? 0 : (srq > 248 ? 248 : srq);
    int sr1 = r0 + 1 - 4; sr1 = sr1 < 0 ? 0 : (sr1 > 248 ? 248 : sr1);
    int csq = cq - 8; csq = csq < 0 ? 0 : (csq > 48 ? 48 : csq);
    const int koff = wid == 0 ? 0 : wid == 1 ? 8 : wid == 2 ? 24 : 32;
    const float* bq = rpbs + (7 - rq) * 31 + koff - cq + 15;
    if (kind == 1) {
        const float* rp = p->rpb + ((long)layer * 8 + h) * 465;
        for (int i = lane; i < 465; i += 64) rpbs[i] = rp[i];
    }
    const int nloc = kind == 0 ? 5 : kind == 1 ? 9 : 0, nt = nloc + 4;
    const int wt0 = (q0 >> 6) - 2;
    auto tile_row = [&](int i) -> int {
        if (i >= nloc) return NLAT + (i - nloc) * 64;
        if (kind == 0) { const int s0 = ((ia * 32) >> 6) - 2 + i; return (s0 < 0 || s0 >= NLAT / 64) ? -1 : s0 * 64; }
        const int kr = sr0 + i; return (kr > sr1 + 7) ? -1 : kr * 64;
    };
    const int skey = tid >> 4, sc16 = tid & 15;
    const int scol = sc16 < 8 ? (sc16 < 4 ? colK1 + sc16 * 8 : colK2 + (sc16 - 4) * 8) : colV + (sc16 - 8) * 8;
    const int sdst = (sc16 < 8 ? 0 : 64 * 72) + skey * 72 + (sc16 & 7) * 8;
    u32x4 pre[4];
    auto load_tile = [&](int row0) {
#pragma unroll
        for (int j = 0; j < 4; ++j) pre[j] = *(const u32x4*)(P_px(p) + (long)(row0 + skey + 16 * j) * INC + scol);
    };
    auto store_tile = [&](int buf) {
#pragma unroll
        for (int j = 0; j < 4; ++j) *(u32x4*)(KV + buf * (2 * 64 * 72) + sdst + 16 * j * 72) = pre[j];
    };
    __syncthreads();
    int rowc = tile_row(0);
    if (rowc >= 0) { load_tile(rowc); store_tile(0); }
    __syncthreads();
    for (int i = 0; i < nt; ++i) {
        const int rown = (i + 1 < nt) ? tile_row(i + 1) : -1;
        if (rown >= 0) load_tile(rown);
        if (rowc >= 0) {
            const u16* Ks = KV + (i & 1) * (2 * 64 * 72);
            const u16* Vs = Ks + 64 * 72;
            if (i >= nloc) fa_tile<0>(st, Ks, Vs, 0, nullptr);
            else if (kind == 0) { if (i == 0 || i == 4) fa_tile<1>(st, Ks, Vs, rowc - q0, nullptr); else fa_tile<0>(st, Ks, Vs, 0, nullptr); }
            else { const int kr = sr0 + i; fa_tile_na32(st, Ks, Vs, koff, kr >= srq && kr < srq + 8, csq, bq + kr * 31); }
        }
        if (rown >= 0) store_tile((i + 1) & 1);
        rowc = rown;
        __syncthreads();
    }
    u16* y = isna ? P_yc(p) : P_yb(p);
    {
        float lt = st.l + __shfl_xor(st.l, 32);
        float inv = 1.f / lt;
        u16* ob = KV + wid * (32 * 72);
#pragma unroll
        for (int db = 0; db < 2; ++db)
#pragma unroll
            for (int g = 0; g < 4; ++g) {
                uint2 o;
                o.x = pack2(st.o[db][4 * g] * inv, st.o[db][4 * g + 1] * inv);
                o.y = pack2(st.o[db][4 * g + 2] * inv, st.o[db][4 * g + 3] * inv);
                *(uint2*)(ob + c * 72 + db * 32 + 8 * g + 4 * hh) = o;
            }
#pragma unroll
        for (int i = 0; i < 4; ++i) {
            const int idx = i * 64 + lane, qi = idx >> 3, ch = idx & 7;
            const int tq = (kind == 1) ? q0 + (qi >> 4) * 64 + wid * 16 + (qi & 15) : q0 + qi;
            *(u32x4*)(y + (long)tq * 512 + h * 64 + ch * 8) = *(const u32x4*)(ob + qi * 72 + ch * 8);
        }
    }
}

DI void ret_gammas(KP p, int layer, int h, float& lgf2, float& lgb2) {
    float xf = p->decay[layer * 8 + h], xb = p->decay[layer * 8 + 4 + h];
    lgf2 = -log1pf(expf(-xf)) * 1.4426950408889634f;
    lgb2 = -log1pf(expf(-xb)) * 1.4426950408889634f;
}
DI void phC_state_item(KP p, int layer, int c, int h, int eh, char* smem) {
    const int tid = TIDX(), lane = tid & 63, wid = tid >> 6, wr = wid >> 1, wc = wid & 1, fr = lane & 15, fq = lane >> 4;
    u16* Vr = (u16*)smem;
    u16* Kf = Vr + 64 * 72;
    u16* Kb = Kf + 64 * 136;
    float lgf2, lgb2; ret_gammas(p, layer, h, lgf2, lgb2);
    f32x4 accF[2][4], accB[2][4]; zero_acc<2>(accF); zero_acc<2>(accB);
    const u16* base = P_px(p) + (long)c * 128 * INC;
    u32x4 pv[2], pk[4];
    auto load_half = [&](int jh) {
        const u16* rb = base + (long)jh * 64 * INC;
#pragma unroll
        for (int i = 0; i < 2; ++i) { const int idx = i * 256 + tid, row = idx >> 3, ch = idx & 7; pv[i] = *(const u32x4*)(rb + (long)row * INC + C_VR + h * 128 + eh * 64 + ch * 8); }
#pragma unroll
        for (int i = 0; i < 4; ++i) { const int idx = i * 256 + tid, row = idx >> 4, ch = idx & 15; pk[i] = *(const u32x4*)(rb + (long)row * INC + (ch < 8 ? col_kr(h, 0) + ch * 8 : col_kr(h, 1) + (ch - 8) * 8)); }
    };
    auto store_half = [&](int jh) {
#pragma unroll
        for (int i = 0; i < 2; ++i) { const int idx = i * 256 + tid, row = idx >> 3, ch = idx & 7; *(u32x4*)(Vr + row * 72 + ch * 8) = pv[i]; }
#pragma unroll
        for (int i = 0; i < 4; ++i) {
            const int idx = i * 256 + tid, row = idx >> 4, ch = idx & 15, j = jh * 64 + row;
            const float zf = exp2f((float)(127 - j) * lgf2), zb = exp2f((float)j * lgb2);
            u32x4 of, ob;
#pragma unroll
            for (int e = 0; e < 4; ++e) { const float lo = bflo(pk[i][e]), hi = bfhi(pk[i][e]); of[e] = pack2(lo * zf, hi * zf); ob[e] = pack2(lo * zb, hi * zb); }
            *(u32x4*)(Kf + row * 136 + ch * 8) = of;
            *(u32x4*)(Kb + row * 136 + ch * 8) = ob;
        }
    };
    load_half(0);
    __syncthreads();
    store_half(0);
    load_half(1);
    __syncthreads();
    mma_lds64_tt<2>(accF, Vr, 72, Kf, 136);
    mma_lds64_tt<2>(accB, Vr, 72, Kb, 136);
    __syncthreads();
    store_half(1);
    __syncthreads();
    mma_lds64_tt<2>(accF, Vr, 72, Kf, 136);
    mma_lds64_tt<2>(accB, Vr, 72, Kb, 136);
    __syncthreads();
#pragma unroll
    for (int m = 0; m < 2; ++m)
#pragma unroll
        for (int n = 0; n < 4; ++n)
#pragma unroll
            for (int j = 0; j < 4; ++j) {
                const int el = wr * 32 + m * 16 + fq * 4 + j, d = wc * 64 + n * 16 + fr;
                Kf[el * 136 + d] = f2bf(accF[m][n][j]);
                Kb[el * 136 + d] = f2bf(accB[m][n][j]);
            }
    __syncthreads();
    u16* Sf = (u16*)P_S(p) + ((long)(c * 4 + h) * 2 + 0) * 16384 + (long)eh * 64 * 128;
    u16* Sb = Sf + 16384;
#pragma unroll
    for (int i = 0; i < 4; ++i) {
        const int idx = i * 256 + tid, el = idx >> 4, ch = idx & 15;
        *(u32x4*)(Sf + el * 128 + ch * 8) = *(const u32x4*)(Kf + el * 136 + ch * 8);
        *(u32x4*)(Sb + el * 128 + ch * 8) = *(const u32x4*)(Kb + el * 136 + ch * 8);
    }
}

DI void phD_item(KP p, int layer, int item) {
    const int h = item >> 7, dir = (item >> 6) & 1, pos = (item & 63) * 256 + TIDX();
    float lgf2, lgb2; ret_gammas(p, layer, h, lgf2, lgb2);
    const float decay = exp2f(128.f * (dir == 0 ? lgf2 : lgb2));
    float r = 0.f;
    const long hs = (long)(h * 2 + dir) * 16384 + pos;
    auto chunk_at = [&](int i) -> int {
        if (dir == 0) return i < 2 ? 128 + i : i - 2;
        return i < 2 ? 129 - i : 129 - i;
    };
    for (int i0 = 0; i0 < NCHUNK; i0 += 13) {
        float s[13];
#pragma unroll
        for (int u = 0; u < 13; ++u) s[u] = bf2f(((const u16*)P_S(p))[(long)chunk_at(i0 + u) * 8 * 16384 + hs]);
#pragma unroll
        for (int u = 0; u < 13; ++u) {
            P_R(p)[(long)chunk_at(i0 + u) * 8 * 16384 + hs] = f2bf(r);
            r = decay * r + s[u];
        }
    }
}

DI void phE_item(KP p, int layer, int c, int h, int ih, char* smem) {
    const int tid = TIDX(), lane = tid & 63, wid = tid >> 6, wr = wid >> 1, wc = wid & 1, fr = lane & 15, fq = lane >> 4;
    u16* Qs = (u16*)smem;
    u16* X = Qs + 64 * 136;
    u16* P = X + 128 * 136;
    float* red = (float*)(P + 64 * 136);
    float lgf2, lgb2; ret_gammas(p, layer, h, lgf2, lgb2);
    const u16* base = P_px(p) + (long)c * 128 * INC;
    const u16* Rf = P_R(p) + ((long)(c * 4 + h) * 2 + 0) * 16384;
    const u16* Rb = Rf + 16384;
    const int ch = tid & 15, rw = tid >> 4;
    const int qkcol = ch < 8 ? ch * 8 : (ch - 8) * 8;
    u32x4 pre[8];
    auto load_rows = [&](const u16* src, long stride, int nrow16) {
#pragma unroll
        for (int i = 0; i < 8; ++i) if (i < nrow16) pre[i] = *(const u32x4*)(src + (long)(rw + 16 * i) * stride);
    };
    auto store_rows = [&](u16* dst, int nrow16) {
#pragma unroll
        for (int i = 0; i < 8; ++i) if (i < nrow16) *(u32x4*)(dst + (rw + 16 * i) * 136 + ch * 8) = pre[i];
    };
    f32x4 Y[2][4], T[2][4];
    zero_acc<2>(Y); zero_acc<2>(T);
    __syncthreads();
    load_rows(base + (long)ih * 64 * INC + (ch < 8 ? col_qr(h, 0) : col_qr(h, 1)) + qkcol, INC, 4); store_rows(Qs, 4);
    load_rows(Rf + ch * 8, 128, 8); store_rows(X, 8);
    load_rows(Rb + ch * 8, 128, 8);
    __syncthreads();
    mma_lds64<2>(Y, Qs, 136, X, 136); mma_lds64<2>(Y, Qs + 64, 136, X + 64, 136);
    __syncthreads();
    store_rows(X, 8);
    load_rows(base + (ch < 8 ? col_kr(h, 0) : col_kr(h, 1)) + qkcol, INC, 8);
    __syncthreads();
    mma_lds64<2>(T, Qs, 136, X, 136); mma_lds64<2>(T, Qs + 64, 136, X + 64, 136);
#pragma unroll
    for (int m = 0; m < 2; ++m)
#pragma unroll
        for (int j = 0; j < 4; ++j) {
            int i = ih * 64 + wr * 32 + m * 16 + fq * 4 + j;
            float xf = exp2f((float)(i + 1) * lgf2), xb = exp2f((float)(128 - i) * lgb2);
#pragma unroll
            for (int n = 0; n < 4; ++n) Y[m][n][j] = xf * Y[m][n][j] + xb * T[m][n][j];
        }
    zero_acc<2>(T);
    __syncthreads();
    store_rows(X, 8);
    load_rows(base + C_VR + h * 128 + ch * 8, INC, 8);
    __syncthreads();
    mma_lds64<2>(T, Qs, 136, X, 136); mma_lds64<2>(T, Qs + 64, 136, X + 64, 136);
#pragma unroll
    for (int m = 0; m < 2; ++m)
#pragma unroll
        for (int n = 0; n < 4; ++n)
#pragma unroll
            for (int j = 0; j < 4; ++j) {
                int il = wr * 32 + m * 16 + fq * 4 + j, i = ih * 64 + il, jj = wc * 64 + n * 16 + fr;
                float dm = (i >= jj) ? exp2f((float)(i - jj) * lgf2) : exp2f((float)(jj - i) * lgb2);
                P[il * 136 + jj] = f2bf(T[m][n][j] * dm);
            }
    __syncthreads();
    store_rows(X, 8);
    __syncthreads();
    mma_lds64_btr<2>(Y, P, 136, X, 136); mma_lds64_btr<2>(Y, P + 64, 136, X + 64 * 136, 136);
    float mu[2][4], rs[2][4];
#pragma unroll
    for (int m = 0; m < 2; ++m)
#pragma unroll
        for (int j = 0; j < 4; ++j) {
            float s = Y[m][0][j] + Y[m][1][j] + Y[m][2][j] + Y[m][3][j];
            s += __shfl_xor(s, 1); s += __shfl_xor(s, 2); s += __shfl_xor(s, 4); s += __shfl_xor(s, 8);
            if (fr == 0) red[(wr * 32 + m * 16 + fq * 4 + j) * 2 + wc] = s;
        }
    __syncthreads();
#pragma unroll
    for (int m = 0; m < 2; ++m)
#pragma unroll
        for (int j = 0; j < 4; ++j) { int il = wr * 32 + m * 16 + fq * 4 + j; mu[m][j] = (red[il * 2] + red[il * 2 + 1]) * (1.f / 128.f); }
    __syncthreads();
#pragma unroll
    for (int m = 0; m < 2; ++m)
#pragma unroll
        for (int j = 0; j < 4; ++j) {
            float s = 0.f;
#pragma unroll
            for (int n = 0; n < 4; ++n) { float d = Y[m][n][j] - mu[m][j]; s += d * d; }
            s += __shfl_xor(s, 1); s += __shfl_xor(s, 2); s += __shfl_xor(s, 4); s += __shfl_xor(s, 8);
            if (fr == 0) red[(wr * 32 + m * 16 + fq * 4 + j) * 2 + wc] = s;
        }
    __syncthreads();
#pragma unroll
    for (int m = 0; m < 2; ++m)
#pragma unroll
        for (int j = 0; j < 4; ++j) { int il = wr * 32 + m * 16 + fq * 4 + j; rs[m][j] = rsqrtf((red[il * 2] + red[il * 2 + 1]) * (1.f / 128.f) + 1e-6f); }
    __syncthreads();
    const float* gn = p->ret_gn + layer * 512 + h * 128;
#pragma unroll
    for (int m = 0; m < 2; ++m)
#pragma unroll
        for (int n = 0; n < 4; ++n)
#pragma unroll
            for (int j = 0; j < 4; ++j) {
                const int il = wr * 32 + m * 16 + fq * 4 + j, e = wc * 64 + n * 16 + fr;
                P[il * 136 + e] = f2bf((Y[m][n][j] - mu[m][j]) * rs[m][j] * gn[e]);
            }
    __syncthreads();
#pragma unroll
    for (int i = 0; i < 4; ++i) {
        const int idx = i * 256 + tid, il = idx >> 4, ch = idx & 15;
        const long row = (long)c * 128 + ih * 64 + il;
        const u32x4 yv = *(const u32x4*)(P + il * 136 + ch * 8);
        const u32x4 gv = *(const u32x4*)(P_px(p) + row * INC + C_GR + h * 128 + ch * 8);
        u32x4 o;
#pragma unroll
        for (int e = 0; e < 4; ++e) o[e] = pack2(bflo(yv[e]) * siluf_(bflo(gv[e])), bfhi(yv[e]) * siluf_(bfhi(gv[e])));
        *(u32x4*)(P_ya(p) + row * 512 + h * 128 + ch * 8) = o;
    }
    __syncthreads();
}

DI void phF_tile(KP p, int mt, int nt, int b, int ks, char* smem) {
    const int tid = TIDX(), lane = tid & 63, wid = tid >> 6, wr = wid >> 1, wc = wid & 1, fr = lane & 15, fq = lane >> 4;
    const int r0 = tid >> 2, ko = (tid & 3) * 8 + ks * 64;
    float* macc = P_maccx(p) - (long)NLAT * DM;
    const u16* y = (b == 0 ? P_ya(p) : b == 1 ? P_yb(p) : P_yc(p));
    const u16* w = (b == 0 ? P_wt_ret(p) : b == 1 ? P_wt_win(p) : P_wt_na(p));
    f32x4 acc[4][4]; zero_acc<4>(acc);
    const u16* a0 = y + (long)(mt * 128 + r0) * 512 + ko;
    const u16* b0 = w + (long)(nt * 128 + r0) * 512 + ko;
    gemm_core<2>(acc, a0, a0 + 64 * 512, b0, b0 + 64 * 512, smem);
    int zero = 0; asm volatile("" : "+v"(zero));
#pragma unroll
    for (int m = 0; m < 4; ++m)
#pragma unroll
        for (int n = 0; n < 4; ++n)
#pragma unroll
            for (int j = 0; j < 4; ++j) {
                int row = mt * 128 + wr * 64 + m * 16 + fq * 4 + j + zero, col = nt * 128 + wc * 64 + n * 16 + fr;
                float g = bf2f(P_px(p)[(long)row * INC + C_GATE + b * 1024 + col]);
                unsafeAtomicAdd(macc + (long)row * DM + col, acc[m][n][j] * sigmoidf_(g));
            }
}
DI void phG_tile(KP p, int layer, int mt, int nt, int ks, char* smem) {
    const int tid = TIDX(), lane = tid & 63, wid = tid >> 6, wr = wid >> 1, wc = wid & 1, fr = lane & 15, fq = lane >> 4;
    f32x4 acc[4][4]; zero_acc<4>(acc);
    const int r0 = tid >> 2, ko = (tid & 3) * 8 + ks * 32;
    const float* a0 = P_maccx(p) + (long)((mt - 128) * 128 + r0) * DM + ko;
    const u16* b0 = P_wt_out(p) + (long)(nt * 128 + r0) * DM + ko;
    gemm_core_af32<1>(acc, a0, a0 + 64 * DM, b0, b0 + 64 * DM, smem);
    const float* md = P_mod(p) + (layer * 2 + 1) * 6144 + 2 * 1024;
    int zero = 0; asm volatile("" : "+v"(zero));
#pragma unroll
    for (int m = 0; m < 4; ++m)
#pragma unroll
        for (int n = 0; n < 4; ++n)
#pragma unroll
            for (int j = 0; j < 4; ++j) {
                int row = mt * 128 + wr * 64 + m * 16 + fq * 4 + j + zero, col = nt * 128 + wc * 64 + n * 16 + fr;
                unsafeAtomicAdd(P_ctxres(p) + (long)(row - NLAT) * DM + col, md[col] * acc[m][n][j]);
            }
}


#define LAS __attribute__((address_space(3)))
namespace g8 {
constexpr int BM = 256, BK = 64, HALF = 128, HTB = HALF * BK * 2, STAGE_BYTES = 8 * HTB;
DI int lds_byte(int r, int c) { const int st = (r >> 4) * 2 + (c >> 5), rr = r & 15, cc = c & 31, ob = rr * 64 + cc * 2; return st * 1024 + (ob ^ (((ob >> 9) & 1) << 5)); }
DI void stage_rc(int b, int& R, int& C) { const int st = b / 1024, sb = b % 1024, swz = sb ^ (((sb >> 9) & 1) << 5); R = (st >> 1) * 16 + swz / 64; C = (st & 1) * 32 + (swz % 64) / 2; }
DI int perm32(int rho) { const int n = rho >> 4, i = rho & 15; return 8 * (i >> 2) + 4 * n + (i & 3); }
struct Unit { int pm, pn, aux; };
typedef f32x4 Acc[2][2][4][2];

template <class P>
DI void gemm_phase(LAS unsigned char* lds, const P& prob) {
    const int tid = TID512(), wid = __builtin_amdgcn_readfirstlane(tid >> 6), lane = tid & 63, wr = wid >> 2, wc = wid & 3, fr = lane & 15, fq = lane >> 4;
    constexpr int K = P::K, nt = K / BK;
    int Rr[2], Cc[2];
    unsigned voffA[2], voffB[2];
#pragma unroll
    for (int i = 0; i < 2; ++i) { stage_rc(tid * 16 + i * 8192, Rr[i], Cc[i]); const int Rb = P::PERM ? ((Rr[i] & ~31) + perm32(Rr[i] & 31)) : Rr[i];
        voffA[i] = (unsigned)(Rr[i] * K + Cc[i]) * 2u; voffB[i] = (unsigned)(Rb * K + Cc[i]) * 2u; }
    constexpr size_t kstep = (size_t)(BK * 2);
    constexpr size_t hstep = (size_t)HALF * K * 2;
    const unsigned ldsw = (unsigned)wid * 1024u;
    const int aoff = lds_byte(wr * 64 + fr, fq * 8), boff = lds_byte(wc * 32 + fr, fq * 8);
    unsigned vaC[2][2], vaN[2][2];
#define G8_SA(b, h) (((b) * 2 + (h)) * HTB)
#define G8_SB(b, h) ((4 + (b) * 2 + (h)) * HTB)
#define G8_STAGEA(bufoff, base, VA, h, kt) do { _Pragma("unroll") for (int _i = 0; _i < 2; ++_i) \
        __builtin_amdgcn_global_load_lds((const unsigned*)((base) + (P::GATHER ? (size_t)(VA)[h][_i] : (size_t)voffA[_i] + (size_t)(h) * hstep) + (size_t)(kt) * kstep), (LAS unsigned*)(lds + (bufoff) + ldsw + _i * 8192), 16, 0, 0); } while (0)
#define G8_STAGEB(bufoff, base, h, kt) do { _Pragma("unroll") for (int _i = 0; _i < 2; ++_i) \
        __builtin_amdgcn_global_load_lds((const unsigned*)((base) + (size_t)(h) * hstep + voffB[_i] + (size_t)(kt) * kstep), (LAS unsigned*)(lds + (bufoff) + ldsw + _i * 8192), 16, 0, 0); } while (0)
#define G8_LDA(dst, b, h) do { _Pragma("unroll") for (int m = 0; m < 4; ++m) _Pragma("unroll") for (int k = 0; k < 2; ++k) dst[m][k] = *(const LAS bf16x8*)(lds + G8_SA(b, h) + aoff + m * 2048 + k * 1024); } while (0)
#define G8_LDB(dst, b, h) do { _Pragma("unroll") for (int n = 0; n < 2; ++n) _Pragma("unroll") for (int k = 0; k < 2; ++k) dst[n][k] = *(const LAS bf16x8*)(lds + G8_SB(b, h) + boff + n * 2048 + k * 1024); } while (0)
#define G8_MMA(ai, bj, At, Bt) do { __builtin_amdgcn_s_setprio(1); _Pragma("unroll") for (int m = 0; m < 4; ++m) _Pragma("unroll") for (int n = 0; n < 2; ++n) _Pragma("unroll") for (int k = 0; k < 2; ++k) \
        acc[ai][bj][m][n] = __builtin_amdgcn_mfma_f32_16x16x32_bf16(Bt[n][k], At[m][k], acc[ai][bj][m][n], 0, 0, 0); __builtin_amdgcn_s_setprio(0); } while (0)
#define G8_WAIT_V(n) asm volatile("s_waitcnt vmcnt(" #n ")" ::: "memory")
#define G8_WAIT_L(n) asm volatile("s_waitcnt lgkmcnt(" #n ")" ::: "memory")
#define G8_BAR __builtin_amdgcn_s_barrier()
#define G8_SCHED __builtin_amdgcn_sched_barrier(0)
    Unit cur, nxt; int ui = 0;
    __syncthreads();
    if (!prob.next(0, cur)) return;
    if (P::GATHER) prob.gather(cur, Rr, Cc, vaC);
    const char* cA = prob.a_base(cur); const char* cB = prob.b_base(cur);
    Acc acc;
#pragma unroll
    for (int a = 0; a < 2; ++a)
#pragma unroll
        for (int b = 0; b < 2; ++b)
#pragma unroll
            for (int m = 0; m < 4; ++m)
#pragma unroll
                for (int n = 0; n < 2; ++n) acc[a][b][m][n] = (f32x4){0.f, 0.f, 0.f, 0.f};
    bf16x8 At[4][2], B0[2][2], B1[2][2];
    G8_STAGEB(G8_SB(0, 0), cB, 0, 0); G8_STAGEA(G8_SA(0, 0), cA, vaC, 0, 0); G8_STAGEB(G8_SB(0, 1), cB, 1, 0); G8_STAGEA(G8_SA(0, 1), cA, vaC, 1, 0);
    if (wr == 1) G8_BAR;
    G8_WAIT_V(4); G8_BAR;
    G8_STAGEB(G8_SB(1, 0), cB, 0, 1); G8_STAGEA(G8_SA(1, 0), cA, vaC, 0, 1); G8_STAGEB(G8_SB(1, 1), cB, 1, 1);
    G8_WAIT_V(6); G8_BAR;
    for (;;) {
        const bool has_next = prob.next(ui + 1, nxt);
        if (!has_next) nxt = cur;
        if (P::GATHER) {
            if (has_next) prob.gather(nxt, Rr, Cc, vaN);
            else {
#pragma unroll
                for (int h = 0; h < 2; ++h) { vaN[h][0] = vaC[h][0]; vaN[h][1] = vaC[h][1]; }
            }
        }
        const char* nA = prob.a_base(nxt); const char* nB = prob.b_base(nxt);
#pragma unroll 1
        for (int t = 0; t < nt; t += 2) {
            const bool last = (t == nt - 2);
            const char* a2 = last ? nA : cA; const char* b2 = last ? nB : cB; const int k2 = last ? 0 : t + 2;
            unsigned va2[2][2];
#pragma unroll
            for (int h = 0; h < 2; ++h) { va2[h][0] = last ? vaN[h][0] : vaC[h][0]; va2[h][1] = last ? vaN[h][1] : vaC[h][1]; }
            G8_LDB(B0, 0, 0); G8_SCHED; G8_LDA(At, 0, 0); G8_STAGEA(G8_SA(1, 1), cA, vaC, 1, t + 1);
            G8_WAIT_L(8); G8_BAR; G8_WAIT_L(0); G8_MMA(0, 0, At, B0); G8_BAR; G8_SCHED;
            G8_LDB(B1, 0, 1); G8_STAGEB(G8_SB(0, 0), b2, 0, k2);
            G8_BAR; G8_WAIT_L(0); G8_MMA(0, 1, At, B1); G8_BAR;
            G8_LDA(At, 0, 1); G8_STAGEA(G8_SA(0, 0), a2, va2, 0, k2);
            G8_BAR; G8_WAIT_L(0); G8_MMA(1, 0, At, B0); G8_BAR; G8_SCHED;
            G8_STAGEB(G8_SB(0, 1), b2, 1, k2);
            G8_WAIT_V(6); G8_BAR; G8_MMA(1, 1, At, B1); G8_BAR;
            G8_LDB(B0, 1, 0); G8_SCHED; G8_LDA(At, 1, 0); G8_STAGEA(G8_SA(0, 1), a2, va2, 1, k2);
            G8_WAIT_L(8); G8_BAR; G8_WAIT_L(0); G8_MMA(0, 0, At, B0); G8_BAR; G8_SCHED;
            G8_LDB(B1, 1, 1); G8_STAGEB(G8_SB(1, 0), b2, 0, k2 + 1);
            G8_BAR; G8_WAIT_L(0); G8_MMA(0, 1, At, B1); G8_BAR;
            G8_LDA(At, 1, 1); G8_STAGEA(G8_SA(1, 0), a2, va2, 0, k2 + 1);
            G8_BAR; G8_WAIT_L(0); G8_MMA(1, 0, At, B0); G8_BAR; G8_SCHED;
            G8_STAGEB(G8_SB(1, 1), b2, 1, k2 + 1);
            G8_WAIT_V(6); G8_BAR; G8_MMA(1, 1, At, B1); G8_BAR;
        }
        { const int l2 = TID512() & 63; prob.epi(acc, cur, wr, wc, l2 & 15, l2 >> 4); }
        if (!has_next) break;
#pragma unroll
        for (int a = 0; a < 2; ++a)
#pragma unroll
            for (int b = 0; b < 2; ++b)
#pragma unroll
                for (int m = 0; m < 4; ++m)
#pragma unroll
                    for (int n = 0; n < 2; ++n) acc[a][b][m][n] = (f32x4){0.f, 0.f, 0.f, 0.f};
        cur = nxt; cA = nA; cB = nB; ++ui;
        if (P::GATHER) {
#pragma unroll
            for (int h = 0; h < 2; ++h) { vaC[h][0] = vaN[h][0]; vaC[h][1] = vaN[h][1]; }
        }
    }
    G8_WAIT_V(0);
    if (wr == 0) G8_BAR;
    G8_BAR;
#undef G8_SA
#undef G8_SB
#undef G8_STAGEA
#undef G8_STAGEB
#undef G8_LDA
#undef G8_LDB
#undef G8_MMA
#undef G8_WAIT_V
#undef G8_WAIT_L
#undef G8_BAR
#undef G8_SCHED
}
}

struct ProbG {
    static constexpr int K = 1024; static constexpr bool PERM = false, GATHER = false;
    KP p; int layer;
    DI bool next(int i, g8::Unit& u) const {
        const int id = i * (int)gridDim.x + BIDX();
        if (id >= 256) return false;
        if (gridDim.x == 256) { const int x = id & 7, y = id >> 3; u.pm = x * 8 + (y >> 2); u.pn = y & 3; } else { u.pm = id >> 2; u.pn = id & 3; }
        u.aux = 0;
        return true;
    }
    DI const char* a_base(const g8::Unit& u) const { return (const char*)(P_hx(p) + (long)u.pm * 256 * DM); }
    DI const char* b_base(const g8::Unit& u) const { return (const char*)(P_wt_out(p) + (long)u.pn * 256 * DM); }
    DI void gather(const g8::Unit&, const int (&)[2], const int (&)[2], unsigned (&)[2][2]) const {}
    DI void epi(g8::Acc& acc, const g8::Unit& u, int wr, int wc, int fr, int fq) const {
        const float* xin = layer == 0 ? p->x : p->out;
        const float* md = P_mod(p) + (layer * 2) * 6144 + 2 * 1024;
#pragma unroll
        for (int bj = 0; bj < 2; ++bj)
#pragma unroll
            for (int n = 0; n < 2; ++n) {
                const int col = u.pn * 256 + bj * 128 + wc * 32 + n * 16 + fq * 4;
                const f32x4 mv = *(const f32x4*)(md + col);
#pragma unroll
                for (int ai = 0; ai < 2; ++ai)
#pragma unroll
                    for (int m = 0; m < 4; ++m) {
                        const long row = (long)u.pm * 256 + ai * 128 + wr * 64 + m * 16 + fr;
                        const f32x4 xv = *(const f32x4*)(xin + row * DM + col);
                        *(f32x4*)(p->out + row * DM + col) = xv + mv * acc[ai][bj][m][n];
                    }
            }
    }
};


constexpr int B_SPARE = 20;
constexpr int CONV_INB = 2560;
struct ProbB {
    static constexpr int K = 1024; static constexpr bool PERM = true, GATHER = false;
    KP p;
    DI bool next(int i, g8::Unit& u) const {
        constexpr int nM = 65, nN = 29, nwg = nM * nN, NX = 8, WGM = 8;
        const int nwork = (int)gridDim.x - B_SPARE;
        if (BIDX() >= nwork) return false;
        const long L = (long)i * nwork + BIDX(); if (L >= nwg) return false;
        int wgid = (int)L; { const int q = nwg / NX, r = nwg % NX, xcd = wgid % NX, off = wgid / NX; wgid = (xcd < r ? xcd * (q + 1) : r * (q + 1) + (xcd - r) * q) + off; }
        const int nig = WGM * nN, gid = wgid / nig, fm = gid * WGM, gsz = (nM - fm) < WGM ? (nM - fm) : WGM;
        u.pm = fm + ((wgid % nig) % gsz); u.pn = (wgid % nig) / gsz; u.aux = 0; return true;
    }
    DI const char* a_base(const g8::Unit& u) const { return (const char*)(P_hx(p) + (long)u.pm * 256 * DM); }
    DI const char* b_base(const g8::Unit& u) const { return (const char*)(P_wt_in(p) + (long)u.pn * 256 * DM); }
    DI void gather(const g8::Unit&, const int (&)[2], const int (&)[2], unsigned (&)[2][2]) const {}
    DI void epi(g8::Acc& acc, const g8::Unit& u, int wr, int wc, int fr, int fq) const {
        const int pn = u.pn;
        const bool lat = u.pm < 64;
        const int rk = !lat ? 0 : (pn < 4) ? 1 : (pn == 8 || pn == 9 || (pn == 10 && wc < 2)) ? 2 : 0;
        const float mul = (pn == 2 || pn == 3) ? 0.08838834764831845f : (pn == 8 || pn == 9 || pn == 11 || pn == 12) ? 0.125f : 1.f;
#pragma unroll
        for (int ai = 0; ai < 2; ++ai)
#pragma unroll
            for (int m = 0; m < 4; ++m) {
                const int row = u.pm * 256 + ai * 128 + wr * 64 + m * 16 + fr;
                if (rk != 0) {
                    const float2* tab;
                    if (rk == 1) tab = P_rope128(p) + ((wc & 1) ? (row & 63) : (row >> 6)) * 32 + fq * 8;
                    else tab = P_rope64(p) + ((fq >= 2) ? (row & 63) : (row >> 6)) * 16 + (fq & 1) * 8;
#pragma unroll
                    for (int n = 0; n < 2; ++n) {
                        const f32x4 c01 = *(const f32x4*)(tab + n * 4), c23 = *(const f32x4*)(tab + n * 4 + 2);
                        const float cs_[4] = {c01[0], c01[2], c23[0], c23[2]}, sn_[4] = {c01[1], c01[3], c23[1], c23[3]};
#pragma unroll
                        for (int e = 0; e < 4; ++e) {
                            const float x1 = acc[ai][0][m][n][e], x2 = acc[ai][1][m][n][e];
                            acc[ai][0][m][n][e] = x1 * cs_[e] - x2 * sn_[e];
                            acc[ai][1][m][n][e] = x1 * sn_[e] + x2 * cs_[e];
                        }
                    }
                }
                u16* orow = P_px(p) + (long)row * INC + pn * 256 + wc * 32 + fq * 8;
#pragma unroll
                for (int bj = 0; bj < 2; ++bj) {
                    u32x4 o;
#pragma unroll
                    for (int n = 0; n < 2; ++n)
#pragma unroll
                        for (int e = 0; e < 2; ++e) o[2 * n + e] = pack2(acc[ai][bj][m][n][2 * e] * mul, acc[ai][bj][m][n][2 * e + 1] * mul);
                    *(u32x4*)(orow + bj * 128) = o;
                }
            }
    }
};
struct ProbF {
    static constexpr int K = 512; static constexpr bool PERM = true, GATHER = false;
    KP p;
    DI bool next(int i, g8::Unit& u) const {
        const int tile = (i / 3) * (int)gridDim.x + BIDX();
        if (tile >= 256) return false;
        if (gridDim.x == 256) { const int x = tile & 7, y = tile >> 3; u.pm = x * 8 + (y >> 2); u.pn = y & 3; } else { u.pm = tile >> 2; u.pn = tile & 3; }
        u.aux = i % 3;
        return true;
    }
    DI const char* a_base(const g8::Unit& u) const { const u16* y = u.aux == 0 ? P_ya(p) : u.aux == 1 ? P_yb(p) : P_yc(p); return (const char*)(y + (long)u.pm * 256 * 512); }
    DI const char* b_base(const g8::Unit& u) const { const u16* w = u.aux == 0 ? P_wt_ret(p) : u.aux == 1 ? P_wt_win(p) : P_wt_na(p); return (const char*)(w + (long)u.pn * 256 * 512); }
    DI void gather(const g8::Unit&, const int (&)[2], const int (&)[2], unsigned (&)[2][2]) const {}
    DI void epi(g8::Acc& acc, const g8::Unit& u, int wr, int wc, int fr, int fq) const {
        const int b = u.aux;
        const long row0 = (long)u.pm * 256 + wr * 64 + fr;
        const int col0 = u.pn * 256 + wc * 32 + fq * 8;
        if (b != 2) {
            u16* z = P_z(p) + (long)b * NLAT * DM;
#pragma unroll
            for (int ai = 0; ai < 2; ++ai)
#pragma unroll
                for (int m = 0; m < 4; ++m)
#pragma unroll
                    for (int bj = 0; bj < 2; ++bj) {
                        u32x4 o;
#pragma unroll
                        for (int n = 0; n < 2; ++n)
#pragma unroll
                            for (int e = 0; e < 2; ++e) o[2 * n + e] = pack2(acc[ai][bj][m][n][2 * e], acc[ai][bj][m][n][2 * e + 1]);
                        *(u32x4*)(z + (row0 + ai * 128 + m * 16) * DM + col0 + bj * 128) = o;
                    }
            return;
        }
        const u16* zb = P_z(p);
        const u16* gp = P_px(p) + C_GATE;
#pragma unroll
        for (int ai = 0; ai < 2; ++ai)
#pragma unroll
            for (int m = 0; m < 4; ++m)
#pragma unroll
                for (int bj = 0; bj < 2; ++bj) {
                    const long row = row0 + ai * 128 + m * 16; const int col = col0 + bj * 128;
                    u32x4 zv[2], gv[3];
#pragma unroll
                    for (int q = 0; q < 2; ++q) zv[q] = *(const u32x4*)(zb + ((long)q * NLAT + row) * DM + col);
#pragma unroll
                    for (int q = 0; q < 3; ++q) gv[q] = *(const u32x4*)(gp + row * INC + q * 1024 + col);
                    u32x4 o;
#pragma unroll
                    for (int e = 0; e < 4; ++e) {
                        const int n = e >> 1, e2 = (e & 1) * 2;
                        float lo = acc[ai][bj][m][n][e2] * sigmoidf_(bflo(gv[2][e])), hi = acc[ai][bj][m][n][e2 + 1] * sigmoidf_(bfhi(gv[2][e]));
#pragma unroll
                        for (int q = 0; q < 2; ++q) { lo += bflo(zv[q][e]) * sigmoidf_(bflo(gv[q][e])); hi += bfhi(zv[q][e]) * sigmoidf_(bfhi(gv[q][e])); }
                        o[e] = pack2(lo, hi);
                    }
                    *(u32x4*)(P_hx(p) + row * DM + col) = o;
                }
    }
};
struct ProbJ {
    static constexpr int K = 1024; static constexpr bool PERM = true, GATHER = true;
    KP p;
    DI bool next(int i, g8::Unit& u) const {
        const int id = i * (int)gridDim.x + BIDX();
        if (id >= 1024) return false;
        if (gridDim.x == 256) {
            const int x = BIDX() & 7, y = BIDX() >> 3;
            u.aux = 4 * i + (x >> 1); u.pm = (x & 1) * 4 + (y >> 3); u.pn = y & 7;
        } else { u.aux = id >> 6; u.pm = (id >> 3) & 7; u.pn = id & 7; }
        return true;
    }
    DI const char* a_base(const g8::Unit&) const { return (const char*)P_hx(p); }
    DI const char* b_base(const g8::Unit& u) const { return (const char*)(P_wt_gu(p) + ((long)u.aux * 2048 + u.pn * 256) * DM); }
    DI void gather(const g8::Unit& u, const int (&R)[2], const int (&C)[2], unsigned (&va)[2][2]) const {
        const int* si = P_sel_idx(p) + u.aux * 2048 + u.pm * 256;
#pragma unroll
        for (int h = 0; h < 2; ++h)
#pragma unroll
            for (int j = 0; j < 2; ++j) va[h][j] = (unsigned)(si[h * 128 + R[j]] * DM + C[j]) * 2u;
    }
    DI void epi(g8::Acc& acc, const g8::Unit& u, int wr, int wc, int fr, int fq) const {
        u16* hb = P_hid(p) + (long)u.aux * 2048 * EH;
#pragma unroll
        for (int ai = 0; ai < 2; ++ai)
#pragma unroll
            for (int m = 0; m < 4; ++m) {
                const int slot = u.pm * 256 + ai * 128 + wr * 64 + m * 16 + fr;
                const int f = u.pn * 128 + wc * 32 + fq * 8;
                u32x4 o;
#pragma unroll
                for (int n = 0; n < 2; ++n)
#pragma unroll
                    for (int e = 0; e < 2; ++e)
                        o[2 * n + e] = pack2(siluf_(acc[ai][0][m][n][2 * e]) * acc[ai][1][m][n][2 * e], siluf_(acc[ai][0][m][n][2 * e + 1]) * acc[ai][1][m][n][2 * e + 1]);
                *(u32x4*)(hb + (long)slot * EH + f) = o;
            }
    }
};
struct ProbK {
    static constexpr int K = 1024; static constexpr bool PERM = true, GATHER = false;
    KP p; int layer;
    DI bool next(int i, g8::Unit& u) const {
        const int id = i * (int)gridDim.x + BIDX();
        if (id >= 512) return false;
        if (gridDim.x == 256) { const int x = BIDX() & 7, y = BIDX() >> 3; u.aux = 8 * i + x; u.pm = y >> 2; u.pn = y & 3; }
        else { u.aux = id >> 5; u.pm = (id >> 2) & 7; u.pn = id & 3; }
        return true;
    }
    DI const char* a_base(const g8::Unit& u) const { return (const char*)(P_hid(p) + ((long)u.aux * 2048 + u.pm * 256) * EH); }
    DI const char* b_base(const g8::Unit& u) const { return (const char*)(P_wt_dn(p) + ((long)u.aux * 1024 + u.pn * 256) * EH); }
    DI void gather(const g8::Unit&, const int (&)[2], const int (&)[2], unsigned (&)[2][2]) const {}
    DI void epi(g8::Acc& acc, const g8::Unit& u, int wr, int wc, int fr, int fq) const {
        const float* md = P_mod(p) + (layer * 2) * 6144 + 5 * 1024;
        f32x4 mv[2][2];
#pragma unroll
        for (int bj = 0; bj < 2; ++bj)
#pragma unroll
            for (int n = 0; n < 2; ++n) mv[bj][n] = *(const f32x4*)(md + u.pn * 256 + bj * 128 + wc * 32 + fq * 8 + n * 4);
#pragma unroll
        for (int ai = 0; ai < 2; ++ai)
#pragma unroll
            for (int m = 0; m < 4; ++m) {
                const int slot = u.aux * 2048 + u.pm * 256 + ai * 128 + wr * 64 + m * 16 + fr;
                const float g = P_sel_gate(p)[slot];
                u16* yr = P_ye(p) + (long)slot * DM + u.pn * 256 + wc * 32 + fq * 8;
#pragma unroll
                for (int bj = 0; bj < 2; ++bj) {
                    u32x4 o;
#pragma unroll
                    for (int n = 0; n < 2; ++n)
#pragma unroll
                        for (int e = 0; e < 2; ++e)
                            o[2 * n + e] = pack2(acc[ai][bj][m][n][2 * e] * g * mv[bj][n][2 * e], acc[ai][bj][m][n][2 * e + 1] * g * mv[bj][n][2 * e + 1]);
                    *(u32x4*)(yr + bj * 128) = o;
                }
            }
    }
};

DI void phH_item(KP p, int layer, int item, char* smem) {
    const int lane = TIDX() & 63, wid = TIDX() >> 6;
    float* hrow = (float*)smem + wid * 4096;
    const int row0 = item * 16 + wid * 4;
    norm_rows4(p, layer, row0, p->g_ffn + layer * DM, 3, 4, false, false, hrow);
    const int e = lane & 15, kp = lane >> 4;
    const float* wr_ = p->w_router + (long)layer * 1024 * 16 + e;
    float lg[4] = {0.f, 0.f, 0.f, 0.f};
#pragma unroll 8
    for (int k = kp * 256; k < kp * 256 + 256; ++k) {
        float w = wr_[k * 16];
#pragma unroll
        for (int r = 0; r < 4; ++r) lg[r] += hrow[r * 1024 + k] * w;
    }
#pragma unroll
    for (int r = 0; r < 4; ++r) {
        float l = lg[r];
        l += __shfl_xor(l, 16); l += __shfl_xor(l, 32);
        float mx = l;
        mx = fmaxf(mx, __shfl_xor(mx, 1)); mx = fmaxf(mx, __shfl_xor(mx, 2)); mx = fmaxf(mx, __shfl_xor(mx, 4)); mx = fmaxf(mx, __shfl_xor(mx, 8));
        float ex = expf(l - mx);
        float sm = ex;
        sm += __shfl_xor(sm, 1); sm += __shfl_xor(sm, 2); sm += __shfl_xor(sm, 4); sm += __shfl_xor(sm, 8);
        float a = ex / sm;
        int row = row0 + r;
        if (lane < 16) {
            if (row < NLAT) P_aff(p)[(long)e * NLAT + row] = a;
            else P_aff(p)[(long)(16 + e) * NLAT + (row - NLAT)] = a;
        }
    }
    __syncthreads();
}

DI int block_excl_scan(int v, int* sh  , int& total) {
    const int lane = TIDX() & 63, wid = TIDX() >> 6;
    int inc = v;
    for (int o = 1; o < 64; o <<= 1) { int t = __shfl_up(inc, o); if (lane >= o) inc += t; }
    __syncthreads();
    if (lane == 63) sh[wid] = inc;
    __syncthreads();
    int base = 0;
    for (int w = 0; w < wid; ++w) base += sh[w];
    total = sh[0] + sh[1] + sh[2] + sh[3];
    return base + inc - v;
}
DI void phI_item(KP p, int job, char* smem) {
    const int tid = TIDX(), lane = tid & 63, wid = tid >> 6;
    const bool lat = job < 16;
    const int n = lat ? NLAT : NCTX, cap = lat ? CAP_LAT : CAP_CTX, rowbase = lat ? 0 : NLAT;
    int* sh = (int*)smem;
    const float* a = P_aff(p) + (long)job * NLAT;
    unsigned keys[64];
    if (lat) {
#pragma unroll
        for (int i = 0; i < 16; ++i) { u32x4 v = *(const u32x4*)(a + tid * 64 + i * 4); keys[4 * i] = v[0]; keys[4 * i + 1] = v[1]; keys[4 * i + 2] = v[2]; keys[4 * i + 3] = v[3]; }
    } else {
#pragma unroll
        for (int i = 0; i < 64; ++i) keys[i] = 0u;
        keys[0] = __float_as_uint(a[tid]);
    }
    __syncthreads();
    auto block_sum = [&](int v, int it) -> int {
        for (int o = 32; o > 0; o >>= 1) v += __shfl_xor(v, o);
        int* slot = sh + (it & 1) * 4;
        if (lane == 0) slot[wid] = v;
        __syncthreads();
        return slot[0] + slot[1] + slot[2] + slot[3];
    };
    int* hist = sh + 32;
    unsigned T = 0u, pmask = 0u; int remaining = cap;
#pragma unroll 1
    for (int pass = 0; pass < 3; ++pass) {
        const int shift = pass == 0 ? 19 : pass == 1 ? 8 : 0, nb_ = pass == 2 ? 256 : 2048;
        for (int i = tid; i < 2048; i += 256) hist[i] = 0;
        __syncthreads();
#pragma unroll
        for (int i = 0; i < 64; ++i) { const unsigned k = keys[i]; if (k != 0u && (k & pmask) == T) atomicAdd(&hist[(k >> shift) & (nb_ - 1)], 1); }
        __syncthreads();
        int mine = 0;
        const int top = nb_ - 1 - 8 * tid;
        if (top >= 7) {
#pragma unroll
            for (int q = 0; q < 8; ++q) mine += hist[top - q];
        }
        int tot_;
        const int above = block_excl_scan(mine, sh + 8, tot_);
        if (top >= 7 && above < remaining && above + mine >= remaining) {
            int cum = above, q = 0;
            for (; q < 7; ++q) { const int hv = hist[top - q]; if (cum + hv >= remaining) break; cum += hv; }
            sh[16] = top - q; sh[17] = remaining - cum;
        }
        __syncthreads();
        T |= ((unsigned)sh[16]) << shift; pmask |= ((unsigned)(nb_ - 1)) << shift; remaining = sh[17];
        __syncthreads();
    }
    int ceq = 0;
#pragma unroll
    for (int i = 0; i < 64; ++i) ceq += (keys[i] == T);
    const int it = 0; (void)it; (void)block_sum;
    __syncthreads();
    int tot;
    int er = block_excl_scan(ceq, sh + 8, tot);
    int csel = 0;
    { int e2 = er;
#pragma unroll
      for (int i = 0; i < 64; ++i) { const unsigned k = keys[i]; if (k > T) ++csel; else if (k == T) { if (e2 < remaining) ++csel; ++e2; } } }
    int slot = block_excl_scan(csel, sh + 8, tot);
    int* ts = P_tslot(p) + (long)job * NLAT;
    const int per = lat ? 64 : 1;
    const int base = tid * per;
#pragma unroll
    for (int i = 0; i < 64; ++i) {
        if (i < per) {
            const unsigned k = keys[i];
            bool sel = false;
            if (k > T) sel = true; else if (k == T) { sel = er < remaining; ++er; }
            if (sel) { P_sel_idx(p)[job * 2048 + slot] = rowbase + base + i; P_sel_gate(p)[job * 2048 + slot] = __uint_as_float(k); ts[base + i] = slot; ++slot; }
            else ts[base + i] = -1;
        }
    }
    __syncthreads();
}

DI void phJ_tile(KP p, int job, int mt, int nt, char* smem) {
    const int tid = TIDX(), lane = tid & 63, wid = tid >> 6, wr = wid >> 1, wc = wid & 1, fr = lane & 15, fq = lane >> 4;
    const int cap = job < 16 ? CAP_LAT : CAP_CTX, e = job & 15;
    f32x4 acc[4][4]; zero_acc<4>(acc);
    const int r0 = tid >> 2, ko = (tid & 3) * 8;
    int s0 = mt * 128 + r0, s1 = s0 + 64;
    s0 = s0 < cap ? s0 : cap - 1; s1 = s1 < cap ? s1 : cap - 1;
    const u16* a0 = P_hx(p) + (long)P_sel_idx(p)[job * 2048 + s0] * DM + ko;
    const u16* a1 = P_hx(p) + (long)P_sel_idx(p)[job * 2048 + s1] * DM + ko;
    const int f_lo = nt * 64 + (r0 & 31), f_hi = f_lo + 32, gu = (r0 >> 5) & 1;
    const u16* b0 = P_wt_gu(p) + ((long)e * 2048 + (f_lo >> 7) * 256 + gu * 128 + (f_lo & 127)) * DM + ko;
    const u16* b1 = P_wt_gu(p) + ((long)e * 2048 + (f_hi >> 7) * 256 + gu * 128 + (f_hi & 127)) * DM + ko;
    gemm_core<32>(acc, a0, a1, b0, b1, smem);
    u16* hb = job < 16 ? P_hid(p) + (long)job * 2048 * EH : P_hidc(p) + (long)(job - 16) * 32 * EH;
#pragma unroll
    for (int m = 0; m < 4; ++m)
#pragma unroll
        for (int n = 0; n < 2; ++n)
#pragma unroll
            for (int j = 0; j < 4; ++j) {
                int slot = mt * 128 + wr * 64 + m * 16 + fq * 4 + j;
                int f = nt * 64 + wc * 32 + n * 16 + fr;
                if (slot < cap) hb[(long)slot * EH + f] = f2bf(siluf_(acc[m][n][j]) * acc[m][n + 2][j]);
            }
}
DI void phK_tile(KP p, int layer, int job, int mt, int nt, char* smem) {
    const int tid = TIDX(), lane = tid & 63, wid = tid >> 6, wr = wid >> 1, wc = wid & 1, fr = lane & 15, fq = lane >> 4;
    const int cap = job < 16 ? CAP_LAT : CAP_CTX, e = job & 15;
    f32x4 acc[4][4]; zero_acc<4>(acc);
    const int r0 = tid >> 2, ko = (tid & 3) * 8;
    int s0 = mt * 128 + r0, s1 = s0 + 64;
    s0 = s0 < cap ? s0 : cap - 1; s1 = s1 < cap ? s1 : cap - 1;
    const u16* hb = job < 16 ? P_hid(p) + (long)job * 2048 * EH : P_hidc(p) + (long)(job - 16) * 32 * EH;
    const u16* a0 = hb + (long)s0 * EH + ko;
    const u16* a1 = hb + (long)s1 * EH + ko;
    const u16* b0 = P_wt_dn(p) + ((long)e * 1024 + nt * 128 + r0) * EH + ko;
    gemm_core<32>(acc, a0, a1, b0, b0 + 64 * EH, smem);
    const float* md = P_mod(p) + (layer * 2 + (job < 16 ? 0 : 1)) * 6144 + 5 * 1024;
    u16* yb_ = job < 16 ? P_ye(p) + (long)job * 2048 * DM : P_yec(p) + (long)(job - 16) * 32 * DM;
#pragma unroll
    for (int m = 0; m < 4; ++m)
#pragma unroll
        for (int j = 0; j < 4; ++j) {
            int slot = mt * 128 + wr * 64 + m * 16 + fq * 4 + j;
            if (slot < cap) {
                float g = P_sel_gate(p)[job * 2048 + slot];
#pragma unroll
                for (int n = 0; n < 4; ++n) {
                    int col = nt * 128 + wc * 64 + n * 16 + fr;
                    yb_[(long)slot * DM + col] = f2bf(acc[m][n][j] * g * md[col]);
                }
            }
        }
}


#define XB_TMO      128
#define XB_XCNT(j)  (256  + 64 * (j))
#define XB_XSUB(j)  (1280 + 64 * (j))
#define XB_XGEN(j)  (2304 + 64 * (j))
#define XB_TOP      3328
#define XB_TOPGEN   3392
#define XCD_BAR_WORDS 3456
#define XB_SPIN_CAP (1u << 18)
DI unsigned xb_ld(unsigned* p)              { return __hip_atomic_load(p, __ATOMIC_RELAXED, __HIP_MEMORY_SCOPE_AGENT); }
DI unsigned xb_add(unsigned* p, unsigned v) { return __hip_atomic_fetch_add(p, v, __ATOMIC_RELAXED, __HIP_MEMORY_SCOPE_AGENT); }
DI unsigned xb_xcc_id() { return (unsigned)__builtin_amdgcn_s_getreg((3 << 11) | 20) & 0xFu; }
#define XB_SPIN(cond, bar) do { unsigned _sp = 0; while (cond) { __builtin_amdgcn_s_sleep(1); \
    if ((++_sp & 255u) == 0u) { if (xb_ld(&(bar)[XB_TMO])) break; if (_sp > XB_SPIN_CAP) { atomicAdd(&(bar)[XB_TMO], 1u); break; } } } } while (0)
struct XcdBarrier { unsigned* bar; unsigned x; volatile LAS unsigned* st; };
DI XcdBarrier xcd_barrier_post(unsigned* bar, volatile LAS unsigned* st) {
    XcdBarrier b; b.bar = bar; b.x = xb_xcc_id(); b.st = st;
    if (threadIdx.x == 0) (void)xb_add(&bar[XB_XCNT(b.x)], 1u);
    return b;
}
DI void xcd_barrier_complete(unsigned* bar, unsigned x, unsigned& nloc, unsigned& nx) {
    const unsigned G = gridDim.x * gridDim.y * gridDim.z;
    unsigned sum, cnt, mine, sp = 0u;
    for (;;) {
        sum = 0u; cnt = 0u; mine = 0u;
#pragma unroll
        for (unsigned j = 0; j < 16; ++j) { const unsigned c = xb_ld(&bar[XB_XCNT(j)]); sum += c; cnt += (c > 0u) ? 1u : 0u; mine = (j == x) ? c : mine; }
        if (sum == G) break;
        __builtin_amdgcn_s_sleep(1);
        if ((++sp & 255u) == 0u) { if (xb_ld(&bar[XB_TMO])) break; if (sp > XB_SPIN_CAP) { atomicAdd(&bar[XB_TMO], 1u); break; } }
    }
    nloc = mine > 0u ? mine : 1u; nx = cnt > 0u ? cnt : 1u;
}
DI void xcd_barrier(const XcdBarrier& b) {
    asm volatile("s_waitcnt vmcnt(0)" ::: "memory");
    __syncthreads();
    if (threadIdx.x == 0) {
        unsigned* bar = b.bar;
        __builtin_amdgcn_s_waitcnt(0);
        unsigned nloc = b.st[0], nx = b.st[1];
        if (nloc == 0u) { xcd_barrier_complete(bar, b.x, nloc, nx); b.st[0] = nloc; b.st[1] = nx; }
        const unsigned old = xb_add(&bar[XB_XSUB(b.x)], 1u);
        const unsigned gen = old / nloc;
        if (old + 1u == (gen + 1u) * nloc) {
            __builtin_amdgcn_fence(__ATOMIC_RELEASE, "agent");
            asm volatile("s_waitcnt vmcnt(0)" ::: "memory");
            const unsigned og = xb_add(&bar[XB_TOP], 1u);
            const unsigned tg = og / nx;
            if (og + 1u == (tg + 1u) * nx) xb_add(&bar[XB_TOPGEN], 1u);
            else XB_SPIN(xb_ld(&bar[XB_TOPGEN]) == tg, bar);
            __builtin_amdgcn_fence(__ATOMIC_ACQUIRE, "agent");
            xb_add(&bar[XB_XGEN(b.x)], 1u);
            asm volatile("s_waitcnt vmcnt(0)" ::: "memory");
        } else {
            XB_SPIN(xb_ld(&bar[XB_XGEN(b.x)]) == gen, bar);
            __builtin_amdgcn_fence(__ATOMIC_ACQUIRE, "agent");
            asm volatile("s_waitcnt vmcnt(0)" ::: "memory");
        }
    }
    __syncthreads();
}

DI void run_phase(int ph, char* smem_all, int variant = 0) {
    KP p = (KP)__builtin_amdgcn_kernarg_segment_ptr();
    asm volatile("" : "+s"(p));
    const int sb = TID512() >> 8;
    char* smem = smem_all + sb * SUB_LDS;
    const int bid = BIDX() * 2 + sb, nb = gridDim.x * 2, tid = TIDX(), wid = tid >> 6;
#ifndef ONLY_SUB
    if (ph == 0) {
        for (int it = bid; it < 240; it += nb) {
            if (it < 192) ph0_gemv_item(p, it, smem);
            else ph0_rope_item(p, it - 192);
        }
        convert_tiles(p, 0, bid, CONV_DENSE, nb, smem);
        return;
    }
    if (ph == NPHASE - 1) {
        for (int it = bid; it < NLAT / 16; it += nb) {
            const int row0 = it * 16 + wid * 4, lane = tid & 63;
            float4 v[4][4];
#pragma unroll
            for (int r = 0; r < 4; ++r)
#pragma unroll
                for (int i = 0; i < 4; ++i) v[r][i] = *(const float4*)(p->out + (long)(row0 + r) * DM + i * 256 + lane * 4);
            float4 g[4];
#pragma unroll
            for (int i = 0; i < 4; ++i) g[i] = *(const float4*)(p->g_final + i * 256 + lane * 4);
#pragma unroll
            for (int r = 0; r < 4; ++r) {
                moe_combine(p, row0 + r, v[r]);
                float ss = 0.f;
#pragma unroll
                for (int i = 0; i < 4; ++i) ss += v[r][i].x * v[r][i].x + v[r][i].y * v[r][i].y + v[r][i].z * v[r][i].z + v[r][i].w * v[r][i].w;
                ss = wave_sum(ss);
                const float rstd = rsqrtf(ss * (1.f / DM) + 1e-6f);
                float* xr = p->out + (long)(row0 + r) * DM;
#pragma unroll
                for (int i = 0; i < 4; ++i)
                    *(float4*)(xr + i * 256 + lane * 4) = make_float4(v[r][i].x * rstd * g[i].x, v[r][i].y * rstd * g[i].y, v[r][i].z * rstd * g[i].z, v[r][i].w * rstd * g[i].w);
            }
        }
        return;
    }
    const int layer = (ph - 1) / 11, sub = (ph - 1) % 11;
#else
    const int layer = (ph - 1) / 11, sub = ONLY_SUB;
#endif
    const bool need_ctx = layer == 0;
    switch (sub) {
    case 0: {
        const int nrow_items = NROWS / 16;
        for (int it = bid; it < nrow_items; it += nb) norm_rows4(p, layer, it * 16 + wid * 4, p->g_mix + layer * DM, 0, 1, layer == 0, layer == 1);
        if (layer == 1) convert_tiles(p, layer, bid, CONV_DENSE, nb, smem);
    } break;
    case 1: {
        { ProbB pb{p}; g8::gemm_phase((LAS unsigned char*)smem_all, pb); }
        const int nwork = (int)gridDim.x - B_SPARE;
        if (BIDX() >= nwork) {
            const int sb2 = TID512() >> 8, q = (BIDX() - nwork) * 2 + sb2;
            convert_tiles4(p, layer, CONV_DENSE + q, CONV_DENSE + CONV_INB, 2 * B_SPARE, smem_all + sb2 * SUB_LDS);
        }
    } break;
    case 2: {
        const int n_state = NCHUNK * 8, n_win = 1024, n_na = 1024, n_cx = need_ctx ? 32 : 0;
        const int total = n_state + n_win + n_na + n_cx;
        for (int it = bid; it < total; it += nb) {
            if (variant == 1 && it >= n_na && it < n_na + n_win) continue;
            if (variant == 1 && it >= n_na + n_win) continue;
            if (variant == 2 && (it < n_na || it >= n_na + n_win)) continue;
            if (variant == 3 && (it < n_na + n_win || it >= n_na + n_win + n_state)) continue;
            if (it < n_na) attn_block_item(p, layer, 1, it >> 3, it & 7, smem);
            else if (it < n_na + n_win) { int i2 = it - n_na; attn_block_item(p, layer, 0, i2 >> 1, i2 & 1, smem); }
            else if (it < n_win + n_na + n_state) { int i2 = it - n_win - n_na; phC_state_item(p, layer, i2 >> 3, (i2 >> 1) & 3, i2 & 1, smem); }
            else { int i2 = it - n_win - n_na - n_state; if (i2 < 16) attn_block_item(p, layer, 2, i2 >> 1, i2 & 1, smem); else { i2 -= 16; attn_block_item(p, layer, 3, i2 >> 3, i2 & 7, smem); } }
        }
    } break;
    case 3: {
        for (int it = bid; it < 512; it += nb) phD_item(p, layer, it);
    } break;
    case 4: {
        const int nch = need_ctx ? NCHUNK : 128;
        for (int it = bid; it < nch * 8; it += nb) phE_item(p, layer, it >> 3, (it >> 1) & 3, it & 1, smem);
        if (need_ctx && bid >= nb - 64) {
            float* z = P_maccx(p) + (long)(bid - (nb - 64)) * 4096 + tid * 16;
#pragma unroll
            for (int i = 0; i < 4; ++i) *(f32x4*)(z + i * 4) = f32x4{0.f, 0.f, 0.f, 0.f};
        }
    } break;
    case 5: {
        { ProbF pf{p}; g8::gemm_phase((LAS unsigned char*)smem_all, pf); }
        if (need_ctx) {
            const int sb2 = TID512() >> 8;
            for (int it = BIDX() * 2 + sb2; it < 384; it += (int)gridDim.x * 2) { const int tb = it >> 3, tile = tb / 3; phF_tile(p, 128 + (tile >> 3), tile & 7, tb % 3, it & 7, smem_all + sb2 * SUB_LDS); }
        }
    } break;
    case 6: {
        { ProbG pg{p, layer}; g8::gemm_phase((LAS unsigned char*)smem_all, pg); }
        if (need_ctx) {
            const int sb2 = TID512() >> 8;
            for (int it = BIDX() * 2 + sb2; it < 512; it += (int)gridDim.x * 2) { const int tile = it >> 5; phG_tile(p, layer, 128 + (tile >> 3), tile & 7, it & 31, smem_all + sb2 * SUB_LDS); }
        }
    } break;
    case 7: {
        const int nit = (need_ctx ? NROWS : NLAT) / 16;
        for (int it = bid; it < nit; it += nb) phH_item(p, layer, it, smem);
    } break;
    case 8: {
        const int njob = need_ctx ? 32 : 16;
        for (int it = bid; it < njob; it += nb) phI_item(p, it, smem);
        convert_tiles(p, layer, CONV_DENSE + CONV_INB + bid, CONV_TILES, nb, smem);
    } break;
    case 9: {
        { ProbJ pj{p}; g8::gemm_phase((LAS unsigned char*)smem_all, pj); }
        if (need_ctx) {
            const int sb2 = TID512() >> 8;
            for (int it = BIDX() * 2 + sb2; it < 256; it += (int)gridDim.x * 2) phJ_tile(p, 16 + (it >> 4), 0, it & 15, smem_all + sb2 * SUB_LDS);
        }
    } break;
    case 10: {
        { ProbK pk{p, layer}; g8::gemm_phase((LAS unsigned char*)smem_all, pk); }
        if (need_ctx) {
            const int sb2 = TID512() >> 8;
            for (int it = BIDX() * 2 + sb2; it < 128; it += (int)gridDim.x * 2) phK_tile(p, layer, 16 + (it >> 3), 0, it & 7, smem_all + sb2 * SUB_LDS);
        }
    } break;
    }
}

__global__ void __launch_bounds__(NTHREADS, 2) mega_kernel(Params p, int ph_lo, int ph_hi) {
    __shared__ __attribute__((aligned(16))) char smem[LDS_BYTES + 16];
    cg::grid_group grid = cg::this_grid();
#if MK_MULTI
    for (int ph = ph_lo; ph < ph_hi; ++ph) {
        if (ph > ph_lo) grid.sync();
        run_phase(ph, smem);
    }
#else
    unsigned* barw = (unsigned*)(p.ws + WS_BAR);
    volatile LAS unsigned* xst = (volatile LAS unsigned*)(LAS char*)(smem + LDS_BYTES);
    if (threadIdx.x < 4) xst[threadIdx.x] = 0u;
    if (blockIdx.x == 0) for (int i = threadIdx.x; i < XCD_BAR_WORDS; i += NTHREADS) barw[i] = 0u;
    run_phase(0, smem);
    grid.sync();
    const XcdBarrier xb = xcd_barrier_post(barw, xst);
#ifdef PROBE_SUB
#define PH(n) do { if ((n) > 1) xcd_barrier(xb); run_phase((n), smem); if ((n) >= PROBE_MIN && (n) <= PROBE_MAX && (((n) - 1) % 11) == PROBE_SUB) { xcd_barrier(xb); run_phase((n), smem, PROBE_VARIANT); } } while (0)
#else
#define PH(n) do { if ((n) > 1) xcd_barrier(xb); run_phase((n), smem); } while (0)
#endif
    PH(1); PH(2); PH(3); PH(4); PH(5); PH(6); PH(7); PH(8); PH(9); PH(10); PH(11);
    PH(12); PH(13); PH(14); PH(15); PH(16); PH(17); PH(18); PH(19); PH(20); PH(21); PH(22); PH(23);
    static_assert(NPHASE == 24, "phase program");
#undef PH
#endif
}

extern "C" void kernel_launch(void* const* d_in, const int* in_sizes, int n_in, void* d_out, int out_size, void* d_ws, size_t ws_size,
                              hipStream_t stream) {
    static int grid_blocks = 0;
    if (!grid_blocks) {
        int dev = 0, cus = 0, per_cu = 0;
        hipGetDevice(&dev);
        hipDeviceGetAttribute(&cus, hipDeviceAttributeMultiprocessorCount, dev);
        hipOccupancyMaxActiveBlocksPerMultiprocessor(&per_cu, mega_kernel, NTHREADS, 0);
        if (per_cu < 1) per_cu = 1;
        if (per_cu > 1) per_cu = 1;
        grid_blocks = cus * per_cu;
    }
    Params p{};
    const float** ip = (const float**)&p.x;
    for (int i = 0; i < 22; ++i) ip[i] = (const float*)d_in[i];
    p.out = (float*)d_out;
    p.ws = (char*)d_ws;
    if (WS_END > ws_size) { fprintf(stderr, "kernel_launch: workspace too small: need %zu have %zu\n", (size_t)WS_END, ws_size); return; }
#if MK_MULTI
    for (int ph = 0; ph < NPHASE; ++ph) {
        hipLaunchKernelGGL(mega_kernel, dim3(grid_blocks), dim3(NTHREADS), 0, stream, p, ph, ph + 1);
    }
#else
    int lo = 0, hi = NPHASE;
    void* args[] = {&p, &lo, &hi};
    hipError_t e = hipLaunchCooperativeKernel((void*)mega_kernel, dim3(grid_blocks), dim3(NTHREADS), args, 0, stream);
    if (e != hipSuccess) fprintf(stderr, "cooperative launch failed: %s (grid %d)\n", hipGetErrorString(e), grid_blocks);
#endif
}
```

```cpp
#include <hip/hip_runtime.h>
#include <hip/hip_bf16.h>
#include <hip/hip_cooperative_groups.h>
#include <cstdio>
#include <cstdint>
namespace cg = cooperative_groups;

#ifndef MK_MULTI
#define MK_MULTI 0
#endif

#define DI __device__ __forceinline__
typedef unsigned short u16;
typedef __attribute__((ext_vector_type(8))) short bf16x8;
typedef __attribute__((ext_vector_type(4))) float f32x4;
typedef __attribute__((ext_vector_type(4))) unsigned int u32x4;

constexpr int NLAT = 16384, NCTX = 256, NROWS = NLAT + NCTX, DM = 1024, INC = 7424;
constexpr int C_QR = 0, C_KR = 512, C_VR = 1024, C_GR = 1536, C_QW = 2048, C_KW = 2560, C_VW = 2688, C_QN = 2816, C_KN = 3328, C_VN = 3840, C_GATE = 4352;
__host__ __device__ constexpr int col_qr(int h, int x) { return C_QR + (h >> 1) * 256 + x * 128 + (h & 1) * 64; }
__host__ __device__ constexpr int col_kr(int h, int x) { return C_KR + (h >> 1) * 256 + x * 128 + (h & 1) * 64; }
__host__ __device__ constexpr int col_qw(int h, int x) { return C_QW + (h >> 2) * 256 + x * 128 + (h & 3) * 32; }
__host__ __device__ constexpr int col_kw(int kh, int x) { return C_KW + x * 128 + kh * 32; }
__host__ __device__ constexpr int col_vw(int kh) { return C_KW + 64 + kh * 128; }
constexpr int NCHUNK = NROWS / 128;
constexpr int NEXP = 16, EH = 1024, CAP_LAT = 2048, CAP_CTX = 32;
constexpr int NTHREADS = 512;
constexpr int SUB_LDS = 76 * 1024;
constexpr int LDS_BYTES = 2 * SUB_LDS;
constexpr int NPHASE = 24;


constexpr size_t al256(size_t b) { return (b + 255) & ~(size_t)255; }
constexpr size_t WS_CTXRES = 0;
constexpr size_t WS_MOD = WS_CTXRES + al256((size_t)NCTX * DM * 4);
constexpr size_t WS_ROPE128 = WS_MOD + al256(2 * 2 * 6144 * 4);
constexpr size_t WS_ROPE64 = WS_ROPE128 + al256(256 * 32 * 8);
constexpr size_t WS_WT_IN = WS_ROPE64 + al256(256 * 16 * 8);
constexpr size_t WS_WT_RET = WS_WT_IN + al256((size_t)INC * DM * 2);
constexpr size_t WS_WT_WIN = WS_WT_RET + al256((size_t)1024 * 512 * 2);
constexpr size_t WS_WT_NA = WS_WT_WIN + al256((size_t)1024 * 512 * 2);
constexpr size_t WS_WT_OUT = WS_WT_NA + al256((size_t)1024 * 512 * 2);
constexpr size_t WS_WT_GU = WS_WT_OUT + al256((size_t)1024 * 1024 * 2);
constexpr size_t WS_WT_DN = WS_WT_GU + al256((size_t)NEXP * 2048 * 1024 * 2);
constexpr size_t WS_HX = WS_WT_DN + al256((size_t)NEXP * 1024 * 1024 * 2);
constexpr size_t WS_PX = WS_HX + al256((size_t)NROWS * DM * 2);
constexpr size_t WS_YA = WS_PX + al256((size_t)NROWS * INC * 2);
constexpr size_t WS_YB = WS_YA + al256((size_t)NROWS * 512 * 2);
constexpr size_t WS_YC = WS_YB + al256((size_t)NROWS * 512 * 2);
constexpr size_t WS_S = WS_YC + al256((size_t)NROWS * 512 * 2);
constexpr size_t WS_R = WS_S + al256((size_t)NCHUNK * 8 * 16384 * 4);
constexpr size_t WS_AFF = WS_R + al256((size_t)NCHUNK * 8 * 16384 * 2);
constexpr size_t WS_SELI = WS_AFF + al256((size_t)32 * NLAT * 4);
constexpr size_t WS_SELG = WS_SELI + al256(32 * 2048 * 4);
constexpr size_t WS_TSLOT = WS_SELG + al256(32 * 2048 * 4);
constexpr size_t WS_BAR = WS_TSLOT + al256((size_t)32 * NLAT * 4);
constexpr size_t WS_MACCX = WS_BAR + al256(3456 * 4);
constexpr size_t WS_XRES = WS_MACCX + al256((size_t)NCTX * DM * 4);
constexpr size_t WS_END = WS_XRES + al256((size_t)NLAT * DM * 2);
struct Params {
    const float *x, *c, *ctx, *c_ctx, *w_mod, *b_mod, *g_mix, *g_ffn, *w_in, *decay, *ret_gn, *w_ret, *sink, *w_win, *rpb, *w_na, *w_out,
        *w_router, *w_eg, *w_eu, *w_ed, *g_final;
    float* out;
    char* ws;
};
typedef const Params __attribute__((address_space(4)))* KP;
#define WSF(name, type, off) __device__ __forceinline__ type* P_##name(KP p) { return (type*)(p->ws + (off)); }
WSF(ctxres, float, WS_CTXRES)
WSF(mod, float, WS_MOD)
WSF(rope128, float2, WS_ROPE128)
WSF(rope64, float2, WS_ROPE64)
WSF(wt_in, u16, WS_WT_IN) WSF(wt_ret, u16, WS_WT_RET) WSF(wt_win, u16, WS_WT_WIN) WSF(wt_na, u16, WS_WT_NA) WSF(wt_out, u16, WS_WT_OUT)
WSF(wt_gu, u16, WS_WT_GU) WSF(wt_dn, u16, WS_WT_DN)
WSF(hx, u16, WS_HX)
WSF(px, u16, WS_PX)
WSF(ya, u16, WS_YA) WSF(yb, u16, WS_YB) WSF(yc, u16, WS_YC)
WSF(S, float, WS_S)
WSF(R, u16, WS_R)
WSF(aff, float, WS_AFF)
WSF(sel_idx, int, WS_SELI) WSF(sel_gate, float, WS_SELG)
WSF(hid, u16, WS_PX)
__device__ __forceinline__ u16* P_hidc(KP p) { return (u16*)(p->ws + WS_PX) + (size_t)NEXP * 2048 * 1024; }
__device__ __forceinline__ u16* P_ye(KP p) { return (u16*)(p->ws + WS_PX) + (size_t)NEXP * (2048 + 32) * 1024; }
__device__ __forceinline__ u16* P_yec(KP p) { return P_ye(p) + (size_t)NEXP * 2048 * 1024; }
__device__ __forceinline__ int* P_tslot(KP p) { return (int*)(p->ws + WS_TSLOT); }
__device__ __forceinline__ u16* P_z(KP p) { return (u16*)(p->ws + WS_S); }
__device__ __forceinline__ float* P_maccx(KP p) { return (float*)(p->ws + WS_MACCX); }
__device__ __forceinline__ u16* P_xres(KP p) { return (u16*)(p->ws + WS_XRES); }
#undef WSF


DI int TIDX() { int t = threadIdx.x & 255; asm volatile("" : "+v"(t)); return t; }
DI int TID512() { int t = threadIdx.x; asm volatile("" : "+v"(t)); return t; }
DI int BIDX() { int t = blockIdx.x; asm volatile("" : "+s"(t)); return t; }
DI u16 f2bf(float x) { unsigned u = __float_as_uint(x); u += 0x7fffu + ((u >> 16) & 1u); return (u16)(u >> 16); }
DI float bf2f(u16 h) { return __uint_as_float(((unsigned)h) << 16); }
DI float bflo(unsigned w) { return __uint_as_float(w << 16); }
DI float bfhi(unsigned w) { return __uint_as_float(w & 0xffff0000u); }
typedef __bf16 bf16v2 __attribute__((ext_vector_type(2)));
typedef float f32v2 __attribute__((ext_vector_type(2)));
DI unsigned pack2(float a, float b) { f32v2 v = {a, b}; bf16v2 r = __builtin_convertvector(v, bf16v2); return __builtin_bit_cast(unsigned, r); }
DI float sigmoidf_(float x) { return 1.f / (1.f + __expf(-x)); }
DI float siluf_(float x) { return x / (1.f + __expf(-x)); }
DI float wave_sum(float v) { for (int o = 32; o > 0; o >>= 1) v += __shfl_xor(v, o); return v; }
#define MFMA16(a, b, c) __builtin_amdgcn_mfma_f32_16x16x32_bf16((a), (b), (c), 0, 0, 0)

template <int MR>
DI void zero_acc(f32x4 (&acc)[MR][4]) {
#pragma unroll
    for (int m = 0; m < MR; ++m)
#pragma unroll
        for (int n = 0; n < 4; ++n) acc[m][n] = f32x4{0.f, 0.f, 0.f, 0.f};
}

template <int KT>
DI void gemm_core(f32x4 (&acc)[4][4], const u16* a0, const u16* a1, const u16* b0, const u16* b1, char* smem) {
    const int tid = TIDX(), lane = tid & 63, wid = tid >> 6, wr = wid >> 1, wc = wid & 1, fr = lane & 15, fq = lane >> 4;
    auto stage = [&](int kt, int buf) {
        char* base = smem + buf * 16384;
        __builtin_amdgcn_global_load_lds((const unsigned*)(a0 + kt * 32), (unsigned*)(base + tid * 16), 16, 0, 0);
        __builtin_amdgcn_global_load_lds((const unsigned*)(a1 + kt * 32), (unsigned*)(base + 4096 + tid * 16), 16, 0, 0);
        __builtin_amdgcn_global_load_lds((const unsigned*)(b0 + kt * 32), (unsigned*)(base + 8192 + tid * 16), 16, 0, 0);
        __builtin_amdgcn_global_load_lds((const unsigned*)(b1 + kt * 32), (unsigned*)(base + 12288 + tid * 16), 16, 0, 0);
    };
    __syncthreads();
    stage(0, 0);
#pragma unroll 1
    for (int kt = 0; kt < KT; ++kt) {
        asm volatile("s_waitcnt vmcnt(0)" ::: "memory");
        __syncthreads();
        if (kt + 1 < KT) stage(kt + 1, (kt + 1) & 1);
        const char* SA = smem + (kt & 1) * 16384;
        const char* SB = SA + 8192;
        bf16x8 At[4], Bt[4];
#pragma unroll
        for (int m = 0; m < 4; ++m) At[m] = *(const bf16x8*)(SA + (wr * 64 + m * 16 + fr) * 64 + fq * 16);
#pragma unroll
        for (int n = 0; n < 4; ++n) Bt[n] = *(const bf16x8*)(SB + (wc * 64 + n * 16 + fr) * 64 + fq * 16);
#pragma unroll
        for (int m = 0; m < 4; ++m)
#pragma unroll
            for (int n = 0; n < 4; ++n) acc[m][n] = MFMA16(At[m], Bt[n], acc[m][n]);
    }
}

template <int KT>
DI void gemm_core_af32(f32x4 (&acc)[4][4], const float* a0f, const float* a1f, const u16* b0, const u16* b1, char* smem) {
    const int tid = TIDX(), lane = tid & 63, wid = tid >> 6, wr = wid >> 1, wc = wid & 1, fr = lane & 15, fq = lane >> 4;
    f32x4 ar[4];
    auto loadA = [&](int kt) { ar[0] = *(const f32x4*)(a0f + kt * 32); ar[1] = *(const f32x4*)(a0f + kt * 32 + 4); ar[2] = *(const f32x4*)(a1f + kt * 32); ar[3] = *(const f32x4*)(a1f + kt * 32 + 4); };
    auto storeA = [&](int buf) {
        char* base = smem + buf * 16384;
        u32x4 w0, w1;
        w0[0] = pack2(ar[0][0], ar[0][1]); w0[1] = pack2(ar[0][2], ar[0][3]); w0[2] = pack2(ar[1][0], ar[1][1]); w0[3] = pack2(ar[1][2], ar[1][3]);
        w1[0] = pack2(ar[2][0], ar[2][1]); w1[1] = pack2(ar[2][2], ar[2][3]); w1[2] = pack2(ar[3][0], ar[3][1]); w1[3] = pack2(ar[3][2], ar[3][3]);
        *(u32x4*)(base + tid * 16) = w0; *(u32x4*)(base + 4096 + tid * 16) = w1;
    };
    auto stageB = [&](int kt, int buf) {
        char* base = smem + buf * 16384;
        __builtin_amdgcn_global_load_lds((const unsigned*)(b0 + kt * 32), (unsigned*)(base + 8192 + tid * 16), 16, 0, 0);
        __builtin_amdgcn_global_load_lds((const unsigned*)(b1 + kt * 32), (unsigned*)(base + 12288 + tid * 16), 16, 0, 0);
    };
    __syncthreads();
    loadA(0); stageB(0, 0); storeA(0);
#pragma unroll 1
    for (int kt = 0; kt < KT; ++kt) {
        asm volatile("s_waitcnt vmcnt(0)" ::: "memory");
        __syncthreads();
        if (kt + 1 < KT) { loadA(kt + 1); stageB(kt + 1, (kt + 1) & 1); }
        const char* SA = smem + (kt & 1) * 16384;
        const char* SB = SA + 8192;
        bf16x8 At[4], Bt[4];
#pragma unroll
        for (int m = 0; m < 4; ++m) At[m] = *(const bf16x8*)(SA + (wr * 64 + m * 16 + fr) * 64 + fq * 16);
#pragma unroll
        for (int n = 0; n < 4; ++n) Bt[n] = *(const bf16x8*)(SB + (wc * 64 + n * 16 + fr) * 64 + fq * 16);
#pragma unroll
        for (int m = 0; m < 4; ++m)
#pragma unroll
            for (int n = 0; n < 4; ++n) acc[m][n] = MFMA16(At[m], Bt[n], acc[m][n]);
        if (kt + 1 < KT) storeA((kt + 1) & 1);
    }
}

template <int MR>
DI void mma_lds64(f32x4 (&acc)[MR][4], const u16* As, int lda, const u16* Bs, int ldb) {
    const int tid = TIDX(), lane = tid & 63, wid = tid >> 6, wr = wid >> 1, wc = wid & 1, fr = lane & 15, fq = lane >> 4;
#pragma unroll
    for (int kk = 0; kk < 2; ++kk) {
        bf16x8 At[MR], Bt[4];
#pragma unroll
        for (int m = 0; m < MR; ++m) At[m] = *(const bf16x8*)(As + (wr * (MR * 16) + m * 16 + fr) * lda + kk * 32 + fq * 8);
#pragma unroll
        for (int n = 0; n < 4; ++n) Bt[n] = *(const bf16x8*)(Bs + (wc * 64 + n * 16 + fr) * ldb + kk * 32 + fq * 8);
#pragma unroll
        for (int m = 0; m < MR; ++m)
#pragma unroll
            for (int n = 0; n < 4; ++n) acc[m][n] = MFMA16(At[m], Bt[n], acc[m][n]);
    }
}
typedef short v4s_ __attribute__((ext_vector_type(4)));
typedef __attribute__((address_space(3))) v4s_* lds_v4s_ptr_;
DI bf16x8 frag_tr(const u16* M, int ld, int k0, int c0) {
    const int lane = TIDX() & 63, i = lane & 15, g = lane >> 4;
    const u16* a = M + (k0 + 8 * g + (i >> 2)) * ld + c0 + 4 * (i & 3);
    v4s_ lo = __builtin_amdgcn_ds_read_tr16_b64_v4i16((lds_v4s_ptr_)a);
    v4s_ hi = __builtin_amdgcn_ds_read_tr16_b64_v4i16((lds_v4s_ptr_)(a + 4 * ld));
    return __builtin_shufflevector(lo, hi, 0, 1, 2, 3, 4, 5, 6, 7);
}
template <int MR>
DI void mma_lds64_btr(f32x4 (&acc)[MR][4], const u16* As, int lda, const u16* Bm, int ldb) {
    const int tid = TIDX(), lane = tid & 63, wid = tid >> 6, wr = wid >> 1, wc = wid & 1, fr = lane & 15, fq = lane >> 4;
#pragma unroll
    for (int kk = 0; kk < 2; ++kk) {
        bf16x8 At[MR], Bt[4];
#pragma unroll
        for (int m = 0; m < MR; ++m) At[m] = *(const bf16x8*)(As + (wr * (MR * 16) + m * 16 + fr) * lda + kk * 32 + fq * 8);
#pragma unroll
        for (int n = 0; n < 4; ++n) Bt[n] = frag_tr(Bm, ldb, kk * 32, wc * 64 + n * 16);
#pragma unroll
        for (int m = 0; m < MR; ++m)
#pragma unroll
            for (int n = 0; n < 4; ++n) acc[m][n] = MFMA16(At[m], Bt[n], acc[m][n]);
    }
}
template <int MR>
DI void mma_lds64_tt(f32x4 (&acc)[MR][4], const u16* Am, int lda, const u16* Bm, int ldb) {
    const int tid = TIDX(), wid = tid >> 6, wr = wid >> 1, wc = wid & 1;
#pragma unroll
    for (int kk = 0; kk < 2; ++kk) {
        bf16x8 At[MR], Bt[4];
#pragma unroll
        for (int m = 0; m < MR; ++m) At[m] = frag_tr(Am, lda, kk * 32, wr * (MR * 16) + m * 16);
#pragma unroll
        for (int n = 0; n < 4; ++n) Bt[n] = frag_tr(Bm, ldb, kk * 32, wc * 64 + n * 16);
#pragma unroll
        for (int m = 0; m < MR; ++m)
#pragma unroll
            for (int n = 0; n < 4; ++n) acc[m][n] = MFMA16(At[m], Bt[n], acc[m][n]);
    }
}
template <bool SCALE, int NCH>
DI void stage_rows64(u16* dst, int ld, const u16* src0, const u16* src1, long sstride, float z0  , float zstep_unused) {
    const int tid = TIDX();
#pragma unroll
    for (int i = 0; i < NCH / 4; ++i) {
        const int idx = i * 256 + tid, row = idx / NCH, ch = idx % NCH;
        u32x4 v = *(const u32x4*)((ch < 8 ? src0 + ch * 8 : src1 + (ch - 8) * 8) + (long)row * sstride);
        *(u32x4*)(dst + row * ld + ch * 8) = v;
    }
}
template <int ROWS>
DI void stage_n64(u16* dst, int ld, const u16* src, long sstride) {
    const int tid = TIDX();
#pragma unroll
    for (int i = 0; i < ROWS / 32; ++i) {
        int idx = i * 256 + tid, row = idx >> 3, ch = idx & 7;
        u32x4 v = *(const u32x4*)(src + (long)row * sstride + ch * 8);
        *(u32x4*)(dst + row * ld + ch * 8) = v;
    }
}
template <bool SCALE, int NF>
DI void stage_t64(u16* dst, int ld, const u16* src, long sstride, float scale_tok_lane  ) {
    const int tid = TIDX();
#pragma unroll
    for (int i = 0; i < NF / 32; ++i) {
        int idx = i * 256 + tid, jj = idx & 63, ch = idx >> 6;
        u32x4 v = *(const u32x4*)(src + (long)jj * sstride + ch * 8);
#pragma unroll
        for (int e = 0; e < 4; ++e) {
            float lo = bflo(v[e]), hi = bfhi(v[e]);
            if (SCALE) { lo *= scale_tok_lane; hi *= scale_tok_lane; }
            dst[(ch * 8 + 2 * e) * ld + jj] = SCALE ? f2bf(lo) : (u16)(v[e] & 0xffffu);
            dst[(ch * 8 + 2 * e + 1) * ld + jj] = SCALE ? f2bf(hi) : (u16)(v[e] >> 16);
        }
    }
}

DI void convert_tile(KP p, int layer, int tile, char* smem);

DI void ph0_gemv_item(KP p, int item, char* smem) {
    const int tid = TIDX();
    const int l = item / 96, cg_ = item % 96;
    float* sl = (float*)smem;
    float* red = (float*)(smem + 8192);
    __syncthreads();
    for (int k = tid; k < 1024; k += 256) { sl[k] = siluf_(p->c[k]); sl[1024 + k] = siluf_(p->c_ctx[k]); }
    __syncthreads();
    const int c4 = tid & 15, kp = tid >> 4;
    const int col = cg_ * 64 + c4 * 4;
    const float* w = p->w_mod + (long)l * 1024 * 6144 + col;
    float a0[4] = {0, 0, 0, 0}, a1[4] = {0, 0, 0, 0};
#pragma unroll 8
    for (int kk = 0; kk < 64; ++kk) {
        int k = kp * 64 + kk;
        float4 wv = *(const float4*)(w + (long)k * 6144);
        float s0 = sl[k], s1 = sl[1024 + k];
        a0[0] += s0 * wv.x; a0[1] += s0 * wv.y; a0[2] += s0 * wv.z; a0[3] += s0 * wv.w;
        a1[0] += s1 * wv.x; a1[1] += s1 * wv.y; a1[2] += s1 * wv.z; a1[3] += s1 * wv.w;
    }
#pragma unroll
    for (int j = 0; j < 4; ++j) { red[(kp * 2 + 0) * 64 + c4 * 4 + j] = a0[j]; red[(kp * 2 + 1) * 64 + c4 * 4 + j] = a1[j]; }
    __syncthreads();
    if (tid < 128) {
        int src = tid >> 6, cr = tid & 63;
        float s = 0.f;
        for (int q = 0; q < 16; ++q) s += red[(q * 2 + src) * 64 + cr];
        int n = cg_ * 64 + cr;
        P_mod(p)[(l * 2 + src) * 6144 + n] = s + p->b_mod[l * 6144 + n];
    }
}
DI void sincos_d(double a, float& c, float& s) {
    const double TWO_PI = 6.283185307179586476925286766559;
    double k = rint(a / TWO_PI);
    double r = a - k * TWO_PI;
    double r2 = r * r;
    double ts = r, tc = 1.0, ss = r, cc = 1.0;
    for (int i = 1; i <= 14; ++i) {
        tc = -tc * r2 / (double)((2 * i - 1) * (2 * i));
        ts = -ts * r2 / (double)((2 * i) * (2 * i + 1));
        cc += tc; ss += ts;
    }
    c = (float)cc; s = (float)ss;
}
DI void ph0_rope_item(KP p, int item) {
    int idx = item * 256 + TIDX();
    const double LN_BASE = 9.210340371976184;
    if (idx < 8192) {
        int pos = idx >> 5, f = idx & 31;
        float inv = (float)exp(-(double)f / 32.0 * LN_BASE);
        float ang = (float)pos * inv;
        float c, s; sincos_d((double)ang, c, s);
        P_rope128(p)[idx] = make_float2(c, s);
    } else {
        int i2 = idx - 8192;
        int pos = i2 >> 4, f = i2 & 15;
        float inv = (float)exp(-(double)f / 16.0 * LN_BASE);
        float ang = (float)pos * inv;
        float c, s; sincos_d((double)ang, c, s);
        P_rope64(p)[i2] = make_float2(c, s);
    }
}

constexpr int CONV_TILES = 928 + 192 + 128 + 6144;
constexpr int CONV_DENSE = 928 + 192 + 128;
struct ConvTile { const float* sp; u16* dp; int N, K, mode, n0; };
DI ConvTile conv_setup(KP p, int layer, int tile) {
    const float* src; u16* dst; int K, N, mode = 0;
    if (tile < 928) { src = p->w_in + (long)layer * 1024 * INC; dst = P_wt_in(p); K = 1024; N = INC; mode = 1; }
    else if (tile < 928 + 192) {
        int t = tile - 928, which = t / 64; tile = t % 64; K = 512; N = 1024;
        src = (which == 0 ? p->w_ret : which == 1 ? p->w_win : p->w_na) + (long)layer * 512 * 1024;
        dst = (which == 0 ? P_wt_ret(p) : which == 1 ? P_wt_win(p) : P_wt_na(p));
    } else if (tile < 928 + 192 + 128) { tile -= 928 + 192; src = p->w_out + (long)layer * 1024 * 1024; dst = P_wt_out(p); K = 1024; N = 1024; }
    else {
        int t = tile - (928 + 192 + 128), which = t / 2048, e = (t % 2048) / 128; tile = t % 128; K = 1024; N = 1024;
        long eo = ((long)layer * NEXP + e) * 1024 * 1024;
        if (which == 0) { src = p->w_eg + eo; dst = P_wt_gu(p) + (long)e * 2048 * 1024; mode = 2; }
        else if (which == 1) { src = p->w_eu + eo; dst = P_wt_gu(p) + (long)e * 2048 * 1024; mode = 3; }
        else { src = p->w_ed + eo; dst = P_wt_dn(p) + (long)e * 1024 * 1024; }
    }
    const int ntn = N / 64;
    const int k0 = (tile / ntn) * 128, n0 = (tile % ntn) * 64;
    ConvTile c; c.sp = src + (long)k0 * N + n0; c.dp = dst + k0; c.N = N; c.K = K; c.mode = mode; c.n0 = n0;
    return c;
}
DI int conv_drow(int mode, int n) {
    if (mode == 1) {
        if (n < 1024) { int hh_ = (n & 511) >> 7, o_ = n & 127; return (n < 512 ? col_qr(hh_, o_ >> 6) : col_kr(hh_, o_ >> 6)) + (o_ & 63); }
        if (n >= C_QW && n < C_KW) { int m_ = n - C_QW; return col_qw(m_ >> 6, (m_ & 63) >> 5) + (m_ & 31); }
        if (n >= C_KW && n < C_VW) { int m_ = n - C_KW; return col_kw(m_ >> 6, (m_ & 63) >> 5) + (m_ & 31); }
        if (n >= C_VW && n < C_QN) { int m_ = n - C_VW; return col_vw(m_ >> 6) + (m_ & 63); }
        return n;
    }
    if (mode == 2) return (n >> 7) * 256 + (n & 127);
    if (mode == 3) return (n >> 7) * 256 + 128 + (n & 127);
    return n;
}
DI void convert_tiles(KP p, int layer, int first, int last, int step, char* smem) {
    const int tid = TIDX(), lane = tid & 63, w = tid >> 6;
    unsigned* T = (unsigned*)smem;
    float v[32];
    ConvTile c;
    if (first < last) {
        c = conv_setup(p, layer, first);
        const float* sp = c.sp + (long)(w * 32) * c.N + lane;
#pragma unroll
        for (int j = 0; j < 32; ++j) v[j] = sp[(long)j * c.N];
    }
    for (int t = first; t < last; t += step) {
        __syncthreads();
#pragma unroll
        for (int e = 0; e < 16; ++e) T[lane * 66 + w * 16 + e] = pack2(v[2 * e], v[2 * e + 1]);
        const ConvTile cur = c;
        if (t + step < last) {
            c = conv_setup(p, layer, t + step);
            const float* sp = c.sp + (long)(w * 32) * c.N + lane;
#pragma unroll
            for (int j = 0; j < 32; ++j) v[j] = sp[(long)j * c.N];
        }
        __syncthreads();
#pragma unroll
        for (int i = 0; i < 4; ++i) {
            const int idx = i * 256 + tid, nn = idx >> 4, ch = idx & 15;
            const u32x4 o = *(const u32x4*)(T + nn * 66 + ch * 4);
            *(u32x4*)(cur.dp + (long)conv_drow(cur.mode, cur.n0 + nn) * cur.K + ch * 8) = o;
        }
    }
}

DI void convert_tiles4(KP p, int layer, int first, int last, int step, char* smem) {
    const int tid = TIDX(), lane = tid & 63, w = tid >> 6;
    unsigned* T = (unsigned*)smem;
    for (int t = first; t < last; t += 4 * step) {
        float v[4][32];
        ConvTile c[4];
#pragma unroll
        for (int q = 0; q < 4; ++q) {
            const int tq = t + q * step;
            c[q] = conv_setup(p, layer, tq < last ? tq : first);
            if (tq < last) {
                const float* sp = c[q].sp + (long)(w * 32) * c[q].N + lane;
#pragma unroll
                for (int j = 0; j < 32; ++j) v[q][j] = sp[(long)j * c[q].N];
            }
        }
        __syncthreads();
#pragma unroll
        for (int q = 0; q < 4; ++q)
#pragma unroll
            for (int e = 0; e < 16; ++e) T[q * (64 * 66) + lane * 66 + w * 16 + e] = pack2(v[q][2 * e], v[q][2 * e + 1]);
        __syncthreads();
#pragma unroll
        for (int q = 0; q < 4; ++q) {
            if (t + q * step < last) {
#pragma unroll
                for (int i = 0; i < 4; ++i) {
                    const int idx = i * 256 + tid, nn = idx >> 4, ch = idx & 15;
                    const u32x4 o = *(const u32x4*)(T + q * (64 * 66) + nn * 66 + ch * 4);
                    *(u32x4*)(c[q].dp + (long)conv_drow(c[q].mode, c[q].n0 + nn) * c[q].K + ch * 8) = o;
                }
            }
        }
    }
}

DI const float* resid_row(KP p, int layer, int row) {
    if (row < NLAT) return p->x + (long)row * DM;
    return (layer == 0 ? p->ctx : P_ctxres(p)) + (long)(row - NLAT) * DM;
}
DI const float* cur_row(KP p, int row) { return P_ctxres(p) + (long)(row - NLAT) * DM; }
DI void load_res_row(KP p, int row, bool first, float4 (&v)[4]) {
    const int lane = TIDX() & 63;
    if (row < NLAT && !first) {
        const u16* xr = P_xres(p) + (long)row * DM;
#pragma unroll
        for (int i = 0; i < 4; ++i) { const uint2 w = *(const uint2*)(xr + i * 256 + lane * 4); v[i] = make_float4(bflo(w.x), bfhi(w.x), bflo(w.y), bfhi(w.y)); }
    } else {
        const float* xr = first ? resid_row(p, 0, row) : cur_row(p, row);
#pragma unroll
        for (int i = 0; i < 4; ++i) v[i] = *(const float4*)(xr + i * 256 + lane * 4);
    }
}
DI void store_res_row(KP p, int row, const float4 (&v)[4]) {
    const int lane = TIDX() & 63;
    if (row < NLAT) {
        u16* xr = P_xres(p) + (long)row * DM;
#pragma unroll
        for (int i = 0; i < 4; ++i) { uint2 w; w.x = pack2(v[i].x, v[i].y); w.y = pack2(v[i].z, v[i].w); *(uint2*)(xr + i * 256 + lane * 4) = w; }
    } else {
        float* xr = (float*)cur_row(p, row);
#pragma unroll
        for (int i = 0; i < 4; ++i) *(float4*)(xr + i * 256 + lane * 4) = v[i];
    }
}
DI void moe_combine(KP p, int row, float4 (&v)[4]) {
    const int lane = TIDX() & 63;
    const bool lat = row < NLAT;
    const int* ts = P_tslot(p) + (lat ? 0 : 16) * (long)NLAT + (lat ? row : row - NLAT);
    const u16* yb_ = lat ? P_ye(p) : P_yec(p);
    const int cap = lat ? CAP_LAT : CAP_CTX;
#pragma unroll 4
    for (int e = 0; e < NEXP; ++e) {
        const int slot = ts[(long)e * NLAT];
        if (slot >= 0) {
            const u16* yr = yb_ + ((long)e * cap + slot) * DM + lane * 4;
#pragma unroll
            for (int i = 0; i < 4; ++i) {
                uint2 w = *(const uint2*)(yr + i * 256);
                v[i].x += bflo(w.x); v[i].y += bfhi(w.x); v[i].z += bflo(w.y); v[i].w += bfhi(w.y);
            }
        }
    }
}
DI void norm_row(KP p, int layer, int row, const float* xr, const float* g, int shift_idx, int scale_idx, u16* dst_row, float* keep  , float* wb  ) {
    const int lane = TIDX() & 63;
    const float* md = P_mod(p) + (layer * 2 + (row < NLAT ? 0 : 1)) * 6144;
    float4 v[4]; float ss = 0.f;
#pragma unroll
    for (int i = 0; i < 4; ++i) v[i] = *(const float4*)(xr + i * 256 + lane * 4);
    if (wb) {
        moe_combine(p, row, v);
#pragma unroll
        for (int i = 0; i < 4; ++i) *(float4*)(wb + i * 256 + lane * 4) = v[i];
    }
#pragma unroll
    for (int i = 0; i < 4; ++i) ss += v[i].x * v[i].x + v[i].y * v[i].y + v[i].z * v[i].z + v[i].w * v[i].w;
    ss = wave_sum(ss);
    float rstd = rsqrtf(ss * (1.f / DM) + 1e-6f);
#pragma unroll
    for (int i = 0; i < 4; ++i) {
        int c0 = i * 256 + lane * 4;
        float4 gg = *(const float4*)(g + c0), sh = *(const float4*)(md + shift_idx * 1024 + c0), sc = *(const float4*)(md + scale_idx * 1024 + c0);
        float o0 = v[i].x * rstd * gg.x * (1.f + sc.x) + sh.x, o1 = v[i].y * rstd * gg.y * (1.f + sc.y) + sh.y;
        float o2 = v[i].z * rstd * gg.z * (1.f + sc.z) + sh.z, o3 = v[i].w * rstd * gg.w * (1.f + sc.w) + sh.w;
        uint2 pk; pk.x = pack2(o0, o1); pk.y = pack2(o2, o3);
        *(uint2*)(dst_row + c0) = pk;
        if (keep) *(float4*)(keep + c0) = make_float4(o0, o1, o2, o3);
    }
}

DI void norm_rows4(KP p, int layer, int row0, const float* g, int shift_idx, int scale_idx, bool first_layer_src, bool combine, float* keep = nullptr  ) {
    const int lane = TIDX() & 63;
    const float* md = P_mod(p) + (layer * 2 + (row0 < NLAT ? 0 : 1)) * 6144;
    float4 v[4][4];
#pragma unroll
    for (int r = 0; r < 4; ++r) load_res_row(p, row0 + r, first_layer_src, v[r]);
    float4 gg[4], sh[4], sc[4];
#pragma unroll
    for (int i = 0; i < 4; ++i) { const int c0 = i * 256 + lane * 4; gg[i] = *(const float4*)(g + c0); sh[i] = *(const float4*)(md + shift_idx * 1024 + c0); sc[i] = *(const float4*)(md + scale_idx * 1024 + c0); }
#pragma unroll
    for (int r = 0; r < 4; ++r) {
        const int row = row0 + r;
        if (first_layer_src && row >= NLAT) store_res_row(p, row, v[r]);
        if (combine) { moe_combine(p, row, v[r]); store_res_row(p, row, v[r]); }
        float ss = 0.f;
#pragma unroll
        for (int i = 0; i < 4; ++i) ss += v[r][i].x * v[r][i].x + v[r][i].y * v[r][i].y + v[r][i].z * v[r][i].z + v[r][i].w * v[r][i].w;
        ss = wave_sum(ss);
        const float rstd = rsqrtf(ss * (1.f / DM) + 1e-6f);
        u16* dst_row = P_hx(p) + (long)row * DM;
#pragma unroll
        for (int i = 0; i < 4; ++i) {
            const int c0 = i * 256 + lane * 4;
            float o0 = v[r][i].x * rstd * gg[i].x * (1.f + sc[i].x) + sh[i].x, o1 = v[r][i].y * rstd * gg[i].y * (1.f + sc[i].y) + sh[i].y;
            float o2 = v[r][i].z * rstd * gg[i].z * (1.f + sc[i].z) + sh[i].z, o3 = v[r][i].w * rstd * gg[i].w * (1.f + sc[i].w) + sh[i].w;
            uint2 pk; pk.x = pack2(o0, o1); pk.y = pack2(o2, o3);
            *(uint2*)(dst_row + c0) = pk;
            if (keep) *(float4*)(keep + r * 1024 + c0) = make_float4(o0, o1, o2, o3);
        }
    }
}

DI void phB_tile(KP p, int mt, int nt, char* smem) {
    const int tid = TIDX(), lane = tid & 63, wid = tid >> 6, wr = wid >> 1, wc = wid & 1, fr = lane & 15, fq = lane >> 4;
    f32x4 acc[4][4]; zero_acc<4>(acc);
    const int r0 = tid >> 2, ko = (tid & 3) * 8;
    const u16* a0 = P_hx(p) + (long)(mt * 128 + r0) * DM + ko;
    const u16* b0 = P_wt_in(p) + (long)(nt * 128 + r0) * DM + ko;
    gemm_core<32>(acc, a0, a0 + 64 * DM, b0, b0 + 64 * DM, smem);
    const bool lat = mt < 128;
    const int type = (nt < 8) ? 1 : (nt >= 16 && nt < 21) ? 2 : 0;
    if (type != 0 && lat) {
#pragma unroll
        for (int m = 0; m < 4; ++m)
#pragma unroll
            for (int j = 0; j < 4; ++j) {
                int t = mt * 128 + wr * 64 + m * 16 + fq * 4 + j;
                int pr = t >> 6, pc = t & 63;
#pragma unroll
                for (int n = 0; n < 2; ++n) {
                    float2 cs;
                    if (type == 1) { int pos = (wc == 0) ? pr : pc; cs = P_rope128(p)[pos * 32 + n * 16 + fr]; }
                    else { int pos = (n == 0) ? pr : pc; cs = P_rope64(p)[pos * 16 + fr]; }
                    float x1 = acc[m][n][j], x2 = acc[m][n + 2][j];
                    acc[m][n][j] = x1 * cs.x - x2 * cs.y;
                    acc[m][n + 2][j] = x1 * cs.y + x2 * cs.x;
                }
            }
    }
    const float mul = (nt >= 4 && nt < 8) ? 0.08838834764831845f : ((nt >= 16 && nt < 20) || (nt >= 22 && nt < 26)) ? 0.125f : 1.f;
#pragma unroll
    for (int m = 0; m < 4; ++m)
#pragma unroll
        for (int n = 0; n < 4; ++n)
#pragma unroll
            for (int j = 0; j < 4; ++j) {
                int row = mt * 128 + wr * 64 + m * 16 + fq * 4 + j, col = nt * 128 + wc * 64 + n * 16 + fr;
                P_px(p)[(long)row * INC + col] = f2bf(acc[m][n][j] * mul);
            }
}

typedef __attribute__((ext_vector_type(16))) float f32x16;
typedef short v4s __attribute__((ext_vector_type(4)));
typedef __attribute__((address_space(3))) v4s* lds_v4s_ptr;
#define MFMA32(a, b, c) __builtin_amdgcn_mfma_f32_32x32x16_bf16((a), (b), (c), 0, 0, 0)
constexpr float LOG2E = 1.4426950408889634f;

struct FA {
    bf16x8 qf[4];
    f32x16 o[2];
    float m, l;
};
DI void fa_stage(u16* Ks, u16* Vs, const u16* px, int rowstart, int colK1, int colK2, int colV) {
    const int lane = TIDX() & 63;
#pragma unroll
    for (int i = 0; i < 8; ++i) {
        int idx = i * 64 + lane, key = idx >> 3, ch = idx & 7;
        const u16* src = px + (long)(rowstart + key) * INC;
        u32x4 kv = *(const u32x4*)(src + (ch < 4 ? colK1 + ch * 8 : colK2 + (ch - 4) * 8));
        u32x4 vv = *(const u32x4*)(src + colV + ch * 8);
        *(u32x4*)(Ks + key * 72 + ch * 8) = kv;
        *(u32x4*)(Vs + key * 72 + ch * 8) = vv;
    }
}
template <int MODE>
DI void fa_tile(FA& st, const u16* Ks, const u16* Vs, int a0, const float* rrow) {
    const int lane = TIDX() & 63, c = lane & 31, hh = lane >> 5;
    const u16* kbase = Ks + c * 72 + hh * 8;
    const u16* vbase = Vs + (4 * hh + ((lane & 15) >> 2)) * 72 + 16 * ((lane >> 4) & 1) + 4 * (lane & 3);
    f32x16 s[2];
#pragma unroll
    for (int kb = 0; kb < 2; ++kb) {
#pragma unroll
        for (int r = 0; r < 16; ++r) s[kb][r] = 0.f;
#pragma unroll
        for (int ks = 0; ks < 4; ++ks) {
            bf16x8 A = *(const bf16x8*)(kbase + kb * 32 * 72 + ks * 16);
            s[kb] = MFMA32(A, st.qf[ks], s[kb]);
        }
    }
    float mx = -3.0e38f;
    const int cq = a0 + c;
    int cs = cq - 8; cs = cs < 0 ? 0 : (cs > 48 ? 48 : cs);
#pragma unroll
    for (int kb = 0; kb < 2; ++kb)
#pragma unroll
        for (int r = 0; r < 16; ++r) {
            const int j = kb * 32 + (r & 3) + 8 * (r >> 2) + 4 * hh;
            float v = s[kb][r];
            if (MODE == 1) { int d = a0 + j - c; v = (d >= -128 && d <= 128) ? v : -1e30f; }
            if (MODE == 2) { bool ok = (j >= cs) && (j < cs + 16); int ci = j - cq + 15; ci = ci < 0 ? 0 : (ci > 30 ? 30 : ci); v = ok ? v + rrow[ci] : -1e30f; }
            v *= LOG2E;
            s[kb][r] = v;
            mx = fmaxf(mx, v);
        }
    mx = fmaxf(mx, __shfl_xor(mx, 32));
    const float mn = fmaxf(st.m, mx);
    const float alpha = __builtin_amdgcn_exp2f(st.m - mn);
    float ls = 0.f;
#pragma unroll
    for (int kb = 0; kb < 2; ++kb)
#pragma unroll
        for (int r = 0; r < 16; ++r) { float pv = __builtin_amdgcn_exp2f(s[kb][r] - mn); s[kb][r] = pv; ls += pv; }
    st.l = st.l * alpha + ls; st.m = mn;
#pragma unroll
    for (int db = 0; db < 2; ++db)
#pragma unroll
        for (int r = 0; r < 16; ++r) st.o[db][r] *= alpha;
    bf16x8 pf[2][2];
#pragma unroll
    for (int kb = 0; kb < 2; ++kb)
#pragma unroll
        for (int k2 = 0; k2 < 2; ++k2) {
            u32x4 w;
#pragma unroll
            for (int e = 0; e < 4; ++e) w[e] = pack2(s[kb][8 * k2 + 2 * e], s[kb][8 * k2 + 2 * e + 1]);
            pf[kb][k2] = __builtin_bit_cast(bf16x8, w);
        }
#pragma unroll
    for (int db = 0; db < 2; ++db)
#pragma unroll
        for (int kb = 0; kb < 2; ++kb)
#pragma unroll
            for (int k2 = 0; k2 < 2; ++k2) {
                const u16* alo = vbase + (kb * 32 + 16 * k2) * 72 + db * 32;
                v4s lo = __builtin_amdgcn_ds_read_tr16_b64_v4i16((lds_v4s_ptr)alo);
                v4s hi = __builtin_amdgcn_ds_read_tr16_b64_v4i16((lds_v4s_ptr)(alo + 8 * 72));
                bf16x8 A = __builtin_shufflevector(lo, hi, 0, 1, 2, 3, 4, 5, 6, 7);
                st.o[db] = MFMA32(A, pf[kb][k2], st.o[db]);
            }
}
DI void fa_tile_na32(FA& st, const u16* Ks, const u16* Vs, int koff, bool rowok, int cs, const float* brow) {
    const int lane = TIDX() & 63, c = lane & 31, hh = lane >> 5;
    const u16* kbase = Ks + (koff + c) * 72 + hh * 8;
    const u16* vbase = Vs + (koff + 4 * hh + ((lane & 15) >> 2)) * 72 + 16 * ((lane >> 4) & 1) + 4 * (lane & 3);
    f32x16 s;
#pragma unroll
    for (int r = 0; r < 16; ++r) s[r] = 0.f;
#pragma unroll
    for (int ks = 0; ks < 4; ++ks) {
        bf16x8 A = *(const bf16x8*)(kbase + ks * 16);
        s = MFMA32(A, st.qf[ks], s);
    }
    float mx = -3.0e38f;
    const int lo = cs - koff;
#pragma unroll
    for (int r = 0; r < 16; ++r) {
        const int jj = (r & 3) + 8 * (r >> 2) + 4 * hh;
        const bool ok = rowok && (jj >= lo) && (jj < lo + 16);
        float v = ok ? (s[r] + brow[jj]) * LOG2E : -1.4e30f;
        s[r] = v;
        mx = fmaxf(mx, v);
    }
    mx = fmaxf(mx, __shfl_xor(mx, 32));
    const float mn = fmaxf(st.m, mx);
    const float alpha = __builtin_amdgcn_exp2f(st.m - mn);
    float ls = 0.f;
#pragma unroll
    for (int r = 0; r < 16; ++r) { float pv = __builtin_amdgcn_exp2f(s[r] - mn); s[r] = pv; ls += pv; }
    st.l = st.l * alpha + ls; st.m = mn;
#pragma unroll
    for (int db = 0; db < 2; ++db)
#pragma unroll
        for (int r = 0; r < 16; ++r) st.o[db][r] *= alpha;
    bf16x8 pf[2];
#pragma unroll
    for (int k2 = 0; k2 < 2; ++k2) {
        u32x4 w;
#pragma unroll
        for (int e = 0; e < 4; ++e) w[e] = pack2(s[8 * k2 + 2 * e], s[8 * k2 + 2 * e + 1]);
        pf[k2] = __builtin_bit_cast(bf16x8, w);
    }
#pragma unroll
    for (int db = 0; db < 2; ++db)
#pragma unroll
        for (int k2 = 0; k2 < 2; ++k2) {
            const u16* alo = vbase + (16 * k2) * 72 + db * 32;
            v4s lo_ = __builtin_amdgcn_ds_read_tr16_b64_v4i16((lds_v4s_ptr)alo);
            v4s hi_ = __builtin_amdgcn_ds_read_tr16_b64_v4i16((lds_v4s_ptr)(alo + 8 * 72));
            bf16x8 A = __builtin_shufflevector(lo_, hi_, 0, 1, 2, 3, 4, 5, 6, 7);
            st.o[db] = MFMA32(A, pf[k2], st.o[db]);
        }
}
DI void attn_block_item(KP p, int layer, int kind, int ia, int ib, char* smem) {
    const int tid = TIDX(), lane = tid & 63, wid = tid >> 6, c = lane & 31, hh = lane >> 5;
    u16* KV = (u16*)smem;
    float* rpbs = (float*)(smem + 36864) + 64 + wid * 512;
    const bool isna = (kind == 1 || kind == 3);
    int h, q0, a_half = 0, kvh;
    if (kind == 0) { h = ib * 4 + wid; kvh = ib; q0 = ia * 32; }
    else if (kind == 1) { h = ib; kvh = ib; q0 = 2 * ia * 64; }
    else if (kind == 2) { h = ib * 4 + wid; kvh = ib; q0 = NLAT + ia * 32; }
    else { h = ib; kvh = ib; q0 = NLAT + (ia * 4 + wid) * 32; }
    const int colQ1 = isna ? C_QN + h * 64 : col_qw(h, 0), colQ2 = isna ? colQ1 + 32 : col_qw(h, 1);
    const int colK1 = isna ? C_KN + kvh * 64 : col_kw(kvh, 0), colK2 = isna ? colK1 + 32 : col_kw(kvh, 1);
    const int colV = isna ? C_VN + kvh * 64 : col_vw(kvh);
    FA st;
    {
        const int tq = (kind == 1) ? q0 + (c >> 4) * 64 + wid * 16 + (c & 15) : q0 + c;
        const u16* qrow = P_px(p) + (long)tq * INC;
#pragma unroll
        for (int ks = 0; ks < 4; ++ks) st.qf[ks] = *(const bf16x8*)(qrow + (ks < 2 ? colQ1 + ks * 16 : colQ2 + (ks - 2) * 16) + hh * 8);
#pragma unroll
        for (int db = 0; db < 2; ++db)
#pragma unroll
            for (int r = 0; r < 16; ++r) st.o[db][r] = 0.f;
        if (isna) { st.m = -1e30f; st.l = 0.f; } else { st.m = p->sink[layer * 8 + h] * LOG2E; st.l = hh == 0 ? 1.f : 0.f; }
    }
    const int r0 = 2 * ia, rq = r0 + (c >> 4), cq = wid * 16 + (c & 15);
    int sr0 = r0 - 4; sr0 = sr0 < 0 ? 0 : (sr0 > 248 ? 248 : sr0);
    int srq = rq - 4; srq = srq < 0 ? 0 : (srq > 248 ? 248 : srq);
    int sr1 = r0 + 1 - 4; sr1 = sr1 < 0 ? 0 : (sr1 > 248 ? 248 : sr1);
    int csq = cq - 8; csq = csq < 0 ? 0 : (csq > 48 ? 48 : csq);
    const int koff = wid == 0 ? 0 : wid == 1 ? 8 : wid == 2 ? 24 : 32;
    const float* bq = rpbs + (7 - rq) * 31 + koff - cq + 15;
    if (kind == 1) {
        const float* rp = p->rpb + ((long)layer * 8 + h) * 465;
        for (int i = lane; i < 465; i += 64) rpbs[i] = rp[i];
    }
    const int nloc = kind == 0 ? 5 : kind == 1 ? 9 : 0, nt = nloc + 4;
    const int wt0 = (q0 >> 6) - 2;
    auto tile_row = [&](int i) -> int {
        if (i >= nloc) return NLAT + (i - nloc) * 64;
        if (kind == 0) { const int s0 = ((ia * 32) >> 6) - 2 + i; return (s0 < 0 || s0 >= NLAT / 64) ? -1 : s0 * 64; }
        const int kr = sr0 + i; return (kr > sr1 + 7) ? -1 : kr * 64;
    };
    const int skey = tid >> 4, sc16 = tid & 15;
    const int scol = sc16 < 8 ? (sc16 < 4 ? colK1 + sc16 * 8 : colK2 + (sc16 - 4) * 8) : colV + (sc16 - 8) * 8;
    const int sdst = (sc16 < 8 ? 0 : 64 * 72) + skey * 72 + (sc16 & 7) * 8;
    u32x4 pre[4];
    auto load_tile = [&](int row0) {
#pragma unroll
        for (int j = 0; j < 4; ++j) pre[j] = *(const u32x4*)(P_px(p) + (long)(row0 + skey + 16 * j) * INC + scol);
    };
    auto store_tile = [&](int buf) {
#pragma unroll
        for (int j = 0; j < 4; ++j) *(u32x4*)(KV + buf * (2 * 64 * 72) + sdst + 16 * j * 72) = pre[j];
    };
    __syncthreads();
    int rowc = tile_row(0);
    if (rowc >= 0) { load_tile(rowc); store_tile(0); }
    __syncthreads();
    for (int i = 0; i < nt; ++i) {
        const int rown = (i + 1 < nt) ? tile_row(i + 1) : -1;
        if (rown >= 0) load_tile(rown);
        if (rowc >= 0) {
            const u16* Ks = KV + (i & 1) * (2 * 64 * 72);
            const u16* Vs = Ks + 64 * 72;
            if (i >= nloc) fa_tile<0>(st, Ks, Vs, 0, nullptr);
            else if (kind == 0) { if (i == 0 || i == 4) fa_tile<1>(st, Ks, Vs, rowc - q0, nullptr); else fa_tile<0>(st, Ks, Vs, 0, nullptr); }
            else { const int kr = sr0 + i; fa_tile_na32(st, Ks, Vs, koff, kr >= srq && kr < srq + 8, csq, bq + kr * 31); }
        }
        if (rown >= 0) store_tile((i + 1) & 1);
        rowc = rown;
        __syncthreads();
    }
    u16* y = isna ? P_yc(p) : P_yb(p);
    {
        float lt = st.l + __shfl_xor(st.l, 32);
        float inv = 1.f / lt;
        u16* ob = KV + wid * (32 * 72);
#pragma unroll
        for (int db = 0; db < 2; ++db)
#pragma unroll
            for (int g = 0; g < 4; ++g) {
                uint2 o;
                o.x = pack2(st.o[db][4 * g] * inv, st.o[db][4 * g + 1] * inv);
                o.y = pack2(st.o[db][4 * g + 2] * inv, st.o[db][4 * g + 3] * inv);
                *(uint2*)(ob + c * 72 + db * 32 + 8 * g + 4 * hh) = o;
            }
#pragma unroll
        for (int i = 0; i < 4; ++i) {
            const int idx = i * 64 + lane, qi = idx >> 3, ch = idx & 7;
            const int tq = (kind == 1) ? q0 + (qi >> 4) * 64 + wid * 16 + (qi & 15) : q0 + qi;
            *(u32x4*)(y + (long)tq * 512 + h * 64 + ch * 8) = *(const u32x4*)(ob + qi * 72 + ch * 8);
        }
    }
}

DI void ret_gammas(KP p, int layer, int h, float& lgf2, float& lgb2) {
    float xf = p->decay[layer * 8 + h], xb = p->decay[layer * 8 + 4 + h];
    lgf2 = -log1pf(expf(-xf)) * 1.4426950408889634f;
    lgb2 = -log1pf(expf(-xb)) * 1.4426950408889634f;
}
DI void phC_state_item(KP p, int layer, int c, int h, int eh, char* smem) {
    const int tid = TIDX(), lane = tid & 63, wid = tid >> 6, wr = wid >> 1, wc = wid & 1, fr = lane & 15, fq = lane >> 4;
    u16* Vr = (u16*)smem;
    u16* Kf = Vr + 64 * 72;
    u16* Kb = Kf + 64 * 136;
    float lgf2, lgb2; ret_gammas(p, layer, h, lgf2, lgb2);
    f32x4 accF[2][4], accB[2][4]; zero_acc<2>(accF); zero_acc<2>(accB);
    const u16* base = P_px(p) + (long)c * 128 * INC;
    u32x4 pv[2], pk[4];
    auto load_half = [&](int jh) {
        const u16* rb = base + (long)jh * 64 * INC;
#pragma unroll
        for (int i = 0; i < 2; ++i) { const int idx = i * 256 + tid, row = idx >> 3, ch = idx & 7; pv[i] = *(const u32x4*)(rb + (long)row * INC + C_VR + h * 128 + eh * 64 + ch * 8); }
#pragma unroll
        for (int i = 0; i < 4; ++i) { const int idx = i * 256 + tid, row = idx >> 4, ch = idx & 15; pk[i] = *(const u32x4*)(rb + (long)row * INC + (ch < 8 ? col_kr(h, 0) + ch * 8 : col_kr(h, 1) + (ch - 8) * 8)); }
    };
    auto store_half = [&](int jh) {
#pragma unroll
        for (int i = 0; i < 2; ++i) { const int idx = i * 256 + tid, row = idx >> 3, ch = idx & 7; *(u32x4*)(Vr + row * 72 + ch * 8) = pv[i]; }
#pragma unroll
        for (int i = 0; i < 4; ++i) {
            const int idx = i * 256 + tid, row = idx >> 4, ch = idx & 15, j = jh * 64 + row;
            const float zf = exp2f((float)(127 - j) * lgf2), zb = exp2f((float)j * lgb2);
            u32x4 of, ob;
#pragma unroll
            for (int e = 0; e < 4; ++e) { const float lo = bflo(pk[i][e]), hi = bfhi(pk[i][e]); of[e] = pack2(lo * zf, hi * zf); ob[e] = pack2(lo * zb, hi * zb); }
            *(u32x4*)(Kf + row * 136 + ch * 8) = of;
            *(u32x4*)(Kb + row * 136 + ch * 8) = ob;
        }
    };
    load_half(0);
    __syncthreads();
    store_half(0);
    load_half(1);
    __syncthreads();
    mma_lds64_tt<2>(accF, Vr, 72, Kf, 136);
    mma_lds64_tt<2>(accB, Vr, 72, Kb, 136);
    __syncthreads();
    store_half(1);
    __syncthreads();
    mma_lds64_tt<2>(accF, Vr, 72, Kf, 136);
    mma_lds64_tt<2>(accB, Vr, 72, Kb, 136);
    __syncthreads();
#pragma unroll
    for (int m = 0; m < 2; ++m)
#pragma unroll
        for (int n = 0; n < 4; ++n)
#pragma unroll
            for (int j = 0; j < 4; ++j) {
                const int el = wr * 32 + m * 16 + fq * 4 + j, d = wc * 64 + n * 16 + fr;
                Kf[el * 136 + d] = f2bf(accF[m][n][j]);
                Kb[el * 136 + d] = f2bf(accB[m][n][j]);
            }
    __syncthreads();
    u16* Sf = (u16*)P_S(p) + ((long)(c * 4 + h) * 2 + 0) * 16384 + (long)eh * 64 * 128;
    u16* Sb = Sf + 16384;
#pragma unroll
    for (int i = 0; i < 4; ++i) {
        const int idx = i * 256 + tid, el = idx >> 4, ch = idx & 15;
        *(u32x4*)(Sf + el * 128 + ch * 8) = *(const u32x4*)(Kf + el * 136 + ch * 8);
        *(u32x4*)(Sb + el * 128 + ch * 8) = *(const u32x4*)(Kb + el * 136 + ch * 8);
    }
}

DI void phD_item(KP p, int layer, int item) {
    const int h = item >> 7, dir = (item >> 6) & 1, pos = (item & 63) * 256 + TIDX();
    float lgf2, lgb2; ret_gammas(p, layer, h, lgf2, lgb2);
    const float decay = exp2f(128.f * (dir == 0 ? lgf2 : lgb2));
    float r = 0.f;
    const long hs = (long)(h * 2 + dir) * 16384 + pos;
    auto chunk_at = [&](int i) -> int {
        if (dir == 0) return i < 2 ? 128 + i : i - 2;
        return i < 2 ? 129 - i : 129 - i;
    };
    for (int i0 = 0; i0 < NCHUNK; i0 += 13) {
        float s[13];
#pragma unroll
        for (int u = 0; u < 13; ++u) s[u] = bf2f(((const u16*)P_S(p))[(long)chunk_at(i0 + u) * 8 * 16384 + hs]);
#pragma unroll
        for (int u = 0; u < 13; ++u) {
            P_R(p)[(long)chunk_at(i0 + u) * 8 * 16384 + hs] = f2bf(r);
            r = decay * r + s[u];
        }
    }
}

DI void phE_item(KP p, int layer, int c, int h, int ih, char* smem) {
    const int tid = TIDX(), lane = tid & 63, wid = tid >> 6, wr = wid >> 1, wc = wid & 1, fr = lane & 15, fq = lane >> 4;
    u16* Qs = (u16*)smem;
    u16* X = Qs + 64 * 136;
    u16* P = X + 128 * 136;
    float* red = (float*)(P + 64 * 136);
    float lgf2, lgb2; ret_gammas(p, layer, h, lgf2, lgb2);
    const u16* base = P_px(p) + (long)c * 128 * INC;
    const u16* Rf = P_R(p) + ((long)(c * 4 + h) * 2 + 0) * 16384;
    const u16* Rb = Rf + 16384;
    const int ch = tid & 15, rw = tid >> 4;
    const int qkcol = ch < 8 ? ch * 8 : (ch - 8) * 8;
    u32x4 pre[8];
    auto load_rows = [&](const u16* src, long stride, int nrow16) {
#pragma unroll
        for (int i = 0; i < 8; ++i) if (i < nrow16) pre[i] = *(const u32x4*)(src + (long)(rw + 16 * i) * stride);
    };
    auto store_rows = [&](u16* dst, int nrow16) {
#pragma unroll
        for (int i = 0; i < 8; ++i) if (i < nrow16) *(u32x4*)(dst + (rw + 16 * i) * 136 + ch * 8) = pre[i];
    };
    f32x4 Y[2][4], T[2][4];
    zero_acc<2>(Y); zero_acc<2>(T);
    __syncthreads();
    load_rows(base + (long)ih * 64 * INC + (ch < 8 ? col_qr(h, 0) : col_qr(h, 1)) + qkcol, INC, 4); store_rows(Qs, 4);
    load_rows(Rf + ch * 8, 128, 8); store_rows(X, 8);
    load_rows(Rb + ch * 8, 128, 8);
    __syncthreads();
    mma_lds64<2>(Y, Qs, 136, X, 136); mma_lds64<2>(Y, Qs + 64, 136, X + 64, 136);
    __syncthreads();
    store_rows(X, 8);
    load_rows(base + (ch < 8 ? col_kr(h, 0) : col_kr(h, 1)) + qkcol, INC, 8);
    __syncthreads();
    mma_lds64<2>(T, Qs, 136, X, 136); mma_lds64<2>(T, Qs + 64, 136, X + 64, 136);
#pragma unroll
    for (int m = 0; m < 2; ++m)
#pragma unroll
        for (int j = 0; j < 4; ++j) {
            int i = ih * 64 + wr * 32 + m * 16 + fq * 4 + j;
            float xf = exp2f((float)(i + 1) * lgf2), xb = exp2f((float)(128 - i) * lgb2);
#pragma unroll
            for (int n = 0; n < 4; ++n) Y[m][n][j] = xf * Y[m][n][j] + xb * T[m][n][j];
        }
    zero_acc<2>(T);
    __syncthreads();
    store_rows(X, 8);
    load_rows(base + C_VR + h * 128 + ch * 8, INC, 8);
    __syncthreads();
    mma_lds64<2>(T, Qs, 136, X, 136); mma_lds64<2>(T, Qs + 64, 136, X + 64, 136);
#pragma unroll
    for (int m = 0; m < 2; ++m)
#pragma unroll
        for (int n = 0; n < 4; ++n)
#pragma unroll
            for (int j = 0; j < 4; ++j) {
                int il = wr * 32 + m * 16 + fq * 4 + j, i = ih * 64 + il, jj = wc * 64 + n * 16 + fr;
                float dm = (i >= jj) ? exp2f((float)(i - jj) * lgf2) : exp2f((float)(jj - i) * lgb2);
                P[il * 136 + jj] = f2bf(T[m][n][j] * dm);
            }
    __syncthreads();
    store_rows(X, 8);
    __syncthreads();
    mma_lds64_btr<2>(Y, P, 136, X, 136); mma_lds64_btr<2>(Y, P + 64, 136, X + 64 * 136, 136);
    float mu[2][4], rs[2][4];
#pragma unroll
    for (int m = 0; m < 2; ++m)
#pragma unroll
        for (int j = 0; j < 4; ++j) {
            float s = Y[m][0][j] + Y[m][1][j] + Y[m][2][j] + Y[m][3][j];
            s += __shfl_xor(s, 1); s += __shfl_xor(s, 2); s += __shfl_xor(s, 4); s += __shfl_xor(s, 8);
            if (fr == 0) red[(wr * 32 + m * 16 + fq * 4 + j) * 2 + wc] = s;
        }
    __syncthreads();
#pragma unroll
    for (int m = 0; m < 2; ++m)
#pragma unroll
        for (int j = 0; j < 4; ++j) { int il = wr * 32 + m * 16 + fq * 4 + j; mu[m][j] = (red[il * 2] + red[il * 2 + 1]) * (1.f / 128.f); }
    __syncthreads();
#pragma unroll
    for (int m = 0; m < 2; ++m)
#pragma unroll
        for (int j = 0; j < 4; ++j) {
            float s = 0.f;
#pragma unroll
            for (int n = 0; n < 4; ++n) { float d = Y[m][n][j] - mu[m][j]; s += d * d; }
            s += __shfl_xor(s, 1); s += __shfl_xor(s, 2); s += __shfl_xor(s, 4); s += __shfl_xor(s, 8);
            if (fr == 0) red[(wr * 32 + m * 16 + fq * 4 + j) * 2 + wc] = s;
        }
    __syncthreads();
#pragma unroll
    for (int m = 0; m < 2; ++m)
#pragma unroll
        for (int j = 0; j < 4; ++j) { int il = wr * 32 + m * 16 + fq * 4 + j; rs[m][j] = rsqrtf((red[il * 2] + red[il * 2 + 1]) * (1.f / 128.f) + 1e-6f); }
    __syncthreads();
    const float* gn = p->ret_gn + layer * 512 + h * 128;
#pragma unroll
    for (int m = 0; m < 2; ++m)
#pragma unroll
        for (int n = 0; n < 4; ++n)
#pragma unroll
            for (int j = 0; j < 4; ++j) {
                const int il = wr * 32 + m * 16 + fq * 4 + j, e = wc * 64 + n * 16 + fr;
                P[il * 136 + e] = f2bf((Y[m][n][j] - mu[m][j]) * rs[m][j] * gn[e]);
            }
    __syncthreads();
#pragma unroll
    for (int i = 0; i < 4; ++i) {
        const int idx = i * 256 + tid, il = idx >> 4, ch = idx & 15;
        const long row = (long)c * 128 + ih * 64 + il;
        const u32x4 yv = *(const u32x4*)(P + il * 136 + ch * 8);
        const u32x4 gv = *(const u32x4*)(P_px(p) + row * INC + C_GR + h * 128 + ch * 8);
        u32x4 o;
#pragma unroll
        for (int e = 0; e < 4; ++e) o[e] = pack2(bflo(yv[e]) * siluf_(bflo(gv[e])), bfhi(yv[e]) * siluf_(bfhi(gv[e])));
        *(u32x4*)(P_ya(p) + row * 512 + h * 128 + ch * 8) = o;
    }
    __syncthreads();
}

DI void phF_tile(KP p, int mt, int nt, int b, int ks, char* smem) {
    const int tid = TIDX(), lane = tid & 63, wid = tid >> 6, wr = wid >> 1, wc = wid & 1, fr = lane & 15, fq = lane >> 4;
    const int r0 = tid >> 2, ko = (tid & 3) * 8 + ks * 64;
    float* macc = P_maccx(p) - (long)NLAT * DM;
    const u16* y = (b == 0 ? P_ya(p) : b == 1 ? P_yb(p) : P_yc(p));
    const u16* w = (b == 0 ? P_wt_ret(p) : b == 1 ? P_wt_win(p) : P_wt_na(p));
    f32x4 acc[4][4]; zero_acc<4>(acc);
    const u16* a0 = y + (long)(mt * 128 + r0) * 512 + ko;
    const u16* b0 = w + (long)(nt * 128 + r0) * 512 + ko;
    gemm_core<2>(acc, a0, a0 + 64 * 512, b0, b0 + 64 * 512, smem);
    int zero = 0; asm volatile("" : "+v"(zero));
#pragma unroll
    for (int m = 0; m < 4; ++m)
#pragma unroll
        for (int n = 0; n < 4; ++n)
#pragma unroll
            for (int j = 0; j < 4; ++j) {
                int row = mt * 128 + wr * 64 + m * 16 + fq * 4 + j + zero, col = nt * 128 + wc * 64 + n * 16 + fr;
                float g = bf2f(P_px(p)[(long)row * INC + C_GATE + b * 1024 + col]);
                unsafeAtomicAdd(macc + (long)row * DM + col, acc[m][n][j] * sigmoidf_(g));
            }
}
DI void phG_tile(KP p, int layer, int mt, int nt, int ks, char* smem) {
    const int tid = TIDX(), lane = tid & 63, wid = tid >> 6, wr = wid >> 1, wc = wid & 1, fr = lane & 15, fq = lane >> 4;
    f32x4 acc[4][4]; zero_acc<4>(acc);
    const int r0 = tid >> 2, ko = (tid & 3) * 8 + ks * 32;
    const float* a0 = P_maccx(p) + (long)((mt - 128) * 128 + r0) * DM + ko;
    const u16* b0 = P_wt_out(p) + (long)(nt * 128 + r0) * DM + ko;
    gemm_core_af32<1>(acc, a0, a0 + 64 * DM, b0, b0 + 64 * DM, smem);
    const float* md = P_mod(p) + (layer * 2 + 1) * 6144 + 2 * 1024;
    int zero = 0; asm volatile("" : "+v"(zero));
#pragma unroll
    for (int m = 0; m < 4; ++m)
#pragma unroll
        for (int n = 0; n < 4; ++n)
#pragma unroll
            for (int j = 0; j < 4; ++j) {
                int row = mt * 128 + wr * 64 + m * 16 + fq * 4 + j + zero, col = nt * 128 + wc * 64 + n * 16 + fr;
                unsafeAtomicAdd(P_ctxres(p) + (long)(row - NLAT) * DM + col, md[col] * acc[m][n][j]);
            }
}


#define LAS __attribute__((address_space(3)))
namespace g8 {
constexpr int BM = 256, BK = 64, HALF = 128, HTB = HALF * BK * 2, STAGE_BYTES = 8 * HTB;
DI int lds_byte(int r, int c) { const int st = (r >> 4) * 2 + (c >> 5), rr = r & 15, cc = c & 31, ob = rr * 64 + cc * 2; return st * 1024 + (ob ^ (((ob >> 9) & 1) << 5)); }
DI void stage_rc(int b, int& R, int& C) { const int st = b / 1024, sb = b % 1024, swz = sb ^ (((sb >> 9) & 1) << 5); R = (st >> 1) * 16 + swz / 64; C = (st & 1) * 32 + (swz % 64) / 2; }
DI int perm32(int rho) { const int n = rho >> 4, i = rho & 15; return 8 * (i >> 2) + 4 * n + (i & 3); }
struct Unit { int pm, pn, aux; };
typedef f32x4 Acc[2][2][4][2];

template <class P>
DI void gemm_phase(LAS unsigned char* lds, const P& prob) {
    const int tid = TID512(), wid = __builtin_amdgcn_readfirstlane(tid >> 6), lane = tid & 63, wr = wid >> 2, wc = wid & 3, fr = lane & 15, fq = lane >> 4;
    constexpr int K = P::K, nt = K / BK;
    int Rr[2], Cc[2];
    unsigned voffA[2], voffB[2];
#pragma unroll
    for (int i = 0; i < 2; ++i) { stage_rc(tid * 16 + i * 8192, Rr[i], Cc[i]); const int Rb = P::PERM ? ((Rr[i] & ~31) + perm32(Rr[i] & 31)) : Rr[i];
        voffA[i] = (unsigned)(Rr[i] * K + Cc[i]) * 2u; voffB[i] = (unsigned)(Rb * K + Cc[i]) * 2u; }
    constexpr size_t kstep = (size_t)(BK * 2);
    constexpr size_t hstep = (size_t)HALF * K * 2;
    const unsigned ldsw = (unsigned)wid * 1024u;
    const int aoff = lds_byte(wr * 64 + fr, fq * 8), boff = lds_byte(wc * 32 + fr, fq * 8);
    unsigned vaC[2][2], vaN[2][2];
#define G8_SA(b, h) (((b) * 2 + (h)) * HTB)
#define G8_SB(b, h) ((4 + (b) * 2 + (h)) * HTB)
#define G8_STAGEA(bufoff, base, VA, h, kt) do { _Pragma("unroll") for (int _i = 0; _i < 2; ++_i) \
        __builtin_amdgcn_global_load_lds((const unsigned*)((base) + (P::GATHER ? (size_t)(VA)[h][_i] : (size_t)voffA[_i] + (size_t)(h) * hstep) + (size_t)(kt) * kstep), (LAS unsigned*)(lds + (bufoff) + ldsw + _i * 8192), 16, 0, 0); } while (0)
#define G8_STAGEB(bufoff, base, h, kt) do { _Pragma("unroll") for (int _i = 0; _i < 2; ++_i) \
        __builtin_amdgcn_global_load_lds((const unsigned*)((base) + (size_t)(h) * hstep + voffB[_i] + (size_t)(kt) * kstep), (LAS unsigned*)(lds + (bufoff) + ldsw + _i * 8192), 16, 0, 0); } while (0)
#define G8_LDA(dst, b, h) do { _Pragma("unroll") for (int m = 0; m < 4; ++m) _Pragma("unroll") for (int k = 0; k < 2; ++k) dst[m][k] = *(const LAS bf16x8*)(lds + G8_SA(b, h) + aoff + m * 2048 + k * 1024); } while (0)
#define G8_LDB(dst, b, h) do { _Pragma("unroll") for (int n = 0; n < 2; ++n) _Pragma("unroll") for (int k = 0; k < 2; ++k) dst[n][k] = *(const LAS bf16x8*)(lds + G8_SB(b, h) + boff + n * 2048 + k * 1024); } while (0)
#define G8_MMA(ai, bj, At, Bt) do { __builtin_amdgcn_s_setprio(1); _Pragma("unroll") for (int m = 0; m < 4; ++m) _Pragma("unroll") for (int n = 0; n < 2; ++n) _Pragma("unroll") for (int k = 0; k < 2; ++k) \
        acc[ai][bj][m][n] = __builtin_amdgcn_mfma_f32_16x16x32_bf16(Bt[n][k], At[m][k], acc[ai][bj][m][n], 0, 0, 0); __builtin_amdgcn_s_setprio(0); } while (0)
#define G8_WAIT_V(n) asm volatile("s_waitcnt vmcnt(" #n ")" ::: "memory")
#define G8_WAIT_L(n) asm volatile("s_waitcnt lgkmcnt(" #n ")" ::: "memory")
#define G8_BAR __builtin_amdgcn_s_barrier()
#define G8_SCHED __builtin_amdgcn_sched_barrier(0)
    Unit cur, nxt; int ui = 0;
    __syncthreads();
    if (!prob.next(0, cur)) return;
    if (P::GATHER) prob.gather(cur, Rr, Cc, vaC);
    const char* cA = prob.a_base(cur); const char* cB = prob.b_base(cur);
    Acc acc;
#pragma unroll
    for (int a = 0; a < 2; ++a)
#pragma unroll
        for (int b = 0; b < 2; ++b)
#pragma unroll
            for (int m = 0; m < 4; ++m)
#pragma unroll
                for (int n = 0; n < 2; ++n) acc[a][b][m][n] = (f32x4){0.f, 0.f, 0.f, 0.f};
    bf16x8 At[4][2], B0[2][2], B1[2][2];
    G8_STAGEB(G8_SB(0, 0), cB, 0, 0); G8_STAGEA(G8_SA(0, 0), cA, vaC, 0, 0); G8_STAGEB(G8_SB(0, 1), cB, 1, 0); G8_STAGEA(G8_SA(0, 1), cA, vaC, 1, 0);
    if (wr == 1) G8_BAR;
    G8_WAIT_V(4); G8_BAR;
    G8_STAGEB(G8_SB(1, 0), cB, 0, 1); G8_STAGEA(G8_SA(1, 0), cA, vaC, 0, 1); G8_STAGEB(G8_SB(1, 1), cB, 1, 1);
    G8_WAIT_V(6); G8_BAR;
    for (;;) {
        const bool has_next = prob.next(ui + 1, nxt);
        if (!has_next) nxt = cur;
        if (P::GATHER) {
            if (has_next) prob.gather(nxt, Rr, Cc, vaN);
            else {
#pragma unroll
                for (int h = 0; h < 2; ++h) { vaN[h][0] = vaC[h][0]; vaN[h][1] = vaC[h][1]; }
            }
        }
        const char* nA = prob.a_base(nxt); const char* nB = prob.b_base(nxt);
#pragma unroll 1
        for (int t = 0; t < nt; t += 2) {
            const bool last = (t == nt - 2);
            const char* a2 = last ? nA : cA; const char* b2 = last ? nB : cB; const int k2 = last ? 0 : t + 2;
            unsigned va2[2][2];
#pragma unroll
            for (int h = 0; h < 2; ++h) { va2[h][0] = last ? vaN[h][0] : vaC[h][0]; va2[h][1] = last ? vaN[h][1] : vaC[h][1]; }
            G8_LDB(B0, 0, 0); G8_SCHED; G8_LDA(At, 0, 0); G8_STAGEA(G8_SA(1, 1), cA, vaC, 1, t + 1);
            G8_WAIT_L(8); G8_BAR; G8_WAIT_L(0); G8_MMA(0, 0, At, B0); G8_BAR; G8_SCHED;
            G8_LDB(B1, 0, 1); G8_STAGEB(G8_SB(0, 0), b2, 0, k2);
            G8_BAR; G8_WAIT_L(0); G8_MMA(0, 1, At, B1); G8_BAR;
            G8_LDA(At, 0, 1); G8_STAGEA(G8_SA(0, 0), a2, va2, 0, k2);
            G8_BAR; G8_WAIT_L(0); G8_MMA(1, 0, At, B0); G8_BAR; G8_SCHED;
            G8_STAGEB(G8_SB(0, 1), b2, 1, k2);
            G8_WAIT_V(6); G8_BAR; G8_MMA(1, 1, At, B1); G8_BAR;
            G8_LDB(B0, 1, 0); G8_SCHED; G8_LDA(At, 1, 0); G8_STAGEA(G8_SA(0, 1), a2, va2, 1, k2);
            G8_WAIT_L(8); G8_BAR; G8_WAIT_L(0); G8_MMA(0, 0, At, B0); G8_BAR; G8_SCHED;
            G8_LDB(B1, 1, 1); G8_STAGEB(G8_SB(1, 0), b2, 0, k2 + 1);
            G8_BAR; G8_WAIT_L(0); G8_MMA(0, 1, At, B1); G8_BAR;
            G8_LDA(At, 1, 1); G8_STAGEA(G8_SA(1, 0), a2, va2, 0, k2 + 1);
            G8_BAR; G8_WAIT_L(0); G8_MMA(1, 0, At, B0); G8_BAR; G8_SCHED;
            G8_STAGEB(G8_SB(1, 1), b2, 1, k2 + 1);
            G8_WAIT_V(6); G8_BAR; G8_MMA(1, 1, At, B1); G8_BAR;
        }
        { const int l2 = TID512() & 63; prob.epi(acc, cur, wr, wc, l2 & 15, l2 >> 4); }
        if (!has_next) break;
#pragma unroll
        for (int a = 0; a < 2; ++a)
#pragma unroll
            for (int b = 0; b < 2; ++b)
#pragma unroll
                for (int m = 0; m < 4; ++m)
#pragma unroll
                    for (int n = 0; n < 2; ++n) acc[a][b][m][n] = (f32x4){0.f, 0.f, 0.f, 0.f};
        cur = nxt; cA = nA; cB = nB; ++ui;
        if (P::GATHER) {
#pragma unroll
            for (int h = 0; h < 2; ++h) { vaC[h][0] = vaN[h][0]; vaC[h][1] = vaN[h][1]; }
        }
    }
    G8_WAIT_V(0);
    if (wr == 0) G8_BAR;
    G8_BAR;
#undef G8_SA
#undef G8_SB
#undef G8_STAGEA
#undef G8_STAGEB
#undef G8_LDA
#undef G8_LDB
#undef G8_MMA
#undef G8_WAIT_V
#undef G8_WAIT_L
#undef G8_BAR
#undef G8_SCHED
}
}

struct ProbG {
    static constexpr int K = 1024; static constexpr bool PERM = true, GATHER = false;
    KP p; int layer;
    DI bool next(int i, g8::Unit& u) const {
        const int id = i * (int)gridDim.x + BIDX();
        if (id >= 256) return false;
        if (gridDim.x == 256) { const int x = id & 7, y = id >> 3; u.pm = x * 8 + (y >> 2); u.pn = y & 3; } else { u.pm = id >> 2; u.pn = id & 3; }
        u.aux = 0;
        return true;
    }
    DI const char* a_base(const g8::Unit& u) const { return (const char*)(P_hx(p) + (long)u.pm * 256 * DM); }
    DI const char* b_base(const g8::Unit& u) const { return (const char*)(P_wt_out(p) + (long)u.pn * 256 * DM); }
    DI void gather(const g8::Unit&, const int (&)[2], const int (&)[2], unsigned (&)[2][2]) const {}
    DI void epi(g8::Acc& acc, const g8::Unit& u, int wr, int wc, int fr, int fq) const {
        const float* md = P_mod(p) + (layer * 2) * 6144 + 2 * 1024;
        f32x4 mv[2][2];
#pragma unroll
        for (int bj = 0; bj < 2; ++bj)
#pragma unroll
            for (int n = 0; n < 2; ++n) mv[bj][n] = *(const f32x4*)(md + u.pn * 256 + bj * 128 + wc * 32 + fq * 8 + n * 4);
#pragma unroll
        for (int ai = 0; ai < 2; ++ai)
#pragma unroll
            for (int m = 0; m < 4; ++m) {
                const long row = (long)u.pm * 256 + ai * 128 + wr * 64 + m * 16 + fr;
#pragma unroll
                for (int bj = 0; bj < 2; ++bj) {
                    const int col = u.pn * 256 + bj * 128 + wc * 32 + fq * 8;
                    f32x4 x0, x1;
                    if (layer == 0) { x0 = *(const f32x4*)(p->x + row * DM + col); x1 = *(const f32x4*)(p->x + row * DM + col + 4); }
                    else { const u32x4 w = *(const u32x4*)(P_xres(p) + row * DM + col); x0 = f32x4{bflo(w[0]), bfhi(w[0]), bflo(w[1]), bfhi(w[1])}; x1 = f32x4{bflo(w[2]), bfhi(w[2]), bflo(w[3]), bfhi(w[3])}; }
                    x0 += mv[bj][0] * acc[ai][bj][m][0]; x1 += mv[bj][1] * acc[ai][bj][m][1];
                    u32x4 o; o[0] = pack2(x0[0], x0[1]); o[1] = pack2(x0[2], x0[3]); o[2] = pack2(x1[0], x1[1]); o[3] = pack2(x1[2], x1[3]);
                    *(u32x4*)(P_xres(p) + row * DM + col) = o;
                }
            }
    }
};


constexpr int B_SPARE = 20;
constexpr int CONV_INB = 2560;
struct ProbB {
    static constexpr int K = 1024; static constexpr bool PERM = true, GATHER = false;
    KP p;
    DI bool next(int i, g8::Unit& u) const {
        constexpr int nM = 65, nN = 29, nwg = nM * nN, NX = 8, WGM = 8;
        const int nwork = (int)gridDim.x - B_SPARE;
        if (BIDX() >= nwork) return false;
        const long L = (long)i * nwork + BIDX(); if (L >= nwg) return false;
        int wgid = (int)L; { const int q = nwg / NX, r = nwg % NX, xcd = wgid % NX, off = wgid / NX; wgid = (xcd < r ? xcd * (q + 1) : r * (q + 1) + (xcd - r) * q) + off; }
        const int nig = WGM * nN, gid = wgid / nig, fm = gid * WGM, gsz = (nM - fm) < WGM ? (nM - fm) : WGM;
        u.pm = fm + ((wgid % nig) % gsz); u.pn = (wgid % nig) / gsz; u.aux = 0; return true;
    }
    DI const char* a_base(const g8::Unit& u) const { return (const char*)(P_hx(p) + (long)u.pm * 256 * DM); }
    DI const char* b_base(const g8::Unit& u) const { return (const char*)(P_wt_in(p) + (long)u.pn * 256 * DM); }
    DI void gather(const g8::Unit&, const int (&)[2], const int (&)[2], unsigned (&)[2][2]) const {}
    DI void epi(g8::Acc& acc, const g8::Unit& u, int wr, int wc, int fr, int fq) const {
        const int pn = u.pn;
        const bool lat = u.pm < 64;
        const int rk = !lat ? 0 : (pn < 4) ? 1 : (pn == 8 || pn == 9 || (pn == 10 && wc < 2)) ? 2 : 0;
        const float mul = (pn == 2 || pn == 3) ? 0.08838834764831845f : (pn == 8 || pn == 9 || pn == 11 || pn == 12) ? 0.125f : 1.f;
#pragma unroll
        for (int ai = 0; ai < 2; ++ai)
#pragma unroll
            for (int m = 0; m < 4; ++m) {
                const int row = u.pm * 256 + ai * 128 + wr * 64 + m * 16 + fr;
                if (rk != 0) {
                    const float2* tab;
                    if (rk == 1) tab = P_rope128(p) + ((wc & 1) ? (row & 63) : (row >> 6)) * 32 + fq * 8;
                    else tab = P_rope64(p) + ((fq >= 2) ? (row & 63) : (row >> 6)) * 16 + (fq & 1) * 8;
#pragma unroll
                    for (int n = 0; n < 2; ++n) {
                        const f32x4 c01 = *(const f32x4*)(tab + n * 4), c23 = *(const f32x4*)(tab + n * 4 + 2);
                        const float cs_[4] = {c01[0], c01[2], c23[0], c23[2]}, sn_[4] = {c01[1], c01[3], c23[1], c23[3]};
#pragma unroll
                        for (int e = 0; e < 4; ++e) {
                            const float x1 = acc[ai][0][m][n][e], x2 = acc[ai][1][m][n][e];
                            acc[ai][0][m][n][e] = x1 * cs_[e] - x2 * sn_[e];
                            acc[ai][1][m][n][e] = x1 * sn_[e] + x2 * cs_[e];
                        }
                    }
                }
                u16* orow = P_px(p) + (long)row * INC + pn * 256 + wc * 32 + fq * 8;
#pragma unroll
                for (int bj = 0; bj < 2; ++bj) {
                    u32x4 o;
#pragma unroll
                    for (int n = 0; n < 2; ++n)
#pragma unroll
                        for (int e = 0; e < 2; ++e) o[2 * n + e] = pack2(acc[ai][bj][m][n][2 * e] * mul, acc[ai][bj][m][n][2 * e + 1] * mul);
                    *(u32x4*)(orow + bj * 128) = o;
                }
            }
    }
};
struct ProbF {
    static constexpr int K = 512; static constexpr bool PERM = true, GATHER = false;
    KP p;
    DI bool next(int i, g8::Unit& u) const {
        const int tile = (i / 3) * (int)gridDim.x + BIDX();
        if (tile >= 256) return false;
        if (gridDim.x == 256) { const int x = tile & 7, y = tile >> 3; u.pm = x * 8 + (y >> 2); u.pn = y & 3; } else { u.pm = tile >> 2; u.pn = tile & 3; }
        u.aux = i % 3;
        return true;
    }
    DI const char* a_base(const g8::Unit& u) const { const u16* y = u.aux == 0 ? P_ya(p) : u.aux == 1 ? P_yb(p) : P_yc(p); return (const char*)(y + (long)u.pm * 256 * 512); }
    DI const char* b_base(const g8::Unit& u) const { const u16* w = u.aux == 0 ? P_wt_ret(p) : u.aux == 1 ? P_wt_win(p) : P_wt_na(p); return (const char*)(w + (long)u.pn * 256 * 512); }
    DI void gather(const g8::Unit&, const int (&)[2], const int (&)[2], unsigned (&)[2][2]) const {}
    DI void epi(g8::Acc& acc, const g8::Unit& u, int wr, int wc, int fr, int fq) const {
        const int b = u.aux;
        const long row0 = (long)u.pm * 256 + wr * 64 + fr;
        const int col0 = u.pn * 256 + wc * 32 + fq * 8;
        if (b != 2) {
            u16* z = P_z(p) + (long)b * NLAT * DM;
#pragma unroll
            for (int ai = 0; ai < 2; ++ai)
#pragma unroll
                for (int m = 0; m < 4; ++m)
#pragma unroll
                    for (int bj = 0; bj < 2; ++bj) {
                        u32x4 o;
#pragma unroll
                        for (int n = 0; n < 2; ++n)
#pragma unroll
                            for (int e = 0; e < 2; ++e) o[2 * n + e] = pack2(acc[ai][bj][m][n][2 * e], acc[ai][bj][m][n][2 * e + 1]);
                        *(u32x4*)(z + (row0 + ai * 128 + m * 16) * DM + col0 + bj * 128) = o;
                    }
            return;
        }
        const u16* zb = P_z(p);
        const u16* gp = P_px(p) + C_GATE;
#pragma unroll
        for (int ai = 0; ai < 2; ++ai)
#pragma unroll
            for (int m = 0; m < 4; ++m)
#pragma unroll
                for (int bj = 0; bj < 2; ++bj) {
                    const long row = row0 + ai * 128 + m * 16; const int col = col0 + bj * 128;
                    u32x4 zv[2], gv[3];
#pragma unroll
                    for (int q = 0; q < 2; ++q) zv[q] = *(const u32x4*)(zb + ((long)q * NLAT + row) * DM + col);
#pragma unroll
                    for (int q = 0; q < 3; ++q) gv[q] = *(const u32x4*)(gp + row * INC + q * 1024 + col);
                    u32x4 o;
#pragma unroll
                    for (int e = 0; e < 4; ++e) {
                        const int n = e >> 1, e2 = (e & 1) * 2;
                        float lo = acc[ai][bj][m][n][e2] * sigmoidf_(bflo(gv[2][e])), hi = acc[ai][bj][m][n][e2 + 1] * sigmoidf_(bfhi(gv[2][e]));
#pragma unroll
                        for (int q = 0; q < 2; ++q) { lo += bflo(zv[q][e]) * sigmoidf_(bflo(gv[q][e])); hi += bfhi(zv[q][e]) * sigmoidf_(bfhi(gv[q][e])); }
                        o[e] = pack2(lo, hi);
                    }
                    *(u32x4*)(P_hx(p) + row * DM + col) = o;
                }
    }
};
struct ProbJ {
    static constexpr int K = 1024; static constexpr bool PERM = true, GATHER = true;
    KP p;
    DI bool next(int i, g8::Unit& u) const {
        const int id = i * (int)gridDim.x + BIDX();
        if (id >= 1024) return false;
        if (gridDim.x == 256) {
            const int x = BIDX() & 7, y = BIDX() >> 3;
            u.aux = 4 * i + (x >> 1); u.pm = (x & 1) * 4 + (y >> 3); u.pn = y & 7;
        } else { u.aux = id >> 6; u.pm = (id >> 3) & 7; u.pn = id & 7; }
        return true;
    }
    DI const char* a_base(const g8::Unit&) const { return (const char*)P_hx(p); }
    DI const char* b_base(const g8::Unit& u) const { return (const char*)(P_wt_gu(p) + ((long)u.aux * 2048 + u.pn * 256) * DM); }
    DI void gather(const g8::Unit& u, const int (&R)[2], const int (&C)[2], unsigned (&va)[2][2]) const {
        const int* si = P_sel_idx(p) + u.aux * 2048 + u.pm * 256;
#pragma unroll
        for (int h = 0; h < 2; ++h)
#pragma unroll
            for (int j = 0; j < 2; ++j) va[h][j] = (unsigned)(si[h * 128 + R[j]] * DM + C[j]) * 2u;
    }
    DI void epi(g8::Acc& acc, const g8::Unit& u, int wr, int wc, int fr, int fq) const {
        u16* hb = P_hid(p) + (long)u.aux * 2048 * EH;
#pragma unroll
        for (int ai = 0; ai < 2; ++ai)
#pragma unroll
            for (int m = 0; m < 4; ++m) {
                const int slot = u.pm * 256 + ai * 128 + wr * 64 + m * 16 + fr;
                const int f = u.pn * 128 + wc * 32 + fq * 8;
                u32x4 o;
#pragma unroll
                for (int n = 0; n < 2; ++n)
#pragma unroll
                    for (int e = 0; e < 2; ++e)
                        o[2 * n + e] = pack2(siluf_(acc[ai][0][m][n][2 * e]) * acc[ai][1][m][n][2 * e], siluf_(acc[ai][0][m][n][2 * e + 1]) * acc[ai][1][m][n][2 * e + 1]);
                *(u32x4*)(hb + (long)slot * EH + f) = o;
            }
    }
};
struct ProbK {
    static constexpr int K = 1024; static constexpr bool PERM = true, GATHER = false;
    KP p; int layer;
    DI bool next(int i, g8::Unit& u) const {
        const int id = i * (int)gridDim.x + BIDX();
        if (id >= 512) return false;
        if (gridDim.x == 256) { const int x = BIDX() & 7, y = BIDX() >> 3; u.aux = 8 * i + x; u.pm = y >> 2; u.pn = y & 3; }
        else { u.aux = id >> 5; u.pm = (id >> 2) & 7; u.pn = id & 3; }
        return true;
    }
    DI const char* a_base(const g8::Unit& u) const { return (const char*)(P_hid(p) + ((long)u.aux * 2048 + u.pm * 256) * EH); }
    DI const char* b_base(const g8::Unit& u) const { return (const char*)(P_wt_dn(p) + ((long)u.aux * 1024 + u.pn * 256) * EH); }
    DI void gather(const g8::Unit&, const int (&)[2], const int (&)[2], unsigned (&)[2][2]) const {}
    DI void epi(g8::Acc& acc, const g8::Unit& u, int wr, int wc, int fr, int fq) const {
        const float* md = P_mod(p) + (layer * 2) * 6144 + 5 * 1024;
        f32x4 mv[2][2];
#pragma unroll
        for (int bj = 0; bj < 2; ++bj)
#pragma unroll
            for (int n = 0; n < 2; ++n) mv[bj][n] = *(const f32x4*)(md + u.pn * 256 + bj * 128 + wc * 32 + fq * 8 + n * 4);
#pragma unroll
        for (int ai = 0; ai < 2; ++ai)
#pragma unroll
            for (int m = 0; m < 4; ++m) {
                const int slot = u.aux * 2048 + u.pm * 256 + ai * 128 + wr * 64 + m * 16 + fr;
                const float g = P_sel_gate(p)[slot];
                u16* yr = P_ye(p) + (long)slot * DM + u.pn * 256 + wc * 32 + fq * 8;
#pragma unroll
                for (int bj = 0; bj < 2; ++bj) {
                    u32x4 o;
#pragma unroll
                    for (int n = 0; n < 2; ++n)
#pragma unroll
                        for (int e = 0; e < 2; ++e)
                            o[2 * n + e] = pack2(acc[ai][bj][m][n][2 * e] * g * mv[bj][n][2 * e], acc[ai][bj][m][n][2 * e + 1] * g * mv[bj][n][2 * e + 1]);
                    *(u32x4*)(yr + bj * 128) = o;
                }
            }
    }
};

DI void phH_item(KP p, int layer, int item, char* smem) {
    const int lane = TIDX() & 63, wid = TIDX() >> 6;
    float* hrow = (float*)smem + wid * 4096;
    const int row0 = item * 16 + wid * 4;
    norm_rows4(p, layer, row0, p->g_ffn + layer * DM, 3, 4, false, false, hrow);
    const int e = lane & 15, kp = lane >> 4;
    const float* wr_ = p->w_router + (long)layer * 1024 * 16 + e;
    float lg[4] = {0.f, 0.f, 0.f, 0.f};
#pragma unroll 8
    for (int k = kp * 256; k < kp * 256 + 256; ++k) {
        float w = wr_[k * 16];
#pragma unroll
        for (int r = 0; r < 4; ++r) lg[r] += hrow[r * 1024 + k] * w;
    }
#pragma unroll
    for (int r = 0; r < 4; ++r) {
        float l = lg[r];
        l += __shfl_xor(l, 16); l += __shfl_xor(l, 32);
        float mx = l;
        mx = fmaxf(mx, __shfl_xor(mx, 1)); mx = fmaxf(mx, __shfl_xor(mx, 2)); mx = fmaxf(mx, __shfl_xor(mx, 4)); mx = fmaxf(mx, __shfl_xor(mx, 8));
        float ex = expf(l - mx);
        float sm = ex;
        sm += __shfl_xor(sm, 1); sm += __shfl_xor(sm, 2); sm += __shfl_xor(sm, 4); sm += __shfl_xor(sm, 8);
        float a = ex / sm;
        int row = row0 + r;
        if (lane < 16) {
            if (row < NLAT) P_aff(p)[(long)e * NLAT + row] = a;
            else P_aff(p)[(long)(16 + e) * NLAT + (row - NLAT)] = a;
        }
    }
    __syncthreads();
}

DI int block_excl_scan(int v, int* sh  , int& total) {
    const int lane = TIDX() & 63, wid = TIDX() >> 6;
    int inc = v;
    for (int o = 1; o < 64; o <<= 1) { int t = __shfl_up(inc, o); if (lane >= o) inc += t; }
    __syncthreads();
    if (lane == 63) sh[wid] = inc;
    __syncthreads();
    int base = 0;
    for (int w = 0; w < wid; ++w) base += sh[w];
    total = sh[0] + sh[1] + sh[2] + sh[3];
    return base + inc - v;
}
DI void phI_item(KP p, int job, char* smem) {
    const int tid = TIDX(), lane = tid & 63, wid = tid >> 6;
    const bool lat = job < 16;
    const int n = lat ? NLAT : NCTX, cap = lat ? CAP_LAT : CAP_CTX, rowbase = lat ? 0 : NLAT;
    int* sh = (int*)smem;
    const float* a = P_aff(p) + (long)job * NLAT;
    unsigned keys[64];
    if (lat) {
#pragma unroll
        for (int i = 0; i < 16; ++i) { u32x4 v = *(const u32x4*)(a + tid * 64 + i * 4); keys[4 * i] = v[0]; keys[4 * i + 1] = v[1]; keys[4 * i + 2] = v[2]; keys[4 * i + 3] = v[3]; }
    } else {
#pragma unroll
        for (int i = 0; i < 64; ++i) keys[i] = 0u;
        keys[0] = __float_as_uint(a[tid]);
    }
    __syncthreads();
    auto block_sum = [&](int v, int it) -> int {
        for (int o = 32; o > 0; o >>= 1) v += __shfl_xor(v, o);
        int* slot = sh + (it & 1) * 4;
        if (lane == 0) slot[wid] = v;
        __syncthreads();
        return slot[0] + slot[1] + slot[2] + slot[3];
    };
    int* hist = sh + 32;
    unsigned T = 0u, pmask = 0u; int remaining = cap;
#pragma unroll 1
    for (int pass = 0; pass < 3; ++pass) {
        const int shift = pass == 0 ? 19 : pass == 1 ? 8 : 0, nb_ = pass == 2 ? 256 : 2048;
        for (int i = tid; i < 2048; i += 256) hist[i] = 0;
        __syncthreads();
#pragma unroll
        for (int i = 0; i < 64; ++i) { const unsigned k = keys[i]; if (k != 0u && (k & pmask) == T) atomicAdd(&hist[(k >> shift) & (nb_ - 1)], 1); }
        __syncthreads();
        int mine = 0;
        const int top = nb_ - 1 - 8 * tid;
        if (top >= 7) {
#pragma unroll
            for (int q = 0; q < 8; ++q) mine += hist[top - q];
        }
        int tot_;
        const int above = block_excl_scan(mine, sh + 8, tot_);
        if (top >= 7 && above < remaining && above + mine >= remaining) {
            int cum = above, q = 0;
            for (; q < 7; ++q) { const int hv = hist[top - q]; if (cum + hv >= remaining) break; cum += hv; }
            sh[16] = top - q; sh[17] = remaining - cum;
        }
        __syncthreads();
        T |= ((unsigned)sh[16]) << shift; pmask |= ((unsigned)(nb_ - 1)) << shift; remaining = sh[17];
        __syncthreads();
    }
    int ceq = 0;
#pragma unroll
    for (int i = 0; i < 64; ++i) ceq += (keys[i] == T);
    const int it = 0; (void)it; (void)block_sum;
    __syncthreads();
    int tot;
    int er = block_excl_scan(ceq, sh + 8, tot);
    int csel = 0;
    { int e2 = er;
#pragma unroll
      for (int i = 0; i < 64; ++i) { const unsigned k = keys[i]; if (k > T) ++csel; else if (k == T) { if (e2 < remaining) ++csel; ++e2; } } }
    int slot = block_excl_scan(csel, sh + 8, tot);
    int* ts = P_tslot(p) + (long)job * NLAT;
    const int per = lat ? 64 : 1;
    const int base = tid * per;
#pragma unroll
    for (int i = 0; i < 64; ++i) {
        if (i < per) {
            const unsigned k = keys[i];
            bool sel = false;
            if (k > T) sel = true; else if (k == T) { sel = er < remaining; ++er; }
            if (sel) { P_sel_idx(p)[job * 2048 + slot] = rowbase + base + i; P_sel_gate(p)[job * 2048 + slot] = __uint_as_float(k); ts[base + i] = slot; ++slot; }
            else ts[base + i] = -1;
        }
    }
    __syncthreads();
}

DI void phJ_tile(KP p, int job, int mt, int nt, char* smem) {
    const int tid = TIDX(), lane = tid & 63, wid = tid >> 6, wr = wid >> 1, wc = wid & 1, fr = lane & 15, fq = lane >> 4;
    const int cap = job < 16 ? CAP_LAT : CAP_CTX, e = job & 15;
    f32x4 acc[4][4]; zero_acc<4>(acc);
    const int r0 = tid >> 2, ko = (tid & 3) * 8;
    int s0 = mt * 128 + r0, s1 = s0 + 64;
    s0 = s0 < cap ? s0 : cap - 1; s1 = s1 < cap ? s1 : cap - 1;
    const u16* a0 = P_hx(p) + (long)P_sel_idx(p)[job * 2048 + s0] * DM + ko;
    const u16* a1 = P_hx(p) + (long)P_sel_idx(p)[job * 2048 + s1] * DM + ko;
    const int f_lo = nt * 64 + (r0 & 31), f_hi = f_lo + 32, gu = (r0 >> 5) & 1;
    const u16* b0 = P_wt_gu(p) + ((long)e * 2048 + (f_lo >> 7) * 256 + gu * 128 + (f_lo & 127)) * DM + ko;
    const u16* b1 = P_wt_gu(p) + ((long)e * 2048 + (f_hi >> 7) * 256 + gu * 128 + (f_hi & 127)) * DM + ko;
    gemm_core<32>(acc, a0, a1, b0, b1, smem);
    u16* hb = job < 16 ? P_hid(p) + (long)job * 2048 * EH : P_hidc(p) + (long)(job - 16) * 32 * EH;
#pragma unroll
    for (int m = 0; m < 4; ++m)
#pragma unroll
        for (int n = 0; n < 2; ++n)
#pragma unroll
            for (int j = 0; j < 4; ++j) {
                int slot = mt * 128 + wr * 64 + m * 16 + fq * 4 + j;
                int f = nt * 64 + wc * 32 + n * 16 + fr;
                if (slot < cap) hb[(long)slot * EH + f] = f2bf(siluf_(acc[m][n][j]) * acc[m][n + 2][j]);
            }
}
DI void phK_tile(KP p, int layer, int job, int mt, int nt, char* smem) {
    const int tid = TIDX(), lane = tid & 63, wid = tid >> 6, wr = wid >> 1, wc = wid & 1, fr = lane & 15, fq = lane >> 4;
    const int cap = job < 16 ? CAP_LAT : CAP_CTX, e = job & 15;
    f32x4 acc[4][4]; zero_acc<4>(acc);
    const int r0 = tid >> 2, ko = (tid & 3) * 8;
    int s0 = mt * 128 + r0, s1 = s0 + 64;
    s0 = s0 < cap ? s0 : cap - 1; s1 = s1 < cap ? s1 : cap - 1;
    const u16* hb = job < 16 ? P_hid(p) + (long)job * 2048 * EH : P_hidc(p) + (long)(job - 16) * 32 * EH;
    const u16* a0 = hb + (long)s0 * EH + ko;
    const u16* a1 = hb + (long)s1 * EH + ko;
    const u16* b0 = P_wt_dn(p) + ((long)e * 1024 + nt * 128 + r0) * EH + ko;
    gemm_core<32>(acc, a0, a1, b0, b0 + 64 * EH, smem);
    const float* md = P_mod(p) + (layer * 2 + (job < 16 ? 0 : 1)) * 6144 + 5 * 1024;
    u16* yb_ = job < 16 ? P_ye(p) + (long)job * 2048 * DM : P_yec(p) + (long)(job - 16) * 32 * DM;
#pragma unroll
    for (int m = 0; m < 4; ++m)
#pragma unroll
        for (int j = 0; j < 4; ++j) {
            int slot = mt * 128 + wr * 64 + m * 16 + fq * 4 + j;
            if (slot < cap) {
                float g = P_sel_gate(p)[job * 2048 + slot];
#pragma unroll
                for (int n = 0; n < 4; ++n) {
                    int col = nt * 128 + wc * 64 + n * 16 + fr;
                    yb_[(long)slot * DM + col] = f2bf(acc[m][n][j] * g * md[col]);
                }
            }
        }
}


#define XB_TMO      128
#define XB_XCNT(j)  (256  + 64 * (j))
#define XB_XSUB(j)  (1280 + 64 * (j))
#define XB_XGEN(j)  (2304 + 64 * (j))
#define XB_TOP      3328
#define XB_TOPGEN   3392
#define XCD_BAR_WORDS 3456
#define XB_SPIN_CAP (1u << 18)
DI unsigned xb_ld(unsigned* p)              { return __hip_atomic_load(p, __ATOMIC_RELAXED, __HIP_MEMORY_SCOPE_AGENT); }
DI unsigned xb_add(unsigned* p, unsigned v) { return __hip_atomic_fetch_add(p, v, __ATOMIC_RELAXED, __HIP_MEMORY_SCOPE_AGENT); }
DI unsigned xb_xcc_id() { return (unsigned)__builtin_amdgcn_s_getreg((3 << 11) | 20) & 0xFu; }
#define XB_SPIN(cond, bar) do { unsigned _sp = 0; while (cond) { __builtin_amdgcn_s_sleep(1); \
    if ((++_sp & 255u) == 0u) { if (xb_ld(&(bar)[XB_TMO])) break; if (_sp > XB_SPIN_CAP) { atomicAdd(&(bar)[XB_TMO], 1u); break; } } } } while (0)
struct XcdBarrier { unsigned* bar; unsigned x; volatile LAS unsigned* st; };
DI XcdBarrier xcd_barrier_post(unsigned* bar, volatile LAS unsigned* st) {
    XcdBarrier b; b.bar = bar; b.x = xb_xcc_id(); b.st = st;
    if (threadIdx.x == 0) (void)xb_add(&bar[XB_XCNT(b.x)], 1u);
    return b;
}
DI void xcd_barrier_complete(unsigned* bar, unsigned x, unsigned& nloc, unsigned& nx) {
    const unsigned G = gridDim.x * gridDim.y * gridDim.z;
    unsigned sum, cnt, mine, sp = 0u;
    for (;;) {
        sum = 0u; cnt = 0u; mine = 0u;
#pragma unroll
        for (unsigned j = 0; j < 16; ++j) { const unsigned c = xb_ld(&bar[XB_XCNT(j)]); sum += c; cnt += (c > 0u) ? 1u : 0u; mine = (j == x) ? c : mine; }
        if (sum == G) break;
        __builtin_amdgcn_s_sleep(1);
        if ((++sp & 255u) == 0u) { if (xb_ld(&bar[XB_TMO])) break; if (sp > XB_SPIN_CAP) { atomicAdd(&bar[XB_TMO], 1u); break; } }
    }
    nloc = mine > 0u ? mine : 1u; nx = cnt > 0u ? cnt : 1u;
}
DI void xcd_barrier(const XcdBarrier& b) {
    asm volatile("s_waitcnt vmcnt(0)" ::: "memory");
    __syncthreads();
    if (threadIdx.x == 0) {
        unsigned* bar = b.bar;
        __builtin_amdgcn_s_waitcnt(0);
        unsigned nloc = b.st[0], nx = b.st[1];
        if (nloc == 0u) { xcd_barrier_complete(bar, b.x, nloc, nx); b.st[0] = nloc; b.st[1] = nx; }
        const unsigned old = xb_add(&bar[XB_XSUB(b.x)], 1u);
        const unsigned gen = old / nloc;
        if (old + 1u == (gen + 1u) * nloc) {
            __builtin_amdgcn_fence(__ATOMIC_RELEASE, "agent");
            asm volatile("s_waitcnt vmcnt(0)" ::: "memory");
            const unsigned og = xb_add(&bar[XB_TOP], 1u);
            const unsigned tg = og / nx;
            if (og + 1u == (tg + 1u) * nx) xb_add(&bar[XB_TOPGEN], 1u);
            else XB_SPIN(xb_ld(&bar[XB_TOPGEN]) == tg, bar);
            __builtin_amdgcn_fence(__ATOMIC_ACQUIRE, "agent");
            xb_add(&bar[XB_XGEN(b.x)], 1u);
            asm volatile("s_waitcnt vmcnt(0)" ::: "memory");
        } else {
            XB_SPIN(xb_ld(&bar[XB_XGEN(b.x)]) == gen, bar);
            __builtin_amdgcn_fence(__ATOMIC_ACQUIRE, "agent");
            asm volatile("s_waitcnt vmcnt(0)" ::: "memory");
        }
    }
    __syncthreads();
}

DI void run_phase(int ph, char* smem_all, int variant = 0) {
    KP p = (KP)__builtin_amdgcn_kernarg_segment_ptr();
    asm volatile("" : "+s"(p));
    const int sb = TID512() >> 8;
    char* smem = smem_all + sb * SUB_LDS;
    const int bid = BIDX() * 2 + sb, nb = gridDim.x * 2, tid = TIDX(), wid = tid >> 6;
#ifndef ONLY_SUB
    if (ph == 0) {
        for (int it = bid; it < 240; it += nb) {
            if (it < 192) ph0_gemv_item(p, it, smem);
            else ph0_rope_item(p, it - 192);
        }
        convert_tiles(p, 0, bid, CONV_DENSE, nb, smem);
        return;
    }
    if (ph == NPHASE - 1) {
        for (int it = bid; it < NLAT / 16; it += nb) {
            const int row0 = it * 16 + wid * 4, lane = tid & 63;
            float4 v[4][4];
#pragma unroll
            for (int r = 0; r < 4; ++r) load_res_row(p, row0 + r, false, v[r]);
            float4 g[4];
#pragma unroll
            for (int i = 0; i < 4; ++i) g[i] = *(const float4*)(p->g_final + i * 256 + lane * 4);
#pragma unroll
            for (int r = 0; r < 4; ++r) {
                moe_combine(p, row0 + r, v[r]);
                float ss = 0.f;
#pragma unroll
                for (int i = 0; i < 4; ++i) ss += v[r][i].x * v[r][i].x + v[r][i].y * v[r][i].y + v[r][i].z * v[r][i].z + v[r][i].w * v[r][i].w;
                ss = wave_sum(ss);
                const float rstd = rsqrtf(ss * (1.f / DM) + 1e-6f);
                float* xr = p->out + (long)(row0 + r) * DM;
#pragma unroll
                for (int i = 0; i < 4; ++i)
                    *(float4*)(xr + i * 256 + lane * 4) = make_float4(v[r][i].x * rstd * g[i].x, v[r][i].y * rstd * g[i].y, v[r][i].z * rstd * g[i].z, v[r][i].w * rstd * g[i].w);
            }
        }
        return;
    }
    const int layer = (ph - 1) / 11, sub = (ph - 1) % 11;
#else
    const int layer = (ph - 1) / 11, sub = ONLY_SUB;
#endif
    const bool need_ctx = layer == 0;
    switch (sub) {
    case 0: {
        const int nrow_items = NROWS / 16;
        for (int it = bid; it < nrow_items; it += nb) norm_rows4(p, layer, it * 16 + wid * 4, p->g_mix + layer * DM, 0, 1, layer == 0, layer == 1);
        if (layer == 1) convert_tiles(p, layer, bid, CONV_DENSE, nb, smem);
    } break;
    case 1: {
        { ProbB pb{p}; g8::gemm_phase((LAS unsigned char*)smem_all, pb); }
        const int nwork = (int)gridDim.x - B_SPARE;
        if (BIDX() >= nwork) {
            const int sb2 = TID512() >> 8, q = (BIDX() - nwork) * 2 + sb2;
            convert_tiles4(p, layer, CONV_DENSE + q, CONV_DENSE + CONV_INB, 2 * B_SPARE, smem_all + sb2 * SUB_LDS);
        }
    } break;
    case 2: {
        const int n_state = NCHUNK * 8, n_win = 1024, n_na = 1024, n_cx = need_ctx ? 32 : 0;
        const int total = n_state + n_win + n_na + n_cx;
        for (int it = bid; it < total; it += nb) {
            if (variant == 1 && it >= n_na && it < n_na + n_win) continue;
            if (variant == 1 && it >= n_na + n_win) continue;
            if (variant == 2 && (it < n_na || it >= n_na + n_win)) continue;
            if (variant == 3 && (it < n_na + n_win || it >= n_na + n_win + n_state)) continue;
            if (it < n_na) attn_block_item(p, layer, 1, it >> 3, it & 7, smem);
            else if (it < n_na + n_win) { int i2 = it - n_na; attn_block_item(p, layer, 0, i2 >> 1, i2 & 1, smem); }
            else if (it < n_win + n_na + n_state) { int i2 = it - n_win - n_na; phC_state_item(p, layer, i2 >> 3, (i2 >> 1) & 3, i2 & 1, smem); }
            else { int i2 = it - n_win - n_na - n_state; if (i2 < 16) attn_block_item(p, layer, 2, i2 >> 1, i2 & 1, smem); else { i2 -= 16; attn_block_item(p, layer, 3, i2 >> 3, i2 & 7, smem); } }
        }
    } break;
    case 3: {
        for (int it = bid; it < 512; it += nb) phD_item(p, layer, it);
    } break;
    case 4: {
        const int nch = need_ctx ? NCHUNK : 128;
        for (int it = bid; it < nch * 8; it += nb) phE_item(p, layer, it >> 3, (it >> 1) & 3, it & 1, smem);
        if (need_ctx && bid >= nb - 64) {
            float* z = P_maccx(p) + (long)(bid - (nb - 64)) * 4096 + tid * 16;
#pragma unroll
            for (int i = 0; i < 4; ++i) *(f32x4*)(z + i * 4) = f32x4{0.f, 0.f, 0.f, 0.f};
        }
    } break;
    case 5: {
        { ProbF pf{p}; g8::gemm_phase((LAS unsigned char*)smem_all, pf); }
        if (need_ctx) {
            const int sb2 = TID512() >> 8;
            for (int it = BIDX() * 2 + sb2; it < 384; it += (int)gridDim.x * 2) { const int tb = it >> 3, tile = tb / 3; phF_tile(p, 128 + (tile >> 3), tile & 7, tb % 3, it & 7, smem_all + sb2 * SUB_LDS); }
        }
    } break;
    case 6: {
        { ProbG pg{p, layer}; g8::gemm_phase((LAS unsigned char*)smem_all, pg); }
        if (need_ctx) {
            const int sb2 = TID512() >> 8;
            for (int it = BIDX() * 2 + sb2; it < 512; it += (int)gridDim.x * 2) { const int tile = it >> 5; phG_tile(p, layer, 128 + (tile >> 3), tile & 7, it & 31, smem_all + sb2 * SUB_LDS); }
        }
    } break;
    case 7: {
        const int nit = (need_ctx ? NROWS : NLAT) / 16;
        for (int it = bid; it < nit; it += nb) phH_item(p, layer, it, smem);
    } break;
    case 8: {
        const int njob = need_ctx ? 32 : 16;
        for (int it = bid; it < njob; it += nb) phI_item(p, it, smem);
        convert_tiles(p, layer, CONV_DENSE + CONV_INB + bid, CONV_TILES, nb, smem);
    } break;
    case 9: {
        { ProbJ pj{p}; g8::gemm_phase((LAS unsigned char*)smem_all, pj); }
        if (need_ctx) {
            const int sb2 = TID512() >> 8;
            for (int it = BIDX() * 2 + sb2; it < 256; it += (int)gridDim.x * 2) phJ_tile(p, 16 + (it >> 4), 0, it & 15, smem_all + sb2 * SUB_LDS);
        }
    } break;
    case 10: {
        { ProbK pk{p, layer}; g8::gemm_phase((LAS unsigned char*)smem_all, pk); }
        if (need_ctx) {
            const int sb2 = TID512() >> 8;
            for (int it = BIDX() * 2 + sb2; it < 128; it += (int)gridDim.x * 2) phK_tile(p, layer, 16 + (it >> 3), 0, it & 7, smem_all + sb2 * SUB_LDS);
        }
    } break;
    }
}

__global__ void __launch_bounds__(NTHREADS, 2) mega_kernel(Params p, int ph_lo, int ph_hi) {
    __shared__ __attribute__((aligned(16))) char smem[LDS_BYTES + 16];
    cg::grid_group grid = cg::this_grid();
#if MK_MULTI
    for (int ph = ph_lo; ph < ph_hi; ++ph) {
        if (ph > ph_lo) grid.sync();
        run_phase(ph, smem);
    }
#else
    unsigned* barw = (unsigned*)(p.ws + WS_BAR);
    volatile LAS unsigned* xst = (volatile LAS unsigned*)(LAS char*)(smem + LDS_BYTES);
    if (threadIdx.x < 4) xst[threadIdx.x] = 0u;
    if (blockIdx.x == 0) for (int i = threadIdx.x; i < XCD_BAR_WORDS; i += NTHREADS) barw[i] = 0u;
    run_phase(0, smem);
    grid.sync();
    const XcdBarrier xb = xcd_barrier_post(barw, xst);
#ifdef PROBE_SUB
#define PH(n) do { if ((n) > 1) xcd_barrier(xb); run_phase((n), smem); if ((n) >= PROBE_MIN && (n) <= PROBE_MAX && (((n) - 1) % 11) == PROBE_SUB) { xcd_barrier(xb); run_phase((n), smem, PROBE_VARIANT); } } while (0)
#else
#define PH(n) do { if ((n) > 1) xcd_barrier(xb); run_phase((n), smem); } while (0)
#endif
    PH(1); PH(2); PH(3); PH(4); PH(5); PH(6); PH(7); PH(8); PH(9); PH(10); PH(11);
    PH(12); PH(13); PH(14); PH(15); PH(16); PH(17); PH(18); PH(19); PH(20); PH(21); PH(22); PH(23);
    static_assert(NPHASE == 24, "phase program");
#undef PH
#endif
}

extern "C" void kernel_launch(void* const* d_in, const int* in_sizes, int n_in, void* d_out, int out_size, void* d_ws, size_t ws_size,
                              hipStream_t stream) {
    static int grid_blocks = 0;
    if (!grid_blocks) {
        int dev = 0, cus = 0, per_cu = 0;
        hipGetDevice(&dev);
        hipDeviceGetAttribute(&cus, hipDeviceAttributeMultiprocessorCount, dev);
        hipOccupancyMaxActiveBlocksPerMultiprocessor(&per_cu, mega_kernel, NTHREADS, 0);
        if (per_cu < 1) per_cu = 1;
        if (per_cu > 1) per_cu = 1;
        grid_blocks = cus * per_cu;
    }
    Params p{};
    const float** ip = (const float**)&p.x;
    for (int i = 0; i < 22; ++i) ip[i] = (const float*)d_in[i];
    p.out = (float*)d_out;
    p.ws = (char*)d_ws;
    if (WS_END > ws_size) { fprintf(stderr, "kernel_launch: workspace too small: need %zu have %zu\n", (size_t)WS_END, ws_size); return; }
#if MK_MULTI
    for (int ph = 0; ph < NPHASE; ++ph) {
        hipLaunchKernelGGL(mega_kernel, dim3(grid_blocks), dim3(NTHREADS), 0, stream, p, ph, ph + 1);
    }
#else
    int lo = 0, hi = NPHASE;
    void* args[] = {&p, &lo, &hi};
    hipError_t e = hipLaunchCooperativeKernel((void*)mega_kernel, dim3(grid_blocks), dim3(NTHREADS), args, 0, stream);
    if (e != hipSuccess) fprintf(stderr, "cooperative launch failed: %s (grid %d)\n", hipGetErrorString(e), grid_blocks);
#endif
}
```

```cpp
#include <hip/hip_runtime.h>
#include <hip/hip_bf16.h>
#include <hip/hip_cooperative_groups.h>
#include <cstdio>
#include <cstdint>
namespace cg = cooperative_groups;

#ifndef MK_MULTI
#define MK_MULTI 0
#endif

#define DI __device__ __forceinline__
typedef unsigned short u16;
typedef __attribute__((ext_vector_type(8))) short bf16x8;
typedef __attribute__((ext_vector_type(4))) float f32x4;
typedef __attribute__((ext_vector_type(4))) unsigned int u32x4;

constexpr int NLAT = 16384, NCTX = 256, NROWS = NLAT + NCTX, DM = 1024, INC = 7424;
constexpr int C_QR = 0, C_KR = 512, C_VR = 1024, C_GR = 1536, C_QW = 2048, C_KW = 2560, C_VW = 2688, C_QN = 2816, C_KN = 3328, C_VN = 3840, C_GATE = 4352;
__host__ __device__ constexpr int col_qr(int h, int x) { return C_QR + (h >> 1) * 256 + x * 128 + (h & 1) * 64; }
__host__ __device__ constexpr int col_kr(int h, int x) { return C_KR + (h >> 1) * 256 + x * 128 + (h & 1) * 64; }
__host__ __device__ constexpr int col_qw(int h, int x) { return C_QW + (h >> 2) * 256 + x * 128 + (h & 3) * 32; }
__host__ __device__ constexpr int col_kw(int kh, int x) { return C_KW + x * 128 + kh * 32; }
__host__ __device__ constexpr int col_vw(int kh) { return C_KW + 64 + kh * 128; }
constexpr int NCHUNK = NROWS / 128;
constexpr int NEXP = 16, EH = 1024, CAP_LAT = 2048, CAP_CTX = 32;
constexpr int NTHREADS = 512;
constexpr int SUB_LDS = 76 * 1024;
constexpr int LDS_BYTES = 2 * SUB_LDS;
constexpr int NPHASE = 24;


constexpr size_t al256(size_t b) { return (b + 255) & ~(size_t)255; }
constexpr size_t WS_CTXRES = 0;
constexpr size_t WS_MOD = WS_CTXRES + al256((size_t)NCTX * DM * 4);
constexpr size_t WS_ROPE128 = WS_MOD + al256(2 * 2 * 6144 * 4);
constexpr size_t WS_ROPE64 = WS_ROPE128 + al256(256 * 32 * 8);
constexpr size_t WS_WT_IN = WS_ROPE64 + al256(256 * 16 * 8);
constexpr size_t WS_WT_RET = WS_WT_IN + al256((size_t)INC * DM * 2);
constexpr size_t WS_WT_WIN = WS_WT_RET + al256((size_t)1024 * 512 * 2);
constexpr size_t WS_WT_NA = WS_WT_WIN + al256((size_t)1024 * 512 * 2);
constexpr size_t WS_WT_OUT = WS_WT_NA + al256((size_t)1024 * 512 * 2);
constexpr size_t WS_WT_GU = WS_WT_OUT + al256((size_t)1024 * 1024 * 2);
constexpr size_t WS_WT_DN = WS_WT_GU + al256((size_t)NEXP * 2048 * 1024 * 2);
constexpr size_t WS_HX = WS_WT_DN + al256((size_t)NEXP * 1024 * 1024 * 2);
constexpr size_t WS_PX = WS_HX + al256((size_t)NROWS * DM * 2);
constexpr size_t WS_YA = WS_PX + al256((size_t)NROWS * INC * 2);
constexpr size_t WS_YB = WS_YA + al256((size_t)NROWS * 512 * 2);
constexpr size_t WS_YC = WS_YB + al256((size_t)NROWS * 512 * 2);
constexpr size_t WS_S = WS_YC + al256((size_t)NROWS * 512 * 2);
constexpr size_t WS_R = WS_S + al256((size_t)NCHUNK * 8 * 16384 * 4);
constexpr size_t WS_AFF = WS_R + al256((size_t)NCHUNK * 8 * 16384 * 2);
constexpr size_t WS_SELI = WS_AFF + al256((size_t)32 * NLAT * 4);
constexpr size_t WS_SELG = WS_SELI + al256(32 * 2048 * 4);
constexpr size_t WS_TSLOT = WS_SELG + al256(32 * 2048 * 4);
constexpr size_t WS_BAR = WS_TSLOT + al256((size_t)32 * NLAT * 4);
constexpr size_t WS_MACCX = WS_BAR + al256(3456 * 4);
constexpr size_t WS_XRES = WS_MACCX + al256((size_t)NCTX * DM * 4);
constexpr size_t WS_END = WS_XRES + al256((size_t)NLAT * DM * 2);
struct Params {
    const float *x, *c, *ctx, *c_ctx, *w_mod, *b_mod, *g_mix, *g_ffn, *w_in, *decay, *ret_gn, *w_ret, *sink, *w_win, *rpb, *w_na, *w_out,
        *w_router, *w_eg, *w_eu, *w_ed, *g_final;
    float* out;
    char* ws;
};
typedef const Params __attribute__((address_space(4)))* KP;
#define WSF(name, type, off) __device__ __forceinline__ type* P_##name(KP p) { return (type*)(p->ws + (off)); }
WSF(ctxres, float, WS_CTXRES)
WSF(mod, float, WS_MOD)
WSF(rope128, float2, WS_ROPE128)
WSF(rope64, float2, WS_ROPE64)
WSF(wt_in, u16, WS_WT_IN) WSF(wt_ret, u16, WS_WT_RET) WSF(wt_win, u16, WS_WT_WIN) WSF(wt_na, u16, WS_WT_NA) WSF(wt_out, u16, WS_WT_OUT)
WSF(wt_gu, u16, WS_WT_GU) WSF(wt_dn, u16, WS_WT_DN)
WSF(hx, u16, WS_HX)
WSF(px, u16, WS_PX)
WSF(ya, u16, WS_YA) WSF(yb, u16, WS_YB) WSF(yc, u16, WS_YC)
WSF(S, float, WS_S)
WSF(R, u16, WS_R)
WSF(aff, float, WS_AFF)
WSF(sel_idx, int, WS_SELI) WSF(sel_gate, float, WS_SELG)
WSF(hid, u16, WS_PX)
__device__ __forceinline__ u16* P_hidc(KP p) { return (u16*)(p->ws + WS_PX) + (size_t)NEXP * 2048 * 1024; }
__device__ __forceinline__ u16* P_ye(KP p) { return (u16*)(p->ws + WS_PX) + (size_t)NEXP * (2048 + 32) * 1024; }
__device__ __forceinline__ u16* P_yec(KP p) { return P_ye(p) + (size_t)NEXP * 2048 * 1024; }
__device__ __forceinline__ int* P_tslot(KP p) { return (int*)(p->ws + WS_TSLOT); }
__device__ __forceinline__ u16* P_z(KP p) { return (u16*)(p->ws + WS_S); }
__device__ __forceinline__ float* P_maccx(KP p) { return (float*)(p->ws + WS_MACCX); }
__device__ __forceinline__ u16* P_xres(KP p) { return (u16*)(p->ws + WS_XRES); }
#undef WSF


DI int TIDX() { int t = threadIdx.x & 255; asm volatile("" : "+v"(t)); return t; }
DI int TID512() { int t = threadIdx.x; asm volatile("" : "+v"(t)); return t; }
DI int BIDX() { int t = blockIdx.x; asm volatile("" : "+s"(t)); return t; }
DI u16 f2bf(float x) { unsigned u = __float_as_uint(x); u += 0x7fffu + ((u >> 16) & 1u); return (u16)(u >> 16); }
DI float bf2f(u16 h) { return __uint_as_float(((unsigned)h) << 16); }
DI float bflo(unsigned w) { return __uint_as_float(w << 16); }
DI float bfhi(unsigned w) { return __uint_as_float(w & 0xffff0000u); }
typedef __bf16 bf16v2 __attribute__((ext_vector_type(2)));
typedef float f32v2 __attribute__((ext_vector_type(2)));
DI unsigned pack2(float a, float b) { f32v2 v = {a, b}; bf16v2 r = __builtin_convertvector(v, bf16v2); return __builtin_bit_cast(unsigned, r); }
DI float sigmoidf_(float x) { return 1.f / (1.f + __expf(-x)); }
DI float siluf_(float x) { return x / (1.f + __expf(-x)); }
DI float wave_sum(float v) { for (int o = 32; o > 0; o >>= 1) v += __shfl_xor(v, o); return v; }
#define MFMA16(a, b, c) __builtin_amdgcn_mfma_f32_16x16x32_bf16((a), (b), (c), 0, 0, 0)

template <int MR>
DI void zero_acc(f32x4 (&acc)[MR][4]) {
#pragma unroll
    for (int m = 0; m < MR; ++m)
#pragma unroll
        for (int n = 0; n < 4; ++n) acc[m][n] = f32x4{0.f, 0.f, 0.f, 0.f};
}

template <int KT>
DI void gemm_core(f32x4 (&acc)[4][4], const u16* a0, const u16* a1, const u16* b0, const u16* b1, char* smem) {
    const int tid = TIDX(), lane = tid & 63, wid = tid >> 6, wr = wid >> 1, wc = wid & 1, fr = lane & 15, fq = lane >> 4;
    auto stage = [&](int kt, int buf) {
        char* base = smem + buf * 16384;
        __builtin_amdgcn_global_load_lds((const unsigned*)(a0 + kt * 32), (unsigned*)(base + tid * 16), 16, 0, 0);
        __builtin_amdgcn_global_load_lds((const unsigned*)(a1 + kt * 32), (unsigned*)(base + 4096 + tid * 16), 16, 0, 0);
        __builtin_amdgcn_global_load_lds((const unsigned*)(b0 + kt * 32), (unsigned*)(base + 8192 + tid * 16), 16, 0, 0);
        __builtin_amdgcn_global_load_lds((const unsigned*)(b1 + kt * 32), (unsigned*)(base + 12288 + tid * 16), 16, 0, 0);
    };
    __syncthreads();
    stage(0, 0);
#pragma unroll 1
    for (int kt = 0; kt < KT; ++kt) {
        asm volatile("s_waitcnt vmcnt(0)" ::: "memory");
        __syncthreads();
        if (kt + 1 < KT) stage(kt + 1, (kt + 1) & 1);
        const char* SA = smem + (kt & 1) * 16384;
        const char* SB = SA + 8192;
        bf16x8 At[4], Bt[4];
#pragma unroll
        for (int m = 0; m < 4; ++m) At[m] = *(const bf16x8*)(SA + (wr * 64 + m * 16 + fr) * 64 + fq * 16);
#pragma unroll
        for (int n = 0; n < 4; ++n) Bt[n] = *(const bf16x8*)(SB + (wc * 64 + n * 16 + fr) * 64 + fq * 16);
#pragma unroll
        for (int m = 0; m < 4; ++m)
#pragma unroll
            for (int n = 0; n < 4; ++n) acc[m][n] = MFMA16(At[m], Bt[n], acc[m][n]);
    }
}

template <int KT>
DI void gemm_core_af32(f32x4 (&acc)[4][4], const float* a0f, const float* a1f, const u16* b0, const u16* b1, char* smem) {
    const int tid = TIDX(), lane = tid & 63, wid = tid >> 6, wr = wid >> 1, wc = wid & 1, fr = lane & 15, fq = lane >> 4;
    f32x4 ar[4];
    auto loadA = [&](int kt) { ar[0] = *(const f32x4*)(a0f + kt * 32); ar[1] = *(const f32x4*)(a0f + kt * 32 + 4); ar[2] = *(const f32x4*)(a1f + kt * 32); ar[3] = *(const f32x4*)(a1f + kt * 32 + 4); };
    auto storeA = [&](int buf) {
        char* base = smem + buf * 16384;
        u32x4 w0, w1;
        w0[0] = pack2(ar[0][0], ar[0][1]); w0[1] = pack2(ar[0][2], ar[0][3]); w0[2] = pack2(ar[1][0], ar[1][1]); w0[3] = pack2(ar[1][2], ar[1][3]);
        w1[0] = pack2(ar[2][0], ar[2][1]); w1[1] = pack2(ar[2][2], ar[2][3]); w1[2] = pack2(ar[3][0], ar[3][1]); w1[3] = pack2(ar[3][2], ar[3][3]);
        *(u32x4*)(base + tid * 16) = w0; *(u32x4*)(base + 4096 + tid * 16) = w1;
    };
    auto stageB = [&](int kt, int buf) {
        char* base = smem + buf * 16384;
        __builtin_amdgcn_global_load_lds((const unsigned*)(b0 + kt * 32), (unsigned*)(base + 8192 + tid * 16), 16, 0, 0);
        __builtin_amdgcn_global_load_lds((const unsigned*)(b1 + kt * 32), (unsigned*)(base + 12288 + tid * 16), 16, 0, 0);
    };
    __syncthreads();
    loadA(0); stageB(0, 0); storeA(0);
#pragma unroll 1
    for (int kt = 0; kt < KT; ++kt) {
        asm volatile("s_waitcnt vmcnt(0)" ::: "memory");
        __syncthreads();
        if (kt + 1 < KT) { loadA(kt + 1); stageB(kt + 1, (kt + 1) & 1); }
        const char* SA = smem + (kt & 1) * 16384;
        const char* SB = SA + 8192;
        bf16x8 At[4], Bt[4];
#pragma unroll
        for (int m = 0; m < 4; ++m) At[m] = *(const bf16x8*)(SA + (wr * 64 + m * 16 + fr) * 64 + fq * 16);
#pragma unroll
        for (int n = 0; n < 4; ++n) Bt[n] = *(const bf16x8*)(SB + (wc * 64 + n * 16 + fr) * 64 + fq * 16);
#pragma unroll
        for (int m = 0; m < 4; ++m)
#pragma unroll
            for (int n = 0; n < 4; ++n) acc[m][n] = MFMA16(At[m], Bt[n], acc[m][n]);
        if (kt + 1 < KT) storeA((kt + 1) & 1);
    }
}

template <int MR>
DI void mma_lds64(f32x4 (&acc)[MR][4], const u16* As, int lda, const u16* Bs, int ldb) {
    const int tid = TIDX(), lane = tid & 63, wid = tid >> 6, wr = wid >> 1, wc = wid & 1, fr = lane & 15, fq = lane >> 4;
#pragma unroll
    for (int kk = 0; kk < 2; ++kk) {
        bf16x8 At[MR], Bt[4];
#pragma unroll
        for (int m = 0; m < MR; ++m) At[m] = *(const bf16x8*)(As + (wr * (MR * 16) + m * 16 + fr) * lda + kk * 32 + fq * 8);
#pragma unroll
        for (int n = 0; n < 4; ++n) Bt[n] = *(const bf16x8*)(Bs + (wc * 64 + n * 16 + fr) * ldb + kk * 32 + fq * 8);
#pragma unroll
        for (int m = 0; m < MR; ++m)
#pragma unroll
            for (int n = 0; n < 4; ++n) acc[m][n] = MFMA16(At[m], Bt[n], acc[m][n]);
    }
}
typedef short v4s_ __attribute__((ext_vector_type(4)));
typedef __attribute__((address_space(3))) v4s_* lds_v4s_ptr_;
DI bf16x8 frag_tr(const u16* M, int ld, int k0, int c0) {
    const int lane = TIDX() & 63, i = lane & 15, g = lane >> 4;
    const u16* a = M + (k0 + 8 * g + (i >> 2)) * ld + c0 + 4 * (i & 3);
    v4s_ lo = __builtin_amdgcn_ds_read_tr16_b64_v4i16((lds_v4s_ptr_)a);
    v4s_ hi = __builtin_amdgcn_ds_read_tr16_b64_v4i16((lds_v4s_ptr_)(a + 4 * ld));
    return __builtin_shufflevector(lo, hi, 0, 1, 2, 3, 4, 5, 6, 7);
}
template <int MR>
DI void mma_lds64_btr(f32x4 (&acc)[MR][4], const u16* As, int lda, const u16* Bm, int ldb) {
    const int tid = TIDX(), lane = tid & 63, wid = tid >> 6, wr = wid >> 1, wc = wid & 1, fr = lane & 15, fq = lane >> 4;
#pragma unroll
    for (int kk = 0; kk < 2; ++kk) {
        bf16x8 At[MR], Bt[4];
#pragma unroll
        for (int m = 0; m < MR; ++m) At[m] = *(const bf16x8*)(As + (wr * (MR * 16) + m * 16 + fr) * lda + kk * 32 + fq * 8);
#pragma unroll
        for (int n = 0; n < 4; ++n) Bt[n] = frag_tr(Bm, ldb, kk * 32, wc * 64 + n * 16);
#pragma unroll
        for (int m = 0; m < MR; ++m)
#pragma unroll
            for (int n = 0; n < 4; ++n) acc[m][n] = MFMA16(At[m], Bt[n], acc[m][n]);
    }
}
template <int MR>
DI void mma_lds64_tt(f32x4 (&acc)[MR][4], const u16* Am, int lda, const u16* Bm, int ldb) {
    const int tid = TIDX(), wid = tid >> 6, wr = wid >> 1, wc = wid & 1;
#pragma unroll
    for (int kk = 0; kk < 2; ++kk) {
        bf16x8 At[MR], Bt[4];
#pragma unroll
        for (int m = 0; m < MR; ++m) At[m] = frag_tr(Am, lda, kk * 32, wr * (MR * 16) + m * 16);
#pragma unroll
        for (int n = 0; n < 4; ++n) Bt[n] = frag_tr(Bm, ldb, kk * 32, wc * 64 + n * 16);
#pragma unroll
        for (int m = 0; m < MR; ++m)
#pragma unroll
            for (int n = 0; n < 4; ++n) acc[m][n] = MFMA16(At[m], Bt[n], acc[m][n]);
    }
}
template <int ROWS>
DI void stage_n64(u16* dst, int ld, const u16* src, long sstride) {
    const int tid = TIDX();
#pragma unroll
    for (int i = 0; i < ROWS / 32; ++i) {
        int idx = i * 256 + tid, row = idx >> 3, ch = idx & 7;
        u32x4 v = *(const u32x4*)(src + (long)row * sstride + ch * 8);
        *(u32x4*)(dst + row * ld + ch * 8) = v;
    }
}

DI void convert_tile(KP p, int layer, int tile, char* smem);

DI void ph0_gemv_item(KP p, int item, char* smem) {
    const int tid = TIDX();
    const int l = item / 96, cg_ = item % 96;
    float* sl = (float*)smem;
    float* red = (float*)(smem + 8192);
    __syncthreads();
    for (int k = tid; k < 1024; k += 256) { sl[k] = siluf_(p->c[k]); sl[1024 + k] = siluf_(p->c_ctx[k]); }
    __syncthreads();
    const int c4 = tid & 15, kp = tid >> 4;
    const int col = cg_ * 64 + c4 * 4;
    const float* w = p->w_mod + (long)l * 1024 * 6144 + col;
    float a0[4] = {0, 0, 0, 0}, a1[4] = {0, 0, 0, 0};
#pragma unroll 8
    for (int kk = 0; kk < 64; ++kk) {
        int k = kp * 64 + kk;
        float4 wv = *(const float4*)(w + (long)k * 6144);
        float s0 = sl[k], s1 = sl[1024 + k];
        a0[0] += s0 * wv.x; a0[1] += s0 * wv.y; a0[2] += s0 * wv.z; a0[3] += s0 * wv.w;
        a1[0] += s1 * wv.x; a1[1] += s1 * wv.y; a1[2] += s1 * wv.z; a1[3] += s1 * wv.w;
    }
#pragma unroll
    for (int j = 0; j < 4; ++j) { red[(kp * 2 + 0) * 64 + c4 * 4 + j] = a0[j]; red[(kp * 2 + 1) * 64 + c4 * 4 + j] = a1[j]; }
    __syncthreads();
    if (tid < 128) {
        int src = tid >> 6, cr = tid & 63;
        float s = 0.f;
        for (int q = 0; q < 16; ++q) s += red[(q * 2 + src) * 64 + cr];
        int n = cg_ * 64 + cr;
        P_mod(p)[(l * 2 + src) * 6144 + n] = s + p->b_mod[l * 6144 + n];
    }
}
DI void sincos_d(double a, float& c, float& s) {
    const double TWO_PI = 6.283185307179586476925286766559;
    double k = rint(a / TWO_PI);
    double r = a - k * TWO_PI;
    double r2 = r * r;
    double ts = r, tc = 1.0, ss = r, cc = 1.0;
    for (int i = 1; i <= 14; ++i) {
        tc = -tc * r2 / (double)((2 * i - 1) * (2 * i));
        ts = -ts * r2 / (double)((2 * i) * (2 * i + 1));
        cc += tc; ss += ts;
    }
    c = (float)cc; s = (float)ss;
}
DI void ph0_rope_item(KP p, int item) {
    int idx = item * 256 + TIDX();
    const double LN_BASE = 9.210340371976184;
    if (idx < 8192) {
        int pos = idx >> 5, f = idx & 31;
        float inv = (float)exp(-(double)f / 32.0 * LN_BASE);
        float ang = (float)pos * inv;
        float c, s; sincos_d((double)ang, c, s);
        P_rope128(p)[idx] = make_float2(c, s);
    } else {
        int i2 = idx - 8192;
        int pos = i2 >> 4, f = i2 & 15;
        float inv = (float)exp(-(double)f / 16.0 * LN_BASE);
        float ang = (float)pos * inv;
        float c, s; sincos_d((double)ang, c, s);
        P_rope64(p)[i2] = make_float2(c, s);
    }
}

constexpr int CONV_TILES = 928 + 192 + 128 + 6144;
constexpr int CONV_DENSE = 928 + 192 + 128;
struct ConvTile { const float* sp; u16* dp; int N, K, mode, n0; };
DI ConvTile conv_setup(KP p, int layer, int tile) {
    const float* src; u16* dst; int K, N, mode = 0;
    if (tile < 928) { src = p->w_in + (long)layer * 1024 * INC; dst = P_wt_in(p); K = 1024; N = INC; mode = 1; }
    else if (tile < 928 + 192) {
        int t = tile - 928, which = t / 64; tile = t % 64; K = 512; N = 1024;
        src = (which == 0 ? p->w_ret : which == 1 ? p->w_win : p->w_na) + (long)layer * 512 * 1024;
        dst = (which == 0 ? P_wt_ret(p) : which == 1 ? P_wt_win(p) : P_wt_na(p));
    } else if (tile < 928 + 192 + 128) { tile -= 928 + 192; src = p->w_out + (long)layer * 1024 * 1024; dst = P_wt_out(p); K = 1024; N = 1024; }
    else {
        int t = tile - (928 + 192 + 128), which = t / 2048, e = (t % 2048) / 128; tile = t % 128; K = 1024; N = 1024;
        long eo = ((long)layer * NEXP + e) * 1024 * 1024;
        if (which == 0) { src = p->w_eg + eo; dst = P_wt_gu(p) + (long)e * 2048 * 1024; mode = 2; }
        else if (which == 1) { src = p->w_eu + eo; dst = P_wt_gu(p) + (long)e * 2048 * 1024; mode = 3; }
        else { src = p->w_ed + eo; dst = P_wt_dn(p) + (long)e * 1024 * 1024; }
    }
    const int ntn = N / 64;
    const int k0 = (tile / ntn) * 128, n0 = (tile % ntn) * 64;
    ConvTile c; c.sp = src + (long)k0 * N + n0; c.dp = dst + k0; c.N = N; c.K = K; c.mode = mode; c.n0 = n0;
    return c;
}
DI int conv_drow(int mode, int n) {
    if (mode == 1) {
        if (n < 1024) { int hh_ = (n & 511) >> 7, o_ = n & 127; return (n < 512 ? col_qr(hh_, o_ >> 6) : col_kr(hh_, o_ >> 6)) + (o_ & 63); }
        if (n >= C_QW && n < C_KW) { int m_ = n - C_QW; return col_qw(m_ >> 6, (m_ & 63) >> 5) + (m_ & 31); }
        if (n >= C_KW && n < C_VW) { int m_ = n - C_KW; return col_kw(m_ >> 6, (m_ & 63) >> 5) + (m_ & 31); }
        if (n >= C_VW && n < C_QN) { int m_ = n - C_VW; return col_vw(m_ >> 6) + (m_ & 63); }
        return n;
    }
    if (mode == 2) return (n >> 7) * 256 + (n & 127);
    if (mode == 3) return (n >> 7) * 256 + 128 + (n & 127);
    return n;
}
DI void convert_tiles(KP p, int layer, int first, int last, int step, char* smem) {
    const int tid = TIDX(), lane = tid & 63, w = tid >> 6;
    unsigned* T = (unsigned*)smem;
    float v[32];
    ConvTile c;
    if (first < last) {
        c = conv_setup(p, layer, first);
        const float* sp = c.sp + (long)(w * 32) * c.N + lane;
#pragma unroll
        for (int j = 0; j < 32; ++j) v[j] = sp[(long)j * c.N];
    }
    for (int t = first; t < last; t += step) {
        __syncthreads();
#pragma unroll
        for (int e = 0; e < 16; ++e) T[lane * 66 + w * 16 + e] = pack2(v[2 * e], v[2 * e + 1]);
        const ConvTile cur = c;
        if (t + step < last) {
            c = conv_setup(p, layer, t + step);
            const float* sp = c.sp + (long)(w * 32) * c.N + lane;
#pragma unroll
            for (int j = 0; j < 32; ++j) v[j] = sp[(long)j * c.N];
        }
        __syncthreads();
#pragma unroll
        for (int i = 0; i < 4; ++i) {
            const int idx = i * 256 + tid, nn = idx >> 4, ch = idx & 15;
            const u32x4 o = *(const u32x4*)(T + nn * 66 + ch * 4);
            *(u32x4*)(cur.dp + (long)conv_drow(cur.mode, cur.n0 + nn) * cur.K + ch * 8) = o;
        }
    }
}

DI void convert_tiles4(KP p, int layer, int first, int last, int step, char* smem) {
    const int tid = TIDX(), lane = tid & 63, w = tid >> 6;
    unsigned* T = (unsigned*)smem;
    for (int t = first; t < last; t += 4 * step) {
        float v[4][32];
        ConvTile c[4];
#pragma unroll
        for (int q = 0; q < 4; ++q) {
            const int tq = t + q * step;
            c[q] = conv_setup(p, layer, tq < last ? tq : first);
            if (tq < last) {
                const float* sp = c[q].sp + (long)(w * 32) * c[q].N + lane;
#pragma unroll
                for (int j = 0; j < 32; ++j) v[q][j] = sp[(long)j * c[q].N];
            }
        }
        __syncthreads();
#pragma unroll
        for (int q = 0; q < 4; ++q)
#pragma unroll
            for (int e = 0; e < 16; ++e) T[q * (64 * 66) + lane * 66 + w * 16 + e] = pack2(v[q][2 * e], v[q][2 * e + 1]);
        __syncthreads();
#pragma unroll
        for (int q = 0; q < 4; ++q) {
            if (t + q * step < last) {
#pragma unroll
                for (int i = 0; i < 4; ++i) {
                    const int idx = i * 256 + tid, nn = idx >> 4, ch = idx & 15;
                    const u32x4 o = *(const u32x4*)(T + q * (64 * 66) + nn * 66 + ch * 4);
                    *(u32x4*)(c[q].dp + (long)conv_drow(c[q].mode, c[q].n0 + nn) * c[q].K + ch * 8) = o;
                }
            }
        }
    }
}

DI const float* resid_row(KP p, int layer, int row) {
    if (row < NLAT) return p->x + (long)row * DM;
    return (layer == 0 ? p->ctx : P_ctxres(p)) + (long)(row - NLAT) * DM;
}
DI const float* cur_row(KP p, int row) { return P_ctxres(p) + (long)(row - NLAT) * DM; }
DI void load_res_row(KP p, int row, bool first, float4 (&v)[4]) {
    const int lane = TIDX() & 63;
    if (row < NLAT && !first) {
        const u16* xr = P_xres(p) + (long)row * DM;
#pragma unroll
        for (int i = 0; i < 4; ++i) { const uint2 w = *(const uint2*)(xr + i * 256 + lane * 4); v[i] = make_float4(bflo(w.x), bfhi(w.x), bflo(w.y), bfhi(w.y)); }
    } else {
        const float* xr = first ? resid_row(p, 0, row) : cur_row(p, row);
#pragma unroll
        for (int i = 0; i < 4; ++i) v[i] = *(const float4*)(xr + i * 256 + lane * 4);
    }
}
DI void store_res_row(KP p, int row, const float4 (&v)[4]) {
    const int lane = TIDX() & 63;
    if (row < NLAT) {
        u16* xr = P_xres(p) + (long)row * DM;
#pragma unroll
        for (int i = 0; i < 4; ++i) { uint2 w; w.x = pack2(v[i].x, v[i].y); w.y = pack2(v[i].z, v[i].w); *(uint2*)(xr + i * 256 + lane * 4) = w; }
    } else {
        float* xr = (float*)cur_row(p, row);
#pragma unroll
        for (int i = 0; i < 4; ++i) *(float4*)(xr + i * 256 + lane * 4) = v[i];
    }
}
DI void moe_combine(KP p, int row, float4 (&v)[4]) {
    const int lane = TIDX() & 63;
    const bool lat = row < NLAT;
    const int* ts = P_tslot(p) + (lat ? 0 : 16) * (long)NLAT + (lat ? row : row - NLAT);
    const u16* yb_ = lat ? P_ye(p) : P_yec(p);
    const int cap = lat ? CAP_LAT : CAP_CTX;
#pragma unroll 4
    for (int e = 0; e < NEXP; ++e) {
        const int slot = ts[(long)e * NLAT];
        if (slot >= 0) {
            const u16* yr = yb_ + ((long)e * cap + slot) * DM + lane * 4;
#pragma unroll
            for (int i = 0; i < 4; ++i) {
                uint2 w = *(const uint2*)(yr + i * 256);
                v[i].x += bflo(w.x); v[i].y += bfhi(w.x); v[i].z += bflo(w.y); v[i].w += bfhi(w.y);
            }
        }
    }
}
DI void norm_row(KP p, int layer, int row, const float* xr, const float* g, int shift_idx, int scale_idx, u16* dst_row, float* keep  , float* wb  ) {
    const int lane = TIDX() & 63;
    const float* md = P_mod(p) + (layer * 2 + (row < NLAT ? 0 : 1)) * 6144;
    float4 v[4]; float ss = 0.f;
#pragma unroll
    for (int i = 0; i < 4; ++i) v[i] = *(const float4*)(xr + i * 256 + lane * 4);
    if (wb) {
        moe_combine(p, row, v);
#pragma unroll
        for (int i = 0; i < 4; ++i) *(float4*)(wb + i * 256 + lane * 4) = v[i];
    }
#pragma unroll
    for (int i = 0; i < 4; ++i) ss += v[i].x * v[i].x + v[i].y * v[i].y + v[i].z * v[i].z + v[i].w * v[i].w;
    ss = wave_sum(ss);
    float rstd = rsqrtf(ss * (1.f / DM) + 1e-6f);
#pragma unroll
    for (int i = 0; i < 4; ++i) {
        int c0 = i * 256 + lane * 4;
        float4 gg = *(const float4*)(g + c0), sh = *(const float4*)(md + shift_idx * 1024 + c0), sc = *(const float4*)(md + scale_idx * 1024 + c0);
        float o0 = v[i].x * rstd * gg.x * (1.f + sc.x) + sh.x, o1 = v[i].y * rstd * gg.y * (1.f + sc.y) + sh.y;
        float o2 = v[i].z * rstd * gg.z * (1.f + sc.z) + sh.z, o3 = v[i].w * rstd * gg.w * (1.f + sc.w) + sh.w;
        uint2 pk; pk.x = pack2(o0, o1); pk.y = pack2(o2, o3);
        *(uint2*)(dst_row + c0) = pk;
        if (keep) *(float4*)(keep + c0) = make_float4(o0, o1, o2, o3);
    }
}

DI void norm_rows4(KP p, int layer, int row0, const float* g, int shift_idx, int scale_idx, bool first_layer_src, bool combine, float* keep = nullptr  ) {
    const int lane = TIDX() & 63;
    const float* md = P_mod(p) + (layer * 2 + (row0 < NLAT ? 0 : 1)) * 6144;
    float4 v[4][4];
#pragma unroll
    for (int r = 0; r < 4; ++r) load_res_row(p, row0 + r, first_layer_src, v[r]);
    float4 gg[4], sh[4], sc[4];
#pragma unroll
    for (int i = 0; i < 4; ++i) { const int c0 = i * 256 + lane * 4; gg[i] = *(const float4*)(g + c0); sh[i] = *(const float4*)(md + shift_idx * 1024 + c0); sc[i] = *(const float4*)(md + scale_idx * 1024 + c0); }
#pragma unroll
    for (int r = 0; r < 4; ++r) {
        const int row = row0 + r;
        if (first_layer_src && row >= NLAT) store_res_row(p, row, v[r]);
        if (combine) { moe_combine(p, row, v[r]); store_res_row(p, row, v[r]); }
        float ss = 0.f;
#pragma unroll
        for (int i = 0; i < 4; ++i) ss += v[r][i].x * v[r][i].x + v[r][i].y * v[r][i].y + v[r][i].z * v[r][i].z + v[r][i].w * v[r][i].w;
        ss = wave_sum(ss);
        const float rstd = rsqrtf(ss * (1.f / DM) + 1e-6f);
        u16* dst_row = P_hx(p) + (long)row * DM;
#pragma unroll
        for (int i = 0; i < 4; ++i) {
            const int c0 = i * 256 + lane * 4;
            float o0 = v[r][i].x * rstd * gg[i].x * (1.f + sc[i].x) + sh[i].x, o1 = v[r][i].y * rstd * gg[i].y * (1.f + sc[i].y) + sh[i].y;
            float o2 = v[r][i].z * rstd * gg[i].z * (1.f + sc[i].z) + sh[i].z, o3 = v[r][i].w * rstd * gg[i].w * (1.f + sc[i].w) + sh[i].w;
            uint2 pk; pk.x = pack2(o0, o1); pk.y = pack2(o2, o3);
            *(uint2*)(dst_row + c0) = pk;
            if (keep) *(float4*)(keep + r * 1024 + c0) = make_float4(o0, o1, o2, o3);
        }
    }
}

typedef __attribute__((ext_vector_type(16))) float f32x16;
typedef short v4s __attribute__((ext_vector_type(4)));
typedef __attribute__((address_space(3))) v4s* lds_v4s_ptr;
#define MFMA32(a, b, c) __builtin_amdgcn_mfma_f32_32x32x16_bf16((a), (b), (c), 0, 0, 0)
constexpr float LOG2E = 1.4426950408889634f;

struct FA {
    bf16x8 qf[4];
    f32x16 o[2];
    float m, l;
};
DI void fa_stage(u16* Ks, u16* Vs, const u16* px, int rowstart, int colK1, int colK2, int colV) {
    const int lane = TIDX() & 63;
#pragma unroll
    for (int i = 0; i < 8; ++i) {
        int idx = i * 64 + lane, key = idx >> 3, ch = idx & 7;
        const u16* src = px + (long)(rowstart + key) * INC;
        u32x4 kv = *(const u32x4*)(src + (ch < 4 ? colK1 + ch * 8 : colK2 + (ch - 4) * 8));
        u32x4 vv = *(const u32x4*)(src + colV + ch * 8);
        *(u32x4*)(Ks + key * 72 + ch * 8) = kv;
        *(u32x4*)(Vs + key * 72 + ch * 8) = vv;
    }
}
template <int MODE>
DI void fa_tile(FA& st, const u16* Ks, const u16* Vs, int a0, const float* rrow) {
    const int lane = TIDX() & 63, c = lane & 31, hh = lane >> 5;
    const u16* kbase = Ks + c * 72 + hh * 8;
    const u16* vbase = Vs + (4 * hh + ((lane & 15) >> 2)) * 72 + 16 * ((lane >> 4) & 1) + 4 * (lane & 3);
    f32x16 s[2];
#pragma unroll
    for (int kb = 0; kb < 2; ++kb) {
#pragma unroll
        for (int r = 0; r < 16; ++r) s[kb][r] = 0.f;
#pragma unroll
        for (int ks = 0; ks < 4; ++ks) {
            bf16x8 A = *(const bf16x8*)(kbase + kb * 32 * 72 + ks * 16);
            s[kb] = MFMA32(A, st.qf[ks], s[kb]);
        }
    }
    float mx = -3.0e38f;
    const int cq = a0 + c;
    int cs = cq - 8; cs = cs < 0 ? 0 : (cs > 48 ? 48 : cs);
#pragma unroll
    for (int kb = 0; kb < 2; ++kb)
#pragma unroll
        for (int r = 0; r < 16; ++r) {
            const int j = kb * 32 + (r & 3) + 8 * (r >> 2) + 4 * hh;
            float v = s[kb][r];
            if (MODE == 1) { int d = a0 + j - c; v = (d >= -128 && d <= 128) ? v : -1e30f; }
            if (MODE == 2) { bool ok = (j >= cs) && (j < cs + 16); int ci = j - cq + 15; ci = ci < 0 ? 0 : (ci > 30 ? 30 : ci); v = ok ? v + rrow[ci] : -1e30f; }
            v *= LOG2E;
            s[kb][r] = v;
            mx = fmaxf(mx, v);
        }
    mx = fmaxf(mx, __shfl_xor(mx, 32));
    const float mn = fmaxf(st.m, mx);
    const float alpha = __builtin_amdgcn_exp2f(st.m - mn);
    float ls = 0.f;
#pragma unroll
    for (int kb = 0; kb < 2; ++kb)
#pragma unroll
        for (int r = 0; r < 16; ++r) { float pv = __builtin_amdgcn_exp2f(s[kb][r] - mn); s[kb][r] = pv; ls += pv; }
    st.l = st.l * alpha + ls; st.m = mn;
#pragma unroll
    for (int db = 0; db < 2; ++db)
#pragma unroll
        for (int r = 0; r < 16; ++r) st.o[db][r] *= alpha;
    bf16x8 pf[2][2];
#pragma unroll
    for (int kb = 0; kb < 2; ++kb)
#pragma unroll
        for (int k2 = 0; k2 < 2; ++k2) {
            u32x4 w;
#pragma unroll
            for (int e = 0; e < 4; ++e) w[e] = pack2(s[kb][8 * k2 + 2 * e], s[kb][8 * k2 + 2 * e + 1]);
            pf[kb][k2] = __builtin_bit_cast(bf16x8, w);
        }
#pragma unroll
    for (int db = 0; db < 2; ++db)
#pragma unroll
        for (int kb = 0; kb < 2; ++kb)
#pragma unroll
            for (int k2 = 0; k2 < 2; ++k2) {
                const u16* alo = vbase + (kb * 32 + 16 * k2) * 72 + db * 32;
                v4s lo = __builtin_amdgcn_ds_read_tr16_b64_v4i16((lds_v4s_ptr)alo);
                v4s hi = __builtin_amdgcn_ds_read_tr16_b64_v4i16((lds_v4s_ptr)(alo + 8 * 72));
                bf16x8 A = __builtin_shufflevector(lo, hi, 0, 1, 2, 3, 4, 5, 6, 7);
                st.o[db] = MFMA32(A, pf[kb][k2], st.o[db]);
            }
}
DI void fa_tile_na32(FA& st, const u16* Ks, const u16* Vs, int koff, bool rowok, int cs, const float* brow) {
    const int lane = TIDX() & 63, c = lane & 31, hh = lane >> 5;
    const u16* kbase = Ks + (koff + c) * 72 + hh * 8;
    const u16* vbase = Vs + (koff + 4 * hh + ((lane & 15) >> 2)) * 72 + 16 * ((lane >> 4) & 1) + 4 * (lane & 3);
    f32x16 s;
#pragma unroll
    for (int r = 0; r < 16; ++r) s[r] = 0.f;
#pragma unroll
    for (int ks = 0; ks < 4; ++ks) {
        bf16x8 A = *(const bf16x8*)(kbase + ks * 16);
        s = MFMA32(A, st.qf[ks], s);
    }
    float mx = -3.0e38f;
    const int lo = cs - koff;
#pragma unroll
    for (int r = 0; r < 16; ++r) {
        const int jj = (r & 3) + 8 * (r >> 2) + 4 * hh;
        const bool ok = rowok && (jj >= lo) && (jj < lo + 16);
        float v = ok ? (s[r] + brow[jj]) * LOG2E : -1.4e30f;
        s[r] = v;
        mx = fmaxf(mx, v);
    }
    mx = fmaxf(mx, __shfl_xor(mx, 32));
    const float mn = fmaxf(st.m, mx);
    const float alpha = __builtin_amdgcn_exp2f(st.m - mn);
    float ls = 0.f;
#pragma unroll
    for (int r = 0; r < 16; ++r) { float pv = __builtin_amdgcn_exp2f(s[r] - mn); s[r] = pv; ls += pv; }
    st.l = st.l * alpha + ls; st.m = mn;
#pragma unroll
    for (int db = 0; db < 2; ++db)
#pragma unroll
        for (int r = 0; r < 16; ++r) st.o[db][r] *= alpha;
    bf16x8 pf[2];
#pragma unroll
    for (int k2 = 0; k2 < 2; ++k2) {
        u32x4 w;
#pragma unroll
        for (int e = 0; e < 4; ++e) w[e] = pack2(s[8 * k2 + 2 * e], s[8 * k2 + 2 * e + 1]);
        pf[k2] = __builtin_bit_cast(bf16x8, w);
    }
#pragma unroll
    for (int db = 0; db < 2; ++db)
#pragma unroll
        for (int k2 = 0; k2 < 2; ++k2) {
            const u16* alo = vbase + (16 * k2) * 72 + db * 32;
            v4s lo_ = __builtin_amdgcn_ds_read_tr16_b64_v4i16((lds_v4s_ptr)alo);
            v4s hi_ = __builtin_amdgcn_ds_read_tr16_b64_v4i16((lds_v4s_ptr)(alo + 8 * 72));
            bf16x8 A = __builtin_shufflevector(lo_, hi_, 0, 1, 2, 3, 4, 5, 6, 7);
            st.o[db] = MFMA32(A, pf[k2], st.o[db]);
        }
}
DI void attn_block_item(KP p, int layer, int kind, int ia, int ib, char* smem) {
    const int tid = TIDX(), lane = tid & 63, wid = tid >> 6, c = lane & 31, hh = lane >> 5;
    u16* KV = (u16*)smem;
    float* rpbs = (float*)(smem + 36864) + 64 + wid * 512;
    const bool isna = (kind == 1 || kind == 3);
    int h, q0, a_half = 0, kvh;
    if (kind == 0) { h = ib * 4 + wid; kvh = ib; q0 = ia * 32; }
    else if (kind == 1) { h = ib; kvh = ib; q0 = 2 * ia * 64; }
    else if (kind == 2) { h = ib * 4 + wid; kvh = ib; q0 = NLAT + ia * 32; }
    else { h = ib; kvh = ib; q0 = NLAT + (ia * 4 + wid) * 32; }
    const int colQ1 = isna ? C_QN + h * 64 : col_qw(h, 0), colQ2 = isna ? colQ1 + 32 : col_qw(h, 1);
    const int colK1 = isna ? C_KN + kvh * 64 : col_kw(kvh, 0), colK2 = isna ? colK1 + 32 : col_kw(kvh, 1);
    const int colV = isna ? C_VN + kvh * 64 : col_vw(kvh);
    FA st;
    {
        const int tq = (kind == 1) ? q0 + (c >> 4) * 64 + wid * 16 + (c & 15) : q0 + c;
        const u16* qrow = P_px(p) + (long)tq * INC;
#pragma unroll
        for (int ks = 0; ks < 4; ++ks) st.qf[ks] = *(const bf16x8*)(qrow + (ks < 2 ? colQ1 + ks * 16 : colQ2 + (ks - 2) * 16) + hh * 8);
#pragma unroll
        for (int db = 0; db < 2; ++db)
#pragma unroll
            for (int r = 0; r < 16; ++r) st.o[db][r] = 0.f;
        if (isna) { st.m = -1e30f; st.l = 0.f; } else { st.m = p->sink[layer * 8 + h] * LOG2E; st.l = hh == 0 ? 1.f : 0.f; }
    }
    const int r0 = 2 * ia, rq = r0 + (c >> 4), cq = wid * 16 + (c & 15);
    int sr0 = r0 - 4; sr0 = sr0 < 0 ? 0 : (sr0 > 248 ? 248 : sr0);
    int srq = rq - 4; srq = srq < 0 ? 0 : (srq > 248 ? 248 : srq);
    int sr1 = r0 + 1 - 4; sr1 = sr1 < 0 ? 0 : (sr1 > 248 ? 248 : sr1);
    int csq = cq - 8; csq = csq < 0 ? 0 : (csq > 48 ? 48 : csq);
    const int koff = wid == 0 ? 0 : wid == 1 ? 8 : wid == 2 ? 24 : 32;
    const float* bq = rpbs + (7 - rq) * 31 + koff - cq + 15;
    if (kind == 1) {
        const float* rp = p->rpb + ((long)layer * 8 + h) * 465;
        for (int i = lane; i < 465; i += 64) rpbs[i] = rp[i];
    }
    const int nloc = kind == 0 ? 5 : kind == 1 ? 9 : 0, nt = nloc + 4;
    const int wt0 = (q0 >> 6) - 2;
    auto tile_row = [&](int i) -> int {
        if (i >= nloc) return NLAT + (i - nloc) * 64;
        if (kind == 0) { const int s0 = ((ia * 32) >> 6) - 2 + i; return (s0 < 0 || s0 >= NLAT / 64) ? -1 : s0 * 64; }
        const int kr = sr0 + i; return (kr > sr1 + 7) ? -1 : kr * 64;
    };
    const int skey = tid >> 4, sc16 = tid & 15;
    const int scol = sc16 < 8 ? (sc16 < 4 ? colK1 + sc16 * 8 : colK2 + (sc16 - 4) * 8) : colV + (sc16 - 8) * 8;
    const int sdst = (sc16 < 8 ? 0 : 64 * 72) + skey * 72 + (sc16 & 7) * 8;
    u32x4 pre[4];
    auto load_tile = [&](int row0) {
#pragma unroll
        for (int j = 0; j < 4; ++j) pre[j] = *(const u32x4*)(P_px(p) + (long)(row0 + skey + 16 * j) * INC + scol);
    };
    auto store_tile = [&](int buf) {
#pragma unroll
        for (int j = 0; j < 4; ++j) *(u32x4*)(KV + buf * (2 * 64 * 72) + sdst + 16 * j * 72) = pre[j];
    };
    __syncthreads();
    int rowc = tile_row(0);
    if (rowc >= 0) { load_tile(rowc); store_tile(0); }
    __syncthreads();
    for (int i = 0; i < nt; ++i) {
        const int rown = (i + 1 < nt) ? tile_row(i + 1) : -1;
        if (rown >= 0) load_tile(rown);
        if (rowc >= 0) {
            const u16* Ks = KV + (i & 1) * (2 * 64 * 72);
            const u16* Vs = Ks + 64 * 72;
            if (i >= nloc) fa_tile<0>(st, Ks, Vs, 0, nullptr);
            else if (kind == 0) { if (i == 0 || i == 4) fa_tile<1>(st, Ks, Vs, rowc - q0, nullptr); else fa_tile<0>(st, Ks, Vs, 0, nullptr); }
            else { const int kr = sr0 + i; fa_tile_na32(st, Ks, Vs, koff, kr >= srq && kr < srq + 8, csq, bq + kr * 31); }
        }
        if (rown >= 0) store_tile((i + 1) & 1);
        rowc = rown;
        __syncthreads();
    }
    u16* y = isna ? P_yc(p) : P_yb(p);
    {
        float lt = st.l + __shfl_xor(st.l, 32);
        float inv = 1.f / lt;
        u16* ob = KV + wid * (32 * 72);
#pragma unroll
        for (int db = 0; db < 2; ++db)
#pragma unroll
            for (int g = 0; g < 4; ++g) {
                uint2 o;
                o.x = pack2(st.o[db][4 * g] * inv, st.o[db][4 * g + 1] * inv);
                o.y = pack2(st.o[db][4 * g + 2] * inv, st.o[db][4 * g + 3] * inv);
                *(uint2*)(ob + c * 72 + db * 32 + 8 * g + 4 * hh) = o;
            }
#pragma unroll
        for (int i = 0; i < 4; ++i) {
            const int idx = i * 64 + lane, qi = idx >> 3, ch = idx & 7;
            const int tq = (kind == 1) ? q0 + (qi >> 4) * 64 + wid * 16 + (qi & 15) : q0 + qi;
            *(u32x4*)(y + (long)tq * 512 + h * 64 + ch * 8) = *(const u32x4*)(ob + qi * 72 + ch * 8);
        }
    }
}

DI void ret_gammas(KP p, int layer, int h, float& lgf2, float& lgb2) {
    float xf = p->decay[layer * 8 + h], xb = p->decay[layer * 8 + 4 + h];
    lgf2 = -log1pf(expf(-xf)) * 1.4426950408889634f;
    lgb2 = -log1pf(expf(-xb)) * 1.4426950408889634f;
}
DI void phC_state_item(KP p, int layer, int c, int h, int eh, char* smem) {
    const int tid = TIDX(), lane = tid & 63, wid = tid >> 6, wr = wid >> 1, wc = wid & 1, fr = lane & 15, fq = lane >> 4;
    u16* Vr = (u16*)smem;
    u16* Kf = Vr + 64 * 72;
    u16* Kb = Kf + 64 * 136;
    float lgf2, lgb2; ret_gammas(p, layer, h, lgf2, lgb2);
    f32x4 accF[2][4], accB[2][4]; zero_acc<2>(accF); zero_acc<2>(accB);
    const u16* base = P_px(p) + (long)c * 128 * INC;
    u32x4 pv[2], pk[4];
    auto load_half = [&](int jh) {
        const u16* rb = base + (long)jh * 64 * INC;
#pragma unroll
        for (int i = 0; i < 2; ++i) { const int idx = i * 256 + tid, row = idx >> 3, ch = idx & 7; pv[i] = *(const u32x4*)(rb + (long)row * INC + C_VR + h * 128 + eh * 64 + ch * 8); }
#pragma unroll
        for (int i = 0; i < 4; ++i) { const int idx = i * 256 + tid, row = idx >> 4, ch = idx & 15; pk[i] = *(const u32x4*)(rb + (long)row * INC + (ch < 8 ? col_kr(h, 0) + ch * 8 : col_kr(h, 1) + (ch - 8) * 8)); }
    };
    auto store_half = [&](int jh) {
#pragma unroll
        for (int i = 0; i < 2; ++i) { const int idx = i * 256 + tid, row = idx >> 3, ch = idx & 7; *(u32x4*)(Vr + row * 72 + ch * 8) = pv[i]; }
#pragma unroll
        for (int i = 0; i < 4; ++i) {
            const int idx = i * 256 + tid, row = idx >> 4, ch = idx & 15, j = jh * 64 + row;
            const float zf = exp2f((float)(127 - j) * lgf2), zb = exp2f((float)j * lgb2);
            u32x4 of, ob;
#pragma unroll
            for (int e = 0; e < 4; ++e) { const float lo = bflo(pk[i][e]), hi = bfhi(pk[i][e]); of[e] = pack2(lo * zf, hi * zf); ob[e] = pack2(lo * zb, hi * zb); }
            *(u32x4*)(Kf + row * 136 + ch * 8) = of;
            *(u32x4*)(Kb + row * 136 + ch * 8) = ob;
        }
    };
    load_half(0);
    __syncthreads();
    store_half(0);
    load_half(1);
    __syncthreads();
    mma_lds64_tt<2>(accF, Vr, 72, Kf, 136);
    mma_lds64_tt<2>(accB, Vr, 72, Kb, 136);
    __syncthreads();
    store_half(1);
    __syncthreads();
    mma_lds64_tt<2>(accF, Vr, 72, Kf, 136);
    mma_lds64_tt<2>(accB, Vr, 72, Kb, 136);
    __syncthreads();
#pragma unroll
    for (int m = 0; m < 2; ++m)
#pragma unroll
        for (int n = 0; n < 4; ++n)
#pragma unroll
            for (int j = 0; j < 4; ++j) {
                const int el = wr * 32 + m * 16 + fq * 4 + j, d = wc * 64 + n * 16 + fr;
                Kf[el * 136 + d] = f2bf(accF[m][n][j]);
                Kb[el * 136 + d] = f2bf(accB[m][n][j]);
            }
    __syncthreads();
    u16* Sf = (u16*)P_S(p) + ((long)(c * 4 + h) * 2 + 0) * 16384 + (long)eh * 64 * 128;
    u16* Sb = Sf + 16384;
#pragma unroll
    for (int i = 0; i < 4; ++i) {
        const int idx = i * 256 + tid, el = idx >> 4, ch = idx & 15;
        *(u32x4*)(Sf + el * 128 + ch * 8) = *(const u32x4*)(Kf + el * 136 + ch * 8);
        *(u32x4*)(Sb + el * 128 + ch * 8) = *(const u32x4*)(Kb + el * 136 + ch * 8);
    }
}

DI void phD_item(KP p, int layer, int item) {
    const int h = item >> 7, dir = (item >> 6) & 1, pos = (item & 63) * 256 + TIDX();
    float lgf2, lgb2; ret_gammas(p, layer, h, lgf2, lgb2);
    const float decay = exp2f(128.f * (dir == 0 ? lgf2 : lgb2));
    float r = 0.f;
    const long hs = (long)(h * 2 + dir) * 16384 + pos;
    auto chunk_at = [&](int i) -> int {
        if (dir == 0) return i < 2 ? 128 + i : i - 2;
        return i < 2 ? 129 - i : 129 - i;
    };
    for (int i0 = 0; i0 < NCHUNK; i0 += 13) {
        float s[13];
#pragma unroll
        for (int u = 0; u < 13; ++u) s[u] = bf2f(((const u16*)P_S(p))[(long)chunk_at(i0 + u) * 8 * 16384 + hs]);
#pragma unroll
        for (int u = 0; u < 13; ++u) {
            P_R(p)[(long)chunk_at(i0 + u) * 8 * 16384 + hs] = f2bf(r);
            r = decay * r + s[u];
        }
    }
}

DI void phE_item(KP p, int layer, int c, int h, int ih, char* smem) {
    const int tid = TIDX(), lane = tid & 63, wid = tid >> 6, wr = wid >> 1, wc = wid & 1, fr = lane & 15, fq = lane >> 4;
    u16* Qs = (u16*)smem;
    u16* X = Qs + 64 * 136;
    u16* P = X + 128 * 136;
    float* red = (float*)(P + 64 * 136);
    float lgf2, lgb2; ret_gammas(p, layer, h, lgf2, lgb2);
    const u16* base = P_px(p) + (long)c * 128 * INC;
    const u16* Rf = P_R(p) + ((long)(c * 4 + h) * 2 + 0) * 16384;
    const u16* Rb = Rf + 16384;
    const int ch = tid & 15, rw = tid >> 4;
    const int qkcol = ch < 8 ? ch * 8 : (ch - 8) * 8;
    u32x4 pre[8];
    auto load_rows = [&](const u16* src, long stride, int nrow16) {
#pragma unroll
        for (int i = 0; i < 8; ++i) if (i < nrow16) pre[i] = *(const u32x4*)(src + (long)(rw + 16 * i) * stride);
    };
    auto store_rows = [&](u16* dst, int nrow16) {
#pragma unroll
        for (int i = 0; i < 8; ++i) if (i < nrow16) *(u32x4*)(dst + (rw + 16 * i) * 136 + ch * 8) = pre[i];
    };
    f32x4 Y[2][4], T[2][4];
    zero_acc<2>(Y); zero_acc<2>(T);
    __syncthreads();
    load_rows(base + (long)ih * 64 * INC + (ch < 8 ? col_qr(h, 0) : col_qr(h, 1)) + qkcol, INC, 4); store_rows(Qs, 4);
    load_rows(Rf + ch * 8, 128, 8); store_rows(X, 8);
    load_rows(Rb + ch * 8, 128, 8);
    __syncthreads();
    mma_lds64<2>(Y, Qs, 136, X, 136); mma_lds64<2>(Y, Qs + 64, 136, X + 64, 136);
    __syncthreads();
    store_rows(X, 8);
    load_rows(base + (ch < 8 ? col_kr(h, 0) : col_kr(h, 1)) + qkcol, INC, 8);
    __syncthreads();
    mma_lds64<2>(T, Qs, 136, X, 136); mma_lds64<2>(T, Qs + 64, 136, X + 64, 136);
#pragma unroll
    for (int m = 0; m < 2; ++m)
#pragma unroll
        for (int j = 0; j < 4; ++j) {
            int i = ih * 64 + wr * 32 + m * 16 + fq * 4 + j;
            float xf = exp2f((float)(i + 1) * lgf2), xb = exp2f((float)(128 - i) * lgb2);
#pragma unroll
            for (int n = 0; n < 4; ++n) Y[m][n][j] = xf * Y[m][n][j] + xb * T[m][n][j];
        }
    zero_acc<2>(T);
    __syncthreads();
    store_rows(X, 8);
    load_rows(base + C_VR + h * 128 + ch * 8, INC, 8);
    __syncthreads();
    mma_lds64<2>(T, Qs, 136, X, 136); mma_lds64<2>(T, Qs + 64, 136, X + 64, 136);
#pragma unroll
    for (int m = 0; m < 2; ++m)
#pragma unroll
        for (int n = 0; n < 4; ++n)
#pragma unroll
            for (int j = 0; j < 4; ++j) {
                int il = wr * 32 + m * 16 + fq * 4 + j, i = ih * 64 + il, jj = wc * 64 + n * 16 + fr;
                float dm = (i >= jj) ? exp2f((float)(i - jj) * lgf2) : exp2f((float)(jj - i) * lgb2);
                P[il * 136 + jj] = f2bf(T[m][n][j] * dm);
            }
    __syncthreads();
    store_rows(X, 8);
    __syncthreads();
    mma_lds64_btr<2>(Y, P, 136, X, 136); mma_lds64_btr<2>(Y, P + 64, 136, X + 64 * 136, 136);
    float mu[2][4], rs[2][4];
#pragma unroll
    for (int m = 0; m < 2; ++m)
#pragma unroll
        for (int j = 0; j < 4; ++j) {
            float s = Y[m][0][j] + Y[m][1][j] + Y[m][2][j] + Y[m][3][j];
            s += __shfl_xor(s, 1); s += __shfl_xor(s, 2); s += __shfl_xor(s, 4); s += __shfl_xor(s, 8);
            if (fr == 0) red[(wr * 32 + m * 16 + fq * 4 + j) * 2 + wc] = s;
        }
    __syncthreads();
#pragma unroll
    for (int m = 0; m < 2; ++m)
#pragma unroll
        for (int j = 0; j < 4; ++j) { int il = wr * 32 + m * 16 + fq * 4 + j; mu[m][j] = (red[il * 2] + red[il * 2 + 1]) * (1.f / 128.f); }
    __syncthreads();
#pragma unroll
    for (int m = 0; m < 2; ++m)
#pragma unroll
        for (int j = 0; j < 4; ++j) {
            float s = 0.f;
#pragma unroll
            for (int n = 0; n < 4; ++n) { float d = Y[m][n][j] - mu[m][j]; s += d * d; }
            s += __shfl_xor(s, 1); s += __shfl_xor(s, 2); s += __shfl_xor(s, 4); s += __shfl_xor(s, 8);
            if (fr == 0) red[(wr * 32 + m * 16 + fq * 4 + j) * 2 + wc] = s;
        }
    __syncthreads();
#pragma unroll
    for (int m = 0; m < 2; ++m)
#pragma unroll
        for (int j = 0; j < 4; ++j) { int il = wr * 32 + m * 16 + fq * 4 + j; rs[m][j] = rsqrtf((red[il * 2] + red[il * 2 + 1]) * (1.f / 128.f) + 1e-6f); }
    __syncthreads();
    const float* gn = p->ret_gn + layer * 512 + h * 128;
#pragma unroll
    for (int m = 0; m < 2; ++m)
#pragma unroll
        for (int n = 0; n < 4; ++n)
#pragma unroll
            for (int j = 0; j < 4; ++j) {
                const int il = wr * 32 + m * 16 + fq * 4 + j, e = wc * 64 + n * 16 + fr;
                P[il * 136 + e] = f2bf((Y[m][n][j] - mu[m][j]) * rs[m][j] * gn[e]);
            }
    __syncthreads();
#pragma unroll
    for (int i = 0; i < 4; ++i) {
        const int idx = i * 256 + tid, il = idx >> 4, ch = idx & 15;
        const long row = (long)c * 128 + ih * 64 + il;
        const u32x4 yv = *(const u32x4*)(P + il * 136 + ch * 8);
        const u32x4 gv = *(const u32x4*)(P_px(p) + row * INC + C_GR + h * 128 + ch * 8);
        u32x4 o;
#pragma unroll
        for (int e = 0; e < 4; ++e) o[e] = pack2(bflo(yv[e]) * siluf_(bflo(gv[e])), bfhi(yv[e]) * siluf_(bfhi(gv[e])));
        *(u32x4*)(P_ya(p) + row * 512 + h * 128 + ch * 8) = o;
    }
    __syncthreads();
}

DI void phF_tile(KP p, int mt, int nt, int b, int ks, char* smem) {
    const int tid = TIDX(), lane = tid & 63, wid = tid >> 6, wr = wid >> 1, wc = wid & 1, fr = lane & 15, fq = lane >> 4;
    const int r0 = tid >> 2, ko = (tid & 3) * 8 + ks * 64;
    float* macc = P_maccx(p) - (long)NLAT * DM;
    const u16* y = (b == 0 ? P_ya(p) : b == 1 ? P_yb(p) : P_yc(p));
    const u16* w = (b == 0 ? P_wt_ret(p) : b == 1 ? P_wt_win(p) : P_wt_na(p));
    f32x4 acc[4][4]; zero_acc<4>(acc);
    const u16* a0 = y + (long)(mt * 128 + r0) * 512 + ko;
    const u16* b0 = w + (long)(nt * 128 + r0) * 512 + ko;
    gemm_core<2>(acc, a0, a0 + 64 * 512, b0, b0 + 64 * 512, smem);
    int zero = 0; asm volatile("" : "+v"(zero));
#pragma unroll
    for (int m = 0; m < 4; ++m)
#pragma unroll
        for (int n = 0; n < 4; ++n)
#pragma unroll
            for (int j = 0; j < 4; ++j) {
                int row = mt * 128 + wr * 64 + m * 16 + fq * 4 + j + zero, col = nt * 128 + wc * 64 + n * 16 + fr;
                float g = bf2f(P_px(p)[(long)row * INC + C_GATE + b * 1024 + col]);
                unsafeAtomicAdd(macc + (long)row * DM + col, acc[m][n][j] * sigmoidf_(g));
            }
}
DI void phG_tile(KP p, int layer, int mt, int nt, int ks, char* smem) {
    const int tid = TIDX(), lane = tid & 63, wid = tid >> 6, wr = wid >> 1, wc = wid & 1, fr = lane & 15, fq = lane >> 4;
    f32x4 acc[4][4]; zero_acc<4>(acc);
    const int r0 = tid >> 2, ko = (tid & 3) * 8 + ks * 32;
    const float* a0 = P_maccx(p) + (long)((mt - 128) * 128 + r0) * DM + ko;
    const u16* b0 = P_wt_out(p) + (long)(nt * 128 + r0) * DM + ko;
    gemm_core_af32<1>(acc, a0, a0 + 64 * DM, b0, b0 + 64 * DM, smem);
    const float* md = P_mod(p) + (layer * 2 + 1) * 6144 + 2 * 1024;
    int zero = 0; asm volatile("" : "+v"(zero));
#pragma unroll
    for (int m = 0; m < 4; ++m)
#pragma unroll
        for (int n = 0; n < 4; ++n)
#pragma unroll
            for (int j = 0; j < 4; ++j) {
                int row = mt * 128 + wr * 64 + m * 16 + fq * 4 + j + zero, col = nt * 128 + wc * 64 + n * 16 + fr;
                unsafeAtomicAdd(P_ctxres(p) + (long)(row - NLAT) * DM + col, md[col] * acc[m][n][j]);
            }
}


#define LAS __attribute__((address_space(3)))
namespace g8 {
constexpr int BM = 256, BK = 64, HALF = 128, HTB = HALF * BK * 2, STAGE_BYTES = 8 * HTB;
DI int lds_byte(int r, int c) { const int st = (r >> 4) * 2 + (c >> 5), rr = r & 15, cc = c & 31, ob = rr * 64 + cc * 2; return st * 1024 + (ob ^ (((ob >> 9) & 1) << 5)); }
DI void stage_rc(int b, int& R, int& C) { const int st = b / 1024, sb = b % 1024, swz = sb ^ (((sb >> 9) & 1) << 5); R = (st >> 1) * 16 + swz / 64; C = (st & 1) * 32 + (swz % 64) / 2; }
DI int perm32(int rho) { const int n = rho >> 4, i = rho & 15; return 8 * (i >> 2) + 4 * n + (i & 3); }
struct Unit { int pm, pn, aux; };
typedef f32x4 Acc[2][2][4][2];

template <class P>
DI void gemm_phase(LAS unsigned char* lds, const P& prob) {
    const int tid = TID512(), wid = __builtin_amdgcn_readfirstlane(tid >> 6), lane = tid & 63, wr = wid >> 2, wc = wid & 3, fr = lane & 15, fq = lane >> 4;
    constexpr int K = P::K, nt = K / BK;
    int Rr[2], Cc[2];
    unsigned voffA[2], voffB[2];
#pragma unroll
    for (int i = 0; i < 2; ++i) { stage_rc(tid * 16 + i * 8192, Rr[i], Cc[i]); const int Rb = P::PERM ? ((Rr[i] & ~31) + perm32(Rr[i] & 31)) : Rr[i];
        voffA[i] = (unsigned)(Rr[i] * K + Cc[i]) * 2u; voffB[i] = (unsigned)(Rb * K + Cc[i]) * 2u; }
    constexpr size_t kstep = (size_t)(BK * 2);
    constexpr size_t hstep = (size_t)HALF * K * 2;
    const unsigned ldsw = (unsigned)wid * 1024u;
    const int aoff = lds_byte(wr * 64 + fr, fq * 8), boff = lds_byte(wc * 32 + fr, fq * 8);
    unsigned vaC[2][2], vaN[2][2];
#define G8_SA(b, h) (((b) * 2 + (h)) * HTB)
#define G8_SB(b, h) ((4 + (b) * 2 + (h)) * HTB)
#define G8_STAGEA(bufoff, base, VA, h, kt) do { _Pragma("unroll") for (int _i = 0; _i < 2; ++_i) \
        __builtin_amdgcn_global_load_lds((const unsigned*)((base) + (P::GATHER ? (size_t)(VA)[h][_i] : (size_t)voffA[_i] + (size_t)(h) * hstep) + (size_t)(kt) * kstep), (LAS unsigned*)(lds + (bufoff) + ldsw + _i * 8192), 16, 0, 0); } while (0)
#define G8_STAGEB(bufoff, base, h, kt) do { _Pragma("unroll") for (int _i = 0; _i < 2; ++_i) \
        __builtin_amdgcn_global_load_lds((const unsigned*)((base) + (size_t)(h) * hstep + voffB[_i] + (size_t)(kt) * kstep), (LAS unsigned*)(lds + (bufoff) + ldsw + _i * 8192), 16, 0, 0); } while (0)
#define G8_LDA(dst, b, h) do { _Pragma("unroll") for (int m = 0; m < 4; ++m) _Pragma("unroll") for (int k = 0; k < 2; ++k) dst[m][k] = *(const LAS bf16x8*)(lds + G8_SA(b, h) + aoff + m * 2048 + k * 1024); } while (0)
#define G8_LDB(dst, b, h) do { _Pragma("unroll") for (int n = 0; n < 2; ++n) _Pragma("unroll") for (int k = 0; k < 2; ++k) dst[n][k] = *(const LAS bf16x8*)(lds + G8_SB(b, h) + boff + n * 2048 + k * 1024); } while (0)
#define G8_MMA(ai, bj, At, Bt) do { __builtin_amdgcn_s_setprio(1); _Pragma("unroll") for (int m = 0; m < 4; ++m) _Pragma("unroll") for (int n = 0; n < 2; ++n) _Pragma("unroll") for (int k = 0; k < 2; ++k) \
        acc[ai][bj][m][n] = __builtin_amdgcn_mfma_f32_16x16x32_bf16(Bt[n][k], At[m][k], acc[ai][bj][m][n], 0, 0, 0); __builtin_amdgcn_s_setprio(0); } while (0)
#define G8_WAIT_V(n) asm volatile("s_waitcnt vmcnt(" #n ")" ::: "memory")
#define G8_WAIT_L(n) asm volatile("s_waitcnt lgkmcnt(" #n ")" ::: "memory")
#define G8_BAR __builtin_amdgcn_s_barrier()
#define G8_SCHED __builtin_amdgcn_sched_barrier(0)
    Unit cur, nxt; int ui = 0;
    __syncthreads();
    if (!prob.next(0, cur)) return;
    if (P::GATHER) prob.gather(cur, Rr, Cc, vaC);
    const char* cA = prob.a_base(cur); const char* cB = prob.b_base(cur);
    Acc acc;
#pragma unroll
    for (int a = 0; a < 2; ++a)
#pragma unroll
        for (int b = 0; b < 2; ++b)
#pragma unroll
            for (int m = 0; m < 4; ++m)
#pragma unroll
                for (int n = 0; n < 2; ++n) acc[a][b][m][n] = (f32x4){0.f, 0.f, 0.f, 0.f};
    bf16x8 At[4][2], B0[2][2], B1[2][2];
    G8_STAGEB(G8_SB(0, 0), cB, 0, 0); G8_STAGEA(G8_SA(0, 0), cA, vaC, 0, 0); G8_STAGEB(G8_SB(0, 1), cB, 1, 0); G8_STAGEA(G8_SA(0, 1), cA, vaC, 1, 0);
    if (wr == 1) G8_BAR;
    G8_WAIT_V(4); G8_BAR;
    G8_STAGEB(G8_SB(1, 0), cB, 0, 1); G8_STAGEA(G8_SA(1, 0), cA, vaC, 0, 1); G8_STAGEB(G8_SB(1, 1), cB, 1, 1);
    G8_WAIT_V(6); G8_BAR;
    for (;;) {
        const bool has_next = prob.next(ui + 1, nxt);
        if (!has_next) nxt = cur;
        if (P::GATHER) {
            if (has_next) prob.gather(nxt, Rr, Cc, vaN);
            else {
#pragma unroll
                for (int h = 0; h < 2; ++h) { vaN[h][0] = vaC[h][0]; vaN[h][1] = vaC[h][1]; }
            }
        }
        const char* nA = prob.a_base(nxt); const char* nB = prob.b_base(nxt);
#pragma unroll 1
        for (int t = 0; t < nt; t += 2) {
            const bool last = (t == nt - 2);
            const char* a2 = last ? nA : cA; const char* b2 = last ? nB : cB; const int k2 = last ? 0 : t + 2;
            unsigned va2[2][2];
#pragma unroll
            for (int h = 0; h < 2; ++h) { va2[h][0] = last ? vaN[h][0] : vaC[h][0]; va2[h][1] = last ? vaN[h][1] : vaC[h][1]; }
            G8_LDB(B0, 0, 0); G8_SCHED; G8_LDA(At, 0, 0); G8_STAGEA(G8_SA(1, 1), cA, vaC, 1, t + 1);
            G8_WAIT_L(8); G8_BAR; G8_WAIT_L(0); G8_MMA(0, 0, At, B0); G8_BAR; G8_SCHED;
            G8_LDB(B1, 0, 1); G8_STAGEB(G8_SB(0, 0), b2, 0, k2);
            G8_BAR; G8_WAIT_L(0); G8_MMA(0, 1, At, B1); G8_BAR;
            G8_LDA(At, 0, 1); G8_STAGEA(G8_SA(0, 0), a2, va2, 0, k2);
            G8_BAR; G8_WAIT_L(0); G8_MMA(1, 0, At, B0); G8_BAR; G8_SCHED;
            G8_STAGEB(G8_SB(0, 1), b2, 1, k2);
            G8_WAIT_V(6); G8_BAR; G8_MMA(1, 1, At, B1); G8_BAR;
            G8_LDB(B0, 1, 0); G8_SCHED; G8_LDA(At, 1, 0); G8_STAGEA(G8_SA(0, 1), a2, va2, 1, k2);
            G8_WAIT_L(8); G8_BAR; G8_WAIT_L(0); G8_MMA(0, 0, At, B0); G8_BAR; G8_SCHED;
            G8_LDB(B1, 1, 1); G8_STAGEB(G8_SB(1, 0), b2, 0, k2 + 1);
            G8_BAR; G8_WAIT_L(0); G8_MMA(0, 1, At, B1); G8_BAR;
            G8_LDA(At, 1, 1); G8_STAGEA(G8_SA(1, 0), a2, va2, 0, k2 + 1);
            G8_BAR; G8_WAIT_L(0); G8_MMA(1, 0, At, B0); G8_BAR; G8_SCHED;
            G8_STAGEB(G8_SB(1, 1), b2, 1, k2 + 1);
            G8_WAIT_V(6); G8_BAR; G8_MMA(1, 1, At, B1); G8_BAR;
        }
        { const int l2 = TID512() & 63; prob.epi(acc, cur, wr, wc, l2 & 15, l2 >> 4); }
        if (!has_next) break;
#pragma unroll
        for (int a = 0; a < 2; ++a)
#pragma unroll
            for (int b = 0; b < 2; ++b)
#pragma unroll
                for (int m = 0; m < 4; ++m)
#pragma unroll
                    for (int n = 0; n < 2; ++n) acc[a][b][m][n] = (f32x4){0.f, 0.f, 0.f, 0.f};
        cur = nxt; cA = nA; cB = nB; ++ui;
        if (P::GATHER) {
#pragma unroll
            for (int h = 0; h < 2; ++h) { vaC[h][0] = vaN[h][0]; vaC[h][1] = vaN[h][1]; }
        }
    }
    G8_WAIT_V(0);
    if (wr == 0) G8_BAR;
    G8_BAR;
#undef G8_SA
#undef G8_SB
#undef G8_STAGEA
#undef G8_STAGEB
#undef G8_LDA
#undef G8_LDB
#undef G8_MMA
#undef G8_WAIT_V
#undef G8_WAIT_L
#undef G8_BAR
#undef G8_SCHED
}
}

struct ProbG {
    static constexpr int K = 1024; static constexpr bool PERM = true, GATHER = false;
    KP p; int layer;
    DI bool next(int i, g8::Unit& u) const {
        const int id = i * (int)gridDim.x + BIDX();
        if (id >= 256) return false;
        if (gridDim.x == 256) { const int x = id & 7, y = id >> 3; u.pm = x * 8 + (y >> 2); u.pn = y & 3; } else { u.pm = id >> 2; u.pn = id & 3; }
        u.aux = 0;
        return true;
    }
    DI const char* a_base(const g8::Unit& u) const { return (const char*)(P_hx(p) + (long)u.pm * 256 * DM); }
    DI const char* b_base(const g8::Unit& u) const { return (const char*)(P_wt_out(p) + (long)u.pn * 256 * DM); }
    DI void gather(const g8::Unit&, const int (&)[2], const int (&)[2], unsigned (&)[2][2]) const {}
    DI void epi(g8::Acc& acc, const g8::Unit& u, int wr, int wc, int fr, int fq) const {
        const float* md = P_mod(p) + (layer * 2) * 6144 + 2 * 1024;
        f32x4 mv[2][2];
#pragma unroll
        for (int bj = 0; bj < 2; ++bj)
#pragma unroll
            for (int n = 0; n < 2; ++n) mv[bj][n] = *(const f32x4*)(md + u.pn * 256 + bj * 128 + wc * 32 + fq * 8 + n * 4);
#pragma unroll
        for (int ai = 0; ai < 2; ++ai)
#pragma unroll
            for (int m = 0; m < 4; ++m) {
                const long row = (long)u.pm * 256 + ai * 128 + wr * 64 + m * 16 + fr;
#pragma unroll
                for (int bj = 0; bj < 2; ++bj) {
                    const int col = u.pn * 256 + bj * 128 + wc * 32 + fq * 8;
                    f32x4 x0, x1;
                    if (layer == 0) { x0 = *(const f32x4*)(p->x + row * DM + col); x1 = *(const f32x4*)(p->x + row * DM + col + 4); }
                    else { const u32x4 w = *(const u32x4*)(P_xres(p) + row * DM + col); x0 = f32x4{bflo(w[0]), bfhi(w[0]), bflo(w[1]), bfhi(w[1])}; x1 = f32x4{bflo(w[2]), bfhi(w[2]), bflo(w[3]), bfhi(w[3])}; }
                    x0 += mv[bj][0] * acc[ai][bj][m][0]; x1 += mv[bj][1] * acc[ai][bj][m][1];
                    u32x4 o; o[0] = pack2(x0[0], x0[1]); o[1] = pack2(x0[2], x0[3]); o[2] = pack2(x1[0], x1[1]); o[3] = pack2(x1[2], x1[3]);
                    *(u32x4*)(P_xres(p) + row * DM + col) = o;
                }
            }
    }
};


constexpr int B_SPARE = 20;
constexpr int CONV_INB = 2560;
struct ProbB {
    static constexpr int K = 1024; static constexpr bool PERM = true, GATHER = false;
    KP p;
    DI bool next(int i, g8::Unit& u) const {
        constexpr int nM = 65, nN = 29, nwg = nM * nN, NX = 8, WGM = 8;
        const int nwork = (int)gridDim.x - B_SPARE;
        if (BIDX() >= nwork) return false;
        const long L = (long)i * nwork + BIDX(); if (L >= nwg) return false;
        int wgid = (int)L; { const int q = nwg / NX, r = nwg % NX, xcd = wgid % NX, off = wgid / NX; wgid = (xcd < r ? xcd * (q + 1) : r * (q + 1) + (xcd - r) * q) + off; }
        const int nig = WGM * nN, gid = wgid / nig, fm = gid * WGM, gsz = (nM - fm) < WGM ? (nM - fm) : WGM;
        u.pm = fm + ((wgid % nig) % gsz); u.pn = (wgid % nig) / gsz; u.aux = 0; return true;
    }
    DI const char* a_base(const g8::Unit& u) const { return (const char*)(P_hx(p) + (long)u.pm * 256 * DM); }
    DI const char* b_base(const g8::Unit& u) const { return (const char*)(P_wt_in(p) + (long)u.pn * 256 * DM); }
    DI void gather(const g8::Unit&, const int (&)[2], const int (&)[2], unsigned (&)[2][2]) const {}
    DI void epi(g8::Acc& acc, const g8::Unit& u, int wr, int wc, int fr, int fq) const {
        const int pn = u.pn;
        const bool lat = u.pm < 64;
        const int rk = !lat ? 0 : (pn < 4) ? 1 : (pn == 8 || pn == 9 || (pn == 10 && wc < 2)) ? 2 : 0;
        const float mul = (pn == 2 || pn == 3) ? 0.08838834764831845f : (pn == 8 || pn == 9 || pn == 11 || pn == 12) ? 0.125f : 1.f;
#pragma unroll
        for (int ai = 0; ai < 2; ++ai)
#pragma unroll
            for (int m = 0; m < 4; ++m) {
                const int row = u.pm * 256 + ai * 128 + wr * 64 + m * 16 + fr;
                if (rk != 0) {
                    const float2* tab;
                    if (rk == 1) tab = P_rope128(p) + ((wc & 1) ? (row & 63) : (row >> 6)) * 32 + fq * 8;
                    else tab = P_rope64(p) + ((fq >= 2) ? (row & 63) : (row >> 6)) * 16 + (fq & 1) * 8;
#pragma unroll
                    for (int n = 0; n < 2; ++n) {
                        const f32x4 c01 = *(const f32x4*)(tab + n * 4), c23 = *(const f32x4*)(tab + n * 4 + 2);
                        const float cs_[4] = {c01[0], c01[2], c23[0], c23[2]}, sn_[4] = {c01[1], c01[3], c23[1], c23[3]};
#pragma unroll
                        for (int e = 0; e < 4; ++e) {
                            const float x1 = acc[ai][0][m][n][e], x2 = acc[ai][1][m][n][e];
                            acc[ai][0][m][n][e] = x1 * cs_[e] - x2 * sn_[e];
                            acc[ai][1][m][n][e] = x1 * sn_[e] + x2 * cs_[e];
                        }
                    }
                }
                u16* orow = P_px(p) + (long)row * INC + pn * 256 + wc * 32 + fq * 8;
#pragma unroll
                for (int bj = 0; bj < 2; ++bj) {
                    u32x4 o;
#pragma unroll
                    for (int n = 0; n < 2; ++n)
#pragma unroll
                        for (int e = 0; e < 2; ++e) o[2 * n + e] = pack2(acc[ai][bj][m][n][2 * e] * mul, acc[ai][bj][m][n][2 * e + 1] * mul);
                    *(u32x4*)(orow + bj * 128) = o;
                }
            }
    }
};
struct ProbF {
    static constexpr int K = 512; static constexpr bool PERM = true, GATHER = false;
    KP p;
    DI bool next(int i, g8::Unit& u) const {
        const int tile = (i / 3) * (int)gridDim.x + BIDX();
        if (tile >= 256) return false;
        if (gridDim.x == 256) { const int x = tile & 7, y = tile >> 3; u.pm = x * 8 + (y >> 2); u.pn = y & 3; } else { u.pm = tile >> 2; u.pn = tile & 3; }
        u.aux = i % 3;
        return true;
    }
    DI const char* a_base(const g8::Unit& u) const { const u16* y = u.aux == 0 ? P_ya(p) : u.aux == 1 ? P_yb(p) : P_yc(p); return (const char*)(y + (long)u.pm * 256 * 512); }
    DI const char* b_base(const g8::Unit& u) const { const u16* w = u.aux == 0 ? P_wt_ret(p) : u.aux == 1 ? P_wt_win(p) : P_wt_na(p); return (const char*)(w + (long)u.pn * 256 * 512); }
    DI void gather(const g8::Unit&, const int (&)[2], const int (&)[2], unsigned (&)[2][2]) const {}
    DI void epi(g8::Acc& acc, const g8::Unit& u, int wr, int wc, int fr, int fq) const {
        const int b = u.aux;
        const long row0 = (long)u.pm * 256 + wr * 64 + fr;
        const int col0 = u.pn * 256 + wc * 32 + fq * 8;
        if (b != 2) {
            u16* z = P_z(p) + (long)b * NLAT * DM;
#pragma unroll
            for (int ai = 0; ai < 2; ++ai)
#pragma unroll
                for (int m = 0; m < 4; ++m)
#pragma unroll
                    for (int bj = 0; bj < 2; ++bj) {
                        u32x4 o;
#pragma unroll
                        for (int n = 0; n < 2; ++n)
#pragma unroll
                            for (int e = 0; e < 2; ++e) o[2 * n + e] = pack2(acc[ai][bj][m][n][2 * e], acc[ai][bj][m][n][2 * e + 1]);
                        *(u32x4*)(z + (row0 + ai * 128 + m * 16) * DM + col0 + bj * 128) = o;
                    }
            return;
        }
        const u16* zb = P_z(p);
        const u16* gp = P_px(p) + C_GATE;
#pragma unroll
        for (int ai = 0; ai < 2; ++ai)
#pragma unroll
            for (int m = 0; m < 4; ++m)
#pragma unroll
                for (int bj = 0; bj < 2; ++bj) {
                    const long row = row0 + ai * 128 + m * 16; const int col = col0 + bj * 128;
                    u32x4 zv[2], gv[3];
#pragma unroll
                    for (int q = 0; q < 2; ++q) zv[q] = *(const u32x4*)(zb + ((long)q * NLAT + row) * DM + col);
#pragma unroll
                    for (int q = 0; q < 3; ++q) gv[q] = *(const u32x4*)(gp + row * INC + q * 1024 + col);
                    u32x4 o;
#pragma unroll
                    for (int e = 0; e < 4; ++e) {
                        const int n = e >> 1, e2 = (e & 1) * 2;
                        float lo = acc[ai][bj][m][n][e2] * sigmoidf_(bflo(gv[2][e])), hi = acc[ai][bj][m][n][e2 + 1] * sigmoidf_(bfhi(gv[2][e]));
#pragma unroll
                        for (int q = 0; q < 2; ++q) { lo += bflo(zv[q][e]) * sigmoidf_(bflo(gv[q][e])); hi += bfhi(zv[q][e]) * sigmoidf_(bfhi(gv[q][e])); }
                        o[e] = pack2(lo, hi);
                    }
                    *(u32x4*)(P_hx(p) + row * DM + col) = o;
                }
    }
};
struct ProbJ {
    static constexpr int K = 1024; static constexpr bool PERM = true, GATHER = true;
    KP p;
    DI bool next(int i, g8::Unit& u) const {
        const int id = i * (int)gridDim.x + BIDX();
        if (id >= 1024) return false;
        if (gridDim.x == 256) {
            const int x = BIDX() & 7, y = BIDX() >> 3;
            u.aux = 4 * i + (x >> 1); u.pm = (x & 1) * 4 + (y >> 3); u.pn = y & 7;
        } else { u.aux = id >> 6; u.pm = (id >> 3) & 7; u.pn = id & 7; }
        return true;
    }
    DI const char* a_base(const g8::Unit&) const { return (const char*)P_hx(p); }
    DI const char* b_base(const g8::Unit& u) const { return (const char*)(P_wt_gu(p) + ((long)u.aux * 2048 + u.pn * 256) * DM); }
    DI void gather(const g8::Unit& u, const int (&R)[2], const int (&C)[2], unsigned (&va)[2][2]) const {
        const int* si = P_sel_idx(p) + u.aux * 2048 + u.pm * 256;
#pragma unroll
        for (int h = 0; h < 2; ++h)
#pragma unroll
            for (int j = 0; j < 2; ++j) va[h][j] = (unsigned)(si[h * 128 + R[j]] * DM + C[j]) * 2u;
    }
    DI void epi(g8::Acc& acc, const g8::Unit& u, int wr, int wc, int fr, int fq) const {
        u16* hb = P_hid(p) + (long)u.aux * 2048 * EH;
#pragma unroll
        for (int ai = 0; ai < 2; ++ai)
#pragma unroll
            for (int m = 0; m < 4; ++m) {
                const int slot = u.pm * 256 + ai * 128 + wr * 64 + m * 16 + fr;
                const int f = u.pn * 128 + wc * 32 + fq * 8;
                u32x4 o;
#pragma unroll
                for (int n = 0; n < 2; ++n)
#pragma unroll
                    for (int e = 0; e < 2; ++e)
                        o[2 * n + e] = pack2(siluf_(acc[ai][0][m][n][2 * e]) * acc[ai][1][m][n][2 * e], siluf_(acc[ai][0][m][n][2 * e + 1]) * acc[ai][1][m][n][2 * e + 1]);
                *(u32x4*)(hb + (long)slot * EH + f) = o;
            }
    }
};
struct ProbK {
    static constexpr int K = 1024; static constexpr bool PERM = true, GATHER = false;
    KP p; int layer;
    DI bool next(int i, g8::Unit& u) const {
        const int id = i * (int)gridDim.x + BIDX();
        if (id >= 512) return false;
        if (gridDim.x == 256) { const int x = BIDX() & 7, y = BIDX() >> 3; u.aux = 8 * i + x; u.pm = y >> 2; u.pn = y & 3; }
        else { u.aux = id >> 5; u.pm = (id >> 2) & 7; u.pn = id & 3; }
        return true;
    }
    DI const char* a_base(const g8::Unit& u) const { return (const char*)(P_hid(p) + ((long)u.aux * 2048 + u.pm * 256) * EH); }
    DI const char* b_base(const g8::Unit& u) const { return (const char*)(P_wt_dn(p) + ((long)u.aux * 1024 + u.pn * 256) * EH); }
    DI void gather(const g8::Unit&, const int (&)[2], const int (&)[2], unsigned (&)[2][2]) const {}
    DI void epi(g8::Acc& acc, const g8::Unit& u, int wr, int wc, int fr, int fq) const {
        const float* md = P_mod(p) + (layer * 2) * 6144 + 5 * 1024;
        f32x4 mv[2][2];
#pragma unroll
        for (int bj = 0; bj < 2; ++bj)
#pragma unroll
            for (int n = 0; n < 2; ++n) mv[bj][n] = *(const f32x4*)(md + u.pn * 256 + bj * 128 + wc * 32 + fq * 8 + n * 4);
#pragma unroll
        for (int ai = 0; ai < 2; ++ai)
#pragma unroll
            for (int m = 0; m < 4; ++m) {
                const int slot = u.aux * 2048 + u.pm * 256 + ai * 128 + wr * 64 + m * 16 + fr;
                const float g = P_sel_gate(p)[slot];
                u16* yr = P_ye(p) + (long)slot * DM + u.pn * 256 + wc * 32 + fq * 8;
#pragma unroll
                for (int bj = 0; bj < 2; ++bj) {
                    u32x4 o;
#pragma unroll
                    for (int n = 0; n < 2; ++n)
#pragma unroll
                        for (int e = 0; e < 2; ++e)
                            o[2 * n + e] = pack2(acc[ai][bj][m][n][2 * e] * g * mv[bj][n][2 * e], acc[ai][bj][m][n][2 * e + 1] * g * mv[bj][n][2 * e + 1]);
                    *(u32x4*)(yr + bj * 128) = o;
                }
            }
    }
};

DI void phH_item(KP p, int layer, int item, char* smem) {
    const int lane = TIDX() & 63, wid = TIDX() >> 6;
    float* hrow = (float*)smem + wid * 4096;
    const int row0 = item * 16 + wid * 4;
    norm_rows4(p, layer, row0, p->g_ffn + layer * DM, 3, 4, false, false, hrow);
    const int e = lane & 15, kp = lane >> 4;
    const float* wr_ = p->w_router + (long)layer * 1024 * 16 + e;
    float lg[4] = {0.f, 0.f, 0.f, 0.f};
#pragma unroll 8
    for (int k = kp * 256; k < kp * 256 + 256; ++k) {
        float w = wr_[k * 16];
#pragma unroll
        for (int r = 0; r < 4; ++r) lg[r] += hrow[r * 1024 + k] * w;
    }
#pragma unroll
    for (int r = 0; r < 4; ++r) {
        float l = lg[r];
        l += __shfl_xor(l, 16); l += __shfl_xor(l, 32);
        float mx = l;
        mx = fmaxf(mx, __shfl_xor(mx, 1)); mx = fmaxf(mx, __shfl_xor(mx, 2)); mx = fmaxf(mx, __shfl_xor(mx, 4)); mx = fmaxf(mx, __shfl_xor(mx, 8));
        float ex = expf(l - mx);
        float sm = ex;
        sm += __shfl_xor(sm, 1); sm += __shfl_xor(sm, 2); sm += __shfl_xor(sm, 4); sm += __shfl_xor(sm, 8);
        float a = ex / sm;
        int row = row0 + r;
        if (lane < 16) {
            if (row < NLAT) P_aff(p)[(long)e * NLAT + row] = a;
            else P_aff(p)[(long)(16 + e) * NLAT + (row - NLAT)] = a;
        }
    }
    __syncthreads();
}

DI int block_excl_scan(int v, int* sh  , int& total) {
    const int lane = TIDX() & 63, wid = TIDX() >> 6;
    int inc = v;
    for (int o = 1; o < 64; o <<= 1) { int t = __shfl_up(inc, o); if (lane >= o) inc += t; }
    __syncthreads();
    if (lane == 63) sh[wid] = inc;
    __syncthreads();
    int base = 0;
    for (int w = 0; w < wid; ++w) base += sh[w];
    total = sh[0] + sh[1] + sh[2] + sh[3];
    return base + inc - v;
}
DI void phI_item(KP p, int job, char* smem) {
    const int tid = TIDX(), lane = tid & 63, wid = tid >> 6;
    const bool lat = job < 16;
    const int n = lat ? NLAT : NCTX, cap = lat ? CAP_LAT : CAP_CTX, rowbase = lat ? 0 : NLAT;
    int* sh = (int*)smem;
    const float* a = P_aff(p) + (long)job * NLAT;
    unsigned keys[64];
    if (lat) {
#pragma unroll
        for (int i = 0; i < 16; ++i) { u32x4 v = *(const u32x4*)(a + tid * 64 + i * 4); keys[4 * i] = v[0]; keys[4 * i + 1] = v[1]; keys[4 * i + 2] = v[2]; keys[4 * i + 3] = v[3]; }
    } else {
#pragma unroll
        for (int i = 0; i < 64; ++i) keys[i] = 0u;
        keys[0] = __float_as_uint(a[tid]);
    }
    __syncthreads();
    int* hist = sh + 32;
    unsigned T = 0u, pmask = 0u; int remaining = cap;
#pragma unroll 1
    for (int pass = 0; pass < 3; ++pass) {
        const int shift = pass == 0 ? 19 : pass == 1 ? 8 : 0, nb_ = pass == 2 ? 256 : 2048;
        for (int i = tid; i < 2048; i += 256) hist[i] = 0;
        __syncthreads();
#pragma unroll
        for (int i = 0; i < 64; ++i) { const unsigned k = keys[i]; if (k != 0u && (k & pmask) == T) atomicAdd(&hist[(k >> shift) & (nb_ - 1)], 1); }
        __syncthreads();
        int mine = 0;
        const int top = nb_ - 1 - 8 * tid;
        if (top >= 7) {
#pragma unroll
            for (int q = 0; q < 8; ++q) mine += hist[top - q];
        }
        int tot_;
        const int above = block_excl_scan(mine, sh + 8, tot_);
        if (top >= 7 && above < remaining && above + mine >= remaining) {
            int cum = above, q = 0;
            for (; q < 7; ++q) { const int hv = hist[top - q]; if (cum + hv >= remaining) break; cum += hv; }
            sh[16] = top - q; sh[17] = remaining - cum;
        }
        __syncthreads();
        T |= ((unsigned)sh[16]) << shift; pmask |= ((unsigned)(nb_ - 1)) << shift; remaining = sh[17];
        __syncthreads();
    }
    int ceq = 0;
#pragma unroll
    for (int i = 0; i < 64; ++i) ceq += (keys[i] == T);
    __syncthreads();
    int tot;
    int er = block_excl_scan(ceq, sh + 8, tot);
    int csel = 0;
    { int e2 = er;
#pragma unroll
      for (int i = 0; i < 64; ++i) { const unsigned k = keys[i]; if (k > T) ++csel; else if (k == T) { if (e2 < remaining) ++csel; ++e2; } } }
    int slot = block_excl_scan(csel, sh + 8, tot);
    int* ts = P_tslot(p) + (long)job * NLAT;
    const int per = lat ? 64 : 1;
    const int base = tid * per;
#pragma unroll
    for (int i = 0; i < 64; ++i) {
        if (i < per) {
            const unsigned k = keys[i];
            bool sel = false;
            if (k > T) sel = true; else if (k == T) { sel = er < remaining; ++er; }
            if (sel) { P_sel_idx(p)[job * 2048 + slot] = rowbase + base + i; P_sel_gate(p)[job * 2048 + slot] = __uint_as_float(k); ts[base + i] = slot; ++slot; }
            else ts[base + i] = -1;
        }
    }
    __syncthreads();
}

DI void phJ_tile(KP p, int job, int mt, int nt, char* smem) {
    const int tid = TIDX(), lane = tid & 63, wid = tid >> 6, wr = wid >> 1, wc = wid & 1, fr = lane & 15, fq = lane >> 4;
    const int cap = job < 16 ? CAP_LAT : CAP_CTX, e = job & 15;
    f32x4 acc[4][4]; zero_acc<4>(acc);
    const int r0 = tid >> 2, ko = (tid & 3) * 8;
    int s0 = mt * 128 + r0, s1 = s0 + 64;
    s0 = s0 < cap ? s0 : cap - 1; s1 = s1 < cap ? s1 : cap - 1;
    const u16* a0 = P_hx(p) + (long)P_sel_idx(p)[job * 2048 + s0] * DM + ko;
    const u16* a1 = P_hx(p) + (long)P_sel_idx(p)[job * 2048 + s1] * DM + ko;
    const int f_lo = nt * 64 + (r0 & 31), f_hi = f_lo + 32, gu = (r0 >> 5) & 1;
    const u16* b0 = P_wt_gu(p) + ((long)e * 2048 + (f_lo >> 7) * 256 + gu * 128 + (f_lo & 127)) * DM + ko;
    const u16* b1 = P_wt_gu(p) + ((long)e * 2048 + (f_hi >> 7) * 256 + gu * 128 + (f_hi & 127)) * DM + ko;
    gemm_core<32>(acc, a0, a1, b0, b1, smem);
    u16* hb = job < 16 ? P_hid(p) + (long)job * 2048 * EH : P_hidc(p) + (long)(job - 16) * 32 * EH;
#pragma unroll
    for (int m = 0; m < 4; ++m)
#pragma unroll
        for (int n = 0; n < 2; ++n)
#pragma unroll
            for (int j = 0; j < 4; ++j) {
                int slot = mt * 128 + wr * 64 + m * 16 + fq * 4 + j;
                int f = nt * 64 + wc * 32 + n * 16 + fr;
                if (slot < cap) hb[(long)slot * EH + f] = f2bf(siluf_(acc[m][n][j]) * acc[m][n + 2][j]);
            }
}
DI void phK_tile(KP p, int layer, int job, int mt, int nt, char* smem) {
    const int tid = TIDX(), lane = tid & 63, wid = tid >> 6, wr = wid >> 1, wc = wid & 1, fr = lane & 15, fq = lane >> 4;
    const int cap = job < 16 ? CAP_LAT : CAP_CTX, e = job & 15;
    f32x4 acc[4][4]; zero_acc<4>(acc);
    const int r0 = tid >> 2, ko = (tid & 3) * 8;
    int s0 = mt * 128 + r0, s1 = s0 + 64;
    s0 = s0 < cap ? s0 : cap - 1; s1 = s1 < cap ? s1 : cap - 1;
    const u16* hb = job < 16 ? P_hid(p) + (long)job * 2048 * EH : P_hidc(p) + (long)(job - 16) * 32 * EH;
    const u16* a0 = hb + (long)s0 * EH + ko;
    const u16* a1 = hb + (long)s1 * EH + ko;
    const u16* b0 = P_wt_dn(p) + ((long)e * 1024 + nt * 128 + r0) * EH + ko;
    gemm_core<32>(acc, a0, a1, b0, b0 + 64 * EH, smem);
    const float* md = P_mod(p) + (layer * 2 + (job < 16 ? 0 : 1)) * 6144 + 5 * 1024;
    u16* yb_ = job < 16 ? P_ye(p) + (long)job * 2048 * DM : P_yec(p) + (long)(job - 16) * 32 * DM;
#pragma unroll
    for (int m = 0; m < 4; ++m)
#pragma unroll
        for (int j = 0; j < 4; ++j) {
            int slot = mt * 128 + wr * 64 + m * 16 + fq * 4 + j;
            if (slot < cap) {
                float g = P_sel_gate(p)[job * 2048 + slot];
#pragma unroll
                for (int n = 0; n < 4; ++n) {
                    int col = nt * 128 + wc * 64 + n * 16 + fr;
                    yb_[(long)slot * DM + col] = f2bf(acc[m][n][j] * g * md[col]);
                }
            }
        }
}


#define XB_TMO      128
#define XB_XCNT(j)  (256  + 64 * (j))
#define XB_XSUB(j)  (1280 + 64 * (j))
#define XB_XGEN(j)  (2304 + 64 * (j))
#define XB_TOP      3328
#define XB_TOPGEN   3392
#define XCD_BAR_WORDS 3456
#define XB_SPIN_CAP (1u << 18)
DI unsigned xb_ld(unsigned* p)              { return __hip_atomic_load(p, __ATOMIC_RELAXED, __HIP_MEMORY_SCOPE_AGENT); }
DI unsigned xb_add(unsigned* p, unsigned v) { return __hip_atomic_fetch_add(p, v, __ATOMIC_RELAXED, __HIP_MEMORY_SCOPE_AGENT); }
DI unsigned xb_xcc_id() { return (unsigned)__builtin_amdgcn_s_getreg((3 << 11) | 20) & 0xFu; }
#define XB_SPIN(cond, bar) do { unsigned _sp = 0; while (cond) { __builtin_amdgcn_s_sleep(1); \
    if ((++_sp & 255u) == 0u) { if (xb_ld(&(bar)[XB_TMO])) break; if (_sp > XB_SPIN_CAP) { atomicAdd(&(bar)[XB_TMO], 1u); break; } } } } while (0)
struct XcdBarrier { unsigned* bar; unsigned x; volatile LAS unsigned* st; };
DI XcdBarrier xcd_barrier_post(unsigned* bar, volatile LAS unsigned* st) {
    XcdBarrier b; b.bar = bar; b.x = xb_xcc_id(); b.st = st;
    if (threadIdx.x == 0) (void)xb_add(&bar[XB_XCNT(b.x)], 1u);
    return b;
}
DI void xcd_barrier_complete(unsigned* bar, unsigned x, unsigned& nloc, unsigned& nx) {
    const unsigned G = gridDim.x * gridDim.y * gridDim.z;
    unsigned sum, cnt, mine, sp = 0u;
    for (;;) {
        sum = 0u; cnt = 0u; mine = 0u;
#pragma unroll
        for (unsigned j = 0; j < 16; ++j) { const unsigned c = xb_ld(&bar[XB_XCNT(j)]); sum += c; cnt += (c > 0u) ? 1u : 0u; mine = (j == x) ? c : mine; }
        if (sum == G) break;
        __builtin_amdgcn_s_sleep(1);
        if ((++sp & 255u) == 0u) { if (xb_ld(&bar[XB_TMO])) break; if (sp > XB_SPIN_CAP) { atomicAdd(&bar[XB_TMO], 1u); break; } }
    }
    nloc = mine > 0u ? mine : 1u; nx = cnt > 0u ? cnt : 1u;
}
DI void xcd_barrier(const XcdBarrier& b) {
    asm volatile("s_waitcnt vmcnt(0)" ::: "memory");
    __syncthreads();
    if (threadIdx.x == 0) {
        unsigned* bar = b.bar;
        __builtin_amdgcn_s_waitcnt(0);
        unsigned nloc = b.st[0], nx = b.st[1];
        if (nloc == 0u) { xcd_barrier_complete(bar, b.x, nloc, nx); b.st[0] = nloc; b.st[1] = nx; }
        const unsigned old = xb_add(&bar[XB_XSUB(b.x)], 1u);
        const unsigned gen = old / nloc;
        if (old + 1u == (gen + 1u) * nloc) {
            __builtin_amdgcn_fence(__ATOMIC_RELEASE, "agent");
            asm volatile("s_waitcnt vmcnt(0)" ::: "memory");
            const unsigned og = xb_add(&bar[XB_TOP], 1u);
            const unsigned tg = og / nx;
            if (og + 1u == (tg + 1u) * nx) xb_add(&bar[XB_TOPGEN], 1u);
            else XB_SPIN(xb_ld(&bar[XB_TOPGEN]) == tg, bar);
            __builtin_amdgcn_fence(__ATOMIC_ACQUIRE, "agent");
            xb_add(&bar[XB_XGEN(b.x)], 1u);
            asm volatile("s_waitcnt vmcnt(0)" ::: "memory");
        } else {
            XB_SPIN(xb_ld(&bar[XB_XGEN(b.x)]) == gen, bar);
            __builtin_amdgcn_fence(__ATOMIC_ACQUIRE, "agent");
            asm volatile("s_waitcnt vmcnt(0)" ::: "memory");
        }
    }
    __syncthreads();
}

DI void run_phase(int ph, char* smem_all, int variant = 0) {
    KP p = (KP)__builtin_amdgcn_kernarg_segment_ptr();
    asm volatile("" : "+s"(p));
    const int sb = TID512() >> 8;
    char* smem = smem_all + sb * SUB_LDS;
    const int bid = BIDX() * 2 + sb, nb = gridDim.x * 2, tid = TIDX(), wid = tid >> 6;
#ifndef ONLY_SUB
    if (ph == 0) {
        for (int it = bid; it < 240; it += nb) {
            if (it < 192) ph0_gemv_item(p, it, smem);
            else ph0_rope_item(p, it - 192);
        }
        convert_tiles(p, 0, bid, CONV_DENSE, nb, smem);
        return;
    }
    if (ph == NPHASE - 1) {
        for (int it = bid; it < NLAT / 16; it += nb) {
            const int row0 = it * 16 + wid * 4, lane = tid & 63;
            float4 v[4][4];
#pragma unroll
            for (int r = 0; r < 4; ++r) load_res_row(p, row0 + r, false, v[r]);
            float4 g[4];
#pragma unroll
            for (int i = 0; i < 4; ++i) g[i] = *(const float4*)(p->g_final + i * 256 + lane * 4);
#pragma unroll
            for (int r = 0; r < 4; ++r) {
                moe_combine(p, row0 + r, v[r]);
                float ss = 0.f;
#pragma unroll
                for (int i = 0; i < 4; ++i) ss += v[r][i].x * v[r][i].x + v[r][i].y * v[r][i].y + v[r][i].z * v[r][i].z + v[r][i].w * v[r][i].w;
                ss = wave_sum(ss);
                const float rstd = rsqrtf(ss * (1.f / DM) + 1e-6f);
                float* xr = p->out + (long)(row0 + r) * DM;
#pragma unroll
                for (int i = 0; i < 4; ++i)
                    *(float4*)(xr + i * 256 + lane * 4) = make_float4(v[r][i].x * rstd * g[i].x, v[r][i].y * rstd * g[i].y, v[r][i].z * rstd * g[i].z, v[r][i].w * rstd * g[i].w);
            }
        }
        return;
    }
    const int layer = (ph - 1) / 11, sub = (ph - 1) % 11;
#else
    const int layer = (ph - 1) / 11, sub = ONLY_SUB;
#endif
    const bool need_ctx = layer == 0;
    switch (sub) {
    case 0: {
        const int nrow_items = NROWS / 16;
        for (int it = bid; it < nrow_items; it += nb) norm_rows4(p, layer, it * 16 + wid * 4, p->g_mix + layer * DM, 0, 1, layer == 0, layer == 1);
        if (layer == 1) convert_tiles(p, layer, bid, CONV_DENSE, nb, smem);
    } break;
    case 1: {
        { ProbB pb{p}; g8::gemm_phase((LAS unsigned char*)smem_all, pb); }
        const int nwork = (int)gridDim.x - B_SPARE;
        if (BIDX() >= nwork) {
            const int sb2 = TID512() >> 8, q = (BIDX() - nwork) * 2 + sb2;
            convert_tiles4(p, layer, CONV_DENSE + q, CONV_DENSE + CONV_INB, 2 * B_SPARE, smem_all + sb2 * SUB_LDS);
        }
    } break;
    case 2: {
        const int n_state = NCHUNK * 8, n_win = 1024, n_na = 1024, n_cx = need_ctx ? 32 : 0;
        const int total = n_state + n_win + n_na + n_cx;
        for (int it = bid; it < total; it += nb) {
            if (variant == 1 && it >= n_na && it < n_na + n_win) continue;
            if (variant == 1 && it >= n_na + n_win) continue;
            if (variant == 2 && (it < n_na || it >= n_na + n_win)) continue;
            if (variant == 3 && (it < n_na + n_win || it >= n_na + n_win + n_state)) continue;
            if (it < n_na) attn_block_item(p, layer, 1, it >> 3, it & 7, smem);
            else if (it < n_na + n_win) { int i2 = it - n_na; attn_block_item(p, layer, 0, i2 >> 1, i2 & 1, smem); }
            else if (it < n_win + n_na + n_state) { int i2 = it - n_win - n_na; phC_state_item(p, layer, i2 >> 3, (i2 >> 1) & 3, i2 & 1, smem); }
            else { int i2 = it - n_win - n_na - n_state; if (i2 < 16) attn_block_item(p, layer, 2, i2 >> 1, i2 & 1, smem); else { i2 -= 16; attn_block_item(p, layer, 3, i2 >> 3, i2 & 7, smem); } }
        }
    } break;
    case 3: {
        for (int it = bid; it < 512; it += nb) phD_item(p, layer, it);
    } break;
    case 4: {
        const int nch = need_ctx ? NCHUNK : 128;
        for (int it = bid; it < nch * 8; it += nb) phE_item(p, layer, it >> 3, (it >> 1) & 3, it & 1, smem);
        if (need_ctx && bid >= nb - 64) {
            float* z = P_maccx(p) + (long)(bid - (nb - 64)) * 4096 + tid * 16;
#pragma unroll
            for (int i = 0; i < 4; ++i) *(f32x4*)(z + i * 4) = f32x4{0.f, 0.f, 0.f, 0.f};
        }
    } break;
    case 5: {
        { ProbF pf{p}; g8::gemm_phase((LAS unsigned char*)smem_all, pf); }
        if (need_ctx) {
            const int sb2 = TID512() >> 8;
            for (int it = BIDX() * 2 + sb2; it < 384; it += (int)gridDim.x * 2) { const int tb = it >> 3, tile = tb / 3; phF_tile(p, 128 + (tile >> 3), tile & 7, tb % 3, it & 7, smem_all + sb2 * SUB_LDS); }
        }
    } break;
    case 6: {
        { ProbG pg{p, layer}; g8::gemm_phase((LAS unsigned char*)smem_all, pg); }
        if (need_ctx) {
            const int sb2 = TID512() >> 8;
            for (int it = BIDX() * 2 + sb2; it < 512; it += (int)gridDim.x * 2) { const int tile = it >> 5; phG_tile(p, layer, 128 + (tile >> 3), tile & 7, it & 31, smem_all + sb2 * SUB_LDS); }
        }
    } break;
    case 7: {
        const int nit = (need_ctx ? NROWS : NLAT) / 16;
        for (int it = bid; it < nit; it += nb) phH_item(p, layer, it, smem);
    } break;
    case 8: {
        const int njob = need_ctx ? 32 : 16;
        for (int it = bid; it < njob; it += nb) phI_item(p, it, smem);
        convert_tiles(p, layer, CONV_DENSE + CONV_INB + bid, CONV_TILES, nb, smem);
    } break;
    case 9: {
        { ProbJ pj{p}; g8::gemm_phase((LAS unsigned char*)smem_all, pj); }
        if (need_ctx) {
            const int sb2 = TID512() >> 8;
            for (int it = BIDX() * 2 + sb2; it < 256; it += (int)gridDim.x * 2) phJ_tile(p, 16 + (it >> 4), 0, it & 15, smem_all + sb2 * SUB_LDS);
        }
    } break;
    case 10: {
        { ProbK pk{p, layer}; g8::gemm_phase((LAS unsigned char*)smem_all, pk); }
        if (need_ctx) {
            const int sb2 = TID512() >> 8;
            for (int it = BIDX() * 2 + sb2; it < 128; it += (int)gridDim.x * 2) phK_tile(p, layer, 16 + (it >> 3), 0, it & 7, smem_all + sb2 * SUB_LDS);
        }
    } break;
    }
}

__global__ void __launch_bounds__(NTHREADS, 2) mega_kernel(Params p, int ph_lo, int ph_hi) {
    __shared__ __attribute__((aligned(16))) char smem[LDS_BYTES + 16];
    cg::grid_group grid = cg::this_grid();
#if MK_MULTI
    for (int ph = ph_lo; ph < ph_hi; ++ph) {
        if (ph > ph_lo) grid.sync();
        run_phase(ph, smem);
    }
#else
    unsigned* barw = (unsigned*)(p.ws + WS_BAR);
    volatile LAS unsigned* xst = (volatile LAS unsigned*)(LAS char*)(smem + LDS_BYTES);
    if (threadIdx.x < 4) xst[threadIdx.x] = 0u;
    if (blockIdx.x == 0) for (int i = threadIdx.x; i < XCD_BAR_WORDS; i += NTHREADS) barw[i] = 0u;
    run_phase(0, smem);
    grid.sync();
    const XcdBarrier xb = xcd_barrier_post(barw, xst);
#ifdef PROBE_SUB
#define PH(n) do { if ((n) > 1) xcd_barrier(xb); run_phase((n), smem); if ((n) >= PROBE_MIN && (n) <= PROBE_MAX && (((n) - 1) % 11) == PROBE_SUB) { xcd_barrier(xb); run_phase((n), smem, PROBE_VARIANT); } } while (0)
#else
#define PH(n) do { if ((n) > 1) xcd_barrier(xb); run_phase((n), smem); } while (0)
#endif
    PH(1); PH(2); PH(3); PH(4); PH(5); PH(6); PH(7); PH(8); PH(9); PH(10); PH(11);
    PH(12); PH(13); PH(14); PH(15); PH(16); PH(17); PH(18); PH(19); PH(20); PH(21); PH(22); PH(23);
    static_assert(NPHASE == 24, "phase program");
#undef PH
#endif
}

extern "C" void kernel_launch(void* const* d_in, const int* in_sizes, int n_in, void* d_out, int out_size, void* d_ws, size_t ws_size,
                              hipStream_t stream) {
    static int grid_blocks = 0;
    if (!grid_blocks) {
        int dev = 0, cus = 0, per_cu = 0;
        hipGetDevice(&dev);
        hipDeviceGetAttribute(&cus, hipDeviceAttributeMultiprocessorCount, dev);
        hipOccupancyMaxActiveBlocksPerMultiprocessor(&per_cu, mega_kernel, NTHREADS, 0);
        if (per_cu < 1) per_cu = 1;
        if (per_cu > 1) per_cu = 1;
        grid_blocks = cus * per_cu;
    }
    Params p{};
    const float** ip = (const float**)&p.x;
    for (int i = 0; i < 22; ++i) ip[i] = (const float*)d_in[i];
    p.out = (float*)d_out;
    p.ws = (char*)d_ws;
    if (WS_END > ws_size) { fprintf(stderr, "kernel_launch: workspace too small: need %zu have %zu\n", (size_t)WS_END, ws_size); return; }
#if MK_MULTI
    for (int ph = 0; ph < NPHASE; ++ph) {
        hipLaunchKernelGGL(mega_kernel, dim3(grid_blocks), dim3(NTHREADS), 0, stream, p, ph, ph + 1);
    }
#else
    int lo = 0, hi = NPHASE;
    void* args[] = {&p, &lo, &hi};
    hipError_t e = hipLaunchCooperativeKernel((void*)mega_kernel, dim3(grid_blocks), dim3(NTHREADS), args, 0, stream);
    if (e != hipSuccess) fprintf(stderr, "cooperative launch failed: %s (grid %d)\n", hipGetErrorString(e), grid_blocks);
#endif
}
```

```cpp
#include <hip/hip_runtime.h>
#include <hip/hip_bf16.h>
#include <hip/hip_cooperative_groups.h>
#include <cstdio>
#include <cstdint>
namespace cg = cooperative_groups;

#ifndef MK_MULTI
#define MK_MULTI 0
#endif
#ifndef MOE_HM
#define MOE_HM false
#endif
#ifndef MOE_SC
#define MOE_SC 0x7f7f7f7f
#endif

#define DI __device__ __forceinline__
typedef unsigned short u16;
typedef __attribute__((ext_vector_type(8))) short bf16x8;
typedef __attribute__((ext_vector_type(4))) float f32x4;
typedef __attribute__((ext_vector_type(4))) unsigned int u32x4;

constexpr int NLAT = 16384, NCTX = 256, NROWS = NLAT + NCTX, DM = 1024, INC = 7424;
constexpr int C_QR = 0, C_KR = 512, C_VR = 1024, C_GR = 1536, C_QW = 2048, C_KW = 2560, C_VW = 2688, C_QN = 2816, C_KN = 3328, C_VN = 3840, C_GATE = 4352;
__host__ __device__ constexpr int col_qr(int h, int x) { return C_QR + (h >> 1) * 256 + x * 128 + (h & 1) * 64; }
__host__ __device__ constexpr int col_kr(int h, int x) { return C_KR + (h >> 1) * 256 + x * 128 + (h & 1) * 64; }
__host__ __device__ constexpr int col_qw(int h, int x) { return C_QW + (h >> 2) * 256 + x * 128 + (h & 3) * 32; }
__host__ __device__ constexpr int col_kw(int kh, int x) { return C_KW + x * 128 + kh * 32; }
__host__ __device__ constexpr int col_vw(int kh) { return C_KW + 64 + kh * 128; }
constexpr int NCHUNK = NROWS / 128;
constexpr int NEXP = 16, EH = 1024, CAP_LAT = 2048, CAP_CTX = 32;
constexpr int NTHREADS = 512;
constexpr int SUB_LDS = 76 * 1024;
constexpr int LDS_BYTES = 2 * SUB_LDS;
constexpr int NPHASE = 24;


constexpr size_t al256(size_t b) { return (b + 255) & ~(size_t)255; }
constexpr size_t WS_CTXRES = 0;
constexpr size_t WS_MOD = WS_CTXRES + al256((size_t)NCTX * DM * 4);
constexpr size_t WS_ROPE128 = WS_MOD + al256(2 * 2 * 6144 * 4);
constexpr size_t WS_ROPE64 = WS_ROPE128 + al256(256 * 32 * 8);
constexpr size_t WS_WT_IN = WS_ROPE64 + al256(256 * 16 * 8);
constexpr size_t WS_WT_RET = WS_WT_IN + al256((size_t)INC * DM * 2);
constexpr size_t WS_WT_WIN = WS_WT_RET + al256((size_t)1024 * 512 * 2);
constexpr size_t WS_WT_NA = WS_WT_WIN + al256((size_t)1024 * 512 * 2);
constexpr size_t WS_WT_OUT = WS_WT_NA + al256((size_t)1024 * 512 * 2);
constexpr size_t WS_WT_GU = WS_WT_OUT + al256((size_t)1024 * 1024 * 2);
constexpr size_t WS_WT_DN = WS_WT_GU + al256((size_t)NEXP * 2048 * 1024 * 2);
constexpr size_t WS_HX = WS_WT_DN + al256((size_t)NEXP * 1024 * 1024 * 2);
constexpr size_t WS_PX = WS_HX + al256((size_t)NROWS * DM * 2);
constexpr size_t WS_YA = WS_PX + al256((size_t)NROWS * INC * 2);
constexpr size_t WS_YB = WS_YA + al256((size_t)NROWS * 512 * 2);
constexpr size_t WS_YC = WS_YB + al256((size_t)NROWS * 512 * 2);
constexpr size_t WS_S = WS_YC + al256((size_t)NROWS * 512 * 2);
constexpr size_t WS_R = WS_S + al256((size_t)NCHUNK * 8 * 16384 * 4);
constexpr size_t WS_AFF = WS_R + al256((size_t)NCHUNK * 8 * 16384 * 2);
constexpr size_t WS_SELI = WS_AFF + al256((size_t)32 * NLAT * 4);
constexpr size_t WS_SELG = WS_SELI + al256(32 * 2048 * 4);
constexpr size_t WS_TSLOT = WS_SELG + al256(32 * 2048 * 4);
constexpr size_t WS_BAR = WS_TSLOT + al256((size_t)32 * NLAT * 4);
constexpr size_t WS_MACCX = WS_BAR + al256(3456 * 4);
constexpr size_t WS_XRES = WS_MACCX + al256((size_t)NCTX * DM * 4);
constexpr size_t WS_GACC = WS_XRES + al256((size_t)NLAT * DM * 2);
constexpr size_t WS_END = WS_GACC + al256((size_t)NCTX * DM * 4);
struct Params {
    const float *x, *c, *ctx, *c_ctx, *w_mod, *b_mod, *g_mix, *g_ffn, *w_in, *decay, *ret_gn, *w_ret, *sink, *w_win, *rpb, *w_na, *w_out,
        *w_router, *w_eg, *w_eu, *w_ed, *g_final;
    float* out;
    char* ws;
};
typedef const Params __attribute__((address_space(4)))* KP;
#define WSF(name, type, off) __device__ __forceinline__ type* P_##name(KP p) { return (type*)(p->ws + (off)); }
WSF(ctxres, float, WS_CTXRES)
WSF(mod, float, WS_MOD)
WSF(rope128, float2, WS_ROPE128)
WSF(rope64, float2, WS_ROPE64)
WSF(wt_in, u16, WS_WT_IN) WSF(wt_ret, u16, WS_WT_RET) WSF(wt_win, u16, WS_WT_WIN) WSF(wt_na, u16, WS_WT_NA) WSF(wt_out, u16, WS_WT_OUT)
WSF(wt_gu, u16, WS_WT_GU) WSF(wt_dn, u16, WS_WT_DN)
WSF(hx, u16, WS_HX)
WSF(px, u16, WS_PX)
WSF(ya, u16, WS_YA) WSF(yb, u16, WS_YB) WSF(yc, u16, WS_YC)
WSF(S, float, WS_S)
WSF(R, u16, WS_R)
WSF(aff, float, WS_AFF)
WSF(sel_idx, int, WS_SELI) WSF(sel_gate, float, WS_SELG)
WSF(hid, u16, WS_PX)
__device__ __forceinline__ u16* P_hidc(KP p) { return (u16*)(p->ws + WS_PX) + (size_t)NEXP * 2048 * 1024; }
__device__ __forceinline__ u16* P_ye(KP p) { return (u16*)(p->ws + WS_PX) + (size_t)NEXP * (2048 + 32) * 1024; }
__device__ __forceinline__ u16* P_yec(KP p) { return P_ye(p) + (size_t)NEXP * 2048 * 1024; }
__device__ __forceinline__ int* P_tslot(KP p) { return (int*)(p->ws + WS_TSLOT); }
__device__ __forceinline__ u16* P_z(KP p) { return (u16*)(p->ws + WS_S); }
__device__ __forceinline__ float* P_maccx(KP p) { return (float*)(p->ws + WS_MACCX); }
__device__ __forceinline__ int* P_gacc(KP p) { return (int*)(p->ws + WS_GACC); }
constexpr float FIX_SCALE = 1048576.f, FIX_INV = 1.f / 1048576.f;
typedef unsigned char u8;
__device__ __forceinline__ u8* P_hx8(KP p) { return (u8*)(p->ws + WS_HX); }
__device__ __forceinline__ u8* P_ye8(KP p) { return (u8*)(p->ws + WS_PX) + (size_t)NEXP * (2048 + 32) * 1024 * 2; }
__device__ __forceinline__ u8* P_yec8(KP p) { return P_ye8(p) + (size_t)NEXP * 2048 * 1024; }
__device__ __forceinline__ u8* P_hx8a(KP p) { return (u8*)(p->ws + WS_S); }
__device__ __forceinline__ u8* P_wtin8(KP p) { return (u8*)(p->ws + WS_S) + (size_t)NROWS * DM; }
__device__ __forceinline__ u8* P_wgu8(KP p) { return (u8*)(p->ws + WS_WT_GU); }
__device__ __forceinline__ u8* P_wdn8(KP p) { return (u8*)(p->ws + WS_WT_DN); }
__device__ __forceinline__ u8* P_hid8(KP p) { return (u8*)(p->ws + WS_PX); }
__device__ __forceinline__ u8* P_hidc8(KP p) { return (u8*)(p->ws + WS_PX) + (size_t)NEXP * 2048 * 1024; }
__device__ __forceinline__ u16* P_xres(KP p) { return (u16*)(p->ws + WS_XRES); }
#undef WSF


DI int TIDX() { int t = threadIdx.x & 255; asm volatile("" : "+v"(t)); return t; }
DI int TID512() { int t = threadIdx.x; asm volatile("" : "+v"(t)); return t; }
DI int BIDX() { int t = blockIdx.x; asm volatile("" : "+s"(t)); return t; }
DI u16 f2bf(float x) { unsigned u = __float_as_uint(x); u += 0x7fffu + ((u >> 16) & 1u); return (u16)(u >> 16); }
DI float bf2f(u16 h) { return __uint_as_float(((unsigned)h) << 16); }
DI float bflo(unsigned w) { return __uint_as_float(w << 16); }
DI float bfhi(unsigned w) { return __uint_as_float(w & 0xffff0000u); }
typedef __bf16 bf16v2 __attribute__((ext_vector_type(2)));
typedef float f32v2 __attribute__((ext_vector_type(2)));
DI unsigned pack2(float a, float b) { f32v2 v = {a, b}; bf16v2 r = __builtin_convertvector(v, bf16v2); return __builtin_bit_cast(unsigned, r); }
DI unsigned pack_fp8x4(float a, float b, float c, float d) { int w = 0; w = __builtin_amdgcn_cvt_pk_fp8_f32(a, b, w, false); w = __builtin_amdgcn_cvt_pk_fp8_f32(c, d, w, true); return (unsigned)w; }
DI float clamp448(float v) { return fminf(fmaxf(v, -448.f), 448.f); }
DI float sigmoidf_(float x) { return __builtin_amdgcn_rcpf(1.f + __builtin_amdgcn_exp2f(x * -1.4426950408889634f)); }
DI float siluf_(float x) { return x * __builtin_amdgcn_rcpf(1.f + __builtin_amdgcn_exp2f(x * -1.4426950408889634f)); }
DI float wave_sum(float v) { for (int o = 32; o > 0; o >>= 1) v += __shfl_xor(v, o); return v; }
#define MFMA16(a, b, c) __builtin_amdgcn_mfma_f32_16x16x32_bf16((a), (b), (c), 0, 0, 0)

template <int MR>
DI void zero_acc(f32x4 (&acc)[MR][4]) {
#pragma unroll
    for (int m = 0; m < MR; ++m)
#pragma unroll
        for (int n = 0; n < 4; ++n) acc[m][n] = f32x4{0.f, 0.f, 0.f, 0.f};
}

template <int KT>
DI void gemm_core(f32x4 (&acc)[4][4], const u16* a0, const u16* a1, const u16* b0, const u16* b1, char* smem) {
    const int tid = TIDX(), lane = tid & 63, wid = tid >> 6, wr = wid >> 1, wc = wid & 1, fr = lane & 15, fq = lane >> 4;
    auto stage = [&](int kt, int buf) {
        char* base = smem + buf * 16384;
        __builtin_amdgcn_global_load_lds((const unsigned*)(a0 + kt * 32), (unsigned*)(base + tid * 16), 16, 0, 0);
        __builtin_amdgcn_global_load_lds((const unsigned*)(a1 + kt * 32), (unsigned*)(base + 4096 + tid * 16), 16, 0, 0);
        __builtin_amdgcn_global_load_lds((const unsigned*)(b0 + kt * 32), (unsigned*)(base + 8192 + tid * 16), 16, 0, 0);
        __builtin_amdgcn_global_load_lds((const unsigned*)(b1 + kt * 32), (unsigned*)(base + 12288 + tid * 16), 16, 0, 0);
    };
    __syncthreads();
    stage(0, 0);
#pragma unroll 1
    for (int kt = 0; kt < KT; ++kt) {
        asm volatile("s_waitcnt vmcnt(0)" ::: "memory");
        __syncthreads();
        if (kt + 1 < KT) stage(kt + 1, (kt + 1) & 1);
        const char* SA = smem + (kt & 1) * 16384;
        const char* SB = SA + 8192;
        bf16x8 At[4], Bt[4];
#pragma unroll
        for (int m = 0; m < 4; ++m) At[m] = *(const bf16x8*)(SA + (wr * 64 + m * 16 + fr) * 64 + fq * 16);
#pragma unroll
        for (int n = 0; n < 4; ++n) Bt[n] = *(const bf16x8*)(SB + (wc * 64 + n * 16 + fr) * 64 + fq * 16);
#pragma unroll
        for (int m = 0; m < 4; ++m)
#pragma unroll
            for (int n = 0; n < 4; ++n) acc[m][n] = MFMA16(At[m], Bt[n], acc[m][n]);
    }
}

template <int KT>
DI void gemm_core_af32(f32x4 (&acc)[4][4], const float* a0f, const float* a1f, const u16* b0, const u16* b1, char* smem) {
    const int tid = TIDX(), lane = tid & 63, wid = tid >> 6, wr = wid >> 1, wc = wid & 1, fr = lane & 15, fq = lane >> 4;
    f32x4 ar[4];
    typedef int i32x4_ __attribute__((ext_vector_type(4)));
    auto ldfix = [&](const float* q) -> f32x4 { const i32x4_ t = *(const i32x4_*)q; return __builtin_convertvector(t, f32x4) * FIX_INV; };
    auto loadA = [&](int kt) { ar[0] = ldfix(a0f + kt * 32); ar[1] = ldfix(a0f + kt * 32 + 4); ar[2] = ldfix(a1f + kt * 32); ar[3] = ldfix(a1f + kt * 32 + 4); };
    auto storeA = [&](int buf) {
        char* base = smem + buf * 16384;
        u32x4 w0, w1;
        w0[0] = pack2(ar[0][0], ar[0][1]); w0[1] = pack2(ar[0][2], ar[0][3]); w0[2] = pack2(ar[1][0], ar[1][1]); w0[3] = pack2(ar[1][2], ar[1][3]);
        w1[0] = pack2(ar[2][0], ar[2][1]); w1[1] = pack2(ar[2][2], ar[2][3]); w1[2] = pack2(ar[3][0], ar[3][1]); w1[3] = pack2(ar[3][2], ar[3][3]);
        *(u32x4*)(base + tid * 16) = w0; *(u32x4*)(base + 4096 + tid * 16) = w1;
    };
    auto stageB = [&](int kt, int buf) {
        char* base = smem + buf * 16384;
        __builtin_amdgcn_global_load_lds((const unsigned*)(b0 + kt * 32), (unsigned*)(base + 8192 + tid * 16), 16, 0, 0);
        __builtin_amdgcn_global_load_lds((const unsigned*)(b1 + kt * 32), (unsigned*)(base + 12288 + tid * 16), 16, 0, 0);
    };
    __syncthreads();
    loadA(0); stageB(0, 0); storeA(0);
#pragma unroll 1
    for (int kt = 0; kt < KT; ++kt) {
        asm volatile("s_waitcnt vmcnt(0)" ::: "memory");
        __syncthreads();
        if (kt + 1 < KT) { loadA(kt + 1); stageB(kt + 1, (kt + 1) & 1); }
        const char* SA = smem + (kt & 1) * 16384;
        const char* SB = SA + 8192;
        bf16x8 At[4], Bt[4];
#pragma unroll
        for (int m = 0; m < 4; ++m) At[m] = *(const bf16x8*)(SA + (wr * 64 + m * 16 + fr) * 64 + fq * 16);
#pragma unroll
        for (int n = 0; n < 4; ++n) Bt[n] = *(const bf16x8*)(SB + (wc * 64 + n * 16 + fr) * 64 + fq * 16);
#pragma unroll
        for (int m = 0; m < 4; ++m)
#pragma unroll
            for (int n = 0; n < 4; ++n) acc[m][n] = MFMA16(At[m], Bt[n], acc[m][n]);
        if (kt + 1 < KT) storeA((kt + 1) & 1);
    }
}

template <int MR>
DI void mma_lds64(f32x4 (&acc)[MR][4], const u16* As, int lda, const u16* Bs, int ldb) {
    const int tid = TIDX(), lane = tid & 63, wid = tid >> 6, wr = wid >> 1, wc = wid & 1, fr = lane & 15, fq = lane >> 4;
#pragma unroll
    for (int kk = 0; kk < 2; ++kk) {
        bf16x8 At[MR], Bt[4];
#pragma unroll
        for (int m = 0; m < MR; ++m) At[m] = *(const bf16x8*)(As + (wr * (MR * 16) + m * 16 + fr) * lda + kk * 32 + fq * 8);
#pragma unroll
        for (int n = 0; n < 4; ++n) Bt[n] = *(const bf16x8*)(Bs + (wc * 64 + n * 16 + fr) * ldb + kk * 32 + fq * 8);
#pragma unroll
        for (int m = 0; m < MR; ++m)
#pragma unroll
            for (int n = 0; n < 4; ++n) acc[m][n] = MFMA16(At[m], Bt[n], acc[m][n]);
    }
}
typedef short v4s_ __attribute__((ext_vector_type(4)));
typedef __attribute__((address_space(3))) v4s_* lds_v4s_ptr_;
DI bf16x8 frag_tr(const u16* M, int ld, int k0, int c0) {
    const int lane = TIDX() & 63, i = lane & 15, g = lane >> 4;
    const u16* a = M + (k0 + 8 * g + (i >> 2)) * ld + c0 + 4 * (i & 3);
    v4s_ lo = __builtin_amdgcn_ds_read_tr16_b64_v4i16((lds_v4s_ptr_)a);
    v4s_ hi = __builtin_amdgcn_ds_read_tr16_b64_v4i16((lds_v4s_ptr_)(a + 4 * ld));
    return __builtin_shufflevector(lo, hi, 0, 1, 2, 3, 4, 5, 6, 7);
}
template <int MR>
DI void mma_lds64_btr(f32x4 (&acc)[MR][4], const u16* As, int lda, const u16* Bm, int ldb) {
    const int tid = TIDX(), lane = tid & 63, wid = tid >> 6, wr = wid >> 1, wc = wid & 1, fr = lane & 15, fq = lane >> 4;
#pragma unroll
    for (int kk = 0; kk < 2; ++kk) {
        bf16x8 At[MR], Bt[4];
#pragma unroll
        for (int m = 0; m < MR; ++m) At[m] = *(const bf16x8*)(As + (wr * (MR * 16) + m * 16 + fr) * lda + kk * 32 + fq * 8);
#pragma unroll
        for (int n = 0; n < 4; ++n) Bt[n] = frag_tr(Bm, ldb, kk * 32, wc * 64 + n * 16);
#pragma unroll
        for (int m = 0; m < MR; ++m)
#pragma unroll
            for (int n = 0; n < 4; ++n) acc[m][n] = MFMA16(At[m], Bt[n], acc[m][n]);
    }
}
template <int MR>
DI void mma_lds64_tt(f32x4 (&acc)[MR][4], const u16* Am, int lda, const u16* Bm, int ldb) {
    const int tid = TIDX(), wid = tid >> 6, wr = wid >> 1, wc = wid & 1;
#pragma unroll
    for (int kk = 0; kk < 2; ++kk) {
        bf16x8 At[MR], Bt[4];
#pragma unroll
        for (int m = 0; m < MR; ++m) At[m] = frag_tr(Am, lda, kk * 32, wr * (MR * 16) + m * 16);
#pragma unroll
        for (int n = 0; n < 4; ++n) Bt[n] = frag_tr(Bm, ldb, kk * 32, wc * 64 + n * 16);
#pragma unroll
        for (int m = 0; m < MR; ++m)
#pragma unroll
            for (int n = 0; n < 4; ++n) acc[m][n] = MFMA16(At[m], Bt[n], acc[m][n]);
    }
}
template <int ROWS>
DI void stage_n64(u16* dst, int ld, const u16* src, long sstride) {
    const int tid = TIDX();
#pragma unroll
    for (int i = 0; i < ROWS / 32; ++i) {
        int idx = i * 256 + tid, row = idx >> 3, ch = idx & 7;
        u32x4 v = *(const u32x4*)(src + (long)row * sstride + ch * 8);
        *(u32x4*)(dst + row * ld + ch * 8) = v;
    }
}

DI void convert_tile(KP p, int layer, int tile, char* smem);

DI void ph0_gemv_item(KP p, int item, char* smem) {
    const int tid = TIDX();
    const int l = item / 96, cg_ = item % 96;
    float* sl = (float*)smem;
    float* red = (float*)(smem + 8192);
    __syncthreads();
    for (int k = tid; k < 1024; k += 256) { sl[k] = siluf_(p->c[k]); sl[1024 + k] = siluf_(p->c_ctx[k]); }
    __syncthreads();
    const int c4 = tid & 15, kp = tid >> 4;
    const int col = cg_ * 64 + c4 * 4;
    const float* w = p->w_mod + (long)l * 1024 * 6144 + col;
    float a0[4] = {0, 0, 0, 0}, a1[4] = {0, 0, 0, 0};
#pragma unroll 8
    for (int kk = 0; kk < 64; ++kk) {
        int k = kp * 64 + kk;
        float4 wv = *(const float4*)(w + (long)k * 6144);
        float s0 = sl[k], s1 = sl[1024 + k];
        a0[0] += s0 * wv.x; a0[1] += s0 * wv.y; a0[2] += s0 * wv.z; a0[3] += s0 * wv.w;
        a1[0] += s1 * wv.x; a1[1] += s1 * wv.y; a1[2] += s1 * wv.z; a1[3] += s1 * wv.w;
    }
#pragma unroll
    for (int j = 0; j < 4; ++j) { red[(kp * 2 + 0) * 64 + c4 * 4 + j] = a0[j]; red[(kp * 2 + 1) * 64 + c4 * 4 + j] = a1[j]; }
    __syncthreads();
    if (tid < 128) {
        int src = tid >> 6, cr = tid & 63;
        float s = 0.f;
        for (int q = 0; q < 16; ++q) s += red[(q * 2 + src) * 64 + cr];
        int n = cg_ * 64 + cr;
        P_mod(p)[(l * 2 + src) * 6144 + n] = s + p->b_mod[l * 6144 + n];
    }
}
DI void sincos_d(double a, float& c, float& s) {
    const double TWO_PI = 6.283185307179586476925286766559;
    double k = rint(a / TWO_PI);
    double r = a - k * TWO_PI;
    double r2 = r * r;
    double ts = r, tc = 1.0, ss = r, cc = 1.0;
    for (int i = 1; i <= 14; ++i) {
        tc = -tc * r2 / (double)((2 * i - 1) * (2 * i));
        ts = -ts * r2 / (double)((2 * i) * (2 * i + 1));
        cc += tc; ss += ts;
    }
    c = (float)cc; s = (float)ss;
}
DI void ph0_rope_item(KP p, int item) {
    int idx = item * 256 + TIDX();
    const double LN_BASE = 9.210340371976184;
    if (idx < 8192) {
        int pos = idx >> 5, f = idx & 31;
        float inv = (float)exp(-(double)f / 32.0 * LN_BASE);
        float ang = (float)pos * inv;
        float c, s; sincos_d((double)ang, c, s);
        P_rope128(p)[idx] = make_float2(c, s);
    } else {
        int i2 = idx - 8192;
        int pos = i2 >> 4, f = i2 & 15;
        float inv = (float)exp(-(double)f / 16.0 * LN_BASE);
        float ang = (float)pos * inv;
        float c, s; sincos_d((double)ang, c, s);
        P_rope64(p)[i2] = make_float2(c, s);
    }
}

constexpr int CONV_TILES = 928 + 192 + 128 + 6144;
constexpr int CONV_DENSE = 928 + 192 + 128;
struct ConvTile { const float* sp; u16* dp; int N, K, mode, n0, f8; };
DI ConvTile conv_setup(KP p, int layer, int tile) {
    const float* src; u16* dst; int K, N, mode = 0;
    if (tile < 928) { src = p->w_in + (long)layer * 1024 * INC; dst = P_wt_in(p); K = 1024; N = INC; mode = 1; }
    else if (tile < 928 + 192) {
        int t = tile - 928, which = t / 64; tile = t % 64; K = 512; N = 1024;
        src = (which == 0 ? p->w_ret : which == 1 ? p->w_win : p->w_na) + (long)layer * 512 * 1024;
        dst = (which == 0 ? P_wt_ret(p) : which == 1 ? P_wt_win(p) : P_wt_na(p));
    } else if (tile < 928 + 192 + 128) { tile -= 928 + 192; src = p->w_out + (long)layer * 1024 * 1024; dst = P_wt_out(p); K = 1024; N = 1024; }
    else {
        int t = tile - (928 + 192 + 128), which = t / 2048, e = (t % 2048) / 128; tile = t % 128; K = 1024; N = 1024;
        long eo = ((long)layer * NEXP + e) * 1024 * 1024;
        u8* d8;
        if (which == 0) { src = p->w_eg + eo; d8 = P_wgu8(p) + (long)e * 2048 * 1024; mode = 2; }
        else if (which == 1) { src = p->w_eu + eo; d8 = P_wgu8(p) + (long)e * 2048 * 1024; mode = 3; }
        else { src = p->w_ed + eo; d8 = P_wdn8(p) + (long)e * 1024 * 1024; }
        const int k0 = (tile >> 4) * 128, n0 = (tile & 15) * 64;
        ConvTile c; c.sp = src + (long)k0 * N + n0; c.dp = (u16*)(d8 + k0); c.N = N; c.K = K; c.mode = mode; c.n0 = n0; c.f8 = 1;
        return c;
    }
    const int ntn = N / 64;
    const int k0 = (tile / ntn) * 128, n0 = (tile % ntn) * 64;
    ConvTile c; c.sp = src + (long)k0 * N + n0; c.dp = dst + k0; c.N = N; c.K = K; c.mode = mode; c.n0 = n0; c.f8 = 0;
    if (mode == 1 && n0 >= C_VR && !(n0 >= C_GR && n0 < C_QW)) { c.f8 = 1; c.dp = (u16*)(P_wtin8(p) - (long)C_VR * 1024 + k0); }
    return c;
}
DI int conv_drow(int mode, int n) {
    if (mode == 1) {
        if (n < 1024) { int hh_ = (n & 511) >> 7, o_ = n & 127; return (n < 512 ? col_qr(hh_, o_ >> 6) : col_kr(hh_, o_ >> 6)) + (o_ & 63); }
        if (n >= C_QW && n < C_KW) { int m_ = n - C_QW; return col_qw(m_ >> 6, (m_ & 63) >> 5) + (m_ & 31); }
        if (n >= C_KW && n < C_VW) { int m_ = n - C_KW; return col_kw(m_ >> 6, (m_ & 63) >> 5) + (m_ & 31); }
        if (n >= C_VW && n < C_QN) { int m_ = n - C_VW; return col_vw(m_ >> 6) + (m_ & 63); }
        return n;
    }
    if (mode == 2) return (n >> 7) * 256 + (n & 127);
    if (mode == 3) return (n >> 7) * 256 + 128 + (n & 127);
    return n;
}
DI void convert_tiles(KP p, int layer, int first, int last, int step, char* smem) {
    const int tid = TIDX(), lane = tid & 63, w = tid >> 6;
    unsigned* T = (unsigned*)smem;
    float v[32];
    ConvTile c;
    if (first < last) {
        c = conv_setup(p, layer, first);
        const float* sp = c.sp + (long)(w * 32) * c.N + lane;
#pragma unroll
        for (int j = 0; j < 32; ++j) v[j] = sp[(long)j * c.N];
    }
    for (int t = first; t < last; t += step) {
        __syncthreads();
        if (c.f8) {
#pragma unroll
            for (int e = 0; e < 8; ++e) T[lane * 66 + w * 8 + e] = pack_fp8x4(v[4 * e] * 32.f, v[4 * e + 1] * 32.f, v[4 * e + 2] * 32.f, v[4 * e + 3] * 32.f);
        } else {
#pragma unroll
            for (int e = 0; e < 16; ++e) T[lane * 66 + w * 16 + e] = pack2(v[2 * e], v[2 * e + 1]);
        }
        const ConvTile cur = c;
        if (t + step < last) {
            c = conv_setup(p, layer, t + step);
            const float* sp = c.sp + (long)(w * 32) * c.N + lane;
#pragma unroll
            for (int j = 0; j < 32; ++j) v[j] = sp[(long)j * c.N];
        }
        __syncthreads();
        if (cur.f8) {
#pragma unroll
            for (int i = 0; i < 2; ++i) {
                const int idx = i * 256 + tid, nn = idx >> 3, ch = idx & 7;
                const u32x4 o = *(const u32x4*)(T + nn * 66 + ch * 4);
                *(u32x4*)((u8*)cur.dp + (long)conv_drow(cur.mode, cur.n0 + nn) * cur.K + ch * 16) = o;
            }
        } else {
#pragma unroll
            for (int i = 0; i < 4; ++i) {
                const int idx = i * 256 + tid, nn = idx >> 4, ch = idx & 15;
                const u32x4 o = *(const u32x4*)(T + nn * 66 + ch * 4);
                *(u32x4*)(cur.dp + (long)conv_drow(cur.mode, cur.n0 + nn) * cur.K + ch * 8) = o;
            }
        }
    }
}

DI void convert_tiles4(KP p, int layer, int first, int last, int step, char* smem) {
    const int tid = TIDX(), lane = tid & 63, w = tid >> 6;
    unsigned* T = (unsigned*)smem;
    for (int t = first; t < last; t += 4 * step) {
        float v[4][32];
        ConvTile c[4];
#pragma unroll
        for (int q = 0; q < 4; ++q) {
            const int tq = t + q * step;
            c[q] = conv_setup(p, layer, tq < last ? tq : first);
            if (tq < last) {
                const float* sp = c[q].sp + (long)(w * 32) * c[q].N + lane;
#pragma unroll
                for (int j = 0; j < 32; ++j) v[q][j] = sp[(long)j * c[q].N];
            }
        }
        __syncthreads();
#pragma unroll
        for (int q = 0; q < 4; ++q)
#pragma unroll
            for (int e = 0; e < 8; ++e) T[q * (64 * 66) + lane * 66 + w * 8 + e] = pack_fp8x4(v[q][4 * e] * 32.f, v[q][4 * e + 1] * 32.f, v[q][4 * e + 2] * 32.f, v[q][4 * e + 3] * 32.f);
        __syncthreads();
#pragma unroll
        for (int q = 0; q < 4; ++q) {
            if (t + q * step < last) {
#pragma unroll
                for (int i = 0; i < 2; ++i) {
                    const int idx = i * 256 + tid, nn = idx >> 3, ch = idx & 7;
                    const u32x4 o = *(const u32x4*)(T + q * (64 * 66) + nn * 66 + ch * 4);
                    *(u32x4*)((u8*)c[q].dp + (long)conv_drow(c[q].mode, c[q].n0 + nn) * c[q].K + ch * 16) = o;
                }
            }
        }
    }
}

DI const float* resid_row(KP p, int layer, int row) {
    if (row < NLAT) return p->x + (long)row * DM;
    return (layer == 0 ? p->ctx : P_ctxres(p)) + (long)(row - NLAT) * DM;
}
DI const float* cur_row(KP p, int row) { return P_ctxres(p) + (long)(row - NLAT) * DM; }
DI void load_res_row(KP p, int row, bool first, float4 (&v)[4]) {
    const int lane = TIDX() & 63;
    if (row < NLAT && !first) {
        const u16* xr = P_xres(p) + (long)row * DM;
#pragma unroll
        for (int i = 0; i < 4; ++i) { const uint2 w = *(const uint2*)(xr + i * 256 + lane * 4); v[i] = make_float4(bflo(w.x), bfhi(w.x), bflo(w.y), bfhi(w.y)); }
    } else {
        const float* xr = first ? resid_row(p, 0, row) : cur_row(p, row);
#pragma unroll
        for (int i = 0; i < 4; ++i) v[i] = *(const float4*)(xr + i * 256 + lane * 4);
    }
}
DI void store_res_row(KP p, int row, const float4 (&v)[4]) {
    const int lane = TIDX() & 63;
    if (row < NLAT) {
        u16* xr = P_xres(p) + (long)row * DM;
#pragma unroll
        for (int i = 0; i < 4; ++i) { uint2 w; w.x = pack2(v[i].x, v[i].y); w.y = pack2(v[i].z, v[i].w); *(uint2*)(xr + i * 256 + lane * 4) = w; }
    } else {
        float* xr = (float*)cur_row(p, row);
#pragma unroll
        for (int i = 0; i < 4; ++i) *(float4*)(xr + i * 256 + lane * 4) = v[i];
    }
}
DI void moe_combine(KP p, int row, float4 (&v)[4]) {
    const int lane = TIDX() & 63;
    const bool lat = row < NLAT;
    const int* ts = P_tslot(p) + (lat ? 0 : 16) * (long)NLAT + (lat ? row : row - NLAT);
    const u16* yb_ = lat ? P_ye(p) : P_yec(p);
    const int cap = lat ? CAP_LAT : CAP_CTX;
    int slots[NEXP];
#pragma unroll
    for (int e = 0; e < NEXP; ++e) slots[e] = ts[(long)e * NLAT];
#pragma unroll
    for (int e = 0; e < NEXP; ++e) {
        const int slot = slots[e];
        if (slot >= 0) {
            const u16* yr = yb_ + ((long)e * cap + slot) * DM + lane * 4;
#pragma unroll
            for (int i = 0; i < 4; ++i) {
                uint2 w = *(const uint2*)(yr + i * 256);
                v[i].x += bflo(w.x); v[i].y += bfhi(w.x); v[i].z += bflo(w.y); v[i].w += bfhi(w.y);
            }
        }
    }
}
DI void moe_combine4(KP p, int row0, float4 (&v)[4][4]) {
    const int lane = TIDX() & 63;
    const bool lat = row0 < NLAT;
    const int* ts0 = P_tslot(p) + (lat ? 0 : 16) * (long)NLAT + (lat ? row0 : row0 - NLAT);
    const u8* yb_ = lat ? P_ye8(p) : P_yec8(p);
    const int cap = lat ? CAP_LAT : CAP_CTX;
    int sv[4];
#pragma unroll
    for (int r = 0; r < 4; ++r) sv[r] = ts0[(long)(lane & 15) * NLAT + r];
#pragma unroll
    for (int rp = 0; rp < 2; ++rp) {
        unsigned m0 = (unsigned)__ballot(sv[rp * 2] >= 0) & 0xffffu, m1 = (unsigned)__ballot(sv[rp * 2 + 1] >= 0) & 0xffffu;
        while ((m0 | m1) != 0u) {
            int w[2][4][4]; float wt[2][4];
#pragma unroll
            for (int q = 0; q < 2; ++q)
#pragma unroll
                for (int j = 0; j < 4; ++j) {
                    unsigned& m = q == 0 ? m0 : m1;
                    const bool has = m != 0u;
                    const int e = has ? __builtin_ctz(m) : 0;
                    m = has ? (m & (m - 1u)) : 0u;
                    int sl = __builtin_amdgcn_readlane(sv[rp * 2 + q], e);
                    sl = has ? sl : 0; wt[q][j] = has ? 0.03125f : 0.f;
                    const u8* yr = yb_ + ((long)e * cap + sl) * DM + lane * 4;
#pragma unroll
                    for (int i = 0; i < 4; ++i) w[q][j][i] = *(const int*)(yr + i * 256);
                }
#pragma unroll
            for (int q = 0; q < 2; ++q)
#pragma unroll
                for (int j = 0; j < 4; ++j)
#pragma unroll
                    for (int i = 0; i < 4; ++i) {
                        float4& d = v[rp * 2 + q][i]; const int ww = w[q][j][i]; const float t = wt[q][j];
                        d.x += t * __builtin_amdgcn_cvt_f32_fp8(ww, 0); d.y += t * __builtin_amdgcn_cvt_f32_fp8(ww, 1); d.z += t * __builtin_amdgcn_cvt_f32_fp8(ww, 2); d.w += t * __builtin_amdgcn_cvt_f32_fp8(ww, 3);
                    }
        }
    }
}
DI void norm_row(KP p, int layer, int row, const float* xr, const float* g, int shift_idx, int scale_idx, u16* dst_row, float* keep  , float* wb  ) {
    const int lane = TIDX() & 63;
    const float* md = P_mod(p) + (layer * 2 + (row < NLAT ? 0 : 1)) * 6144;
    float4 v[4]; float ss = 0.f;
#pragma unroll
    for (int i = 0; i < 4; ++i) v[i] = *(const float4*)(xr + i * 256 + lane * 4);
    if (wb) {
        moe_combine(p, row, v);
#pragma unroll
        for (int i = 0; i < 4; ++i) *(float4*)(wb + i * 256 + lane * 4) = v[i];
    }
#pragma unroll
    for (int i = 0; i < 4; ++i) ss += v[i].x * v[i].x + v[i].y * v[i].y + v[i].z * v[i].z + v[i].w * v[i].w;
    ss = wave_sum(ss);
    float rstd = rsqrtf(ss * (1.f / DM) + 1e-6f);
#pragma unroll
    for (int i = 0; i < 4; ++i) {
        int c0 = i * 256 + lane * 4;
        float4 gg = *(const float4*)(g + c0), sh = *(const float4*)(md + shift_idx * 1024 + c0), sc = *(const float4*)(md + scale_idx * 1024 + c0);
        float o0 = v[i].x * rstd * gg.x * (1.f + sc.x) + sh.x, o1 = v[i].y * rstd * gg.y * (1.f + sc.y) + sh.y;
        float o2 = v[i].z * rstd * gg.z * (1.f + sc.z) + sh.z, o3 = v[i].w * rstd * gg.w * (1.f + sc.w) + sh.w;
        uint2 pk; pk.x = pack2(o0, o1); pk.y = pack2(o2, o3);
        *(uint2*)(dst_row + c0) = pk;
        if (keep) *(float4*)(keep + c0) = make_float4(o0, o1, o2, o3);
    }
}

template <int F8 = 0>
DI void norm_rows4(KP p, int layer, int row0, const float* g, int shift_idx, int scale_idx, bool first_layer_src, bool combine, float* keep = nullptr  ) {
    const int lane = TIDX() & 63;
    const float* md = P_mod(p) + (layer * 2 + (row0 < NLAT ? 0 : 1)) * 6144;
    float4 v[4][4];
#pragma unroll
    for (int r = 0; r < 4; ++r) load_res_row(p, row0 + r, first_layer_src, v[r]);
    float4 gg[4], sh[4], sc[4];
#pragma unroll
    for (int i = 0; i < 4; ++i) { const int c0 = i * 256 + lane * 4; gg[i] = *(const float4*)(g + c0); sh[i] = *(const float4*)(md + shift_idx * 1024 + c0); sc[i] = *(const float4*)(md + scale_idx * 1024 + c0); }
    if (combine) moe_combine4(p, row0, v);
#pragma unroll
    for (int r = 0; r < 4; ++r) {
        const int row = row0 + r;
        if (first_layer_src && row >= NLAT) store_res_row(p, row, v[r]);
        if (F8 == 1 && row >= NLAT) {
            const int* gr = P_gacc(p) + (long)(row - NLAT) * DM;
            const float* m2 = P_mod(p) + (layer * 2 + 1) * 6144 + 2 * 1024;
#pragma unroll
            for (int i = 0; i < 4; ++i) {
                const int c0 = i * 256 + lane * 4;
                const int4 gi = *(const int4*)(gr + c0); const float4 mm = *(const float4*)(m2 + c0);
                v[r][i].x += mm.x * ((float)gi.x * FIX_INV); v[r][i].y += mm.y * ((float)gi.y * FIX_INV); v[r][i].z += mm.z * ((float)gi.z * FIX_INV); v[r][i].w += mm.w * ((float)gi.w * FIX_INV);
            }
            store_res_row(p, row, v[r]);
        }
        if (combine) store_res_row(p, row, v[r]);
        float ss = 0.f;
#pragma unroll
        for (int i = 0; i < 4; ++i) ss += v[r][i].x * v[r][i].x + v[r][i].y * v[r][i].y + v[r][i].z * v[r][i].z + v[r][i].w * v[r][i].w;
        ss = wave_sum(ss);
        const float rstd = rsqrtf(ss * (1.f / DM) + 1e-6f);
        u16* dst_row = P_hx(p) + (long)row * DM;
#pragma unroll
        for (int i = 0; i < 4; ++i) {
            const int c0 = i * 256 + lane * 4;
            float o0 = v[r][i].x * rstd * gg[i].x * (1.f + sc[i].x) + sh[i].x, o1 = v[r][i].y * rstd * gg[i].y * (1.f + sc[i].y) + sh[i].y;
            float o2 = v[r][i].z * rstd * gg[i].z * (1.f + sc[i].z) + sh[i].z, o3 = v[r][i].w * rstd * gg[i].w * (1.f + sc[i].w) + sh[i].w;
            if (F8 == 1) *(unsigned*)(P_hx8(p) + (long)row * DM + c0) = pack_fp8x4(o0, o1, o2, o3);
            if (F8 == 2) *(unsigned*)(P_hx8a(p) + (long)row * DM + c0) = pack_fp8x4(o0, o1, o2, o3);
            if (F8 != 1) { uint2 pk; pk.x = pack2(o0, o1); pk.y = pack2(o2, o3); *(uint2*)(dst_row + c0) = pk; }
            if (keep) *(float4*)(keep + r * 1028 + c0) = make_float4(o0, o1, o2, o3);
        }
    }
}

typedef __attribute__((ext_vector_type(16))) float f32x16;
typedef short v4s __attribute__((ext_vector_type(4)));
typedef __attribute__((address_space(3))) v4s* lds_v4s_ptr;
#define MFMA32(a, b, c) __builtin_amdgcn_mfma_f32_32x32x16_bf16((a), (b), (c), 0, 0, 0)
constexpr float LOG2E = 1.4426950408889634f;

struct FA {
    bf16x8 qf[4];
    f32x16 o[2];
    float m, l;
};
DI void fa_stage(u16* Ks, u16* Vs, const u16* px, int rowstart, int colK1, int colK2, int colV) {
    const int lane = TIDX() & 63;
#pragma unroll
    for (int i = 0; i < 8; ++i) {
        int idx = i * 64 + lane, key = idx >> 3, ch = idx & 7;
        const u16* src = px + (long)(rowstart + key) * INC;
        u32x4 kv = *(const u32x4*)(src + (ch < 4 ? colK1 + ch * 8 : colK2 + (ch - 4) * 8));
        u32x4 vv = *(const u32x4*)(src + colV + ch * 8);
        *(u32x4*)(Ks + key * 72 + ch * 8) = kv;
        *(u32x4*)(Vs + key * 72 + ch * 8) = vv;
    }
}
template <int MODE>
DI void fa_tile(FA& st, const u16* Ks, const u16* Vs, int a0, const float* rrow) {
    const int lane = TIDX() & 63, c = lane & 31, hh = lane >> 5;
    const u16* kbase = Ks + c * 72 + hh * 8;
    const u16* vbase = Vs + (4 * hh + ((lane & 15) >> 2)) * 72 + 16 * ((lane >> 4) & 1) + 4 * (lane & 3);
    f32x16 s[2];
#pragma unroll
    for (int kb = 0; kb < 2; ++kb) {
#pragma unroll
        for (int r = 0; r < 16; ++r) s[kb][r] = 0.f;
#pragma unroll
        for (int ks = 0; ks < 4; ++ks) {
            bf16x8 A = *(const bf16x8*)(kbase + kb * 32 * 72 + ks * 16);
            s[kb] = MFMA32(A, st.qf[ks], s[kb]);
        }
    }
    float mx = -3.0e38f;
    const int cq = a0 + c;
    int cs = cq - 8; cs = cs < 0 ? 0 : (cs > 48 ? 48 : cs);
#pragma unroll
    for (int kb = 0; kb < 2; ++kb)
#pragma unroll
        for (int r = 0; r < 16; ++r) {
            const int j = kb * 32 + (r & 3) + 8 * (r >> 2) + 4 * hh;
            float v = s[kb][r];
            if (MODE == 1) { int d = a0 + j - c; v = (d >= -128 && d <= 128) ? v : -1e30f; }
            if (MODE == 2) { bool ok = (j >= cs) && (j < cs + 16); int ci = j - cq + 15; ci = ci < 0 ? 0 : (ci > 30 ? 30 : ci); v = ok ? v + rrow[ci] : -1e30f; }
            v *= LOG2E;
            s[kb][r] = v;
            mx = fmaxf(mx, v);
        }
    mx = fmaxf(mx, __shfl_xor(mx, 32));
    const float mn = fmaxf(st.m, mx);
    const float alpha = __builtin_amdgcn_exp2f(st.m - mn);
    float ls = 0.f;
#pragma unroll
    for (int kb = 0; kb < 2; ++kb)
#pragma unroll
        for (int r = 0; r < 16; ++r) { float pv = __builtin_amdgcn_exp2f(s[kb][r] - mn); s[kb][r] = pv; ls += pv; }
    st.l = st.l * alpha + ls; st.m = mn;
#pragma unroll
    for (int db = 0; db < 2; ++db)
#pragma unroll
        for (int r = 0; r < 16; ++r) st.o[db][r] *= alpha;
    bf16x8 pf[2][2];
#pragma unroll
    for (int kb = 0; kb < 2; ++kb)
#pragma unroll
        for (int k2 = 0; k2 < 2; ++k2) {
            u32x4 w;
#pragma unroll
            for (int e = 0; e < 4; ++e) w[e] = pack2(s[kb][8 * k2 + 2 * e], s[kb][8 * k2 + 2 * e + 1]);
            pf[kb][k2] = __builtin_bit_cast(bf16x8, w);
        }
#pragma unroll
    for (int db = 0; db < 2; ++db)
#pragma unroll
        for (int kb = 0; kb < 2; ++kb)
#pragma unroll
            for (int k2 = 0; k2 < 2; ++k2) {
                const u16* alo = vbase + (kb * 32 + 16 * k2) * 72 + db * 32;
                v4s lo = __builtin_amdgcn_ds_read_tr16_b64_v4i16((lds_v4s_ptr)alo);
                v4s hi = __builtin_amdgcn_ds_read_tr16_b64_v4i16((lds_v4s_ptr)(alo + 8 * 72));
                bf16x8 A = __builtin_shufflevector(lo, hi, 0, 1, 2, 3, 4, 5, 6, 7);
                st.o[db] = MFMA32(A, pf[kb][k2], st.o[db]);
            }
}
DI void fa_tile_na32(FA& st, const u16* Ks, const u16* Vs, int koff, bool rowok, int cs, const float* brow) {
    const int lane = TIDX() & 63, c = lane & 31, hh = lane >> 5;
    const u16* kbase = Ks + (koff + c) * 72 + hh * 8;
    const u16* vbase = Vs + (koff + 4 * hh + ((lane & 15) >> 2)) * 72 + 16 * ((lane >> 4) & 1) + 4 * (lane & 3);
    f32x16 s;
#pragma unroll
    for (int r = 0; r < 16; ++r) s[r] = 0.f;
#pragma unroll
    for (int ks = 0; ks < 4; ++ks) {
        bf16x8 A = *(const bf16x8*)(kbase + ks * 16);
        s = MFMA32(A, st.qf[ks], s);
    }
    float mx = -3.0e38f;
    const int lo = cs - koff;
#pragma unroll
    for (int r = 0; r < 16; ++r) {
        const int jj = (r & 3) + 8 * (r >> 2) + 4 * hh;
        const bool ok = rowok && (jj >= lo) && (jj < lo + 16);
        float v = ok ? (s[r] + brow[jj]) * LOG2E : -1.4e30f;
        s[r] = v;
        mx = fmaxf(mx, v);
    }
    mx = fmaxf(mx, __shfl_xor(mx, 32));
    const float mn = fmaxf(st.m, mx);
    const float alpha = __builtin_amdgcn_exp2f(st.m - mn);
    float ls = 0.f;
#pragma unroll
    for (int r = 0; r < 16; ++r) { float pv = __builtin_amdgcn_exp2f(s[r] - mn); s[r] = pv; ls += pv; }
    st.l = st.l * alpha + ls; st.m = mn;
#pragma unroll
    for (int db = 0; db < 2; ++db)
#pragma unroll
        for (int r = 0; r < 16; ++r) st.o[db][r] *= alpha;
    bf16x8 pf[2];
#pragma unroll
    for (int k2 = 0; k2 < 2; ++k2) {
        u32x4 w;
#pragma unroll
        for (int e = 0; e < 4; ++e) w[e] = pack2(s[8 * k2 + 2 * e], s[8 * k2 + 2 * e + 1]);
        pf[k2] = __builtin_bit_cast(bf16x8, w);
    }
#pragma unroll
    for (int db = 0; db < 2; ++db)
#pragma unroll
        for (int k2 = 0; k2 < 2; ++k2) {
            const u16* alo = vbase + (16 * k2) * 72 + db * 32;
            v4s lo_ = __builtin_amdgcn_ds_read_tr16_b64_v4i16((lds_v4s_ptr)alo);
            v4s hi_ = __builtin_amdgcn_ds_read_tr16_b64_v4i16((lds_v4s_ptr)(alo + 8 * 72));
            bf16x8 A = __builtin_shufflevector(lo_, hi_, 0, 1, 2, 3, 4, 5, 6, 7);
            st.o[db] = MFMA32(A, pf[k2], st.o[db]);
        }
}
DI void attn_block_item(KP p, int layer, int kind, int ia, int ib, char* smem) {
    const int tid = TIDX(), lane = tid & 63, wid = tid >> 6, c = lane & 31, hh = lane >> 5;
    u16* KV = (u16*)smem;
    float* rpbs = (float*)(smem + 36864) + 64 + wid * 512;
    const bool isna = (kind == 1 || kind == 3);
    int h, q0, a_half = 0, kvh;
    if (kind == 0) { h = ib * 4 + wid; kvh = ib; q0 = ia * 32; }
    else if (kind == 1) { h = ib; kvh = ib; q0 = 2 * ia * 64; }
    else if (kind == 2) { h = ib * 4 + wid; kvh = ib; q0 = NLAT + ia * 32; }
    else { h = ib; kvh = ib; q0 = NLAT + (ia * 4 + wid) * 32; }
    const int colQ1 = isna ? C_QN + h * 64 : col_qw(h, 0), colQ2 = isna ? colQ1 + 32 : col_qw(h, 1);
    const int colK1 = isna ? C_KN + kvh * 64 : col_kw(kvh, 0), colK2 = isna ? colK1 + 32 : col_kw(kvh, 1);
    const int colV = isna ? C_VN + kvh * 64 : col_vw(kvh);
    FA st;
    {
        const int tq = (kind == 1) ? q0 + (c >> 4) * 64 + wid * 16 + (c & 15) : q0 + c;
        const u16* qrow = P_px(p) + (long)tq * INC;
#pragma unroll
        for (int ks = 0; ks < 4; ++ks) st.qf[ks] = *(const bf16x8*)(qrow + (ks < 2 ? colQ1 + ks * 16 : colQ2 + (ks - 2) * 16) + hh * 8);
#pragma unroll
        for (int db = 0; db < 2; ++db)
#pragma unroll
            for (int r = 0; r < 16; ++r) st.o[db][r] = 0.f;
        if (isna) { st.m = -1e30f; st.l = 0.f; } else { st.m = p->sink[layer * 8 + h] * LOG2E; st.l = hh == 0 ? 1.f : 0.f; }
    }
    const int r0 = 2 * ia, rq = r0 + (c >> 4), cq = wid * 16 + (c & 15);
    int sr0 = r0 - 4; sr0 = sr0 < 0 ? 0 : (sr0 > 248 ? 248 : sr0);
    int srq = rq - 4; srq = srq < 0 ? 0 : (srq > 248 ? 248 : srq);
    int sr1 = r0 + 1 - 4; sr1 = sr1 < 0 ? 0 : (sr1 > 248 ? 248 : sr1);
    int csq = cq - 8; csq = csq < 0 ? 0 : (csq > 48 ? 48 : csq);
    const int koff = wid == 0 ? 0 : wid == 1 ? 8 : wid == 2 ? 24 : 32;
    const float* bq = rpbs + (7 - rq) * 31 + koff - cq + 15;
    if (kind == 1) {
        const float* rp = p->rpb + ((long)layer * 8 + h) * 465;
        for (int i = lane; i < 465; i += 64) rpbs[i] = rp[i];
    }
    const int nloc = kind == 0 ? 5 : kind == 1 ? 9 : 0, nt = nloc + 4;
    const int wt0 = (q0 >> 6) - 2;
    auto tile_row = [&](int i) -> int {
        if (i >= nloc) return NLAT + (i - nloc) * 64;
        if (kind == 0) { const int s0 = ((ia * 32) >> 6) - 2 + i; return (s0 < 0 || s0 >= NLAT / 64) ? -1 : s0 * 64; }
        const int kr = sr0 + i; return (kr > sr1 + 7) ? -1 : kr * 64;
    };
    const int skey = tid >> 4, sc16 = tid & 15;
    const int scol = sc16 < 8 ? (sc16 < 4 ? colK1 + sc16 * 8 : colK2 + (sc16 - 4) * 8) : colV + (sc16 - 8) * 8;
    const int sdst = (sc16 < 8 ? 0 : 64 * 72) + skey * 72 + (sc16 & 7) * 8;
    u32x4 pre[4];
    auto load_tile = [&](int row0) {
#pragma unroll
        for (int j = 0; j < 4; ++j) pre[j] = *(const u32x4*)(P_px(p) + (long)(row0 + skey + 16 * j) * INC + scol);
    };
    auto store_tile = [&](int buf) {
#pragma unroll
        for (int j = 0; j < 4; ++j) *(u32x4*)(KV + buf * (2 * 64 * 72) + sdst + 16 * j * 72) = pre[j];
    };
    __syncthreads();
    int rowc = tile_row(0);
    if (rowc >= 0) { load_tile(rowc); store_tile(0); }
    __syncthreads();
    for (int i = 0; i < nt; ++i) {
        const int rown = (i + 1 < nt) ? tile_row(i + 1) : -1;
        if (rown >= 0) load_tile(rown);
        if (rowc >= 0) {
            const u16* Ks = KV + (i & 1) * (2 * 64 * 72);
            const u16* Vs = Ks + 64 * 72;
            if (i >= nloc) fa_tile<0>(st, Ks, Vs, 0, nullptr);
            else if (kind == 0) { if (i == 0 || i == 4) fa_tile<1>(st, Ks, Vs, rowc - q0, nullptr); else fa_tile<0>(st, Ks, Vs, 0, nullptr); }
            else { const int kr = sr0 + i; fa_tile_na32(st, Ks, Vs, koff, kr >= srq && kr < srq + 8, csq, bq + kr * 31); }
        }
        if (rown >= 0) store_tile((i + 1) & 1);
        rowc = rown;
        __syncthreads();
    }
    u16* y = isna ? P_yc(p) : P_yb(p);
    {
        float lt = st.l + __shfl_xor(st.l, 32);
        float inv = 1.f / lt;
        u16* ob = KV + wid * (32 * 72);
#pragma unroll
        for (int db = 0; db < 2; ++db)
#pragma unroll
            for (int g = 0; g < 4; ++g) {
                uint2 o;
                o.x = pack2(st.o[db][4 * g] * inv, st.o[db][4 * g + 1] * inv);
                o.y = pack2(st.o[db][4 * g + 2] * inv, st.o[db][4 * g + 3] * inv);
                *(uint2*)(ob + c * 72 + db * 32 + 8 * g + 4 * hh) = o;
            }
#pragma unroll
        for (int i = 0; i < 4; ++i) {
            const int idx = i * 64 + lane, qi = idx >> 3, ch = idx & 7;
            const int tq = (kind == 1) ? q0 + (qi >> 4) * 64 + wid * 16 + (qi & 15) : q0 + qi;
            *(u32x4*)(y + (long)tq * 512 + h * 64 + ch * 8) = *(const u32x4*)(ob + qi * 72 + ch * 8);
        }
    }
}

DI void ret_gammas(KP p, int layer, int h, float& lgf2, float& lgb2) {
    float xf = p->decay[layer * 8 + h], xb = p->decay[layer * 8 + 4 + h];
    lgf2 = -log1pf(expf(-xf)) * 1.4426950408889634f;
    lgb2 = -log1pf(expf(-xb)) * 1.4426950408889634f;
}
DI void phC_state_item(KP p, int layer, int c, int h, int eh, char* smem) {
    const int tid = TIDX(), lane = tid & 63, wid = tid >> 6, wr = wid >> 1, wc = wid & 1, fr = lane & 15, fq = lane >> 4;
    u16* Vr = (u16*)smem;
    u16* Kf = Vr + 64 * 72;
    u16* Kb = Kf + 64 * 136;
    float lgf2, lgb2; ret_gammas(p, layer, h, lgf2, lgb2);
    f32x4 accF[2][4], accB[2][4]; zero_acc<2>(accF); zero_acc<2>(accB);
    const u16* base = P_px(p) + (long)c * 128 * INC;
    u32x4 pv[2], pk[4];
    auto load_half = [&](int jh) {
        const u16* rb = base + (long)jh * 64 * INC;
#pragma unroll
        for (int i = 0; i < 2; ++i) { const int idx = i * 256 + tid, row = idx >> 3, ch = idx & 7; pv[i] = *(const u32x4*)(rb + (long)row * INC + C_VR + h * 128 + eh * 64 + ch * 8); }
#pragma unroll
        for (int i = 0; i < 4; ++i) { const int idx = i * 256 + tid, row = idx >> 4, ch = idx & 15; pk[i] = *(const u32x4*)(rb + (long)row * INC + (ch < 8 ? col_kr(h, 0) + ch * 8 : col_kr(h, 1) + (ch - 8) * 8)); }
    };
    auto store_half = [&](int jh) {
#pragma unroll
        for (int i = 0; i < 2; ++i) { const int idx = i * 256 + tid, row = idx >> 3, ch = idx & 7; *(u32x4*)(Vr + row * 72 + ch * 8) = pv[i]; }
#pragma unroll
        for (int i = 0; i < 4; ++i) {
            const int idx = i * 256 + tid, row = idx >> 4, ch = idx & 15, j = jh * 64 + row;
            const float zf = __builtin_amdgcn_exp2f((float)(127 - j) * lgf2), zb = __builtin_amdgcn_exp2f((float)j * lgb2);
            u32x4 of, ob;
#pragma unroll
            for (int e = 0; e < 4; ++e) { const float lo = bflo(pk[i][e]), hi = bfhi(pk[i][e]); of[e] = pack2(lo * zf, hi * zf); ob[e] = pack2(lo * zb, hi * zb); }
            *(u32x4*)(Kf + row * 136 + ch * 8) = of;
            *(u32x4*)(Kb + row * 136 + ch * 8) = ob;
        }
    };
    load_half(0);
    __syncthreads();
    store_half(0);
    load_half(1);
    __syncthreads();
    mma_lds64_tt<2>(accF, Vr, 72, Kf, 136);
    mma_lds64_tt<2>(accB, Vr, 72, Kb, 136);
    __syncthreads();
    store_half(1);
    __syncthreads();
    mma_lds64_tt<2>(accF, Vr, 72, Kf, 136);
    mma_lds64_tt<2>(accB, Vr, 72, Kb, 136);
    __syncthreads();
#pragma unroll
    for (int m = 0; m < 2; ++m)
#pragma unroll
        for (int n = 0; n < 4; ++n)
#pragma unroll
            for (int j = 0; j < 4; ++j) {
                const int el = wr * 32 + m * 16 + fq * 4 + j, d = wc * 64 + n * 16 + fr;
                Kf[el * 136 + d] = f2bf(accF[m][n][j]);
                Kb[el * 136 + d] = f2bf(accB[m][n][j]);
            }
    __syncthreads();
    u16* Sf = (u16*)P_S(p) + ((long)(c * 4 + h) * 2 + 0) * 16384 + (long)eh * 64 * 128;
    u16* Sb = Sf + 16384;
#pragma unroll
    for (int i = 0; i < 4; ++i) {
        const int idx = i * 256 + tid, el = idx >> 4, ch = idx & 15;
        *(u32x4*)(Sf + el * 128 + ch * 8) = *(const u32x4*)(Kf + el * 136 + ch * 8);
        *(u32x4*)(Sb + el * 128 + ch * 8) = *(const u32x4*)(Kb + el * 136 + ch * 8);
    }
}

DI void phD_item(KP p, int layer, int item) {
    const int h = item >> 7, dir = (item >> 6) & 1, pos = (item & 63) * 256 + TIDX();
    float lgf2, lgb2; ret_gammas(p, layer, h, lgf2, lgb2);
    const float decay = exp2f(128.f * (dir == 0 ? lgf2 : lgb2));
    float r = 0.f;
    const long hs = (long)(h * 2 + dir) * 16384 + pos;
    auto chunk_at = [&](int i) -> int {
        if (dir == 0) return i < 2 ? 128 + i : i - 2;
        return i < 2 ? 129 - i : 129 - i;
    };
    for (int i0 = 0; i0 < NCHUNK; i0 += 13) {
        float s[13];
#pragma unroll
        for (int u = 0; u < 13; ++u) s[u] = bf2f(((const u16*)P_S(p))[(long)chunk_at(i0 + u) * 8 * 16384 + hs]);
#pragma unroll
        for (int u = 0; u < 13; ++u) {
            P_R(p)[(long)chunk_at(i0 + u) * 8 * 16384 + hs] = f2bf(r);
            r = decay * r + s[u];
        }
    }
}

DI void phE_item(KP p, int layer, int c, int h, int ih, char* smem) {
    const int tid = TIDX(), lane = tid & 63, wid = tid >> 6, wr = wid >> 1, wc = wid & 1, fr = lane & 15, fq = lane >> 4;
    u16* Qs = (u16*)smem;
    u16* X = Qs + 64 * 136;
    u16* P = X + 128 * 136;
    float* red = (float*)(P + 64 * 136);
    float lgf2, lgb2; ret_gammas(p, layer, h, lgf2, lgb2);
    const u16* base = P_px(p) + (long)c * 128 * INC;
    const u16* Rf = P_R(p) + ((long)(c * 4 + h) * 2 + 0) * 16384;
    const u16* Rb = Rf + 16384;
    const int ch = tid & 15, rw = tid >> 4;
    const int qkcol = ch < 8 ? ch * 8 : (ch - 8) * 8;
    u32x4 pre[8];
    auto load_rows = [&](const u16* src, long stride, int nrow16) {
#pragma unroll
        for (int i = 0; i < 8; ++i) if (i < nrow16) pre[i] = *(const u32x4*)(src + (long)(rw + 16 * i) * stride);
    };
    auto store_rows = [&](u16* dst, int nrow16) {
#pragma unroll
        for (int i = 0; i < 8; ++i) if (i < nrow16) *(u32x4*)(dst + (rw + 16 * i) * 136 + ch * 8) = pre[i];
    };
    f32x4 Y[2][4], T[2][4];
    zero_acc<2>(Y); zero_acc<2>(T);
    __syncthreads();
    load_rows(base + (long)ih * 64 * INC + (ch < 8 ? col_qr(h, 0) : col_qr(h, 1)) + qkcol, INC, 4); store_rows(Qs, 4);
    load_rows(Rf + ch * 8, 128, 8); store_rows(X, 8);
    load_rows(Rb + ch * 8, 128, 8);
    __syncthreads();
    mma_lds64<2>(Y, Qs, 136, X, 136); mma_lds64<2>(Y, Qs + 64, 136, X + 64, 136);
    __syncthreads();
    store_rows(X, 8);
    load_rows(base + (ch < 8 ? col_kr(h, 0) : col_kr(h, 1)) + qkcol, INC, 8);
    __syncthreads();
    mma_lds64<2>(T, Qs, 136, X, 136); mma_lds64<2>(T, Qs + 64, 136, X + 64, 136);
#pragma unroll
    for (int m = 0; m < 2; ++m)
#pragma unroll
        for (int j = 0; j < 4; ++j) {
            int i = ih * 64 + wr * 32 + m * 16 + fq * 4 + j;
            float xf = __builtin_amdgcn_exp2f((float)(i + 1) * lgf2), xb = __builtin_amdgcn_exp2f((float)(128 - i) * lgb2);
#pragma unroll
            for (int n = 0; n < 4; ++n) Y[m][n][j] = xf * Y[m][n][j] + xb * T[m][n][j];
        }
    zero_acc<2>(T);
    __syncthreads();
    store_rows(X, 8);
    load_rows(base + C_VR + h * 128 + ch * 8, INC, 8);
    __syncthreads();
    mma_lds64<2>(T, Qs, 136, X, 136); mma_lds64<2>(T, Qs + 64, 136, X + 64, 136);
#pragma unroll
    for (int m = 0; m < 2; ++m)
#pragma unroll
        for (int n = 0; n < 4; ++n)
#pragma unroll
            for (int j = 0; j < 4; ++j) {
                int il = wr * 32 + m * 16 + fq * 4 + j, i = ih * 64 + il, jj = wc * 64 + n * 16 + fr;
                float dm = __builtin_amdgcn_exp2f((i >= jj) ? (float)(i - jj) * lgf2 : (float)(jj - i) * lgb2);
                P[il * 136 + jj] = f2bf(T[m][n][j] * dm);
            }
    __syncthreads();
    store_rows(X, 8);
    __syncthreads();
    mma_lds64_btr<2>(Y, P, 136, X, 136); mma_lds64_btr<2>(Y, P + 64, 136, X + 64 * 136, 136);
    float mu[2][4], rs[2][4];
#pragma unroll
    for (int m = 0; m < 2; ++m)
#pragma unroll
        for (int j = 0; j < 4; ++j) {
            float s = Y[m][0][j] + Y[m][1][j] + Y[m][2][j] + Y[m][3][j];
            s += __shfl_xor(s, 1); s += __shfl_xor(s, 2); s += __shfl_xor(s, 4); s += __shfl_xor(s, 8);
            if (fr == 0) red[(wr * 32 + m * 16 + fq * 4 + j) * 2 + wc] = s;
        }
    __syncthreads();
#pragma unroll
    for (int m = 0; m < 2; ++m)
#pragma unroll
        for (int j = 0; j < 4; ++j) { int il = wr * 32 + m * 16 + fq * 4 + j; mu[m][j] = (red[il * 2] + red[il * 2 + 1]) * (1.f / 128.f); }
    __syncthreads();
#pragma unroll
    for (int m = 0; m < 2; ++m)
#pragma unroll
        for (int j = 0; j < 4; ++j) {
            float s = 0.f;
#pragma unroll
            for (int n = 0; n < 4; ++n) { float d = Y[m][n][j] - mu[m][j]; s += d * d; }
            s += __shfl_xor(s, 1); s += __shfl_xor(s, 2); s += __shfl_xor(s, 4); s += __shfl_xor(s, 8);
            if (fr == 0) red[(wr * 32 + m * 16 + fq * 4 + j) * 2 + wc] = s;
        }
    __syncthreads();
#pragma unroll
    for (int m = 0; m < 2; ++m)
#pragma unroll
        for (int j = 0; j < 4; ++j) { int il = wr * 32 + m * 16 + fq * 4 + j; rs[m][j] = rsqrtf((red[il * 2] + red[il * 2 + 1]) * (1.f / 128.f) + 1e-6f); }
    __syncthreads();
    const float* gn = p->ret_gn + layer * 512 + h * 128;
#pragma unroll
    for (int m = 0; m < 2; ++m)
#pragma unroll
        for (int n = 0; n < 4; ++n)
#pragma unroll
            for (int j = 0; j < 4; ++j) {
                const int il = wr * 32 + m * 16 + fq * 4 + j, e = wc * 64 + n * 16 + fr;
                P[il * 136 + e] = f2bf((Y[m][n][j] - mu[m][j]) * rs[m][j] * gn[e]);
            }
    __syncthreads();
#pragma unroll
    for (int i = 0; i < 4; ++i) {
        const int idx = i * 256 + tid, il = idx >> 4, ch = idx & 15;
        const long row = (long)c * 128 + ih * 64 + il;
        const u32x4 yv = *(const u32x4*)(P + il * 136 + ch * 8);
        const u32x4 gv = *(const u32x4*)(P_px(p) + row * INC + C_GR + h * 128 + ch * 8);
        u32x4 o;
#pragma unroll
        for (int e = 0; e < 4; ++e) o[e] = pack2(bflo(yv[e]) * siluf_(bflo(gv[e])), bfhi(yv[e]) * siluf_(bfhi(gv[e])));
        *(u32x4*)(P_ya(p) + row * 512 + h * 128 + ch * 8) = o;
    }
    __syncthreads();
}

DI void phF_tile(KP p, int mt, int nt, int b, int ks, char* smem) {
    const int tid = TIDX(), lane = tid & 63, wid = tid >> 6, wr = wid >> 1, wc = wid & 1, fr = lane & 15, fq = lane >> 4;
    const int r0 = tid >> 2, ko = (tid & 3) * 8 + ks * 64;
    float* macc = P_maccx(p) - (long)NLAT * DM;
    const u16* y = (b == 0 ? P_ya(p) : b == 1 ? P_yb(p) : P_yc(p));
    const u16* w = (b == 0 ? P_wt_ret(p) : b == 1 ? P_wt_win(p) : P_wt_na(p));
    f32x4 acc[4][4]; zero_acc<4>(acc);
    const u16* a0 = y + (long)(mt * 128 + r0) * 512 + ko;
    const u16* b0 = w + (long)(nt * 128 + r0) * 512 + ko;
    gemm_core<2>(acc, a0, a0 + 64 * 512, b0, b0 + 64 * 512, smem);
    int zero = 0; asm volatile("" : "+v"(zero));
    u8 gq[4][4][4];
#pragma unroll
    for (int m = 0; m < 4; ++m)
#pragma unroll
        for (int n = 0; n < 4; ++n)
#pragma unroll
            for (int j = 0; j < 4; ++j) {
                int row = mt * 128 + wr * 64 + m * 16 + fq * 4 + j + zero, col = nt * 128 + wc * 64 + n * 16 + fr;
                gq[m][n][j] = ((const u8*)(P_px(p) + (long)row * INC + C_GATE))[b * 1024 + col];
            }
#pragma unroll
    for (int m = 0; m < 4; ++m)
#pragma unroll
        for (int n = 0; n < 4; ++n)
#pragma unroll
            for (int j = 0; j < 4; ++j) {
                int row = mt * 128 + wr * 64 + m * 16 + fq * 4 + j + zero, col = nt * 128 + wc * 64 + n * 16 + fr;
                atomicAdd((int*)(macc + (long)row * DM + col), __float2int_rn(acc[m][n][j] * sigmoidf_(__builtin_amdgcn_cvt_f32_fp8((int)gq[m][n][j], 0)) * FIX_SCALE));
            }
}
DI void phG_tile(KP p, int layer, int mt, int nt, int ks, char* smem) {
    const int tid = TIDX(), lane = tid & 63, wid = tid >> 6, wr = wid >> 1, wc = wid & 1, fr = lane & 15, fq = lane >> 4;
    f32x4 acc[4][4]; zero_acc<4>(acc);
    const int r0 = tid >> 2, ko = (tid & 3) * 8 + ks * 32;
    const float* a0 = P_maccx(p) + (long)((mt - 128) * 128 + r0) * DM + ko;
    const u16* b0 = P_wt_out(p) + (long)(nt * 128 + r0) * DM + ko;
    gemm_core_af32<1>(acc, a0, a0 + 64 * DM, b0, b0 + 64 * DM, smem);
    int zero = 0; asm volatile("" : "+v"(zero));
#pragma unroll
    for (int m = 0; m < 4; ++m)
#pragma unroll
        for (int n = 0; n < 4; ++n)
#pragma unroll
            for (int j = 0; j < 4; ++j) {
                int row = mt * 128 + wr * 64 + m * 16 + fq * 4 + j + zero, col = nt * 128 + wc * 64 + n * 16 + fr;
                atomicAdd(P_gacc(p) + (long)(row - NLAT) * DM + col, __float2int_rn(acc[m][n][j] * FIX_SCALE));
            }
}


#define LAS __attribute__((address_space(3)))
namespace g8 {
constexpr int BM = 256, BK = 64, HALF = 128, HTB = HALF * BK * 2, STAGE_BYTES = 8 * HTB;
DI int lds_byte(int r, int c) { const int st = (r >> 4) * 2 + (c >> 5), rr = r & 15, cc = c & 31, ob = rr * 64 + cc * 2; return st * 1024 + (ob ^ (((ob >> 9) & 1) << 5)); }
DI void stage_rc(int b, int& R, int& C) { const int st = b / 1024, sb = b % 1024, swz = sb ^ (((sb >> 9) & 1) << 5); R = (st >> 1) * 16 + swz / 64; C = (st & 1) * 32 + (swz % 64) / 2; }
DI int perm32(int rho) { const int n = rho >> 4, i = rho & 15; return 8 * (i >> 2) + 4 * n + (i & 3); }
typedef int v8i_t __attribute__((ext_vector_type(8)));
typedef int v4i_t __attribute__((ext_vector_type(4)));
struct Unit { int pm, pn, aux; };
typedef f32x4 Acc[2][2][4][2];

template <class P>
DI void gemm_phase(LAS unsigned char* lds, const P& prob) {
    const int tid = TID512(), wid = __builtin_amdgcn_readfirstlane(tid >> 6), lane = tid & 63, wr = wid >> 2, wc = wid & 3, fr = lane & 15, fq = lane >> 4;
    constexpr int K = P::K, EB = P::FP8 ? 1 : 2, nt = K * EB / (BK * 2);
    int Rr[2], Cc[2];
    unsigned voffA[2], voffB[2];
#pragma unroll
    for (int i = 0; i < 2; ++i) { stage_rc(tid * 16 + i * 8192, Rr[i], Cc[i]); const int Rb = P::PERM ? ((Rr[i] & ~31) + perm32(Rr[i] & 31)) : Rr[i];
        voffA[i] = (unsigned)(Rr[i] * K * EB + Cc[i] * 2); voffB[i] = (unsigned)(Rb * K * EB + Cc[i] * 2); }
    constexpr size_t kstep = (size_t)(BK * 2);
    constexpr size_t hstep = (size_t)HALF * K * EB;
    const unsigned ldsw = (unsigned)wid * 1024u;
    const int aoff0 = lds_byte(wr * 64 + fr, fq * 8), aoff1 = aoff0 + 1024;
    const int boff0 = lds_byte(wc * 32 + fr, fq * 8), boff1 = boff0 + 1024;
    unsigned vaC[2][2], vaN[2][2];
#define G8_SA(b, h) (((b) * 2 + (h)) * HTB)
#define G8_SB(b, h) ((4 + (b) * 2 + (h)) * HTB)
#define G8_STAGEA(bufoff, base, VA, h, kt) do { _Pragma("unroll") for (int _i = 0; _i < 2; ++_i) \
        __builtin_amdgcn_global_load_lds((const unsigned*)((base) + (P::GATHER ? (size_t)(VA)[h][_i] : (size_t)voffA[_i] + (size_t)(h) * hstep) + (size_t)(kt) * kstep), (LAS unsigned*)(lds + (bufoff) + ldsw + _i * 8192), 16, 0, 0); } while (0)
#define G8_STAGEB(bufoff, base, h, kt) do { _Pragma("unroll") for (int _i = 0; _i < 2; ++_i) \
        __builtin_amdgcn_global_load_lds((const unsigned*)((base) + (size_t)(h) * hstep + voffB[_i] + (size_t)(kt) * kstep), (LAS unsigned*)(lds + (bufoff) + ldsw + _i * 8192), 16, 0, 0); } while (0)
#define G8_LD16(off) (*(const LAS v4i_t*)(lds + (off)))
#define G8_LDA(dst, b, h) do { _Pragma("unroll") for (int m = 0; m < 4; ++m) { const v4i_t _lo = G8_LD16(G8_SA(b, h) + aoff0 + m * 2048), _hi = G8_LD16(G8_SA(b, h) + aoff1 + m * 2048); \
        dst[m] = __builtin_shufflevector(_lo, _hi, 0, 1, 2, 3, 4, 5, 6, 7); } } while (0)
#define G8_LDB(dst, b, h) do { _Pragma("unroll") for (int n = 0; n < 2; ++n) { const v4i_t _lo = G8_LD16(G8_SB(b, h) + boff0 + n * 2048), _hi = G8_LD16(G8_SB(b, h) + boff1 + n * 2048); \
        dst[n] = __builtin_shufflevector(_lo, _hi, 0, 1, 2, 3, 4, 5, 6, 7); } } while (0)
#define G8_HALF(v, k) __builtin_bit_cast(bf16x8, __builtin_shufflevector((v), (v), 4 * (k), 4 * (k) + 1, 4 * (k) + 2, 4 * (k) + 3))
#define G8_MMA(ai, bj, At, Bt) do { __builtin_amdgcn_s_setprio(1); _Pragma("unroll") for (int m = 0; m < 4; ++m) _Pragma("unroll") for (int n = 0; n < 2; ++n) { \
        if (P::FP8) asm volatile("v_mfma_f32_16x16x128_f8f6f4 %0, %1, %2, %0" : "+v"(acc[ai][bj][m][n]) : "v"(Bt[n]), "v"(At[m])); \
        else { acc[ai][bj][m][n] = __builtin_amdgcn_mfma_f32_16x16x32_bf16(G8_HALF(Bt[n], 0), G8_HALF(At[m], 0), acc[ai][bj][m][n], 0, 0, 0); \
               acc[ai][bj][m][n] = __builtin_amdgcn_mfma_f32_16x16x32_bf16(G8_HALF(Bt[n], 1), G8_HALF(At[m], 1), acc[ai][bj][m][n], 0, 0, 0); } } \
        __builtin_amdgcn_s_setprio(0); } while (0)
#define G8_WAIT_V(n) asm volatile("s_waitcnt vmcnt(" #n ")" ::: "memory")
#define G8_WAIT_L(n) asm volatile("s_waitcnt lgkmcnt(" #n ")" ::: "memory")
#define G8_BAR __builtin_amdgcn_s_barrier()
#define G8_SCHED __builtin_amdgcn_sched_barrier(0)
    Unit cur, nxt; int ui = 0;
    __syncthreads();
    if (!prob.next(0, cur)) return;
    if (P::GATHER) prob.gather(cur, Rr, Cc, vaC);
    const char* cA = prob.a_base(cur); const char* cB = prob.b_base(cur);
    Acc acc;
#pragma unroll
    for (int a = 0; a < 2; ++a)
#pragma unroll
        for (int b = 0; b < 2; ++b)
#pragma unroll
            for (int m = 0; m < 4; ++m)
#pragma unroll
                for (int n = 0; n < 2; ++n) acc[a][b][m][n] = (f32x4){0.f, 0.f, 0.f, 0.f};
    v8i_t At[4], B0[2], B1[2];
    G8_STAGEB(G8_SB(0, 0), cB, 0, 0); G8_STAGEA(G8_SA(0, 0), cA, vaC, 0, 0); G8_STAGEB(G8_SB(0, 1), cB, 1, 0); if (!P::HALF_M) G8_STAGEA(G8_SA(0, 1), cA, vaC, 1, 0);
    if (wr == 1) G8_BAR;
    G8_WAIT_V(4); G8_BAR;
    G8_STAGEB(G8_SB(1, 0), cB, 0, 1); G8_STAGEA(G8_SA(1, 0), cA, vaC, 0, 1); G8_STAGEB(G8_SB(1, 1), cB, 1, 1);
    G8_WAIT_V(6); G8_BAR;
    for (;;) {
        const bool has_next = prob.next(ui + 1, nxt);
        if (!has_next) nxt = cur;
        if (P::GATHER) {
            if (has_next) prob.gather(nxt, Rr, Cc, vaN);
            else {
#pragma unroll
                for (int h = 0; h < 2; ++h) { vaN[h][0] = vaC[h][0]; vaN[h][1] = vaC[h][1]; }
            }
        }
        const char* nA = prob.a_base(nxt); const char* nB = prob.b_base(nxt);
#pragma unroll 1
        for (int t = 0; t < nt; t += 2) {
            const bool last = (t == nt - 2);
            const char* a2 = last ? nA : cA; const char* b2 = last ? nB : cB; const int k2 = last ? 0 : t + 2;
            unsigned va2[2][2];
#pragma unroll
            for (int h = 0; h < 2; ++h) { va2[h][0] = last ? vaN[h][0] : vaC[h][0]; va2[h][1] = last ? vaN[h][1] : vaC[h][1]; }
            G8_LDB(B0, 0, 0); G8_SCHED; G8_LDA(At, 0, 0); if (!P::HALF_M) G8_STAGEA(G8_SA(1, 1), cA, vaC, 1, t + 1);
            G8_WAIT_L(8); G8_BAR; G8_WAIT_L(0); G8_MMA(0, 0, At, B0); G8_BAR; G8_SCHED;
            G8_LDB(B1, 0, 1); G8_STAGEB(G8_SB(0, 0), b2, 0, k2);
            G8_BAR; G8_WAIT_L(0); G8_MMA(0, 1, At, B1); G8_BAR;
            if (!P::HALF_M) G8_LDA(At, 0, 1);
            G8_STAGEA(G8_SA(0, 0), a2, va2, 0, k2);
            G8_BAR; G8_WAIT_L(0); if (!P::HALF_M) G8_MMA(1, 0, At, B0); G8_BAR; G8_SCHED;
            G8_STAGEB(G8_SB(0, 1), b2, 1, k2);
            G8_WAIT_V(6); G8_BAR; if (!P::HALF_M) G8_MMA(1, 1, At, B1); G8_BAR;
            G8_LDB(B0, 1, 0); G8_SCHED; G8_LDA(At, 1, 0); if (!P::HALF_M) G8_STAGEA(G8_SA(0, 1), a2, va2, 1, k2);
            G8_WAIT_L(8); G8_BAR; G8_WAIT_L(0); G8_MMA(0, 0, At, B0); G8_BAR; G8_SCHED;
            G8_LDB(B1, 1, 1); G8_STAGEB(G8_SB(1, 0), b2, 0, k2 + 1);
            G8_BAR; G8_WAIT_L(0); G8_MMA(0, 1, At, B1); G8_BAR;
            if (!P::HALF_M) G8_LDA(At, 1, 1);
            G8_STAGEA(G8_SA(1, 0), a2, va2, 0, k2 + 1);
            G8_BAR; G8_WAIT_L(0); if (!P::HALF_M) G8_MMA(1, 0, At, B0); G8_BAR; G8_SCHED;
            G8_STAGEB(G8_SB(1, 1), b2, 1, k2 + 1);
            G8_WAIT_V(6); G8_BAR; if (!P::HALF_M) G8_MMA(1, 1, At, B1); G8_BAR;
        }
        if (P::FP8) asm volatile("s_nop 15\n\ts_nop 15" ::: "memory");
        { const int l2 = TID512() & 63; prob.epi(acc, cur, wr, wc, l2 & 15, l2 >> 4); }
        if (!has_next) break;
#pragma unroll
        for (int a = 0; a < 2; ++a)
#pragma unroll
            for (int b = 0; b < 2; ++b)
#pragma unroll
                for (int m = 0; m < 4; ++m)
#pragma unroll
                    for (int n = 0; n < 2; ++n) acc[a][b][m][n] = (f32x4){0.f, 0.f, 0.f, 0.f};
        cur = nxt; cA = nA; cB = nB; ++ui;
        if (P::GATHER) {
#pragma unroll
            for (int h = 0; h < 2; ++h) { vaC[h][0] = vaN[h][0]; vaC[h][1] = vaN[h][1]; }
        }
    }
    G8_WAIT_V(0);
    if (wr == 0) G8_BAR;
    G8_BAR;
#undef G8_SA
#undef G8_SB
#undef G8_STAGEA
#undef G8_STAGEB
#undef G8_LDA
#undef G8_LD16
#undef G8_LD32
#undef G8_HALF
#undef G8_LDB
#undef G8_MMA
#undef G8_WAIT_V
#undef G8_WAIT_L
#undef G8_BAR
#undef G8_SCHED
}
}

struct ProbG {
    static constexpr int K = 1024; static constexpr bool PERM = true, GATHER = false, FP8 = false, HALF_M = false;
    KP p; int layer;
    DI bool next(int i, g8::Unit& u) const {
        const int id = i * (int)gridDim.x + BIDX();
        if (id >= 256) return false;
        if (gridDim.x == 256) { const int x = id & 7, y = id >> 3; u.pm = x * 8 + (y >> 2); u.pn = y & 3; } else { u.pm = id >> 2; u.pn = id & 3; }
        u.aux = 0;
        return true;
    }
    DI const char* a_base(const g8::Unit& u) const { return (const char*)(P_hx(p) + (long)u.pm * 256 * DM); }
    DI const char* b_base(const g8::Unit& u) const { return (const char*)(P_wt_out(p) + (long)u.pn * 256 * DM); }
    DI void gather(const g8::Unit&, const int (&)[2], const int (&)[2], unsigned (&)[2][2]) const {}
    DI void epi(g8::Acc& acc, const g8::Unit& u, int wr, int wc, int fr, int fq) const {
        const float* md = P_mod(p) + (layer * 2) * 6144 + 2 * 1024;
        f32x4 mv[2][2];
#pragma unroll
        for (int bj = 0; bj < 2; ++bj)
#pragma unroll
            for (int n = 0; n < 2; ++n) mv[bj][n] = *(const f32x4*)(md + u.pn * 256 + bj * 128 + wc * 32 + fq * 8 + n * 4);
        const long rowb = (long)u.pm * 256 + wr * 64 + fr; const int colb = u.pn * 256 + wc * 32 + fq * 8;
#pragma unroll
        for (int ai = 0; ai < 2; ++ai)
#pragma unroll
            for (int mh = 0; mh < 2; ++mh) {
                f32x4 xv[4][2];
                if (layer == 0) {
#pragma unroll
                    for (int j = 0; j < 4; ++j) { const float* xp = p->x + (rowb + ai * 128 + (mh * 2 + (j >> 1)) * 16) * DM + colb + (j & 1) * 128; xv[j][0] = *(const f32x4*)xp; xv[j][1] = *(const f32x4*)(xp + 4); }
                } else {
                    u32x4 w[4];
#pragma unroll
                    for (int j = 0; j < 4; ++j) w[j] = *(const u32x4*)(P_xres(p) + (rowb + ai * 128 + (mh * 2 + (j >> 1)) * 16) * DM + colb + (j & 1) * 128);
#pragma unroll
                    for (int j = 0; j < 4; ++j) { xv[j][0] = f32x4{bflo(w[j][0]), bfhi(w[j][0]), bflo(w[j][1]), bfhi(w[j][1])}; xv[j][1] = f32x4{bflo(w[j][2]), bfhi(w[j][2]), bflo(w[j][3]), bfhi(w[j][3])}; }
                }
#pragma unroll
                for (int j = 0; j < 4; ++j) {
                    const int m = mh * 2 + (j >> 1), bj = j & 1;
                    const f32x4 x0 = xv[j][0] + mv[bj][0] * acc[ai][bj][m][0], x1 = xv[j][1] + mv[bj][1] * acc[ai][bj][m][1];
                    u32x4 o; o[0] = pack2(x0[0], x0[1]); o[1] = pack2(x0[2], x0[3]); o[2] = pack2(x1[0], x1[1]); o[3] = pack2(x1[2], x1[3]);
                    *(u32x4*)(P_xres(p) + (rowb + ai * 128 + m * 16) * DM + colb + bj * 128) = o;
                }
            }
    }
};


constexpr int B_SPARE = 20;
constexpr int CONV_INB = 1600;
template <bool F8>
struct ProbBT {
    static constexpr int K = 1024; static constexpr bool PERM = true, GATHER = false, FP8 = F8, HALF_M = false;
    KP p;
    DI bool next(int i, g8::Unit& u) const {
        constexpr int nM = 65, nN = F8 ? 23 : 6, nwg = nM * nN, NX = 8, WGM = 8;
        const int nwork = (int)gridDim.x - B_SPARE;
        if (BIDX() >= nwork) return false;
        const long L = (long)i * nwork + (F8 ? nwork - 1 - BIDX() : BIDX()); if (L >= nwg) return false;
        int wgid = (int)L; { const int q = nwg / NX, r = nwg % NX, xcd = wgid % NX, off = wgid / NX; wgid = (xcd < r ? xcd * (q + 1) : r * (q + 1) + (xcd - r) * q) + off; }
        const int nig = WGM * nN, gid = wgid / nig, fm = gid * WGM, gsz = (nM - fm) < WGM ? (nM - fm) : WGM;
        u.pm = fm + ((wgid % nig) % gsz); { const int idx = (wgid % nig) / gsz; u.pn = F8 ? (idx < 2 ? 4 + idx : idx + 6) : (idx < 4 ? idx : idx + 2); } u.aux = 0; return true;
    }
    DI const char* a_base(const g8::Unit& u) const { return F8 ? (const char*)(P_hx8a(p) + (long)u.pm * 256 * DM) : (const char*)(P_hx(p) + (long)u.pm * 256 * DM); }
    DI const char* b_base(const g8::Unit& u) const { return F8 ? (const char*)(P_wtin8(p) + (long)(u.pn - 4) * 256 * DM) : (const char*)(P_wt_in(p) + (long)u.pn * 256 * DM); }
    DI void gather(const g8::Unit&, const int (&)[2], const int (&)[2], unsigned (&)[2][2]) const {}
    DI void epi(g8::Acc& acc, const g8::Unit& u, int wr, int wc, int fr, int fq) const {
        const int pn = u.pn;
        const bool lat = u.pm < 64;
        const int rk = !lat ? 0 : (pn < 4) ? 1 : (pn == 8 || pn == 9 || (pn == 10 && wc < 2)) ? 2 : 0;
        const float mul = ((pn == 2 || pn == 3) ? 0.08838834764831845f : (pn == 8 || pn == 9 || pn == 11 || pn == 12) ? 0.125f : 1.f) * (F8 ? 0.03125f : 1.f);
#pragma unroll
        for (int ai = 0; ai < 2; ++ai) {
        if (rk != 0) {
#pragma unroll
                for (int m = 0; m < 4; ++m) {
                    const int row = u.pm * 256 + ai * 128 + wr * 64 + m * 16 + fr;
                    const float2* tab;
                    if (rk == 1) tab = P_rope128(p) + ((wc & 1) ? (row & 63) : (row >> 6)) * 32 + fq * 8;
                    else tab = P_rope64(p) + ((fq >= 2) ? (row & 63) : (row >> 6)) * 16 + (fq & 1) * 8;
#pragma unroll
                    for (int n = 0; n < 2; ++n) {
                        const f32x4 c01 = *(const f32x4*)(tab + n * 4), c23 = *(const f32x4*)(tab + n * 4 + 2);
                        const float cs_[4] = {c01[0], c01[2], c23[0], c23[2]}, sn_[4] = {c01[1], c01[3], c23[1], c23[3]};
#pragma unroll
                        for (int e = 0; e < 4; ++e) {
                            const float x1 = acc[ai][0][m][n][e], x2 = acc[ai][1][m][n][e];
                            acc[ai][0][m][n][e] = x1 * cs_[e] - x2 * sn_[e];
                            acc[ai][1][m][n][e] = x1 * sn_[e] + x2 * cs_[e];
                        }
                    }
                }
        }
#pragma unroll
            for (int m = 0; m < 4; ++m) {
                const int row = u.pm * 256 + ai * 128 + wr * 64 + m * 16 + fr;
                u16* orow = P_px(p) + (long)row * INC + pn * 256 + wc * 32 + fq * 8;
                if (F8 && pn >= 17) {
                    u8* grow = (u8*)(P_px(p) + (long)row * INC + C_GATE) + (pn - 17) * 256 + wc * 32 + fq * 8;
#pragma unroll
                    for (int bj = 0; bj < 2; ++bj) {
                        float hv[8];
#pragma unroll
                        for (int n = 0; n < 2; ++n)
#pragma unroll
                            for (int e = 0; e < 4; ++e) hv[4 * n + e] = clamp448(acc[ai][bj][m][n][e] * mul);
                        uint2 o; o.x = pack_fp8x4(hv[0], hv[1], hv[2], hv[3]); o.y = pack_fp8x4(hv[4], hv[5], hv[6], hv[7]);
                        *(uint2*)(grow + bj * 128) = o;
                    }
                    continue;
                }
#pragma unroll
                for (int bj = 0; bj < 2; ++bj) {
                    u32x4 o;
#pragma unroll
                    for (int n = 0; n < 2; ++n)
#pragma unroll
                        for (int e = 0; e < 2; ++e) o[2 * n + e] = pack2(acc[ai][bj][m][n][2 * e] * mul, acc[ai][bj][m][n][2 * e + 1] * mul);
                    *(u32x4*)(orow + bj * 128) = o;
                }
            }
        }
    }
};
struct ProbF {
    static constexpr int K = 512; static constexpr bool PERM = true, GATHER = false, FP8 = false, HALF_M = false;
    KP p;
    DI bool next(int i, g8::Unit& u) const {
        const int tile = (i / 3) * (int)gridDim.x + BIDX();
        if (tile >= 256) return false;
        if (gridDim.x == 256) { const int x = tile & 7, y = tile >> 3; u.pm = x * 8 + (y >> 2); u.pn = y & 3; } else { u.pm = tile >> 2; u.pn = tile & 3; }
        u.aux = i % 3;
        return true;
    }
    DI const char* a_base(const g8::Unit& u) const { const u16* y = u.aux == 0 ? P_ya(p) : u.aux == 1 ? P_yb(p) : P_yc(p); return (const char*)(y + (long)u.pm * 256 * 512); }
    DI const char* b_base(const g8::Unit& u) const { const u16* w = u.aux == 0 ? P_wt_ret(p) : u.aux == 1 ? P_wt_win(p) : P_wt_na(p); return (const char*)(w + (long)u.pn * 256 * 512); }
    DI void gather(const g8::Unit&, const int (&)[2], const int (&)[2], unsigned (&)[2][2]) const {}
    DI void epi(g8::Acc& acc, const g8::Unit& u, int wr, int wc, int fr, int fq) const {
        const int b = u.aux;
        const long row0 = (long)u.pm * 256 + wr * 64 + fr;
        const int col0 = u.pn * 256 + wc * 32 + fq * 8;
        const u8* gp = (const u8*)(P_px(p) + C_GATE) + b * 1024;
        const u16* zs = P_z(p) + (b == 2 ? (long)NLAT * DM : 0);
        u16* dst = b == 2 ? P_hx(p) : P_z(p) + (b == 1 ? (long)NLAT * DM : 0);
#pragma unroll
        for (int ai = 0; ai < 2; ++ai) {
            uint2 gv[8]; u32x4 zv[8];
#pragma unroll
            for (int j = 0; j < 8; ++j) gv[j] = *(const uint2*)(gp + (row0 + ai * 128 + (j >> 1) * 16) * (INC * 2) + col0 + (j & 1) * 128);
            if (b != 0) {
#pragma unroll
                for (int j = 0; j < 8; ++j) zv[j] = *(const u32x4*)(zs + (row0 + ai * 128 + (j >> 1) * 16) * DM + col0 + (j & 1) * 128);
            } else {
#pragma unroll
                for (int j = 0; j < 8; ++j) zv[j] = u32x4{0u, 0u, 0u, 0u};
            }
#pragma unroll
            for (int j = 0; j < 8; ++j) {
                const int m = j >> 1, bj = j & 1;
                u32x4 o;
#pragma unroll
                for (int e = 0; e < 4; ++e) {
                    const int n = e >> 1, e2 = (e & 1) * 2;
                    const int gw = (int)(n == 0 ? gv[j].x : gv[j].y);
                    const float g0 = (e & 1) ? __builtin_amdgcn_cvt_f32_fp8(gw, 2) : __builtin_amdgcn_cvt_f32_fp8(gw, 0), g1 = (e & 1) ? __builtin_amdgcn_cvt_f32_fp8(gw, 3) : __builtin_amdgcn_cvt_f32_fp8(gw, 1);
                    const float lo = bflo(zv[j][e]) + acc[ai][bj][m][n][e2] * sigmoidf_(g0), hi = bfhi(zv[j][e]) + acc[ai][bj][m][n][e2 + 1] * sigmoidf_(g1);
                    o[e] = pack2(lo, hi);
                }
                *(u32x4*)(dst + (row0 + ai * 128 + m * 16) * DM + col0 + bj * 128) = o;
            }
        }
    }
};
template <bool HM>
struct ProbJ {
    static constexpr int K = 1024, UM = HM ? 128 : 256, NAI = HM ? 1 : 2, NLU = 16 * (2048 / UM) * 8; static constexpr bool PERM = true, GATHER = true, FP8 = true, HALF_M = HM;
    KP p; int nctx;
    DI bool next(int i, g8::Unit& u) const {
        const int id = i * (int)gridDim.x + BIDX();
        if (id >= NLU + nctx) return false;
        if (id >= NLU) { const int j = id - NLU; u.aux = 16 + (j >> 3); u.pm = 0; u.pn = j & 7; return true; }
        if (gridDim.x == 256) {
            const int x = BIDX() & 7, y = BIDX() >> 3;
            if (HM) { u.aux = 2 * i + (x >> 2); u.pm = (x & 3) * 4 + (y >> 3); u.pn = y & 7; }
            else { u.aux = 4 * i + (x >> 1); u.pm = (x & 1) * 4 + (y >> 3); u.pn = y & 7; }
        } else { u.aux = id / (NLU / 16); u.pm = (id >> 3) & (2048 / UM - 1); u.pn = id & 7; }
        return true;
    }
    DI const char* a_base(const g8::Unit&) const { return (const char*)P_hx8(p); }
    DI const char* b_base(const g8::Unit& u) const { return (const char*)(P_wgu8(p) + ((long)(u.aux & 15) * 2048 + u.pn * 256) * DM); }
    DI void gather(const g8::Unit& u, const int (&R)[2], const int (&C)[2], unsigned (&va)[2][2]) const {
        const int* si = P_sel_idx(p) + u.aux * 2048 + u.pm * UM;
        const int cap = u.aux < 16 ? CAP_LAT : CAP_CTX;
#pragma unroll
        for (int h = 0; h < 2; ++h)
#pragma unroll
            for (int j = 0; j < 2; ++j) {
                const int r = (HM ? 0 : h * 128) + R[j];
                va[h][j] = (unsigned)(si[u.pm * UM + r < cap ? r : -u.pm * UM] * DM + C[j] * 2);
            }
    }
    DI void epi(g8::Acc& acc, const g8::Unit& u, int wr, int wc, int fr, int fq) const {
        const bool lat = u.aux < 16;
        u8* hb = lat ? P_hid8(p) + (long)u.aux * 2048 * EH : P_hidc8(p) + (long)(u.aux - 16) * 32 * EH;
        const int cap = lat ? CAP_LAT : CAP_CTX;
#pragma unroll
        for (int ai = 0; ai < NAI; ++ai)
#pragma unroll
            for (int m = 0; m < 4; ++m) {
                const int slot = u.pm * UM + ai * 128 + wr * 64 + m * 16 + fr;
                const int f = u.pn * 128 + wc * 32 + fq * 8;
                float hv[8];
#pragma unroll
                for (int n = 0; n < 2; ++n)
#pragma unroll
                    for (int e = 0; e < 4; ++e) hv[4 * n + e] = clamp448(siluf_(acc[ai][0][m][n][e] * 0.03125f) * acc[ai][1][m][n][e] * (0.03125f * 4.f));
                uint2 o; o.x = pack_fp8x4(hv[0], hv[1], hv[2], hv[3]); o.y = pack_fp8x4(hv[4], hv[5], hv[6], hv[7]);
                if (slot < cap) *(uint2*)(hb + (long)slot * EH + f) = o;
            }
    }
};
template <bool HM>
struct ProbK {
    static constexpr int K = 1024, UM = HM ? 128 : 256, NAI = HM ? 1 : 2, NLU = 16 * (2048 / UM) * 4; static constexpr bool PERM = true, GATHER = false, FP8 = true, HALF_M = HM;
    KP p; int layer; int nctx;
    DI bool next(int i, g8::Unit& u) const {
        const int id = i * (int)gridDim.x + BIDX();
        if (id >= NLU + nctx) return false;
        if (id >= NLU) { const int j = id - NLU; u.aux = 16 + (j >> 2); u.pm = 0; u.pn = j & 3; return true; }
        if (gridDim.x == 256) {
            const int x = BIDX() & 7, y = BIDX() >> 3;
            if (HM) { u.aux = 4 * i + (x >> 1); u.pm = (x & 1) * 8 + (y >> 2); u.pn = y & 3; }
            else { u.aux = 8 * i + x; u.pm = y >> 2; u.pn = y & 3; }
        } else { u.aux = id / (NLU / 16); u.pm = (id >> 2) & (2048 / UM - 1); u.pn = id & 3; }
        return true;
    }
    DI const char* a_base(const g8::Unit& u) const { return (const char*)(u.aux < 16 ? P_hid8(p) + ((long)u.aux * 2048 + u.pm * UM) * EH : P_hidc8(p) + (long)(u.aux - 16) * 32 * EH); }
    DI const char* b_base(const g8::Unit& u) const { return (const char*)(P_wdn8(p) + ((long)(u.aux & 15) * 1024 + u.pn * 256) * EH); }
    DI void gather(const g8::Unit&, const int (&)[2], const int (&)[2], unsigned (&)[2][2]) const {}
    DI void epi(g8::Acc& acc, const g8::Unit& u, int wr, int wc, int fr, int fq) const {
        const bool lat = u.aux < 16;
        const float* md = P_mod(p) + (layer * 2 + (lat ? 0 : 1)) * 6144 + 5 * 1024;
        const int cap = lat ? CAP_LAT : CAP_CTX;
        f32x4 mv[2][2];
#pragma unroll
        for (int bj = 0; bj < 2; ++bj)
#pragma unroll
            for (int n = 0; n < 2; ++n) mv[bj][n] = *(const f32x4*)(md + u.pn * 256 + bj * 128 + wc * 32 + fq * 8 + n * 4) * (32.f / 128.f);
        float gs[NAI][4];
#pragma unroll
        for (int ai = 0; ai < NAI; ++ai)
#pragma unroll
            for (int m = 0; m < 4; ++m) { const int sl = u.pm * UM + ai * 128 + wr * 64 + m * 16 + fr; gs[ai][m] = P_sel_gate(p)[u.aux * 2048 + (sl < cap ? sl : 0)]; }
#pragma unroll
        for (int ai = 0; ai < NAI; ++ai)
#pragma unroll
            for (int m = 0; m < 4; ++m) {
                const int sl = u.pm * UM + ai * 128 + wr * 64 + m * 16 + fr;
                const float g = gs[ai][m];
                u8* yr = (lat ? P_ye8(p) + ((long)u.aux * 2048 + sl) * DM : P_yec8(p) + ((long)(u.aux - 16) * 32 + sl) * DM) + u.pn * 256 + wc * 32 + fq * 8;
#pragma unroll
                for (int bj = 0; bj < 2; ++bj) {
                    float hv[8];
#pragma unroll
                    for (int n = 0; n < 2; ++n)
#pragma unroll
                        for (int e = 0; e < 4; ++e) hv[4 * n + e] = clamp448(acc[ai][bj][m][n][e] * g * mv[bj][n][e]);
                    uint2 o; o.x = pack_fp8x4(hv[0], hv[1], hv[2], hv[3]); o.y = pack_fp8x4(hv[4], hv[5], hv[6], hv[7]);
                    if (sl < cap) *(uint2*)(yr + bj * 128) = o;
                }
            }
    }
};

DI void phH_item(KP p, int layer, int item, char* smem) {
    const int lane = TIDX() & 63, wid = TIDX() >> 6;
    float* hall = (float*)smem;
    float* red = (float*)smem + 16 * 1028;
    const int row0 = item * 16 + wid * 4;
    norm_rows4<1>(p, layer, row0, p->g_ffn + layer * DM, 3, 4, false, false, hall + wid * 4 * 1028);
    __syncthreads();
    {
        const float* ap = hall + (lane & 15) * 1028 + wid * 256 + (lane >> 4);
        const float* bp = p->w_router + (long)layer * 1024 * 16 + (long)(wid * 256 + (lane >> 4)) * 16 + (lane & 15);
        f32x4 acc = {0.f, 0.f, 0.f, 0.f};
#pragma unroll 16
        for (int s2 = 0; s2 < 64; ++s2) acc = __builtin_amdgcn_mfma_f32_16x16x4f32(ap[s2 * 4], bp[s2 * 64], acc, 0, 0, 0);
#pragma unroll
        for (int r = 0; r < 4; ++r) red[wid * 256 + (4 * (lane >> 4) + r) * 16 + (lane & 15)] = acc[r];
    }
    __syncthreads();
    {
        const int e = lane & 15, r = lane >> 4, row = row0 + r;
        float l = 0.f;
#pragma unroll
        for (int w = 0; w < 4; ++w) l += red[w * 256 + (wid * 4 + r) * 16 + e];
        float mx = l;
        mx = fmaxf(mx, __shfl_xor(mx, 1)); mx = fmaxf(mx, __shfl_xor(mx, 2)); mx = fmaxf(mx, __shfl_xor(mx, 4)); mx = fmaxf(mx, __shfl_xor(mx, 8));
        const float ex = expf(l - mx);
        float sm = ex;
        sm += __shfl_xor(sm, 1); sm += __shfl_xor(sm, 2); sm += __shfl_xor(sm, 4); sm += __shfl_xor(sm, 8);
        const float a = ex / sm;
        if (row < NLAT) P_aff(p)[(long)e * NLAT + row] = a;
        else P_aff(p)[(long)(16 + e) * NLAT + (row - NLAT)] = a;
    }
    __syncthreads();
}

DI int block_excl_scan(int v, int* sh  , int& total) {
    const int lane = TIDX() & 63, wid = TIDX() >> 6;
    int inc = v;
    for (int o = 1; o < 64; o <<= 1) { int t = __shfl_up(inc, o); if (lane >= o) inc += t; }
    __syncthreads();
    if (lane == 63) sh[wid] = inc;
    __syncthreads();
    int base = 0;
    for (int w = 0; w < wid; ++w) base += sh[w];
    total = sh[0] + sh[1] + sh[2] + sh[3];
    return base + inc - v;
}
DI void phI_item(KP p, int job, char* smem) {
    const int tid = TIDX(), lane = tid & 63, wid = tid >> 6;
    const bool lat = job < 16;
    const int n = lat ? NLAT : NCTX, cap = lat ? CAP_LAT : CAP_CTX, rowbase = lat ? 0 : NLAT;
    int* sh = (int*)smem;
    const float* a = P_aff(p) + (long)job * NLAT;
    unsigned keys[64];
    if (lat) {
#pragma unroll
        for (int i = 0; i < 16; ++i) { u32x4 v = *(const u32x4*)(a + tid * 64 + i * 4); keys[4 * i] = v[0]; keys[4 * i + 1] = v[1]; keys[4 * i + 2] = v[2]; keys[4 * i + 3] = v[3]; }
    } else {
#pragma unroll
        for (int i = 0; i < 64; ++i) keys[i] = 0u;
        keys[0] = __float_as_uint(a[tid]);
    }
    __syncthreads();
    int* hist = sh + 32;
    unsigned T = 0u, pmask = 0u; int remaining = cap;
#pragma unroll 1
    for (int pass = 0; pass < 3; ++pass) {
        const int shift = pass == 0 ? 19 : pass == 1 ? 8 : 0, nb_ = pass == 2 ? 256 : 2048;
        for (int i = tid; i < 2048; i += 256) hist[i] = 0;
        __syncthreads();
#pragma unroll
        for (int i = 0; i < 64; ++i) { const unsigned k = keys[i]; if (k != 0u && (k & pmask) == T) atomicAdd(&hist[(k >> shift) & (nb_ - 1)], 1); }
        __syncthreads();
        int mine = 0;
        const int top = nb_ - 1 - 8 * tid;
        if (top >= 7) {
#pragma unroll
            for (int q = 0; q < 8; ++q) mine += hist[top - q];
        }
        int tot_;
        const int above = block_excl_scan(mine, sh + 8, tot_);
        if (top >= 7 && above < remaining && above + mine >= remaining) {
            int cum = above, q = 0;
            for (; q < 7; ++q) { const int hv = hist[top - q]; if (cum + hv >= remaining) break; cum += hv; }
            sh[16] = top - q; sh[17] = remaining - cum;
        }
        __syncthreads();
        T |= ((unsigned)sh[16]) << shift; pmask |= ((unsigned)(nb_ - 1)) << shift; remaining = sh[17];
        __syncthreads();
    }
    int ceq = 0;
#pragma unroll
    for (int i = 0; i < 64; ++i) ceq += (keys[i] == T);
    __syncthreads();
    int tot;
    int er = block_excl_scan(ceq, sh + 8, tot);
    int csel = 0;
    { int e2 = er;
#pragma unroll
      for (int i = 0; i < 64; ++i) { const unsigned k = keys[i]; if (k > T) ++csel; else if (k == T) { if (e2 < remaining) ++csel; ++e2; } } }
    int slot = block_excl_scan(csel, sh + 8, tot);
    int* ts = P_tslot(p) + (long)job * NLAT;
    const int per = lat ? 64 : 1;
    const int base = tid * per;
    int* tsl = sh + 32 + 2048;
#pragma unroll
    for (int i = 0; i < 64; ++i) {
        if (i < per) {
            const unsigned k = keys[i];
            bool sel = false;
            if (k > T) sel = true; else if (k == T) { sel = er < remaining; ++er; }
            if (sel) { P_sel_idx(p)[job * 2048 + slot] = rowbase + base + i; P_sel_gate(p)[job * 2048 + slot] = __uint_as_float(k); tsl[tid * 65 + i] = slot; ++slot; }
            else tsl[tid * 65 + i] = -1;
        }
    }
    __syncthreads();
    if (lat) { for (int idx = tid; idx < NLAT; idx += 256) ts[idx] = tsl[(idx >> 6) * 65 + (idx & 63)]; }
    else ts[tid] = tsl[tid * 65];
    __syncthreads();
}

DI void phJ_tile(KP p, int job, int mt, int nt, char* smem) {
    const int tid = TIDX(), lane = tid & 63, wid = tid >> 6, wr = wid >> 1, wc = wid & 1, fr = lane & 15, fq = lane >> 4;
    const int cap = job < 16 ? CAP_LAT : CAP_CTX, e = job & 15;
    f32x4 acc[4][4]; zero_acc<4>(acc);
    const int r0 = tid >> 2, ko = (tid & 3) * 8;
    int s0 = mt * 128 + r0, s1 = s0 + 64;
    s0 = s0 < cap ? s0 : cap - 1; s1 = s1 < cap ? s1 : cap - 1;
    const u16* a0 = P_hx(p) + (long)P_sel_idx(p)[job * 2048 + s0] * DM + ko;
    const u16* a1 = P_hx(p) + (long)P_sel_idx(p)[job * 2048 + s1] * DM + ko;
    const int f_lo = nt * 64 + (r0 & 31), f_hi = f_lo + 32, gu = (r0 >> 5) & 1;
    const u16* b0 = P_wt_gu(p) + ((long)e * 2048 + (f_lo >> 7) * 256 + gu * 128 + (f_lo & 127)) * DM + ko;
    const u16* b1 = P_wt_gu(p) + ((long)e * 2048 + (f_hi >> 7) * 256 + gu * 128 + (f_hi & 127)) * DM + ko;
    gemm_core<32>(acc, a0, a1, b0, b1, smem);
    u16* hb = job < 16 ? P_hid(p) + (long)job * 2048 * EH : P_hidc(p) + (long)(job - 16) * 32 * EH;
#pragma unroll
    for (int m = 0; m < 4; ++m)
#pragma unroll
        for (int n = 0; n < 2; ++n)
#pragma unroll
            for (int j = 0; j < 4; ++j) {
                int slot = mt * 128 + wr * 64 + m * 16 + fq * 4 + j;
                int f = nt * 64 + wc * 32 + n * 16 + fr;
                if (slot < cap) hb[(long)slot * EH + f] = f2bf(siluf_(acc[m][n][j]) * acc[m][n + 2][j]);
            }
}
DI void phK_tile(KP p, int layer, int job, int mt, int nt, char* smem) {
    const int tid = TIDX(), lane = tid & 63, wid = tid >> 6, wr = wid >> 1, wc = wid & 1, fr = lane & 15, fq = lane >> 4;
    const int cap = job < 16 ? CAP_LAT : CAP_CTX, e = job & 15;
    f32x4 acc[4][4]; zero_acc<4>(acc);
    const int r0 = tid >> 2, ko = (tid & 3) * 8;
    int s0 = mt * 128 + r0, s1 = s0 + 64;
    s0 = s0 < cap ? s0 : cap - 1; s1 = s1 < cap ? s1 : cap - 1;
    const u16* hb = job < 16 ? P_hid(p) + (long)job * 2048 * EH : P_hidc(p) + (long)(job - 16) * 32 * EH;
    const u16* a0 = hb + (long)s0 * EH + ko;
    const u16* a1 = hb + (long)s1 * EH + ko;
    const u16* b0 = P_wt_dn(p) + ((long)e * 1024 + nt * 128 + r0) * EH + ko;
    gemm_core<32>(acc, a0, a1, b0, b0 + 64 * EH, smem);
    const float* md = P_mod(p) + (layer * 2 + (job < 16 ? 0 : 1)) * 6144 + 5 * 1024;
    u16* yb_ = job < 16 ? P_ye(p) + (long)job * 2048 * DM : P_yec(p) + (long)(job - 16) * 32 * DM;
#pragma unroll
    for (int m = 0; m < 4; ++m)
#pragma unroll
        for (int j = 0; j < 4; ++j) {
            int slot = mt * 128 + wr * 64 + m * 16 + fq * 4 + j;
            if (slot < cap) {
                float g = P_sel_gate(p)[job * 2048 + slot];
#pragma unroll
                for (int n = 0; n < 4; ++n) {
                    int col = nt * 128 + wc * 64 + n * 16 + fr;
                    yb_[(long)slot * DM + col] = f2bf(acc[m][n][j] * g * md[col]);
                }
            }
        }
}


#define XB_TMO      128
#define XB_XCNT(j)  (256  + 64 * (j))
#define XB_XSUB(j)  (1280 + 64 * (j))
#define XB_XGEN(j)  (2304 + 64 * (j))
#define XB_TOP      3328
#define XB_TOPGEN   3392
#define XCD_BAR_WORDS 3456
#define XB_SPIN_CAP (1u << 18)
DI unsigned xb_ld(unsigned* p)              { return __hip_atomic_load(p, __ATOMIC_RELAXED, __HIP_MEMORY_SCOPE_AGENT); }
DI unsigned xb_add(unsigned* p, unsigned v) { return __hip_atomic_fetch_add(p, v, __ATOMIC_RELAXED, __HIP_MEMORY_SCOPE_AGENT); }
DI unsigned xb_xcc_id() { return (unsigned)__builtin_amdgcn_s_getreg((3 << 11) | 20) & 0xFu; }
#define XB_SPIN(cond, bar) do { unsigned _sp = 0; while (cond) { __builtin_amdgcn_s_sleep(1); \
    if ((++_sp & 255u) == 0u) { if (xb_ld(&(bar)[XB_TMO])) break; if (_sp > XB_SPIN_CAP) { atomicAdd(&(bar)[XB_TMO], 1u); break; } } } } while (0)
struct XcdBarrier { unsigned* bar; unsigned x; volatile LAS unsigned* st; };
DI XcdBarrier xcd_barrier_post(unsigned* bar, volatile LAS unsigned* st) {
    XcdBarrier b; b.bar = bar; b.x = xb_xcc_id(); b.st = st;
    if (threadIdx.x == 0) (void)xb_add(&bar[XB_XCNT(b.x)], 1u);
    return b;
}
DI void xcd_barrier_complete(unsigned* bar, unsigned x, unsigned& nloc, unsigned& nx) {
    const unsigned G = gridDim.x * gridDim.y * gridDim.z;
    unsigned sum, cnt, mine, sp = 0u;
    for (;;) {
        sum = 0u; cnt = 0u; mine = 0u;
#pragma unroll
        for (unsigned j = 0; j < 16; ++j) { const unsigned c = xb_ld(&bar[XB_XCNT(j)]); sum += c; cnt += (c > 0u) ? 1u : 0u; mine = (j == x) ? c : mine; }
        if (sum == G) break;
        __builtin_amdgcn_s_sleep(1);
        if ((++sp & 255u) == 0u) { if (xb_ld(&bar[XB_TMO])) break; if (sp > XB_SPIN_CAP) { atomicAdd(&bar[XB_TMO], 1u); break; } }
    }
    nloc = mine > 0u ? mine : 1u; nx = cnt > 0u ? cnt : 1u;
}
DI void xcd_barrier(const XcdBarrier& b) {
    asm volatile("s_waitcnt vmcnt(0)" ::: "memory");
    __syncthreads();
    if (threadIdx.x == 0) {
        unsigned* bar = b.bar;
        __builtin_amdgcn_s_waitcnt(0);
        unsigned nloc = b.st[0], nx = b.st[1];
        if (nloc == 0u) { xcd_barrier_complete(bar, b.x, nloc, nx); b.st[0] = nloc; b.st[1] = nx; }
        const unsigned old = xb_add(&bar[XB_XSUB(b.x)], 1u);
        const unsigned gen = old / nloc;
        if (old + 1u == (gen + 1u) * nloc) {
            __builtin_amdgcn_fence(__ATOMIC_RELEASE, "agent");
            asm volatile("s_waitcnt vmcnt(0)" ::: "memory");
            const unsigned og = xb_add(&bar[XB_TOP], 1u);
            const unsigned tg = og / nx;
            if (og + 1u == (tg + 1u) * nx) xb_add(&bar[XB_TOPGEN], 1u);
            else XB_SPIN(xb_ld(&bar[XB_TOPGEN]) == tg, bar);
            __builtin_amdgcn_fence(__ATOMIC_ACQUIRE, "agent");
            xb_add(&bar[XB_XGEN(b.x)], 1u);
            asm volatile("s_waitcnt vmcnt(0)" ::: "memory");
        } else {
            XB_SPIN(xb_ld(&bar[XB_XGEN(b.x)]) == gen, bar);
            __builtin_amdgcn_fence(__ATOMIC_ACQUIRE, "agent");
            asm volatile("s_waitcnt vmcnt(0)" ::: "memory");
        }
    }
    __syncthreads();
}

DI void run_phase(int ph, char* smem_all, int variant = 0) {
    KP p = (KP)__builtin_amdgcn_kernarg_segment_ptr();
    asm volatile("" : "+s"(p));
    const int sb = TID512() >> 8;
    char* smem = smem_all + sb * SUB_LDS;
    const int bid = BIDX() * 2 + sb, nb = gridDim.x * 2, tid = TIDX(), wid = tid >> 6;
#ifndef ONLY_SUB
    if (ph == 0) {
        for (int it = bid; it < 240; it += nb) {
            if (it < 192) ph0_gemv_item(p, it, smem);
            else ph0_rope_item(p, it - 192);
        }
        convert_tiles(p, 0, bid, CONV_DENSE, nb, smem);
        return;
    }
    if (ph == NPHASE - 1) {
        for (int it = bid; it < NLAT / 16; it += nb) {
            const int row0 = it * 16 + wid * 4, lane = tid & 63;
            float4 v[4][4];
#pragma unroll
            for (int r = 0; r < 4; ++r) load_res_row(p, row0 + r, false, v[r]);
            float4 g[4];
#pragma unroll
            for (int i = 0; i < 4; ++i) g[i] = *(const float4*)(p->g_final + i * 256 + lane * 4);
            moe_combine4(p, row0, v);
#pragma unroll
            for (int r = 0; r < 4; ++r) {
                float ss = 0.f;
#pragma unroll
                for (int i = 0; i < 4; ++i) ss += v[r][i].x * v[r][i].x + v[r][i].y * v[r][i].y + v[r][i].z * v[r][i].z + v[r][i].w * v[r][i].w;
                ss = wave_sum(ss);
                const float rstd = rsqrtf(ss * (1.f / DM) + 1e-6f);
                float* xr = p->out + (long)(row0 + r) * DM;
#pragma unroll
                for (int i = 0; i < 4; ++i)
                    *(float4*)(xr + i * 256 + lane * 4) = make_float4(v[r][i].x * rstd * g[i].x, v[r][i].y * rstd * g[i].y, v[r][i].z * rstd * g[i].z, v[r][i].w * rstd * g[i].w);
            }
        }
        return;
    }
    const int layer = (ph - 1) / 11, sub = (ph - 1) % 11;
#else
    const int layer = (ph - 1) / 11, sub = ONLY_SUB;
#endif
    const bool need_ctx = layer == 0;
    switch (sub) {
    case 0: {
        const int nrow_items = NROWS / 16;
        for (int it = bid; it < nrow_items; it += nb) norm_rows4<2>(p, layer, it * 16 + wid * 4, p->g_mix + layer * DM, 0, 1, layer == 0, layer == 1);
        if (layer == 1) convert_tiles(p, layer, bid, CONV_DENSE, nb, smem);
    } break;
    case 1: {
        { ProbBT<false> pb{p}; g8::gemm_phase((LAS unsigned char*)smem_all, pb); }
        { ProbBT<true> pb8{p}; g8::gemm_phase((LAS unsigned char*)smem_all, pb8); }
        const int nwork = (int)gridDim.x - B_SPARE;
        if (BIDX() >= nwork) {
            const int sb2 = TID512() >> 8, q = (BIDX() - nwork) * 2 + sb2;
            convert_tiles4(p, layer, CONV_DENSE + q, CONV_DENSE + CONV_INB, 2 * B_SPARE, smem_all + sb2 * SUB_LDS);
        }
    } break;
    case 2: {
        const int n_state = NCHUNK * 8, n_win = 1024, n_na = 1024, n_cx = need_ctx ? 32 : 0;
        const int total = n_state + n_win + n_na + n_cx;
        for (int it = bid; it < total; it += nb) {
            if (variant == 1 && it >= n_na && it < n_na + n_win) continue;
            if (variant == 1 && it >= n_na + n_win) continue;
            if (variant == 2 && (it < n_na || it >= n_na + n_win)) continue;
            if (variant == 3 && (it < n_na + n_win || it >= n_na + n_win + n_state)) continue;
            if (it < n_na) attn_block_item(p, layer, 1, it >> 3, it & 7, smem);
            else if (it < n_na + n_win) { int i2 = it - n_na; attn_block_item(p, layer, 0, i2 >> 1, i2 & 1, smem); }
            else if (it < n_win + n_na + n_state) { int i2 = it - n_win - n_na; phC_state_item(p, layer, i2 >> 3, (i2 >> 1) & 3, i2 & 1, smem); }
            else { int i2 = it - n_win - n_na - n_state; if (i2 < 16) attn_block_item(p, layer, 2, i2 >> 1, i2 & 1, smem); else { i2 -= 16; attn_block_item(p, layer, 3, i2 >> 3, i2 & 7, smem); } }
        }
    } break;
    case 3: {
        for (int it = bid; it < 512; it += nb) phD_item(p, layer, it);
    } break;
    case 4: {
        const int nch = need_ctx ? NCHUNK : 128;
        for (int it = bid; it < nch * 8; it += nb) phE_item(p, layer, it >> 3, (it >> 1) & 3, it & 1, smem);
        if (need_ctx && bid >= nb - 128) {
            float* z = (bid >= nb - 64 ? P_maccx(p) + (long)(bid - (nb - 64)) * 4096 : (float*)P_gacc(p) + (long)(bid - (nb - 128)) * 4096) + tid * 16;
#pragma unroll
            for (int i = 0; i < 4; ++i) *(f32x4*)(z + i * 4) = f32x4{0.f, 0.f, 0.f, 0.f};
        }
    } break;
    case 5: {
        { ProbF pf{p}; g8::gemm_phase((LAS unsigned char*)smem_all, pf); }
        if (need_ctx) {
            const int sb2 = TID512() >> 8;
            for (int it = BIDX() * 2 + sb2; it < 384; it += (int)gridDim.x * 2) { const int tb = it >> 3, tile = tb / 3; phF_tile(p, 128 + (tile >> 3), tile & 7, tb % 3, it & 7, smem_all + sb2 * SUB_LDS); }
        }
    } break;
    case 6: {
        { ProbG pg{p, layer}; g8::gemm_phase((LAS unsigned char*)smem_all, pg); }
        if (need_ctx) {
            const int sb2 = TID512() >> 8;
            for (int it = BIDX() * 2 + sb2; it < 512; it += (int)gridDim.x * 2) { const int tile = it >> 5; phG_tile(p, layer, 128 + (tile >> 3), tile & 7, it & 31, smem_all + sb2 * SUB_LDS); }
        }
    } break;
    case 7: {
        const int nit = (need_ctx ? NROWS : NLAT) / 16;
        for (int it = bid; it < nit; it += nb) phH_item(p, layer, it, smem);
    } break;
    case 8: {
        const int njob = need_ctx ? 32 : 16;
        if (bid < njob) phI_item(p, bid, smem);
        else convert_tiles(p, layer, CONV_DENSE + CONV_INB + (bid - njob), CONV_TILES, nb - njob, smem);
    } break;
    case 9: {
        ProbJ<MOE_HM> pj{p, need_ctx ? 128 : 0}; g8::gemm_phase((LAS unsigned char*)smem_all, pj);
    } break;
    case 10: {
        ProbK<MOE_HM> pk{p, layer, need_ctx ? 64 : 0}; g8::gemm_phase((LAS unsigned char*)smem_all, pk);
    } break;
    }
}

__global__ void __launch_bounds__(NTHREADS, 2) mega_kernel(Params p, int ph_lo, int ph_hi) {
    __shared__ __attribute__((aligned(16))) char smem[LDS_BYTES + 16];
    cg::grid_group grid = cg::this_grid();
#if MK_MULTI
    for (int ph = ph_lo; ph < ph_hi; ++ph) {
        if (ph > ph_lo) grid.sync();
        run_phase(ph, smem);
    }
#else
    unsigned* barw = (unsigned*)(p.ws + WS_BAR);
    volatile LAS unsigned* xst = (volatile LAS unsigned*)(LAS char*)(smem + LDS_BYTES);
    if (threadIdx.x < 4) xst[threadIdx.x] = 0u;
    if (blockIdx.x == 0) for (int i = threadIdx.x; i < XCD_BAR_WORDS; i += NTHREADS) barw[i] = 0u;
    run_phase(0, smem);
    grid.sync();
    const XcdBarrier xb = xcd_barrier_post(barw, xst);
#ifdef PROBE_SUB
#define PH(n) do { if ((n) > 1) xcd_barrier(xb); run_phase((n), smem); if ((n) >= PROBE_MIN && (n) <= PROBE_MAX && (((n) - 1) % 11) == PROBE_SUB) { xcd_barrier(xb); run_phase((n), smem, PROBE_VARIANT); } } while (0)
#else
#define PH(n) do { if ((n) > 1) xcd_barrier(xb); run_phase((n), smem); } while (0)
#endif
    PH(1); PH(2); PH(3); PH(4); PH(5); PH(6); PH(7); PH(8); PH(9); PH(10); PH(11);
    PH(12); PH(13); PH(14); PH(15); PH(16); PH(17); PH(18); PH(19); PH(20); PH(21); PH(22); PH(23);
    static_assert(NPHASE == 24, "phase program");
#undef PH
#endif
}

extern "C" void kernel_launch(void* const* d_in, const int* in_sizes, int n_in, void* d_out, int out_size, void* d_ws, size_t ws_size,
                              hipStream_t stream) {
    static int grid_blocks = 0;
    if (!grid_blocks) {
        int dev = 0, cus = 0, per_cu = 0;
        hipGetDevice(&dev);
        hipDeviceGetAttribute(&cus, hipDeviceAttributeMultiprocessorCount, dev);
        hipOccupancyMaxActiveBlocksPerMultiprocessor(&per_cu, mega_kernel, NTHREADS, 0);
        if (per_cu < 1) per_cu = 1;
        if (per_cu > 1) per_cu = 1;
        grid_blocks = cus * per_cu;
    }
    Params p{};
    const float** ip = (const float**)&p.x;
    for (int i = 0; i < 22; ++i) ip[i] = (const float*)d_in[i];
    p.out = (float*)d_out;
    p.ws = (char*)d_ws;
    if (WS_END > ws_size) { fprintf(stderr, "kernel_launch: workspace too small: need %zu have %zu\n", (size_t)WS_END, ws_size); return; }
#if MK_MULTI
    for (int ph = 0; ph < NPHASE; ++ph) {
        hipLaunchKernelGGL(mega_kernel, dim3(grid_blocks), dim3(NTHREADS), 0, stream, p, ph, ph + 1);
    }
#else
    int lo = 0, hi = NPHASE;
    void* args[] = {&p, &lo, &hi};
    hipError_t e = hipLaunchCooperativeKernel((void*)mega_kernel, dim3(grid_blocks), dim3(NTHREADS), args, 0, stream);
    if (e != hipSuccess) fprintf(stderr, "cooperative launch failed: %s (grid %d)\n", hipGetErrorString(e), grid_blocks);
#endif
}
```
